# Optimizing an MI355X kernel written in HIP

```python
import math
import jax
import jax.numpy as jnp
from jax import lax
import numpy as np

D_MODEL = 1024
BATCH = 2
SEQ = 16384
DEPTH = 2

GRID_W = 64
CTX_LEN = 256

HG_HEADS = 6
HG_KDIM = 64
HG_VDIM = 64
RET_HEADS = 6
RET_KDIM = 64
RET_VDIM = 64
DA_HEADS = 4
DA_HEAD_DIM = 32
DA_VDIM = 2 * DA_HEAD_DIM
MIX_WIDTH = HG_HEADS * HG_VDIM + RET_HEADS * RET_VDIM + DA_HEADS * DA_VDIM
IN_SPLITS = (HG_HEADS * HG_KDIM, HG_HEADS * HG_KDIM, HG_HEADS * HG_KDIM, HG_HEADS * HG_VDIM, HG_HEADS * HG_VDIM, RET_HEADS * RET_KDIM, RET_HEADS * RET_KDIM, RET_HEADS * RET_VDIM, RET_HEADS * RET_VDIM, 2 * DA_HEADS * DA_HEAD_DIM, 2 * DA_HEADS * DA_HEAD_DIM, DA_HEADS * DA_VDIM)
IN_COLS = sum(IN_SPLITS)

CHUNK = 64
ATTN_BLOCK = 128
ROPE_BASE = 10000.0
N_EXPERTS = 32
TOP_K = 4
D_FF = D_MODEL
EXPERT_BLOCK = 128
SWIGLU_ALPHA = 1.702
SWIGLU_LIMIT = 7.0
NORM_EPS = 1e-6

kernel_name = 'hybrid_hgrn2_retention_diffattn_moe_dit'

F32 = jnp.float32


def rms_norm(x, g):
    xf = x.astype(F32)
    y = xf * lax.rsqrt(jnp.mean(xf * xf, axis=-1, keepdims=True) + NORM_EPS)
    return (y * g.astype(F32)).astype(x.dtype)


def split_heads(a, head_dim):
    return a.reshape(a.shape[:-1] + (a.shape[-1] // head_dim, head_dim))


def split_cols(p):
    bounds = []
    acc = 0
    for w in IN_SPLITS[:-1]:
        acc += w
        bounds.append(acc)
    return jnp.split(p, bounds, axis=-1)


def rope_tables(pos, dim):
    inv = 1.0 / (ROPE_BASE ** (jnp.arange(0, dim, 2, dtype=F32) / dim))
    ang = pos.astype(F32)[:, None] * inv[None, :]
    return jnp.cos(ang), jnp.sin(ang)


def apply_rope(x, cos, sin):
    half = x.shape[-1] // 2
    xf = x.astype(F32)
    x1, x2 = xf[..., :half], xf[..., half:]
    c = cos[None, :, None, :]
    s = sin[None, :, None, :]
    return jnp.concatenate([x1 * c - x2 * s, x2 * c + x1 * s], axis=-1).astype(x.dtype)


def apply_axial_rope(x, rope_row, rope_col):
    half = x.shape[-1] // 2
    return jnp.concatenate([apply_rope(x[..., :half], *rope_row), apply_rope(x[..., half:], *rope_col)], axis=-1)


def chunk_scan(q, k, v, logf, s0):
    out_dtype = v.dtype
    B, T, H, K = q.shape
    V = v.shape[-1]
    n = T // CHUNK

    def chunks(a):
        return a.astype(F32).reshape(B, n, CHUNK, H, a.shape[-1]).transpose(1, 0, 3, 2, 4)

    lower = jnp.tril(jnp.ones((CHUNK, CHUNK), dtype=bool))[:, :, None]

    def step(state, blk):
        qi, ki, vi, gi = blk
        b = jnp.cumsum(gi, axis=2)
        rel = jnp.where(lower, b[:, :, :, None, :] - b[:, :, None, :, :], -jnp.inf)
        scores = jnp.sum(qi[:, :, :, None, :] * ki[:, :, None, :, :] * jnp.exp(rel), axis=-1)
        o = jnp.einsum('bhts,bhsv->bhtv', scores, vi) + jnp.einsum('bhtk,bhkv->bhtv', qi * jnp.exp(b), state)
        b_end = b[:, :, -1:, :]
        state = jnp.exp(b_end[:, :, 0, :])[..., None] * state + jnp.einsum('bhsk,bhsv->bhkv', ki * jnp.exp(b_end - b), vi)
        return state, o

    state, o = lax.scan(step, s0.astype(F32), (chunks(q), chunks(k), chunks(v), chunks(logf)))
    o = o.transpose(1, 0, 3, 2, 4).reshape(B, T, H, V)
    return o.astype(out_dtype), state


def final_state(k, v, logf):
    cum = jnp.cumsum(logf.astype(F32), axis=1)
    w = jnp.exp(cum[:, -1:] - cum)
    return jnp.einsum('bthk,bthv->bhkv', k.astype(F32) * w, v.astype(F32))


def prefixed_scan(q, k, v, logf, qc, kc, vc, logfc, need_ctx, reverse):
    if reverse:
        q, k, v, logf, qc, kc, vc, logfc = [jnp.flip(a, axis=1) for a in (q, k, v, logf, qc, kc, vc, logfc)]
    if need_ctx:
        s_zero = jnp.zeros((qc.shape[0], qc.shape[2], qc.shape[3], vc.shape[3]), F32)
        oc, s_ctx = chunk_scan(qc, kc, vc, logfc, s_zero)
    else:
        oc, s_ctx = None, final_state(kc, vc, logfc)
    o, _ = chunk_scan(q, k, v, logf, s_ctx)
    if reverse:
        o = jnp.flip(o, axis=1)
        if oc is not None:
            oc = jnp.flip(oc, axis=1)
    return o, oc


def gated_head_norm(o, w, g):
    return rms_norm(o, w).reshape(g.shape) * jax.nn.silu(g)


def diff_attention(q, k, v, lam):
    B, T, H2, d = q.shape
    H = H2 // 2
    nb = T // ATTN_BLOCK
    qb = q.reshape(B, nb, ATTN_BLOCK, H2, d).transpose(1, 0, 2, 3, 4)
    scale = d ** -0.5

    def block(qi):
        s = jnp.einsum('bqhd,bkhd->bhqk', qi, k).astype(F32) * scale
        p = jax.nn.softmax(s, axis=-1).reshape(B, H, 2, ATTN_BLOCK, -1)
        a = p[:, :, 0] - lam * p[:, :, 1]
        return jnp.einsum('bhqk,bkhv->bqhv', a.astype(v.dtype), v)

    o = lax.map(block, qb)
    return o.transpose(1, 0, 2, 3, 4).reshape(B, T, H, v.shape[-1])


def token_mixer(h, hc, w_in, w_out, lower_bound, hg_norm_w, ret_dec, ret_norm_w, da_lam, da_subln_w, lam_init, rope_row, rope_col, rope_seq, need_ctx):
    (hq, hff, hfb, hi, hg, rq, rk, rv, rg, dq, dk, dv) = split_cols(h @ w_in)
    (hq_c, hff_c, hfb_c, hi_c, hg_c, rq_c, rk_c, rv_c, rg_c, dq_c, dk_c, dv_c) = split_cols(hc @ w_in)

    lb = lower_bound.astype(F32).reshape(HG_HEADS, HG_KDIM)

    def hg_gates(z):
        z = split_heads(z, HG_KDIM).astype(F32)
        logf = jnp.logaddexp(jnp.log(lb), jnp.log1p(-lb) + jax.nn.log_sigmoid(z))
        return (1.0 - lb) * jax.nn.sigmoid(-z), logf

    hq_h, hq_ch = split_heads(hq, HG_KDIM), split_heads(hq_c, HG_KDIM)
    hv, hv_c = split_heads(hi, HG_VDIM), split_heads(hi_c, HG_VDIM)
    kf, lff = hg_gates(hff)
    kf_c, lff_c = hg_gates(hff_c)
    kb, lfb = hg_gates(hfb)
    kb_c, lfb_c = hg_gates(hfb_c)
    hg_f, hg_fc = prefixed_scan(hq_h, kf, hv, lff, hq_ch, kf_c, hv_c, lff_c, need_ctx, False)
    hg_b, hg_bc = prefixed_scan(hq_h, kb, hv, lfb, hq_ch, kb_c, hv_c, lfb_c, need_ctx, True)
    out_a = gated_head_norm(hg_f + hg_b, hg_norm_w, hg)

    log_gamma = jnp.log1p(-jnp.exp2(-ret_dec.astype(F32)))

    def decay_like(t, direction):
        return jnp.broadcast_to(log_gamma[direction][:, None], t.shape)

    kscale = RET_KDIM ** -0.5
    r_q = apply_rope(split_heads(rq, RET_KDIM), *rope_seq)
    r_k = apply_rope(split_heads(rk, RET_KDIM), *rope_seq) * kscale
    r_v = split_heads(rv, RET_VDIM)
    r_qc = split_heads(rq_c, RET_KDIM)
    r_kc = split_heads(rk_c, RET_KDIM) * kscale
    r_vc = split_heads(rv_c, RET_VDIM)
    ret_f, ret_fc = prefixed_scan(r_q, r_k, r_v, decay_like(r_q, 0), r_qc, r_kc, r_vc, decay_like(r_qc, 0), need_ctx, False)
    ret_b, ret_bc = prefixed_scan(r_q, r_k, r_v, decay_like(r_q, 1), r_qc, r_kc, r_vc, decay_like(r_qc, 1), need_ctx, True)
    out_b = gated_head_norm(ret_f + ret_b, ret_norm_w, rg)

    lamv = da_lam.astype(F32)
    lam = jnp.exp(jnp.sum(lamv[0] * lamv[1])) - jnp.exp(jnp.sum(lamv[2] * lamv[3])) + lam_init
    d_q = apply_axial_rope(split_heads(dq, DA_HEAD_DIM), rope_row, rope_col)
    d_k = apply_axial_rope(split_heads(dk, DA_HEAD_DIM), rope_row, rope_col)
    d_v = split_heads(dv, DA_VDIM)
    d_qc, d_kc, d_vc = split_heads(dq_c, DA_HEAD_DIM), split_heads(dk_c, DA_HEAD_DIM), split_heads(dv_c, DA_VDIM)
    o_c = diff_attention(d_q, jnp.concatenate([d_kc, d_k], axis=1), jnp.concatenate([d_vc, d_v], axis=1), lam)
    out_c = (rms_norm(o_c, da_subln_w) * (1.0 - lam_init)).reshape(o_c.shape[:2] + (-1,))

    y = jnp.concatenate([out_a, out_b, out_c], axis=-1) @ w_out
    if not need_ctx:
        return y, None
    oc_c = diff_attention(d_qc, d_kc, d_vc, lam)
    yc = jnp.concatenate([gated_head_norm(hg_fc + hg_bc, hg_norm_w, hg_c), gated_head_norm(ret_fc + ret_bc, ret_norm_w, rg_c), (rms_norm(oc_c, da_subln_w) * (1.0 - lam_init)).reshape(oc_c.shape[:2] + (-1,))], axis=-1) @ w_out
    return y, yc


def clamped_swiglu(a):
    a_glu = jnp.minimum(a[..., ::2], SWIGLU_LIMIT)
    a_lin = jnp.clip(a[..., 1::2], -SWIGLU_LIMIT, SWIGLU_LIMIT)
    return a_glu * jax.nn.sigmoid(SWIGLU_ALPHA * a_glu) * (a_lin + 1.0)


def moe_ffn(h, router_w, router_b, w1, b1, w2, b2):
    N, D = h.shape
    logits = (h @ router_w + router_b).astype(F32)
    top_val, top_idx = lax.top_k(logits, TOP_K)
    gates = jax.nn.softmax(top_val, axis=-1)
    A = N * TOP_K
    flat_e = top_idx.reshape(A)
    order = jnp.argsort(flat_e)
    sorted_e = flat_e[order]
    counts = jnp.bincount(flat_e, length=N_EXPERTS)
    padded = (counts + EXPERT_BLOCK - 1) // EXPERT_BLOCK * EXPERT_BLOCK
    start = jnp.cumsum(counts) - counts
    pend = jnp.cumsum(padded)
    pstart = pend - padded
    dest = pstart[sorted_e] + jnp.arange(A) - start[sorted_e]
    n_blocks = -(-(A + N_EXPERTS * (EXPERT_BLOCK - 1)) // EXPERT_BLOCK)
    P = n_blocks * EXPERT_BLOCK
    slot = jnp.full((P,), A, dtype=jnp.int32).at[dest].set(order.astype(jnp.int32))
    tok = jnp.where(slot < A, slot // TOP_K, N)
    slot_gate = jnp.concatenate([gates.reshape(A), jnp.zeros((1,), F32)])[slot]
    block_expert = jnp.minimum(jnp.searchsorted(pend, jnp.arange(n_blocks) * EXPERT_BLOCK, side='right'), N_EXPERTS - 1)
    h_pad = jnp.concatenate([h, jnp.zeros((1, D), h.dtype)], axis=0)

    def run_block(args):
        tok_b, gate_b, e = args
        a = h_pad[tok_b] @ w1[e] + b1[e]
        y = clamped_swiglu(a) @ w2[e] + b2[e]
        return y * gate_b[:, None].astype(y.dtype)

    y = lax.map(run_block, (tok.reshape(n_blocks, EXPERT_BLOCK), slot_gate.reshape(n_blocks, EXPERT_BLOCK), block_expert))
    return jax.ops.segment_sum(y.reshape(P, D), tok, num_segments=N + 1)[:N]


def setup_inputs(seed: int = 0) -> dict:
    key = jax.random.key(seed)
    ks = jax.random.split(key, 24)
    D = D_MODEL

    def nrm(k, shape, s):
        return jax.random.normal(k, shape, F32) * s

    return {
        'x': nrm(ks[0], (BATCH, SEQ, D), 1.0),
        'c': nrm(ks[1], (BATCH, D), 1.0),
        'ctx': nrm(ks[2], (BATCH, CTX_LEN, D), 1.0),
        'c_ctx': nrm(ks[3], (D,), 1.0),
        'mod_w': nrm(ks[4], (DEPTH, D, 6 * D), 0.3 * D ** -0.5),
        'mod_b': nrm(ks[5], (DEPTH, 6 * D), 0.02),
        'norm_g': 1.0 + nrm(ks[6], (DEPTH, 4, D), 0.02),
        'w_in': nrm(ks[7], (DEPTH, D, IN_COLS), D ** -0.5),
        'hgrn_lb': nrm(ks[8], (DEPTH, HG_HEADS * HG_KDIM), 1.0),
        'hgrn_norm': 1.0 + nrm(ks[9], (DEPTH, HG_VDIM), 0.02),
        'ret_decay': 5.0 + jnp.arange(RET_HEADS, dtype=F32) + nrm(ks[10], (DEPTH, 2, RET_HEADS), 0.1),
        'ret_norm': 1.0 + nrm(ks[11], (DEPTH, RET_VDIM), 0.02),
        'da_lambda': nrm(ks[12], (DEPTH, 4, DA_HEAD_DIM), 0.1),
        'da_subln': 1.0 + nrm(ks[13], (DEPTH, DA_VDIM), 0.02),
        'w_out': nrm(ks[14], (DEPTH, MIX_WIDTH, D), MIX_WIDTH ** -0.5),
        'router_w': nrm(ks[15], (DEPTH, D, N_EXPERTS), D ** -0.5),
        'router_b': nrm(ks[16], (DEPTH, N_EXPERTS), 0.01),
        'w1': nrm(ks[17], (DEPTH, N_EXPERTS, D, 2 * D_FF), D ** -0.5),
        'b1': nrm(ks[18], (DEPTH, N_EXPERTS, 2 * D_FF), 0.02),
        'w2': nrm(ks[19], (DEPTH, N_EXPERTS, D_FF, D), D_FF ** -0.5),
        'b2': nrm(ks[20], (DEPTH, N_EXPERTS, D), 0.02),
    }


def reference(x, c, ctx, c_ctx, mod_w, mod_b, norm_g, w_in, hgrn_lb, hgrn_norm, ret_decay, ret_norm, da_lambda, da_subln, w_out, router_w, router_b, w1, b1, w2, b2):
    B, S, D = x.shape
    C = ctx.shape[1]
    rows = S // GRID_W
    pos = jnp.arange(rows * GRID_W)
    rope_row = rope_tables(pos // GRID_W, DA_HEAD_DIM // 2)
    rope_col = rope_tables(pos % GRID_W, DA_HEAD_DIM // 2)
    rope_seq = rope_tables(pos, RET_KDIM)
    lb_cum = jnp.cumsum(jax.nn.softmax(hgrn_lb.astype(F32), axis=0), axis=0)
    lower_bounds = lb_cum - lb_cum[0:1]
    xc = ctx
    for layer in range(DEPTH):
        need_ctx = layer < DEPTH - 1
        lam_init = 0.8 - 0.6 * math.exp(-0.3 * layer)
        sh1, sc1, g1, sh2, sc2, g2 = [m[:, None, :] for m in jnp.split(jax.nn.silu(c) @ mod_w[layer] + mod_b[layer], 6, axis=-1)]
        csh1, csc1, cg1, csh2, csc2, cg2 = jnp.split(jax.nn.silu(c_ctx) @ mod_w[layer] + mod_b[layer], 6, axis=-1)
        h = rms_norm(x, norm_g[layer, 0]) * (1.0 + sc1) + sh1
        hc = rms_norm(xc, norm_g[layer, 0]) * (1.0 + csc1) + csh1
        y, yc = token_mixer(h, hc, w_in[layer], w_out[layer], lower_bounds[layer], hgrn_norm[layer], ret_decay[layer], ret_norm[layer], da_lambda[layer], da_subln[layer], lam_init, rope_row, rope_col, rope_seq, need_ctx)
        x = x + g1 * rms_norm(y, norm_g[layer, 1])
        tokens = (rms_norm(x, norm_g[layer, 2]) * (1.0 + sc2) + sh2).reshape(B * S, D)
        if need_ctx:
            xc = xc + cg1 * rms_norm(yc, norm_g[layer, 1])
            tokens_c = (rms_norm(xc, norm_g[layer, 2]) * (1.0 + csc2) + csh2).reshape(B * C, D)
            tokens = jnp.concatenate([tokens, tokens_c], axis=0)
        f = moe_ffn(tokens, router_w[layer], router_b[layer], w1[layer], b1[layer], w2[layer], b2[layer])
        x = x + g2 * rms_norm(f[:B * S].reshape(B, S, D), norm_g[layer, 3])
        if need_ctx:
            xc = xc + cg2 * rms_norm(f[B * S:].reshape(B, C, D), norm_g[layer, 3])
    return x
```

```cpp
#include <hip/hip_runtime.h>
#include <cstdio>
#include <cstdint>
#include <cmath>

#ifndef DBG_MASK
#define DBG_MASK 0xf800
#endif
#ifndef PHMASK
#define PHMASK 0xfff
#endif
#define PHON(k) ((PHMASK >> (k)) & 1)
#ifndef REPMASK
#define REPMASK 0
#endif
#define NREP(k) (1 + ((REPMASK >> (k)) & 1))
#ifndef ATTVAR
#define ATTVAR -1
#endif
#ifndef MK_ONE_LAUNCH
#define MK_ONE_LAUNCH 1
#endif

#define LAS __attribute__((address_space(3)))
#define GAS __attribute__((address_space(1)))
typedef unsigned short bf16_t;
typedef short bf16x8 __attribute__((ext_vector_type(8)));
typedef short s16x4 __attribute__((ext_vector_type(4)));
typedef float f32x2 __attribute__((ext_vector_type(2)));
typedef float f32x4 __attribute__((ext_vector_type(4)));
typedef float f32x16 __attribute__((ext_vector_type(16)));
typedef unsigned u32x2 __attribute__((ext_vector_type(2)));
typedef unsigned u32x4 __attribute__((ext_vector_type(4)));
typedef GAS unsigned gu32;
typedef int v4i __attribute__((ext_vector_type(4)));
typedef int v8i __attribute__((ext_vector_type(8)));

constexpr int NB = 2, T = 16384, CL = 256, D = 1024;
constexpr int NLAT = NB * T, NCTX = NB * CL, NROW = NLAT + NCTX;
constexpr int NE = 32, CAP = NROW;
constexpr int NIN = 4352;
constexpr int NSEQ = 48, NSC = 65;
constexpr int KT_TILES = 260;
constexpr float EPS = 1e-6f;
constexpr float LOG2E = 1.4426950408889634f;
constexpr int NWAVES = 8, NTHR = 512;

constexpr size_t MiB = 1u << 20;
constexpr size_t WS_CTL = 0, CTL_ZERO_BYTES = 64 * 1024;
constexpr size_t WS_MODV = 1 * MiB;
constexpr size_t WS_TAB = 1 * MiB + 256 * 1024;
constexpr size_t WS_RWT = 1 * MiB + 512 * 1024;
constexpr size_t WS_ROPE = 2 * MiB;
constexpr size_t WS_WIN = 6 * MiB;
constexpr size_t WS_WOUT = 23 * MiB;
constexpr size_t WS_W1 = 27 * MiB;
constexpr size_t WS_W2 = 283 * MiB;
constexpr size_t WS_X1 = 411 * MiB;
constexpr size_t WS_H = 541 * MiB;
constexpr size_t WS_SCAN = 606 * MiB;
constexpr size_t SCAN_PITCH = 25 * MiB;
constexpr size_t WS_QA = 831 * MiB;
constexpr size_t WS_QC = 847 * MiB;
constexpr size_t WS_KA = 848 * MiB;
constexpr size_t WS_VA = 865 * MiB;
constexpr size_t WS_SLOC = 882 * MiB;
constexpr size_t WS_SIN = 931 * MiB;
constexpr size_t WS_DEC = 980 * MiB;
constexpr size_t WS_OSCR = 981 * MiB;
constexpr size_t WS_MIX = 1079 * MiB;
constexpr size_t WS_Y = 1144 * MiB;
constexpr size_t WS_SLOT = 1274 * MiB;
constexpr size_t WS_GATE = 1279 * MiB;
constexpr size_t WS_ACT = 1280 * MiB;
constexpr size_t WS_YK = 1540 * MiB;
constexpr size_t WS_TOK8 = 1816 * MiB;
constexpr size_t WS_SGATE = 1850 * MiB;
constexpr size_t WS_END = 1856 * MiB;
enum { SC_KF = 0, SC_KB = 1, SC_RQ = 2, SC_RK = 3, SC_HQ = 4, SC_HV = 5, SC_HG = 6, SC_RV = 7, SC_RG = 8 };
constexpr int CW_TMO = 0, CW_BAR = 4096, CW_CNT = 8192;
constexpr int TB_LBT = 0;
constexpr int TB_LAM = 1024;
constexpr int TB_GAM = 1040;
constexpr int TB_AXR = 2048;
constexpr int TB_AXC = 2048 + 4096;

constexpr int LDS_BYTES = 147456;
constexpr int LDS_MISC = 131072 + 12288;
constexpr int LDS_TAB = 131072;

__device__ __forceinline__ unsigned f2bf(float f) { unsigned u = __builtin_bit_cast(unsigned, f); return (u + 0x7fffu + ((u >> 16) & 1u)) >> 16; }
__device__ __forceinline__ unsigned pk2(float lo, float hi) { return f2bf(lo) | (f2bf(hi) << 16); }
__device__ __forceinline__ float bf2f(unsigned short b) { return __builtin_bit_cast(float, (unsigned)b << 16); }
__device__ __forceinline__ float bflo(unsigned w) { return __builtin_bit_cast(float, w << 16); }
__device__ __forceinline__ float bfhi(unsigned w) { return __builtin_bit_cast(float, w & 0xffff0000u); }
typedef __bf16 bf16x2_t __attribute__((ext_vector_type(2)));
__device__ __forceinline__ unsigned trunc_pk_bf16(float lo, float hi) { return __builtin_amdgcn_perm(__builtin_bit_cast(unsigned, hi), __builtin_bit_cast(unsigned, lo), 0x07060302u); }
__device__ __forceinline__ unsigned cvt_pk_bf16(float lo, float hi) { const f32x2 v = {lo, hi}; const bf16x2_t b = __builtin_convertvector(v, bf16x2_t); return __builtin_bit_cast(unsigned, b); }
__device__ __forceinline__ float wave_sum_dpp(float v) {
#define DPP_ADD(ctrl, rmask) v += __builtin_bit_cast(float, __builtin_amdgcn_update_dpp(0, __builtin_bit_cast(int, v), ctrl, rmask, 0xF, false))
    DPP_ADD(0xB1, 0xF); DPP_ADD(0x4E, 0xF); DPP_ADD(0x141, 0xF); DPP_ADD(0x140, 0xF); DPP_ADD(0x142, 0xA); DPP_ADD(0x143, 0xC);
#undef DPP_ADD
    return __builtin_bit_cast(float, __builtin_amdgcn_readlane(__builtin_bit_cast(int, v), 63));
}
__device__ __forceinline__ float wave_sum(float v) { return wave_sum_dpp(v); }
template <int M> __device__ __forceinline__ float xor_swz(float v) { return __builtin_bit_cast(float, __builtin_amdgcn_ds_swizzle(__builtin_bit_cast(int, v), 0x1F | (M << 10))); }
__device__ __forceinline__ float xor32(float v, int lane) { return __builtin_bit_cast(float, __builtin_amdgcn_ds_bpermute((lane ^ 32) << 2, __builtin_bit_cast(int, v))); }
__device__ __forceinline__ float rdlane(float v, int l) { return __builtin_bit_cast(float, __builtin_amdgcn_readlane(__builtin_bit_cast(int, v), l)); }
__device__ __forceinline__ float sigmoidf_(float x) { return __builtin_amdgcn_rcpf(1.f + __builtin_amdgcn_exp2f(-LOG2E * x)); }
#define PHASE_IDS_W(WV) int lane; asm volatile("v_mbcnt_lo_u32_b32 %0, -1, 0\n\tv_mbcnt_hi_u32_b32 %0, -1, %0" : "=v"(lane)); int wave = (WV); asm volatile("" : "+s"(wave)); const int tid = wave * 64 + lane; (void)tid
#define PHASE_IDS() PHASE_IDS_W(F.wave); int blk_ = F.blk; asm volatile("" : "+s"(blk_))
__device__ __forceinline__ unsigned pk4_fp8(float a, float b, float c, float d) { int w = 0; w = __builtin_amdgcn_cvt_pk_fp8_f32(a, b, w, false); w = __builtin_amdgcn_cvt_pk_fp8_f32(c, d, w, true); return (unsigned)w; }
constexpr float W8_MUL = 64.f;
constexpr int SCALE_W8 = 0x79797979, SCALE_A8 = 0x7F7F7F7F;
#define LDS_WAIT() asm volatile("s_waitcnt lgkmcnt(0)" ::: "memory")
#define VM_WAIT() asm volatile("s_waitcnt vmcnt(0)" ::: "memory")

#define XB_TMO      128
#define XB_XCNT(j)  (256  + 64 * (j))
#define XB_XSUB(j)  (1280 + 64 * (j))
#define XB_XGEN(j)  (2304 + 64 * (j))
#define XB_TOP      3328
#define XB_TOPGEN   3392
#define XCD_BAR_WORDS 3456
#define XB_SPIN_CAP (1u << 22)
__device__ __forceinline__ unsigned xb_ld(unsigned* p)              { return __hip_atomic_load(p, __ATOMIC_RELAXED, __HIP_MEMORY_SCOPE_AGENT); }
__device__ __forceinline__ unsigned xb_add(unsigned* p, unsigned v) { return __hip_atomic_fetch_add(p, v, __ATOMIC_RELAXED, __HIP_MEMORY_SCOPE_AGENT); }
__device__ __forceinline__ unsigned xb_xcc_id() { return (unsigned)__builtin_amdgcn_s_getreg((3 << 11) | 20) & 0xFu; }
#define XB_SPIN(cond, bar) do { unsigned _sp = 0; while (cond) { __builtin_amdgcn_s_sleep(1); \
    if ((++_sp & 255u) == 0u) { if (xb_ld(&(bar)[XB_TMO])) break; if (_sp > XB_SPIN_CAP) { atomicAdd(&(bar)[XB_TMO], 1u); break; } } } } while (0)
struct XcdBarrier { unsigned* bar; unsigned x; volatile LAS unsigned* st; };
__device__ __forceinline__ XcdBarrier xcd_barrier_post(unsigned* bar, volatile LAS unsigned* st) {
    XcdBarrier b; b.bar = bar; b.x = xb_xcc_id(); b.st = st;
    if (threadIdx.x == 0) (void)xb_add(&bar[XB_XCNT(b.x)], 1u);
    return b;
}
__device__ __forceinline__ void xcd_barrier_complete(unsigned* bar, unsigned x, unsigned& nloc, unsigned& nx) {
    const unsigned G = gridDim.x * gridDim.y * gridDim.z;
    unsigned sum, cnt, mine, sp = 0u;
    for (;;) {
        sum = 0u; cnt = 0u; mine = 0u;
#pragma unroll
        for (unsigned j = 0; j < 16; ++j) { const unsigned c = xb_ld(&bar[XB_XCNT(j)]); sum += c; cnt += (c > 0u) ? 1u : 0u; mine = (j == x) ? c : mine; }
        if (sum == G) break;
        __builtin_amdgcn_s_sleep(1);
        if ((++sp & 255u) == 0u) { if (xb_ld(&bar[XB_TMO])) break; if (sp > XB_SPIN_CAP) { atomicAdd(&bar[XB_TMO], 1u); break; } }
    }
    nloc = mine > 0u ? mine : 1u; nx = cnt > 0u ? cnt : 1u;
}
__device__ __forceinline__ void xcd_barrier_census(const XcdBarrier& b) {
    unsigned nloc, nx; xcd_barrier_complete(b.bar, b.x, nloc, nx); b.st[0] = nloc; b.st[1] = nx;
}
__device__ __forceinline__ void xcd_barrier(const XcdBarrier& b) {
    asm volatile("s_waitcnt vmcnt(0)" ::: "memory");
    __syncthreads();
    if (threadIdx.x == 0) {
        unsigned* bar = b.bar;
        __builtin_amdgcn_s_waitcnt(0);
        const unsigned nloc = b.st[0], nx = b.st[1];
        const unsigned old = xb_add(&bar[XB_XSUB(b.x)], 1u);
        const unsigned gen = old / nloc;
        if (old + 1u == (gen + 1u) * nloc) {
            __builtin_amdgcn_fence(__ATOMIC_RELEASE, "agent");
            asm volatile("s_waitcnt vmcnt(0)" ::: "memory");
            const unsigned og = xb_add(&bar[XB_TOP], 1u);
            const unsigned tg = og / nx;
            if (og + 1u == (tg + 1u) * nx) xb_add(&bar[XB_TOPGEN], 1u);
            else XB_SPIN(xb_ld(&bar[XB_TOPGEN]) == tg, bar);
            __builtin_amdgcn_fence(__ATOMIC_ACQUIRE, "agent");
            xb_add(&bar[XB_XGEN(b.x)], 1u);
            asm volatile("s_waitcnt vmcnt(0)" ::: "memory");
        } else {
            XB_SPIN(xb_ld(&bar[XB_XGEN(b.x)]) == gen, bar);
            __builtin_amdgcn_fence(__ATOMIC_ACQUIRE, "agent");
            asm volatile("s_waitcnt vmcnt(0)" ::: "memory");
        }
    }
    __syncthreads();
}

struct Frame {
    LAS unsigned char* lds;
    unsigned char* ws;
    const float* in[21];
    float* out;
    gu32* ctl;
    int tid, lane, wave, G, blk;
};

__device__ __forceinline__ void glds16(const void* sbase, unsigned voff, unsigned lds_dst) { unsigned keep;
    asm volatile("s_mov_b32 %0, m0\n\ts_mov_b32 m0, %3\n\ts_nop 0\n\tglobal_load_lds_dwordx4 %1, %2\n\ts_mov_b32 m0, %0" : "=&s"(keep) : "v"(voff), "s"(sbase), "s"(lds_dst) : "memory"); }

namespace pg8 {
constexpr int BM = 256, BK = 64, HALF = 128, HTB = HALF * BK * 2, STAGE_BYTES = 8 * HTB, NXCD = 8, WGM = 8, K = 1024;
__host__ __device__ __forceinline__ int lds_byte(int r, int c) { const int st = (r >> 4) * 2 + (c >> 5), rr = r & 15, cc = c & 31, ob = rr * 64 + cc * 2; return st * 1024 + (ob ^ (((ob >> 9) & 1) << 5)); }
__host__ __device__ __forceinline__ void stage_rc(int b, int& R, int& C) { const int st = b / 1024, sb = b % 1024, swz = sb ^ (((sb >> 9) & 1) << 5); R = (st >> 1) * 16 + swz / 64; C = (st & 1) * 32 + (swz % 64) / 2; }
__host__ __device__ __forceinline__ int perm32(int rho) { const int n = rho >> 4, i = rho & 15; return 8 * (i >> 2) + 4 * n + (i & 3); }
struct Unit { int pm, pn, e, nvalid, sbase; };
template <class Epi, class Sched, bool GATHER, bool FP8 = false>
__device__ __forceinline__ void gemm_phase(LAS unsigned char* lds, int wave_id, const Sched& S, const Epi& E) {
    constexpr int KB = FP8 ? 1024 : 2048, NT = KB / 128;
    PHASE_IDS_W(wave_id); const int wid = wave, wr = wid >> 2, wc = wid & 3, fr = lane & 15, fq = lane >> 4;
    unsigned voffB[2], vA[2][2]; int R0, C0;
    { int R, C; stage_rc(tid * 16, R, C); R0 = R; C0 = C;
#pragma unroll
      for (int i = 0; i < 2; ++i) { const int Ri = R + 64 * i; const int Rb = Epi::PERM ? ((Ri & ~31) + perm32(Ri & 31)) : Ri; voffB[i] = (unsigned)(Rb * KB + C * 2);
#pragma unroll
          for (int h = 0; h < 2; ++h) vA[h][i] = (unsigned)((Ri + 128 * h) * KB + C * 2); } }
    const size_t kstep = (size_t)(BK * 2);
    const size_t hstep = (size_t)HALF * KB;
    const unsigned ldsw = (unsigned)wid * 1024u, lds0 = (unsigned)(uintptr_t)lds;
    const int aoff = lds_byte(wr * 64 + fr, fq * 8), boff = lds_byte(wc * 32 + fr, fq * 8);
#define PG8_SA(b, h) (((b) * 2 + (h)) * HTB)
#define PG8_SB(b, h) ((4 + (b) * 2 + (h)) * HTB)
#define PG8_STAGE(bufoff, gbase, voff) do { _Pragma("unroll") for (int _i = 0; _i < 2; ++_i) \
        glds16((const void*)(gbase), (voff)[_i], (unsigned)__builtin_amdgcn_readfirstlane(lds0 + (unsigned)(bufoff) + ldsw + _i * 8192)); } while (0)
#define PG8_LDA(dst, b, h) do { _Pragma("unroll") for (int m = 0; m < 4; ++m) { dst[m].lo = *(const LAS v4i*)(lds + PG8_SA(b, h) + aoff + m * 2048); dst[m].hi = *(const LAS v4i*)(lds + PG8_SA(b, h) + aoff + m * 2048 + 1024); } } while (0)
#define PG8_LDB(dst, b, h) do { _Pragma("unroll") for (int n = 0; n < 2; ++n) { dst[n].lo = *(const LAS v4i*)(lds + PG8_SB(b, h) + boff + n * 2048); dst[n].hi = *(const LAS v4i*)(lds + PG8_SB(b, h) + boff + n * 2048 + 1024); } } while (0)
#define PG8_MMA(ai, bj, At, Bt) do { __builtin_amdgcn_s_setprio(1); _Pragma("unroll") for (int m = 0; m < 4; ++m) _Pragma("unroll") for (int n = 0; n < 2; ++n) { \
        if constexpr (FP8) acc[ai][bj][m][n] = __builtin_amdgcn_mfma_scale_f32_16x16x128_f8f6f4(Bt[n], At[m], acc[ai][bj][m][n], 0, 0, 0, SCALE_W8, 0, SCALE_A8); \
        else { acc[ai][bj][m][n] = __builtin_amdgcn_mfma_f32_16x16x32_bf16(__builtin_bit_cast(bf16x8, (v4i)Bt[n].lo), __builtin_bit_cast(bf16x8, (v4i)At[m].lo), acc[ai][bj][m][n], 0, 0, 0); \
               acc[ai][bj][m][n] = __builtin_amdgcn_mfma_f32_16x16x32_bf16(__builtin_bit_cast(bf16x8, (v4i)Bt[n].hi), __builtin_bit_cast(bf16x8, (v4i)At[m].hi), acc[ai][bj][m][n], 0, 0, 0); } } \
        __builtin_amdgcn_s_setprio(0); } while (0)
#define PG8_WAIT_V(n) asm volatile("s_waitcnt vmcnt(" #n ")" ::: "memory")
#define PG8_WAIT_L(n) asm volatile("s_waitcnt lgkmcnt(" #n ")" ::: "memory")
#define PG8_BAR __builtin_amdgcn_s_barrier()
#define PG8_SCHED __builtin_amdgcn_sched_barrier(0)
    Unit cur, nxt; int ui = 0;
    if (!S.next(0, cur)) return;
    f32x4 acc[2][2][4][2];
#pragma unroll
    for (int a = 0; a < 2; ++a)
#pragma unroll
        for (int b = 0; b < 2; ++b)
#pragma unroll
            for (int m = 0; m < 4; ++m)
#pragma unroll
                for (int n = 0; n < 2; ++n) acc[a][b][m][n] = (f32x4){0.f, 0.f, 0.f, 0.f};
    v8i At[4], B0[2], B1[2];
    const char* cA = S.a_ptr(cur); const char* cB = S.b_ptr(cur);
    unsigned nvA[2][2];
    if constexpr (GATHER) S.a_off(cur, R0, C0, vA);
    PG8_STAGE(PG8_SB(0, 0), cB, voffB); PG8_STAGE(PG8_SB(0, 1), cB + hstep, voffB); PG8_STAGE(PG8_SA(0, 0), cA, vA[0]); PG8_STAGE(PG8_SA(0, 1), cA, vA[1]);
    if (wr == 1) PG8_BAR;
    PG8_WAIT_V(2); PG8_BAR;
    PG8_STAGE(PG8_SB(1, 0), cB + kstep, voffB); PG8_STAGE(PG8_SA(1, 0), cA + kstep, vA[0]); PG8_STAGE(PG8_SB(1, 1), cB + hstep + kstep, voffB);
    PG8_WAIT_V(6); PG8_BAR;
    for (;;) {
        const bool has_next = S.next(ui + 1, nxt);
        const char* nA = has_next ? S.a_ptr(nxt) : cA; const char* nB = has_next ? S.b_ptr(nxt) : cB;
        if constexpr (GATHER) { if (has_next) S.a_off(nxt, R0, C0, nvA); }
#pragma unroll 1
        for (int t = 0; t < NT; t += 2) {
            const bool last = (t == NT - 2);
            const char* a1 = cA + (size_t)(t + 1) * kstep;
            const char* a2 = last ? nA : cA + (size_t)(t + 2) * kstep; const char* b2 = last ? nB : cB + (size_t)(t + 2) * kstep;
            const char* a3 = a2 + kstep; const char* b3 = b2 + kstep;
            PG8_LDB(B0, 0, 0); PG8_LDB(B1, 0, 1); PG8_SCHED; PG8_LDA(At, 0, 0); PG8_STAGE(PG8_SA(1, 1), a1, vA[1]);
            if constexpr (GATHER) { if (last && has_next) {
#pragma unroll
                for (int h = 0; h < 2; ++h)
#pragma unroll
                    for (int i = 0; i < 2; ++i) vA[h][i] = nvA[h][i]; } }
            PG8_WAIT_V(8); PG8_WAIT_L(0); PG8_BAR; PG8_MMA(0, 0, At, B0); PG8_MMA(0, 1, At, B1); PG8_BAR; PG8_SCHED;
            PG8_LDA(At, 0, 1); PG8_STAGE(PG8_SB(0, 0), b2, voffB); PG8_STAGE(PG8_SB(0, 1), b2 + hstep, voffB); PG8_STAGE(PG8_SA(0, 0), a2, vA[0]);
            PG8_WAIT_V(8); PG8_WAIT_L(0); PG8_BAR; PG8_MMA(1, 0, At, B0); PG8_MMA(1, 1, At, B1); PG8_BAR; PG8_SCHED;
            PG8_LDB(B0, 1, 0); PG8_LDB(B1, 1, 1); PG8_SCHED; PG8_LDA(At, 1, 0); PG8_STAGE(PG8_SA(0, 1), a2, vA[1]);
            PG8_WAIT_V(8); PG8_WAIT_L(0); PG8_BAR; PG8_MMA(0, 0, At, B0); PG8_MMA(0, 1, At, B1); PG8_BAR; PG8_SCHED;
            PG8_LDA(At, 1, 1); PG8_STAGE(PG8_SB(1, 0), b3, voffB); PG8_STAGE(PG8_SB(1, 1), b3 + hstep, voffB); PG8_STAGE(PG8_SA(1, 0), a3, vA[0]);
            PG8_WAIT_V(8); PG8_WAIT_L(0); PG8_BAR; PG8_MMA(1, 0, At, B0); PG8_MMA(1, 1, At, B1); PG8_BAR; PG8_SCHED;
        }
        if (wr == 0) PG8_BAR;
        { int le; asm volatile("v_mbcnt_lo_u32_b32 %0, -1, 0\n\tv_mbcnt_hi_u32_b32 %0, -1, %0" : "=v"(le)); E(acc, cur, wr, wc, le & 15, le >> 4); }
        if (!has_next) break;
#pragma unroll
        for (int a = 0; a < 2; ++a)
#pragma unroll
            for (int b = 0; b < 2; ++b)
#pragma unroll
                for (int m = 0; m < 4; ++m)
#pragma unroll
                    for (int n = 0; n < 2; ++n) acc[a][b][m][n] = (f32x4){0.f, 0.f, 0.f, 0.f};
        cur = nxt; cA = nA; cB = nB; ++ui;
        if (wr == 1) PG8_BAR;
    }
    PG8_WAIT_V(0);
    PG8_BAR;
#undef PG8_SA
#undef PG8_SB
#undef PG8_STAGE
#undef PG8_LDA
#undef PG8_LDB
#undef PG8_MMA
#undef PG8_WAIT_V
#undef PG8_WAIT_L
#undef PG8_BAR
#undef PG8_SCHED
}

struct DenseSched {
    const char* A; const char* Bt; int nM, nN, nwg, G, c;
    __device__ __forceinline__ void init(const void* A_, const void* Bt_, int M, int N, int G_, int c_) { A = (const char*)A_; Bt = (const char*)Bt_; nM = M / BM; nN = N / BM; nwg = nM * nN; G = G_; c = c_; }
    __device__ __forceinline__ bool next(int i, Unit& u) const {
        const long L = (long)i * G + c; if (L >= nwg) return false;
        int wgid = (int)L; { const int q = nwg / NXCD, r = nwg % NXCD, xcd = wgid % NXCD, off = wgid / NXCD; wgid = (xcd < r ? xcd * (q + 1) : r * (q + 1) + (xcd - r) * q) + off; }
        const int nig = WGM * nN, gid = wgid / nig, fm = gid * WGM, gsz = (nM - fm) < WGM ? (nM - fm) : WGM;
        u.pm = fm + ((wgid % nig) % gsz); u.pn = (wgid % nig) / gsz; u.e = 0; u.nvalid = 256; u.sbase = 0; return true;
    }
    __device__ __forceinline__ const char* a_ptr(const Unit& u) const { return A + (size_t)u.pm * (BM * K * 2); }
    __device__ __forceinline__ const char* b_ptr(const Unit& u) const { return Bt + (size_t)u.pn * (BM * K * 2); }
    __device__ __forceinline__ void a_off(const Unit&, int, int, unsigned (&)[2][2]) const {}
};
template <int NPN, bool GATHER_A, int KB> struct MoeSched {
    const char* A; const char* Bt; const int* slot; const LAS int* tab; int G, c; size_t bstride;
    __device__ __forceinline__ bool next(int i, Unit& u) const {
        const int ntile = __builtin_amdgcn_readfirstlane(tab[32]);
        int mtg;
        if ((G & 7) == 0) { const int x = c & 7, j = (c >> 3) + (G >> 3) * i; u.pn = j % NPN; mtg = (j / NPN) * 8 + x; if (mtg >= ntile) return false; }
        else { const int lin = i * G + c; if (lin >= ntile * NPN) return false; u.pn = lin % NPN; mtg = lin / NPN; }
        int e = 0;
        while (e < 31 && __builtin_amdgcn_readfirstlane(tab[e + 1]) <= mtg) ++e;
        const int mtl = mtg - __builtin_amdgcn_readfirstlane(tab[e]); int nv = __builtin_amdgcn_readfirstlane(tab[33 + e]) - 256 * mtl; nv = nv > 256 ? 256 : nv;
        u.pm = mtg; u.e = e; u.nvalid = nv; u.sbase = e * CAP + 256 * mtl; return true;
    }
    __device__ __forceinline__ const char* a_ptr(const Unit& u) const { return GATHER_A ? A : A + (size_t)u.pm * (BM * KB); }
    __device__ __forceinline__ const char* b_ptr(const Unit& u) const { return Bt + (size_t)u.e * bstride + (size_t)u.pn * (BM * KB); }
    __device__ __forceinline__ void a_off(const Unit& u, int R0, int C0, unsigned (&v)[2][2]) const {
#pragma unroll
        for (int h = 0; h < 2; ++h)
#pragma unroll
            for (int i = 0; i < 2; ++i) { const int rl = h * 128 + R0 + 64 * i; const int id = (rl < u.nvalid) ? slot[u.sbase + rl] : 0; v[h][i] = (unsigned)(id >> 2) * (unsigned)KB + (unsigned)C0 * 2u; }
    }
};
}

struct EpiInProj {
    static constexpr bool PERM = true;
    unsigned char* ws; const float* tab; const float* rope; int layer;
    template <int TYPE> __device__ __forceinline__ void run(const f32x4 (&acc)[2][2][4][2], const pg8::Unit& u, int wr, int wc, int fr, int fq) const {
        asm volatile("" : "+v"(fr), "+v"(fq));
        const int pn = u.pn, pm = u.pm; const bool ctx = pm >= 128;
        const int bb = ctx ? (pm - 128) : (pm >> 6);
#pragma unroll
        for (int ai = 0; ai < 2; ++ai)
#pragma unroll
            for (int m = 0; m < 4; ++m) {
                const int rl = 128 * ai + 64 * wr + 16 * m + fr; const int row = pm * 256 + rl;
                const int tt = ctx ? rl : (row & (T - 1));
                const int Lk = ctx ? tt : 256 + tt; const int ktile = Lk >> 6, krr = Lk & 63;
#pragma unroll
                for (int bj = 0; bj < 2; ++bj) {
                    const int np = 256 * pn + 128 * bj + 32 * wc + 8 * fq;
                    f32x4 v0 = acc[ai][bj][m][0], v1 = acc[ai][bj][m][1];
                    bf16_t* dst;
                    if (TYPE == 0) {
                        const int dir = np >= 384, col = np - 384 * dir;
                        const f32x4 l0 = *(const f32x4*)(tab + TB_LBT + layer * 384 + col), l1 = *(const f32x4*)(tab + TB_LBT + layer * 384 + col + 4);
#pragma unroll
                        for (int q = 0; q < 4; ++q) { v0[q] = (1.f - l0[q]) * sigmoidf_(-v0[q]); v1[q] = (1.f - l1[q]) * sigmoidf_(-v1[q]); }
                        dst = (bf16_t*)(ws + WS_SCAN + (size_t)(dir ? SC_KB : SC_KF) * SCAN_PITCH) + (size_t)row * 384 + col;
                    } else if (TYPE == 1 || TYPE == 2) {
                        f32x4 cs = (f32x4){1.f, 1.f, 1.f, 1.f}, sn = (f32x4){0.f, 0.f, 0.f, 0.f}; float sc;
                        if (TYPE == 1) {
                            const int m2 = np - 768; const int isk = m2 >= 384, col = m2 - 384 * isk; const int w0 = col & 63;
                            if (!ctx) { cs = *(const f32x4*)(rope + (size_t)tt * 32 + (w0 >> 1)); sn = *(const f32x4*)(rope + (size_t)T * 32 + (size_t)tt * 32 + (w0 >> 1)); }
                            sc = isk ? 0.125f : 1.f;
                            dst = (bf16_t*)(ws + WS_SCAN + (size_t)(isk ? SC_RK : SC_RQ) * SCAN_PITCH) + (size_t)row * 384 + col;
                        } else {
                            const int m3 = np - 1536; const int isk = m3 >= 256, col = m3 - 256 * isk; const int map = col >> 5, w0 = col & 31;
                            if (!ctx) { const float* tb = (w0 < 16) ? (tab + TB_AXR + (tt >> 6) * 8 + (w0 >> 1)) : (tab + TB_AXC + (tt & 63) * 8 + ((w0 - 16) >> 1));
                                        const int so = (w0 < 16) ? 2048 : 512; cs = *(const f32x4*)tb; sn = *(const f32x4*)(tb + so); }
                            sc = isk ? 1.f : 0.17677669529663687f * LOG2E;
                            if (isk) dst = (bf16_t*)(ws + WS_KA) + ((size_t)((bb * 8 + map) * KT_TILES + ktile) * 4 + (w0 >> 3)) * 512 + krr * 8;
                            else if (ctx) dst = (bf16_t*)(ws + WS_QC) + ((size_t)(bb * 8 + map) * CL + tt) * 32 + w0;
                            else dst = (bf16_t*)(ws + WS_QA) + ((size_t)(bb * 8 + map) * T + tt) * 32 + w0;
                        }
                        f32x4 o0, o1;
                        o0[0] = (v0[0] * cs[0] - v0[1] * sn[0]) * sc; o0[1] = (v0[1] * cs[0] + v0[0] * sn[0]) * sc;
                        o0[2] = (v0[2] * cs[1] - v0[3] * sn[1]) * sc; o0[3] = (v0[3] * cs[1] + v0[2] * sn[1]) * sc;
                        o1[0] = (v1[0] * cs[2] - v1[1] * sn[2]) * sc; o1[1] = (v1[1] * cs[2] + v1[0] * sn[2]) * sc;
                        o1[2] = (v1[2] * cs[3] - v1[3] * sn[3]) * sc; o1[3] = (v1[3] * cs[3] + v1[2] * sn[3]) * sc;
                        v0 = o0; v1 = o1;
                    } else {
                        const int m4 = np - 2048; const int seg = m4 / 384, col = m4 - 384 * seg;
                        if (m4 >= 2176) continue;
                        if (seg < 5) dst = (bf16_t*)(ws + WS_SCAN + (size_t)(SC_HQ + seg) * SCAN_PITCH) + (size_t)row * 384 + col;
                        else { const int h4 = col >> 6, w0 = col & 63;
                               const int k5 = krr & 31; unsigned char* vb = ws + WS_VA + (size_t)((bb * 4 + h4) * KT_TILES + ktile) * 4096 + (krr >> 5) * 2048 + (w0 >> 5) * 1024 + ((k5 >> 2) & 1) * 512 + (w0 & 31) * 16 + (k5 & 3) + 4 * (k5 >> 3);
                               const unsigned wa = pk4_fp8(v0[0] * 16.f, v0[1] * 16.f, v0[2] * 16.f, v0[3] * 16.f), wb = pk4_fp8(v1[0] * 16.f, v1[1] * 16.f, v1[2] * 16.f, v1[3] * 16.f);
#pragma unroll
                               for (int i = 0; i < 4; ++i) { vb[16 * i] = (unsigned char)(wa >> (8 * i)); vb[64 + 16 * i] = (unsigned char)(wb >> (8 * i)); }
                               continue; }
                    }
                    u32x4 w; w.x = cvt_pk_bf16(v0[0], v0[1]); w.y = cvt_pk_bf16(v0[2], v0[3]); w.z = cvt_pk_bf16(v1[0], v1[1]); w.w = cvt_pk_bf16(v1[2], v1[3]);
                    *(u32x4*)dst = w;
                }
                if (m == 3) asm volatile("" ::: "memory");
            }
    }
    __device__ __forceinline__ void operator()(const f32x4 (&acc)[2][2][4][2], const pg8::Unit& u, int wr, int wc, int fr, int fq) const {
        if (u.pn < 3) run<0>(acc, u, wr, wc, fr, fq); else if (u.pn < 6) run<1>(acc, u, wr, wc, fr, fq); else if (u.pn < 8) run<2>(acc, u, wr, wc, fr, fq); else run<3>(acc, u, wr, wc, fr, fq);
    }
};
struct EpiBf16Out {
    static constexpr bool PERM = true;
    bf16_t* C;
    __device__ __forceinline__ void operator()(const f32x4 (&acc)[2][2][4][2], const pg8::Unit& u, int wr, int wc, int fr, int fq) const {
        asm volatile("" : "+v"(fr), "+v"(fq));
        const int row0 = u.pm * 256 + wr * 64 + fr, col0 = u.pn * 256 + wc * 32 + 8 * fq;
#pragma unroll
        for (int ai = 0; ai < 2; ++ai)
#pragma unroll
            for (int m = 0; m < 4; ++m) { bf16_t* rowp = C + (size_t)(row0 + ai * 128 + m * 16) * D + col0;
#pragma unroll
                for (int bj = 0; bj < 2; ++bj) { const f32x4 v0 = acc[ai][bj][m][0], v1 = acc[ai][bj][m][1];
                    u32x4 w; w.x = cvt_pk_bf16(v0[0], v0[1]); w.y = cvt_pk_bf16(v0[2], v0[3]); w.z = cvt_pk_bf16(v1[0], v1[1]); w.w = cvt_pk_bf16(v1[2], v1[3]);
                    *(u32x4*)(rowp + bj * 128) = w; } }
    }
};
struct EpiSwiglu {
    static constexpr bool PERM = true;
    unsigned char* act; const float* b1;
    __device__ __forceinline__ void operator()(const f32x4 (&acc)[2][2][4][2], const pg8::Unit& u, int wr, int wc, int fr, int fq) const {
        asm volatile("" : "+v"(fr), "+v"(fq));
        const int j0 = 128 * u.pn + 32 * wc + 8 * fq;
        const float* bp = b1 + (size_t)u.e * 2048 + 2 * j0;
        f32x4 bq[4];
#pragma unroll
        for (int q = 0; q < 4; ++q) bq[q] = *(const f32x4*)(bp + 4 * q);
#pragma unroll
        for (int ai = 0; ai < 2; ++ai)
#pragma unroll
            for (int m = 0; m < 4; ++m) {
                const int rl = 128 * ai + 64 * wr + 16 * m + fr;
                float o[8];
#pragma unroll
                for (int n = 0; n < 2; ++n)
#pragma unroll
                    for (int q = 0; q < 4; ++q) { const int j = 4 * n + q;
                        float g = acc[ai][0][m][n][q] + bq[j >> 1][(j & 1) * 2], l = acc[ai][1][m][n][q] + bq[j >> 1][(j & 1) * 2 + 1];
                        g = fminf(g, 7.f); l = fminf(fmaxf(l, -7.f), 7.f);
                        o[j] = g * sigmoidf_(1.702f * g) * (l + 1.f); }
                u32x2 w; w.x = pk4_fp8(o[0], o[1], o[2], o[3]); w.y = pk4_fp8(o[4], o[5], o[6], o[7]);
                *(u32x2*)(act + (size_t)(u.pm * 256 + rl) * 1024 + j0) = w;
            }
    }
};
struct EpiMoeOut {
    static constexpr bool PERM = true;
    bf16_t* ys; const float* b2; const float* sgate;
    __device__ __forceinline__ void operator()(const f32x4 (&acc)[2][2][4][2], const pg8::Unit& u, int wr, int wc, int fr, int fq) const {
        asm volatile("" : "+v"(fr), "+v"(fq));
        const int c0 = 256 * u.pn + 32 * wc + 8 * fq;
        const float* bp = b2 + (size_t)u.e * 1024 + c0;
        f32x4 bv[2][2];
#pragma unroll
        for (int bj = 0; bj < 2; ++bj)
#pragma unroll
            for (int n = 0; n < 2; ++n) bv[bj][n] = *(const f32x4*)(bp + 128 * bj + 4 * n);
#pragma unroll
        for (int ai = 0; ai < 2; ++ai)
#pragma unroll
            for (int m = 0; m < 4; ++m) {
                const int rl = 128 * ai + 64 * wr + 16 * m + fr;
                const float g = (rl < u.nvalid) ? sgate[u.sbase + rl] : 0.f;
                bf16_t* rowp = ys + (size_t)(u.pm * 256 + rl) * 1024 + c0;
#pragma unroll
                for (int bj = 0; bj < 2; ++bj) { const f32x4 v0 = (acc[ai][bj][m][0] + bv[bj][0]) * g, v1 = (acc[ai][bj][m][1] + bv[bj][1]) * g;
                    u32x4 w; w.x = cvt_pk_bf16(v0[0], v0[1]); w.y = cvt_pk_bf16(v0[2], v0[3]); w.z = cvt_pk_bf16(v1[0], v1[1]); w.w = cvt_pk_bf16(v1[2], v1[3]);
                    *(u32x4*)(rowp + 128 * bj) = w; }
            }
    }
};

__device__ __forceinline__ int map_in(int n) {
    if (n < 384) return 2048 + n;
    if (n < 768) return n - 384;
    if (n < 1152) return 384 + (n - 768);
    if (n < 1536) return 2048 + 384 + (n - 1152);
    if (n < 1920) return 2048 + 768 + (n - 1536);
    if (n < 2688) { const int isk = n >= 2304; const int c = n - 1920 - 384 * isk; const int h = c >> 6, w = c & 63; const int wp = (w < 32) ? 2 * w : 2 * (w - 32) + 1; return 768 + 384 * isk + h * 64 + wp; }
    if (n < 3072) return 2048 + 1152 + (n - 2688);
    if (n < 3456) return 2048 + 1536 + (n - 3072);
    if (n < 3968) { const int isk = n >= 3712; const int c = n - 3456 - 256 * isk; const int h = c >> 5, w = c & 31; const int half = w >> 4, uu = w & 15; const int up = (uu < 8) ? 2 * uu : 2 * (uu - 8) + 1; return 1536 + 256 * isk + h * 32 + half * 16 + up; }
    return 2048 + 1920 + (n - 3968);
}
__device__ __forceinline__ int map_w1(int n) { const int j = n >> 1, lin = n & 1; return (j >> 7) * 256 + lin * 128 + (j & 127); }
template <int MAP> __device__ __forceinline__ void p0_transpose_item(const float* W, int Kd, int N, bf16_t* WT, LAS float* scr, int item, int lane) {
    const int nblk = N / 32, kb = item / nblk, nb = item % nblk, k0 = 64 * kb, n0 = 32 * nb;
    { f32x4 rv[8];
#pragma unroll
      for (int i = 0; i < 8; ++i) rv[i] = *(const f32x4*)(W + (size_t)(k0 + (lane >> 3) + 8 * i) * N + n0 + 4 * (lane & 7));
#pragma unroll
      for (int i = 0; i < 8; ++i) { LAS float* sp_ = scr + ((lane >> 3) + 8 * i) * 33 + 4 * (lane & 7); sp_[0] = rv[i][0]; sp_[1] = rv[i][1]; sp_[2] = rv[i][2]; sp_[3] = rv[i][3]; } }
    LDS_WAIT(); asm volatile("" ::: "memory");
    const int c = lane & 7;
#pragma unroll
    for (int j = 0; j < 4; ++j) { const int n = (lane >> 3) + 8 * j; const LAS float* s = scr + (8 * c) * 33 + n;
        u32x4 o; o.x = pk2(s[0 * 33], s[1 * 33]); o.y = pk2(s[2 * 33], s[3 * 33]); o.z = pk2(s[4 * 33], s[5 * 33]); o.w = pk2(s[6 * 33], s[7 * 33]);
        const int nn = n0 + n; const int dr = MAP == 1 ? map_in(nn) : (MAP == 2 ? map_w1(nn) : nn);
        *(u32x4*)(WT + (size_t)dr * Kd + k0 + 8 * c) = o; }
    LDS_WAIT(); asm volatile("" ::: "memory");
}
template <int MAP> __device__ __forceinline__ void p0_transpose_item_fp8(const float* W, int Kd, int N, unsigned char* WT, LAS float* scr, int item, int lane) {
    const int nblk = N / 32, kb = item / nblk, nb = item % nblk, k0 = 64 * kb, n0 = 32 * nb;
    { f32x4 rv[8];
#pragma unroll
      for (int i = 0; i < 8; ++i) rv[i] = *(const f32x4*)(W + (size_t)(k0 + (lane >> 3) + 8 * i) * N + n0 + 4 * (lane & 7));
#pragma unroll
      for (int i = 0; i < 8; ++i) { LAS float* sp_ = scr + ((lane >> 3) + 8 * i) * 33 + 4 * (lane & 7); sp_[0] = rv[i][0]; sp_[1] = rv[i][1]; sp_[2] = rv[i][2]; sp_[3] = rv[i][3]; } }
    LDS_WAIT(); asm volatile("" ::: "memory");
    const int n = lane >> 1, hf = lane & 1; const LAS float* sp = scr + (32 * hf) * 33 + n;
    u32x4 o0, o1;
#pragma unroll
    for (int q = 0; q < 4; ++q) { o0[q] = pk4_fp8(sp[(4 * q) * 33] * W8_MUL, sp[(4 * q + 1) * 33] * W8_MUL, sp[(4 * q + 2) * 33] * W8_MUL, sp[(4 * q + 3) * 33] * W8_MUL);
                                  o1[q] = pk4_fp8(sp[(16 + 4 * q) * 33] * W8_MUL, sp[(16 + 4 * q + 1) * 33] * W8_MUL, sp[(16 + 4 * q + 2) * 33] * W8_MUL, sp[(16 + 4 * q + 3) * 33] * W8_MUL); }
    const int nn = n0 + n; const int dr = MAP == 2 ? map_w1(nn) : nn;
    unsigned char* dp = WT + (size_t)dr * Kd + k0 + 32 * hf;
    *(u32x4*)dp = o0; *(u32x4*)(dp + 16) = o1;
    LDS_WAIT(); asm volatile("" ::: "memory");
}
__device__ __forceinline__ void phase_prologue_a(Frame& F) {
    PHASE_IDS();
    LAS float* scr = (LAS float*)(F.lds + wave * 16384);
    const int gw = blk_ * NWAVES + wave, NGW = F.G * NWAVES;
    unsigned char* ws = F.ws;
    constexpr int I_IN = 16 * 132, I_OUT = 16 * 32, I_W1 = 16 * 64, I_W2 = 16 * 32;
    constexpr int PER_L = I_IN + I_OUT + NE * (I_W1 + I_W2);
    for (int it = gw; it < 2 * PER_L; it += NGW) {
        const int l = it / PER_L; int r = it % PER_L;
        if (r < I_IN) { p0_transpose_item<1>(F.in[7] + (size_t)l * 1024 * 4224, 1024, 4224, (bf16_t*)(ws + WS_WIN) + (size_t)l * NIN * 1024, scr, r, lane); continue; } r -= I_IN;
        if (r < I_OUT) { p0_transpose_item<0>(F.in[14] + (size_t)l * 1024 * 1024, 1024, 1024, (bf16_t*)(ws + WS_WOUT) + (size_t)l * 1024 * 1024, scr, r, lane); continue; } r -= I_OUT;
        const int e = r / (I_W1 + I_W2); r -= e * (I_W1 + I_W2);
        if (r < I_W1) p0_transpose_item_fp8<2>(F.in[17] + ((size_t)l * NE + e) * 1024 * 2048, 1024, 2048, ws + WS_W1 + ((size_t)l * NE + e) * 2048 * 1024, scr, r, lane);
        else p0_transpose_item_fp8<0>(F.in[19] + ((size_t)l * NE + e) * 1024 * 1024, 1024, 1024, ws + WS_W2 + ((size_t)l * NE + e) * 1024 * 1024, scr, r - I_W1, lane);
    }
    for (int i = gw * 64 + lane; i < 2 * 128 * 1024 / 8; i += NGW * 64) { const int l = i / (128 * 128), rr = i % (128 * 128);
        *(u32x4*)((bf16_t*)(ws + WS_WIN) + ((size_t)l * NIN + 4224) * 1024 + (size_t)rr * 8) = (u32x4){0u, 0u, 0u, 0u}; }
    for (int it = gw; it < 2 * 96; it += NGW) {
        const int l = it / 96, n0 = (it % 96) * 64, n = n0 + lane;
        const float* mw = F.in[4] + (size_t)l * 1024 * 6144;
        float a0 = 0.f, a1 = 0.f, a2 = 0.f;
        for (int kb = 0; kb < 16; ++kb) {
            const int kk = kb * 64 + lane;
            float c0 = F.in[1][kk], c1 = F.in[1][1024 + kk], c2 = F.in[3][kk];
            c0 = c0 * sigmoidf_(c0); c1 = c1 * sigmoidf_(c1); c2 = c2 * sigmoidf_(c2);
#pragma unroll 8
            for (int j = 0; j < 64; ++j) { const float w = mw[(size_t)(kb * 64 + j) * 6144 + n]; a0 += rdlane(c0, j) * w; a1 += rdlane(c1, j) * w; a2 += rdlane(c2, j) * w; }
        }
        const float bias = F.in[5][l * 6144 + n];
        const int ch = n >> 10, col = n & 1023;
        const float* ng = F.in[6] + (size_t)l * 4096;
        float vals[3] = {a0 + bias, a1 + bias, a2 + bias};
#pragma unroll
        for (int w = 0; w < 3; ++w) { float v = vals[w];
            if (ch == 1) v = (1.f + v) * ng[col]; else if (ch == 2) v = v * ng[1024 + col]; else if (ch == 4) v = (1.f + v) * ng[2048 + col]; else if (ch == 5) v = v * ng[3072 + col];
            const int slot = (ch == 0) ? 1 : (ch == 1) ? 0 : (ch == 2) ? 2 : (ch == 3) ? 4 : (ch == 4) ? 3 : 5;
            ((float*)(ws + WS_MODV))[((size_t)(l * 3 + w) * 6 + slot) * 1024 + col] = v; }
    }
    float* tab = (float*)(ws + WS_TAB);
    const int gt = blk_ * NTHR + tid, NGT = F.G * NTHR;
    for (int i = gt; i < 2 * 384; i += NGT) { const int l = i / 384, c = i % 384; const float a = F.in[8][c], b = F.in[8][384 + c];
        tab[TB_LBT + i] = (l == 0) ? 0.f : 1.f / (1.f + expf(a - b)); }
    if (gt < 2) { const int l = gt; const float* lm = F.in[12] + l * 128; float s0 = 0.f, s1 = 0.f;
        for (int i = 0; i < 32; ++i) { s0 += lm[i] * lm[32 + i]; s1 += lm[64 + i] * lm[96 + i]; }
        const float li = 0.8f - 0.6f * expf(-0.3f * (float)l);
        tab[TB_LAM + l] = expf(s0) - expf(s1) + li; tab[TB_LAM + 2 + l] = 1.f - li; }
    if (gt < 24) tab[TB_GAM + gt] = 1.f - exp2f(-F.in[10][gt]);
    for (int i = gt; i < 256 * 8 + 64 * 8; i += NGT) {
        const bool isr = i < 2048; const int ii = isr ? i : i - 2048; const int pos = ii >> 3, j = ii & 7;
        const float inv = exp2f(-(float)j * (13.287712379549449f / 8.f));
        const double rev = (double)pos * (double)inv * 0.15915494309189535; const float fr = (float)(rev - floor(rev));
        const float cs = __builtin_amdgcn_cosf(fr), sn = __builtin_amdgcn_sinf(fr);
        if (isr) { tab[TB_AXR + ii] = cs; tab[TB_AXR + 2048 + ii] = sn; } else { tab[TB_AXC + ii] = cs; tab[TB_AXC + 512 + ii] = sn; }
    }
    float* rope = (float*)(ws + WS_ROPE);
    for (int i = gt; i < T * 32; i += NGT) { const int pos = i >> 5, j = i & 31;
        const float inv = exp2f(-(float)j * (13.287712379549449f / 32.f));
        const double rev = (double)pos * (double)inv * 0.15915494309189535; const float fr = (float)(rev - floor(rev));
        rope[i] = __builtin_amdgcn_cosf(fr); rope[(size_t)T * 32 + i] = __builtin_amdgcn_sinf(fr); }
    bf16_t* rwh = (bf16_t*)(ws + WS_RWT); bf16_t* rwl = rwh + 2 * 32 * 1024;
    for (int i = gt; i < 2 * 32 * 1024; i += NGT) { const int l = i >> 15, e = (i >> 10) & 31, c = i & 1023; const float wv = F.in[15][((size_t)l * 1024 + c) * 32 + e];
        const unsigned hb = f2bf(wv); rwh[i] = (bf16_t)hb; rwl[i] = (bf16_t)f2bf(wv - __builtin_bit_cast(float, hb << 16)); }
}

__device__ __forceinline__ float row_sumsq(const f32x4 (&v)[4]) {
    float s = 0.f;
#pragma unroll
    for (int j = 0; j < 4; ++j) s += (v[j][0] * v[j][0] + v[j][1] * v[j][1]) + (v[j][2] * v[j][2] + v[j][3] * v[j][3]);
    return wave_sum(s);
}
__device__ __forceinline__ void row_load(const float* p, int lane, f32x4 (&v)[4]) {
#pragma unroll
    for (int j = 0; j < 4; ++j) v[j] = *(const f32x4*)(p + 4 * lane + 256 * j);
}
__device__ __forceinline__ void row_store(float* p, int lane, const f32x4 (&v)[4]) {
#pragma unroll
    for (int j = 0; j < 4; ++j) *(f32x4*)(p + 4 * lane + 256 * j) = v[j];
}
__device__ __forceinline__ void row_store_bf16(bf16_t* p, int lane, const f32x4 (&v)[4]) {
#pragma unroll
    for (int j = 0; j < 4; ++j) { u32x2 w; w.x = pk2(v[j][0], v[j][1]); w.y = pk2(v[j][2], v[j][3]); *(u32x2*)(p + 4 * lane + 256 * j) = w; }
}
__device__ __forceinline__ int row_which(int r) { return r < NLAT ? (r >> 14) : 2; }
__device__ __forceinline__ void row_norm_mod(const f32x4 (&x)[4], const float* a, const float* b, int lane, f32x4 (&o)[4]) {
    const float r = __builtin_amdgcn_rsqf(row_sumsq(x) * (1.f / 1024.f) + EPS);
#pragma unroll
    for (int j = 0; j < 4; ++j) { const f32x4 av = *(const f32x4*)(a + 4 * lane + 256 * j), bv = *(const f32x4*)(b + 4 * lane + 256 * j); o[j] = x[j] * r * av + bv; }
}
__device__ __forceinline__ void phase_prologue_b(Frame& F) {
    PHASE_IDS();
    const int gw = blk_ * NWAVES + wave, NGW = F.G * NWAVES;
    const float* modv = (const float*)(F.ws + WS_MODV);
    for (int r = gw; r < NROW; r += NGW) {
        const float* src = r < NLAT ? F.in[0] + (size_t)r * D : F.in[2] + (size_t)(r - NLAT) * D;
        const int w = row_which(r);
        f32x4 x[4], o[4]; row_load(src, lane, x);
        row_norm_mod(x, modv + (size_t)(0 * 3 + w) * 6 * 1024, modv + ((size_t)(0 * 3 + w) * 6 + 1) * 1024, lane, o);
        row_store_bf16((bf16_t*)(F.ws + WS_H) + (size_t)r * D, lane, o);
    }
}

__device__ __forceinline__ int scan_row(int sc, int p, int dir, int b) {
    if (sc == 0) return NLAT + b * CL + (dir ? (CL - 1 - p) : p);
    const int tt = (sc - 1) * 256 + p; return b * T + (dir ? (T - 1 - tt) : tt);
}
template <int TYPE, bool WITHQ>
__device__ __forceinline__ float scan_step(float (&S)[64], const LAS float* kq, float vv, float gam) {
    float o = 0.f;
#pragma unroll
    for (int kg = 0; kg < 8; ++kg) {
        f32x4 kv[2], qv[2];
#pragma unroll
        for (int j = 0; j < 2; ++j) { kv[j] = *(const LAS f32x4*)(kq + kg * 8 + 4 * j); if (WITHQ) qv[j] = *(const LAS f32x4*)(kq + 64 + kg * 8 + 4 * j); }
#pragma unroll
        for (int j = 0; j < 8; ++j) { const int k = kg * 8 + j; const float kk = kv[j >> 2][j & 3];
            if (TYPE == 0) S[k] = __builtin_fmaf(kk, vv - S[k], S[k]); else S[k] = __builtin_fmaf(kk, vv, gam * S[k]);
            if (WITHQ) o = __builtin_fmaf(qv[j >> 2][j & 3], S[k], o); }
        asm volatile("" ::: "memory"); __builtin_amdgcn_sched_barrier(0);
    }
    return o;
}
__device__ __forceinline__ void phase_scan_a(Frame& F, int layer) {
    PHASE_IDS();
    const int gw = blk_ * NWAVES + wave, NGW = F.G * NWAVES;
    const float* tab = (const float*)(F.ws + WS_TAB);
    LAS float* scr = (LAS float*)(F.lds + wave * 2048);
    for (int wu = gw; wu < NSEQ * NSC; wu += NGW) {
        const int s = wu / NSC, sc = wu % NSC; const int type = s / 24, rem = s % 24, b = rem / 12, h = (rem % 12) >> 1, dir = rem & 1;
        const bf16_t* Kb = (const bf16_t*)(F.ws + WS_SCAN + (size_t)(type ? SC_RK : (dir ? SC_KB : SC_KF)) * SCAN_PITCH);
        const bf16_t* Vb = (const bf16_t*)(F.ws + WS_SCAN + (size_t)(type ? SC_RV : SC_HV) * SCAN_PITCH);
        unsigned co = (unsigned)(h * 64 + lane); asm volatile("" : "+v"(co));
        const float gam = tab[TB_GAM + layer * 12 + dir * 6 + h];
        float S[64];
#pragma unroll
        for (int k = 0; k < 64; ++k) S[k] = 0.f;
        float dprod = 1.f;
        float kc[4], vc[4], kn[4], vn[4];
#pragma unroll
        for (int i = 0; i < 4; ++i) { const unsigned ro = (unsigned)scan_row(sc, i, dir, b) * 384u + co; kc[i] = bf2f(Kb[ro]); vc[i] = bf2f(Vb[ro]); kn[i] = 0.f; vn[i] = 0.f; }
        for (int p0 = 0; p0 < 256; p0 += 4) {
            if (p0 + 4 < 256) {
#pragma unroll
                for (int i = 0; i < 4; ++i) { const unsigned ro = (unsigned)scan_row(sc, p0 + 4 + i, dir, b) * 384u + co; kn[i] = bf2f(Kb[ro]); vn[i] = bf2f(Vb[ro]); }
            }
#pragma unroll
            for (int i = 0; i < 4; ++i) scr[i * 128 + lane] = kc[i];
#pragma unroll
            for (int i = 0; i < 4; ++i) {
                if (type == 0) { dprod *= (1.f - kc[i]); (void)scan_step<0, false>(S, scr + i * 128, vc[i], gam); }
                else { dprod *= gam; (void)scan_step<1, false>(S, scr + i * 128, vc[i], gam); }
            }
#pragma unroll
            for (int i = 0; i < 4; ++i) { kc[i] = kn[i]; vc[i] = vn[i]; }
        }
        float* sl = (float*)(F.ws + WS_SLOC) + (size_t)wu * 4096 + lane;
#pragma unroll
        for (int k = 0; k < 64; ++k) { *sl = S[k]; sl += 64; asm volatile("" : "+v"(sl)); }
        ((float*)(F.ws + WS_DEC))[(size_t)wu * 64 + lane] = dprod;
    }
}
__device__ __forceinline__ void phase_scan_b(Frame& F) {
    const float* sloc = (const float*)(F.ws + WS_SLOC); const float* dec = (const float*)(F.ws + WS_DEC); float* sin_ = (float*)(F.ws + WS_SIN);
    PHASE_IDS();
    for (int idx = blk_ * NTHR + tid; idx < NSEQ * 4096; idx += F.G * NTHR) {
        const int s = idx >> 12, kv = idx & 4095, k = kv >> 6; float st = 0.f;
#pragma unroll 8
        for (int sc = 0; sc < NSC - 1; ++sc) { const size_t u = (size_t)s * NSC + sc; st = dec[u * 64 + k] * st + sloc[u * 4096 + kv]; sin_[(u + 1) * 4096 + kv] = st; }
    }
}
template <int TYPE, bool SECOND>
__device__ __forceinline__ void scan_dir(Frame& F, int lane_in, int wave, int layer, int b, int h, int dir, int sc, bool zero_state) {
    int lane = lane_in; asm volatile("" : "+v"(lane));
    const float* tab = (const float*)(F.ws + WS_TAB);
    const int s = TYPE * 24 + b * 12 + h * 2 + dir;
    const bf16_t* Kb = (const bf16_t*)(F.ws + WS_SCAN + (size_t)(TYPE ? SC_RK : (dir ? SC_KB : SC_KF)) * SCAN_PITCH);
    const bf16_t* Vb = (const bf16_t*)(F.ws + WS_SCAN + (size_t)(TYPE ? SC_RV : SC_HV) * SCAN_PITCH);
    const bf16_t* Qb = (const bf16_t*)(F.ws + WS_SCAN + (size_t)(TYPE ? SC_RQ : SC_HQ) * SCAN_PITCH);
    const bf16_t* Gb = (const bf16_t*)(F.ws + WS_SCAN + (size_t)(TYPE ? SC_RG : SC_HG) * SCAN_PITCH);
    float* oscr = (float*)(F.ws + WS_OSCR);
    bf16_t* mix = (bf16_t*)(F.ws + WS_MIX);
    unsigned co = (unsigned)(h * 64 + lane); asm volatile("" : "+v"(co));
    const unsigned co2 = co + TYPE * 384;
    const float gam = tab[TB_GAM + layer * 12 + dir * 6 + h];
    const float nw = F.in[TYPE ? 11 : 9][layer * 64 + lane];
    LAS float* scr = (LAS float*)(F.lds + wave * 2048);
    float S[64];
    if (zero_state) {
#pragma unroll
        for (int k = 0; k < 64; ++k) S[k] = 0.f;
    } else { const float* si = (const float*)(F.ws + WS_SIN) + ((size_t)s * NSC + sc) * 4096 + lane;
#pragma unroll
        for (int k = 0; k < 64; ++k) { S[k] = *si; si += 64; asm volatile("" : "+v"(si)); } }
    float kc[2], vc[2], qc[2], kn[2], vn[2], qn[2];
#pragma unroll
    for (int i = 0; i < 2; ++i) { const unsigned ro = (unsigned)scan_row(sc, i, dir, b) * 384u + co; kc[i] = bf2f(Kb[ro]); vc[i] = bf2f(Vb[ro]); qc[i] = bf2f(Qb[ro]); kn[i] = 0.f; vn[i] = 0.f; qn[i] = 0.f; }
    for (int p0 = 0; p0 < 256; p0 += 2) {
        if (p0 + 2 < 256) {
#pragma unroll
            for (int i = 0; i < 2; ++i) { const unsigned ro = (unsigned)scan_row(sc, p0 + 2 + i, dir, b) * 384u + co; kn[i] = bf2f(Kb[ro]); vn[i] = bf2f(Vb[ro]); qn[i] = bf2f(Qb[ro]); }
        }
#pragma unroll
        for (int i = 0; i < 2; ++i) { scr[i * 128 + lane] = kc[i]; scr[i * 128 + 64 + lane] = qc[i]; }
#pragma unroll
        for (int i = 0; i < 2; ++i) {
            float o = scan_step<TYPE, true>(S, scr + i * 128, vc[i], gam);
            const unsigned row = (unsigned)scan_row(sc, p0 + i, dir, b);
            if (!SECOND) oscr[row * 768u + co2] = o;
            else { o += oscr[row * 768u + co2];
                const float r = __builtin_amdgcn_rsqf(wave_sum_dpp(o * o) * (1.f / 64.f) + EPS);
                const float g = bf2f(Gb[row * 384u + co]);
                mix[row * 1024u + co2] = (bf16_t)f2bf(o * r * nw * g * sigmoidf_(g)); }
            asm volatile("" ::: "memory");
        }
#pragma unroll
        for (int i = 0; i < 2; ++i) { kc[i] = kn[i]; vc[i] = vn[i]; qc[i] = qn[i]; }
    }
}
__device__ __forceinline__ void phase_scan_c(Frame& F, int layer) {
    PHASE_IDS();
    const int gw = blk_ * NWAVES + wave, NGW = F.G * NWAVES;
    const bool need_ctx = layer == 0;
    for (int wu = gw; wu < 24 * NSC; wu += NGW) {
        const int sq = wu / NSC, blk = wu % NSC; const int type = sq / 12, b = (sq % 12) / 6, h = sq % 6;
        if (blk == 0 && !need_ctx) continue;
        const int scf = blk, scb = (blk == 0) ? 0 : 65 - blk;
        if (type == 0) { scan_dir<0, false>(F, lane, wave, layer, b, h, 0, scf, scf == 0); scan_dir<0, true>(F, lane, wave, layer, b, h, 1, scb, scb == 0); }
        else           { scan_dir<1, false>(F, lane, wave, layer, b, h, 0, scf, scf == 0); scan_dir<1, true>(F, lane, wave, layer, b, h, 1, scb, scb == 0); }
    }
}


namespace sc2 {
constexpr int WLDS = 8448;
__device__ __forceinline__ f32x4 mfma16(bf16x8 a, bf16x8 b, f32x4 c) { return __builtin_amdgcn_mfma_f32_16x16x32_bf16(a, b, c, 0, 0, 0); }
template <int TYPE, int MODE>
__device__ __forceinline__ void run(Frame& F, int lane_in, int wave, int layer, int b, int h, int dir, int sc, bool zero_state, int wu_out) {
    int lane = lane_in; asm volatile("" : "+v"(lane));
    const int g = lane >> 4, n = lane & 15;
    const float* tab = (const float*)(F.ws + WS_TAB);
    const int s = TYPE * 24 + b * 12 + h * 2 + dir;
    const bf16_t* Kb = (const bf16_t*)(F.ws + WS_SCAN + (size_t)(TYPE ? SC_RK : (dir ? SC_KB : SC_KF)) * SCAN_PITCH);
    const bf16_t* Vb = (const bf16_t*)(F.ws + WS_SCAN + (size_t)(TYPE ? SC_RV : SC_HV) * SCAN_PITCH);
    const bf16_t* Qb = (const bf16_t*)(F.ws + WS_SCAN + (size_t)(TYPE ? SC_RQ : SC_HQ) * SCAN_PITCH);
    const bf16_t* Gb = (const bf16_t*)(F.ws + WS_SCAN + (size_t)(TYPE ? SC_RG : SC_HG) * SCAN_PITCH);
    float* oscr = (float*)(F.ws + WS_OSCR);
    bf16_t* mix = (bf16_t*)(F.ws + WS_MIX);
    const unsigned co = (unsigned)(h * 64 + lane);
    const float lg2 = TYPE ? __builtin_amdgcn_logf(tab[TB_GAM + layer * 12 + dir * 6 + h]) : 0.f;
    LAS unsigned char* wl = F.lds + wave * WLDS;
    LAS bf16_t* QT = (LAS bf16_t*)wl; LAS bf16_t* KT = (LAS bf16_t*)(wl + 2048); LAS bf16_t* KPT = (LAS bf16_t*)(wl + 4096); LAS bf16_t* VT = (LAS bf16_t*)(wl + 6144); LAS float* DD = (LAS float*)(wl + 8192);
    f32x4 S[4][4];
    if (zero_state) {
#pragma unroll
        for (int kb = 0; kb < 4; ++kb)
#pragma unroll
            for (int vb = 0; vb < 4; ++vb) S[kb][vb] = (f32x4){0.f, 0.f, 0.f, 0.f};
    } else { const float* si = (const float*)(F.ws + WS_SIN) + ((size_t)s * NSC + sc) * 4096;
#pragma unroll
        for (int kb = 0; kb < 4; ++kb)
#pragma unroll
            for (int vb = 0; vb < 4; ++vb)
#pragma unroll
                for (int r = 0; r < 4; ++r) S[kb][vb][r] = si[(16 * kb + 4 * g + r) * 64 + 16 * vb + n]; }
    float dtot = 1.f;
    const float gam = TYPE ? tab[TB_GAM + layer * 12 + dir * 6 + h] : 0.f;
    unsigned short kr[16], vr[16], qr[16];
#pragma unroll
    for (int t = 0; t < 16; ++t) { const unsigned ro = (unsigned)scan_row(sc, t, dir, b) * 384u + co; kr[t] = Kb[ro]; vr[t] = Vb[ro]; if (MODE != 0) qr[t] = Qb[ro]; else qr[t] = 0; }
    for (int blk = 0; blk < 16; ++blk) {
        const unsigned row = (unsigned)scan_row(sc, 16 * blk + n, dir, b);
        const unsigned ob = row * 768u + (unsigned)(TYPE * 384 + h * 64 + 4 * g);
        f32x4 of[4]; u32x2 gg[4];
        if (MODE == 2) {
#pragma unroll
            for (int vb = 0; vb < 4; ++vb) { of[vb] = *(const f32x4*)(oscr + ob + 16 * vb); gg[vb] = *(const u32x2*)(Gb + row * 384u + (unsigned)(h * 64 + 16 * vb + 4 * g)); }
        }
        float ek[16]; float eq = 1.f;
#pragma unroll
        for (int t = 0; t < 16; ++t) { const float kk = bf2f(kr[t]);
            eq = fmaxf(eq * (TYPE == 0 ? 1.f - kk : gam), 7.9e-31f);
            ek[t] = __builtin_amdgcn_rcpf(eq);
            if (MODE != 0) { QT[t * 64 + lane] = (bf16_t)f2bf(bf2f(qr[t]) * eq); KT[t * 64 + lane] = (bf16_t)f2bf(kk * ek[t]); } }
        dtot *= eq; DD[lane] = eq;
        { u32x4 w0, w1, x0, x1;
#pragma unroll
          for (int q = 0; q < 4; ++q) {
              w0[q] = cvt_pk_bf16(bf2f(kr[2 * q]) * (eq * ek[2 * q]), bf2f(kr[2 * q + 1]) * (eq * ek[2 * q + 1]));
              w1[q] = cvt_pk_bf16(bf2f(kr[8 + 2 * q]) * (eq * ek[8 + 2 * q]), bf2f(kr[8 + 2 * q + 1]) * (eq * ek[8 + 2 * q + 1]));
              x0[q] = (unsigned)vr[2 * q] | ((unsigned)vr[2 * q + 1] << 16); x1[q] = (unsigned)vr[8 + 2 * q] | ((unsigned)vr[8 + 2 * q + 1] << 16); }
          *(LAS u32x4*)(KPT + lane * 16) = w0; *(LAS u32x4*)(KPT + lane * 16 + 8) = w1; *(LAS u32x4*)(VT + lane * 16) = x0; *(LAS u32x4*)(VT + lane * 16 + 8) = x1; }
        if (blk + 1 < 16) {
#pragma unroll
            for (int t = 0; t < 16; ++t) { const unsigned ro = (unsigned)scan_row(sc, 16 * (blk + 1) + t, dir, b) * 384u + co; kr[t] = Kb[ro]; vr[t] = Vb[ro]; if (MODE != 0) qr[t] = Qb[ro]; }
        }
        asm volatile("s_waitcnt lgkmcnt(0)" ::: "memory");
        if (MODE != 0) {
            f32x4 sct = (f32x4){0.f, 0.f, 0.f, 0.f};
#pragma unroll
            for (int ks = 0; ks < 2; ++ks) { const bf16x8 a = *(const LAS bf16x8*)(KT + n * 64 + 32 * ks + 8 * g), bq = *(const LAS bf16x8*)(QT + n * 64 + 32 * ks + 8 * g); sct = mfma16(a, bq, sct); }
#pragma unroll
            for (int r = 0; r < 4; ++r) sct[r] = (4 * g + r <= n) ? sct[r] : 0.f;
            u32x4 bs; bs.x = cvt_pk_bf16(sct[0], sct[1]); bs.y = cvt_pk_bf16(sct[2], sct[3]); bs.z = 0u; bs.w = 0u;
            f32x4 o[4];
#pragma unroll
            for (int vb = 0; vb < 4; ++vb) { const u32x2 lo = *(const LAS u32x2*)(VT + (16 * vb + n) * 16 + 4 * g); u32x4 av; av.x = lo.x; av.y = lo.y; av.z = 0u; av.w = 0u;
                o[vb] = mfma16(__builtin_bit_cast(bf16x8, av), __builtin_bit_cast(bf16x8, bs), (f32x4){0.f, 0.f, 0.f, 0.f}); }
#pragma unroll
            for (int ks = 0; ks < 2; ++ks) {
                const u32x2 q0 = *(const LAS u32x2*)(QT + n * 64 + 32 * ks + 4 * g), q1 = *(const LAS u32x2*)(QT + n * 64 + 32 * ks + 16 + 4 * g);
                u32x4 bq; bq.x = q0.x; bq.y = q0.y; bq.z = q1.x; bq.w = q1.y;
#pragma unroll
                for (int vb = 0; vb < 4; ++vb) { u32x4 av; av.x = cvt_pk_bf16(S[2 * ks][vb][0], S[2 * ks][vb][1]); av.y = cvt_pk_bf16(S[2 * ks][vb][2], S[2 * ks][vb][3]);
                    av.z = cvt_pk_bf16(S[2 * ks + 1][vb][0], S[2 * ks + 1][vb][1]); av.w = cvt_pk_bf16(S[2 * ks + 1][vb][2], S[2 * ks + 1][vb][3]);
                    o[vb] = mfma16(__builtin_bit_cast(bf16x8, av), __builtin_bit_cast(bf16x8, bq), o[vb]); }
            }
            if (MODE == 1) {
#pragma unroll
                for (int vb = 0; vb < 4; ++vb) *(f32x4*)(oscr + ob + 16 * vb) = o[vb];
            } else {
                float ss = 0.f;
#pragma unroll
                for (int vb = 0; vb < 4; ++vb) { o[vb] = o[vb] + of[vb]; ss += (o[vb][0] * o[vb][0] + o[vb][1] * o[vb][1]) + (o[vb][2] * o[vb][2] + o[vb][3] * o[vb][3]); }
                ss += xor_swz<16>(ss); ss += xor32(ss, lane);
                const float rn = __builtin_amdgcn_rsqf(ss * (1.f / 64.f) + EPS);
                const float* nw = F.in[TYPE ? 11 : 9] + layer * 64 + 4 * g;
#pragma unroll
                for (int vb = 0; vb < 4; ++vb) { const f32x4 w4 = *(const f32x4*)(nw + 16 * vb);
                    const float g0 = bflo(gg[vb].x), g1 = bfhi(gg[vb].x), g2 = bflo(gg[vb].y), g3 = bfhi(gg[vb].y);
                    u32x2 w; w.x = cvt_pk_bf16(o[vb][0] * rn * w4[0] * g0 * sigmoidf_(g0), o[vb][1] * rn * w4[1] * g1 * sigmoidf_(g1)); w.y = cvt_pk_bf16(o[vb][2] * rn * w4[2] * g2 * sigmoidf_(g2), o[vb][3] * rn * w4[3] * g3 * sigmoidf_(g3));
                    *(u32x2*)(mix + row * 1024u + (unsigned)(TYPE * 384 + h * 64 + 16 * vb + 4 * g)) = w; }
            }
        }
#pragma unroll
        for (int kb = 0; kb < 4; ++kb) { const f32x4 d4 = *(const LAS f32x4*)(DD + 16 * kb + 4 * g);
#pragma unroll
            for (int vb = 0; vb < 4; ++vb) S[kb][vb] = S[kb][vb] * d4; }
        { bf16x8 af[4], bfv[4];
#pragma unroll
          for (int q = 0; q < 4; ++q) { u32x4 a = *(const LAS u32x4*)(KPT + (16 * q + n) * 16 + 8 * (g & 1)), bq = *(const LAS u32x4*)(VT + (16 * q + n) * 16 + 8 * (g & 1));
              if (g >= 2) { a = (u32x4){0u, 0u, 0u, 0u}; bq = (u32x4){0u, 0u, 0u, 0u}; }
              af[q] = __builtin_bit_cast(bf16x8, a); bfv[q] = __builtin_bit_cast(bf16x8, bq); }
#pragma unroll
          for (int kb = 0; kb < 4; ++kb)
#pragma unroll
              for (int vb = 0; vb < 4; ++vb) S[kb][vb] = mfma16(af[kb], bfv[vb], S[kb][vb]); }
        asm volatile("s_waitcnt lgkmcnt(0)" ::: "memory");
    }
    if (MODE == 0) {
        float* sl = (float*)(F.ws + WS_SLOC) + (size_t)wu_out * 4096;
#pragma unroll
        for (int kb = 0; kb < 4; ++kb)
#pragma unroll
            for (int vb = 0; vb < 4; ++vb)
#pragma unroll
                for (int r = 0; r < 4; ++r) sl[(16 * kb + 4 * g + r) * 64 + 16 * vb + n] = S[kb][vb][r];
        ((float*)(F.ws + WS_DEC))[(size_t)wu_out * 64 + lane] = dtot;
    }
}
}
__device__ __forceinline__ void phase_scan2_a(Frame& F, int layer) {
    PHASE_IDS();
    const int gw = blk_ * NWAVES + wave, NGW = F.G * NWAVES;
    for (int wu = gw; wu < NSEQ * NSC; wu += NGW) {
        const int s = wu / NSC, sc = wu % NSC; const int type = s / 24, rem = s % 24, b = rem / 12, h = (rem % 12) >> 1, dir = rem & 1;
        if (type == 0) sc2::run<0, 0>(F, lane, wave, layer, b, h, dir, sc, true, wu); else sc2::run<1, 0>(F, lane, wave, layer, b, h, dir, sc, true, wu);
    }
}
__device__ __forceinline__ void phase_scan2_c(Frame& F, int layer) {
    PHASE_IDS();
    const int gw = blk_ * NWAVES + wave, NGW = F.G * NWAVES;
    const bool need_ctx = layer == 0;
    for (int wu = gw; wu < 24 * NSC; wu += NGW) {
        const int sq = wu / NSC, blk = wu % NSC; const int type = sq / 12, b = (sq % 12) / 6, h = sq % 6;
        if (blk == 0 && !need_ctx) continue;
        const int scf = blk, scb = (blk == 0) ? 0 : 65 - blk;
        if (type == 0) { sc2::run<0, 1>(F, lane, wave, layer, b, h, 0, scf, scf == 0, 0); sc2::run<0, 2>(F, lane, wave, layer, b, h, 1, scb, scb == 0, 0); }
        else           { sc2::run<1, 1>(F, lane, wave, layer, b, h, 0, scf, scf == 0, 0); sc2::run<1, 2>(F, lane, wave, layer, b, h, 1, scb, scb == 0, 0); }
    }
}

namespace att {
constexpr int SLOT = 32768, NS = 3, WSF_OFF = NS * SLOT, OST_OFF = 0, OST_W = 32 * 68 * 4;
__device__ __forceinline__ int crow(int r, int hi) { return (r & 3) + 8 * (r >> 2) + 4 * hi; }
typedef short v4i16_t __attribute__((ext_vector_type(4)));
typedef LAS const char* lds_cptr;
__device__ __forceinline__ s16x4 vtr(lds_cptr p) { return __builtin_bit_cast(s16x4, __builtin_amdgcn_ds_read_tr16_b64_v4i16((LAS v4i16_t*)p)); }
__device__ __forceinline__ float max3f(float a, float b, float c) { return __builtin_fmaxf(__builtin_fmaxf(a, b), c); }
__device__ __forceinline__ float hmax32(const f32x16& p0, const f32x16& p1) {
    float a = max3f(p0[0], p0[1], p1[0]), b = max3f(p0[2], p0[3], p1[1]); a = max3f(a, p1[2], p1[3]);
#pragma unroll
    for (int r = 4; r < 16; r += 4) { a = max3f(a, p0[r], p0[r + 1]); b = max3f(b, p0[r + 2], p0[r + 3]); a = max3f(a, p1[r], p1[r + 1]); b = max3f(b, p1[r + 2], p1[r + 3]); }
    const float m = __builtin_fmaxf(a, b);
    auto rr = __builtin_amdgcn_permlane32_swap(__builtin_bit_cast(unsigned, m), __builtin_bit_cast(unsigned, m), false, false);
    return __builtin_fmaxf(__builtin_bit_cast(float, rr[0]), __builtin_bit_cast(float, rr[1]));
}
#define ATT_WAIT_BAR(N) asm volatile("s_waitcnt vmcnt(" #N ") lgkmcnt(0)\n\ts_barrier" ::: "memory")
template<int VAR>
__device__ __forceinline__ void attn_unit(Frame& F, int lane_in, int wid, int layer, int b, int h, bool isctx, int qb) {
    int lane = lane_in; asm volatile("" : "+v"(lane));
    const int r32 = lane & 31, hi = lane >> 5;
    LAS unsigned char* lds = F.lds; const unsigned lds0 = (unsigned)(uintptr_t)lds;
    const float* tab = (const float*)(F.ws + WS_TAB);
    const int qrow = qb * 256 + wid * 32 + r32;
    bf16x8 qr[2][2];
#pragma unroll
    for (int m = 0; m < 2; ++m) { const int mp = b * 8 + 2 * h + m;
        const bf16_t* qp = isctx ? (const bf16_t*)(F.ws + WS_QC) + ((size_t)mp * CL + qrow) * 32 : (const bf16_t*)(F.ws + WS_QA) + ((size_t)mp * T + qrow) * 32;
#pragma unroll
        for (int d0 = 0; d0 < 2; ++d0) qr[m][d0] = *(const bf16x8*)(qp + d0 * 16 + hi * 8); }
    const int NTL = isctx ? 2 : KT_TILES / 2;
    const bf16_t* ksrc = (const bf16_t*)(F.ws + WS_KA) + (size_t)((b * 8 + 2 * h + (wid >> 2)) * KT_TILES) * 2048 + (wid & 3) * 512;
    const unsigned char* vsrc = F.ws + WS_VA + (size_t)((b * 4 + h) * KT_TILES) * 4096 + (wid >> 2) * 4096 + (wid & 3) * 1024;
    const unsigned dma_off = (unsigned)lane * 16u;
#define ATT_DMA(t, slot) do { _Pragma("unroll") for (int sb_ = 0; sb_ < 2; ++sb_) \
                              ::glds16(ksrc + (size_t)(2 * (t) + sb_) * 2048, dma_off, (unsigned)__builtin_amdgcn_readfirstlane(lds0 + (slot) * SLOT + sb_ * 16384 + wid * 1024)); \
                              ::glds16(vsrc + (size_t)(t) * 8192, dma_off, (unsigned)__builtin_amdgcn_readfirstlane(lds0 + (slot) * SLOT + (wid >> 2) * 16384 + 8192 + (wid & 3) * 1024)); } while (0)
    LAS float* wsf = (LAS float*)(lds + WSF_OFF) + wid * 128;
    LAS float* ost = (LAS float*)(lds + OST_OFF + wid * OST_W);
    f32x16 o[2][2];
#pragma unroll
    for (int m = 0; m < 2; ++m)
#pragma unroll
        for (int d = 0; d < 2; ++d) o[m][d] = f32x16{};
    float mhat = 0.f;
    f32x16 lacc[2]; lacc[0] = f32x16{}; lacc[1] = f32x16{};
    v8i ones8; { int o8 = 0x38383838; asm volatile("" : "+v"(o8)); ones8 = (v8i){o8, o8, o8, o8, o8, o8, o8, o8}; }
    f32x16 negm = f32x16{};
    ATT_DMA(0, 0); ATT_DMA(1, 1);
    asm volatile("" : "+v"(qr[0][0]), "+v"(qr[0][1]), "+v"(qr[1][0]), "+v"(qr[1][1]));
    int slot = 0;
    for (int t = 0; t < NTL; ++t) {
        if (t + 1 < NTL) { ATT_WAIT_BAR(3); } else { ATT_WAIT_BAR(0); }
        if (t + 2 < NTL) { const int s2 = slot >= 1 ? slot - 1 : 2; ATT_DMA(t + 2, s2); }
#pragma unroll
        for (int sub = 0; sub < 2; ++sub) {
        const lds_cptr base = (lds_cptr)lds + slot * SLOT + sub * 16384;
        f32x16 p[2][2];
#pragma unroll
        for (int m = 0; m < 2; ++m) {
            const lds_cptr kb = base + m * 4096 + hi * 1024 + r32 * 16;
            const bf16x8 k00 = VAR == 4 ? qr[m][0] : *(const LAS bf16x8*)(kb), k01 = VAR == 4 ? qr[m][1] : *(const LAS bf16x8*)(kb + 512), k10 = VAR == 4 ? qr[1 - m][0] : *(const LAS bf16x8*)(kb + 2048), k11 = VAR == 4 ? qr[1 - m][1] : *(const LAS bf16x8*)(kb + 2048 + 512);
            p[m][0] = __builtin_amdgcn_mfma_f32_32x32x16_bf16(k00, qr[m][0], negm, 0, 0, 0);
            p[m][1] = __builtin_amdgcn_mfma_f32_32x32x16_bf16(k01, qr[m][0], negm, 0, 0, 0);
            p[m][0] = __builtin_amdgcn_mfma_f32_32x32x16_bf16(k10, qr[m][1], p[m][0], 0, 0, 0);
            p[m][1] = __builtin_amdgcn_mfma_f32_32x32x16_bf16(k11, qr[m][1], p[m][1], 0, 0, 0);
        }
        v8i vf[2];
        if (sub == 0 && (t & 1) == 0) {
          const float rm = __builtin_fmaxf(hmax32(p[0][0], p[0][1]), hmax32(p[1][0], p[1][1]));
          const bool first = (t == 0);
          if (first || __any(rm > 8.f)) {
              const float dl = first ? rm : fmaxf(rm, 0.f);
              mhat += dl;
#pragma unroll
              for (int r = 0; r < 16; ++r) { p[0][0][r] -= dl; p[0][1][r] -= dl; p[1][0][r] -= dl; p[1][1][r] -= dl; negm[r] = -mhat; }
              if (!first) {
                  const float f = __builtin_amdgcn_exp2f(-dl);
                  if (hi == 0) wsf[r32] = f;
                  LDS_WAIT();
#pragma unroll
                  for (int r = 0; r < 16; ++r) { const float fr_ = wsf[crow(r, hi)]; o[0][0][r] *= fr_; o[0][1][r] *= fr_; o[1][0][r] *= fr_; o[1][1][r] *= fr_; lacc[0][r] *= fr_; lacc[1][r] *= fr_; }
                  LDS_WAIT();
              }
          } }
#pragma unroll
        for (int m = 0; m < 2; ++m) {
            f32x16& p0 = p[m][0]; f32x16& p1 = p[m][1];
#pragma unroll
            for (int r = 0; r < 16; ++r) { p0[r] = __builtin_amdgcn_exp2f(p0[r]); p1[r] = __builtin_amdgcn_exp2f(p1[r]); }
            v8i pw;
#pragma unroll
            for (int q = 0; q < 4; ++q) { int w0_ = 0, w1_ = 0;
                w0_ = __builtin_amdgcn_cvt_pk_bf8_f32(p0[4 * q], p0[4 * q + 1], w0_, false); w0_ = __builtin_amdgcn_cvt_pk_bf8_f32(p0[4 * q + 2], p0[4 * q + 3], w0_, true);
                w1_ = __builtin_amdgcn_cvt_pk_bf8_f32(p1[4 * q], p1[4 * q + 1], w1_, false); w1_ = __builtin_amdgcn_cvt_pk_bf8_f32(p1[4 * q + 2], p1[4 * q + 3], w1_, true);
                pw[q] = w0_; pw[4 + q] = w1_; }
            if (m == 0) {
                const lds_cptr vp0 = base + 8192 + hi * 512 + r32 * 16;
#pragma unroll
                for (int d0 = 0; d0 < 2; ++d0) { const u32x4 lo = *(const LAS u32x4*)(vp0 + d0 * 1024), hh = *(const LAS u32x4*)(vp0 + d0 * 1024 + 2048);
                    vf[d0] = (v8i){(int)lo.x, (int)lo.y, (int)lo.z, (int)lo.w, (int)hh.x, (int)hh.y, (int)hh.z, (int)hh.w}; }
            }
#pragma unroll
            for (int d0 = 0; d0 < 2; ++d0) o[m][d0] = __builtin_amdgcn_mfma_scale_f32_32x32x64_f8f6f4(pw, vf[d0], o[m][d0], 1, 0, 0, 0x7F7F7F7F, 0, 0x7B7B7B7B);
            lacc[m] = __builtin_amdgcn_mfma_scale_f32_32x32x64_f8f6f4(pw, ones8, lacc[m], 1, 0, 0, 0x7F7F7F7F, 0, 0x7F7F7F7F);
        }
        }
        slot = slot == 2 ? 0 : slot + 1;
    }
    asm volatile("s_waitcnt lgkmcnt(0)\n\ts_barrier" ::: "memory");
    int lane_e = lane; asm volatile("" : "+v"(lane_e));
    const int r32e = lane_e & 31, hie = lane_e >> 5;
    const float lam = tab[TB_LAM + layer], oml = tab[TB_LAM + 2 + layer];
#pragma unroll
    for (int r = 0; r < 16; ++r) { const int qq = crow(r, hie); const float f0 = __builtin_amdgcn_rcpf(lacc[0][r]), f1 = -lam * __builtin_amdgcn_rcpf(lacc[1][r]);
#pragma unroll
        for (int d0 = 0; d0 < 2; ++d0) ost[qq * 68 + d0 * 32 + r32e] = o[0][d0][r] * f0 + o[1][d0][r] * f1; }
    LDS_WAIT();
    { const int rw = lane_e >> 1, hf = lane_e & 1; f32x4 xv[8]; float ss = 0.f;
#pragma unroll
      for (int j = 0; j < 8; ++j) { xv[j] = *(const LAS f32x4*)(ost + rw * 68 + hf * 32 + 4 * j); ss += (xv[j][0] * xv[j][0] + xv[j][1] * xv[j][1]) + (xv[j][2] * xv[j][2] + xv[j][3] * xv[j][3]); }
      ss += xor_swz<1>(ss);
      const float rs = __builtin_amdgcn_rsqf(ss * (1.f / 64.f) + EPS) * oml;
      const float* sw = F.in[13] + layer * 64 + hf * 32;
      const int qi = qb * 256 + wid * 32 + rw; const size_t orow = isctx ? (size_t)(NLAT + b * CL + qi) : (size_t)(b * T + qi);
      bf16_t* dst = (bf16_t*)(F.ws + WS_MIX) + orow * 1024 + 768 + h * 64 + hf * 32;
#pragma unroll
      for (int j = 0; j < 4; ++j) { const f32x4 a = xv[2 * j], c = xv[2 * j + 1]; const f32x4 wa = *(const f32x4*)(sw + 8 * j), wb = *(const f32x4*)(sw + 8 * j + 4);
          u32x4 w; w.x = pk2(a[0] * rs * wa[0], a[1] * rs * wa[1]); w.y = pk2(a[2] * rs * wa[2], a[3] * rs * wa[3]); w.z = pk2(c[0] * rs * wb[0], c[1] * rs * wb[1]); w.w = pk2(c[2] * rs * wb[2], c[3] * rs * wb[3]);
          *(u32x4*)(dst + 8 * j) = w; } }
    asm volatile("s_waitcnt lgkmcnt(0)\n\ts_barrier" ::: "memory");
#undef ATT_DMA
}

#define ATT_SBAR() __builtin_amdgcn_sched_barrier(0)
#define ATT_PIN(x) asm volatile("" : "+v"(x))
#define ATT_MFMA(a, b, c) __builtin_amdgcn_mfma_f32_32x32x16_bf16(a, b, c, 0, 0, 0)
#define ATT_VLD(D0, D1, vp, ks) do { const s16x4 l0_ = vtr((vp) + (ks) * 1024), h0_ = vtr((vp) + (ks) * 1024 + 512), l1_ = vtr((vp) + 4096 + (ks) * 1024), h1_ = vtr((vp) + 4096 + (ks) * 1024 + 512); \
                                     D0 = (bf16x8){l0_[0], l0_[1], l0_[2], l0_[3], h0_[0], h0_[1], h0_[2], h0_[3]}; D1 = (bf16x8){l1_[0], l1_[1], l1_[2], l1_[3], h1_[0], h1_[1], h1_[2], h1_[3]}; } while (0)
#define ATT_EP(X, e, W) do { X[e] = __builtin_amdgcn_exp2f(X[e]); X[(e) + 1] = __builtin_amdgcn_exp2f(X[(e) + 1]); W = trunc_pk_bf16(X[e], X[(e) + 1]); \
                             S.l[M] = __builtin_amdgcn_fdot2_f32_bf16(__builtin_bit_cast(bf16x2_t, W), __builtin_bit_cast(bf16x2_t, 0x3F803F80u), S.l[M], false); } while (0)
struct SpState { f32x16 o[2][2]; f32x16 negm; bf16x8 qr[2][2]; float mhat; float l[2]; };
template<int M>
__device__ __forceinline__ void half_step(SpState& S, f32x16& pa0, f32x16& pa1, f32x16& pb0, f32x16& pb1, u32x4 (&pwp)[4], u32x4 (&pwc)[4], bf16x8& vA0, bf16x8& vA1, bf16x8& vB0, bf16x8& vB1,
                                          lds_cptr vpp, lds_cptr vpn, lds_cptr kbn, bool chk, LAS float* wsfw, int lane) {
    constexpr int MP = 1 - M;
    if (chk) {
        const float rm = hmax32(pa0, pa1);
        if (__any(rm > 8.f)) {
            const int r32 = lane & 31, hi = lane >> 5;
#pragma unroll
            for (int ks = 0; ks < 4; ++ks) { if (ks == 2) ATT_VLD(vA0, vA1, vpp, 2); if (ks == 3) ATT_VLD(vB0, vB1, vpp, 3);
                S.o[MP][0] = ATT_MFMA(__builtin_bit_cast(bf16x8, pwp[ks]), (ks & 1) ? vB0 : vA0, S.o[MP][0]); S.o[MP][1] = ATT_MFMA(__builtin_bit_cast(bf16x8, pwp[ks]), (ks & 1) ? vB1 : vA1, S.o[MP][1]);
                pwp[ks] = (u32x4){0u, 0u, 0u, 0u}; }
            ATT_VLD(vA0, vA1, vpp, 0); ATT_VLD(vB0, vB1, vpp, 1);
            const float dl = fmaxf(rm, 0.f);
            S.mhat += dl;
#pragma unroll
            for (int r = 0; r < 16; ++r) { pa0[r] -= dl; pa1[r] -= dl; S.negm[r] = -S.mhat; }
            const float f = __builtin_amdgcn_exp2f(-dl);
            S.l[0] *= f; S.l[1] *= f;
            if (hi == 0) wsfw[r32] = f;
            LDS_WAIT();
#pragma unroll
            for (int r = 0; r < 16; ++r) { const float fr_ = wsfw[crow(r, hi)]; S.o[0][0][r] *= fr_; S.o[0][1][r] *= fr_; S.o[1][0][r] *= fr_; S.o[1][1][r] *= fr_; }
            LDS_WAIT();
        }
    }
    bf16x8 k00, k01, k10, k11;
    ATT_SBAR();
    S.o[MP][0] = ATT_MFMA(__builtin_bit_cast(bf16x8, pwp[0]), vA0, S.o[MP][0]); ATT_EP(pa0, 0, pwc[0][0]); ATT_PIN(pa0); ATT_PIN(pwc[0]); ATT_SBAR();
    S.o[MP][1] = ATT_MFMA(__builtin_bit_cast(bf16x8, pwp[0]), vA1, S.o[MP][1]); ATT_EP(pa0, 2, pwc[0][1]); ATT_EP(pa0, 4, pwc[0][2]); ATT_PIN(pa0); ATT_PIN(pwc[0]); ATT_SBAR();
    S.o[MP][0] = ATT_MFMA(__builtin_bit_cast(bf16x8, pwp[1]), vB0, S.o[MP][0]); ATT_VLD(vA0, vA1, vpp, 2); ATT_EP(pa0, 6, pwc[0][3]); ATT_PIN(pa0); ATT_PIN(pwc[0]); ATT_SBAR();
    S.o[MP][1] = ATT_MFMA(__builtin_bit_cast(bf16x8, pwp[1]), vB1, S.o[MP][1]); ATT_EP(pa0, 8, pwc[1][0]); ATT_EP(pa0, 10, pwc[1][1]); ATT_PIN(pa0); ATT_PIN(pwc[1]); ATT_SBAR();
    S.o[MP][0] = ATT_MFMA(__builtin_bit_cast(bf16x8, pwp[2]), vA0, S.o[MP][0]); ATT_VLD(vB0, vB1, vpp, 3); ATT_EP(pa0, 12, pwc[1][2]); ATT_PIN(pa0); ATT_PIN(pwc[1]); ATT_SBAR();
    S.o[MP][1] = ATT_MFMA(__builtin_bit_cast(bf16x8, pwp[2]), vA1, S.o[MP][1]); ATT_EP(pa0, 14, pwc[1][3]); ATT_EP(pa1, 0, pwc[2][0]); ATT_PIN(pa0); ATT_PIN(pa1); ATT_PIN(pwc[1]); ATT_PIN(pwc[2]); ATT_SBAR();
    S.o[MP][0] = ATT_MFMA(__builtin_bit_cast(bf16x8, pwp[3]), vB0, S.o[MP][0]); k00 = *(const LAS bf16x8*)(kbn); k10 = *(const LAS bf16x8*)(kbn + 2048); ATT_VLD(vA0, vA1, vpn, 0); ATT_EP(pa1, 2, pwc[2][1]); ATT_PIN(pa1); ATT_PIN(pwc[2]); ATT_SBAR();
    S.o[MP][1] = ATT_MFMA(__builtin_bit_cast(bf16x8, pwp[3]), vB1, S.o[MP][1]); k01 = *(const LAS bf16x8*)(kbn + 512); k11 = *(const LAS bf16x8*)(kbn + 2048 + 512); ATT_EP(pa1, 4, pwc[2][2]); ATT_EP(pa1, 6, pwc[2][3]); ATT_PIN(pa1); ATT_PIN(pwc[2]); ATT_SBAR();
    pb0 = ATT_MFMA(k00, S.qr[MP][0], S.negm); ATT_VLD(vB0, vB1, vpn, 1); ATT_EP(pa1, 8, pwc[3][0]); ATT_EP(pa1, 10, pwc[3][1]); ATT_PIN(pa1); ATT_PIN(pwc[3]); ATT_SBAR();
    pb0 = ATT_MFMA(k10, S.qr[MP][1], pb0); ATT_EP(pa1, 12, pwc[3][2]); ATT_EP(pa1, 14, pwc[3][3]); ATT_PIN(pa1); ATT_PIN(pwc[3]); ATT_SBAR();
    pb1 = ATT_MFMA(k01, S.qr[MP][0], S.negm); ATT_SBAR();
    pb1 = ATT_MFMA(k11, S.qr[MP][1], pb1); ATT_SBAR();
}
__device__ __forceinline__ void attn_unit_sp(Frame& F, int lane_in, int wid, int layer, int b, int h, bool isctx, int qb) {
    constexpr int NS4 = 4, WSF4 = NS4 * SLOT;
    int lane = lane_in; asm volatile("" : "+v"(lane));
    const int r32 = lane & 31, hi = lane >> 5;
    LAS unsigned char* lds = F.lds; const unsigned lds0 = (unsigned)(uintptr_t)lds;
    const float* tab = (const float*)(F.ws + WS_TAB);
    const int qrow = qb * 256 + wid * 32 + r32;
    SpState S;
#pragma unroll
    for (int m = 0; m < 2; ++m) { const int mp = b * 8 + 2 * h + m;
        const bf16_t* qp = isctx ? (const bf16_t*)(F.ws + WS_QC) + ((size_t)mp * CL + qrow) * 32 : (const bf16_t*)(F.ws + WS_QA) + ((size_t)mp * T + qrow) * 32;
#pragma unroll
        for (int d0 = 0; d0 < 2; ++d0) S.qr[m][d0] = *(const bf16x8*)(qp + d0 * 16 + hi * 8); }
    const int NTL = isctx ? 2 : KT_TILES / 2;
    const bf16_t* ksrc = (const bf16_t*)(F.ws + WS_KA) + (size_t)((b * 8 + 2 * h + (wid >> 2)) * KT_TILES) * 2048 + (wid & 3) * 512;
    const bf16_t* vsrc = (const bf16_t*)(F.ws + WS_VA) + (size_t)((b * 4 + h) * KT_TILES) * 4096 + wid * 512;
    const unsigned dma_off = (unsigned)lane * 16u;
#define ATT_DMA4(t, slot) do { _Pragma("unroll") for (int sb_ = 0; sb_ < 2; ++sb_) { \
                              ::glds16(ksrc + (size_t)(2 * (t) + sb_) * 2048, dma_off, (unsigned)__builtin_amdgcn_readfirstlane(lds0 + (slot) * SLOT + sb_ * 16384 + wid * 1024)); \
                              ::glds16(vsrc + (size_t)(2 * (t) + sb_) * 4096, dma_off, (unsigned)__builtin_amdgcn_readfirstlane(lds0 + (slot) * SLOT + sb_ * 16384 + 8192 + wid * 1024)); } } while (0)
    LAS float* wsf = (LAS float*)(lds + WSF4) + wid * 128;
    LAS float* ost = (LAS float*)(lds + OST_OFF + wid * OST_W);
#pragma unroll
    for (int m = 0; m < 2; ++m) { S.o[m][0] = f32x16{}; S.o[m][1] = f32x16{}; S.l[m] = 0.f; }
    S.mhat = 0.f; S.negm = f32x16{};
    ATT_DMA4(0, 0); if (NTL > 1) ATT_DMA4(1, 1);
    asm volatile("" : "+v"(S.qr[0][0]), "+v"(S.qr[0][1]), "+v"(S.qr[1][0]), "+v"(S.qr[1][1]));
    const int koff = hi * 1024 + r32 * 16;
    const int voff = 8192 + ((lane >> 4) & 1) * 32 + (lane & 3) * 8 + (4 * hi + ((lane & 15) >> 2)) * 64;
    ATT_WAIT_BAR(4);
    f32x16 pa0, pa1, pb0, pb1; u32x4 pwx[4], pwy[4]; bf16x8 vA0, vA1, vB0, vB1;
    {
        const lds_cptr kb = (lds_cptr)lds + koff;
        const bf16x8 k00 = *(const LAS bf16x8*)(kb), k01 = *(const LAS bf16x8*)(kb + 512), k10 = *(const LAS bf16x8*)(kb + 2048), k11 = *(const LAS bf16x8*)(kb + 2048 + 512);
        pa0 = ATT_MFMA(k00, S.qr[0][0], S.negm); pa1 = ATT_MFMA(k01, S.qr[0][0], S.negm); pa0 = ATT_MFMA(k10, S.qr[0][1], pa0); pa1 = ATT_MFMA(k11, S.qr[0][1], pa1);
        const float rm = hmax32(pa0, pa1); S.mhat = rm;
#pragma unroll
        for (int r = 0; r < 16; ++r) { pa0[r] -= rm; pa1[r] -= rm; S.negm[r] = -rm; }
        ATT_VLD(vA0, vA1, (lds_cptr)lds + voff, 0); ATT_VLD(vB0, vB1, (lds_cptr)lds + voff, 1);
#pragma unroll
        for (int k = 0; k < 4; ++k) pwx[k] = (u32x4){0u, 0u, 0u, 0u};
    }
    for (int t = 0; t < NTL; ++t) {
        ATT_WAIT_BAR(0);
        if (t + 2 < NTL) ATT_DMA4(t + 2, (t + 2) & 3);
        const lds_cptr tb = (lds_cptr)lds + (t & 3) * SLOT, tn = (lds_cptr)lds + ((t + 1) & 3) * SLOT, tp = (lds_cptr)lds + ((t == 0 ? 0 : t - 1) & 3) * SLOT + (t == 0 ? 0 : 16384);
        const bool chk = (t & 1) == 0;
        half_step<0>(S, pa0, pa1, pb0, pb1, pwx, pwy, vA0, vA1, vB0, vB1, tp + voff,         tb + voff,         tb + 4096 + koff,         chk && t > 0, wsf, lane);
        half_step<1>(S, pb0, pb1, pa0, pa1, pwy, pwx, vA0, vA1, vB0, vB1, tb + voff,         tb + voff,         tb + 16384 + koff,        chk,          wsf, lane);
        half_step<0>(S, pa0, pa1, pb0, pb1, pwx, pwy, vA0, vA1, vB0, vB1, tb + voff,         tb + 16384 + voff, tb + 16384 + 4096 + koff, false,        wsf, lane);
        half_step<1>(S, pb0, pb1, pa0, pa1, pwy, pwx, vA0, vA1, vB0, vB1, tb + 16384 + voff, tb + 16384 + voff, tn + koff,                false,        wsf, lane);
    }
    {
        const lds_cptr vpl = (lds_cptr)lds + ((NTL - 1) & 3) * SLOT + 16384 + voff;
#pragma unroll
        for (int ks = 0; ks < 4; ++ks) { if (ks == 2) ATT_VLD(vA0, vA1, vpl, 2); if (ks == 3) ATT_VLD(vB0, vB1, vpl, 3);
            S.o[1][0] = ATT_MFMA(__builtin_bit_cast(bf16x8, pwx[ks]), (ks & 1) ? vB0 : vA0, S.o[1][0]); S.o[1][1] = ATT_MFMA(__builtin_bit_cast(bf16x8, pwx[ks]), (ks & 1) ? vB1 : vA1, S.o[1][1]); }
    }
    { const float l0 = S.l[0] + xor32(S.l[0], lane), l1 = S.l[1] + xor32(S.l[1], lane);
      if (hi == 0) { wsf[r32] = __builtin_amdgcn_rcpf(l0); wsf[32 + r32] = __builtin_amdgcn_rcpf(l1); } }
    asm volatile("s_waitcnt lgkmcnt(0)\n\ts_barrier" ::: "memory");
    int lane_e = lane; asm volatile("" : "+v"(lane_e));
    const int r32e = lane_e & 31, hie = lane_e >> 5;
    const float lam = tab[TB_LAM + layer], oml = tab[TB_LAM + 2 + layer];
#pragma unroll
    for (int r = 0; r < 16; ++r) { const int qq = crow(r, hie); const float f0 = wsf[qq], f1 = -lam * wsf[32 + qq];
#pragma unroll
        for (int d0 = 0; d0 < 2; ++d0) ost[qq * 68 + d0 * 32 + r32e] = S.o[0][d0][r] * f0 + S.o[1][d0][r] * f1; }
    LDS_WAIT();
    { const int rw = lane_e >> 1, hf = lane_e & 1; f32x4 xv[8]; float ss = 0.f;
#pragma unroll
      for (int j = 0; j < 8; ++j) { xv[j] = *(const LAS f32x4*)(ost + rw * 68 + hf * 32 + 4 * j); ss += (xv[j][0] * xv[j][0] + xv[j][1] * xv[j][1]) + (xv[j][2] * xv[j][2] + xv[j][3] * xv[j][3]); }
      ss += xor_swz<1>(ss);
      const float rs = __builtin_amdgcn_rsqf(ss * (1.f / 64.f) + EPS) * oml;
      const float* sw = F.in[13] + layer * 64 + hf * 32;
      const int qi = qb * 256 + wid * 32 + rw; const size_t orow = isctx ? (size_t)(NLAT + b * CL + qi) : (size_t)(b * T + qi);
      bf16_t* dst = (bf16_t*)(F.ws + WS_MIX) + orow * 1024 + 768 + h * 64 + hf * 32;
#pragma unroll
      for (int j = 0; j < 4; ++j) { const f32x4 a = xv[2 * j], c = xv[2 * j + 1]; const f32x4 wa = *(const f32x4*)(sw + 8 * j), wb = *(const f32x4*)(sw + 8 * j + 4);
          u32x4 w; w.x = pk2(a[0] * rs * wa[0], a[1] * rs * wa[1]); w.y = pk2(a[2] * rs * wa[2], a[3] * rs * wa[3]); w.z = pk2(c[0] * rs * wb[0], c[1] * rs * wb[1]); w.w = pk2(c[2] * rs * wb[2], c[3] * rs * wb[3]);
          *(u32x4*)(dst + 8 * j) = w; } }
    asm volatile("s_waitcnt lgkmcnt(0)\n\ts_barrier" ::: "memory");
#undef ATT_DMA4
}
}
template<int VAR>
__device__ __forceinline__ void phase_attn(Frame& F, int layer, int ulo, int uhi) {
    PHASE_IDS();
    __syncthreads();
    const int nunits = 512 + (layer == 0 ? 8 : 0);
    for (int u = blk_; u < nunits && u < uhi; u += F.G) {
        if (u < ulo) continue;
        if (u < 512) { const int bh = u & 7, qb = u >> 3; att::attn_unit<VAR>(F, lane, wave, layer, bh >> 2, bh & 3, false, qb); }
        else { const int bh = u - 512; att::attn_unit<VAR>(F, lane, wave, layer, bh >> 2, bh & 3, true, 0); }
    }
}

__device__ __forceinline__ void phase_route(Frame& F, int layer) {
    PHASE_IDS();
    const int wid = wave, G = F.G, blk = blk_;
    const int nrows = layer == 0 ? NROW : NLAT;
    constexpr int TP = 2064;
    LAS unsigned char* Th = F.lds; LAS unsigned char* Tl = F.lds + 16 * TP; LAS float* Pp = (LAS float*)(F.lds + 32 * TP);
    LAS int* hist = (LAS int*)(F.lds + LDS_TAB); LAS int* sbase = hist + 32; LAS unsigned* ent = (LAS unsigned*)(hist + 64); LAS float* entg = (LAS float*)(ent + 640);
    for (int i = tid; i < 64 + 640; i += NTHR) hist[i] = (i < 64) ? 0 : -1;
    LAS float* mv = (LAS float*)(F.lds + 32 * TP + 16384);
    { const float* mg = (const float*)(F.ws + WS_MODV) + (size_t)layer * 3 * 6 * 1024;
      for (int i = tid; i < 9 * 256; i += NTHR) { const int v = i >> 8, c4 = i & 255; *(LAS f32x4*)(mv + v * 1024 + 4 * c4) = *(const f32x4*)(mg + (size_t)((v / 3) * 6 + 2 + (v % 3)) * 1024 + 4 * c4); } }
    bf16x8 bh[4][2], bl[4][2];
    { const bf16_t* rwh = (const bf16_t*)(F.ws + WS_RWT) + (size_t)layer * 32768; const bf16_t* rwl = rwh + 2 * 32768;
#pragma unroll
      for (int ks = 0; ks < 4; ++ks)
#pragma unroll
        for (int nb = 0; nb < 2; ++nb) { const int o_ = (16 * nb + (lane & 15)) * 1024 + 128 * wid + 32 * ks + 8 * (lane >> 4); bh[ks][nb] = *(const bf16x8*)(rwh + o_); bl[ks][nb] = *(const bf16x8*)(rwl + o_); } }
    __syncthreads();
    const float* modv = (const float*)(F.ws + WS_MODV) + (size_t)layer * 3 * 6 * 1024;
    const bf16_t* yb = (const bf16_t*)(F.ws + WS_Y);
    float* x1b = (float*)(F.ws + WS_X1);
    const int nloc = (nrows - blk + G - 1) / G;
    const float rbias = F.in[16][layer * 32 + (lane & 31)];
    const int nbatch = (nloc + 15) >> 4;
    for (int it = 0; it < nbatch; ++it) { const int i0 = 16 * it + 2 * wid;
        f32x4 tk[2][4]; bool val[2];
#pragma unroll
        for (int q = 0; q < 2; ++q) {
            const int il = i0 + q; val[q] = il < nloc; const int r = val[q] ? blk + il * G : blk;
            const int w = row_which(r);
            const float* xs = (layer == 0) ? (r < NLAT ? F.in[0] + (size_t)r * D : F.in[2] + (size_t)(r - NLAT) * D) : x1b + (size_t)r * D;
            f32x4 x[4], y[4]; row_load(xs, lane, x);
#pragma unroll
            for (int j = 0; j < 4; ++j) { const u32x2 yy = *(const u32x2*)(yb + (size_t)r * D + 4 * lane + 256 * j); y[j] = (f32x4){bflo(yy.x), bfhi(yy.x), bflo(yy.y), bfhi(yy.y)}; }
            const float ry = __builtin_amdgcn_rsqf(row_sumsq(y) * (1.f / 1024.f) + EPS);
            const LAS float* c1 = mv + (w * 3 + 0) * 1024;
#pragma unroll
            for (int j = 0; j < 4; ++j) { const f32x4 cv = *(const LAS f32x4*)(c1 + 4 * lane + 256 * j); x[j] = x[j] + cv * (y[j] * ry); }
            if (val[q]) row_store(x1b + (size_t)r * D, lane, x);
            { const float rr_ = __builtin_amdgcn_rsqf(row_sumsq(x) * (1.f / 1024.f) + EPS); const LAS float* at_ = mv + (w * 3 + 1) * 1024; const LAS float* bt_ = mv + (w * 3 + 2) * 1024;
#pragma unroll
              for (int j = 0; j < 4; ++j) { const f32x4 av = *(const LAS f32x4*)(at_ + 4 * lane + 256 * j), bv = *(const LAS f32x4*)(bt_ + 4 * lane + 256 * j); tk[q][j] = x[j] * rr_ * av + bv; } }
            if (val[q]) {
                unsigned char* t8 = F.ws + WS_TOK8 + (size_t)r * D;
#pragma unroll
                for (int j = 0; j < 4; ++j) *(unsigned*)(t8 + 4 * lane + 256 * j) = pk4_fp8(tk[q][j][0], tk[q][j][1], tk[q][j][2], tk[q][j][3]); }
        }
#pragma unroll
        for (int q = 0; q < 2; ++q)
#pragma unroll
            for (int j = 0; j < 4; ++j) { unsigned hb[4], lb[4];
#pragma unroll
                for (int c = 0; c < 4; ++c) { hb[c] = f2bf(tk[q][j][c]); lb[c] = f2bf(tk[q][j][c] - __builtin_bit_cast(float, hb[c] << 16)); }
                const int off = (2 * wid + q) * TP + (4 * lane + 256 * j) * 2;
                *(LAS u32x2*)(Th + off) = (u32x2){hb[0] | (hb[1] << 16), hb[2] | (hb[3] << 16)}; *(LAS u32x2*)(Tl + off) = (u32x2){lb[0] | (lb[1] << 16), lb[2] | (lb[3] << 16)}; }
        __syncthreads();
        { f32x4 pacc[2]; pacc[0] = (f32x4){0.f, 0.f, 0.f, 0.f}; pacc[1] = pacc[0];
#pragma unroll
          for (int ks = 0; ks < 4; ++ks) { const int ao = (lane & 15) * TP + (128 * wid + 32 * ks + 8 * (lane >> 4)) * 2;
              const bf16x8 ah = *(const LAS bf16x8*)(Th + ao), al = *(const LAS bf16x8*)(Tl + ao);
#pragma unroll
              for (int nb = 0; nb < 2; ++nb) { pacc[nb] = __builtin_amdgcn_mfma_f32_16x16x32_bf16(ah, bh[ks][nb], pacc[nb], 0, 0, 0); pacc[nb] = __builtin_amdgcn_mfma_f32_16x16x32_bf16(al, bh[ks][nb], pacc[nb], 0, 0, 0);
                                               pacc[nb] = __builtin_amdgcn_mfma_f32_16x16x32_bf16(ah, bl[ks][nb], pacc[nb], 0, 0, 0); } }
#pragma unroll
          for (int nb = 0; nb < 2; ++nb)
#pragma unroll
              for (int r = 0; r < 4; ++r) Pp[(wid * 16 + 4 * (lane >> 4) + r) * 32 + 16 * nb + (lane & 15)] = pacc[nb][r]; }
        __syncthreads();
        float lg = 0.f;
#pragma unroll
        for (int w8 = 0; w8 < 8; ++w8) lg += Pp[(w8 * 16 + 2 * wid + (lane >> 5)) * 32 + (lane & 31)];
        lg += rbias;
#ifdef DBG_CHECK
        { const int q_ = lane >> 5; if (q_ == 0 ? val[0] : val[1]) ((float*)(F.ws + WS_END + 65536))[(size_t)(blk + (i0 + q_) * G) * 32 + (lane & 31)] = lg; }
#endif
        float tv[4]; int te[4];
#pragma unroll
        for (int k = 0; k < 4; ++k) {
            float m = lg;
            m = fmaxf(m, xor_swz<16>(m)); m = fmaxf(m, xor_swz<8>(m)); m = fmaxf(m, xor_swz<4>(m)); m = fmaxf(m, xor_swz<2>(m)); m = fmaxf(m, xor_swz<1>(m));
            const unsigned long long bal = __ballot(lg == m);
            const unsigned hb = (lane & 32) ? (unsigned)(bal >> 32) : (unsigned)bal;
            const int idx = __builtin_ctz(hb);
            tv[k] = m; te[k] = idx;
            if ((lane & 31) == idx) lg = -INFINITY;
        }
        float g[4]; { float s = 0.f;
#pragma unroll
            for (int k = 0; k < 4; ++k) { g[k] = __expf(tv[k] - tv[0]); s += g[k]; }
            const float inv = 1.f / s;
#pragma unroll
            for (int k = 0; k < 4; ++k) g[k] *= inv; }
        const int q = lane >> 5, k = lane & 31;
        if (k < 4 && (q == 0 ? val[0] : val[1])) {
            const int il = i0 + q; const int r = blk + il * G;
            const int ee = (k == 0) ? te[0] : (k == 1) ? te[1] : (k == 2) ? te[2] : te[3];
            const float gg = (k == 0) ? g[0] : (k == 1) ? g[1] : (k == 2) ? g[2] : g[3];
            entg[il * 4 + k] = gg;
            const int lp = __hip_atomic_fetch_add(hist + ee, 1, __ATOMIC_RELAXED, __HIP_MEMORY_SCOPE_WORKGROUP);
            ent[il * 4 + k] = (unsigned)ee | ((unsigned)lp << 8);
        }
    }
    __syncthreads();
    if (tid < 32) sbase[tid] = (int)__hip_atomic_fetch_add((unsigned*)F.ctl + CW_CNT + layer * 32 + tid, (unsigned)hist[tid], __ATOMIC_RELAXED, __HIP_MEMORY_SCOPE_AGENT);
    __syncthreads();
    int* slot = (int*)(F.ws + WS_SLOT);
    for (int i = tid; i < nloc * 4; i += NTHR) { const unsigned en = ent[i]; if (en != 0xffffffffu) { const int e = en & 255, pos = sbase[e] + (int)(en >> 8); const int r = blk + (i >> 2) * G;
        slot[e * CAP + pos] = r * 4 + (i & 3); ((float*)(F.ws + WS_SGATE))[e * CAP + pos] = entg[i]; ((int*)(F.ws + WS_GATE))[r * 4 + (i & 3)] = e | (pos << 8); } }
    __syncthreads();
}
__device__ __forceinline__ void moe_tables(Frame& F, int layer) {
    PHASE_IDS();
    LAS int* tab = (LAS int*)(F.lds + LDS_TAB);
    if (tid == 0) { int acc = 0;
        for (int e = 0; e < 32; ++e) { const int c = (int)__hip_atomic_load((unsigned*)F.ctl + CW_CNT + layer * 32 + e, __ATOMIC_RELAXED, __HIP_MEMORY_SCOPE_AGENT); tab[e] = acc; tab[33 + e] = c; acc += (c + 255) >> 8; }
        tab[32] = acc; }
    __syncthreads();
}
__device__ __forceinline__ void phase_combine(Frame& F, int layer) {
    PHASE_IDS();
    const int gw = blk_ * NWAVES + wave, NGW = F.G * NWAVES;
    const int nrows = layer == 0 ? NROW : NLAT;
    const bf16_t* yk = (const bf16_t*)(F.ws + WS_YK); float* x1b = (float*)(F.ws + WS_X1);
    LAS float* mv = (LAS float*)F.lds;
    { const float* mg = (const float*)(F.ws + WS_MODV);
      for (int i = tid; i < 9 * 256; i += NTHR) { const int v = i >> 8, c4 = i & 255, w = v / 3, k = v % 3;
          const float* src = (k == 0) ? mg + (size_t)((layer * 3 + w) * 6 + 5) * 1024 : mg + (size_t)((1 * 3 + w) * 6 + (k - 1)) * 1024;
          *(LAS f32x4*)(mv + v * 1024 + 4 * c4) = *(const f32x4*)(src + 4 * c4); } }
    moe_tables(F, layer);
    const LAS int* ttab = (const LAS int*)(F.lds + LDS_TAB); const int* epos = (const int*)(F.ws + WS_GATE);
    int epn[4];
#pragma unroll
    for (int k = 0; k < 4; ++k) epn[k] = (gw < nrows) ? epos[gw * 4 + k] : 0;
    for (int r = gw; r < nrows; r += NGW) {
        const int w = row_which(r);
        int srow[4];
#pragma unroll
        for (int k = 0; k < 4; ++k) { const int ep = __builtin_amdgcn_readfirstlane(epn[k]); srow[k] = 256 * ttab[ep & 255] + (ep >> 8); }
        if (r + NGW < nrows) {
#pragma unroll
            for (int k = 0; k < 4; ++k) epn[k] = epos[(r + NGW) * 4 + k];
        }
        f32x4 x[4]; row_load(x1b + (size_t)r * D, lane, x);
        f32x4 f[4];
#pragma unroll
        for (int j = 0; j < 4; ++j) f[j] = (f32x4){0.f, 0.f, 0.f, 0.f};
#pragma unroll
        for (int k = 0; k < 4; ++k)
#pragma unroll
            for (int j = 0; j < 4; ++j) { const u32x2 u = *(const u32x2*)(yk + (size_t)srow[k] * D + 4 * lane + 256 * j); f[j][0] += bflo(u.x); f[j][1] += bfhi(u.x); f[j][2] += bflo(u.y); f[j][3] += bfhi(u.y); }
        const float rf = __builtin_amdgcn_rsqf(row_sumsq(f) * (1.f / 1024.f) + EPS);
        const LAS float* c2 = mv + (w * 3 + 0) * 1024;
#pragma unroll
        for (int j = 0; j < 4; ++j) { const f32x4 cv = *(const LAS f32x4*)(c2 + 4 * lane + 256 * j); x[j] = x[j] + cv * (f[j] * rf); }
        if (layer == 1) row_store(F.out + (size_t)r * D, lane, x);
        else { row_store(x1b + (size_t)r * D, lane, x);
            const float rr_ = __builtin_amdgcn_rsqf(row_sumsq(x) * (1.f / 1024.f) + EPS); const LAS float* ah_ = mv + (w * 3 + 1) * 1024; const LAS float* bh_ = mv + (w * 3 + 2) * 1024;
            f32x4 o[4];
#pragma unroll
            for (int j = 0; j < 4; ++j) { const f32x4 av = *(const LAS f32x4*)(ah_ + 4 * lane + 256 * j), bv = *(const LAS f32x4*)(bh_ + 4 * lane + 256 * j); o[j] = x[j] * rr_ * av + bv; }
            row_store_bf16((bf16_t*)(F.ws + WS_H) + (size_t)r * D, lane, o); }
    }
}

struct Args { const float* in[21]; float* out; unsigned char* ws; int ph_lo, ph_hi; };
constexpr int PH_PER_LAYER = 10, NPHASE = 2 + 2 * PH_PER_LAYER;
__global__ void __launch_bounds__(NTHR, 2) mk_fwd(Args args) {
    extern __shared__ __attribute__((aligned(16))) unsigned char lds_raw[];
    Frame F;
    F.lds = (LAS unsigned char*)lds_raw; F.ws = args.ws; F.out = args.out;
#pragma unroll
    for (int i = 0; i < 21; ++i) F.in[i] = args.in[i];
    F.ctl = (gu32*)(args.ws + WS_CTL);
    __builtin_amdgcn_s_setreg(1473, 1);
    F.tid = threadIdx.x; F.lane = F.tid & 63; F.wave = __builtin_amdgcn_readfirstlane(F.tid >> 6); F.G = gridDim.x; F.blk = blockIdx.x;
    volatile LAS unsigned* misc = (volatile LAS unsigned*)(F.lds + LDS_MISC);
    if (F.tid < 16) misc[F.tid] = 0u;
    __syncthreads();
    const int lo = args.ph_lo, hi = args.ph_hi;
    const bool use_bar = (hi - lo) > 1;
    XcdBarrier bar; bar.bar = (unsigned*)F.ctl + CW_BAR; bar.x = 0; bar.st = nullptr;
    if (use_bar) { bar = xcd_barrier_post((unsigned*)F.ctl + CW_BAR, misc + 8); if (F.tid == 0) xcd_barrier_census(bar); }
#define IN(k) (lo <= (k) && (k) < hi)
#define SEAM(k) do { if (IN(k) && IN((k) + 1)) xcd_barrier(bar); } while (0)
    if (PHON(0) && IN(0)) { for (int rep = 0; rep < NREP(0); ++rep) phase_prologue_a(F); } SEAM(0);
    if (PHON(1) && IN(1)) { for (int rep = 0; rep < NREP(1); ++rep) phase_prologue_b(F); } SEAM(1);
    for (int layer = 0; layer < 2; ++layer) {
        const int p0 = 2 + layer * PH_PER_LAYER;
        unsigned char* ws = F.ws;
        int blk_ = F.blk; asm volatile("" : "+s"(blk_));
        if (PHON(2) && IN(p0 + 0)) {
            pg8::DenseSched S; S.init(ws + WS_H, (bf16_t*)(ws + WS_WIN) + (size_t)layer * NIN * 1024, NROW, NIN, F.G, blk_);
            EpiInProj E{ws, (const float*)(ws + WS_TAB), (const float*)(ws + WS_ROPE), layer};
            for (int rep = 0; rep < NREP(2); ++rep) pg8::gemm_phase<EpiInProj, pg8::DenseSched, false>(F.lds, F.wave, S, E);
        } SEAM(p0 + 0);
        if (PHON(3) && IN(p0 + 1)) { for (int rep = 0; rep < NREP(3); ++rep) phase_scan2_a(F, layer); if (ATTVAR >= 0) phase_attn<(ATTVAR >= 0 ? ATTVAR : 0)>(F, layer, 0, F.G); phase_attn<0>(F, layer, 0, F.G); } SEAM(p0 + 1);
        if (PHON(4) && IN(p0 + 2)) { for (int rep = 0; rep < NREP(4); ++rep) phase_scan_b(F); } SEAM(p0 + 2);
        if (PHON(5) && IN(p0 + 3)) { for (int rep = 0; rep < NREP(5); ++rep) phase_scan2_c(F, layer); if (ATTVAR >= 0) phase_attn<(ATTVAR >= 0 ? ATTVAR : 0)>(F, layer, F.G, 1 << 30); phase_attn<0>(F, layer, F.G, 1 << 30); } SEAM(p0 + 3);
          if (IN(p0 + 4) && IN(p0 + 5) && !IN(p0 + 3)) xcd_barrier(bar);
        if (PHON(7) && IN(p0 + 5)) {
            pg8::DenseSched S; S.init(ws + WS_MIX, (bf16_t*)(ws + WS_WOUT) + (size_t)layer * 1024 * 1024, layer == 0 ? NROW : NLAT, 1024, F.G, blk_);
            EpiBf16Out E{(bf16_t*)(ws + WS_Y)};
            for (int rep = 0; rep < NREP(7); ++rep) pg8::gemm_phase<EpiBf16Out, pg8::DenseSched, false>(F.lds, F.wave, S, E);
        } SEAM(p0 + 5);
        if (PHON(8) && IN(p0 + 6)) { phase_route(F, layer); } SEAM(p0 + 6);
        if (PHON(9) && IN(p0 + 7)) {
            moe_tables(F, layer);
            pg8::MoeSched<8, true, 1024> S{(const char*)(ws + WS_TOK8), (const char*)(ws + WS_W1 + (size_t)layer * NE * 2048 * 1024), (const int*)(ws + WS_SLOT), (const LAS int*)(F.lds + LDS_TAB), F.G, blk_, (size_t)2048 * 1024};
            EpiSwiglu E{ws + WS_ACT, F.in[18] + (size_t)layer * NE * 2048};
            for (int rep = 0; rep < NREP(9); ++rep) pg8::gemm_phase<EpiSwiglu, pg8::MoeSched<8, true, 1024>, true, true>(F.lds, F.wave, S, E);
        } SEAM(p0 + 7);
        if (PHON(10) && IN(p0 + 8)) {
            moe_tables(F, layer);
            pg8::MoeSched<4, false, 1024> S{(const char*)(ws + WS_ACT), (const char*)(ws + WS_W2 + (size_t)layer * NE * 1024 * 1024), (const int*)(ws + WS_SLOT), (const LAS int*)(F.lds + LDS_TAB), F.G, blk_, (size_t)1024 * 1024};
            EpiMoeOut E{(bf16_t*)(ws + WS_YK), F.in[20] + (size_t)layer * NE * 1024, (const float*)(ws + WS_SGATE)};
            for (int rep = 0; rep < NREP(10); ++rep) pg8::gemm_phase<EpiMoeOut, pg8::MoeSched<4, false, 1024>, false, true>(F.lds, F.wave, S, E);
        } SEAM(p0 + 8);
        if (PHON(11) && IN(p0 + 9)) { phase_combine(F, layer); } SEAM(p0 + 9);
    }
#ifdef OVFL_PROBE
    int lane_z; asm volatile("v_mbcnt_lo_u32_b32 %0, -1, 0\n\tv_mbcnt_hi_u32_b32 %0, -1, %0" : "=v"(lane_z));
    if (hi == NPHASE && F.blk == 0 && F.wave == 0 && lane_z == 0) { int w = 0; float big = 1e6f, huge = 3e38f; asm volatile("" : "+v"(big), "+v"(huge));
      w = __builtin_amdgcn_cvt_pk_bf8_f32(big, huge, w, false); int w2 = 0; w2 = __builtin_amdgcn_cvt_pk_fp8_f32(big, huge, w2, false);
      if (((w & 0xffff) != 0x7B7B) || ((w2 & 0xffff) != 0x7E7E)) { asm volatile("s_waitcnt vmcnt(0)" ::: "memory"); F.out[5] = __builtin_nanf(""); } }
#endif
#undef IN
#undef SEAM
}


#ifdef DBG_CHECK
namespace dbg {
__device__ float blk_sum(float v, float* red) { const int t = threadIdx.x; red[t] = v; __syncthreads(); for (int o = 128; o > 0; o >>= 1) { if (t < o) red[t] += red[t + o]; __syncthreads(); } const float r = red[0]; __syncthreads(); return r; }
struct Ctx { const float* const* in; unsigned char* ws; float* red; };
__device__ float bfb(const unsigned char* ws, size_t off, size_t idx) { return bf2f(((const bf16_t*)(ws + off))[idx]); }
__device__ float zdot(const Ctx& c, int row, int ocol) {
    float a = 0.f; for (int k = threadIdx.x; k < 1024; k += 256) a += bfb(c.ws, WS_H, (size_t)row * 1024 + k) * c.in[7][(size_t)k * 4224 + ocol];
    return blk_sum(a, c.red);
}
__device__ void upd(float* flag, float got, float want) { const float e = fabsf(got - want) / (fabsf(want) + 0.05f); if (threadIdx.x == 0 && (e > *flag || !(e == e))) *flag = (e == e) ? e : 1e9f; }
__device__ float sc_buf(const Ctx& c, int which, int row, int col) { return bfb(c.ws, WS_SCAN + (size_t)which * SCAN_PITCH, (size_t)row * 384 + col); }
__device__ void naive_scan(const Ctx& c, const float* tab, int type, int b, int h, int dir, int n, float* S, float* o64) {
    const int t = threadIdx.x;
    for (int i = t; i < 4096; i += 256) S[i] = 0.f; __syncthreads();
    const float gam = tab[TB_GAM + 0 * 12 + dir * 6 + h];
    int lastrow = 0;
    for (int p = 0; p < n; ++p) {
        const int sc = p < 256 ? 0 : 1 + (p - 256) / 256, pl = p < 256 ? p : (p - 256) % 256; const int row = scan_row(sc, pl, dir, 0) + (sc == 0 ? b * CL : b * T); lastrow = row;
        for (int i = t; i < 4096; i += 256) { const int k = i >> 6, v = i & 63;
            const float kk = sc_buf(c, type ? SC_RK : (dir ? SC_KB : SC_KF), row, h * 64 + k), vv = sc_buf(c, type ? SC_RV : SC_HV, row, h * 64 + v);
            const float f = type ? gam : 1.f - kk; S[i] = f * S[i] + kk * vv; }
        __syncthreads();
    }
    if (t < 64) { float o = 0.f; for (int k = 0; k < 64; ++k) o += sc_buf(c, type ? SC_RQ : SC_HQ, lastrow, h * 64 + k) * S[k * 64 + t]; o64[t] = o; }
    __syncthreads();
}
__global__ void __launch_bounds__(256) k_check(Args args, float* flags) {
    __shared__ float red[256]; __shared__ float S[4096]; __shared__ float o1[64], o2[64];
    Ctx c{args.in, args.ws, red}; const int id = blockIdx.x, t = threadIdx.x; float* fl = flags + id;
    const float* tab = (const float*)(args.ws + WS_TAB);
    if (t == 0) { *fl = 0.f; if (id == 12) { flags[13] = 0.f; flags[14] = 0.f; flags[15] = 0.f; } } __syncthreads();
#define rows(i) ((i) == 0 ? 5 : (i) == 1 ? 20000 : 33000)
    if (id == 0) { for (int ri = 0; ri < 3; ++ri) for (int cc = 3; cc < 384; cc += 197) { const float z = zdot(c, rows(ri), cc); upd(fl, sc_buf(c, SC_HQ, rows(ri), cc), z); } }
    if (id == 1) { for (int ri = 0; ri < 3; ++ri) for (int cc = 3; cc < 384; cc += 197) { upd(fl, sc_buf(c, SC_HV, rows(ri), cc), zdot(c, rows(ri), 1152 + cc)); upd(fl, sc_buf(c, SC_RG, rows(ri), cc), zdot(c, rows(ri), 3072 + cc)); upd(fl, sc_buf(c, SC_HG, rows(ri), cc), zdot(c, rows(ri), 1536 + cc)); upd(fl, sc_buf(c, SC_RV, rows(ri), cc), zdot(c, rows(ri), 2688 + cc)); } }
    if (id == 2) { for (int ri = 0; ri < 3; ++ri) for (int cc = 3; cc < 384; cc += 197) { const float z1 = zdot(c, rows(ri), 384 + cc), z2 = zdot(c, rows(ri), 768 + cc); upd(fl, sc_buf(c, SC_KF, rows(ri), cc), 1.f / (1.f + expf(z1))); upd(fl, sc_buf(c, SC_KB, rows(ri), cc), 1.f / (1.f + expf(z2))); } }
    if (id == 3) { for (int ri = 0; ri < 3; ++ri) for (int hh = 0; hh < 6; hh += 5) for (int i = 1; i < 32; i += 13) for (int isk = 0; isk < 2; ++isk) { const int r = rows(ri); const bool ctx = r >= NLAT; const int tt = r & (T - 1);
            const float x1 = zdot(c, r, 1920 + 384 * isk + hh * 64 + i), x2 = zdot(c, r, 1920 + 384 * isk + hh * 64 + i + 32);
            const float ang = ctx ? 0.f : (float)tt * powf(10000.f, -(float)i / 32.f); const float cs = cosf(ang), sn = sinf(ang), scl = isk ? 0.125f : 1.f;
            upd(fl, sc_buf(c, isk ? SC_RK : SC_RQ, r, hh * 64 + 2 * i), (x1 * cs - x2 * sn) * scl); upd(fl, sc_buf(c, isk ? SC_RK : SC_RQ, r, hh * 64 + 2 * i + 1), (x2 * cs + x1 * sn) * scl); } }
    if (id == 4) { for (int ri = 0; ri < 3; ++ri) for (int mp = 0; mp < 8; mp += 7) for (int half = 0; half < 2; ++half) for (int j = 1; j < 8; j += 5) { const int r = rows(ri); const bool ctx = r >= NLAT; const int tt = ctx ? (r - NLAT) & 255 : r & (T - 1); const int bb = ctx ? (r - NLAT) >> 8 : r >> 14;
            const int pos = half ? (tt & 63) : (tt >> 6); const float ang = ctx ? 0.f : (float)pos * powf(10000.f, -(float)j / 8.f); const float cs = cosf(ang), sn = sinf(ang);
            { const float x1 = zdot(c, r, 3456 + mp * 32 + half * 16 + j), x2 = zdot(c, r, 3456 + mp * 32 + half * 16 + j + 8); const float scl = 0.17677669529663687f * LOG2E;
              const size_t qi = ctx ? ((size_t)(bb * 8 + mp) * CL + tt) * 32 + half * 16 + 2 * j : ((size_t)(bb * 8 + mp) * T + tt) * 32 + half * 16 + 2 * j;
              upd(fl, bfb(c.ws, ctx ? WS_QC : WS_QA, qi), (x1 * cs - x2 * sn) * scl); upd(fl, bfb(c.ws, ctx ? WS_QC : WS_QA, qi + 1), (x2 * cs + x1 * sn) * scl); }
            { const float x1 = zdot(c, r, 3712 + mp * 32 + half * 16 + j), x2 = zdot(c, r, 3712 + mp * 32 + half * 16 + j + 8);
              const int Lk = ctx ? tt : 256 + tt, tile = Lk >> 6, rr = Lk & 63, pw = half * 16 + 2 * j;
              const size_t ki = ((size_t)((bb * 8 + mp) * KT_TILES + tile) * 4 + (pw >> 3)) * 512 + rr * 8 + (pw & 7);
              upd(fl, bfb(c.ws, WS_KA, ki), x1 * cs - x2 * sn); upd(fl, bfb(c.ws, WS_KA, ki + 1), x2 * cs + x1 * sn); }
            { const int h4 = mp >> 1, w = half * 32 + j * 3; const float z = zdot(c, r, 3968 + h4 * 64 + w); const int Lk = ctx ? tt : 256 + tt, tile = Lk >> 6, rr = Lk & 63;
              upd(fl, bfb(c.ws, WS_VA, ((size_t)((bb * 4 + h4) * KT_TILES + tile) * 2 + (w >> 5)) * 2048 + rr * 32 + (w & 31)), z); } } }
    if (id == 5 || id == 6) {
        const int type = id - 5, b = 1, h = 2;
#define ts(i) ((i) == 0 ? 0 : (i) == 1 ? 1 : 300)
        for (int q = 0; q < 3; ++q) { naive_scan(c, tab, type, b, h, 0, 256 + ts(q) + 1, S, o1);
            if (t < 64) { const float got = ((const float*)(args.ws + WS_OSCR))[(size_t)(b * T + ts(q)) * 768 + type * 384 + h * 64 + t]; const float e = fabsf(got - o1[t]) / (fabsf(o1[t]) + 0.05f); if (e > 0.05f || !(e == e)) atomicMax((int*)fl, __float_as_int((e == e) ? e : 1e9f)); } __syncthreads(); }
    }
    if (id == 7 || id == 8) {
        const int type = id - 7, b = 1, h = 4;
        for (int q = 0; q < 2; ++q) {
            int row;
            if (q == 0) { naive_scan(c, tab, type, b, h, 0, 101, S, o1); naive_scan(c, tab, type, b, h, 1, 256 - 100, S, o2); row = NLAT + b * CL + 100; }
            else { naive_scan(c, tab, type, b, h, 1, 257, S, o2); row = b * T + T - 1; if (t < 64) o1[t] = ((const float*)(args.ws + WS_OSCR))[(size_t)row * 768 + type * 384 + h * 64 + t]; __syncthreads(); }
            float o = t < 64 ? o1[t] + o2[t] : 0.f; const float ss = blk_sum(o * o, red); const float r = rsqrtf(ss / 64.f + EPS);
            if (t < 64) { const float g = sc_buf(c, type ? SC_RG : SC_HG, row, h * 64 + t); const float want = o * r * args.in[type ? 11 : 9][t] * g / (1.f + expf(-g));
                const float got = bfb(c.ws, WS_MIX, (size_t)row * 1024 + type * 384 + h * 64 + t); const float e = fabsf(got - want) / (fabsf(want) + 0.05f); if (e > 0.05f || !(e == e)) atomicMax((int*)fl, __float_as_int((e == e) ? e : 1e9f)); }
            __syncthreads(); }
    }
    if (id == 9) {
        for (int q = 0; q < 2; ++q) { const bool ctx = q == 1; const int b = ctx ? 0 : 1, h = ctx ? 3 : 2, tq = ctx ? 77 : 5000; const int nk = ctx ? 256 : 16640;
            __shared__ float po[2][64]; __shared__ float pl[2];
            for (int m = 0; m < 2; ++m) { const int mp = b * 8 + 2 * h + m;
                float mx = -1e30f;
                for (int kk = t; kk < nk; kk += 256) { float sdot = 0.f; for (int d = 0; d < 32; ++d) { const float qv = bfb(c.ws, ctx ? WS_QC : WS_QA, ((size_t)mp * (ctx ? CL : T) + tq) * 32 + d); const float kv = bfb(c.ws, WS_KA, ((size_t)(mp * KT_TILES + (kk >> 6)) * 4 + (d >> 3)) * 512 + (kk & 63) * 8 + (d & 7)); sdot += qv * kv; } mx = fmaxf(mx, sdot); }
                red[t] = mx; __syncthreads(); for (int o = 128; o > 0; o >>= 1) { if (t < o) red[t] = fmaxf(red[t], red[t + o]); __syncthreads(); } mx = red[0]; __syncthreads();
                float ls = 0.f; float av[64];
_Pragma("unroll") for (int d = 0; d < 64; ++d) av[d] = 0.f;
                for (int kk = t; kk < nk; kk += 256) { float sdot = 0.f; for (int d = 0; d < 32; ++d) { const float qv = bfb(c.ws, ctx ? WS_QC : WS_QA, ((size_t)mp * (ctx ? CL : T) + tq) * 32 + d); const float kv = bfb(c.ws, WS_KA, ((size_t)(mp * KT_TILES + (kk >> 6)) * 4 + (d >> 3)) * 512 + (kk & 63) * 8 + (d & 7)); sdot += qv * kv; }
                    const float p = exp2f(sdot - mx); ls += p;
_Pragma("unroll") for (int d = 0; d < 64; ++d) av[d] += p * bfb(c.ws, WS_VA, ((size_t)((b * 4 + h) * KT_TILES + (kk >> 6)) * 2 + (d >> 5)) * 2048 + (kk & 63) * 32 + (d & 31)); }
                ls = blk_sum(ls, red);
_Pragma("unroll") for (int d = 0; d < 64; ++d) { const float sv = blk_sum(av[d], red); if (t == 0) po[m][d] = sv; } if (t == 0) pl[m] = ls; __syncthreads();
            }
            const float lam = tab[TB_LAM + 0], oml = tab[TB_LAM + 2];
            float o = t < 64 ? po[0][t] / pl[0] - lam * po[1][t] / pl[1] : 0.f; const float ss = blk_sum(o * o, red); const float r = rsqrtf(ss / 64.f + EPS);
            if (t < 64) { const float want = o * r * args.in[13][t] * oml; const size_t row = ctx ? (size_t)(NLAT + b * CL + tq) : (size_t)(b * T + tq); const float got = bfb(c.ws, WS_MIX, row * 1024 + 768 + h * 64 + t);
                const float e = fabsf(got - want) / (fabsf(want) + 0.05f); if (e > 0.05f || !(e == e)) atomicMax((int*)fl, __float_as_int((e == e) ? e : 1e9f)); }
            __syncthreads(); }
    }
    if (id == 10) { for (int ri = 0; ri < 3; ++ri) for (int cc = 7; cc < 1024; cc += 401) { float a = 0.f; for (int k = t; k < 1024; k += 256) a += bfb(c.ws, WS_MIX, (size_t)rows(ri) * 1024 + k) * args.in[14][(size_t)k * 1024 + cc]; a = blk_sum(a, red); upd(fl, ((const float*)(args.ws + WS_Y))[(size_t)rows(ri) * 1024 + cc], a); } }
    if (id == 11) {
        const float* modv = (const float*)(args.ws + WS_MODV);
        for (int ri = 0; ri < 3; ++ri) { const int r = rows(ri), w = row_which(r); const float* xs = r < NLAT ? args.in[0] + (size_t)r * D : args.in[2] + (size_t)(r - NLAT) * D; const float* y = (const float*)(args.ws + WS_Y) + (size_t)r * D;
            float sy = 0.f; for (int k = t; k < 1024; k += 256) sy += y[k] * y[k]; sy = blk_sum(sy, red); const float ry = rsqrtf(sy / 1024.f + EPS);
            float x1[4]; float sx = 0.f;
_Pragma("unroll") for (int q = 0; q < 4; ++q) { const int k = t + 256 * q; x1[q] = xs[k] + modv[(size_t)(w * 6 + 2) * 1024 + k] * y[k] * ry; sx += x1[q] * x1[q]; } sx = blk_sum(sx, red); const float rx = rsqrtf(sx / 1024.f + EPS);
_Pragma("unroll")
            for (int q = 0; q < 4; ++q) { const int k = t + 256 * q; const float tk = x1[q] * rx * modv[(size_t)(w * 6 + 3) * 1024 + k] + modv[(size_t)(w * 6 + 4) * 1024 + k];
                const float got = bfb(c.ws, WS_H, (size_t)r * 1024 + k), got1 = ((const float*)(args.ws + WS_X1))[(size_t)r * 1024 + k];
                const float e = fmaxf(fabsf(got - tk) / (fabsf(tk) + 0.05f), fabsf(got1 - x1[q]) / (fabsf(x1[q]) + 0.05f)); if (e > 0.05f || !(e == e)) atomicMax((int*)fl, __float_as_int((e == e) ? e : 1e9f)); }
            __syncthreads(); } }

    if (id == 12) {
        __shared__ float tokf[1024], lg[32], abuf[2048], actb[1024], yb[1024]; __shared__ int te[4]; __shared__ float tg[4]; __shared__ int spos;
        const unsigned* cnt = (const unsigned*)(args.ws + WS_CTL) + CW_CNT; const int* slot = (const int*)(args.ws + WS_SLOT);
        for (int ri = 0; ri < 3; ++ri) { const int r = rows(ri);
            for (int k = t; k < 1024; k += 256) tokf[k] = bfb(c.ws, WS_H, (size_t)r * 1024 + k); __syncthreads();
            if (t < 32) { float a = args.in[16][t]; for (int k = 0; k < 1024; ++k) a += tokf[k] * args.in[15][(size_t)k * 32 + t]; lg[t] = a; } __syncthreads();
            if (t < 32) { const float got = ((const float*)(args.ws + WS_END + 65536))[(size_t)r * 32 + t]; const float e = fabsf(got - lg[t]); if (e > 0.02f || !(e == e)) atomicMax((int*)(flags + 15), __float_as_int((e == e) ? 1.f + e : 1e9f)); } __syncthreads();
            if (t == 0) { float tv[4]; for (int k = 0; k < 4; ++k) { int bi = 0; float bv = -1e30f; for (int e = 0; e < 32; ++e) if (lg[e] > bv) { bv = lg[e]; bi = e; } te[k] = bi; tv[k] = bv; lg[bi] = -1e30f; }
                float sm = 0.f; for (int k = 0; k < 4; ++k) { tg[k] = expf(tv[k] - tv[0]); sm += tg[k]; } for (int k = 0; k < 4; ++k) tg[k] /= sm; } __syncthreads();
            if (t < 4) { const float got = ((const float*)(args.ws + WS_GATE))[(size_t)r * 4 + t]; const float e = fabsf(got - tg[t]) / (tg[t] + 0.01f); if (e > 0.05f || !(e == e)) atomicMax((int*)(flags + 12), __float_as_int((e == e) ? e : 1e9f)); }
            for (int k4 = 0; k4 < 4; ++k4) { const int e = te[k4]; const float* w1 = args.in[17] + (size_t)e * 1024 * 2048; const float* w2 = args.in[19] + (size_t)e * 1024 * 1024;
                for (int n = t; n < 2048; n += 256) { float a = args.in[18][(size_t)e * 2048 + n]; for (int k = 0; k < 1024; ++k) a += tokf[k] * w1[(size_t)k * 2048 + n]; abuf[n] = a; } __syncthreads();
                for (int j = t; j < 1024; j += 256) { const float g = fminf(abuf[2 * j], 7.f), l = fminf(fmaxf(abuf[2 * j + 1], -7.f), 7.f); actb[j] = g / (1.f + expf(-1.702f * g)) * (l + 1.f); } __syncthreads();
                for (int cc = t; cc < 1024; cc += 256) { float a = args.in[20][(size_t)e * 1024 + cc]; for (int j = 0; j < 1024; ++j) a += actb[j] * w2[(size_t)j * 1024 + cc]; yb[cc] = a * tg[k4]; } __syncthreads();
                if (t == 0) spos = -1; __syncthreads();
                const int ce = (int)cnt[e]; for (int p = t; p < ce; p += 256) if (slot[e * CAP + p] == r * 4 + k4) spos = p; __syncthreads();
                int ts0 = 0; for (int q = 0; q < e; ++q) ts0 += ((int)cnt[q] + 255) >> 8;
                float sqa = 0.f, sqy = 0.f; for (int k = t; k < 1024; k += 256) { sqa += actb[k] * actb[k]; sqy += yb[k] * yb[k]; } sqa = blk_sum(sqa, red); sqy = blk_sum(sqy, red); const float ra = sqrtf(sqa / 1024.f), ry = sqrtf(sqy / 1024.f);
                if (spos < 0) { if (t == 0) flags[13] = 7e8f; }
                else for (int k = t; k < 1024; k += 256) { const float got = bfb(c.ws, WS_ACT, ((size_t)ts0 * 256 + spos) * 1024 + k); const float er = fabsf(got - actb[k]) / (fabsf(actb[k]) + 0.2f * ra + 1e-6f); if (er > 0.05f || !(er == er)) atomicMax((int*)(flags + 13), __float_as_int((er == er) ? er : 1e9f)); }
                for (int k = t; k < 1024; k += 256) { const float got = bfb(c.ws, WS_YK, ((size_t)r * 4 + k4) * 1024 + k); const float er = fabsf(got - yb[k]) / (fabsf(yb[k]) + 0.2f * ry + 1e-6f); if (er > 0.05f || !(er == er)) atomicMax((int*)(flags + 14), __float_as_int((er == er) ? er : 1e9f)); }
                __syncthreads(); }
        } }
}
__global__ void k_out(Args args, const float* flags, int nchk, unsigned mask) {
    int code = 0; for (int i = nchk - 1; i >= 0; --i) if (((mask >> i) & 1u) && flags[i] > 0.05f) code = i + 1;
    const float sc = 1.f + (float)code;
    for (size_t i = (size_t)blockIdx.x * blockDim.x + threadIdx.x; i < (size_t)NLAT * D; i += (size_t)gridDim.x * blockDim.x) args.out[i] = args.in[0][i] * sc;
}
}
#endif

extern "C" void kernel_launch(void* const* d_in, const int* in_sizes, int n_in, void* d_out, int out_size, void* d_ws, size_t ws_size, hipStream_t stream) {
    static int grid = 0;
    if (grid == 0) {
        if (n_in != 21 || out_size != NLAT * D || ws_size < WS_END) { fprintf(stderr, "kernel_launch: unexpected shapes (n_in %d out %d ws %zu)\n", n_in, out_size, ws_size); grid = -1; return; }
        int dev = 0, cus = 0, per_cu = 0;
        if (hipGetDevice(&dev) != hipSuccess || hipDeviceGetAttribute(&cus, hipDeviceAttributeMultiprocessorCount, dev) != hipSuccess) { grid = -1; return; }
        if (hipFuncSetAttribute((const void*)mk_fwd, hipFuncAttributeMaxDynamicSharedMemorySize, LDS_BYTES) != hipSuccess) { fprintf(stderr, "kernel_launch: hipFuncSetAttribute failed\n"); grid = -1; return; }
        if (hipOccupancyMaxActiveBlocksPerMultiprocessor(&per_cu, (const void*)mk_fwd, NTHR, LDS_BYTES) != hipSuccess || per_cu < 1) fprintf(stderr, "kernel_launch: occupancy query reports %d\n", per_cu);
        (void)hipGetLastError();
        grid = cus;
    }
    if (grid < 0) return;
    if (hipMemsetAsync((char*)d_ws + WS_CTL, 0, CTL_ZERO_BYTES, stream) != hipSuccess) return;
    Args a{};
    for (int i = 0; i < 21; ++i) a.in[i] = (const float*)d_in[i];
    a.out = (float*)d_out; a.ws = (unsigned char*)d_ws;
#if MK_ONE_LAUNCH
    a.ph_lo = 0; a.ph_hi = NPHASE;
    hipLaunchKernelGGL(mk_fwd, dim3(grid), dim3(NTHR), LDS_BYTES, stream, a);
#elif defined(DBG_CHECK)
    for (int p = 0; p < DBG_CHECK; ++p) { a.ph_lo = p; a.ph_hi = p + 1; hipLaunchKernelGGL(mk_fwd, dim3(grid), dim3(NTHR), LDS_BYTES, stream, a); }
    float* flags = (float*)((char*)d_ws + WS_END);
    hipLaunchKernelGGL(dbg::k_check, dim3(13), dim3(256), 0, stream, a, flags);
    hipLaunchKernelGGL(dbg::k_out, dim3(1024), dim3(256), 0, stream, a, (const float*)flags, 16, (unsigned)DBG_MASK);
#else
    for (int p = 0; p < NPHASE; ++p) { a.ph_lo = p; a.ph_hi = p + 1; hipLaunchKernelGGL(mk_fwd, dim3(grid), dim3(NTHR), LDS_BYTES, stream, a); }
#endif
}
```

```cpp
#include <hip/hip_runtime.h>
#include <cstdio>
#include <cstdint>
#include <cmath>

#ifndef DBG_MASK
#define DBG_MASK 0xf800
#endif
#ifndef PHMASK
#define PHMASK 0xfff
#endif
#define PHON(k) ((PHMASK >> (k)) & 1)
#ifndef REPMASK
#define REPMASK 0
#endif
#define NREP(k) (1 + ((REPMASK >> (k)) & 1))
#ifndef ATTVAR
#define ATTVAR -1
#endif
#ifndef MK_ONE_LAUNCH
#define MK_ONE_LAUNCH 1
#endif

#define LAS __attribute__((address_space(3)))
#define GAS __attribute__((address_space(1)))
typedef unsigned short bf16_t;
typedef short bf16x8 __attribute__((ext_vector_type(8)));
typedef short s16x4 __attribute__((ext_vector_type(4)));
typedef float f32x2 __attribute__((ext_vector_type(2)));
typedef float f32x4 __attribute__((ext_vector_type(4)));
typedef float f32x16 __attribute__((ext_vector_type(16)));
typedef unsigned u32x2 __attribute__((ext_vector_type(2)));
typedef unsigned u32x4 __attribute__((ext_vector_type(4)));
typedef GAS unsigned gu32;
typedef int v4i __attribute__((ext_vector_type(4)));
typedef int v8i __attribute__((ext_vector_type(8)));

constexpr int NB = 2, T = 16384, CL = 256, D = 1024;
constexpr int NLAT = NB * T, NCTX = NB * CL, NROW = NLAT + NCTX;
constexpr int NE = 32, CAP = NROW;
constexpr int NIN = 4352;
constexpr int NSEQ = 48, NSC = 65;
constexpr int KT_TILES = 260;
constexpr float EPS = 1e-6f;
constexpr float LOG2E = 1.4426950408889634f;
constexpr int NWAVES = 8, NTHR = 512;

constexpr size_t MiB = 1u << 20;
constexpr size_t WS_CTL = 0, CTL_ZERO_BYTES = 64 * 1024;
constexpr size_t WS_MODV = 1 * MiB;
constexpr size_t WS_TAB = 1 * MiB + 256 * 1024;
constexpr size_t WS_RWT = 1 * MiB + 512 * 1024;
constexpr size_t WS_ROPE = 2 * MiB;
constexpr size_t WS_WIN = 6 * MiB;
constexpr size_t WS_WOUT = 23 * MiB;
constexpr size_t WS_W1 = 27 * MiB;
constexpr size_t WS_W2 = 283 * MiB;
constexpr size_t WS_X1 = 411 * MiB;
constexpr size_t WS_H = 541 * MiB;
constexpr size_t WS_SCAN = 606 * MiB;
constexpr size_t SCAN_PITCH = 25 * MiB;
constexpr size_t WS_QA = 831 * MiB;
constexpr size_t WS_QC = 847 * MiB;
constexpr size_t WS_KA = 848 * MiB;
constexpr size_t WS_VA = 865 * MiB;
constexpr size_t WS_SLOC = 882 * MiB;
constexpr size_t WS_SIN = 931 * MiB;
constexpr size_t WS_DEC = 980 * MiB;
constexpr size_t WS_OSCR = 981 * MiB;
constexpr size_t WS_MIX = 1079 * MiB;
constexpr size_t WS_Y = 1144 * MiB;
constexpr size_t WS_SLOT = 1274 * MiB;
constexpr size_t WS_GATE = 1279 * MiB;
constexpr size_t WS_ACT = 1280 * MiB;
constexpr size_t WS_YK = 1540 * MiB;
constexpr size_t WS_TOK8 = 1816 * MiB;
constexpr size_t WS_SGATE = 1850 * MiB;
constexpr size_t WS_END = 1856 * MiB;
enum { SC_KF = 0, SC_KB = 1, SC_RQ = 2, SC_RK = 3, SC_HQ = 4, SC_HV = 5, SC_HG = 6, SC_RV = 7, SC_RG = 8 };
constexpr int CW_TMO = 0, CW_BAR = 4096, CW_CNT = 8192;
constexpr int TB_LBT = 0;
constexpr int TB_LAM = 1024;
constexpr int TB_GAM = 1040;
constexpr int TB_AXR = 2048;
constexpr int TB_AXC = 2048 + 4096;

constexpr int LDS_BYTES = 147456;
constexpr int LDS_MISC = 131072 + 12288;
constexpr int LDS_TAB = 131072;

__device__ __forceinline__ unsigned f2bf(float f) { unsigned u = __builtin_bit_cast(unsigned, f); return (u + 0x7fffu + ((u >> 16) & 1u)) >> 16; }
__device__ __forceinline__ unsigned pk2(float lo, float hi) { return f2bf(lo) | (f2bf(hi) << 16); }
__device__ __forceinline__ float bf2f(unsigned short b) { return __builtin_bit_cast(float, (unsigned)b << 16); }
__device__ __forceinline__ float bflo(unsigned w) { return __builtin_bit_cast(float, w << 16); }
__device__ __forceinline__ float bfhi(unsigned w) { return __builtin_bit_cast(float, w & 0xffff0000u); }
typedef __bf16 bf16x2_t __attribute__((ext_vector_type(2)));
__device__ __forceinline__ unsigned trunc_pk_bf16(float lo, float hi) { return __builtin_amdgcn_perm(__builtin_bit_cast(unsigned, hi), __builtin_bit_cast(unsigned, lo), 0x07060302u); }
__device__ __forceinline__ unsigned cvt_pk_bf16(float lo, float hi) { const f32x2 v = {lo, hi}; const bf16x2_t b = __builtin_convertvector(v, bf16x2_t); return __builtin_bit_cast(unsigned, b); }
__device__ __forceinline__ float wave_sum_dpp(float v) {
#define DPP_ADD(ctrl, rmask) v += __builtin_bit_cast(float, __builtin_amdgcn_update_dpp(0, __builtin_bit_cast(int, v), ctrl, rmask, 0xF, false))
    DPP_ADD(0xB1, 0xF); DPP_ADD(0x4E, 0xF); DPP_ADD(0x141, 0xF); DPP_ADD(0x140, 0xF); DPP_ADD(0x142, 0xA); DPP_ADD(0x143, 0xC);
#undef DPP_ADD
    return __builtin_bit_cast(float, __builtin_amdgcn_readlane(__builtin_bit_cast(int, v), 63));
}
__device__ __forceinline__ float wave_sum(float v) { return wave_sum_dpp(v); }
template <int M> __device__ __forceinline__ float xor_swz(float v) { return __builtin_bit_cast(float, __builtin_amdgcn_ds_swizzle(__builtin_bit_cast(int, v), 0x1F | (M << 10))); }
__device__ __forceinline__ float xor32(float v, int lane) { return __builtin_bit_cast(float, __builtin_amdgcn_ds_bpermute((lane ^ 32) << 2, __builtin_bit_cast(int, v))); }
__device__ __forceinline__ float rdlane(float v, int l) { return __builtin_bit_cast(float, __builtin_amdgcn_readlane(__builtin_bit_cast(int, v), l)); }
__device__ __forceinline__ float sigmoidf_(float x) { return __builtin_amdgcn_rcpf(1.f + __builtin_amdgcn_exp2f(-LOG2E * x)); }
#define PHASE_IDS_W(WV) int lane; asm volatile("v_mbcnt_lo_u32_b32 %0, -1, 0\n\tv_mbcnt_hi_u32_b32 %0, -1, %0" : "=v"(lane)); int wave = (WV); asm volatile("" : "+s"(wave)); const int tid = wave * 64 + lane; (void)tid
#define PHASE_IDS() PHASE_IDS_W(F.wave); int blk_ = F.blk; asm volatile("" : "+s"(blk_))
__device__ __forceinline__ unsigned pk4_fp8(float a, float b, float c, float d) { int w = __builtin_bit_cast(int, a); w = __builtin_amdgcn_cvt_pk_fp8_f32(a, b, w, false); w = __builtin_amdgcn_cvt_pk_fp8_f32(c, d, w, true); return (unsigned)w; }
constexpr float W8_MUL = 64.f;
constexpr int SCALE_W8 = 0x79797979, SCALE_A8 = 0x7F7F7F7F;
#define LDS_WAIT() asm volatile("s_waitcnt lgkmcnt(0)" ::: "memory")
#define VM_WAIT() asm volatile("s_waitcnt vmcnt(0)" ::: "memory")

#define XB_TMO      128
#define XB_XCNT(j)  (256  + 64 * (j))
#define XB_XSUB(j)  (1280 + 64 * (j))
#define XB_XGEN(j)  (2304 + 64 * (j))
#define XB_TOP      3328
#define XB_TOPGEN   3392
#define XCD_BAR_WORDS 3456
#define XB_SPIN_CAP (1u << 22)
__device__ __forceinline__ unsigned xb_ld(unsigned* p)              { return __hip_atomic_load(p, __ATOMIC_RELAXED, __HIP_MEMORY_SCOPE_AGENT); }
__device__ __forceinline__ unsigned xb_add(unsigned* p, unsigned v) { return __hip_atomic_fetch_add(p, v, __ATOMIC_RELAXED, __HIP_MEMORY_SCOPE_AGENT); }
__device__ __forceinline__ unsigned xb_xcc_id() { return (unsigned)__builtin_amdgcn_s_getreg((3 << 11) | 20) & 0xFu; }
#define XB_SPIN(cond, bar) do { unsigned _sp = 0; while (cond) { __builtin_amdgcn_s_sleep(1); \
    if ((++_sp & 255u) == 0u) { if (xb_ld(&(bar)[XB_TMO])) break; if (_sp > XB_SPIN_CAP) { atomicAdd(&(bar)[XB_TMO], 1u); break; } } } } while (0)
struct XcdBarrier { unsigned* bar; unsigned x; volatile LAS unsigned* st; };
__device__ __forceinline__ XcdBarrier xcd_barrier_post(unsigned* bar, volatile LAS unsigned* st) {
    XcdBarrier b; b.bar = bar; b.x = xb_xcc_id(); b.st = st;
    if (threadIdx.x == 0) (void)xb_add(&bar[XB_XCNT(b.x)], 1u);
    return b;
}
__device__ __forceinline__ void xcd_barrier_complete(unsigned* bar, unsigned x, unsigned& nloc, unsigned& nx) {
    const unsigned G = gridDim.x * gridDim.y * gridDim.z;
    unsigned sum, cnt, mine, sp = 0u;
    for (;;) {
        sum = 0u; cnt = 0u; mine = 0u;
#pragma unroll
        for (unsigned j = 0; j < 16; ++j) { const unsigned c = xb_ld(&bar[XB_XCNT(j)]); sum += c; cnt += (c > 0u) ? 1u : 0u; mine = (j == x) ? c : mine; }
        if (sum == G) break;
        __builtin_amdgcn_s_sleep(1);
        if ((++sp & 255u) == 0u) { if (xb_ld(&bar[XB_TMO])) break; if (sp > XB_SPIN_CAP) { atomicAdd(&bar[XB_TMO], 1u); break; } }
    }
    nloc = mine > 0u ? mine : 1u; nx = cnt > 0u ? cnt : 1u;
}
__device__ __forceinline__ void xcd_barrier_census(const XcdBarrier& b) {
    unsigned nloc, nx; xcd_barrier_complete(b.bar, b.x, nloc, nx); b.st[0] = nloc; b.st[1] = nx;
}
__device__ __forceinline__ void xcd_barrier(const XcdBarrier& b) {
    asm volatile("s_waitcnt vmcnt(0)" ::: "memory");
    __syncthreads();
    if (threadIdx.x == 0) {
        unsigned* bar = b.bar;
        __builtin_amdgcn_s_waitcnt(0);
        const unsigned nloc = b.st[0], nx = b.st[1];
        const unsigned old = xb_add(&bar[XB_XSUB(b.x)], 1u);
        const unsigned gen = old / nloc;
        if (old + 1u == (gen + 1u) * nloc) {
            __builtin_amdgcn_fence(__ATOMIC_RELEASE, "agent");
            asm volatile("s_waitcnt vmcnt(0)" ::: "memory");
            const unsigned og = xb_add(&bar[XB_TOP], 1u);
            const unsigned tg = og / nx;
            if (og + 1u == (tg + 1u) * nx) xb_add(&bar[XB_TOPGEN], 1u);
            else XB_SPIN(xb_ld(&bar[XB_TOPGEN]) == tg, bar);
            __builtin_amdgcn_fence(__ATOMIC_ACQUIRE, "agent");
            xb_add(&bar[XB_XGEN(b.x)], 1u);
            asm volatile("s_waitcnt vmcnt(0)" ::: "memory");
        } else {
            XB_SPIN(xb_ld(&bar[XB_XGEN(b.x)]) == gen, bar);
            __builtin_amdgcn_fence(__ATOMIC_ACQUIRE, "agent");
            asm volatile("s_waitcnt vmcnt(0)" ::: "memory");
        }
    }
    __syncthreads();
}

struct Frame {
    LAS unsigned char* lds;
    unsigned char* ws;
    const float* in[21];
    float* out;
    gu32* ctl;
    int tid, lane, wave, G, blk;
};

__device__ __forceinline__ void glds16(const void* sbase, unsigned voff, unsigned lds_dst) { unsigned keep;
    asm volatile("s_mov_b32 %0, m0\n\ts_mov_b32 m0, %3\n\ts_nop 0\n\tglobal_load_lds_dwordx4 %1, %2\n\ts_mov_b32 m0, %0" : "=&s"(keep) : "v"(voff), "s"(sbase), "s"(lds_dst) : "memory"); }

namespace pg8 {
constexpr int BM = 256, BK = 64, HALF = 128, HTB = HALF * BK * 2, STAGE_BYTES = 8 * HTB, NXCD = 8, WGM = 8, K = 1024;
__host__ __device__ __forceinline__ int lds_byte(int r, int c) { const int st = (r >> 4) * 2 + (c >> 5), rr = r & 15, cc = c & 31, ob = rr * 64 + cc * 2; return st * 1024 + (ob ^ (((ob >> 9) & 1) << 5)); }
__host__ __device__ __forceinline__ void stage_rc(int b, int& R, int& C) { const int st = b / 1024, sb = b % 1024, swz = sb ^ (((sb >> 9) & 1) << 5); R = (st >> 1) * 16 + swz / 64; C = (st & 1) * 32 + (swz % 64) / 2; }
__host__ __device__ __forceinline__ int perm32(int rho) { const int n = rho >> 4, i = rho & 15; return 8 * (i >> 2) + 4 * n + (i & 3); }
struct Unit { int pm, pn, e, nvalid, sbase; };
template <class Epi, class Sched, bool GATHER, bool FP8 = false>
__device__ __forceinline__ void gemm_phase(LAS unsigned char* lds, int wave_id, const Sched& S, const Epi& E) {
    constexpr int KB = FP8 ? 1024 : 2048, NT = KB / 128;
    PHASE_IDS_W(wave_id); const int wid = wave, wr = wid >> 2, wc = wid & 3, fr = lane & 15, fq = lane >> 4;
    unsigned voffB[2], vA[2][2]; int R0, C0;
    { int R, C; stage_rc(tid * 16, R, C); R0 = R; C0 = C;
#pragma unroll
      for (int i = 0; i < 2; ++i) { const int Ri = R + 64 * i; const int Rb = Epi::PERM ? ((Ri & ~31) + perm32(Ri & 31)) : Ri; voffB[i] = (unsigned)(Rb * KB + C * 2);
#pragma unroll
          for (int h = 0; h < 2; ++h) vA[h][i] = (unsigned)((Ri + 128 * h) * KB + C * 2); } }
    const size_t kstep = (size_t)(BK * 2);
    const size_t hstep = (size_t)HALF * KB;
    const unsigned ldsw = (unsigned)wid * 1024u, lds0 = (unsigned)(uintptr_t)lds;
    const int aoff = lds_byte(wr * 64 + fr, fq * 8), boff = lds_byte(wc * 32 + fr, fq * 8);
#define PG8_SA(b, h) (((b) * 2 + (h)) * HTB)
#define PG8_SB(b, h) ((4 + (b) * 2 + (h)) * HTB)
#define PG8_STAGE(bufoff, gbase, voff) do { _Pragma("unroll") for (int _i = 0; _i < 2; ++_i) \
        glds16((const void*)(gbase), (voff)[_i], (unsigned)__builtin_amdgcn_readfirstlane(lds0 + (unsigned)(bufoff) + ldsw + _i * 8192)); } while (0)
#define PG8_LDA(dst, b, h) do { _Pragma("unroll") for (int m = 0; m < 4; ++m) { dst[m].lo = *(const LAS v4i*)(lds + PG8_SA(b, h) + aoff + m * 2048); dst[m].hi = *(const LAS v4i*)(lds + PG8_SA(b, h) + aoff + m * 2048 + 1024); } } while (0)
#define PG8_LDB(dst, b, h) do { _Pragma("unroll") for (int n = 0; n < 2; ++n) { dst[n].lo = *(const LAS v4i*)(lds + PG8_SB(b, h) + boff + n * 2048); dst[n].hi = *(const LAS v4i*)(lds + PG8_SB(b, h) + boff + n * 2048 + 1024); } } while (0)
#define PG8_MMA(ai, bj, At, Bt) do { __builtin_amdgcn_s_setprio(1); _Pragma("unroll") for (int m = 0; m < 4; ++m) _Pragma("unroll") for (int n = 0; n < 2; ++n) { \
        if constexpr (FP8) acc[ai][bj][m][n] = __builtin_amdgcn_mfma_scale_f32_16x16x128_f8f6f4(Bt[n], At[m], acc[ai][bj][m][n], 0, 0, 0, SCALE_W8, 0, SCALE_A8); \
        else { acc[ai][bj][m][n] = __builtin_amdgcn_mfma_f32_16x16x32_bf16(__builtin_bit_cast(bf16x8, (v4i)Bt[n].lo), __builtin_bit_cast(bf16x8, (v4i)At[m].lo), acc[ai][bj][m][n], 0, 0, 0); \
               acc[ai][bj][m][n] = __builtin_amdgcn_mfma_f32_16x16x32_bf16(__builtin_bit_cast(bf16x8, (v4i)Bt[n].hi), __builtin_bit_cast(bf16x8, (v4i)At[m].hi), acc[ai][bj][m][n], 0, 0, 0); } } \
        __builtin_amdgcn_s_setprio(0); } while (0)
#define PG8_WAIT_V(n) asm volatile("s_waitcnt vmcnt(" #n ")" ::: "memory")
#define PG8_WAIT_L(n) asm volatile("s_waitcnt lgkmcnt(" #n ")" ::: "memory")
#define PG8_BAR __builtin_amdgcn_s_barrier()
#define PG8_SCHED __builtin_amdgcn_sched_barrier(0)
    Unit cur, nxt; int ui = 0;
    if (!S.next(0, cur)) return;
    f32x4 acc[2][2][4][2];
#pragma unroll
    for (int a = 0; a < 2; ++a)
#pragma unroll
        for (int b = 0; b < 2; ++b)
#pragma unroll
            for (int m = 0; m < 4; ++m)
#pragma unroll
                for (int n = 0; n < 2; ++n) acc[a][b][m][n] = (f32x4){0.f, 0.f, 0.f, 0.f};
    v8i At[4], B0[2], B1[2];
    const char* cA = S.a_ptr(cur); const char* cB = S.b_ptr(cur);
    unsigned nvA[2][2];
    if constexpr (GATHER) S.a_off(cur, R0, C0, vA);
    PG8_STAGE(PG8_SB(0, 0), cB, voffB); PG8_STAGE(PG8_SB(0, 1), cB + hstep, voffB); PG8_STAGE(PG8_SA(0, 0), cA, vA[0]); PG8_STAGE(PG8_SA(0, 1), cA, vA[1]);
    if (wr == 1) PG8_BAR;
    PG8_WAIT_V(2); PG8_BAR;
    PG8_STAGE(PG8_SB(1, 0), cB + kstep, voffB); PG8_STAGE(PG8_SA(1, 0), cA + kstep, vA[0]); PG8_STAGE(PG8_SB(1, 1), cB + hstep + kstep, voffB);
    PG8_WAIT_V(6); PG8_BAR;
    for (;;) {
        const bool has_next = S.next(ui + 1, nxt);
        const char* nA = has_next ? S.a_ptr(nxt) : cA; const char* nB = has_next ? S.b_ptr(nxt) : cB;
        if constexpr (GATHER) { if (has_next) S.a_off(nxt, R0, C0, nvA); }
#pragma unroll 1
        for (int t = 0; t < NT; t += 2) {
            const bool last = (t == NT - 2);
            const char* a1 = cA + (size_t)(t + 1) * kstep;
            const char* a2 = last ? nA : cA + (size_t)(t + 2) * kstep; const char* b2 = last ? nB : cB + (size_t)(t + 2) * kstep;
            const char* a3 = a2 + kstep; const char* b3 = b2 + kstep;
            PG8_LDB(B0, 0, 0); PG8_LDB(B1, 0, 1); PG8_SCHED; PG8_LDA(At, 0, 0); PG8_STAGE(PG8_SA(1, 1), a1, vA[1]);
            if constexpr (GATHER) { if (last && has_next) {
#pragma unroll
                for (int h = 0; h < 2; ++h)
#pragma unroll
                    for (int i = 0; i < 2; ++i) vA[h][i] = nvA[h][i]; } }
            PG8_WAIT_V(8); PG8_WAIT_L(0); PG8_BAR; PG8_MMA(0, 0, At, B0); PG8_MMA(0, 1, At, B1); PG8_BAR; PG8_SCHED;
            PG8_LDA(At, 0, 1); PG8_STAGE(PG8_SB(0, 0), b2, voffB); PG8_STAGE(PG8_SB(0, 1), b2 + hstep, voffB); PG8_STAGE(PG8_SA(0, 0), a2, vA[0]);
            PG8_WAIT_V(8); PG8_WAIT_L(0); PG8_BAR; PG8_MMA(1, 0, At, B0); PG8_MMA(1, 1, At, B1); PG8_BAR; PG8_SCHED;
            PG8_LDB(B0, 1, 0); PG8_LDB(B1, 1, 1); PG8_SCHED; PG8_LDA(At, 1, 0); PG8_STAGE(PG8_SA(0, 1), a2, vA[1]);
            PG8_WAIT_V(8); PG8_WAIT_L(0); PG8_BAR; PG8_MMA(0, 0, At, B0); PG8_MMA(0, 1, At, B1); PG8_BAR; PG8_SCHED;
            PG8_LDA(At, 1, 1); PG8_STAGE(PG8_SB(1, 0), b3, voffB); PG8_STAGE(PG8_SB(1, 1), b3 + hstep, voffB); PG8_STAGE(PG8_SA(1, 0), a3, vA[0]);
            PG8_WAIT_V(8); PG8_WAIT_L(0); PG8_BAR; PG8_MMA(1, 0, At, B0); PG8_MMA(1, 1, At, B1); PG8_BAR; PG8_SCHED;
        }
        if (wr == 0) PG8_BAR;
        { int le; asm volatile("v_mbcnt_lo_u32_b32 %0, -1, 0\n\tv_mbcnt_hi_u32_b32 %0, -1, %0" : "=v"(le)); E(acc, cur, wr, wc, le & 15, le >> 4); }
        if (!has_next) break;
#pragma unroll
        for (int a = 0; a < 2; ++a)
#pragma unroll
            for (int b = 0; b < 2; ++b)
#pragma unroll
                for (int m = 0; m < 4; ++m)
#pragma unroll
                    for (int n = 0; n < 2; ++n) acc[a][b][m][n] = (f32x4){0.f, 0.f, 0.f, 0.f};
        cur = nxt; cA = nA; cB = nB; ++ui;
        if (wr == 1) PG8_BAR;
    }
    PG8_WAIT_V(0);
    PG8_BAR;
#undef PG8_SA
#undef PG8_SB
#undef PG8_STAGE
#undef PG8_LDA
#undef PG8_LDB
#undef PG8_MMA
#undef PG8_WAIT_V
#undef PG8_WAIT_L
#undef PG8_BAR
#undef PG8_SCHED
}

struct DenseSched {
    const char* A; const char* Bt; int nM, nN, nwg, G, c;
    __device__ __forceinline__ void init(const void* A_, const void* Bt_, int M, int N, int G_, int c_) { A = (const char*)A_; Bt = (const char*)Bt_; nM = M / BM; nN = N / BM; nwg = nM * nN; G = G_; c = c_; }
    __device__ __forceinline__ bool next(int i, Unit& u) const {
        const long L = (long)i * G + c; if (L >= nwg) return false;
        int wgid = (int)L; { const int q = nwg / NXCD, r = nwg % NXCD, xcd = wgid % NXCD, off = wgid / NXCD; wgid = (xcd < r ? xcd * (q + 1) : r * (q + 1) + (xcd - r) * q) + off; }
        const int nig = WGM * nN, gid = wgid / nig, fm = gid * WGM, gsz = (nM - fm) < WGM ? (nM - fm) : WGM;
        u.pm = fm + ((wgid % nig) % gsz); u.pn = (wgid % nig) / gsz; u.e = 0; u.nvalid = 256; u.sbase = 0; return true;
    }
    __device__ __forceinline__ const char* a_ptr(const Unit& u) const { return A + (size_t)u.pm * (BM * K * 2); }
    __device__ __forceinline__ const char* b_ptr(const Unit& u) const { return Bt + (size_t)u.pn * (BM * K * 2); }
    __device__ __forceinline__ void a_off(const Unit&, int, int, unsigned (&)[2][2]) const {}
};
template <int NPN, bool GATHER_A, int KB> struct MoeSched {
    const char* A; const char* Bt; const int* slot; const LAS int* tab; int G, c; size_t bstride;
    __device__ __forceinline__ bool next(int i, Unit& u) const {
        const int ntile = __builtin_amdgcn_readfirstlane(tab[32]);
        int mtg;
        if ((G & 7) == 0) { const int x = c & 7, j = (c >> 3) + (G >> 3) * i; u.pn = j % NPN; mtg = (j / NPN) * 8 + x; if (mtg >= ntile) return false; }
        else { const int lin = i * G + c; if (lin >= ntile * NPN) return false; u.pn = lin % NPN; mtg = lin / NPN; }
        int e = 0;
        while (e < 31 && __builtin_amdgcn_readfirstlane(tab[e + 1]) <= mtg) ++e;
        const int mtl = mtg - __builtin_amdgcn_readfirstlane(tab[e]); int nv = __builtin_amdgcn_readfirstlane(tab[33 + e]) - 256 * mtl; nv = nv > 256 ? 256 : nv;
        u.pm = mtg; u.e = e; u.nvalid = nv; u.sbase = e * CAP + 256 * mtl; return true;
    }
    __device__ __forceinline__ const char* a_ptr(const Unit& u) const { return GATHER_A ? A : A + (size_t)u.pm * (BM * KB); }
    __device__ __forceinline__ const char* b_ptr(const Unit& u) const { return Bt + (size_t)u.e * bstride + (size_t)u.pn * (BM * KB); }
    __device__ __forceinline__ void a_off(const Unit& u, int R0, int C0, unsigned (&v)[2][2]) const {
#pragma unroll
        for (int h = 0; h < 2; ++h)
#pragma unroll
            for (int i = 0; i < 2; ++i) { const int rl = h * 128 + R0 + 64 * i; const int id = (rl < u.nvalid) ? slot[u.sbase + rl] : 0; v[h][i] = (unsigned)(id >> 2) * (unsigned)KB + (unsigned)C0 * 2u; }
    }
};
}

struct EpiInProj {
    static constexpr bool PERM = true;
    unsigned char* ws; const float* tab; const float* rope; int layer;
    template <int TYPE> __device__ __forceinline__ void run(const f32x4 (&acc)[2][2][4][2], const pg8::Unit& u, int wr, int wc, int fr, int fq) const {
        asm volatile("" : "+v"(fr), "+v"(fq));
        const int pn = u.pn, pm = u.pm; const bool ctx = pm >= 128;
        const int bb = ctx ? (pm - 128) : (pm >> 6);
#pragma unroll
        for (int ai = 0; ai < 2; ++ai)
#pragma unroll
            for (int m = 0; m < 4; ++m) {
                const int rl = 128 * ai + 64 * wr + 16 * m + fr; const int row = pm * 256 + rl;
                const int tt = ctx ? rl : (row & (T - 1));
                const int Lk = ctx ? tt : 256 + tt; const int ktile = Lk >> 6, krr = Lk & 63;
#pragma unroll
                for (int bj = 0; bj < 2; ++bj) {
                    const int np = 256 * pn + 128 * bj + 32 * wc + 8 * fq;
                    f32x4 v0 = acc[ai][bj][m][0], v1 = acc[ai][bj][m][1];
                    bf16_t* dst;
                    if (TYPE == 0) {
                        const int dir = np >= 384, col = np - 384 * dir;
                        const f32x4 l0 = *(const f32x4*)(tab + TB_LBT + layer * 384 + col), l1 = *(const f32x4*)(tab + TB_LBT + layer * 384 + col + 4);
#pragma unroll
                        for (int q = 0; q < 4; ++q) { v0[q] = (1.f - l0[q]) * sigmoidf_(-v0[q]); v1[q] = (1.f - l1[q]) * sigmoidf_(-v1[q]); }
                        dst = (bf16_t*)(ws + WS_SCAN + (size_t)(dir ? SC_KB : SC_KF) * SCAN_PITCH) + (size_t)row * 384 + col;
                    } else if (TYPE == 1 || TYPE == 2) {
                        f32x4 cs = (f32x4){1.f, 1.f, 1.f, 1.f}, sn = (f32x4){0.f, 0.f, 0.f, 0.f}; float sc;
                        if (TYPE == 1) {
                            const int m2 = np - 768; const int isk = m2 >= 384, col = m2 - 384 * isk; const int w0 = col & 63;
                            if (!ctx) { cs = *(const f32x4*)(rope + (size_t)tt * 32 + (w0 >> 1)); sn = *(const f32x4*)(rope + (size_t)T * 32 + (size_t)tt * 32 + (w0 >> 1)); }
                            sc = isk ? 0.125f : 1.f;
                            dst = (bf16_t*)(ws + WS_SCAN + (size_t)(isk ? SC_RK : SC_RQ) * SCAN_PITCH) + (size_t)row * 384 + col;
                        } else {
                            const int m3 = np - 1536; const int isk = m3 >= 256, col = m3 - 256 * isk; const int map = col >> 5, w0 = col & 31;
                            if (!ctx) { const float* tb = (w0 < 16) ? (tab + TB_AXR + (tt >> 6) * 8 + (w0 >> 1)) : (tab + TB_AXC + (tt & 63) * 8 + ((w0 - 16) >> 1));
                                        const int so = (w0 < 16) ? 2048 : 512; cs = *(const f32x4*)tb; sn = *(const f32x4*)(tb + so); }
                            sc = isk ? 1.f : 0.17677669529663687f * LOG2E;
                            if (isk) dst = (bf16_t*)(ws + WS_KA) + ((size_t)((bb * 8 + map) * KT_TILES + ktile) * 4 + (w0 >> 3)) * 512 + krr * 8;
                            else if (ctx) dst = (bf16_t*)(ws + WS_QC) + ((size_t)(bb * 8 + map) * CL + tt) * 32 + w0;
                            else dst = (bf16_t*)(ws + WS_QA) + ((size_t)(bb * 8 + map) * T + tt) * 32 + w0;
                        }
                        f32x4 o0, o1;
                        o0[0] = (v0[0] * cs[0] - v0[1] * sn[0]) * sc; o0[1] = (v0[1] * cs[0] + v0[0] * sn[0]) * sc;
                        o0[2] = (v0[2] * cs[1] - v0[3] * sn[1]) * sc; o0[3] = (v0[3] * cs[1] + v0[2] * sn[1]) * sc;
                        o1[0] = (v1[0] * cs[2] - v1[1] * sn[2]) * sc; o1[1] = (v1[1] * cs[2] + v1[0] * sn[2]) * sc;
                        o1[2] = (v1[2] * cs[3] - v1[3] * sn[3]) * sc; o1[3] = (v1[3] * cs[3] + v1[2] * sn[3]) * sc;
                        v0 = o0; v1 = o1;
                    } else {
                        const int m4 = np - 2048; const int seg = m4 / 384, col = m4 - 384 * seg;
                        if (m4 >= 2176) continue;
                        if (seg < 5) dst = (bf16_t*)(ws + WS_SCAN + (size_t)(SC_HQ + seg) * SCAN_PITCH) + (size_t)row * 384 + col;
                        else { const int h4 = col >> 6, w0 = col & 63;
                               const int k5 = krr & 31; unsigned char* vb = ws + WS_VA + (size_t)((bb * 4 + h4) * KT_TILES + ktile) * 4096 + (krr >> 5) * 2048 + (w0 >> 5) * 1024 + ((k5 >> 2) & 1) * 512 + (w0 & 31) * 16 + (k5 & 3) + 4 * (k5 >> 3);
                               const unsigned wa = pk4_fp8(v0[0] * 16.f, v0[1] * 16.f, v0[2] * 16.f, v0[3] * 16.f), wb = pk4_fp8(v1[0] * 16.f, v1[1] * 16.f, v1[2] * 16.f, v1[3] * 16.f);
#pragma unroll
                               for (int i = 0; i < 4; ++i) { vb[16 * i] = (unsigned char)(wa >> (8 * i)); vb[64 + 16 * i] = (unsigned char)(wb >> (8 * i)); }
                               continue; }
                    }
                    u32x4 w; w.x = cvt_pk_bf16(v0[0], v0[1]); w.y = cvt_pk_bf16(v0[2], v0[3]); w.z = cvt_pk_bf16(v1[0], v1[1]); w.w = cvt_pk_bf16(v1[2], v1[3]);
                    *(u32x4*)dst = w;
                }
                if (m == 3) asm volatile("" ::: "memory");
            }
    }
    __device__ __forceinline__ void operator()(const f32x4 (&acc)[2][2][4][2], const pg8::Unit& u, int wr, int wc, int fr, int fq) const {
        if (u.pn < 3) run<0>(acc, u, wr, wc, fr, fq); else if (u.pn < 6) run<1>(acc, u, wr, wc, fr, fq); else if (u.pn < 8) run<2>(acc, u, wr, wc, fr, fq); else run<3>(acc, u, wr, wc, fr, fq);
    }
};
struct EpiBf16Out {
    static constexpr bool PERM = true;
    bf16_t* C;
    __device__ __forceinline__ void operator()(const f32x4 (&acc)[2][2][4][2], const pg8::Unit& u, int wr, int wc, int fr, int fq) const {
        asm volatile("" : "+v"(fr), "+v"(fq));
        const int row0 = u.pm * 256 + wr * 64 + fr, col0 = u.pn * 256 + wc * 32 + 8 * fq;
#pragma unroll
        for (int ai = 0; ai < 2; ++ai)
#pragma unroll
            for (int m = 0; m < 4; ++m) { bf16_t* rowp = C + (size_t)(row0 + ai * 128 + m * 16) * D + col0;
#pragma unroll
                for (int bj = 0; bj < 2; ++bj) { const f32x4 v0 = acc[ai][bj][m][0], v1 = acc[ai][bj][m][1];
                    u32x4 w; w.x = cvt_pk_bf16(v0[0], v0[1]); w.y = cvt_pk_bf16(v0[2], v0[3]); w.z = cvt_pk_bf16(v1[0], v1[1]); w.w = cvt_pk_bf16(v1[2], v1[3]);
                    *(u32x4*)(rowp + bj * 128) = w; } }
    }
};
struct EpiSwiglu {
    static constexpr bool PERM = true;
    unsigned char* act; const float* b1;
    __device__ __forceinline__ void operator()(const f32x4 (&acc)[2][2][4][2], const pg8::Unit& u, int wr, int wc, int fr, int fq) const {
        asm volatile("" : "+v"(fr), "+v"(fq));
        const int j0 = 128 * u.pn + 32 * wc + 8 * fq;
        const float* bp = b1 + (size_t)u.e * 2048 + 2 * j0;
        f32x4 bq[4];
#pragma unroll
        for (int q = 0; q < 4; ++q) bq[q] = *(const f32x4*)(bp + 4 * q);
#pragma unroll
        for (int ai = 0; ai < 2; ++ai)
#pragma unroll
            for (int m = 0; m < 4; ++m) {
                const int rl = 128 * ai + 64 * wr + 16 * m + fr;
                float o[8];
#pragma unroll
                for (int n = 0; n < 2; ++n)
#pragma unroll
                    for (int q = 0; q < 4; ++q) { const int j = 4 * n + q;
                        float g = acc[ai][0][m][n][q] + bq[j >> 1][(j & 1) * 2], l = acc[ai][1][m][n][q] + bq[j >> 1][(j & 1) * 2 + 1];
                        g = fminf(g, 7.f); l = fminf(fmaxf(l, -7.f), 7.f);
                        o[j] = g * sigmoidf_(1.702f * g) * (l + 1.f); }
                u32x2 w; w.x = pk4_fp8(o[0], o[1], o[2], o[3]); w.y = pk4_fp8(o[4], o[5], o[6], o[7]);
                *(u32x2*)(act + (size_t)(u.pm * 256 + rl) * 1024 + j0) = w;
            }
    }
};
struct EpiMoeOut {
    static constexpr bool PERM = true;
    bf16_t* ys; const float* b2; const float* sgate;
    __device__ __forceinline__ void operator()(const f32x4 (&acc)[2][2][4][2], const pg8::Unit& u, int wr, int wc, int fr, int fq) const {
        asm volatile("" : "+v"(fr), "+v"(fq));
        const int c0 = 256 * u.pn + 32 * wc + 8 * fq;
        const float* bp = b2 + (size_t)u.e * 1024 + c0;
        f32x4 bv[2][2];
#pragma unroll
        for (int bj = 0; bj < 2; ++bj)
#pragma unroll
            for (int n = 0; n < 2; ++n) bv[bj][n] = *(const f32x4*)(bp + 128 * bj + 4 * n);
#pragma unroll
        for (int ai = 0; ai < 2; ++ai)
#pragma unroll
            for (int m = 0; m < 4; ++m) {
                const int rl = 128 * ai + 64 * wr + 16 * m + fr;
                const float g = (rl < u.nvalid) ? sgate[u.sbase + rl] : 0.f;
                bf16_t* rowp = ys + (size_t)(u.pm * 256 + rl) * 1024 + c0;
#pragma unroll
                for (int bj = 0; bj < 2; ++bj) { const f32x4 v0 = (acc[ai][bj][m][0] + bv[bj][0]) * g, v1 = (acc[ai][bj][m][1] + bv[bj][1]) * g;
                    u32x4 w; w.x = cvt_pk_bf16(v0[0], v0[1]); w.y = cvt_pk_bf16(v0[2], v0[3]); w.z = cvt_pk_bf16(v1[0], v1[1]); w.w = cvt_pk_bf16(v1[2], v1[3]);
                    *(u32x4*)(rowp + 128 * bj) = w; }
            }
    }
};

__device__ __forceinline__ int map_in(int n) {
    if (n < 384) return 2048 + n;
    if (n < 768) return n - 384;
    if (n < 1152) return 384 + (n - 768);
    if (n < 1536) return 2048 + 384 + (n - 1152);
    if (n < 1920) return 2048 + 768 + (n - 1536);
    if (n < 2688) { const int isk = n >= 2304; const int c = n - 1920 - 384 * isk; const int h = c >> 6, w = c & 63; const int wp = (w < 32) ? 2 * w : 2 * (w - 32) + 1; return 768 + 384 * isk + h * 64 + wp; }
    if (n < 3072) return 2048 + 1152 + (n - 2688);
    if (n < 3456) return 2048 + 1536 + (n - 3072);
    if (n < 3968) { const int isk = n >= 3712; const int c = n - 3456 - 256 * isk; const int h = c >> 5, w = c & 31; const int half = w >> 4, uu = w & 15; const int up = (uu < 8) ? 2 * uu : 2 * (uu - 8) + 1; return 1536 + 256 * isk + h * 32 + half * 16 + up; }
    return 2048 + 1920 + (n - 3968);
}
__device__ __forceinline__ int map_w1(int n) { const int j = n >> 1, lin = n & 1; return (j >> 7) * 256 + lin * 128 + (j & 127); }
template <int MAP> __device__ __forceinline__ void p0_transpose_item(const float* W, int Kd, int N, bf16_t* WT, LAS float* scr, int item, int lane) {
    const int nblk = N / 32, kb = item / nblk, nb = item % nblk, k0 = 64 * kb, n0 = 32 * nb;
    { f32x4 rv[8];
#pragma unroll
      for (int i = 0; i < 8; ++i) rv[i] = *(const f32x4*)(W + (size_t)(k0 + (lane >> 3) + 8 * i) * N + n0 + 4 * (lane & 7));
#pragma unroll
      for (int i = 0; i < 8; ++i) { LAS float* sp_ = scr + ((lane >> 3) + 8 * i) * 33 + 4 * (lane & 7); sp_[0] = rv[i][0]; sp_[1] = rv[i][1]; sp_[2] = rv[i][2]; sp_[3] = rv[i][3]; } }
    LDS_WAIT(); asm volatile("" ::: "memory");
    const int c = lane & 7;
#pragma unroll
    for (int j = 0; j < 4; ++j) { const int n = (lane >> 3) + 8 * j; const LAS float* s = scr + (8 * c) * 33 + n;
        u32x4 o; o.x = pk2(s[0 * 33], s[1 * 33]); o.y = pk2(s[2 * 33], s[3 * 33]); o.z = pk2(s[4 * 33], s[5 * 33]); o.w = pk2(s[6 * 33], s[7 * 33]);
        const int nn = n0 + n; const int dr = MAP == 1 ? map_in(nn) : (MAP == 2 ? map_w1(nn) : nn);
        *(u32x4*)(WT + (size_t)dr * Kd + k0 + 8 * c) = o; }
    LDS_WAIT(); asm volatile("" ::: "memory");
}
template <int MAP> __device__ __forceinline__ void p0_transpose_item_fp8(const float* W, int Kd, int N, unsigned char* WT, LAS float* scr, int item, int lane) {
    const int nblk = N / 32, kb = item / nblk, nb = item % nblk, k0 = 64 * kb, n0 = 32 * nb;
    { f32x4 rv[8];
#pragma unroll
      for (int i = 0; i < 8; ++i) rv[i] = *(const f32x4*)(W + (size_t)(k0 + (lane >> 3) + 8 * i) * N + n0 + 4 * (lane & 7));
#pragma unroll
      for (int i = 0; i < 8; ++i) { LAS float* sp_ = scr + ((lane >> 3) + 8 * i) * 33 + 4 * (lane & 7); sp_[0] = rv[i][0]; sp_[1] = rv[i][1]; sp_[2] = rv[i][2]; sp_[3] = rv[i][3]; } }
    LDS_WAIT(); asm volatile("" ::: "memory");
    const int n = lane >> 1, hf = lane & 1; const LAS float* sp = scr + (32 * hf) * 33 + n;
    u32x4 o0, o1;
#pragma unroll
    for (int q = 0; q < 4; ++q) { o0[q] = pk4_fp8(sp[(4 * q) * 33] * W8_MUL, sp[(4 * q + 1) * 33] * W8_MUL, sp[(4 * q + 2) * 33] * W8_MUL, sp[(4 * q + 3) * 33] * W8_MUL);
                                  o1[q] = pk4_fp8(sp[(16 + 4 * q) * 33] * W8_MUL, sp[(16 + 4 * q + 1) * 33] * W8_MUL, sp[(16 + 4 * q + 2) * 33] * W8_MUL, sp[(16 + 4 * q + 3) * 33] * W8_MUL); }
    const int nn = n0 + n; const int dr = MAP == 2 ? map_w1(nn) : nn;
    unsigned char* dp = WT + (size_t)dr * Kd + k0 + 32 * hf;
    *(u32x4*)dp = o0; *(u32x4*)(dp + 16) = o1;
    LDS_WAIT(); asm volatile("" ::: "memory");
}
__device__ __forceinline__ void phase_prologue_a(Frame& F) {
    PHASE_IDS();
    LAS float* scr = (LAS float*)(F.lds + wave * 16384);
    const int gw = blk_ * NWAVES + wave, NGW = F.G * NWAVES;
    unsigned char* ws = F.ws;
    constexpr int I_IN = 16 * 132, I_OUT = 16 * 32, I_W1 = 16 * 64, I_W2 = 16 * 32;
    constexpr int PER_L = I_IN + I_OUT + NE * (I_W1 + I_W2);
    for (int it = gw; it < 2 * PER_L; it += NGW) {
        const int l = it / PER_L; int r = it % PER_L;
        if (r < I_IN) { p0_transpose_item<1>(F.in[7] + (size_t)l * 1024 * 4224, 1024, 4224, (bf16_t*)(ws + WS_WIN) + (size_t)l * NIN * 1024, scr, r, lane); continue; } r -= I_IN;
        if (r < I_OUT) { p0_transpose_item<0>(F.in[14] + (size_t)l * 1024 * 1024, 1024, 1024, (bf16_t*)(ws + WS_WOUT) + (size_t)l * 1024 * 1024, scr, r, lane); continue; } r -= I_OUT;
        const int e = r / (I_W1 + I_W2); r -= e * (I_W1 + I_W2);
        if (r < I_W1) p0_transpose_item_fp8<2>(F.in[17] + ((size_t)l * NE + e) * 1024 * 2048, 1024, 2048, ws + WS_W1 + ((size_t)l * NE + e) * 2048 * 1024, scr, r, lane);
        else p0_transpose_item_fp8<0>(F.in[19] + ((size_t)l * NE + e) * 1024 * 1024, 1024, 1024, ws + WS_W2 + ((size_t)l * NE + e) * 1024 * 1024, scr, r - I_W1, lane);
    }
    for (int i = gw * 64 + lane; i < 2 * 128 * 1024 / 8; i += NGW * 64) { const int l = i / (128 * 128), rr = i % (128 * 128);
        *(u32x4*)((bf16_t*)(ws + WS_WIN) + ((size_t)l * NIN + 4224) * 1024 + (size_t)rr * 8) = (u32x4){0u, 0u, 0u, 0u}; }
    for (int it = gw; it < 2 * 96; it += NGW) {
        const int l = it / 96, n0 = (it % 96) * 64, n = n0 + lane;
        const float* mw = F.in[4] + (size_t)l * 1024 * 6144;
        float a0 = 0.f, a1 = 0.f, a2 = 0.f;
        for (int kb = 0; kb < 16; ++kb) {
            const int kk = kb * 64 + lane;
            float c0 = F.in[1][kk], c1 = F.in[1][1024 + kk], c2 = F.in[3][kk];
            c0 = c0 * sigmoidf_(c0); c1 = c1 * sigmoidf_(c1); c2 = c2 * sigmoidf_(c2);
#pragma unroll 8
            for (int j = 0; j < 64; ++j) { const float w = mw[(size_t)(kb * 64 + j) * 6144 + n]; a0 += rdlane(c0, j) * w; a1 += rdlane(c1, j) * w; a2 += rdlane(c2, j) * w; }
        }
        const float bias = F.in[5][l * 6144 + n];
        const int ch = n >> 10, col = n & 1023;
        const float* ng = F.in[6] + (size_t)l * 4096;
        float vals[3] = {a0 + bias, a1 + bias, a2 + bias};
#pragma unroll
        for (int w = 0; w < 3; ++w) { float v = vals[w];
            if (ch == 1) v = (1.f + v) * ng[col]; else if (ch == 2) v = v * ng[1024 + col]; else if (ch == 4) v = (1.f + v) * ng[2048 + col]; else if (ch == 5) v = v * ng[3072 + col];
            const int slot = (ch == 0) ? 1 : (ch == 1) ? 0 : (ch == 2) ? 2 : (ch == 3) ? 4 : (ch == 4) ? 3 : 5;
            ((float*)(ws + WS_MODV))[((size_t)(l * 3 + w) * 6 + slot) * 1024 + col] = v; }
    }
    float* tab = (float*)(ws + WS_TAB);
    const int gt = blk_ * NTHR + tid, NGT = F.G * NTHR;
    for (int i = gt; i < 2 * 384; i += NGT) { const int l = i / 384, c = i % 384; const float a = F.in[8][c], b = F.in[8][384 + c];
        tab[TB_LBT + i] = (l == 0) ? 0.f : 1.f / (1.f + expf(a - b)); }
    if (gt < 2) { const int l = gt; const float* lm = F.in[12] + l * 128; float s0 = 0.f, s1 = 0.f;
        for (int i = 0; i < 32; ++i) { s0 += lm[i] * lm[32 + i]; s1 += lm[64 + i] * lm[96 + i]; }
        const float li = 0.8f - 0.6f * expf(-0.3f * (float)l);
        tab[TB_LAM + l] = expf(s0) - expf(s1) + li; tab[TB_LAM + 2 + l] = 1.f - li; }
    if (gt < 24) tab[TB_GAM + gt] = 1.f - exp2f(-F.in[10][gt]);
    for (int i = gt; i < 256 * 8 + 64 * 8; i += NGT) {
        const bool isr = i < 2048; const int ii = isr ? i : i - 2048; const int pos = ii >> 3, j = ii & 7;
        const float inv = exp2f(-(float)j * (13.287712379549449f / 8.f));
        const double rev = (double)pos * (double)inv * 0.15915494309189535; const float fr = (float)(rev - floor(rev));
        const float cs = __builtin_amdgcn_cosf(fr), sn = __builtin_amdgcn_sinf(fr);
        if (isr) { tab[TB_AXR + ii] = cs; tab[TB_AXR + 2048 + ii] = sn; } else { tab[TB_AXC + ii] = cs; tab[TB_AXC + 512 + ii] = sn; }
    }
    float* rope = (float*)(ws + WS_ROPE);
    for (int i = gt; i < T * 32; i += NGT) { const int pos = i >> 5, j = i & 31;
        const float inv = exp2f(-(float)j * (13.287712379549449f / 32.f));
        const double rev = (double)pos * (double)inv * 0.15915494309189535; const float fr = (float)(rev - floor(rev));
        rope[i] = __builtin_amdgcn_cosf(fr); rope[(size_t)T * 32 + i] = __builtin_amdgcn_sinf(fr); }
    bf16_t* rwh = (bf16_t*)(ws + WS_RWT); bf16_t* rwl = rwh + 2 * 32 * 1024;
    for (int i = gt; i < 2 * 32 * 1024; i += NGT) { const int l = i >> 15, e = (i >> 10) & 31, c = i & 1023; const float wv = F.in[15][((size_t)l * 1024 + c) * 32 + e];
        const unsigned hb = f2bf(wv); rwh[i] = (bf16_t)hb; rwl[i] = (bf16_t)f2bf(wv - __builtin_bit_cast(float, hb << 16)); }
}

__device__ __forceinline__ float row_sumsq(const f32x4 (&v)[4]) {
    float s = 0.f;
#pragma unroll
    for (int j = 0; j < 4; ++j) s += (v[j][0] * v[j][0] + v[j][1] * v[j][1]) + (v[j][2] * v[j][2] + v[j][3] * v[j][3]);
    return wave_sum(s);
}
__device__ __forceinline__ void row_load(const float* p, int lane, f32x4 (&v)[4]) {
#pragma unroll
    for (int j = 0; j < 4; ++j) v[j] = *(const f32x4*)(p + 4 * lane + 256 * j);
}
__device__ __forceinline__ void row_store(float* p, int lane, const f32x4 (&v)[4]) {
#pragma unroll
    for (int j = 0; j < 4; ++j) *(f32x4*)(p + 4 * lane + 256 * j) = v[j];
}
__device__ __forceinline__ void row_store_bf16(bf16_t* p, int lane, const f32x4 (&v)[4]) {
#pragma unroll
    for (int j = 0; j < 4; ++j) { u32x2 w; w.x = pk2(v[j][0], v[j][1]); w.y = pk2(v[j][2], v[j][3]); *(u32x2*)(p + 4 * lane + 256 * j) = w; }
}
__device__ __forceinline__ int row_which(int r) { return r < NLAT ? (r >> 14) : 2; }
__device__ __forceinline__ void row_norm_mod(const f32x4 (&x)[4], const float* a, const float* b, int lane, f32x4 (&o)[4]) {
    const float r = __builtin_amdgcn_rsqf(row_sumsq(x) * (1.f / 1024.f) + EPS);
#pragma unroll
    for (int j = 0; j < 4; ++j) { const f32x4 av = *(const f32x4*)(a + 4 * lane + 256 * j), bv = *(const f32x4*)(b + 4 * lane + 256 * j); o[j] = x[j] * r * av + bv; }
}
__device__ __forceinline__ void phase_prologue_b(Frame& F) {
    PHASE_IDS();
    const int gw = blk_ * NWAVES + wave, NGW = F.G * NWAVES;
    const float* modv = (const float*)(F.ws + WS_MODV);
    for (int r = gw; r < NROW; r += NGW) {
        const float* src = r < NLAT ? F.in[0] + (size_t)r * D : F.in[2] + (size_t)(r - NLAT) * D;
        const int w = row_which(r);
        f32x4 x[4], o[4]; row_load(src, lane, x);
        row_norm_mod(x, modv + (size_t)(0 * 3 + w) * 6 * 1024, modv + ((size_t)(0 * 3 + w) * 6 + 1) * 1024, lane, o);
        row_store_bf16((bf16_t*)(F.ws + WS_H) + (size_t)r * D, lane, o);
    }
}

__device__ __forceinline__ int scan_row(int sc, int p, int dir, int b) {
    if (sc == 0) return NLAT + b * CL + (dir ? (CL - 1 - p) : p);
    const int tt = (sc - 1) * 256 + p; return b * T + (dir ? (T - 1 - tt) : tt);
}
template <int TYPE, bool WITHQ>
__device__ __forceinline__ float scan_step(float (&S)[64], const LAS float* kq, float vv, float gam) {
    float o = 0.f;
#pragma unroll
    for (int kg = 0; kg < 8; ++kg) {
        f32x4 kv[2], qv[2];
#pragma unroll
        for (int j = 0; j < 2; ++j) { kv[j] = *(const LAS f32x4*)(kq + kg * 8 + 4 * j); if (WITHQ) qv[j] = *(const LAS f32x4*)(kq + 64 + kg * 8 + 4 * j); }
#pragma unroll
        for (int j = 0; j < 8; ++j) { const int k = kg * 8 + j; const float kk = kv[j >> 2][j & 3];
            if (TYPE == 0) S[k] = __builtin_fmaf(kk, vv - S[k], S[k]); else S[k] = __builtin_fmaf(kk, vv, gam * S[k]);
            if (WITHQ) o = __builtin_fmaf(qv[j >> 2][j & 3], S[k], o); }
        asm volatile("" ::: "memory"); __builtin_amdgcn_sched_barrier(0);
    }
    return o;
}
__device__ __forceinline__ void phase_scan_a(Frame& F, int layer) {
    PHASE_IDS();
    const int gw = blk_ * NWAVES + wave, NGW = F.G * NWAVES;
    const float* tab = (const float*)(F.ws + WS_TAB);
    LAS float* scr = (LAS float*)(F.lds + wave * 2048);
    for (int wu = gw; wu < NSEQ * NSC; wu += NGW) {
        const int s = wu / NSC, sc = wu % NSC; const int type = s / 24, rem = s % 24, b = rem / 12, h = (rem % 12) >> 1, dir = rem & 1;
        const bf16_t* Kb = (const bf16_t*)(F.ws + WS_SCAN + (size_t)(type ? SC_RK : (dir ? SC_KB : SC_KF)) * SCAN_PITCH);
        const bf16_t* Vb = (const bf16_t*)(F.ws + WS_SCAN + (size_t)(type ? SC_RV : SC_HV) * SCAN_PITCH);
        unsigned co = (unsigned)(h * 64 + lane); asm volatile("" : "+v"(co));
        const float gam = tab[TB_GAM + layer * 12 + dir * 6 + h];
        float S[64];
#pragma unroll
        for (int k = 0; k < 64; ++k) S[k] = 0.f;
        float dprod = 1.f;
        float kc[4], vc[4], kn[4], vn[4];
#pragma unroll
        for (int i = 0; i < 4; ++i) { const unsigned ro = (unsigned)scan_row(sc, i, dir, b) * 384u + co; kc[i] = bf2f(Kb[ro]); vc[i] = bf2f(Vb[ro]); kn[i] = 0.f; vn[i] = 0.f; }
        for (int p0 = 0; p0 < 256; p0 += 4) {
            if (p0 + 4 < 256) {
#pragma unroll
                for (int i = 0; i < 4; ++i) { const unsigned ro = (unsigned)scan_row(sc, p0 + 4 + i, dir, b) * 384u + co; kn[i] = bf2f(Kb[ro]); vn[i] = bf2f(Vb[ro]); }
            }
#pragma unroll
            for (int i = 0; i < 4; ++i) scr[i * 128 + lane] = kc[i];
#pragma unroll
            for (int i = 0; i < 4; ++i) {
                if (type == 0) { dprod *= (1.f - kc[i]); (void)scan_step<0, false>(S, scr + i * 128, vc[i], gam); }
                else { dprod *= gam; (void)scan_step<1, false>(S, scr + i * 128, vc[i], gam); }
            }
#pragma unroll
            for (int i = 0; i < 4; ++i) { kc[i] = kn[i]; vc[i] = vn[i]; }
        }
        float* sl = (float*)(F.ws + WS_SLOC) + (size_t)wu * 4096 + lane;
#pragma unroll
        for (int k = 0; k < 64; ++k) { *sl = S[k]; sl += 64; asm volatile("" : "+v"(sl)); }
        ((float*)(F.ws + WS_DEC))[(size_t)wu * 64 + lane] = dprod;
    }
}
__device__ __forceinline__ void phase_scan_b(Frame& F) {
    const float* sloc = (const float*)(F.ws + WS_SLOC); const float* dec = (const float*)(F.ws + WS_DEC); float* sin_ = (float*)(F.ws + WS_SIN);
    PHASE_IDS();
    for (int idx = blk_ * NTHR + tid; idx < NSEQ * 4096; idx += F.G * NTHR) {
        const int s = idx >> 12, kv = idx & 4095, k = kv >> 6; float st = 0.f;
#pragma unroll 8
        for (int sc = 0; sc < NSC - 1; ++sc) { const size_t u = (size_t)s * NSC + sc; st = dec[u * 64 + k] * st + sloc[u * 4096 + kv]; sin_[(u + 1) * 4096 + kv] = st; }
    }
}
template <int TYPE, bool SECOND>
__device__ __forceinline__ void scan_dir(Frame& F, int lane_in, int wave, int layer, int b, int h, int dir, int sc, bool zero_state) {
    int lane = lane_in; asm volatile("" : "+v"(lane));
    const float* tab = (const float*)(F.ws + WS_TAB);
    const int s = TYPE * 24 + b * 12 + h * 2 + dir;
    const bf16_t* Kb = (const bf16_t*)(F.ws + WS_SCAN + (size_t)(TYPE ? SC_RK : (dir ? SC_KB : SC_KF)) * SCAN_PITCH);
    const bf16_t* Vb = (const bf16_t*)(F.ws + WS_SCAN + (size_t)(TYPE ? SC_RV : SC_HV) * SCAN_PITCH);
    const bf16_t* Qb = (const bf16_t*)(F.ws + WS_SCAN + (size_t)(TYPE ? SC_RQ : SC_HQ) * SCAN_PITCH);
    const bf16_t* Gb = (const bf16_t*)(F.ws + WS_SCAN + (size_t)(TYPE ? SC_RG : SC_HG) * SCAN_PITCH);
    float* oscr = (float*)(F.ws + WS_OSCR);
    bf16_t* mix = (bf16_t*)(F.ws + WS_MIX);
    unsigned co = (unsigned)(h * 64 + lane); asm volatile("" : "+v"(co));
    const unsigned co2 = co + TYPE * 384;
    const float gam = tab[TB_GAM + layer * 12 + dir * 6 + h];
    const float nw = F.in[TYPE ? 11 : 9][layer * 64 + lane];
    LAS float* scr = (LAS float*)(F.lds + wave * 2048);
    float S[64];
    if (zero_state) {
#pragma unroll
        for (int k = 0; k < 64; ++k) S[k] = 0.f;
    } else { const float* si = (const float*)(F.ws + WS_SIN) + ((size_t)s * NSC + sc) * 4096 + lane;
#pragma unroll
        for (int k = 0; k < 64; ++k) { S[k] = *si; si += 64; asm volatile("" : "+v"(si)); } }
    float kc[2], vc[2], qc[2], kn[2], vn[2], qn[2];
#pragma unroll
    for (int i = 0; i < 2; ++i) { const unsigned ro = (unsigned)scan_row(sc, i, dir, b) * 384u + co; kc[i] = bf2f(Kb[ro]); vc[i] = bf2f(Vb[ro]); qc[i] = bf2f(Qb[ro]); kn[i] = 0.f; vn[i] = 0.f; qn[i] = 0.f; }
    for (int p0 = 0; p0 < 256; p0 += 2) {
        if (p0 + 2 < 256) {
#pragma unroll
            for (int i = 0; i < 2; ++i) { const unsigned ro = (unsigned)scan_row(sc, p0 + 2 + i, dir, b) * 384u + co; kn[i] = bf2f(Kb[ro]); vn[i] = bf2f(Vb[ro]); qn[i] = bf2f(Qb[ro]); }
        }
#pragma unroll
        for (int i = 0; i < 2; ++i) { scr[i * 128 + lane] = kc[i]; scr[i * 128 + 64 + lane] = qc[i]; }
#pragma unroll
        for (int i = 0; i < 2; ++i) {
            float o = scan_step<TYPE, true>(S, scr + i * 128, vc[i], gam);
            const unsigned row = (unsigned)scan_row(sc, p0 + i, dir, b);
            if (!SECOND) oscr[row * 768u + co2] = o;
            else { o += oscr[row * 768u + co2];
                const float r = __builtin_amdgcn_rsqf(wave_sum_dpp(o * o) * (1.f / 64.f) + EPS);
                const float g = bf2f(Gb[row * 384u + co]);
                mix[row * 1024u + co2] = (bf16_t)f2bf(o * r * nw * g * sigmoidf_(g)); }
            asm volatile("" ::: "memory");
        }
#pragma unroll
        for (int i = 0; i < 2; ++i) { kc[i] = kn[i]; vc[i] = vn[i]; qc[i] = qn[i]; }
    }
}
__device__ __forceinline__ void phase_scan_c(Frame& F, int layer) {
    PHASE_IDS();
    const int gw = blk_ * NWAVES + wave, NGW = F.G * NWAVES;
    const bool need_ctx = layer == 0;
    for (int wu = gw; wu < 24 * NSC; wu += NGW) {
        const int sq = wu / NSC, blk = wu % NSC; const int type = sq / 12, b = (sq % 12) / 6, h = sq % 6;
        if (blk == 0 && !need_ctx) continue;
        const int scf = blk, scb = (blk == 0) ? 0 : 65 - blk;
        if (type == 0) { scan_dir<0, false>(F, lane, wave, layer, b, h, 0, scf, scf == 0); scan_dir<0, true>(F, lane, wave, layer, b, h, 1, scb, scb == 0); }
        else           { scan_dir<1, false>(F, lane, wave, layer, b, h, 0, scf, scf == 0); scan_dir<1, true>(F, lane, wave, layer, b, h, 1, scb, scb == 0); }
    }
}


namespace sc2 {
constexpr int WLDS = 8448;
__device__ __forceinline__ f32x4 mfma16(bf16x8 a, bf16x8 b, f32x4 c) { return __builtin_amdgcn_mfma_f32_16x16x32_bf16(a, b, c, 0, 0, 0); }
template <int TYPE, int MODE>
__device__ __forceinline__ void run(Frame& F, int lane_in, int wave, int layer, int b, int h, int dir, int sc, bool zero_state, int wu_out) {
    int lane = lane_in; asm volatile("" : "+v"(lane));
    const int g = lane >> 4, n = lane & 15;
    const float* tab = (const float*)(F.ws + WS_TAB);
    const int s = TYPE * 24 + b * 12 + h * 2 + dir;
    const bf16_t* Kb = (const bf16_t*)(F.ws + WS_SCAN + (size_t)(TYPE ? SC_RK : (dir ? SC_KB : SC_KF)) * SCAN_PITCH);
    const bf16_t* Vb = (const bf16_t*)(F.ws + WS_SCAN + (size_t)(TYPE ? SC_RV : SC_HV) * SCAN_PITCH);
    const bf16_t* Qb = (const bf16_t*)(F.ws + WS_SCAN + (size_t)(TYPE ? SC_RQ : SC_HQ) * SCAN_PITCH);
    const bf16_t* Gb = (const bf16_t*)(F.ws + WS_SCAN + (size_t)(TYPE ? SC_RG : SC_HG) * SCAN_PITCH);
    float* oscr = (float*)(F.ws + WS_OSCR);
    bf16_t* mix = (bf16_t*)(F.ws + WS_MIX);
    const unsigned co = (unsigned)(h * 64 + lane);
    const float lg2 = TYPE ? __builtin_amdgcn_logf(tab[TB_GAM + layer * 12 + dir * 6 + h]) : 0.f;
    LAS unsigned char* wl = F.lds + wave * WLDS;
    LAS bf16_t* QT = (LAS bf16_t*)wl; LAS bf16_t* KT = (LAS bf16_t*)(wl + 2048); LAS bf16_t* KPT = (LAS bf16_t*)(wl + 4096); LAS bf16_t* VT = (LAS bf16_t*)(wl + 6144); LAS float* DD = (LAS float*)(wl + 8192);
    f32x4 S[4][4];
    if (zero_state) {
#pragma unroll
        for (int kb = 0; kb < 4; ++kb)
#pragma unroll
            for (int vb = 0; vb < 4; ++vb) S[kb][vb] = (f32x4){0.f, 0.f, 0.f, 0.f};
    } else { const float* si = (const float*)(F.ws + WS_SIN) + ((size_t)s * NSC + sc) * 4096;
#pragma unroll
        for (int kb = 0; kb < 4; ++kb)
#pragma unroll
            for (int vb = 0; vb < 4; ++vb)
#pragma unroll
                for (int r = 0; r < 4; ++r) S[kb][vb][r] = si[(16 * kb + 4 * g + r) * 64 + 16 * vb + n]; }
    float dtot = 1.f;
    const float gam = TYPE ? tab[TB_GAM + layer * 12 + dir * 6 + h] : 0.f;
    unsigned short kr[16], vr[16], qr[16];
#pragma unroll
    for (int t = 0; t < 16; ++t) { const unsigned ro = (unsigned)scan_row(sc, t, dir, b) * 384u + co; kr[t] = Kb[ro]; vr[t] = Vb[ro]; if (MODE != 0) qr[t] = Qb[ro]; else qr[t] = 0; }
    for (int blk = 0; blk < 16; ++blk) {
        const unsigned row = (unsigned)scan_row(sc, 16 * blk + n, dir, b);
        const unsigned ob = row * 768u + (unsigned)(TYPE * 384 + h * 64 + 4 * g);
        f32x4 of[4]; u32x2 gg[4];
        if (MODE == 2) {
#pragma unroll
            for (int vb = 0; vb < 4; ++vb) { of[vb] = *(const f32x4*)(oscr + ob + 16 * vb); gg[vb] = *(const u32x2*)(Gb + row * 384u + (unsigned)(h * 64 + 16 * vb + 4 * g)); }
        }
        float ek[16]; float eq = 1.f;
#pragma unroll
        for (int t = 0; t < 16; ++t) { const float kk = bf2f(kr[t]);
            eq = fmaxf(eq * (TYPE == 0 ? 1.f - kk : gam), 7.9e-31f);
            ek[t] = __builtin_amdgcn_rcpf(eq);
            if (MODE != 0) { QT[t * 64 + lane] = (bf16_t)f2bf(bf2f(qr[t]) * eq); KT[t * 64 + lane] = (bf16_t)f2bf(kk * ek[t]); } }
        dtot *= eq; DD[lane] = eq;
        { u32x4 w0, w1, x0, x1;
#pragma unroll
          for (int q = 0; q < 4; ++q) {
              w0[q] = cvt_pk_bf16(bf2f(kr[2 * q]) * (eq * ek[2 * q]), bf2f(kr[2 * q + 1]) * (eq * ek[2 * q + 1]));
              w1[q] = cvt_pk_bf16(bf2f(kr[8 + 2 * q]) * (eq * ek[8 + 2 * q]), bf2f(kr[8 + 2 * q + 1]) * (eq * ek[8 + 2 * q + 1]));
              x0[q] = (unsigned)vr[2 * q] | ((unsigned)vr[2 * q + 1] << 16); x1[q] = (unsigned)vr[8 + 2 * q] | ((unsigned)vr[8 + 2 * q + 1] << 16); }
          *(LAS u32x4*)(KPT + lane * 16) = w0; *(LAS u32x4*)(KPT + lane * 16 + 8) = w1; *(LAS u32x4*)(VT + lane * 16) = x0; *(LAS u32x4*)(VT + lane * 16 + 8) = x1; }
        if (blk + 1 < 16) {
#pragma unroll
            for (int t = 0; t < 16; ++t) { const unsigned ro = (unsigned)scan_row(sc, 16 * (blk + 1) + t, dir, b) * 384u + co; kr[t] = Kb[ro]; vr[t] = Vb[ro]; if (MODE != 0) qr[t] = Qb[ro]; }
        }
        asm volatile("s_waitcnt lgkmcnt(0)" ::: "memory");
        if (MODE != 0) {
            f32x4 sct = (f32x4){0.f, 0.f, 0.f, 0.f};
#pragma unroll
            for (int ks = 0; ks < 2; ++ks) { const bf16x8 a = *(const LAS bf16x8*)(KT + n * 64 + 32 * ks + 8 * g), bq = *(const LAS bf16x8*)(QT + n * 64 + 32 * ks + 8 * g); sct = mfma16(a, bq, sct); }
#pragma unroll
            for (int r = 0; r < 4; ++r) sct[r] = (4 * g + r <= n) ? sct[r] : 0.f;
            u32x4 bs; bs.x = cvt_pk_bf16(sct[0], sct[1]); bs.y = cvt_pk_bf16(sct[2], sct[3]); bs.z = 0u; bs.w = 0u;
            f32x4 o[4];
#pragma unroll
            for (int vb = 0; vb < 4; ++vb) { const u32x2 lo = *(const LAS u32x2*)(VT + (16 * vb + n) * 16 + 4 * g); u32x4 av; av.x = lo.x; av.y = lo.y; av.z = 0u; av.w = 0u;
                o[vb] = mfma16(__builtin_bit_cast(bf16x8, av), __builtin_bit_cast(bf16x8, bs), (f32x4){0.f, 0.f, 0.f, 0.f}); }
#pragma unroll
            for (int ks = 0; ks < 2; ++ks) {
                const u32x2 q0 = *(const LAS u32x2*)(QT + n * 64 + 32 * ks + 4 * g), q1 = *(const LAS u32x2*)(QT + n * 64 + 32 * ks + 16 + 4 * g);
                u32x4 bq; bq.x = q0.x; bq.y = q0.y; bq.z = q1.x; bq.w = q1.y;
#pragma unroll
                for (int vb = 0; vb < 4; ++vb) { u32x4 av; av.x = cvt_pk_bf16(S[2 * ks][vb][0], S[2 * ks][vb][1]); av.y = cvt_pk_bf16(S[2 * ks][vb][2], S[2 * ks][vb][3]);
                    av.z = cvt_pk_bf16(S[2 * ks + 1][vb][0], S[2 * ks + 1][vb][1]); av.w = cvt_pk_bf16(S[2 * ks + 1][vb][2], S[2 * ks + 1][vb][3]);
                    o[vb] = mfma16(__builtin_bit_cast(bf16x8, av), __builtin_bit_cast(bf16x8, bq), o[vb]); }
            }
            if (MODE == 1) {
#pragma unroll
                for (int vb = 0; vb < 4; ++vb) *(f32x4*)(oscr + ob + 16 * vb) = o[vb];
            } else {
                float ss = 0.f;
#pragma unroll
                for (int vb = 0; vb < 4; ++vb) { o[vb] = o[vb] + of[vb]; ss += (o[vb][0] * o[vb][0] + o[vb][1] * o[vb][1]) + (o[vb][2] * o[vb][2] + o[vb][3] * o[vb][3]); }
                ss += xor_swz<16>(ss); ss += xor32(ss, lane);
                const float rn = __builtin_amdgcn_rsqf(ss * (1.f / 64.f) + EPS);
                const float* nw = F.in[TYPE ? 11 : 9] + layer * 64 + 4 * g;
#pragma unroll
                for (int vb = 0; vb < 4; ++vb) { const f32x4 w4 = *(const f32x4*)(nw + 16 * vb);
                    const float g0 = bflo(gg[vb].x), g1 = bfhi(gg[vb].x), g2 = bflo(gg[vb].y), g3 = bfhi(gg[vb].y);
                    u32x2 w; w.x = cvt_pk_bf16(o[vb][0] * rn * w4[0] * g0 * sigmoidf_(g0), o[vb][1] * rn * w4[1] * g1 * sigmoidf_(g1)); w.y = cvt_pk_bf16(o[vb][2] * rn * w4[2] * g2 * sigmoidf_(g2), o[vb][3] * rn * w4[3] * g3 * sigmoidf_(g3));
                    *(u32x2*)(mix + row * 1024u + (unsigned)(TYPE * 384 + h * 64 + 16 * vb + 4 * g)) = w; }
            }
        }
#pragma unroll
        for (int kb = 0; kb < 4; ++kb) { const f32x4 d4 = *(const LAS f32x4*)(DD + 16 * kb + 4 * g);
#pragma unroll
            for (int vb = 0; vb < 4; ++vb) S[kb][vb] = S[kb][vb] * d4; }
        { bf16x8 af[4], bfv[4];
#pragma unroll
          for (int q = 0; q < 4; ++q) { u32x4 a = *(const LAS u32x4*)(KPT + (16 * q + n) * 16 + 8 * (g & 1)), bq = *(const LAS u32x4*)(VT + (16 * q + n) * 16 + 8 * (g & 1));
              if (g >= 2) { a = (u32x4){0u, 0u, 0u, 0u}; bq = (u32x4){0u, 0u, 0u, 0u}; }
              af[q] = __builtin_bit_cast(bf16x8, a); bfv[q] = __builtin_bit_cast(bf16x8, bq); }
#pragma unroll
          for (int kb = 0; kb < 4; ++kb)
#pragma unroll
              for (int vb = 0; vb < 4; ++vb) S[kb][vb] = mfma16(af[kb], bfv[vb], S[kb][vb]); }
        asm volatile("s_waitcnt lgkmcnt(0)" ::: "memory");
    }
    if (MODE == 0) {
        float* sl = (float*)(F.ws + WS_SLOC) + (size_t)wu_out * 4096;
#pragma unroll
        for (int kb = 0; kb < 4; ++kb)
#pragma unroll
            for (int vb = 0; vb < 4; ++vb)
#pragma unroll
                for (int r = 0; r < 4; ++r) sl[(16 * kb + 4 * g + r) * 64 + 16 * vb + n] = S[kb][vb][r];
        ((float*)(F.ws + WS_DEC))[(size_t)wu_out * 64 + lane] = dtot;
    }
}
}
__device__ __forceinline__ void phase_scan2_a(Frame& F, int layer) {
    PHASE_IDS();
    const int gw = blk_ * NWAVES + wave, NGW = F.G * NWAVES;
    for (int wu = gw; wu < NSEQ * NSC; wu += NGW) {
        const int s = wu / NSC, sc = wu % NSC; const int type = s / 24, rem = s % 24, b = rem / 12, h = (rem % 12) >> 1, dir = rem & 1;
        if (type == 0) sc2::run<0, 0>(F, lane, wave, layer, b, h, dir, sc, true, wu); else sc2::run<1, 0>(F, lane, wave, layer, b, h, dir, sc, true, wu);
    }
}
__device__ __forceinline__ void phase_scan2_c(Frame& F, int layer) {
    PHASE_IDS();
    const int gw = blk_ * NWAVES + wave, NGW = F.G * NWAVES;
    const bool need_ctx = layer == 0;
    for (int wu = gw; wu < 24 * NSC; wu += NGW) {
        const int sq = wu / NSC, blk = wu % NSC; const int type = sq / 12, b = (sq % 12) / 6, h = sq % 6;
        if (blk == 0 && !need_ctx) continue;
        const int scf = blk, scb = (blk == 0) ? 0 : 65 - blk;
        if (type == 0) { sc2::run<0, 1>(F, lane, wave, layer, b, h, 0, scf, scf == 0, 0); sc2::run<0, 2>(F, lane, wave, layer, b, h, 1, scb, scb == 0, 0); }
        else           { sc2::run<1, 1>(F, lane, wave, layer, b, h, 0, scf, scf == 0, 0); sc2::run<1, 2>(F, lane, wave, layer, b, h, 1, scb, scb == 0, 0); }
    }
}

namespace att {
constexpr int SLOT = 32768, NS = 3, WSF_OFF = NS * SLOT, OST_OFF = 0, OST_W = 32 * 68 * 4;
__device__ __forceinline__ int crow(int r, int hi) { return (r & 3) + 8 * (r >> 2) + 4 * hi; }
typedef short v4i16_t __attribute__((ext_vector_type(4)));
typedef LAS const char* lds_cptr;
__device__ __forceinline__ s16x4 vtr(lds_cptr p) { return __builtin_bit_cast(s16x4, __builtin_amdgcn_ds_read_tr16_b64_v4i16((LAS v4i16_t*)p)); }
__device__ __forceinline__ float max3f(float a, float b, float c) { return __builtin_fmaxf(__builtin_fmaxf(a, b), c); }
__device__ __forceinline__ float hmax32(const f32x16& p0, const f32x16& p1) {
    float a = max3f(p0[0], p0[1], p1[0]), b = max3f(p0[2], p0[3], p1[1]); a = max3f(a, p1[2], p1[3]);
#pragma unroll
    for (int r = 4; r < 16; r += 4) { a = max3f(a, p0[r], p0[r + 1]); b = max3f(b, p0[r + 2], p0[r + 3]); a = max3f(a, p1[r], p1[r + 1]); b = max3f(b, p1[r + 2], p1[r + 3]); }
    const float m = __builtin_fmaxf(a, b);
    auto rr = __builtin_amdgcn_permlane32_swap(__builtin_bit_cast(unsigned, m), __builtin_bit_cast(unsigned, m), false, false);
    return __builtin_fmaxf(__builtin_bit_cast(float, rr[0]), __builtin_bit_cast(float, rr[1]));
}
#define ATT_WAIT_BAR(N) asm volatile("s_waitcnt vmcnt(" #N ") lgkmcnt(0)\n\ts_barrier" ::: "memory")
template<int VAR>
__device__ __forceinline__ void attn_unit(Frame& F, int lane_in, int wid, int layer, int b, int h, bool isctx, int qb) {
    int lane = lane_in; asm volatile("" : "+v"(lane));
    const int r32 = lane & 31, hi = lane >> 5;
    LAS unsigned char* lds = F.lds; const unsigned lds0 = (unsigned)(uintptr_t)lds;
    const float* tab = (const float*)(F.ws + WS_TAB);
    const int qrow = qb * 256 + wid * 32 + r32;
    bf16x8 qr[2][2];
#pragma unroll
    for (int m = 0; m < 2; ++m) { const int mp = b * 8 + 2 * h + m;
        const bf16_t* qp = isctx ? (const bf16_t*)(F.ws + WS_QC) + ((size_t)mp * CL + qrow) * 32 : (const bf16_t*)(F.ws + WS_QA) + ((size_t)mp * T + qrow) * 32;
#pragma unroll
        for (int d0 = 0; d0 < 2; ++d0) qr[m][d0] = *(const bf16x8*)(qp + d0 * 16 + hi * 8); }
    const int NTL = isctx ? 2 : KT_TILES / 2;
    const bf16_t* ksrc = (const bf16_t*)(F.ws + WS_KA) + (size_t)((b * 8 + 2 * h + (wid >> 2)) * KT_TILES) * 2048 + (wid & 3) * 512;
    const unsigned char* vsrc = F.ws + WS_VA + (size_t)((b * 4 + h) * KT_TILES) * 4096 + (wid >> 2) * 4096 + (wid & 3) * 1024;
    const unsigned dma_off = (unsigned)lane * 16u;
#define ATT_DMA(t, slot) do { _Pragma("unroll") for (int sb_ = 0; sb_ < 2; ++sb_) \
                              ::glds16(ksrc + (size_t)(2 * (t) + sb_) * 2048, dma_off, (unsigned)__builtin_amdgcn_readfirstlane(lds0 + (slot) * SLOT + sb_ * 16384 + wid * 1024)); \
                              ::glds16(vsrc + (size_t)(t) * 8192, dma_off, (unsigned)__builtin_amdgcn_readfirstlane(lds0 + (slot) * SLOT + (wid >> 2) * 16384 + 8192 + (wid & 3) * 1024)); } while (0)
    LAS float* wsf = (LAS float*)(lds + WSF_OFF) + wid * 128;
    LAS float* ost = (LAS float*)(lds + OST_OFF + wid * OST_W);
    f32x16 o[2][2];
#pragma unroll
    for (int m = 0; m < 2; ++m)
#pragma unroll
        for (int d = 0; d < 2; ++d) o[m][d] = f32x16{};
    float mhat = 0.f;
    f32x16 lacc[2]; lacc[0] = f32x16{}; lacc[1] = f32x16{};
    v8i ones8; { int o8 = 0x38383838; asm volatile("" : "+v"(o8)); ones8 = (v8i){o8, o8, o8, o8, o8, o8, o8, o8}; asm volatile("" : "+v"(ones8)); }
    f32x16 negm = f32x16{};
    ATT_DMA(0, 0); ATT_DMA(1, 1);
    asm volatile("" : "+v"(qr[0][0]), "+v"(qr[0][1]), "+v"(qr[1][0]), "+v"(qr[1][1]));
    int slot = 0;
    for (int t = 0; t < NTL; ++t) {
        if (t + 1 < NTL) { ATT_WAIT_BAR(3); } else { ATT_WAIT_BAR(0); }
        if (t + 2 < NTL) { const int s2 = slot >= 1 ? slot - 1 : 2; ATT_DMA(t + 2, s2); }
#pragma unroll
        for (int sub = 0; sub < 2; ++sub) {
        const lds_cptr base = (lds_cptr)lds + slot * SLOT + sub * 16384;
        f32x16 p[2][2];
#pragma unroll
        for (int m = 0; m < 2; ++m) {
            const lds_cptr kb = base + m * 4096 + hi * 1024 + r32 * 16;
            const bf16x8 k00 = VAR == 4 ? qr[m][0] : *(const LAS bf16x8*)(kb), k01 = VAR == 4 ? qr[m][1] : *(const LAS bf16x8*)(kb + 512), k10 = VAR == 4 ? qr[1 - m][0] : *(const LAS bf16x8*)(kb + 2048), k11 = VAR == 4 ? qr[1 - m][1] : *(const LAS bf16x8*)(kb + 2048 + 512);
            p[m][0] = __builtin_amdgcn_mfma_f32_32x32x16_bf16(k00, qr[m][0], negm, 0, 0, 0);
            p[m][1] = __builtin_amdgcn_mfma_f32_32x32x16_bf16(k01, qr[m][0], negm, 0, 0, 0);
            p[m][0] = __builtin_amdgcn_mfma_f32_32x32x16_bf16(k10, qr[m][1], p[m][0], 0, 0, 0);
            p[m][1] = __builtin_amdgcn_mfma_f32_32x32x16_bf16(k11, qr[m][1], p[m][1], 0, 0, 0);
        }
        v8i vf[2];
        if (sub == 0 && (t & 1) == 0) {
          const float rm = __builtin_fmaxf(hmax32(p[0][0], p[0][1]), hmax32(p[1][0], p[1][1]));
          const bool first = (t == 0);
          if (first || __any(rm > 8.f)) {
              const float dl = first ? rm : fmaxf(rm, 0.f);
              mhat += dl;
#pragma unroll
              for (int r = 0; r < 16; ++r) { p[0][0][r] -= dl; p[0][1][r] -= dl; p[1][0][r] -= dl; p[1][1][r] -= dl; negm[r] = -mhat; }
              asm volatile("" : "+v"(negm));
              if (!first) {
                  const float f = __builtin_amdgcn_exp2f(-dl);
                  if (hi == 0) wsf[r32] = f;
                  LDS_WAIT();
#pragma unroll
                  for (int r = 0; r < 16; ++r) { const float fr_ = wsf[crow(r, hi)]; o[0][0][r] *= fr_; o[0][1][r] *= fr_; o[1][0][r] *= fr_; o[1][1][r] *= fr_; lacc[0][r] *= fr_; lacc[1][r] *= fr_; }
                  LDS_WAIT();
              }
          } }
#pragma unroll
        for (int m = 0; m < 2; ++m) {
            f32x16& p0 = p[m][0]; f32x16& p1 = p[m][1];
#pragma unroll
            for (int r = 0; r < 16; ++r) { p0[r] = __builtin_amdgcn_exp2f(p0[r]); p1[r] = __builtin_amdgcn_exp2f(p1[r]); }
            v8i pw; asm("" : "=v"(pw));
#pragma unroll
            for (int q = 0; q < 4; ++q) {
                pw[q] = __builtin_amdgcn_cvt_pk_bf8_f32(p0[4 * q], p0[4 * q + 1], pw[q], false); pw[q] = __builtin_amdgcn_cvt_pk_bf8_f32(p0[4 * q + 2], p0[4 * q + 3], pw[q], true);
                pw[4 + q] = __builtin_amdgcn_cvt_pk_bf8_f32(p1[4 * q], p1[4 * q + 1], pw[4 + q], false); pw[4 + q] = __builtin_amdgcn_cvt_pk_bf8_f32(p1[4 * q + 2], p1[4 * q + 3], pw[4 + q], true); }
            if (m == 0) {
                const lds_cptr vp0 = base + 8192 + hi * 512 + r32 * 16;
#pragma unroll
                for (int d0 = 0; d0 < 2; ++d0) { const u32x4 lo = *(const LAS u32x4*)(vp0 + d0 * 1024), hh = *(const LAS u32x4*)(vp0 + d0 * 1024 + 2048);
                    vf[d0] = (v8i){(int)lo.x, (int)lo.y, (int)lo.z, (int)lo.w, (int)hh.x, (int)hh.y, (int)hh.z, (int)hh.w}; }
            }
#pragma unroll
            for (int d0 = 0; d0 < 2; ++d0) o[m][d0] = __builtin_amdgcn_mfma_scale_f32_32x32x64_f8f6f4(pw, vf[d0], o[m][d0], 1, 0, 0, 0x7F7F7F7F, 0, 0x7B7B7B7B);
            lacc[m] = __builtin_amdgcn_mfma_scale_f32_32x32x64_f8f6f4(pw, ones8, lacc[m], 1, 0, 0, 0x7F7F7F7F, 0, 0x7F7F7F7F);
        }
        }
        slot = slot == 2 ? 0 : slot + 1;
    }
    asm volatile("s_waitcnt lgkmcnt(0)\n\ts_barrier" ::: "memory");
    int lane_e = lane; asm volatile("" : "+v"(lane_e));
    const int r32e = lane_e & 31, hie = lane_e >> 5;
    const float lam = tab[TB_LAM + layer], oml = tab[TB_LAM + 2 + layer];
#pragma unroll
    for (int r = 0; r < 16; ++r) { const int qq = crow(r, hie); const float f0 = __builtin_amdgcn_rcpf(lacc[0][r]), f1 = -lam * __builtin_amdgcn_rcpf(lacc[1][r]);
#pragma unroll
        for (int d0 = 0; d0 < 2; ++d0) ost[qq * 68 + d0 * 32 + r32e] = o[0][d0][r] * f0 + o[1][d0][r] * f1; }
    LDS_WAIT();
    { const int rw = lane_e >> 1, hf = lane_e & 1; f32x4 xv[8]; float ss = 0.f;
#pragma unroll
      for (int j = 0; j < 8; ++j) { xv[j] = *(const LAS f32x4*)(ost + rw * 68 + hf * 32 + 4 * j); ss += (xv[j][0] * xv[j][0] + xv[j][1] * xv[j][1]) + (xv[j][2] * xv[j][2] + xv[j][3] * xv[j][3]); }
      ss += xor_swz<1>(ss);
      const float rs = __builtin_amdgcn_rsqf(ss * (1.f / 64.f) + EPS) * oml;
      const float* sw = F.in[13] + layer * 64 + hf * 32;
      const int qi = qb * 256 + wid * 32 + rw; const size_t orow = isctx ? (size_t)(NLAT + b * CL + qi) : (size_t)(b * T + qi);
      bf16_t* dst = (bf16_t*)(F.ws + WS_MIX) + orow * 1024 + 768 + h * 64 + hf * 32;
#pragma unroll
      for (int j = 0; j < 4; ++j) { const f32x4 a = xv[2 * j], c = xv[2 * j + 1]; const f32x4 wa = *(const f32x4*)(sw + 8 * j), wb = *(const f32x4*)(sw + 8 * j + 4);
          u32x4 w; w.x = pk2(a[0] * rs * wa[0], a[1] * rs * wa[1]); w.y = pk2(a[2] * rs * wa[2], a[3] * rs * wa[3]); w.z = pk2(c[0] * rs * wb[0], c[1] * rs * wb[1]); w.w = pk2(c[2] * rs * wb[2], c[3] * rs * wb[3]);
          *(u32x4*)(dst + 8 * j) = w; } }
    asm volatile("s_waitcnt lgkmcnt(0)\n\ts_barrier" ::: "memory");
#undef ATT_DMA
}

#define ATT_SBAR() __builtin_amdgcn_sched_barrier(0)
#define ATT_PIN(x) asm volatile("" : "+v"(x))
#define ATT_MFMA(a, b, c) __builtin_amdgcn_mfma_f32_32x32x16_bf16(a, b, c, 0, 0, 0)
#define ATT_VLD(D0, D1, vp, ks) do { const s16x4 l0_ = vtr((vp) + (ks) * 1024), h0_ = vtr((vp) + (ks) * 1024 + 512), l1_ = vtr((vp) + 4096 + (ks) * 1024), h1_ = vtr((vp) + 4096 + (ks) * 1024 + 512); \
                                     D0 = (bf16x8){l0_[0], l0_[1], l0_[2], l0_[3], h0_[0], h0_[1], h0_[2], h0_[3]}; D1 = (bf16x8){l1_[0], l1_[1], l1_[2], l1_[3], h1_[0], h1_[1], h1_[2], h1_[3]}; } while (0)
#define ATT_EP(X, e, W) do { X[e] = __builtin_amdgcn_exp2f(X[e]); X[(e) + 1] = __builtin_amdgcn_exp2f(X[(e) + 1]); W = trunc_pk_bf16(X[e], X[(e) + 1]); \
                             S.l[M] = __builtin_amdgcn_fdot2_f32_bf16(__builtin_bit_cast(bf16x2_t, W), __builtin_bit_cast(bf16x2_t, 0x3F803F80u), S.l[M], false); } while (0)
struct SpState { f32x16 o[2][2]; f32x16 negm; bf16x8 qr[2][2]; float mhat; float l[2]; };
template<int M>
__device__ __forceinline__ void half_step(SpState& S, f32x16& pa0, f32x16& pa1, f32x16& pb0, f32x16& pb1, u32x4 (&pwp)[4], u32x4 (&pwc)[4], bf16x8& vA0, bf16x8& vA1, bf16x8& vB0, bf16x8& vB1,
                                          lds_cptr vpp, lds_cptr vpn, lds_cptr kbn, bool chk, LAS float* wsfw, int lane) {
    constexpr int MP = 1 - M;
    if (chk) {
        const float rm = hmax32(pa0, pa1);
        if (__any(rm > 8.f)) {
            const int r32 = lane & 31, hi = lane >> 5;
#pragma unroll
            for (int ks = 0; ks < 4; ++ks) { if (ks == 2) ATT_VLD(vA0, vA1, vpp, 2); if (ks == 3) ATT_VLD(vB0, vB1, vpp, 3);
                S.o[MP][0] = ATT_MFMA(__builtin_bit_cast(bf16x8, pwp[ks]), (ks & 1) ? vB0 : vA0, S.o[MP][0]); S.o[MP][1] = ATT_MFMA(__builtin_bit_cast(bf16x8, pwp[ks]), (ks & 1) ? vB1 : vA1, S.o[MP][1]);
                pwp[ks] = (u32x4){0u, 0u, 0u, 0u}; }
            ATT_VLD(vA0, vA1, vpp, 0); ATT_VLD(vB0, vB1, vpp, 1);
            const float dl = fmaxf(rm, 0.f);
            S.mhat += dl;
#pragma unroll
            for (int r = 0; r < 16; ++r) { pa0[r] -= dl; pa1[r] -= dl; S.negm[r] = -S.mhat; }
            const float f = __builtin_amdgcn_exp2f(-dl);
            S.l[0] *= f; S.l[1] *= f;
            if (hi == 0) wsfw[r32] = f;
            LDS_WAIT();
#pragma unroll
            for (int r = 0; r < 16; ++r) { const float fr_ = wsfw[crow(r, hi)]; S.o[0][0][r] *= fr_; S.o[0][1][r] *= fr_; S.o[1][0][r] *= fr_; S.o[1][1][r] *= fr_; }
            LDS_WAIT();
        }
    }
    bf16x8 k00, k01, k10, k11;
    ATT_SBAR();
    S.o[MP][0] = ATT_MFMA(__builtin_bit_cast(bf16x8, pwp[0]), vA0, S.o[MP][0]); ATT_EP(pa0, 0, pwc[0][0]); ATT_PIN(pa0); ATT_PIN(pwc[0]); ATT_SBAR();
    S.o[MP][1] = ATT_MFMA(__builtin_bit_cast(bf16x8, pwp[0]), vA1, S.o[MP][1]); ATT_EP(pa0, 2, pwc[0][1]); ATT_EP(pa0, 4, pwc[0][2]); ATT_PIN(pa0); ATT_PIN(pwc[0]); ATT_SBAR();
    S.o[MP][0] = ATT_MFMA(__builtin_bit_cast(bf16x8, pwp[1]), vB0, S.o[MP][0]); ATT_VLD(vA0, vA1, vpp, 2); ATT_EP(pa0, 6, pwc[0][3]); ATT_PIN(pa0); ATT_PIN(pwc[0]); ATT_SBAR();
    S.o[MP][1] = ATT_MFMA(__builtin_bit_cast(bf16x8, pwp[1]), vB1, S.o[MP][1]); ATT_EP(pa0, 8, pwc[1][0]); ATT_EP(pa0, 10, pwc[1][1]); ATT_PIN(pa0); ATT_PIN(pwc[1]); ATT_SBAR();
    S.o[MP][0] = ATT_MFMA(__builtin_bit_cast(bf16x8, pwp[2]), vA0, S.o[MP][0]); ATT_VLD(vB0, vB1, vpp, 3); ATT_EP(pa0, 12, pwc[1][2]); ATT_PIN(pa0); ATT_PIN(pwc[1]); ATT_SBAR();
    S.o[MP][1] = ATT_MFMA(__builtin_bit_cast(bf16x8, pwp[2]), vA1, S.o[MP][1]); ATT_EP(pa0, 14, pwc[1][3]); ATT_EP(pa1, 0, pwc[2][0]); ATT_PIN(pa0); ATT_PIN(pa1); ATT_PIN(pwc[1]); ATT_PIN(pwc[2]); ATT_SBAR();
    S.o[MP][0] = ATT_MFMA(__builtin_bit_cast(bf16x8, pwp[3]), vB0, S.o[MP][0]); k00 = *(const LAS bf16x8*)(kbn); k10 = *(const LAS bf16x8*)(kbn + 2048); ATT_VLD(vA0, vA1, vpn, 0); ATT_EP(pa1, 2, pwc[2][1]); ATT_PIN(pa1); ATT_PIN(pwc[2]); ATT_SBAR();
    S.o[MP][1] = ATT_MFMA(__builtin_bit_cast(bf16x8, pwp[3]), vB1, S.o[MP][1]); k01 = *(const LAS bf16x8*)(kbn + 512); k11 = *(const LAS bf16x8*)(kbn + 2048 + 512); ATT_EP(pa1, 4, pwc[2][2]); ATT_EP(pa1, 6, pwc[2][3]); ATT_PIN(pa1); ATT_PIN(pwc[2]); ATT_SBAR();
    pb0 = ATT_MFMA(k00, S.qr[MP][0], S.negm); ATT_VLD(vB0, vB1, vpn, 1); ATT_EP(pa1, 8, pwc[3][0]); ATT_EP(pa1, 10, pwc[3][1]); ATT_PIN(pa1); ATT_PIN(pwc[3]); ATT_SBAR();
    pb0 = ATT_MFMA(k10, S.qr[MP][1], pb0); ATT_EP(pa1, 12, pwc[3][2]); ATT_EP(pa1, 14, pwc[3][3]); ATT_PIN(pa1); ATT_PIN(pwc[3]); ATT_SBAR();
    pb1 = ATT_MFMA(k01, S.qr[MP][0], S.negm); ATT_SBAR();
    pb1 = ATT_MFMA(k11, S.qr[MP][1], pb1); ATT_SBAR();
}
__device__ __forceinline__ void attn_unit_sp(Frame& F, int lane_in, int wid, int layer, int b, int h, bool isctx, int qb) {
    constexpr int NS4 = 4, WSF4 = NS4 * SLOT;
    int lane = lane_in; asm volatile("" : "+v"(lane));
    const int r32 = lane & 31, hi = lane >> 5;
    LAS unsigned char* lds = F.lds; const unsigned lds0 = (unsigned)(uintptr_t)lds;
    const float* tab = (const float*)(F.ws + WS_TAB);
    const int qrow = qb * 256 + wid * 32 + r32;
    SpState S;
#pragma unroll
    for (int m = 0; m < 2; ++m) { const int mp = b * 8 + 2 * h + m;
        const bf16_t* qp = isctx ? (const bf16_t*)(F.ws + WS_QC) + ((size_t)mp * CL + qrow) * 32 : (const bf16_t*)(F.ws + WS_QA) + ((size_t)mp * T + qrow) * 32;
#pragma unroll
        for (int d0 = 0; d0 < 2; ++d0) S.qr[m][d0] = *(const bf16x8*)(qp + d0 * 16 + hi * 8); }
    const int NTL = isctx ? 2 : KT_TILES / 2;
    const bf16_t* ksrc = (const bf16_t*)(F.ws + WS_KA) + (size_t)((b * 8 + 2 * h + (wid >> 2)) * KT_TILES) * 2048 + (wid & 3) * 512;
    const bf16_t* vsrc = (const bf16_t*)(F.ws + WS_VA) + (size_t)((b * 4 + h) * KT_TILES) * 4096 + wid * 512;
    const unsigned dma_off = (unsigned)lane * 16u;
#define ATT_DMA4(t, slot) do { _Pragma("unroll") for (int sb_ = 0; sb_ < 2; ++sb_) { \
                              ::glds16(ksrc + (size_t)(2 * (t) + sb_) * 2048, dma_off, (unsigned)__builtin_amdgcn_readfirstlane(lds0 + (slot) * SLOT + sb_ * 16384 + wid * 1024)); \
                              ::glds16(vsrc + (size_t)(2 * (t) + sb_) * 4096, dma_off, (unsigned)__builtin_amdgcn_readfirstlane(lds0 + (slot) * SLOT + sb_ * 16384 + 8192 + wid * 1024)); } } while (0)
    LAS float* wsf = (LAS float*)(lds + WSF4) + wid * 128;
    LAS float* ost = (LAS float*)(lds + OST_OFF + wid * OST_W);
#pragma unroll
    for (int m = 0; m < 2; ++m) { S.o[m][0] = f32x16{}; S.o[m][1] = f32x16{}; S.l[m] = 0.f; }
    S.mhat = 0.f; S.negm = f32x16{};
    ATT_DMA4(0, 0); if (NTL > 1) ATT_DMA4(1, 1);
    asm volatile("" : "+v"(S.qr[0][0]), "+v"(S.qr[0][1]), "+v"(S.qr[1][0]), "+v"(S.qr[1][1]));
    const int koff = hi * 1024 + r32 * 16;
    const int voff = 8192 + ((lane >> 4) & 1) * 32 + (lane & 3) * 8 + (4 * hi + ((lane & 15) >> 2)) * 64;
    ATT_WAIT_BAR(4);
    f32x16 pa0, pa1, pb0, pb1; u32x4 pwx[4], pwy[4]; bf16x8 vA0, vA1, vB0, vB1;
    {
        const lds_cptr kb = (lds_cptr)lds + koff;
        const bf16x8 k00 = *(const LAS bf16x8*)(kb), k01 = *(const LAS bf16x8*)(kb + 512), k10 = *(const LAS bf16x8*)(kb + 2048), k11 = *(const LAS bf16x8*)(kb + 2048 + 512);
        pa0 = ATT_MFMA(k00, S.qr[0][0], S.negm); pa1 = ATT_MFMA(k01, S.qr[0][0], S.negm); pa0 = ATT_MFMA(k10, S.qr[0][1], pa0); pa1 = ATT_MFMA(k11, S.qr[0][1], pa1);
        const float rm = hmax32(pa0, pa1); S.mhat = rm;
#pragma unroll
        for (int r = 0; r < 16; ++r) { pa0[r] -= rm; pa1[r] -= rm; S.negm[r] = -rm; }
        ATT_VLD(vA0, vA1, (lds_cptr)lds + voff, 0); ATT_VLD(vB0, vB1, (lds_cptr)lds + voff, 1);
#pragma unroll
        for (int k = 0; k < 4; ++k) pwx[k] = (u32x4){0u, 0u, 0u, 0u};
    }
    for (int t = 0; t < NTL; ++t) {
        ATT_WAIT_BAR(0);
        if (t + 2 < NTL) ATT_DMA4(t + 2, (t + 2) & 3);
        const lds_cptr tb = (lds_cptr)lds + (t & 3) * SLOT, tn = (lds_cptr)lds + ((t + 1) & 3) * SLOT, tp = (lds_cptr)lds + ((t == 0 ? 0 : t - 1) & 3) * SLOT + (t == 0 ? 0 : 16384);
        const bool chk = (t & 1) == 0;
        half_step<0>(S, pa0, pa1, pb0, pb1, pwx, pwy, vA0, vA1, vB0, vB1, tp + voff,         tb + voff,         tb + 4096 + koff,         chk && t > 0, wsf, lane);
        half_step<1>(S, pb0, pb1, pa0, pa1, pwy, pwx, vA0, vA1, vB0, vB1, tb + voff,         tb + voff,         tb + 16384 + koff,        chk,          wsf, lane);
        half_step<0>(S, pa0, pa1, pb0, pb1, pwx, pwy, vA0, vA1, vB0, vB1, tb + voff,         tb + 16384 + voff, tb + 16384 + 4096 + koff, false,        wsf, lane);
        half_step<1>(S, pb0, pb1, pa0, pa1, pwy, pwx, vA0, vA1, vB0, vB1, tb + 16384 + voff, tb + 16384 + voff, tn + koff,                false,        wsf, lane);
    }
    {
        const lds_cptr vpl = (lds_cptr)lds + ((NTL - 1) & 3) * SLOT + 16384 + voff;
#pragma unroll
        for (int ks = 0; ks < 4; ++ks) { if (ks == 2) ATT_VLD(vA0, vA1, vpl, 2); if (ks == 3) ATT_VLD(vB0, vB1, vpl, 3);
            S.o[1][0] = ATT_MFMA(__builtin_bit_cast(bf16x8, pwx[ks]), (ks & 1) ? vB0 : vA0, S.o[1][0]); S.o[1][1] = ATT_MFMA(__builtin_bit_cast(bf16x8, pwx[ks]), (ks & 1) ? vB1 : vA1, S.o[1][1]); }
    }
    { const float l0 = S.l[0] + xor32(S.l[0], lane), l1 = S.l[1] + xor32(S.l[1], lane);
      if (hi == 0) { wsf[r32] = __builtin_amdgcn_rcpf(l0); wsf[32 + r32] = __builtin_amdgcn_rcpf(l1); } }
    asm volatile("s_waitcnt lgkmcnt(0)\n\ts_barrier" ::: "memory");
    int lane_e = lane; asm volatile("" : "+v"(lane_e));
    const int r32e = lane_e & 31, hie = lane_e >> 5;
    const float lam = tab[TB_LAM + layer], oml = tab[TB_LAM + 2 + layer];
#pragma unroll
    for (int r = 0; r < 16; ++r) { const int qq = crow(r, hie); const float f0 = wsf[qq], f1 = -lam * wsf[32 + qq];
#pragma unroll
        for (int d0 = 0; d0 < 2; ++d0) ost[qq * 68 + d0 * 32 + r32e] = S.o[0][d0][r] * f0 + S.o[1][d0][r] * f1; }
    LDS_WAIT();
    { const int rw = lane_e >> 1, hf = lane_e & 1; f32x4 xv[8]; float ss = 0.f;
#pragma unroll
      for (int j = 0; j < 8; ++j) { xv[j] = *(const LAS f32x4*)(ost + rw * 68 + hf * 32 + 4 * j); ss += (xv[j][0] * xv[j][0] + xv[j][1] * xv[j][1]) + (xv[j][2] * xv[j][2] + xv[j][3] * xv[j][3]); }
      ss += xor_swz<1>(ss);
      const float rs = __builtin_amdgcn_rsqf(ss * (1.f / 64.f) + EPS) * oml;
      const float* sw = F.in[13] + layer * 64 + hf * 32;
      const int qi = qb * 256 + wid * 32 + rw; const size_t orow = isctx ? (size_t)(NLAT + b * CL + qi) : (size_t)(b * T + qi);
      bf16_t* dst = (bf16_t*)(F.ws + WS_MIX) + orow * 1024 + 768 + h * 64 + hf * 32;
#pragma unroll
      for (int j = 0; j < 4; ++j) { const f32x4 a = xv[2 * j], c = xv[2 * j + 1]; const f32x4 wa = *(const f32x4*)(sw + 8 * j), wb = *(const f32x4*)(sw + 8 * j + 4);
          u32x4 w; w.x = pk2(a[0] * rs * wa[0], a[1] * rs * wa[1]); w.y = pk2(a[2] * rs * wa[2], a[3] * rs * wa[3]); w.z = pk2(c[0] * rs * wb[0], c[1] * rs * wb[1]); w.w = pk2(c[2] * rs * wb[2], c[3] * rs * wb[3]);
          *(u32x4*)(dst + 8 * j) = w; } }
    asm volatile("s_waitcnt lgkmcnt(0)\n\ts_barrier" ::: "memory");
#undef ATT_DMA4
}
}
template<int VAR>
__device__ __forceinline__ void phase_attn(Frame& F, int layer, int ulo, int uhi) {
    PHASE_IDS();
    __syncthreads();
    const int nunits = 512 + (layer == 0 ? 8 : 0);
    for (int u = blk_; u < nunits && u < uhi; u += F.G) {
        if (u < ulo) continue;
        if (u < 512) { const int bh = u & 7, qb = u >> 3; att::attn_unit<VAR>(F, lane, wave, layer, bh >> 2, bh & 3, false, qb); }
        else { const int bh = u - 512; att::attn_unit<VAR>(F, lane, wave, layer, bh >> 2, bh & 3, true, 0); }
    }
}

__device__ __forceinline__ void phase_route(Frame& F, int layer) {
    PHASE_IDS();
    const int wid = wave, G = F.G, blk = blk_;
    const int nrows = layer == 0 ? NROW : NLAT;
    constexpr int TP = 2064;
    LAS unsigned char* Th = F.lds; LAS unsigned char* Tl = F.lds + 16 * TP; LAS float* Pp = (LAS float*)(F.lds + 32 * TP);
    LAS int* hist = (LAS int*)(F.lds + LDS_TAB); LAS int* sbase = hist + 32; LAS unsigned* ent = (LAS unsigned*)(hist + 64); LAS float* entg = (LAS float*)(ent + 640);
    for (int i = tid; i < 64 + 640; i += NTHR) hist[i] = (i < 64) ? 0 : -1;
    LAS float* mv = (LAS float*)(F.lds + 32 * TP + 16384);
    { const float* mg = (const float*)(F.ws + WS_MODV) + (size_t)layer * 3 * 6 * 1024;
      for (int i = tid; i < 9 * 256; i += NTHR) { const int v = i >> 8, c4 = i & 255; *(LAS f32x4*)(mv + v * 1024 + 4 * c4) = *(const f32x4*)(mg + (size_t)((v / 3) * 6 + 2 + (v % 3)) * 1024 + 4 * c4); } }
    bf16x8 bh[4][2], bl[4][2];
    { const bf16_t* rwh = (const bf16_t*)(F.ws + WS_RWT) + (size_t)layer * 32768; const bf16_t* rwl = rwh + 2 * 32768;
#pragma unroll
      for (int ks = 0; ks < 4; ++ks)
#pragma unroll
        for (int nb = 0; nb < 2; ++nb) { const int o_ = (16 * nb + (lane & 15)) * 1024 + 128 * wid + 32 * ks + 8 * (lane >> 4); bh[ks][nb] = *(const bf16x8*)(rwh + o_); bl[ks][nb] = *(const bf16x8*)(rwl + o_); } }
    __syncthreads();
    const float* modv = (const float*)(F.ws + WS_MODV) + (size_t)layer * 3 * 6 * 1024;
    const bf16_t* yb = (const bf16_t*)(F.ws + WS_Y);
    float* x1b = (float*)(F.ws + WS_X1);
    const int nloc = (nrows - blk + G - 1) / G;
    const float rbias = F.in[16][layer * 32 + (lane & 31)];
    const int nbatch = (nloc + 15) >> 4;
    for (int it = 0; it < nbatch; ++it) { const int i0 = 16 * it + 2 * wid;
        f32x4 tk[2][4]; bool val[2];
#pragma unroll
        for (int q = 0; q < 2; ++q) {
            const int il = i0 + q; val[q] = il < nloc; const int r = val[q] ? blk + il * G : blk;
            const int w = row_which(r);
            const float* xs = (layer == 0) ? (r < NLAT ? F.in[0] + (size_t)r * D : F.in[2] + (size_t)(r - NLAT) * D) : x1b + (size_t)r * D;
            f32x4 x[4], y[4]; row_load(xs, lane, x);
#pragma unroll
            for (int j = 0; j < 4; ++j) { const u32x2 yy = *(const u32x2*)(yb + (size_t)r * D + 4 * lane + 256 * j); y[j] = (f32x4){bflo(yy.x), bfhi(yy.x), bflo(yy.y), bfhi(yy.y)}; }
            const float ry = __builtin_amdgcn_rsqf(row_sumsq(y) * (1.f / 1024.f) + EPS);
            const LAS float* c1 = mv + (w * 3 + 0) * 1024;
#pragma unroll
            for (int j = 0; j < 4; ++j) { const f32x4 cv = *(const LAS f32x4*)(c1 + 4 * lane + 256 * j); x[j] = x[j] + cv * (y[j] * ry); }
            if (val[q]) row_store(x1b + (size_t)r * D, lane, x);
            { const float rr_ = __builtin_amdgcn_rsqf(row_sumsq(x) * (1.f / 1024.f) + EPS); const LAS float* at_ = mv + (w * 3 + 1) * 1024; const LAS float* bt_ = mv + (w * 3 + 2) * 1024;
#pragma unroll
              for (int j = 0; j < 4; ++j) { const f32x4 av = *(const LAS f32x4*)(at_ + 4 * lane + 256 * j), bv = *(const LAS f32x4*)(bt_ + 4 * lane + 256 * j); tk[q][j] = x[j] * rr_ * av + bv; } }
            if (val[q]) {
                unsigned char* t8 = F.ws + WS_TOK8 + (size_t)r * D;
#pragma unroll
                for (int j = 0; j < 4; ++j) *(unsigned*)(t8 + 4 * lane + 256 * j) = pk4_fp8(tk[q][j][0], tk[q][j][1], tk[q][j][2], tk[q][j][3]); }
        }
#pragma unroll
        for (int q = 0; q < 2; ++q)
#pragma unroll
            for (int j = 0; j < 4; ++j) { unsigned hb[4], lb[4];
#pragma unroll
                for (int c = 0; c < 4; ++c) { hb[c] = f2bf(tk[q][j][c]); lb[c] = f2bf(tk[q][j][c] - __builtin_bit_cast(float, hb[c] << 16)); }
                const int off = (2 * wid + q) * TP + (4 * lane + 256 * j) * 2;
                *(LAS u32x2*)(Th + off) = (u32x2){hb[0] | (hb[1] << 16), hb[2] | (hb[3] << 16)}; *(LAS u32x2*)(Tl + off) = (u32x2){lb[0] | (lb[1] << 16), lb[2] | (lb[3] << 16)}; }
        __syncthreads();
        { f32x4 pacc[2]; pacc[0] = (f32x4){0.f, 0.f, 0.f, 0.f}; pacc[1] = pacc[0];
#pragma unroll
          for (int ks = 0; ks < 4; ++ks) { const int ao = (lane & 15) * TP + (128 * wid + 32 * ks + 8 * (lane >> 4)) * 2;
              const bf16x8 ah = *(const LAS bf16x8*)(Th + ao), al = *(const LAS bf16x8*)(Tl + ao);
#pragma unroll
              for (int nb = 0; nb < 2; ++nb) { pacc[nb] = __builtin_amdgcn_mfma_f32_16x16x32_bf16(ah, bh[ks][nb], pacc[nb], 0, 0, 0); pacc[nb] = __builtin_amdgcn_mfma_f32_16x16x32_bf16(al, bh[ks][nb], pacc[nb], 0, 0, 0);
                                               pacc[nb] = __builtin_amdgcn_mfma_f32_16x16x32_bf16(ah, bl[ks][nb], pacc[nb], 0, 0, 0); } }
#pragma unroll
          for (int nb = 0; nb < 2; ++nb)
#pragma unroll
              for (int r = 0; r < 4; ++r) Pp[(wid * 16 + 4 * (lane >> 4) + r) * 32 + 16 * nb + (lane & 15)] = pacc[nb][r]; }
        __syncthreads();
        float lg = 0.f;
#pragma unroll
        for (int w8 = 0; w8 < 8; ++w8) lg += Pp[(w8 * 16 + 2 * wid + (lane >> 5)) * 32 + (lane & 31)];
        lg += rbias;
#ifdef DBG_CHECK
        { const int q_ = lane >> 5; if (q_ == 0 ? val[0] : val[1]) ((float*)(F.ws + WS_END + 65536))[(size_t)(blk + (i0 + q_) * G) * 32 + (lane & 31)] = lg; }
#endif
        float tv[4]; int te[4];
#pragma unroll
        for (int k = 0; k < 4; ++k) {
            float m = lg;
            m = fmaxf(m, xor_swz<16>(m)); m = fmaxf(m, xor_swz<8>(m)); m = fmaxf(m, xor_swz<4>(m)); m = fmaxf(m, xor_swz<2>(m)); m = fmaxf(m, xor_swz<1>(m));
            const unsigned long long bal = __ballot(lg == m);
            const unsigned hb = (lane & 32) ? (unsigned)(bal >> 32) : (unsigned)bal;
            const int idx = __builtin_ctz(hb);
            tv[k] = m; te[k] = idx;
            if ((lane & 31) == idx) lg = -INFINITY;
        }
        float g[4]; { float s = 0.f;
#pragma unroll
            for (int k = 0; k < 4; ++k) { g[k] = __expf(tv[k] - tv[0]); s += g[k]; }
            const float inv = 1.f / s;
#pragma unroll
            for (int k = 0; k < 4; ++k) g[k] *= inv; }
        const int q = lane >> 5, k = lane & 31;
        if (k < 4 && (q == 0 ? val[0] : val[1])) {
            const int il = i0 + q; const int r = blk + il * G;
            const int ee = (k == 0) ? te[0] : (k == 1) ? te[1] : (k == 2) ? te[2] : te[3];
            const float gg = (k == 0) ? g[0] : (k == 1) ? g[1] : (k == 2) ? g[2] : g[3];
            entg[il * 4 + k] = gg;
            const int lp = __hip_atomic_fetch_add(hist + ee, 1, __ATOMIC_RELAXED, __HIP_MEMORY_SCOPE_WORKGROUP);
            ent[il * 4 + k] = (unsigned)ee | ((unsigned)lp << 8);
        }
    }
    __syncthreads();
    if (tid < 32) sbase[tid] = (int)__hip_atomic_fetch_add((unsigned*)F.ctl + CW_CNT + layer * 32 + tid, (unsigned)hist[tid], __ATOMIC_RELAXED, __HIP_MEMORY_SCOPE_AGENT);
    __syncthreads();
    int* slot = (int*)(F.ws + WS_SLOT);
    for (int i = tid; i < nloc * 4; i += NTHR) { const unsigned en = ent[i]; if (en != 0xffffffffu) { const int e = en & 255, pos = sbase[e] + (int)(en >> 8); const int r = blk + (i >> 2) * G;
        slot[e * CAP + pos] = r * 4 + (i & 3); ((float*)(F.ws + WS_SGATE))[e * CAP + pos] = entg[i]; ((int*)(F.ws + WS_GATE))[r * 4 + (i & 3)] = e | (pos << 8); } }
    __syncthreads();
}
__device__ __forceinline__ void moe_tables(Frame& F, int layer) {
    PHASE_IDS();
    LAS int* tab = (LAS int*)(F.lds + LDS_TAB);
    if (tid == 0) { int acc = 0;
        for (int e = 0; e < 32; ++e) { const int c = (int)__hip_atomic_load((unsigned*)F.ctl + CW_CNT + layer * 32 + e, __ATOMIC_RELAXED, __HIP_MEMORY_SCOPE_AGENT); tab[e] = acc; tab[33 + e] = c; acc += (c + 255) >> 8; }
        tab[32] = acc; }
    __syncthreads();
}
__device__ __forceinline__ void phase_combine(Frame& F, int layer) {
    PHASE_IDS();
    const int gw = blk_ * NWAVES + wave, NGW = F.G * NWAVES;
    const int nrows = layer == 0 ? NROW : NLAT;
    const bf16_t* yk = (const bf16_t*)(F.ws + WS_YK); float* x1b = (float*)(F.ws + WS_X1);
    LAS float* mv = (LAS float*)F.lds;
    { const float* mg = (const float*)(F.ws + WS_MODV);
      for (int i = tid; i < 9 * 256; i += NTHR) { const int v = i >> 8, c4 = i & 255, w = v / 3, k = v % 3;
          const float* src = (k == 0) ? mg + (size_t)((layer * 3 + w) * 6 + 5) * 1024 : mg + (size_t)((1 * 3 + w) * 6 + (k - 1)) * 1024;
          *(LAS f32x4*)(mv + v * 1024 + 4 * c4) = *(const f32x4*)(src + 4 * c4); } }
    moe_tables(F, layer);
    const LAS int* ttab = (const LAS int*)(F.lds + LDS_TAB); const int* epos = (const int*)(F.ws + WS_GATE);
    int epn[4];
#pragma unroll
    for (int k = 0; k < 4; ++k) epn[k] = (gw < nrows) ? epos[gw * 4 + k] : 0;
    for (int r = gw; r < nrows; r += NGW) {
        const int w = row_which(r);
        int srow[4];
#pragma unroll
        for (int k = 0; k < 4; ++k) { const int ep = __builtin_amdgcn_readfirstlane(epn[k]); srow[k] = 256 * ttab[ep & 255] + (ep >> 8); }
        if (r + NGW < nrows) {
#pragma unroll
            for (int k = 0; k < 4; ++k) epn[k] = epos[(r + NGW) * 4 + k];
        }
        f32x4 x[4]; row_load(x1b + (size_t)r * D, lane, x);
        f32x4 f[4];
#pragma unroll
        for (int j = 0; j < 4; ++j) f[j] = (f32x4){0.f, 0.f, 0.f, 0.f};
#pragma unroll
        for (int k = 0; k < 4; ++k)
#pragma unroll
            for (int j = 0; j < 4; ++j) { const u32x2 u = *(const u32x2*)(yk + (size_t)srow[k] * D + 4 * lane + 256 * j); f[j][0] += bflo(u.x); f[j][1] += bfhi(u.x); f[j][2] += bflo(u.y); f[j][3] += bfhi(u.y); }
        const float rf = __builtin_amdgcn_rsqf(row_sumsq(f) * (1.f / 1024.f) + EPS);
        const LAS float* c2 = mv + (w * 3 + 0) * 1024;
#pragma unroll
        for (int j = 0; j < 4; ++j) { const f32x4 cv = *(const LAS f32x4*)(c2 + 4 * lane + 256 * j); x[j] = x[j] + cv * (f[j] * rf); }
        if (layer == 1) row_store(F.out + (size_t)r * D, lane, x);
        else { row_store(x1b + (size_t)r * D, lane, x);
            const float rr_ = __builtin_amdgcn_rsqf(row_sumsq(x) * (1.f / 1024.f) + EPS); const LAS float* ah_ = mv + (w * 3 + 1) * 1024; const LAS float* bh_ = mv + (w * 3 + 2) * 1024;
            f32x4 o[4];
#pragma unroll
            for (int j = 0; j < 4; ++j) { const f32x4 av = *(const LAS f32x4*)(ah_ + 4 * lane + 256 * j), bv = *(const LAS f32x4*)(bh_ + 4 * lane + 256 * j); o[j] = x[j] * rr_ * av + bv; }
            row_store_bf16((bf16_t*)(F.ws + WS_H) + (size_t)r * D, lane, o); }
    }
}

struct Args { const float* in[21]; float* out; unsigned char* ws; int ph_lo, ph_hi; };
constexpr int PH_PER_LAYER = 10, NPHASE = 2 + 2 * PH_PER_LAYER;
__global__ void __launch_bounds__(NTHR, 2) mk_fwd(Args args) {
    extern __shared__ __attribute__((aligned(16))) unsigned char lds_raw[];
    Frame F;
    F.lds = (LAS unsigned char*)lds_raw; F.ws = args.ws; F.out = args.out;
#pragma unroll
    for (int i = 0; i < 21; ++i) F.in[i] = args.in[i];
    F.ctl = (gu32*)(args.ws + WS_CTL);
    __builtin_amdgcn_s_setreg(1473, 1);
    F.tid = threadIdx.x; F.lane = F.tid & 63; F.wave = __builtin_amdgcn_readfirstlane(F.tid >> 6); F.G = gridDim.x; F.blk = blockIdx.x;
    volatile LAS unsigned* misc = (volatile LAS unsigned*)(F.lds + LDS_MISC);
    if (F.tid < 16) misc[F.tid] = 0u;
    __syncthreads();
    const int lo = args.ph_lo, hi = args.ph_hi;
    const bool use_bar = (hi - lo) > 1;
    XcdBarrier bar; bar.bar = (unsigned*)F.ctl + CW_BAR; bar.x = 0; bar.st = nullptr;
    if (use_bar) { bar = xcd_barrier_post((unsigned*)F.ctl + CW_BAR, misc + 8); if (F.tid == 0) xcd_barrier_census(bar); }
#define IN(k) (lo <= (k) && (k) < hi)
#define SEAM(k) do { if (IN(k) && IN((k) + 1)) xcd_barrier(bar); } while (0)
    if (PHON(0) && IN(0)) { for (int rep = 0; rep < NREP(0); ++rep) phase_prologue_a(F); } SEAM(0);
    if (PHON(1) && IN(1)) { for (int rep = 0; rep < NREP(1); ++rep) phase_prologue_b(F); } SEAM(1);
    for (int layer = 0; layer < 2; ++layer) {
        const int p0 = 2 + layer * PH_PER_LAYER;
        unsigned char* ws = F.ws;
        int blk_ = F.blk; asm volatile("" : "+s"(blk_));
        if (PHON(2) && IN(p0 + 0)) {
            pg8::DenseSched S; S.init(ws + WS_H, (bf16_t*)(ws + WS_WIN) + (size_t)layer * NIN * 1024, NROW, NIN, F.G, blk_);
            EpiInProj E{ws, (const float*)(ws + WS_TAB), (const float*)(ws + WS_ROPE), layer};
            for (int rep = 0; rep < NREP(2); ++rep) pg8::gemm_phase<EpiInProj, pg8::DenseSched, false>(F.lds, F.wave, S, E);
        } SEAM(p0 + 0);
        if (PHON(3) && IN(p0 + 1)) { for (int rep = 0; rep < NREP(3); ++rep) phase_scan2_a(F, layer); if (ATTVAR >= 0) phase_attn<(ATTVAR >= 0 ? ATTVAR : 0)>(F, layer, 0, F.G); phase_attn<0>(F, layer, 0, F.G); } SEAM(p0 + 1);
        if (PHON(4) && IN(p0 + 2)) { for (int rep = 0; rep < NREP(4); ++rep) phase_scan_b(F); } SEAM(p0 + 2);
        if (PHON(5) && IN(p0 + 3)) { for (int rep = 0; rep < NREP(5); ++rep) phase_scan2_c(F, layer); if (ATTVAR >= 0) phase_attn<(ATTVAR >= 0 ? ATTVAR : 0)>(F, layer, F.G, 1 << 30); phase_attn<0>(F, layer, F.G, 1 << 30); } SEAM(p0 + 3);
          if (IN(p0 + 4) && IN(p0 + 5) && !IN(p0 + 3)) xcd_barrier(bar);
        if (PHON(7) && IN(p0 + 5)) {
            pg8::DenseSched S; S.init(ws + WS_MIX, (bf16_t*)(ws + WS_WOUT) + (size_t)layer * 1024 * 1024, layer == 0 ? NROW : NLAT, 1024, F.G, blk_);
            EpiBf16Out E{(bf16_t*)(ws + WS_Y)};
            for (int rep = 0; rep < NREP(7); ++rep) pg8::gemm_phase<EpiBf16Out, pg8::DenseSched, false>(F.lds, F.wave, S, E);
        } SEAM(p0 + 5);
        if (PHON(8) && IN(p0 + 6)) { phase_route(F, layer); } SEAM(p0 + 6);
        if (PHON(9) && IN(p0 + 7)) {
            moe_tables(F, layer);
            pg8::MoeSched<8, true, 1024> S{(const char*)(ws + WS_TOK8), (const char*)(ws + WS_W1 + (size_t)layer * NE * 2048 * 1024), (const int*)(ws + WS_SLOT), (const LAS int*)(F.lds + LDS_TAB), F.G, blk_, (size_t)2048 * 1024};
            EpiSwiglu E{ws + WS_ACT, F.in[18] + (size_t)layer * NE * 2048};
            for (int rep = 0; rep < NREP(9); ++rep) pg8::gemm_phase<EpiSwiglu, pg8::MoeSched<8, true, 1024>, true, true>(F.lds, F.wave, S, E);
        } SEAM(p0 + 7);
        if (PHON(10) && IN(p0 + 8)) {
            moe_tables(F, layer);
            pg8::MoeSched<4, false, 1024> S{(const char*)(ws + WS_ACT), (const char*)(ws + WS_W2 + (size_t)layer * NE * 1024 * 1024), (const int*)(ws + WS_SLOT), (const LAS int*)(F.lds + LDS_TAB), F.G, blk_, (size_t)1024 * 1024};
            EpiMoeOut E{(bf16_t*)(ws + WS_YK), F.in[20] + (size_t)layer * NE * 1024, (const float*)(ws + WS_SGATE)};
            for (int rep = 0; rep < NREP(10); ++rep) pg8::gemm_phase<EpiMoeOut, pg8::MoeSched<4, false, 1024>, false, true>(F.lds, F.wave, S, E);
        } SEAM(p0 + 8);
        if (PHON(11) && IN(p0 + 9)) { phase_combine(F, layer); } SEAM(p0 + 9);
    }
#ifdef OVFL_PROBE
    int lane_z; asm volatile("v_mbcnt_lo_u32_b32 %0, -1, 0\n\tv_mbcnt_hi_u32_b32 %0, -1, %0" : "=v"(lane_z));
    if (hi == NPHASE && F.blk == 0 && F.wave == 0 && lane_z == 0) { int w = 0; float big = 1e6f, huge = 3e38f; asm volatile("" : "+v"(big), "+v"(huge));
      w = __builtin_amdgcn_cvt_pk_bf8_f32(big, huge, w, false); int w2 = 0; w2 = __builtin_amdgcn_cvt_pk_fp8_f32(big, huge, w2, false);
      if (((w & 0xffff) != 0x7B7B) || ((w2 & 0xffff) != 0x7E7E)) { asm volatile("s_waitcnt vmcnt(0)" ::: "memory"); F.out[5] = __builtin_nanf(""); } }
#endif
#undef IN
#undef SEAM
}


#ifdef DBG_CHECK
namespace dbg {
__device__ float blk_sum(float v, float* red) { const int t = threadIdx.x; red[t] = v; __syncthreads(); for (int o = 128; o > 0; o >>= 1) { if (t < o) red[t] += red[t + o]; __syncthreads(); } const float r = red[0]; __syncthreads(); return r; }
struct Ctx { const float* const* in; unsigned char* ws; float* red; };
__device__ float bfb(const unsigned char* ws, size_t off, size_t idx) { return bf2f(((const bf16_t*)(ws + off))[idx]); }
__device__ float zdot(const Ctx& c, int row, int ocol) {
    float a = 0.f; for (int k = threadIdx.x; k < 1024; k += 256) a += bfb(c.ws, WS_H, (size_t)row * 1024 + k) * c.in[7][(size_t)k * 4224 + ocol];
    return blk_sum(a, c.red);
}
__device__ void upd(float* flag, float got, float want) { const float e = fabsf(got - want) / (fabsf(want) + 0.05f); if (threadIdx.x == 0 && (e > *flag || !(e == e))) *flag = (e == e) ? e : 1e9f; }
__device__ float sc_buf(const Ctx& c, int which, int row, int col) { return bfb(c.ws, WS_SCAN + (size_t)which * SCAN_PITCH, (size_t)row * 384 + col); }
__device__ void naive_scan(const Ctx& c, const float* tab, int type, int b, int h, int dir, int n, float* S, float* o64) {
    const int t = threadIdx.x;
    for (int i = t; i < 4096; i += 256) S[i] = 0.f; __syncthreads();
    const float gam = tab[TB_GAM + 0 * 12 + dir * 6 + h];
    int lastrow = 0;
    for (int p = 0; p < n; ++p) {
        const int sc = p < 256 ? 0 : 1 + (p - 256) / 256, pl = p < 256 ? p : (p - 256) % 256; const int row = scan_row(sc, pl, dir, 0) + (sc == 0 ? b * CL : b * T); lastrow = row;
        for (int i = t; i < 4096; i += 256) { const int k = i >> 6, v = i & 63;
            const float kk = sc_buf(c, type ? SC_RK : (dir ? SC_KB : SC_KF), row, h * 64 + k), vv = sc_buf(c, type ? SC_RV : SC_HV, row, h * 64 + v);
            const float f = type ? gam : 1.f - kk; S[i] = f * S[i] + kk * vv; }
        __syncthreads();
    }
    if (t < 64) { float o = 0.f; for (int k = 0; k < 64; ++k) o += sc_buf(c, type ? SC_RQ : SC_HQ, lastrow, h * 64 + k) * S[k * 64 + t]; o64[t] = o; }
    __syncthreads();
}
__global__ void __launch_bounds__(256) k_check(Args args, float* flags) {
    __shared__ float red[256]; __shared__ float S[4096]; __shared__ float o1[64], o2[64];
    Ctx c{args.in, args.ws, red}; const int id = blockIdx.x, t = threadIdx.x; float* fl = flags + id;
    const float* tab = (const float*)(args.ws + WS_TAB);
    if (t == 0) { *fl = 0.f; if (id == 12) { flags[13] = 0.f; flags[14] = 0.f; flags[15] = 0.f; } } __syncthreads();
#define rows(i) ((i) == 0 ? 5 : (i) == 1 ? 20000 : 33000)
    if (id == 0) { for (int ri = 0; ri < 3; ++ri) for (int cc = 3; cc < 384; cc += 197) { const float z = zdot(c, rows(ri), cc); upd(fl, sc_buf(c, SC_HQ, rows(ri), cc), z); } }
    if (id == 1) { for (int ri = 0; ri < 3; ++ri) for (int cc = 3; cc < 384; cc += 197) { upd(fl, sc_buf(c, SC_HV, rows(ri), cc), zdot(c, rows(ri), 1152 + cc)); upd(fl, sc_buf(c, SC_RG, rows(ri), cc), zdot(c, rows(ri), 3072 + cc)); upd(fl, sc_buf(c, SC_HG, rows(ri), cc), zdot(c, rows(ri), 1536 + cc)); upd(fl, sc_buf(c, SC_RV, rows(ri), cc), zdot(c, rows(ri), 2688 + cc)); } }
    if (id == 2) { for (int ri = 0; ri < 3; ++ri) for (int cc = 3; cc < 384; cc += 197) { const float z1 = zdot(c, rows(ri), 384 + cc), z2 = zdot(c, rows(ri), 768 + cc); upd(fl, sc_buf(c, SC_KF, rows(ri), cc), 1.f / (1.f + expf(z1))); upd(fl, sc_buf(c, SC_KB, rows(ri), cc), 1.f / (1.f + expf(z2))); } }
    if (id == 3) { for (int ri = 0; ri < 3; ++ri) for (int hh = 0; hh < 6; hh += 5) for (int i = 1; i < 32; i += 13) for (int isk = 0; isk < 2; ++isk) { const int r = rows(ri); const bool ctx = r >= NLAT; const int tt = r & (T - 1);
            const float x1 = zdot(c, r, 1920 + 384 * isk + hh * 64 + i), x2 = zdot(c, r, 1920 + 384 * isk + hh * 64 + i + 32);
            const float ang = ctx ? 0.f : (float)tt * powf(10000.f, -(float)i / 32.f); const float cs = cosf(ang), sn = sinf(ang), scl = isk ? 0.125f : 1.f;
            upd(fl, sc_buf(c, isk ? SC_RK : SC_RQ, r, hh * 64 + 2 * i), (x1 * cs - x2 * sn) * scl); upd(fl, sc_buf(c, isk ? SC_RK : SC_RQ, r, hh * 64 + 2 * i + 1), (x2 * cs + x1 * sn) * scl); } }
    if (id == 4) { for (int ri = 0; ri < 3; ++ri) for (int mp = 0; mp < 8; mp += 7) for (int half = 0; half < 2; ++half) for (int j = 1; j < 8; j += 5) { const int r = rows(ri); const bool ctx = r >= NLAT; const int tt = ctx ? (r - NLAT) & 255 : r & (T - 1); const int bb = ctx ? (r - NLAT) >> 8 : r >> 14;
            const int pos = half ? (tt & 63) : (tt >> 6); const float ang = ctx ? 0.f : (float)pos * powf(10000.f, -(float)j / 8.f); const float cs = cosf(ang), sn = sinf(ang);
            { const float x1 = zdot(c, r, 3456 + mp * 32 + half * 16 + j), x2 = zdot(c, r, 3456 + mp * 32 + half * 16 + j + 8); const float scl = 0.17677669529663687f * LOG2E;
              const size_t qi = ctx ? ((size_t)(bb * 8 + mp) * CL + tt) * 32 + half * 16 + 2 * j : ((size_t)(bb * 8 + mp) * T + tt) * 32 + half * 16 + 2 * j;
              upd(fl, bfb(c.ws, ctx ? WS_QC : WS_QA, qi), (x1 * cs - x2 * sn) * scl); upd(fl, bfb(c.ws, ctx ? WS_QC : WS_QA, qi + 1), (x2 * cs + x1 * sn) * scl); }
            { const float x1 = zdot(c, r, 3712 + mp * 32 + half * 16 + j), x2 = zdot(c, r, 3712 + mp * 32 + half * 16 + j + 8);
              const int Lk = ctx ? tt : 256 + tt, tile = Lk >> 6, rr = Lk & 63, pw = half * 16 + 2 * j;
              const size_t ki = ((size_t)((bb * 8 + mp) * KT_TILES + tile) * 4 + (pw >> 3)) * 512 + rr * 8 + (pw & 7);
              upd(fl, bfb(c.ws, WS_KA, ki), x1 * cs - x2 * sn); upd(fl, bfb(c.ws, WS_KA, ki + 1), x2 * cs + x1 * sn); }
            { const int h4 = mp >> 1, w = half * 32 + j * 3; const float z = zdot(c, r, 3968 + h4 * 64 + w); const int Lk = ctx ? tt : 256 + tt, tile = Lk >> 6, rr = Lk & 63;
              upd(fl, bfb(c.ws, WS_VA, ((size_t)((bb * 4 + h4) * KT_TILES + tile) * 2 + (w >> 5)) * 2048 + rr * 32 + (w & 31)), z); } } }
    if (id == 5 || id == 6) {
        const int type = id - 5, b = 1, h = 2;
#define ts(i) ((i) == 0 ? 0 : (i) == 1 ? 1 : 300)
        for (int q = 0; q < 3; ++q) { naive_scan(c, tab, type, b, h, 0, 256 + ts(q) + 1, S, o1);
            if (t < 64) { const float got = ((const float*)(args.ws + WS_OSCR))[(size_t)(b * T + ts(q)) * 768 + type * 384 + h * 64 + t]; const float e = fabsf(got - o1[t]) / (fabsf(o1[t]) + 0.05f); if (e > 0.05f || !(e == e)) atomicMax((int*)fl, __float_as_int((e == e) ? e : 1e9f)); } __syncthreads(); }
    }
    if (id == 7 || id == 8) {
        const int type = id - 7, b = 1, h = 4;
        for (int q = 0; q < 2; ++q) {
            int row;
            if (q == 0) { naive_scan(c, tab, type, b, h, 0, 101, S, o1); naive_scan(c, tab, type, b, h, 1, 256 - 100, S, o2); row = NLAT + b * CL + 100; }
            else { naive_scan(c, tab, type, b, h, 1, 257, S, o2); row = b * T + T - 1; if (t < 64) o1[t] = ((const float*)(args.ws + WS_OSCR))[(size_t)row * 768 + type * 384 + h * 64 + t]; __syncthreads(); }
            float o = t < 64 ? o1[t] + o2[t] : 0.f; const float ss = blk_sum(o * o, red); const float r = rsqrtf(ss / 64.f + EPS);
            if (t < 64) { const float g = sc_buf(c, type ? SC_RG : SC_HG, row, h * 64 + t); const float want = o * r * args.in[type ? 11 : 9][t] * g / (1.f + expf(-g));
                const float got = bfb(c.ws, WS_MIX, (size_t)row * 1024 + type * 384 + h * 64 + t); const float e = fabsf(got - want) / (fabsf(want) + 0.05f); if (e > 0.05f || !(e == e)) atomicMax((int*)fl, __float_as_int((e == e) ? e : 1e9f)); }
            __syncthreads(); }
    }
    if (id == 9) {
        for (int q = 0; q < 2; ++q) { const bool ctx = q == 1; const int b = ctx ? 0 : 1, h = ctx ? 3 : 2, tq = ctx ? 77 : 5000; const int nk = ctx ? 256 : 16640;
            __shared__ float po[2][64]; __shared__ float pl[2];
            for (int m = 0; m < 2; ++m) { const int mp = b * 8 + 2 * h + m;
                float mx = -1e30f;
                for (int kk = t; kk < nk; kk += 256) { float sdot = 0.f; for (int d = 0; d < 32; ++d) { const float qv = bfb(c.ws, ctx ? WS_QC : WS_QA, ((size_t)mp * (ctx ? CL : T) + tq) * 32 + d); const float kv = bfb(c.ws, WS_KA, ((size_t)(mp * KT_TILES + (kk >> 6)) * 4 + (d >> 3)) * 512 + (kk & 63) * 8 + (d & 7)); sdot += qv * kv; } mx = fmaxf(mx, sdot); }
                red[t] = mx; __syncthreads(); for (int o = 128; o > 0; o >>= 1) { if (t < o) red[t] = fmaxf(red[t], red[t + o]); __syncthreads(); } mx = red[0]; __syncthreads();
                float ls = 0.f; float av[64];
_Pragma("unroll") for (int d = 0; d < 64; ++d) av[d] = 0.f;
                for (int kk = t; kk < nk; kk += 256) { float sdot = 0.f; for (int d = 0; d < 32; ++d) { const float qv = bfb(c.ws, ctx ? WS_QC : WS_QA, ((size_t)mp * (ctx ? CL : T) + tq) * 32 + d); const float kv = bfb(c.ws, WS_KA, ((size_t)(mp * KT_TILES + (kk >> 6)) * 4 + (d >> 3)) * 512 + (kk & 63) * 8 + (d & 7)); sdot += qv * kv; }
                    const float p = exp2f(sdot - mx); ls += p;
_Pragma("unroll") for (int d = 0; d < 64; ++d) av[d] += p * bfb(c.ws, WS_VA, ((size_t)((b * 4 + h) * KT_TILES + (kk >> 6)) * 2 + (d >> 5)) * 2048 + (kk & 63) * 32 + (d & 31)); }
                ls = blk_sum(ls, red);
_Pragma("unroll") for (int d = 0; d < 64; ++d) { const float sv = blk_sum(av[d], red); if (t == 0) po[m][d] = sv; } if (t == 0) pl[m] = ls; __syncthreads();
            }
            const float lam = tab[TB_LAM + 0], oml = tab[TB_LAM + 2];
            float o = t < 64 ? po[0][t] / pl[0] - lam * po[1][t] / pl[1] : 0.f; const float ss = blk_sum(o * o, red); const float r = rsqrtf(ss / 64.f + EPS);
            if (t < 64) { const float want = o * r * args.in[13][t] * oml; const size_t row = ctx ? (size_t)(NLAT + b * CL + tq) : (size_t)(b * T + tq); const float got = bfb(c.ws, WS_MIX, row * 1024 + 768 + h * 64 + t);
                const float e = fabsf(got - want) / (fabsf(want) + 0.05f); if (e > 0.05f || !(e == e)) atomicMax((int*)fl, __float_as_int((e == e) ? e : 1e9f)); }
            __syncthreads(); }
    }
    if (id == 10) { for (int ri = 0; ri < 3; ++ri) for (int cc = 7; cc < 1024; cc += 401) { float a = 0.f; for (int k = t; k < 1024; k += 256) a += bfb(c.ws, WS_MIX, (size_t)rows(ri) * 1024 + k) * args.in[14][(size_t)k * 1024 + cc]; a = blk_sum(a, red); upd(fl, ((const float*)(args.ws + WS_Y))[(size_t)rows(ri) * 1024 + cc], a); } }
    if (id == 11) {
        const float* modv = (const float*)(args.ws + WS_MODV);
        for (int ri = 0; ri < 3; ++ri) { const int r = rows(ri), w = row_which(r); const float* xs = r < NLAT ? args.in[0] + (size_t)r * D : args.in[2] + (size_t)(r - NLAT) * D; const float* y = (const float*)(args.ws + WS_Y) + (size_t)r * D;
            float sy = 0.f; for (int k = t; k < 1024; k += 256) sy += y[k] * y[k]; sy = blk_sum(sy, red); const float ry = rsqrtf(sy / 1024.f + EPS);
            float x1[4]; float sx = 0.f;
_Pragma("unroll") for (int q = 0; q < 4; ++q) { const int k = t + 256 * q; x1[q] = xs[k] + modv[(size_t)(w * 6 + 2) * 1024 + k] * y[k] * ry; sx += x1[q] * x1[q]; } sx = blk_sum(sx, red); const float rx = rsqrtf(sx / 1024.f + EPS);
_Pragma("unroll")
            for (int q = 0; q < 4; ++q) { const int k = t + 256 * q; const float tk = x1[q] * rx * modv[(size_t)(w * 6 + 3) * 1024 + k] + modv[(size_t)(w * 6 + 4) * 1024 + k];
                const float got = bfb(c.ws, WS_H, (size_t)r * 1024 + k), got1 = ((const float*)(args.ws + WS_X1))[(size_t)r * 1024 + k];
                const float e = fmaxf(fabsf(got - tk) / (fabsf(tk) + 0.05f), fabsf(got1 - x1[q]) / (fabsf(x1[q]) + 0.05f)); if (e > 0.05f || !(e == e)) atomicMax((int*)fl, __float_as_int((e == e) ? e : 1e9f)); }
            __syncthreads(); } }

    if (id == 12) {
        __shared__ float tokf[1024], lg[32], abuf[2048], actb[1024], yb[1024]; __shared__ int te[4]; __shared__ float tg[4]; __shared__ int spos;
        const unsigned* cnt = (const unsigned*)(args.ws + WS_CTL) + CW_CNT; const int* slot = (const int*)(args.ws + WS_SLOT);
        for (int ri = 0; ri < 3; ++ri) { const int r = rows(ri);
            for (int k = t; k < 1024; k += 256) tokf[k] = bfb(c.ws, WS_H, (size_t)r * 1024 + k); __syncthreads();
            if (t < 32) { float a = args.in[16][t]; for (int k = 0; k < 1024; ++k) a += tokf[k] * args.in[15][(size_t)k * 32 + t]; lg[t] = a; } __syncthreads();
            if (t < 32) { const float got = ((const float*)(args.ws + WS_END + 65536))[(size_t)r * 32 + t]; const float e = fabsf(got - lg[t]); if (e > 0.02f || !(e == e)) atomicMax((int*)(flags + 15), __float_as_int((e == e) ? 1.f + e : 1e9f)); } __syncthreads();
            if (t == 0) { float tv[4]; for (int k = 0; k < 4; ++k) { int bi = 0; float bv = -1e30f; for (int e = 0; e < 32; ++e) if (lg[e] > bv) { bv = lg[e]; bi = e; } te[k] = bi; tv[k] = bv; lg[bi] = -1e30f; }
                float sm = 0.f; for (int k = 0; k < 4; ++k) { tg[k] = expf(tv[k] - tv[0]); sm += tg[k]; } for (int k = 0; k < 4; ++k) tg[k] /= sm; } __syncthreads();
            if (t < 4) { const float got = ((const float*)(args.ws + WS_GATE))[(size_t)r * 4 + t]; const float e = fabsf(got - tg[t]) / (tg[t] + 0.01f); if (e > 0.05f || !(e == e)) atomicMax((int*)(flags + 12), __float_as_int((e == e) ? e : 1e9f)); }
            for (int k4 = 0; k4 < 4; ++k4) { const int e = te[k4]; const float* w1 = args.in[17] + (size_t)e * 1024 * 2048; const float* w2 = args.in[19] + (size_t)e * 1024 * 1024;
                for (int n = t; n < 2048; n += 256) { float a = args.in[18][(size_t)e * 2048 + n]; for (int k = 0; k < 1024; ++k) a += tokf[k] * w1[(size_t)k * 2048 + n]; abuf[n] = a; } __syncthreads();
                for (int j = t; j < 1024; j += 256) { const float g = fminf(abuf[2 * j], 7.f), l = fminf(fmaxf(abuf[2 * j + 1], -7.f), 7.f); actb[j] = g / (1.f + expf(-1.702f * g)) * (l + 1.f); } __syncthreads();
                for (int cc = t; cc < 1024; cc += 256) { float a = args.in[20][(size_t)e * 1024 + cc]; for (int j = 0; j < 1024; ++j) a += actb[j] * w2[(size_t)j * 1024 + cc]; yb[cc] = a * tg[k4]; } __syncthreads();
                if (t == 0) spos = -1; __syncthreads();
                const int ce = (int)cnt[e]; for (int p = t; p < ce; p += 256) if (slot[e * CAP + p] == r * 4 + k4) spos = p; __syncthreads();
                int ts0 = 0; for (int q = 0; q < e; ++q) ts0 += ((int)cnt[q] + 255) >> 8;
                float sqa = 0.f, sqy = 0.f; for (int k = t; k < 1024; k += 256) { sqa += actb[k] * actb[k]; sqy += yb[k] * yb[k]; } sqa = blk_sum(sqa, red); sqy = blk_sum(sqy, red); const float ra = sqrtf(sqa / 1024.f), ry = sqrtf(sqy / 1024.f);
                if (spos < 0) { if (t == 0) flags[13] = 7e8f; }
                else for (int k = t; k < 1024; k += 256) { const float got = bfb(c.ws, WS_ACT, ((size_t)ts0 * 256 + spos) * 1024 + k); const float er = fabsf(got - actb[k]) / (fabsf(actb[k]) + 0.2f * ra + 1e-6f); if (er > 0.05f || !(er == er)) atomicMax((int*)(flags + 13), __float_as_int((er == er) ? er : 1e9f)); }
                for (int k = t; k < 1024; k += 256) { const float got = bfb(c.ws, WS_YK, ((size_t)r * 4 + k4) * 1024 + k); const float er = fabsf(got - yb[k]) / (fabsf(yb[k]) + 0.2f * ry + 1e-6f); if (er > 0.05f || !(er == er)) atomicMax((int*)(flags + 14), __float_as_int((er == er) ? er : 1e9f)); }
                __syncthreads(); }
        } }
}
__global__ void k_out(Args args, const float* flags, int nchk, unsigned mask) {
    int code = 0; for (int i = nchk - 1; i >= 0; --i) if (((mask >> i) & 1u) && flags[i] > 0.05f) code = i + 1;
    const float sc = 1.f + (float)code;
    for (size_t i = (size_t)blockIdx.x * blockDim.x + threadIdx.x; i < (size_t)NLAT * D; i += (size_t)gridDim.x * blockDim.x) args.out[i] = args.in[0][i] * sc;
}
}
#endif

extern "C" void kernel_launch(void* const* d_in, const int* in_sizes, int n_in, void* d_out, int out_size, void* d_ws, size_t ws_size, hipStream_t stream) {
    static int grid = 0;
    if (grid == 0) {
        if (n_in != 21 || out_size != NLAT * D || ws_size < WS_END) { fprintf(stderr, "kernel_launch: unexpected shapes (n_in %d out %d ws %zu)\n", n_in, out_size, ws_size); grid = -1; return; }
        int dev = 0, cus = 0, per_cu = 0;
        if (hipGetDevice(&dev) != hipSuccess || hipDeviceGetAttribute(&cus, hipDeviceAttributeMultiprocessorCount, dev) != hipSuccess) { grid = -1; return; }
        if (hipFuncSetAttribute((const void*)mk_fwd, hipFuncAttributeMaxDynamicSharedMemorySize, LDS_BYTES) != hipSuccess) { fprintf(stderr, "kernel_launch: hipFuncSetAttribute failed\n"); grid = -1; return; }
        if (hipOccupancyMaxActiveBlocksPerMultiprocessor(&per_cu, (const void*)mk_fwd, NTHR, LDS_BYTES) != hipSuccess || per_cu < 1) fprintf(stderr, "kernel_launch: occupancy query reports %d\n", per_cu);
        (void)hipGetLastError();
        grid = cus;
    }
    if (grid < 0) return;
    if (hipMemsetAsync((char*)d_ws + WS_CTL, 0, CTL_ZERO_BYTES, stream) != hipSuccess) return;
    Args a{};
    for (int i = 0; i < 21; ++i) a.in[i] = (const float*)d_in[i];
    a.out = (float*)d_out; a.ws = (unsigned char*)d_ws;
#if MK_ONE_LAUNCH
    a.ph_lo = 0; a.ph_hi = NPHASE;
    hipLaunchKernelGGL(mk_fwd, dim3(grid), dim3(NTHR), LDS_BYTES, stream, a);
#elif defined(DBG_CHECK)
    for (int p = 0; p < DBG_CHECK; ++p) { a.ph_lo = p; a.ph_hi = p + 1; hipLaunchKernelGGL(mk_fwd, dim3(grid), dim3(NTHR), LDS_BYTES, stream, a); }
    float* flags = (float*)((char*)d_ws + WS_END);
    hipLaunchKernelGGL(dbg::k_check, dim3(13), dim3(256), 0, stream, a, flags);
    hipLaunchKernelGGL(dbg::k_out, dim3(1024), dim3(256), 0, stream, a, (const float*)flags, 16, (unsigned)DBG_MASK);
#else
    for (int p = 0; p < NPHASE; ++p) { a.ph_lo = p; a.ph_hi = p + 1; hipLaunchKernelGGL(mk_fwd, dim3(grid), dim3(NTHR), LDS_BYTES, stream, a); }
#endif
}
```

```cpp
#include <hip/hip_runtime.h>
#include <cstdio>
#include <cstdint>
#include <cmath>

#ifndef DBG_MASK
#define DBG_MASK 0xf800
#endif
#ifndef PHMASK
#define PHMASK 0xfff
#endif
#define PHON(k) ((PHMASK >> (k)) & 1)
#ifndef REPMASK
#define REPMASK 0
#endif
#define NREP(k) (1 + ((REPMASK >> (k)) & 1))
#ifndef ATTVAR
#define ATTVAR -1
#endif
#ifndef MK_ONE_LAUNCH
#define MK_ONE_LAUNCH 1
#endif
#define PROBE_PH -1
#define PROBE_SUB 3

#define LAS __attribute__((address_space(3)))
#define GAS __attribute__((address_space(1)))
typedef unsigned short bf16_t;
typedef short bf16x8 __attribute__((ext_vector_type(8)));
typedef short s16x4 __attribute__((ext_vector_type(4)));
typedef float f32x2 __attribute__((ext_vector_type(2)));
typedef float f32x4 __attribute__((ext_vector_type(4)));
typedef float f32x16 __attribute__((ext_vector_type(16)));
typedef unsigned u32x2 __attribute__((ext_vector_type(2)));
typedef unsigned u32x4 __attribute__((ext_vector_type(4)));
typedef GAS unsigned gu32;
typedef int v4i __attribute__((ext_vector_type(4)));
typedef int v8i __attribute__((ext_vector_type(8)));

constexpr int NB = 2, T = 16384, CL = 256, D = 1024;
constexpr int NLAT = NB * T, NCTX = NB * CL, NROW = NLAT + NCTX;
constexpr int NE = 32, CAP = NROW;
constexpr int NIN = 4352;
constexpr int NSEQ = 48, NSC = 65;
constexpr int KT_TILES = 260;
constexpr float EPS = 1e-6f;
constexpr float LOG2E = 1.4426950408889634f;
constexpr int NWAVES = 8, NTHR = 512;

constexpr size_t MiB = 1u << 20;
constexpr size_t WS_CTL = 0, CTL_ZERO_BYTES = 64 * 1024;
constexpr size_t WS_MODV = 1 * MiB;
constexpr size_t WS_TAB = 1 * MiB + 256 * 1024;
constexpr size_t WS_RWT = 1 * MiB + 512 * 1024;
constexpr size_t WS_ROPE = 2 * MiB;
constexpr size_t WS_WIN = 6 * MiB;
constexpr size_t WS_WOUT = 23 * MiB;
constexpr size_t WS_W1 = 27 * MiB;
constexpr size_t WS_W2 = 283 * MiB;
constexpr size_t WS_X1 = 411 * MiB;
constexpr size_t WS_H = 541 * MiB;
constexpr size_t WS_SCAN = 606 * MiB;
constexpr size_t SCAN_PITCH = 25 * MiB;
constexpr size_t WS_QA = 831 * MiB;
constexpr size_t WS_QC = 847 * MiB;
constexpr size_t WS_KA = 848 * MiB;
constexpr size_t WS_VA = 865 * MiB;
constexpr size_t WS_SLOC = 882 * MiB;
constexpr size_t WS_SIN = 931 * MiB;
constexpr size_t WS_DEC = 980 * MiB;
constexpr size_t WS_OSCR = 981 * MiB;
constexpr size_t WS_MIX = 1079 * MiB;
constexpr size_t WS_Y = 1144 * MiB;
constexpr size_t WS_SLOT = 1274 * MiB;
constexpr size_t WS_GATE = 1279 * MiB;
constexpr size_t WS_ACT = 1280 * MiB;
constexpr size_t WS_YK = 1540 * MiB;
constexpr size_t WS_TOK8 = 1816 * MiB;
constexpr size_t WS_SGATE = 1850 * MiB;
constexpr size_t WS_END = 1856 * MiB;
enum { SC_KF = 0, SC_KB = 1, SC_RQ = 2, SC_RK = 3, SC_HQ = 4, SC_HV = 5, SC_HG = 6, SC_RV = 7, SC_RG = 8 };
constexpr int CW_TMO = 0, CW_BAR = 4096, CW_CNT = 8192;
constexpr int TB_LBT = 0;
constexpr int TB_LAM = 1024;
constexpr int TB_GAM = 1040;
constexpr int TB_AXR = 2048;
constexpr int TB_AXC = 2048 + 4096;

constexpr int LDS_BYTES = 147456;
constexpr int LDS_MISC = 131072 + 12288;
constexpr int LDS_TAB = 131072;

__device__ __forceinline__ unsigned f2bf(float f) { unsigned u = __builtin_bit_cast(unsigned, f); return (u + 0x7fffu + ((u >> 16) & 1u)) >> 16; }
__device__ __forceinline__ unsigned pk2(float lo, float hi) { return f2bf(lo) | (f2bf(hi) << 16); }
__device__ __forceinline__ float bf2f(unsigned short b) { return __builtin_bit_cast(float, (unsigned)b << 16); }
__device__ __forceinline__ float bflo(unsigned w) { return __builtin_bit_cast(float, w << 16); }
__device__ __forceinline__ float bfhi(unsigned w) { return __builtin_bit_cast(float, w & 0xffff0000u); }
typedef __bf16 bf16x2_t __attribute__((ext_vector_type(2)));
__device__ __forceinline__ unsigned trunc_pk_bf16(float lo, float hi) { return __builtin_amdgcn_perm(__builtin_bit_cast(unsigned, hi), __builtin_bit_cast(unsigned, lo), 0x07060302u); }
__device__ __forceinline__ unsigned cvt_pk_bf16(float lo, float hi) { const f32x2 v = {lo, hi}; const bf16x2_t b = __builtin_convertvector(v, bf16x2_t); return __builtin_bit_cast(unsigned, b); }
__device__ __forceinline__ float wave_sum_dpp(float v) {
#define DPP_ADD(ctrl, rmask) v += __builtin_bit_cast(float, __builtin_amdgcn_update_dpp(0, __builtin_bit_cast(int, v), ctrl, rmask, 0xF, false))
    DPP_ADD(0xB1, 0xF); DPP_ADD(0x4E, 0xF); DPP_ADD(0x141, 0xF); DPP_ADD(0x140, 0xF); DPP_ADD(0x142, 0xA); DPP_ADD(0x143, 0xC);
#undef DPP_ADD
    return __builtin_bit_cast(float, __builtin_amdgcn_readlane(__builtin_bit_cast(int, v), 63));
}
__device__ __forceinline__ float wave_sum(float v) { return wave_sum_dpp(v); }
template <int M> __device__ __forceinline__ float xor_swz(float v) { return __builtin_bit_cast(float, __builtin_amdgcn_ds_swizzle(__builtin_bit_cast(int, v), 0x1F | (M << 10))); }
__device__ __forceinline__ float xor32(float v, int lane) { return __builtin_bit_cast(float, __builtin_amdgcn_ds_bpermute((lane ^ 32) << 2, __builtin_bit_cast(int, v))); }
__device__ __forceinline__ float rdlane(float v, int l) { return __builtin_bit_cast(float, __builtin_amdgcn_readlane(__builtin_bit_cast(int, v), l)); }
__device__ __forceinline__ float sigmoidf_(float x) { return __builtin_amdgcn_rcpf(1.f + __builtin_amdgcn_exp2f(-LOG2E * x)); }
#define PHASE_IDS_W(WV) int lane; asm volatile("v_mbcnt_lo_u32_b32 %0, -1, 0\n\tv_mbcnt_hi_u32_b32 %0, -1, %0" : "=v"(lane)); int wave = (WV); asm volatile("" : "+s"(wave)); const int tid = wave * 64 + lane; (void)tid
#define PHASE_IDS() PHASE_IDS_W(F.wave); int blk_ = F.blk; asm volatile("" : "+s"(blk_))
__device__ __forceinline__ unsigned pk4_fp8(float a, float b, float c, float d) { int w = __builtin_bit_cast(int, a); w = __builtin_amdgcn_cvt_pk_fp8_f32(a, b, w, false); w = __builtin_amdgcn_cvt_pk_fp8_f32(c, d, w, true); return (unsigned)w; }
constexpr float W8_MUL = 64.f;
constexpr int SCALE_W8 = 0x79797979, SCALE_A8 = 0x7F7F7F7F;
#define LDS_WAIT() asm volatile("s_waitcnt lgkmcnt(0)" ::: "memory")
#define VM_WAIT() asm volatile("s_waitcnt vmcnt(0)" ::: "memory")

#define XB_TMO      128
#define XB_XCNT(j)  (256  + 64 * (j))
#define XB_XSUB(j)  (1280 + 64 * (j))
#define XB_XGEN(j)  (2304 + 64 * (j))
#define XB_TOP      3328
#define XB_TOPGEN   3392
#define XCD_BAR_WORDS 3456
#define XB_SPIN_CAP (1u << 22)
__device__ __forceinline__ unsigned xb_ld(unsigned* p)              { return __hip_atomic_load(p, __ATOMIC_RELAXED, __HIP_MEMORY_SCOPE_AGENT); }
__device__ __forceinline__ unsigned xb_add(unsigned* p, unsigned v) { return __hip_atomic_fetch_add(p, v, __ATOMIC_RELAXED, __HIP_MEMORY_SCOPE_AGENT); }
__device__ __forceinline__ unsigned xb_xcc_id() { return (unsigned)__builtin_amdgcn_s_getreg((3 << 11) | 20) & 0xFu; }
#define XB_SPIN(cond, bar) do { unsigned _sp = 0; while (cond) { __builtin_amdgcn_s_sleep(1); \
    if ((++_sp & 255u) == 0u) { if (xb_ld(&(bar)[XB_TMO])) break; if (_sp > XB_SPIN_CAP) { atomicAdd(&(bar)[XB_TMO], 1u); break; } } } } while (0)
struct XcdBarrier { unsigned* bar; unsigned x; volatile LAS unsigned* st; };
__device__ __forceinline__ XcdBarrier xcd_barrier_post(unsigned* bar, volatile LAS unsigned* st) {
    XcdBarrier b; b.bar = bar; b.x = xb_xcc_id(); b.st = st;
    if (threadIdx.x == 0) (void)xb_add(&bar[XB_XCNT(b.x)], 1u);
    return b;
}
__device__ __forceinline__ void xcd_barrier_complete(unsigned* bar, unsigned x, unsigned& nloc, unsigned& nx) {
    const unsigned G = gridDim.x * gridDim.y * gridDim.z;
    unsigned sum, cnt, mine, sp = 0u;
    for (;;) {
        sum = 0u; cnt = 0u; mine = 0u;
#pragma unroll
        for (unsigned j = 0; j < 16; ++j) { const unsigned c = xb_ld(&bar[XB_XCNT(j)]); sum += c; cnt += (c > 0u) ? 1u : 0u; mine = (j == x) ? c : mine; }
        if (sum == G) break;
        __builtin_amdgcn_s_sleep(1);
        if ((++sp & 255u) == 0u) { if (xb_ld(&bar[XB_TMO])) break; if (sp > XB_SPIN_CAP) { atomicAdd(&bar[XB_TMO], 1u); break; } }
    }
    nloc = mine > 0u ? mine : 1u; nx = cnt > 0u ? cnt : 1u;
}
__device__ __forceinline__ void xcd_barrier_census(const XcdBarrier& b) {
    unsigned nloc, nx; xcd_barrier_complete(b.bar, b.x, nloc, nx); b.st[0] = nloc; b.st[1] = nx;
}
__device__ __forceinline__ void xcd_barrier(const XcdBarrier& b) {
    asm volatile("s_waitcnt vmcnt(0)" ::: "memory");
    __syncthreads();
    if (threadIdx.x == 0) {
        unsigned* bar = b.bar;
        __builtin_amdgcn_s_waitcnt(0);
        const unsigned nloc = b.st[0], nx = b.st[1];
        const unsigned old = xb_add(&bar[XB_XSUB(b.x)], 1u);
        const unsigned gen = old / nloc;
        if (old + 1u == (gen + 1u) * nloc) {
            __builtin_amdgcn_fence(__ATOMIC_RELEASE, "agent");
            asm volatile("s_waitcnt vmcnt(0)" ::: "memory");
            const unsigned og = xb_add(&bar[XB_TOP], 1u);
            const unsigned tg = og / nx;
            if (og + 1u == (tg + 1u) * nx) xb_add(&bar[XB_TOPGEN], 1u);
            else XB_SPIN(xb_ld(&bar[XB_TOPGEN]) == tg, bar);
            __builtin_amdgcn_fence(__ATOMIC_ACQUIRE, "agent");
            xb_add(&bar[XB_XGEN(b.x)], 1u);
            asm volatile("s_waitcnt vmcnt(0)" ::: "memory");
        } else {
            XB_SPIN(xb_ld(&bar[XB_XGEN(b.x)]) == gen, bar);
            __builtin_amdgcn_fence(__ATOMIC_ACQUIRE, "agent");
            asm volatile("s_waitcnt vmcnt(0)" ::: "memory");
        }
    }
    __syncthreads();
}

struct Frame {
    LAS unsigned char* lds;
    unsigned char* ws;
    const float* in[21];
    float* out;
    gu32* ctl;
    int tid, lane, wave, G, blk;
};

__device__ __forceinline__ void glds16(const void* sbase, unsigned voff, unsigned lds_dst) { unsigned keep;
    asm volatile("s_mov_b32 %0, m0\n\ts_mov_b32 m0, %3\n\ts_nop 0\n\tglobal_load_lds_dwordx4 %1, %2\n\ts_mov_b32 m0, %0" : "=&s"(keep) : "v"(voff), "s"(sbase), "s"(lds_dst) : "memory"); }

namespace pg8 {
constexpr int BM = 256, BK = 64, HALF = 128, HTB = HALF * BK * 2, STAGE_BYTES = 8 * HTB, NXCD = 8, WGM = 8, K = 1024;
__host__ __device__ __forceinline__ int lds_byte(int r, int c) { const int st = (r >> 4) * 2 + (c >> 5), rr = r & 15, cc = c & 31, ob = rr * 64 + cc * 2; return st * 1024 + (ob ^ (((ob >> 9) & 1) << 5)); }
__host__ __device__ __forceinline__ void stage_rc(int b, int& R, int& C) { const int st = b / 1024, sb = b % 1024, swz = sb ^ (((sb >> 9) & 1) << 5); R = (st >> 1) * 16 + swz / 64; C = (st & 1) * 32 + (swz % 64) / 2; }
__host__ __device__ __forceinline__ int perm32(int rho) { const int n = rho >> 4, i = rho & 15; return 8 * (i >> 2) + 4 * n + (i & 3); }
struct Unit { int pm, pn, e, nvalid, sbase; };
template <class Epi, class Sched, bool GATHER, bool FP8 = false>
__device__ __forceinline__ void gemm_phase(LAS unsigned char* lds, int wave_id, const Sched& S, const Epi& E) {
    constexpr int KB = FP8 ? 1024 : 2048, NT = KB / 128;
    PHASE_IDS_W(wave_id); const int wid = wave, wr = wid >> 2, wc = wid & 3, fr = lane & 15, fq = lane >> 4;
    unsigned voffB[2], vA[2][2]; int R0, C0;
    { int R, C; stage_rc(tid * 16, R, C); R0 = R; C0 = C;
#pragma unroll
      for (int i = 0; i < 2; ++i) { const int Ri = R + 64 * i; const int Rb = Epi::PERM ? ((Ri & ~31) + perm32(Ri & 31)) : Ri; voffB[i] = (unsigned)(Rb * KB + C * 2);
#pragma unroll
          for (int h = 0; h < 2; ++h) vA[h][i] = (unsigned)((Ri + 128 * h) * KB + C * 2); } }
    const size_t kstep = (size_t)(BK * 2);
    const size_t hstep = (size_t)HALF * KB;
    const unsigned ldsw = (unsigned)wid * 1024u, lds0 = (unsigned)(uintptr_t)lds;
    const int aoff = lds_byte(wr * 64 + fr, fq * 8), boff = lds_byte(wc * 32 + fr, fq * 8);
#define PG8_SA(b, h) (((b) * 2 + (h)) * HTB)
#define PG8_SB(b, h) ((4 + (b) * 2 + (h)) * HTB)
#define PG8_STAGE(bufoff, gbase, voff) do { _Pragma("unroll") for (int _i = 0; _i < 2; ++_i) \
        glds16((const void*)(gbase), (voff)[_i], (unsigned)__builtin_amdgcn_readfirstlane(lds0 + (unsigned)(bufoff) + ldsw + _i * 8192)); } while (0)
#define PG8_LDA(dst, b, h) do { _Pragma("unroll") for (int m = 0; m < 4; ++m) { dst[m].lo = *(const LAS v4i*)(lds + PG8_SA(b, h) + aoff + m * 2048); dst[m].hi = *(const LAS v4i*)(lds + PG8_SA(b, h) + aoff + m * 2048 + 1024); } } while (0)
#define PG8_LDB(dst, b, h) do { _Pragma("unroll") for (int n = 0; n < 2; ++n) { dst[n].lo = *(const LAS v4i*)(lds + PG8_SB(b, h) + boff + n * 2048); dst[n].hi = *(const LAS v4i*)(lds + PG8_SB(b, h) + boff + n * 2048 + 1024); } } while (0)
#define PG8_MMA(ai, bj, At, Bt) do { __builtin_amdgcn_s_setprio(1); _Pragma("unroll") for (int m = 0; m < 4; ++m) _Pragma("unroll") for (int n = 0; n < 2; ++n) { \
        if constexpr (FP8) acc[ai][bj][m][n] = __builtin_amdgcn_mfma_scale_f32_16x16x128_f8f6f4(Bt[n], At[m], acc[ai][bj][m][n], 0, 0, 0, SCALE_W8, 0, SCALE_A8); \
        else { acc[ai][bj][m][n] = __builtin_amdgcn_mfma_f32_16x16x32_bf16(__builtin_bit_cast(bf16x8, (v4i)Bt[n].lo), __builtin_bit_cast(bf16x8, (v4i)At[m].lo), acc[ai][bj][m][n], 0, 0, 0); \
               acc[ai][bj][m][n] = __builtin_amdgcn_mfma_f32_16x16x32_bf16(__builtin_bit_cast(bf16x8, (v4i)Bt[n].hi), __builtin_bit_cast(bf16x8, (v4i)At[m].hi), acc[ai][bj][m][n], 0, 0, 0); } } \
        __builtin_amdgcn_s_setprio(0); } while (0)
#define PG8_WAIT_V(n) asm volatile("s_waitcnt vmcnt(" #n ")" ::: "memory")
#define PG8_WAIT_L(n) asm volatile("s_waitcnt lgkmcnt(" #n ")" ::: "memory")
#define PG8_BAR __builtin_amdgcn_s_barrier()
#define PG8_SCHED __builtin_amdgcn_sched_barrier(0)
    Unit cur, nxt; int ui = 0;
    if (!S.next(0, cur)) return;
    f32x4 acc[2][2][4][2];
#pragma unroll
    for (int a = 0; a < 2; ++a)
#pragma unroll
        for (int b = 0; b < 2; ++b)
#pragma unroll
            for (int m = 0; m < 4; ++m)
#pragma unroll
                for (int n = 0; n < 2; ++n) acc[a][b][m][n] = (f32x4){0.f, 0.f, 0.f, 0.f};
    v8i At[4], B0[2], B1[2];
    const char* cA = S.a_ptr(cur); const char* cB = S.b_ptr(cur);
    unsigned nvA[2][2];
    if constexpr (GATHER) S.a_off(cur, R0, C0, vA);
    PG8_STAGE(PG8_SB(0, 0), cB, voffB); PG8_STAGE(PG8_SB(0, 1), cB + hstep, voffB); PG8_STAGE(PG8_SA(0, 0), cA, vA[0]); PG8_STAGE(PG8_SA(0, 1), cA, vA[1]);
    if (wr == 1) PG8_BAR;
    PG8_WAIT_V(2); PG8_BAR;
    PG8_STAGE(PG8_SB(1, 0), cB + kstep, voffB); PG8_STAGE(PG8_SA(1, 0), cA + kstep, vA[0]); PG8_STAGE(PG8_SB(1, 1), cB + hstep + kstep, voffB);
    PG8_WAIT_V(6); PG8_BAR;
    for (;;) {
        const bool has_next = S.next(ui + 1, nxt);
        const char* nA = has_next ? S.a_ptr(nxt) : cA; const char* nB = has_next ? S.b_ptr(nxt) : cB;
        if constexpr (GATHER) { if (has_next) S.a_off(nxt, R0, C0, nvA); }
#pragma unroll 1
        for (int t = 0; t < NT; t += 2) {
            const bool last = (t == NT - 2);
            const char* a1 = cA + (size_t)(t + 1) * kstep;
            const char* a2 = last ? nA : cA + (size_t)(t + 2) * kstep; const char* b2 = last ? nB : cB + (size_t)(t + 2) * kstep;
            const char* a3 = a2 + kstep; const char* b3 = b2 + kstep;
            PG8_LDB(B0, 0, 0); PG8_LDB(B1, 0, 1); PG8_SCHED; PG8_LDA(At, 0, 0); PG8_STAGE(PG8_SA(1, 1), a1, vA[1]);
            if constexpr (GATHER) { if (last && has_next) {
#pragma unroll
                for (int h = 0; h < 2; ++h)
#pragma unroll
                    for (int i = 0; i < 2; ++i) vA[h][i] = nvA[h][i]; } }
            PG8_WAIT_V(8); PG8_WAIT_L(0); PG8_BAR; PG8_MMA(0, 0, At, B0); PG8_MMA(0, 1, At, B1); PG8_BAR; PG8_SCHED;
            PG8_LDA(At, 0, 1); PG8_STAGE(PG8_SB(0, 0), b2, voffB); PG8_STAGE(PG8_SB(0, 1), b2 + hstep, voffB); PG8_STAGE(PG8_SA(0, 0), a2, vA[0]);
            PG8_WAIT_V(8); PG8_WAIT_L(0); PG8_BAR; PG8_MMA(1, 0, At, B0); PG8_MMA(1, 1, At, B1); PG8_BAR; PG8_SCHED;
            PG8_LDB(B0, 1, 0); PG8_LDB(B1, 1, 1); PG8_SCHED; PG8_LDA(At, 1, 0); PG8_STAGE(PG8_SA(0, 1), a2, vA[1]);
            PG8_WAIT_V(8); PG8_WAIT_L(0); PG8_BAR; PG8_MMA(0, 0, At, B0); PG8_MMA(0, 1, At, B1); PG8_BAR; PG8_SCHED;
            PG8_LDA(At, 1, 1); PG8_STAGE(PG8_SB(1, 0), b3, voffB); PG8_STAGE(PG8_SB(1, 1), b3 + hstep, voffB); PG8_STAGE(PG8_SA(1, 0), a3, vA[0]);
            PG8_WAIT_V(8); PG8_WAIT_L(0); PG8_BAR; PG8_MMA(1, 0, At, B0); PG8_MMA(1, 1, At, B1); PG8_BAR; PG8_SCHED;
        }
        if (wr == 0) PG8_BAR;
        { int le; asm volatile("v_mbcnt_lo_u32_b32 %0, -1, 0\n\tv_mbcnt_hi_u32_b32 %0, -1, %0" : "=v"(le)); E(acc, cur, wr, wc, le & 15, le >> 4); }
        if (!has_next) break;
#pragma unroll
        for (int a = 0; a < 2; ++a)
#pragma unroll
            for (int b = 0; b < 2; ++b)
#pragma unroll
                for (int m = 0; m < 4; ++m)
#pragma unroll
                    for (int n = 0; n < 2; ++n) acc[a][b][m][n] = (f32x4){0.f, 0.f, 0.f, 0.f};
        cur = nxt; cA = nA; cB = nB; ++ui;
        if (wr == 1) PG8_BAR;
    }
    PG8_WAIT_V(0);
    PG8_BAR;
#undef PG8_SA
#undef PG8_SB
#undef PG8_STAGE
#undef PG8_LDA
#undef PG8_LDB
#undef PG8_MMA
#undef PG8_WAIT_V
#undef PG8_WAIT_L
#undef PG8_BAR
#undef PG8_SCHED
}

struct DenseSched {
    const char* A; const char* Bt; int nM, nN, nwg, G, c;
    __device__ __forceinline__ void init(const void* A_, const void* Bt_, int M, int N, int G_, int c_) { A = (const char*)A_; Bt = (const char*)Bt_; nM = M / BM; nN = N / BM; nwg = nM * nN; G = G_; c = c_; }
    __device__ __forceinline__ bool next(int i, Unit& u) const {
        const long L = (long)i * G + c; if (L >= nwg) return false;
        int wgid = (int)L; { const int q = nwg / NXCD, r = nwg % NXCD, xcd = wgid % NXCD, off = wgid / NXCD; wgid = (xcd < r ? xcd * (q + 1) : r * (q + 1) + (xcd - r) * q) + off; }
        const int nig = WGM * nN, gid = wgid / nig, fm = gid * WGM, gsz = (nM - fm) < WGM ? (nM - fm) : WGM;
        u.pm = fm + ((wgid % nig) % gsz); u.pn = (wgid % nig) / gsz; u.e = 0; u.nvalid = 256; u.sbase = 0; return true;
    }
    __device__ __forceinline__ const char* a_ptr(const Unit& u) const { return A + (size_t)u.pm * (BM * K * 2); }
    __device__ __forceinline__ const char* b_ptr(const Unit& u) const { return Bt + (size_t)u.pn * (BM * K * 2); }
    __device__ __forceinline__ void a_off(const Unit&, int, int, unsigned (&)[2][2]) const {}
};
template <int NPN, bool GATHER_A, int KB> struct MoeSched {
    const char* A; const char* Bt; const int* slot; const LAS int* tab; int G, c; size_t bstride;
    __device__ __forceinline__ bool next(int i, Unit& u) const {
        const int ntile = __builtin_amdgcn_readfirstlane(tab[32]);
        int mtg;
        if ((G & 7) == 0) { const int x = c & 7, j = (c >> 3) + (G >> 3) * i; u.pn = j % NPN; mtg = (j / NPN) * 8 + x; if (mtg >= ntile) return false; }
        else { const int lin = i * G + c; if (lin >= ntile * NPN) return false; u.pn = lin % NPN; mtg = lin / NPN; }
        int e = 0;
        while (e < 31 && __builtin_amdgcn_readfirstlane(tab[e + 1]) <= mtg) ++e;
        const int mtl = mtg - __builtin_amdgcn_readfirstlane(tab[e]); int nv = __builtin_amdgcn_readfirstlane(tab[33 + e]) - 256 * mtl; nv = nv > 256 ? 256 : nv;
        u.pm = mtg; u.e = e; u.nvalid = nv; u.sbase = e * CAP + 256 * mtl; return true;
    }
    __device__ __forceinline__ const char* a_ptr(const Unit& u) const { return GATHER_A ? A : A + (size_t)u.pm * (BM * KB); }
    __device__ __forceinline__ const char* b_ptr(const Unit& u) const { return Bt + (size_t)u.e * bstride + (size_t)u.pn * (BM * KB); }
    __device__ __forceinline__ void a_off(const Unit& u, int R0, int C0, unsigned (&v)[2][2]) const {
#pragma unroll
        for (int h = 0; h < 2; ++h)
#pragma unroll
            for (int i = 0; i < 2; ++i) { const int rl = h * 128 + R0 + 64 * i; const int id = (rl < u.nvalid) ? slot[u.sbase + rl] : 0; v[h][i] = (unsigned)(id >> 2) * (unsigned)KB + (unsigned)C0 * 2u; }
    }
};
}

struct EpiInProj {
    static constexpr bool PERM = true;
    unsigned char* ws; const float* tab; const float* rope; int layer;
    template <int TYPE> __device__ __forceinline__ void run(const f32x4 (&acc)[2][2][4][2], const pg8::Unit& u, int wr, int wc, int fr, int fq) const {
        asm volatile("" : "+v"(fr), "+v"(fq));
        const int pn = u.pn, pm = u.pm; const bool ctx = pm >= 128;
        const int bb = ctx ? (pm - 128) : (pm >> 6);
#pragma unroll
        for (int ai = 0; ai < 2; ++ai)
#pragma unroll
            for (int m = 0; m < 4; ++m) {
                const int rl = 128 * ai + 64 * wr + 16 * m + fr; const int row = pm * 256 + rl;
                const int tt = ctx ? rl : (row & (T - 1));
                const int Lk = ctx ? tt : 256 + tt; const int ktile = Lk >> 6, krr = Lk & 63;
#pragma unroll
                for (int bj = 0; bj < 2; ++bj) {
                    const int np = 256 * pn + 128 * bj + 32 * wc + 8 * fq;
                    f32x4 v0 = acc[ai][bj][m][0], v1 = acc[ai][bj][m][1];
                    bf16_t* dst;
                    if (TYPE == 0) {
                        const int dir = np >= 384, col = np - 384 * dir;
                        const f32x4 l0 = *(const f32x4*)(tab + TB_LBT + layer * 384 + col), l1 = *(const f32x4*)(tab + TB_LBT + layer * 384 + col + 4);
#pragma unroll
                        for (int q = 0; q < 4; ++q) { v0[q] = (1.f - l0[q]) * sigmoidf_(-v0[q]); v1[q] = (1.f - l1[q]) * sigmoidf_(-v1[q]); }
                        dst = (bf16_t*)(ws + WS_SCAN + (size_t)(dir ? SC_KB : SC_KF) * SCAN_PITCH) + (size_t)row * 384 + col;
                    } else if (TYPE == 1 || TYPE == 2) {
                        f32x4 cs = (f32x4){1.f, 1.f, 1.f, 1.f}, sn = (f32x4){0.f, 0.f, 0.f, 0.f}; float sc;
                        if (TYPE == 1) {
                            const int m2 = np - 768; const int isk = m2 >= 384, col = m2 - 384 * isk; const int w0 = col & 63;
                            if (!ctx) { cs = *(const f32x4*)(rope + (size_t)tt * 32 + (w0 >> 1)); sn = *(const f32x4*)(rope + (size_t)T * 32 + (size_t)tt * 32 + (w0 >> 1)); }
                            sc = isk ? 0.125f : 1.f;
                            dst = (bf16_t*)(ws + WS_SCAN + (size_t)(isk ? SC_RK : SC_RQ) * SCAN_PITCH) + (size_t)row * 384 + col;
                        } else {
                            const int m3 = np - 1536; const int isk = m3 >= 256, col = m3 - 256 * isk; const int map = col >> 5, w0 = col & 31;
                            if (!ctx) { const float* tb = (w0 < 16) ? (tab + TB_AXR + (tt >> 6) * 8 + (w0 >> 1)) : (tab + TB_AXC + (tt & 63) * 8 + ((w0 - 16) >> 1));
                                        const int so = (w0 < 16) ? 2048 : 512; cs = *(const f32x4*)tb; sn = *(const f32x4*)(tb + so); }
                            sc = isk ? 1.f : 0.17677669529663687f * LOG2E * 4.f;
                            if (isk) dst = (bf16_t*)(ws + WS_KA) + ((size_t)((bb * 8 + map) * KT_TILES + ktile) * 4 + (w0 >> 3)) * 512 + krr * 8;
                            else if (ctx) dst = (bf16_t*)(ws + WS_QC) + ((size_t)(bb * 8 + map) * CL + tt) * 32 + w0;
                            else dst = (bf16_t*)(ws + WS_QA) + ((size_t)(bb * 8 + map) * T + tt) * 32 + w0;
                        }
                        f32x4 o0, o1;
                        o0[0] = (v0[0] * cs[0] - v0[1] * sn[0]) * sc; o0[1] = (v0[1] * cs[0] + v0[0] * sn[0]) * sc;
                        o0[2] = (v0[2] * cs[1] - v0[3] * sn[1]) * sc; o0[3] = (v0[3] * cs[1] + v0[2] * sn[1]) * sc;
                        o1[0] = (v1[0] * cs[2] - v1[1] * sn[2]) * sc; o1[1] = (v1[1] * cs[2] + v1[0] * sn[2]) * sc;
                        o1[2] = (v1[2] * cs[3] - v1[3] * sn[3]) * sc; o1[3] = (v1[3] * cs[3] + v1[2] * sn[3]) * sc;
                        v0 = o0; v1 = o1;
                    } else {
                        const int m4 = np - 2048; const int seg = m4 / 384, col = m4 - 384 * seg;
                        if (m4 >= 2176) continue;
                        if (seg < 5) dst = (bf16_t*)(ws + WS_SCAN + (size_t)(SC_HQ + seg) * SCAN_PITCH) + (size_t)row * 384 + col;
                        else { const int h4 = col >> 6, w0 = col & 63;
                               const int k5 = krr & 31; unsigned char* vb = ws + WS_VA + (size_t)((bb * 4 + h4) * KT_TILES + ktile) * 4096 + (krr >> 5) * 2048 + (w0 >> 5) * 1024 + ((k5 >> 2) & 1) * 512 + (w0 & 31) * 16 + (k5 & 3) + 4 * (k5 >> 3);
                               const unsigned wa = pk4_fp8(v0[0] * 16.f, v0[1] * 16.f, v0[2] * 16.f, v0[3] * 16.f), wb = pk4_fp8(v1[0] * 16.f, v1[1] * 16.f, v1[2] * 16.f, v1[3] * 16.f);
#pragma unroll
                               for (int i = 0; i < 4; ++i) { vb[16 * i] = (unsigned char)(wa >> (8 * i)); vb[64 + 16 * i] = (unsigned char)(wb >> (8 * i)); }
                               continue; }
                    }
                    u32x4 w; w.x = cvt_pk_bf16(v0[0], v0[1]); w.y = cvt_pk_bf16(v0[2], v0[3]); w.z = cvt_pk_bf16(v1[0], v1[1]); w.w = cvt_pk_bf16(v1[2], v1[3]);
                    *(u32x4*)dst = w;
                }
                if (m == 3) asm volatile("" ::: "memory");
            }
    }
    __device__ __forceinline__ void operator()(const f32x4 (&acc)[2][2][4][2], const pg8::Unit& u, int wr, int wc, int fr, int fq) const {
        if (u.pn < 3) run<0>(acc, u, wr, wc, fr, fq); else if (u.pn < 6) run<1>(acc, u, wr, wc, fr, fq); else if (u.pn < 8) run<2>(acc, u, wr, wc, fr, fq); else run<3>(acc, u, wr, wc, fr, fq);
    }
};
struct EpiBf16Out {
    static constexpr bool PERM = true;
    bf16_t* C;
    __device__ __forceinline__ void operator()(const f32x4 (&acc)[2][2][4][2], const pg8::Unit& u, int wr, int wc, int fr, int fq) const {
        asm volatile("" : "+v"(fr), "+v"(fq));
        const int row0 = u.pm * 256 + wr * 64 + fr, col0 = u.pn * 256 + wc * 32 + 8 * fq;
#pragma unroll
        for (int ai = 0; ai < 2; ++ai)
#pragma unroll
            for (int m = 0; m < 4; ++m) { bf16_t* rowp = C + (size_t)(row0 + ai * 128 + m * 16) * D + col0;
#pragma unroll
                for (int bj = 0; bj < 2; ++bj) { const f32x4 v0 = acc[ai][bj][m][0], v1 = acc[ai][bj][m][1];
                    u32x4 w; w.x = cvt_pk_bf16(v0[0], v0[1]); w.y = cvt_pk_bf16(v0[2], v0[3]); w.z = cvt_pk_bf16(v1[0], v1[1]); w.w = cvt_pk_bf16(v1[2], v1[3]);
                    *(u32x4*)(rowp + bj * 128) = w; } }
    }
};
struct EpiSwiglu {
    static constexpr bool PERM = true;
    unsigned char* act; const float* b1;
    __device__ __forceinline__ void operator()(const f32x4 (&acc)[2][2][4][2], const pg8::Unit& u, int wr, int wc, int fr, int fq) const {
        asm volatile("" : "+v"(fr), "+v"(fq));
        const int j0 = 128 * u.pn + 32 * wc + 8 * fq;
        const float* bp = b1 + (size_t)u.e * 2048 + 2 * j0;
        f32x4 bq[4];
#pragma unroll
        for (int q = 0; q < 4; ++q) bq[q] = *(const f32x4*)(bp + 4 * q);
#pragma unroll
        for (int ai = 0; ai < 2; ++ai)
#pragma unroll
            for (int m = 0; m < 4; ++m) {
                const int rl = 128 * ai + 64 * wr + 16 * m + fr;
                float o[8];
#pragma unroll
                for (int n = 0; n < 2; ++n)
#pragma unroll
                    for (int q = 0; q < 4; ++q) { const int j = 4 * n + q;
                        float g = acc[ai][0][m][n][q] + bq[j >> 1][(j & 1) * 2], l = acc[ai][1][m][n][q] + bq[j >> 1][(j & 1) * 2 + 1];
                        g = fminf(g, 7.f); l = fminf(fmaxf(l, -7.f), 7.f);
                        o[j] = g * sigmoidf_(1.702f * g) * (l + 1.f); }
                u32x2 w; w.x = pk4_fp8(o[0], o[1], o[2], o[3]); w.y = pk4_fp8(o[4], o[5], o[6], o[7]);
                *(u32x2*)(act + (size_t)(u.pm * 256 + rl) * 1024 + j0) = w;
            }
    }
};
struct EpiMoeOut {
    static constexpr bool PERM = true;
    bf16_t* ys; const float* b2; const float* sgate;
    __device__ __forceinline__ void operator()(const f32x4 (&acc)[2][2][4][2], const pg8::Unit& u, int wr, int wc, int fr, int fq) const {
        asm volatile("" : "+v"(fr), "+v"(fq));
        const int c0 = 256 * u.pn + 32 * wc + 8 * fq;
        const float* bp = b2 + (size_t)u.e * 1024 + c0;
        f32x4 bv[2][2];
#pragma unroll
        for (int bj = 0; bj < 2; ++bj)
#pragma unroll
            for (int n = 0; n < 2; ++n) bv[bj][n] = *(const f32x4*)(bp + 128 * bj + 4 * n);
#pragma unroll
        for (int ai = 0; ai < 2; ++ai)
#pragma unroll
            for (int m = 0; m < 4; ++m) {
                const int rl = 128 * ai + 64 * wr + 16 * m + fr;
                const float g = (rl < u.nvalid) ? sgate[u.sbase + rl] : 0.f;
                bf16_t* rowp = ys + (size_t)(u.pm * 256 + rl) * 1024 + c0;
#pragma unroll
                for (int bj = 0; bj < 2; ++bj) { const f32x4 v0 = (acc[ai][bj][m][0] + bv[bj][0]) * g, v1 = (acc[ai][bj][m][1] + bv[bj][1]) * g;
                    u32x4 w; w.x = cvt_pk_bf16(v0[0], v0[1]); w.y = cvt_pk_bf16(v0[2], v0[3]); w.z = cvt_pk_bf16(v1[0], v1[1]); w.w = cvt_pk_bf16(v1[2], v1[3]);
                    *(u32x4*)(rowp + 128 * bj) = w; }
            }
    }
};

__device__ __forceinline__ int map_in(int n) {
    if (n < 384) return 2048 + n;
    if (n < 768) return n - 384;
    if (n < 1152) return 384 + (n - 768);
    if (n < 1536) return 2048 + 384 + (n - 1152);
    if (n < 1920) return 2048 + 768 + (n - 1536);
    if (n < 2688) { const int isk = n >= 2304; const int c = n - 1920 - 384 * isk; const int h = c >> 6, w = c & 63; const int wp = (w < 32) ? 2 * w : 2 * (w - 32) + 1; return 768 + 384 * isk + h * 64 + wp; }
    if (n < 3072) return 2048 + 1152 + (n - 2688);
    if (n < 3456) return 2048 + 1536 + (n - 3072);
    if (n < 3968) { const int isk = n >= 3712; const int c = n - 3456 - 256 * isk; const int h = c >> 5, w = c & 31; const int half = w >> 4, uu = w & 15; const int up = (uu < 8) ? 2 * uu : 2 * (uu - 8) + 1; return 1536 + 256 * isk + h * 32 + half * 16 + up; }
    return 2048 + 1920 + (n - 3968);
}
__device__ __forceinline__ int map_w1(int n) { const int j = n >> 1, lin = n & 1; return (j >> 7) * 256 + lin * 128 + (j & 127); }
template <int MAP> __device__ __forceinline__ void p0_transpose_item(const float* W, int Kd, int N, bf16_t* WT, LAS float* scr, int item, int lane) {
    const int nblk = N / 32, kb = item / nblk, nb = item % nblk, k0 = 64 * kb, n0 = 32 * nb;
    { f32x4 rv[8];
#pragma unroll
      for (int i = 0; i < 8; ++i) rv[i] = *(const f32x4*)(W + (size_t)(k0 + (lane >> 3) + 8 * i) * N + n0 + 4 * (lane & 7));
#pragma unroll
      for (int i = 0; i < 8; ++i) { LAS float* sp_ = scr + ((lane >> 3) + 8 * i) * 33 + 4 * (lane & 7); sp_[0] = rv[i][0]; sp_[1] = rv[i][1]; sp_[2] = rv[i][2]; sp_[3] = rv[i][3]; } }
    LDS_WAIT(); asm volatile("" ::: "memory");
    const int c = lane & 7;
#pragma unroll
    for (int j = 0; j < 4; ++j) { const int n = (lane >> 3) + 8 * j; const LAS float* s = scr + (8 * c) * 33 + n;
        u32x4 o; o.x = pk2(s[0 * 33], s[1 * 33]); o.y = pk2(s[2 * 33], s[3 * 33]); o.z = pk2(s[4 * 33], s[5 * 33]); o.w = pk2(s[6 * 33], s[7 * 33]);
        const int nn = n0 + n; const int dr = MAP == 1 ? map_in(nn) : (MAP == 2 ? map_w1(nn) : nn);
        *(u32x4*)(WT + (size_t)dr * Kd + k0 + 8 * c) = o; }
    LDS_WAIT(); asm volatile("" ::: "memory");
}
template <int MAP> __device__ __forceinline__ void p0_transpose_item_fp8(const float* W, int Kd, int N, unsigned char* WT, LAS float* scr, int item, int lane) {
    const int nblk = N / 32, kb = item / nblk, nb = item % nblk, k0 = 64 * kb, n0 = 32 * nb;
    { f32x4 rv[8];
#pragma unroll
      for (int i = 0; i < 8; ++i) rv[i] = *(const f32x4*)(W + (size_t)(k0 + (lane >> 3) + 8 * i) * N + n0 + 4 * (lane & 7));
#pragma unroll
      for (int i = 0; i < 8; ++i) { LAS float* sp_ = scr + ((lane >> 3) + 8 * i) * 33 + 4 * (lane & 7); sp_[0] = rv[i][0]; sp_[1] = rv[i][1]; sp_[2] = rv[i][2]; sp_[3] = rv[i][3]; } }
    LDS_WAIT(); asm volatile("" ::: "memory");
    const int n = lane >> 1, hf = lane & 1; const LAS float* sp = scr + (32 * hf) * 33 + n;
    u32x4 o0, o1;
#pragma unroll
    for (int q = 0; q < 4; ++q) { o0[q] = pk4_fp8(sp[(4 * q) * 33] * W8_MUL, sp[(4 * q + 1) * 33] * W8_MUL, sp[(4 * q + 2) * 33] * W8_MUL, sp[(4 * q + 3) * 33] * W8_MUL);
                                  o1[q] = pk4_fp8(sp[(16 + 4 * q) * 33] * W8_MUL, sp[(16 + 4 * q + 1) * 33] * W8_MUL, sp[(16 + 4 * q + 2) * 33] * W8_MUL, sp[(16 + 4 * q + 3) * 33] * W8_MUL); }
    const int nn = n0 + n; const int dr = MAP == 2 ? map_w1(nn) : nn;
    unsigned char* dp = WT + (size_t)dr * Kd + k0 + 32 * hf;
    *(u32x4*)dp = o0; *(u32x4*)(dp + 16) = o1;
    LDS_WAIT(); asm volatile("" ::: "memory");
}
__device__ __forceinline__ void phase_prologue_a(Frame& F) {
    PHASE_IDS();
    LAS float* scr = (LAS float*)(F.lds + wave * 16384);
    const int gw = blk_ * NWAVES + wave, NGW = F.G * NWAVES;
    unsigned char* ws = F.ws;
    constexpr int I_IN = 16 * 132, I_OUT = 16 * 32, I_W1 = 16 * 64, I_W2 = 16 * 32;
    constexpr int PER_L = I_IN + I_OUT + NE * (I_W1 + I_W2);
    for (int it = gw; it < 2 * PER_L; it += NGW) {
        const int l = it / PER_L; int r = it % PER_L;
        if (r < I_IN) { p0_transpose_item<1>(F.in[7] + (size_t)l * 1024 * 4224, 1024, 4224, (bf16_t*)(ws + WS_WIN) + (size_t)l * NIN * 1024, scr, r, lane); continue; } r -= I_IN;
        if (r < I_OUT) { p0_transpose_item<0>(F.in[14] + (size_t)l * 1024 * 1024, 1024, 1024, (bf16_t*)(ws + WS_WOUT) + (size_t)l * 1024 * 1024, scr, r, lane); continue; } r -= I_OUT;
        const int e = r / (I_W1 + I_W2); r -= e * (I_W1 + I_W2);
        if (r < I_W1) p0_transpose_item_fp8<2>(F.in[17] + ((size_t)l * NE + e) * 1024 * 2048, 1024, 2048, ws + WS_W1 + ((size_t)l * NE + e) * 2048 * 1024, scr, r, lane);
        else p0_transpose_item_fp8<0>(F.in[19] + ((size_t)l * NE + e) * 1024 * 1024, 1024, 1024, ws + WS_W2 + ((size_t)l * NE + e) * 1024 * 1024, scr, r - I_W1, lane);
    }
    for (int i = gw * 64 + lane; i < 2 * 128 * 1024 / 8; i += NGW * 64) { const int l = i / (128 * 128), rr = i % (128 * 128);
        *(u32x4*)((bf16_t*)(ws + WS_WIN) + ((size_t)l * NIN + 4224) * 1024 + (size_t)rr * 8) = (u32x4){0u, 0u, 0u, 0u}; }
    for (int it = gw; it < 2 * 96; it += NGW) {
        const int l = it / 96, n0 = (it % 96) * 64, n = n0 + lane;
        const float* mw = F.in[4] + (size_t)l * 1024 * 6144;
        float a0 = 0.f, a1 = 0.f, a2 = 0.f;
        for (int kb = 0; kb < 16; ++kb) {
            const int kk = kb * 64 + lane;
            float c0 = F.in[1][kk], c1 = F.in[1][1024 + kk], c2 = F.in[3][kk];
            c0 = c0 * sigmoidf_(c0); c1 = c1 * sigmoidf_(c1); c2 = c2 * sigmoidf_(c2);
#pragma unroll 8
            for (int j = 0; j < 64; ++j) { const float w = mw[(size_t)(kb * 64 + j) * 6144 + n]; a0 += rdlane(c0, j) * w; a1 += rdlane(c1, j) * w; a2 += rdlane(c2, j) * w; }
        }
        const float bias = F.in[5][l * 6144 + n];
        const int ch = n >> 10, col = n & 1023;
        const float* ng = F.in[6] + (size_t)l * 4096;
        float vals[3] = {a0 + bias, a1 + bias, a2 + bias};
#pragma unroll
        for (int w = 0; w < 3; ++w) { float v = vals[w];
            if (ch == 1) v = (1.f + v) * ng[col]; else if (ch == 2) v = v * ng[1024 + col]; else if (ch == 4) v = (1.f + v) * ng[2048 + col]; else if (ch == 5) v = v * ng[3072 + col];
            const int slot = (ch == 0) ? 1 : (ch == 1) ? 0 : (ch == 2) ? 2 : (ch == 3) ? 4 : (ch == 4) ? 3 : 5;
            ((float*)(ws + WS_MODV))[((size_t)(l * 3 + w) * 6 + slot) * 1024 + col] = v; }
    }
    float* tab = (float*)(ws + WS_TAB);
    const int gt = blk_ * NTHR + tid, NGT = F.G * NTHR;
    for (int i = gt; i < 2 * 384; i += NGT) { const int l = i / 384, c = i % 384; const float a = F.in[8][c], b = F.in[8][384 + c];
        tab[TB_LBT + i] = (l == 0) ? 0.f : 1.f / (1.f + expf(a - b)); }
    if (gt < 2) { const int l = gt; const float* lm = F.in[12] + l * 128; float s0 = 0.f, s1 = 0.f;
        for (int i = 0; i < 32; ++i) { s0 += lm[i] * lm[32 + i]; s1 += lm[64 + i] * lm[96 + i]; }
        const float li = 0.8f - 0.6f * expf(-0.3f * (float)l);
        tab[TB_LAM + l] = expf(s0) - expf(s1) + li; tab[TB_LAM + 2 + l] = 1.f - li; }
    if (gt < 24) tab[TB_GAM + gt] = 1.f - exp2f(-F.in[10][gt]);
    for (int i = gt; i < 256 * 8 + 64 * 8; i += NGT) {
        const bool isr = i < 2048; const int ii = isr ? i : i - 2048; const int pos = ii >> 3, j = ii & 7;
        const float inv = exp2f(-(float)j * (13.287712379549449f / 8.f));
        const double rev = (double)pos * (double)inv * 0.15915494309189535; const float fr = (float)(rev - floor(rev));
        const float cs = __builtin_amdgcn_cosf(fr), sn = __builtin_amdgcn_sinf(fr);
        if (isr) { tab[TB_AXR + ii] = cs; tab[TB_AXR + 2048 + ii] = sn; } else { tab[TB_AXC + ii] = cs; tab[TB_AXC + 512 + ii] = sn; }
    }
    float* rope = (float*)(ws + WS_ROPE);
    for (int i = gt; i < T * 32; i += NGT) { const int pos = i >> 5, j = i & 31;
        const float inv = exp2f(-(float)j * (13.287712379549449f / 32.f));
        const double rev = (double)pos * (double)inv * 0.15915494309189535; const float fr = (float)(rev - floor(rev));
        rope[i] = __builtin_amdgcn_cosf(fr); rope[(size_t)T * 32 + i] = __builtin_amdgcn_sinf(fr); }
    bf16_t* rwh = (bf16_t*)(ws + WS_RWT); bf16_t* rwl = rwh + 2 * 32 * 1024;
    for (int i = gt; i < 2 * 32 * 1024; i += NGT) { const int l = i >> 15, e = (i >> 10) & 31, c = i & 1023; const float wv = F.in[15][((size_t)l * 1024 + c) * 32 + e];
        const unsigned hb = f2bf(wv); rwh[i] = (bf16_t)hb; rwl[i] = (bf16_t)f2bf(wv - __builtin_bit_cast(float, hb << 16)); }
}

__device__ __forceinline__ float row_sumsq(const f32x4 (&v)[4]) {
    float s = 0.f;
#pragma unroll
    for (int j = 0; j < 4; ++j) s += (v[j][0] * v[j][0] + v[j][1] * v[j][1]) + (v[j][2] * v[j][2] + v[j][3] * v[j][3]);
    return wave_sum(s);
}
__device__ __forceinline__ void row_load(const float* p, int lane, f32x4 (&v)[4]) {
#pragma unroll
    for (int j = 0; j < 4; ++j) v[j] = *(const f32x4*)(p + 4 * lane + 256 * j);
}
__device__ __forceinline__ void row_store(float* p, int lane, const f32x4 (&v)[4]) {
#pragma unroll
    for (int j = 0; j < 4; ++j) *(f32x4*)(p + 4 * lane + 256 * j) = v[j];
}
__device__ __forceinline__ void row_store_bf16(bf16_t* p, int lane, const f32x4 (&v)[4]) {
#pragma unroll
    for (int j = 0; j < 4; ++j) { u32x2 w; w.x = pk2(v[j][0], v[j][1]); w.y = pk2(v[j][2], v[j][3]); *(u32x2*)(p + 4 * lane + 256 * j) = w; }
}
__device__ __forceinline__ int row_which(int r) { return r < NLAT ? (r >> 14) : 2; }
__device__ __forceinline__ void row_norm_mod(const f32x4 (&x)[4], const float* a, const float* b, int lane, f32x4 (&o)[4]) {
    const float r = __builtin_amdgcn_rsqf(row_sumsq(x) * (1.f / 1024.f) + EPS);
#pragma unroll
    for (int j = 0; j < 4; ++j) { const f32x4 av = *(const f32x4*)(a + 4 * lane + 256 * j), bv = *(const f32x4*)(b + 4 * lane + 256 * j); o[j] = x[j] * r * av + bv; }
}
__device__ __forceinline__ void phase_prologue_b(Frame& F) {
    PHASE_IDS();
    const int gw = blk_ * NWAVES + wave, NGW = F.G * NWAVES;
    const float* modv = (const float*)(F.ws + WS_MODV);
    for (int r = gw; r < NROW; r += NGW) {
        const float* src = r < NLAT ? F.in[0] + (size_t)r * D : F.in[2] + (size_t)(r - NLAT) * D;
        const int w = row_which(r);
        f32x4 x[4], o[4]; row_load(src, lane, x);
        row_norm_mod(x, modv + (size_t)(0 * 3 + w) * 6 * 1024, modv + ((size_t)(0 * 3 + w) * 6 + 1) * 1024, lane, o);
        row_store_bf16((bf16_t*)(F.ws + WS_H) + (size_t)r * D, lane, o);
    }
}

__device__ __forceinline__ int scan_row(int sc, int p, int dir, int b) {
    if (sc == 0) return NLAT + b * CL + (dir ? (CL - 1 - p) : p);
    const int tt = (sc - 1) * 256 + p; return b * T + (dir ? (T - 1 - tt) : tt);
}
template <int TYPE, bool WITHQ>
__device__ __forceinline__ float scan_step(float (&S)[64], const LAS float* kq, float vv, float gam) {
    float o = 0.f;
#pragma unroll
    for (int kg = 0; kg < 8; ++kg) {
        f32x4 kv[2], qv[2];
#pragma unroll
        for (int j = 0; j < 2; ++j) { kv[j] = *(const LAS f32x4*)(kq + kg * 8 + 4 * j); if (WITHQ) qv[j] = *(const LAS f32x4*)(kq + 64 + kg * 8 + 4 * j); }
#pragma unroll
        for (int j = 0; j < 8; ++j) { const int k = kg * 8 + j; const float kk = kv[j >> 2][j & 3];
            if (TYPE == 0) S[k] = __builtin_fmaf(kk, vv - S[k], S[k]); else S[k] = __builtin_fmaf(kk, vv, gam * S[k]);
            if (WITHQ) o = __builtin_fmaf(qv[j >> 2][j & 3], S[k], o); }
        asm volatile("" ::: "memory"); __builtin_amdgcn_sched_barrier(0);
    }
    return o;
}
__device__ __forceinline__ void phase_scan_a(Frame& F, int layer) {
    PHASE_IDS();
    const int gw = blk_ * NWAVES + wave, NGW = F.G * NWAVES;
    const float* tab = (const float*)(F.ws + WS_TAB);
    LAS float* scr = (LAS float*)(F.lds + wave * 2048);
    for (int wu = gw; wu < NSEQ * NSC; wu += NGW) {
        const int s = wu / NSC, sc = wu % NSC; const int type = s / 24, rem = s % 24, b = rem / 12, h = (rem % 12) >> 1, dir = rem & 1;
        const bf16_t* Kb = (const bf16_t*)(F.ws + WS_SCAN + (size_t)(type ? SC_RK : (dir ? SC_KB : SC_KF)) * SCAN_PITCH);
        const bf16_t* Vb = (const bf16_t*)(F.ws + WS_SCAN + (size_t)(type ? SC_RV : SC_HV) * SCAN_PITCH);
        unsigned co = (unsigned)(h * 64 + lane); asm volatile("" : "+v"(co));
        const float gam = tab[TB_GAM + layer * 12 + dir * 6 + h];
        float S[64];
#pragma unroll
        for (int k = 0; k < 64; ++k) S[k] = 0.f;
        float dprod = 1.f;
        float kc[4], vc[4], kn[4], vn[4];
#pragma unroll
        for (int i = 0; i < 4; ++i) { const unsigned ro = (unsigned)scan_row(sc, i, dir, b) * 384u + co; kc[i] = bf2f(Kb[ro]); vc[i] = bf2f(Vb[ro]); kn[i] = 0.f; vn[i] = 0.f; }
        for (int p0 = 0; p0 < 256; p0 += 4) {
            if (p0 + 4 < 256) {
#pragma unroll
                for (int i = 0; i < 4; ++i) { const unsigned ro = (unsigned)scan_row(sc, p0 + 4 + i, dir, b) * 384u + co; kn[i] = bf2f(Kb[ro]); vn[i] = bf2f(Vb[ro]); }
            }
#pragma unroll
            for (int i = 0; i < 4; ++i) scr[i * 128 + lane] = kc[i];
#pragma unroll
            for (int i = 0; i < 4; ++i) {
                if (type == 0) { dprod *= (1.f - kc[i]); (void)scan_step<0, false>(S, scr + i * 128, vc[i], gam); }
                else { dprod *= gam; (void)scan_step<1, false>(S, scr + i * 128, vc[i], gam); }
            }
#pragma unroll
            for (int i = 0; i < 4; ++i) { kc[i] = kn[i]; vc[i] = vn[i]; }
        }
        float* sl = (float*)(F.ws + WS_SLOC) + (size_t)wu * 4096 + lane;
#pragma unroll
        for (int k = 0; k < 64; ++k) { *sl = S[k]; sl += 64; asm volatile("" : "+v"(sl)); }
        ((float*)(F.ws + WS_DEC))[(size_t)wu * 64 + lane] = dprod;
    }
}
__device__ __forceinline__ void phase_scan_b(Frame& F) {
    const float* sloc = (const float*)(F.ws + WS_SLOC); const float* dec = (const float*)(F.ws + WS_DEC); float* sin_ = (float*)(F.ws + WS_SIN);
    PHASE_IDS();
    for (int idx = blk_ * NTHR + tid; idx < NSEQ * 4096; idx += F.G * NTHR) {
        const int s = idx >> 12, kv = idx & 4095, k = kv >> 6; float st = 0.f;
#pragma unroll 8
        for (int sc = 0; sc < NSC - 1; ++sc) { const size_t u = (size_t)s * NSC + sc; st = dec[u * 64 + k] * st + sloc[u * 4096 + kv]; sin_[(u + 1) * 4096 + kv] = st; }
    }
}
template <int TYPE, bool SECOND>
__device__ __forceinline__ void scan_dir(Frame& F, int lane_in, int wave, int layer, int b, int h, int dir, int sc, bool zero_state) {
    int lane = lane_in; asm volatile("" : "+v"(lane));
    const float* tab = (const float*)(F.ws + WS_TAB);
    const int s = TYPE * 24 + b * 12 + h * 2 + dir;
    const bf16_t* Kb = (const bf16_t*)(F.ws + WS_SCAN + (size_t)(TYPE ? SC_RK : (dir ? SC_KB : SC_KF)) * SCAN_PITCH);
    const bf16_t* Vb = (const bf16_t*)(F.ws + WS_SCAN + (size_t)(TYPE ? SC_RV : SC_HV) * SCAN_PITCH);
    const bf16_t* Qb = (const bf16_t*)(F.ws + WS_SCAN + (size_t)(TYPE ? SC_RQ : SC_HQ) * SCAN_PITCH);
    const bf16_t* Gb = (const bf16_t*)(F.ws + WS_SCAN + (size_t)(TYPE ? SC_RG : SC_HG) * SCAN_PITCH);
    float* oscr = (float*)(F.ws + WS_OSCR);
    bf16_t* mix = (bf16_t*)(F.ws + WS_MIX);
    unsigned co = (unsigned)(h * 64 + lane); asm volatile("" : "+v"(co));
    const unsigned co2 = co + TYPE * 384;
    const float gam = tab[TB_GAM + layer * 12 + dir * 6 + h];
    const float nw = F.in[TYPE ? 11 : 9][layer * 64 + lane];
    LAS float* scr = (LAS float*)(F.lds + wave * 2048);
    float S[64];
    if (zero_state) {
#pragma unroll
        for (int k = 0; k < 64; ++k) S[k] = 0.f;
    } else { const float* si = (const float*)(F.ws + WS_SIN) + ((size_t)s * NSC + sc) * 4096 + lane;
#pragma unroll
        for (int k = 0; k < 64; ++k) { S[k] = *si; si += 64; asm volatile("" : "+v"(si)); } }
    float kc[2], vc[2], qc[2], kn[2], vn[2], qn[2];
#pragma unroll
    for (int i = 0; i < 2; ++i) { const unsigned ro = (unsigned)scan_row(sc, i, dir, b) * 384u + co; kc[i] = bf2f(Kb[ro]); vc[i] = bf2f(Vb[ro]); qc[i] = bf2f(Qb[ro]); kn[i] = 0.f; vn[i] = 0.f; qn[i] = 0.f; }
    for (int p0 = 0; p0 < 256; p0 += 2) {
        if (p0 + 2 < 256) {
#pragma unroll
            for (int i = 0; i < 2; ++i) { const unsigned ro = (unsigned)scan_row(sc, p0 + 2 + i, dir, b) * 384u + co; kn[i] = bf2f(Kb[ro]); vn[i] = bf2f(Vb[ro]); qn[i] = bf2f(Qb[ro]); }
        }
#pragma unroll
        for (int i = 0; i < 2; ++i) { scr[i * 128 + lane] = kc[i]; scr[i * 128 + 64 + lane] = qc[i]; }
#pragma unroll
        for (int i = 0; i < 2; ++i) {
            float o = scan_step<TYPE, true>(S, scr + i * 128, vc[i], gam);
            const unsigned row = (unsigned)scan_row(sc, p0 + i, dir, b);
            if (!SECOND) oscr[row * 768u + co2] = o;
            else { o += oscr[row * 768u + co2];
                const float r = __builtin_amdgcn_rsqf(wave_sum_dpp(o * o) * (1.f / 64.f) + EPS);
                const float g = bf2f(Gb[row * 384u + co]);
                mix[row * 1024u + co2] = (bf16_t)f2bf(o * r * nw * g * sigmoidf_(g)); }
            asm volatile("" ::: "memory");
        }
#pragma unroll
        for (int i = 0; i < 2; ++i) { kc[i] = kn[i]; vc[i] = vn[i]; qc[i] = qn[i]; }
    }
}
__device__ __forceinline__ void phase_scan_c(Frame& F, int layer) {
    PHASE_IDS();
    const int gw = blk_ * NWAVES + wave, NGW = F.G * NWAVES;
    const bool need_ctx = layer == 0;
    for (int wu = gw; wu < 24 * NSC; wu += NGW) {
        const int sq = wu / NSC, blk = wu % NSC; const int type = sq / 12, b = (sq % 12) / 6, h = sq % 6;
        if (blk == 0 && !need_ctx) continue;
        const int scf = blk, scb = (blk == 0) ? 0 : 65 - blk;
        if (type == 0) { scan_dir<0, false>(F, lane, wave, layer, b, h, 0, scf, scf == 0); scan_dir<0, true>(F, lane, wave, layer, b, h, 1, scb, scb == 0); }
        else           { scan_dir<1, false>(F, lane, wave, layer, b, h, 0, scf, scf == 0); scan_dir<1, true>(F, lane, wave, layer, b, h, 1, scb, scb == 0); }
    }
}


namespace sc2 {
constexpr int WLDS = 8448;
__device__ __forceinline__ f32x4 mfma16(bf16x8 a, bf16x8 b, f32x4 c) { return __builtin_amdgcn_mfma_f32_16x16x32_bf16(a, b, c, 0, 0, 0); }
template <int TYPE, int MODE>
__device__ __forceinline__ void run(Frame& F, int lane_in, int wave, int layer, int b, int h, int dir, int sc, bool zero_state, int wu_out) {
    int lane = lane_in; asm volatile("" : "+v"(lane));
    const int g = lane >> 4, n = lane & 15;
    const float* tab = (const float*)(F.ws + WS_TAB);
    const int s = TYPE * 24 + b * 12 + h * 2 + dir;
    const bf16_t* Kb = (const bf16_t*)(F.ws + WS_SCAN + (size_t)(TYPE ? SC_RK : (dir ? SC_KB : SC_KF)) * SCAN_PITCH);
    const bf16_t* Vb = (const bf16_t*)(F.ws + WS_SCAN + (size_t)(TYPE ? SC_RV : SC_HV) * SCAN_PITCH);
    const bf16_t* Qb = (const bf16_t*)(F.ws + WS_SCAN + (size_t)(TYPE ? SC_RQ : SC_HQ) * SCAN_PITCH);
    const bf16_t* Gb = (const bf16_t*)(F.ws + WS_SCAN + (size_t)(TYPE ? SC_RG : SC_HG) * SCAN_PITCH);
    float* oscr = (float*)(F.ws + WS_OSCR);
    bf16_t* mix = (bf16_t*)(F.ws + WS_MIX);
    const unsigned co = (unsigned)(h * 64 + lane);
    const float lg2 = TYPE ? __builtin_amdgcn_logf(tab[TB_GAM + layer * 12 + dir * 6 + h]) : 0.f;
    LAS unsigned char* wl = F.lds + wave * WLDS;
    LAS bf16_t* QT = (LAS bf16_t*)wl; LAS bf16_t* KT = (LAS bf16_t*)(wl + 2048); LAS bf16_t* KPT = (LAS bf16_t*)(wl + 4096); LAS bf16_t* VT = (LAS bf16_t*)(wl + 6144); LAS float* DD = (LAS float*)(wl + 8192);
    f32x4 S[4][4];
    if (zero_state) {
#pragma unroll
        for (int kb = 0; kb < 4; ++kb)
#pragma unroll
            for (int vb = 0; vb < 4; ++vb) S[kb][vb] = (f32x4){0.f, 0.f, 0.f, 0.f};
    } else { const float* si = (const float*)(F.ws + WS_SIN) + ((size_t)s * NSC + sc) * 4096;
#pragma unroll
        for (int kb = 0; kb < 4; ++kb)
#pragma unroll
            for (int vb = 0; vb < 4; ++vb)
#pragma unroll
                for (int r = 0; r < 4; ++r) S[kb][vb][r] = si[(16 * kb + 4 * g + r) * 64 + 16 * vb + n]; }
    float dtot = 1.f;
    const float gam = TYPE ? tab[TB_GAM + layer * 12 + dir * 6 + h] : 0.f;
    unsigned short kr[16], vr[16], qr[16];
#pragma unroll
    for (int t = 0; t < 16; ++t) { const unsigned ro = (unsigned)scan_row(sc, t, dir, b) * 384u + co; kr[t] = Kb[ro]; vr[t] = Vb[ro]; if (MODE != 0) qr[t] = Qb[ro]; else qr[t] = 0; }
    for (int blk = 0; blk < 16; ++blk) {
        const unsigned row = (unsigned)scan_row(sc, 16 * blk + n, dir, b);
        const unsigned ob = row * 768u + (unsigned)(TYPE * 384 + h * 64 + 4 * g);
        f32x4 of[4]; u32x2 gg[4];
        if (MODE == 2) {
#pragma unroll
            for (int vb = 0; vb < 4; ++vb) { of[vb] = *(const f32x4*)(oscr + ob + 16 * vb); gg[vb] = *(const u32x2*)(Gb + row * 384u + (unsigned)(h * 64 + 16 * vb + 4 * g)); }
        }
        float ek[16]; float eq = 1.f;
#pragma unroll
        for (int t = 0; t < 16; ++t) { const float kk = bf2f(kr[t]);
            eq = fmaxf(eq * (TYPE == 0 ? 1.f - kk : gam), 7.9e-31f);
            ek[t] = __builtin_amdgcn_rcpf(eq);
            if (MODE != 0) { QT[t * 64 + lane] = (bf16_t)f2bf(bf2f(qr[t]) * eq); KT[t * 64 + lane] = (bf16_t)f2bf(kk * ek[t]); } }
        dtot *= eq; DD[lane] = eq;
        { u32x4 w0, w1, x0, x1;
#pragma unroll
          for (int q = 0; q < 4; ++q) {
              w0[q] = cvt_pk_bf16(bf2f(kr[2 * q]) * (eq * ek[2 * q]), bf2f(kr[2 * q + 1]) * (eq * ek[2 * q + 1]));
              w1[q] = cvt_pk_bf16(bf2f(kr[8 + 2 * q]) * (eq * ek[8 + 2 * q]), bf2f(kr[8 + 2 * q + 1]) * (eq * ek[8 + 2 * q + 1]));
              x0[q] = (unsigned)vr[2 * q] | ((unsigned)vr[2 * q + 1] << 16); x1[q] = (unsigned)vr[8 + 2 * q] | ((unsigned)vr[8 + 2 * q + 1] << 16); }
          *(LAS u32x4*)(KPT + lane * 16) = w0; *(LAS u32x4*)(KPT + lane * 16 + 8) = w1; *(LAS u32x4*)(VT + lane * 16) = x0; *(LAS u32x4*)(VT + lane * 16 + 8) = x1; }
        if (blk + 1 < 16) {
#pragma unroll
            for (int t = 0; t < 16; ++t) { const unsigned ro = (unsigned)scan_row(sc, 16 * (blk + 1) + t, dir, b) * 384u + co; kr[t] = Kb[ro]; vr[t] = Vb[ro]; if (MODE != 0) qr[t] = Qb[ro]; }
        }
        asm volatile("s_waitcnt lgkmcnt(0)" ::: "memory");
        if (MODE != 0) {
            f32x4 sct = (f32x4){0.f, 0.f, 0.f, 0.f};
#pragma unroll
            for (int ks = 0; ks < 2; ++ks) { const bf16x8 a = *(const LAS bf16x8*)(KT + n * 64 + 32 * ks + 8 * g), bq = *(const LAS bf16x8*)(QT + n * 64 + 32 * ks + 8 * g); sct = mfma16(a, bq, sct); }
#pragma unroll
            for (int r = 0; r < 4; ++r) sct[r] = (4 * g + r <= n) ? sct[r] : 0.f;
            u32x4 bs; bs.x = cvt_pk_bf16(sct[0], sct[1]); bs.y = cvt_pk_bf16(sct[2], sct[3]); bs.z = 0u; bs.w = 0u;
            f32x4 o[4];
#pragma unroll
            for (int vb = 0; vb < 4; ++vb) { const u32x2 lo = *(const LAS u32x2*)(VT + (16 * vb + n) * 16 + 4 * g); u32x4 av; av.x = lo.x; av.y = lo.y; av.z = 0u; av.w = 0u;
                o[vb] = mfma16(__builtin_bit_cast(bf16x8, av), __builtin_bit_cast(bf16x8, bs), (f32x4){0.f, 0.f, 0.f, 0.f}); }
#pragma unroll
            for (int ks = 0; ks < 2; ++ks) {
                const u32x2 q0 = *(const LAS u32x2*)(QT + n * 64 + 32 * ks + 4 * g), q1 = *(const LAS u32x2*)(QT + n * 64 + 32 * ks + 16 + 4 * g);
                u32x4 bq; bq.x = q0.x; bq.y = q0.y; bq.z = q1.x; bq.w = q1.y;
#pragma unroll
                for (int vb = 0; vb < 4; ++vb) { u32x4 av; av.x = cvt_pk_bf16(S[2 * ks][vb][0], S[2 * ks][vb][1]); av.y = cvt_pk_bf16(S[2 * ks][vb][2], S[2 * ks][vb][3]);
                    av.z = cvt_pk_bf16(S[2 * ks + 1][vb][0], S[2 * ks + 1][vb][1]); av.w = cvt_pk_bf16(S[2 * ks + 1][vb][2], S[2 * ks + 1][vb][3]);
                    o[vb] = mfma16(__builtin_bit_cast(bf16x8, av), __builtin_bit_cast(bf16x8, bq), o[vb]); }
            }
            if (MODE == 1) {
#pragma unroll
                for (int vb = 0; vb < 4; ++vb) *(f32x4*)(oscr + ob + 16 * vb) = o[vb];
            } else {
                float ss = 0.f;
#pragma unroll
                for (int vb = 0; vb < 4; ++vb) { o[vb] = o[vb] + of[vb]; ss += (o[vb][0] * o[vb][0] + o[vb][1] * o[vb][1]) + (o[vb][2] * o[vb][2] + o[vb][3] * o[vb][3]); }
                ss += xor_swz<16>(ss); ss += xor32(ss, lane);
                const float rn = __builtin_amdgcn_rsqf(ss * (1.f / 64.f) + EPS);
                const float* nw = F.in[TYPE ? 11 : 9] + layer * 64 + 4 * g;
#pragma unroll
                for (int vb = 0; vb < 4; ++vb) { const f32x4 w4 = *(const f32x4*)(nw + 16 * vb);
                    const float g0 = bflo(gg[vb].x), g1 = bfhi(gg[vb].x), g2 = bflo(gg[vb].y), g3 = bfhi(gg[vb].y);
                    u32x2 w; w.x = cvt_pk_bf16(o[vb][0] * rn * w4[0] * g0 * sigmoidf_(g0), o[vb][1] * rn * w4[1] * g1 * sigmoidf_(g1)); w.y = cvt_pk_bf16(o[vb][2] * rn * w4[2] * g2 * sigmoidf_(g2), o[vb][3] * rn * w4[3] * g3 * sigmoidf_(g3));
                    *(u32x2*)(mix + row * 1024u + (unsigned)(TYPE * 384 + h * 64 + 16 * vb + 4 * g)) = w; }
            }
        }
#pragma unroll
        for (int kb = 0; kb < 4; ++kb) { const f32x4 d4 = *(const LAS f32x4*)(DD + 16 * kb + 4 * g);
#pragma unroll
            for (int vb = 0; vb < 4; ++vb) S[kb][vb] = S[kb][vb] * d4; }
        { bf16x8 af[4], bfv[4];
#pragma unroll
          for (int q = 0; q < 4; ++q) { u32x4 a = *(const LAS u32x4*)(KPT + (16 * q + n) * 16 + 8 * (g & 1)), bq = *(const LAS u32x4*)(VT + (16 * q + n) * 16 + 8 * (g & 1));
              if (g >= 2) { a = (u32x4){0u, 0u, 0u, 0u}; bq = (u32x4){0u, 0u, 0u, 0u}; }
              af[q] = __builtin_bit_cast(bf16x8, a); bfv[q] = __builtin_bit_cast(bf16x8, bq); }
#pragma unroll
          for (int kb = 0; kb < 4; ++kb)
#pragma unroll
              for (int vb = 0; vb < 4; ++vb) S[kb][vb] = mfma16(af[kb], bfv[vb], S[kb][vb]); }
        asm volatile("s_waitcnt lgkmcnt(0)" ::: "memory");
    }
    if (MODE == 0) {
        float* sl = (float*)(F.ws + WS_SLOC) + (size_t)wu_out * 4096;
#pragma unroll
        for (int kb = 0; kb < 4; ++kb)
#pragma unroll
            for (int vb = 0; vb < 4; ++vb)
#pragma unroll
                for (int r = 0; r < 4; ++r) sl[(16 * kb + 4 * g + r) * 64 + 16 * vb + n] = S[kb][vb][r];
        ((float*)(F.ws + WS_DEC))[(size_t)wu_out * 64 + lane] = dtot;
    }
}
}
__device__ __forceinline__ void phase_scan2_a(Frame& F, int layer) {
    PHASE_IDS();
    const int gw = blk_ * NWAVES + wave, NGW = F.G * NWAVES;
    for (int wu = gw; wu < NSEQ * NSC; wu += NGW) {
        const int s = wu / NSC, sc = wu % NSC; const int type = s / 24, rem = s % 24, b = rem / 12, h = (rem % 12) >> 1, dir = rem & 1;
        if (type == 0) sc2::run<0, 0>(F, lane, wave, layer, b, h, dir, sc, true, wu); else sc2::run<1, 0>(F, lane, wave, layer, b, h, dir, sc, true, wu);
    }
}
__device__ __forceinline__ void phase_scan2_c(Frame& F, int layer) {
    PHASE_IDS();
    const int gw = blk_ * NWAVES + wave, NGW = F.G * NWAVES;
    const bool need_ctx = layer == 0;
    for (int wu = gw; wu < 24 * NSC; wu += NGW) {
        const int sq = wu / NSC, blk = wu % NSC; const int type = sq / 12, b = (sq % 12) / 6, h = sq % 6;
        if (blk == 0 && !need_ctx) continue;
        const int scf = blk, scb = (blk == 0) ? 0 : 65 - blk;
        if (type == 0) { sc2::run<0, 1>(F, lane, wave, layer, b, h, 0, scf, scf == 0, 0); sc2::run<0, 2>(F, lane, wave, layer, b, h, 1, scb, scb == 0, 0); }
        else           { sc2::run<1, 1>(F, lane, wave, layer, b, h, 0, scf, scf == 0, 0); sc2::run<1, 2>(F, lane, wave, layer, b, h, 1, scb, scb == 0, 0); }
    }
}

namespace att {
constexpr int SLOT = 32768, NS = 3, WSF_OFF = NS * SLOT, OST_OFF = 0, OST_W = 32 * 68 * 4;
__device__ __forceinline__ int crow(int r, int hi) { return (r & 3) + 8 * (r >> 2) + 4 * hi; }
typedef short v4i16_t __attribute__((ext_vector_type(4)));
typedef LAS const char* lds_cptr;
__device__ __forceinline__ s16x4 vtr(lds_cptr p) { return __builtin_bit_cast(s16x4, __builtin_amdgcn_ds_read_tr16_b64_v4i16((LAS v4i16_t*)p)); }
__device__ __forceinline__ float max3f(float a, float b, float c) { return __builtin_fmaxf(__builtin_fmaxf(a, b), c); }
__device__ __forceinline__ float hmax32(const f32x16& p0, const f32x16& p1) {
    float a = max3f(p0[0], p0[1], p1[0]), b = max3f(p0[2], p0[3], p1[1]); a = max3f(a, p1[2], p1[3]);
#pragma unroll
    for (int r = 4; r < 16; r += 4) { a = max3f(a, p0[r], p0[r + 1]); b = max3f(b, p0[r + 2], p0[r + 3]); a = max3f(a, p1[r], p1[r + 1]); b = max3f(b, p1[r + 2], p1[r + 3]); }
    const float m = __builtin_fmaxf(a, b);
    auto rr = __builtin_amdgcn_permlane32_swap(__builtin_bit_cast(unsigned, m), __builtin_bit_cast(unsigned, m), false, false);
    return __builtin_fmaxf(__builtin_bit_cast(float, rr[0]), __builtin_bit_cast(float, rr[1]));
}
#define ATT_WAIT_BAR(N) asm volatile("s_waitcnt vmcnt(" #N ") lgkmcnt(0)\n\ts_barrier" ::: "memory")
template<int VAR>
__device__ __forceinline__ void attn_unit(Frame& F, int lane_in, int wid, int layer, int b, int h, bool isctx, int qb) {
    int lane = lane_in; asm volatile("" : "+v"(lane));
    const int r32 = lane & 31, hi = lane >> 5;
    LAS unsigned char* lds = F.lds; const unsigned lds0 = (unsigned)(uintptr_t)lds;
    const float* tab = (const float*)(F.ws + WS_TAB);
    const int qrow = qb * 256 + wid * 32 + r32;
    bf16x8 qr[2][2];
#pragma unroll
    for (int m = 0; m < 2; ++m) { const int mp = b * 8 + 2 * h + m;
        const bf16_t* qp = isctx ? (const bf16_t*)(F.ws + WS_QC) + ((size_t)mp * CL + qrow) * 32 : (const bf16_t*)(F.ws + WS_QA) + ((size_t)mp * T + qrow) * 32;
#pragma unroll
        for (int d0 = 0; d0 < 2; ++d0) qr[m][d0] = *(const bf16x8*)(qp + d0 * 16 + hi * 8); }
    const int NTL = isctx ? 2 : KT_TILES / 2;
    const bf16_t* ksrc = (const bf16_t*)(F.ws + WS_KA) + (size_t)((b * 8 + 2 * h + (wid >> 2)) * KT_TILES) * 2048 + (wid & 3) * 512;
    const unsigned char* vsrc = F.ws + WS_VA + (size_t)((b * 4 + h) * KT_TILES) * 4096 + (wid >> 2) * 4096 + (wid & 3) * 1024;
    const unsigned dma_off = (unsigned)lane * 16u;
#define ATT_DMA(t, slot) do { _Pragma("unroll") for (int sb_ = 0; sb_ < 2; ++sb_) \
                              ::glds16(ksrc + (size_t)(2 * (t) + sb_) * 2048, dma_off, (unsigned)__builtin_amdgcn_readfirstlane(lds0 + (slot) * SLOT + sb_ * 16384 + wid * 1024)); \
                              ::glds16(vsrc + (size_t)(t) * 8192, dma_off, (unsigned)__builtin_amdgcn_readfirstlane(lds0 + (slot) * SLOT + (wid >> 2) * 16384 + 8192 + (wid & 3) * 1024)); } while (0)
    LAS float* wsf = (LAS float*)(lds + WSF_OFF) + wid * 128;
    LAS float* ost = (LAS float*)(lds + OST_OFF + wid * OST_W);
    f32x16 o[2][2];
#pragma unroll
    for (int m = 0; m < 2; ++m)
#pragma unroll
        for (int d = 0; d < 2; ++d) o[m][d] = f32x16{};
    constexpr float POFS = 60.5f, PTHR = 32.f;
    float mhat = 0.f;
    f32x16 lacc[2]; lacc[0] = f32x16{}; lacc[1] = f32x16{};
    v8i ones8; { int o8 = 0x38383838; asm volatile("" : "+v"(o8)); ones8 = (v8i){o8, o8, o8, o8, o8, o8, o8, o8}; asm volatile("" : "+v"(ones8)); }
    f32x16 negm; { float z_ = POFS; asm volatile("" : "+v"(z_));
#pragma unroll
      for (int r = 0; r < 16; ++r) negm[r] = z_; }
    ATT_DMA(0, 0); ATT_DMA(1, 1);
    asm volatile("" : "+v"(qr[0][0]), "+v"(qr[0][1]), "+v"(qr[1][0]), "+v"(qr[1][1]));
    int slot = 0;
    for (int t = 0; t < NTL; ++t) {
        if (t + 1 < NTL) { ATT_WAIT_BAR(3); } else { ATT_WAIT_BAR(0); }
        if (t + 2 < NTL) { const int s2 = slot >= 1 ? slot - 1 : 2; ATT_DMA(t + 2, s2); }
#pragma unroll
        for (int sub = 0; sub < 2; ++sub) {
        const lds_cptr base = (lds_cptr)lds + slot * SLOT + sub * 16384;
        f32x16 p[2][2];
#pragma unroll
        for (int m = 0; m < 2; ++m) {
            const lds_cptr kb = base + m * 4096 + hi * 1024 + r32 * 16;
            const bf16x8 k00 = VAR == 4 ? qr[m][0] : *(const LAS bf16x8*)(kb), k01 = VAR == 4 ? qr[m][1] : *(const LAS bf16x8*)(kb + 512), k10 = VAR == 4 ? qr[1 - m][0] : *(const LAS bf16x8*)(kb + 2048), k11 = VAR == 4 ? qr[1 - m][1] : *(const LAS bf16x8*)(kb + 2048 + 512);
            p[m][0] = __builtin_amdgcn_mfma_f32_32x32x16_bf16(k00, qr[m][0], negm, 0, 0, 0);
            p[m][1] = __builtin_amdgcn_mfma_f32_32x32x16_bf16(k01, qr[m][0], negm, 0, 0, 0);
            p[m][0] = __builtin_amdgcn_mfma_f32_32x32x16_bf16(k10, qr[m][1], p[m][0], 0, 0, 0);
            p[m][1] = __builtin_amdgcn_mfma_f32_32x32x16_bf16(k11, qr[m][1], p[m][1], 0, 0, 0);
        }
        v8i vf[2];
        if (sub == 0 && (t & 1) == 0) {
          const float rm = __builtin_fmaxf(hmax32(p[0][0], p[0][1]), hmax32(p[1][0], p[1][1])) - POFS;
          const bool first = (t == 0);
          if (first || __any(rm > PTHR)) {
              const float dl = first ? rm : fmaxf(rm, 0.f);
              mhat += dl;
#pragma unroll
              for (int r = 0; r < 16; ++r) { p[0][0][r] -= dl; p[0][1][r] -= dl; p[1][0][r] -= dl; p[1][1][r] -= dl; negm[r] = POFS - mhat; }
              asm volatile("" : "+v"(negm));
              if (!first) {
                  const float f = __builtin_amdgcn_exp2f(-0.25f * dl);
                  if (hi == 0) wsf[r32] = f;
                  LDS_WAIT();
#pragma unroll
                  for (int r = 0; r < 16; ++r) { const float fr_ = wsf[crow(r, hi)]; o[0][0][r] *= fr_; o[0][1][r] *= fr_; o[1][0][r] *= fr_; o[1][1][r] *= fr_; lacc[0][r] *= fr_; lacc[1][r] *= fr_; }
                  LDS_WAIT();
              }
          } }
#pragma unroll
        for (int m = 0; m < 2; ++m) {
            f32x16& p0 = p[m][0]; f32x16& p1 = p[m][1];
            v8i pw;
#pragma unroll
            for (int q = 0; q < 4; ++q) {
                unsigned wa = __builtin_amdgcn_cvt_pk_u8_f32(p0[4 * q], 0, 0u), wb = __builtin_amdgcn_cvt_pk_u8_f32(p1[4 * q], 0, 0u);
#pragma unroll
                for (int j = 1; j < 4; ++j) { wa = __builtin_amdgcn_cvt_pk_u8_f32(p0[4 * q + j], j, wa); wb = __builtin_amdgcn_cvt_pk_u8_f32(p1[4 * q + j], j, wb); }
                pw[q] = (int)wa; pw[4 + q] = (int)wb; }
            if (m == 0) {
                const lds_cptr vp0 = base + 8192 + hi * 512 + r32 * 16;
#pragma unroll
                for (int d0 = 0; d0 < 2; ++d0) { const u32x4 lo = *(const LAS u32x4*)(vp0 + d0 * 1024), hh = *(const LAS u32x4*)(vp0 + d0 * 1024 + 2048);
                    vf[d0] = (v8i){(int)lo.x, (int)lo.y, (int)lo.z, (int)lo.w, (int)hh.x, (int)hh.y, (int)hh.z, (int)hh.w}; }
            }
#pragma unroll
            for (int d0 = 0; d0 < 2; ++d0) o[m][d0] = __builtin_amdgcn_mfma_scale_f32_32x32x64_f8f6f4(pw, vf[d0], o[m][d0], 1, 0, 0, 0x7F7F7F7F, 0, 0x7B7B7B7B);
            lacc[m] = __builtin_amdgcn_mfma_scale_f32_32x32x64_f8f6f4(pw, ones8, lacc[m], 1, 0, 0, 0x7F7F7F7F, 0, 0x7F7F7F7F);
        }
        }
        slot = slot == 2 ? 0 : slot + 1;
    }
    asm volatile("s_waitcnt lgkmcnt(0)\n\ts_barrier" ::: "memory");
    int lane_e = lane; asm volatile("" : "+v"(lane_e));
    const int r32e = lane_e & 31, hie = lane_e >> 5;
    const float lam = tab[TB_LAM + layer], oml = tab[TB_LAM + 2 + layer];
#pragma unroll
    for (int r = 0; r < 16; ++r) { const int qq = crow(r, hie); const float f0 = __builtin_amdgcn_rcpf(lacc[0][r]), f1 = -lam * __builtin_amdgcn_rcpf(lacc[1][r]);
#pragma unroll
        for (int d0 = 0; d0 < 2; ++d0) ost[qq * 68 + d0 * 32 + r32e] = o[0][d0][r] * f0 + o[1][d0][r] * f1; }
    LDS_WAIT();
    { const int rw = lane_e >> 1, hf = lane_e & 1; f32x4 xv[8]; float ss = 0.f;
#pragma unroll
      for (int j = 0; j < 8; ++j) { xv[j] = *(const LAS f32x4*)(ost + rw * 68 + hf * 32 + 4 * j); ss += (xv[j][0] * xv[j][0] + xv[j][1] * xv[j][1]) + (xv[j][2] * xv[j][2] + xv[j][3] * xv[j][3]); }
      ss += xor_swz<1>(ss);
      const float rs = __builtin_amdgcn_rsqf(ss * (1.f / 64.f) + EPS) * oml;
      const float* sw = F.in[13] + layer * 64 + hf * 32;
      const int qi = qb * 256 + wid * 32 + rw; const size_t orow = isctx ? (size_t)(NLAT + b * CL + qi) : (size_t)(b * T + qi);
      bf16_t* dst = (bf16_t*)(F.ws + WS_MIX) + orow * 1024 + 768 + h * 64 + hf * 32;
#pragma unroll
      for (int j = 0; j < 4; ++j) { const f32x4 a = xv[2 * j], c = xv[2 * j + 1]; const f32x4 wa = *(const f32x4*)(sw + 8 * j), wb = *(const f32x4*)(sw + 8 * j + 4);
          u32x4 w; w.x = pk2(a[0] * rs * wa[0], a[1] * rs * wa[1]); w.y = pk2(a[2] * rs * wa[2], a[3] * rs * wa[3]); w.z = pk2(c[0] * rs * wb[0], c[1] * rs * wb[1]); w.w = pk2(c[2] * rs * wb[2], c[3] * rs * wb[3]);
          *(u32x4*)(dst + 8 * j) = w; } }
    asm volatile("s_waitcnt lgkmcnt(0)\n\ts_barrier" ::: "memory");
#undef ATT_DMA
}

#define ATT_SBAR() __builtin_amdgcn_sched_barrier(0)
#define ATT_PIN(x) asm volatile("" : "+v"(x))
#define ATT_MFMA(a, b, c) __builtin_amdgcn_mfma_f32_32x32x16_bf16(a, b, c, 0, 0, 0)
#define ATT_VLD(D0, D1, vp, ks) do { const s16x4 l0_ = vtr((vp) + (ks) * 1024), h0_ = vtr((vp) + (ks) * 1024 + 512), l1_ = vtr((vp) + 4096 + (ks) * 1024), h1_ = vtr((vp) + 4096 + (ks) * 1024 + 512); \
                                     D0 = (bf16x8){l0_[0], l0_[1], l0_[2], l0_[3], h0_[0], h0_[1], h0_[2], h0_[3]}; D1 = (bf16x8){l1_[0], l1_[1], l1_[2], l1_[3], h1_[0], h1_[1], h1_[2], h1_[3]}; } while (0)
#define ATT_EP(X, e, W) do { X[e] = __builtin_amdgcn_exp2f(X[e]); X[(e) + 1] = __builtin_amdgcn_exp2f(X[(e) + 1]); W = trunc_pk_bf16(X[e], X[(e) + 1]); \
                             S.l[M] = __builtin_amdgcn_fdot2_f32_bf16(__builtin_bit_cast(bf16x2_t, W), __builtin_bit_cast(bf16x2_t, 0x3F803F80u), S.l[M], false); } while (0)
struct SpState { f32x16 o[2][2]; f32x16 negm; bf16x8 qr[2][2]; float mhat; float l[2]; };
template<int M>
__device__ __forceinline__ void half_step(SpState& S, f32x16& pa0, f32x16& pa1, f32x16& pb0, f32x16& pb1, u32x4 (&pwp)[4], u32x4 (&pwc)[4], bf16x8& vA0, bf16x8& vA1, bf16x8& vB0, bf16x8& vB1,
                                          lds_cptr vpp, lds_cptr vpn, lds_cptr kbn, bool chk, LAS float* wsfw, int lane) {
    constexpr int MP = 1 - M;
    if (chk) {
        const float rm = hmax32(pa0, pa1);
        if (__any(rm > 8.f)) {
            const int r32 = lane & 31, hi = lane >> 5;
#pragma unroll
            for (int ks = 0; ks < 4; ++ks) { if (ks == 2) ATT_VLD(vA0, vA1, vpp, 2); if (ks == 3) ATT_VLD(vB0, vB1, vpp, 3);
                S.o[MP][0] = ATT_MFMA(__builtin_bit_cast(bf16x8, pwp[ks]), (ks & 1) ? vB0 : vA0, S.o[MP][0]); S.o[MP][1] = ATT_MFMA(__builtin_bit_cast(bf16x8, pwp[ks]), (ks & 1) ? vB1 : vA1, S.o[MP][1]);
                pwp[ks] = (u32x4){0u, 0u, 0u, 0u}; }
            ATT_VLD(vA0, vA1, vpp, 0); ATT_VLD(vB0, vB1, vpp, 1);
            const float dl = fmaxf(rm, 0.f);
            S.mhat += dl;
#pragma unroll
            for (int r = 0; r < 16; ++r) { pa0[r] -= dl; pa1[r] -= dl; S.negm[r] = -S.mhat; }
            const float f = __builtin_amdgcn_exp2f(-dl);
            S.l[0] *= f; S.l[1] *= f;
            if (hi == 0) wsfw[r32] = f;
            LDS_WAIT();
#pragma unroll
            for (int r = 0; r < 16; ++r) { const float fr_ = wsfw[crow(r, hi)]; S.o[0][0][r] *= fr_; S.o[0][1][r] *= fr_; S.o[1][0][r] *= fr_; S.o[1][1][r] *= fr_; }
            LDS_WAIT();
        }
    }
    bf16x8 k00, k01, k10, k11;
    ATT_SBAR();
    S.o[MP][0] = ATT_MFMA(__builtin_bit_cast(bf16x8, pwp[0]), vA0, S.o[MP][0]); ATT_EP(pa0, 0, pwc[0][0]); ATT_PIN(pa0); ATT_PIN(pwc[0]); ATT_SBAR();
    S.o[MP][1] = ATT_MFMA(__builtin_bit_cast(bf16x8, pwp[0]), vA1, S.o[MP][1]); ATT_EP(pa0, 2, pwc[0][1]); ATT_EP(pa0, 4, pwc[0][2]); ATT_PIN(pa0); ATT_PIN(pwc[0]); ATT_SBAR();
    S.o[MP][0] = ATT_MFMA(__builtin_bit_cast(bf16x8, pwp[1]), vB0, S.o[MP][0]); ATT_VLD(vA0, vA1, vpp, 2); ATT_EP(pa0, 6, pwc[0][3]); ATT_PIN(pa0); ATT_PIN(pwc[0]); ATT_SBAR();
    S.o[MP][1] = ATT_MFMA(__builtin_bit_cast(bf16x8, pwp[1]), vB1, S.o[MP][1]); ATT_EP(pa0, 8, pwc[1][0]); ATT_EP(pa0, 10, pwc[1][1]); ATT_PIN(pa0); ATT_PIN(pwc[1]); ATT_SBAR();
    S.o[MP][0] = ATT_MFMA(__builtin_bit_cast(bf16x8, pwp[2]), vA0, S.o[MP][0]); ATT_VLD(vB0, vB1, vpp, 3); ATT_EP(pa0, 12, pwc[1][2]); ATT_PIN(pa0); ATT_PIN(pwc[1]); ATT_SBAR();
    S.o[MP][1] = ATT_MFMA(__builtin_bit_cast(bf16x8, pwp[2]), vA1, S.o[MP][1]); ATT_EP(pa0, 14, pwc[1][3]); ATT_EP(pa1, 0, pwc[2][0]); ATT_PIN(pa0); ATT_PIN(pa1); ATT_PIN(pwc[1]); ATT_PIN(pwc[2]); ATT_SBAR();
    S.o[MP][0] = ATT_MFMA(__builtin_bit_cast(bf16x8, pwp[3]), vB0, S.o[MP][0]); k00 = *(const LAS bf16x8*)(kbn); k10 = *(const LAS bf16x8*)(kbn + 2048); ATT_VLD(vA0, vA1, vpn, 0); ATT_EP(pa1, 2, pwc[2][1]); ATT_PIN(pa1); ATT_PIN(pwc[2]); ATT_SBAR();
    S.o[MP][1] = ATT_MFMA(__builtin_bit_cast(bf16x8, pwp[3]), vB1, S.o[MP][1]); k01 = *(const LAS bf16x8*)(kbn + 512); k11 = *(const LAS bf16x8*)(kbn + 2048 + 512); ATT_EP(pa1, 4, pwc[2][2]); ATT_EP(pa1, 6, pwc[2][3]); ATT_PIN(pa1); ATT_PIN(pwc[2]); ATT_SBAR();
    pb0 = ATT_MFMA(k00, S.qr[MP][0], S.negm); ATT_VLD(vB0, vB1, vpn, 1); ATT_EP(pa1, 8, pwc[3][0]); ATT_EP(pa1, 10, pwc[3][1]); ATT_PIN(pa1); ATT_PIN(pwc[3]); ATT_SBAR();
    pb0 = ATT_MFMA(k10, S.qr[MP][1], pb0); ATT_EP(pa1, 12, pwc[3][2]); ATT_EP(pa1, 14, pwc[3][3]); ATT_PIN(pa1); ATT_PIN(pwc[3]); ATT_SBAR();
    pb1 = ATT_MFMA(k01, S.qr[MP][0], S.negm); ATT_SBAR();
    pb1 = ATT_MFMA(k11, S.qr[MP][1], pb1); ATT_SBAR();
}
__device__ __forceinline__ void attn_unit_sp(Frame& F, int lane_in, int wid, int layer, int b, int h, bool isctx, int qb) {
    constexpr int NS4 = 4, WSF4 = NS4 * SLOT;
    int lane = lane_in; asm volatile("" : "+v"(lane));
    const int r32 = lane & 31, hi = lane >> 5;
    LAS unsigned char* lds = F.lds; const unsigned lds0 = (unsigned)(uintptr_t)lds;
    const float* tab = (const float*)(F.ws + WS_TAB);
    const int qrow = qb * 256 + wid * 32 + r32;
    SpState S;
#pragma unroll
    for (int m = 0; m < 2; ++m) { const int mp = b * 8 + 2 * h + m;
        const bf16_t* qp = isctx ? (const bf16_t*)(F.ws + WS_QC) + ((size_t)mp * CL + qrow) * 32 : (const bf16_t*)(F.ws + WS_QA) + ((size_t)mp * T + qrow) * 32;
#pragma unroll
        for (int d0 = 0; d0 < 2; ++d0) S.qr[m][d0] = *(const bf16x8*)(qp + d0 * 16 + hi * 8); }
    const int NTL = isctx ? 2 : KT_TILES / 2;
    const bf16_t* ksrc = (const bf16_t*)(F.ws + WS_KA) + (size_t)((b * 8 + 2 * h + (wid >> 2)) * KT_TILES) * 2048 + (wid & 3) * 512;
    const bf16_t* vsrc = (const bf16_t*)(F.ws + WS_VA) + (size_t)((b * 4 + h) * KT_TILES) * 4096 + wid * 512;
    const unsigned dma_off = (unsigned)lane * 16u;
#define ATT_DMA4(t, slot) do { _Pragma("unroll") for (int sb_ = 0; sb_ < 2; ++sb_) { \
                              ::glds16(ksrc + (size_t)(2 * (t) + sb_) * 2048, dma_off, (unsigned)__builtin_amdgcn_readfirstlane(lds0 + (slot) * SLOT + sb_ * 16384 + wid * 1024)); \
                              ::glds16(vsrc + (size_t)(2 * (t) + sb_) * 4096, dma_off, (unsigned)__builtin_amdgcn_readfirstlane(lds0 + (slot) * SLOT + sb_ * 16384 + 8192 + wid * 1024)); } } while (0)
    LAS float* wsf = (LAS float*)(lds + WSF4) + wid * 128;
    LAS float* ost = (LAS float*)(lds + OST_OFF + wid * OST_W);
#pragma unroll
    for (int m = 0; m < 2; ++m) { S.o[m][0] = f32x16{}; S.o[m][1] = f32x16{}; S.l[m] = 0.f; }
    S.mhat = 0.f; S.negm = f32x16{};
    ATT_DMA4(0, 0); if (NTL > 1) ATT_DMA4(1, 1);
    asm volatile("" : "+v"(S.qr[0][0]), "+v"(S.qr[0][1]), "+v"(S.qr[1][0]), "+v"(S.qr[1][1]));
    const int koff = hi * 1024 + r32 * 16;
    const int voff = 8192 + ((lane >> 4) & 1) * 32 + (lane & 3) * 8 + (4 * hi + ((lane & 15) >> 2)) * 64;
    ATT_WAIT_BAR(4);
    f32x16 pa0, pa1, pb0, pb1; u32x4 pwx[4], pwy[4]; bf16x8 vA0, vA1, vB0, vB1;
    {
        const lds_cptr kb = (lds_cptr)lds + koff;
        const bf16x8 k00 = *(const LAS bf16x8*)(kb), k01 = *(const LAS bf16x8*)(kb + 512), k10 = *(const LAS bf16x8*)(kb + 2048), k11 = *(const LAS bf16x8*)(kb + 2048 + 512);
        pa0 = ATT_MFMA(k00, S.qr[0][0], S.negm); pa1 = ATT_MFMA(k01, S.qr[0][0], S.negm); pa0 = ATT_MFMA(k10, S.qr[0][1], pa0); pa1 = ATT_MFMA(k11, S.qr[0][1], pa1);
        const float rm = hmax32(pa0, pa1); S.mhat = rm;
#pragma unroll
        for (int r = 0; r < 16; ++r) { pa0[r] -= rm; pa1[r] -= rm; S.negm[r] = -rm; }
        ATT_VLD(vA0, vA1, (lds_cptr)lds + voff, 0); ATT_VLD(vB0, vB1, (lds_cptr)lds + voff, 1);
#pragma unroll
        for (int k = 0; k < 4; ++k) pwx[k] = (u32x4){0u, 0u, 0u, 0u};
    }
    for (int t = 0; t < NTL; ++t) {
        ATT_WAIT_BAR(0);
        if (t + 2 < NTL) ATT_DMA4(t + 2, (t + 2) & 3);
        const lds_cptr tb = (lds_cptr)lds + (t & 3) * SLOT, tn = (lds_cptr)lds + ((t + 1) & 3) * SLOT, tp = (lds_cptr)lds + ((t == 0 ? 0 : t - 1) & 3) * SLOT + (t == 0 ? 0 : 16384);
        const bool chk = (t & 1) == 0;
        half_step<0>(S, pa0, pa1, pb0, pb1, pwx, pwy, vA0, vA1, vB0, vB1, tp + voff,         tb + voff,         tb + 4096 + koff,         chk && t > 0, wsf, lane);
        half_step<1>(S, pb0, pb1, pa0, pa1, pwy, pwx, vA0, vA1, vB0, vB1, tb + voff,         tb + voff,         tb + 16384 + koff,        chk,          wsf, lane);
        half_step<0>(S, pa0, pa1, pb0, pb1, pwx, pwy, vA0, vA1, vB0, vB1, tb + voff,         tb + 16384 + voff, tb + 16384 + 4096 + koff, false,        wsf, lane);
        half_step<1>(S, pb0, pb1, pa0, pa1, pwy, pwx, vA0, vA1, vB0, vB1, tb + 16384 + voff, tb + 16384 + voff, tn + koff,                false,        wsf, lane);
    }
    {
        const lds_cptr vpl = (lds_cptr)lds + ((NTL - 1) & 3) * SLOT + 16384 + voff;
#pragma unroll
        for (int ks = 0; ks < 4; ++ks) { if (ks == 2) ATT_VLD(vA0, vA1, vpl, 2); if (ks == 3) ATT_VLD(vB0, vB1, vpl, 3);
            S.o[1][0] = ATT_MFMA(__builtin_bit_cast(bf16x8, pwx[ks]), (ks & 1) ? vB0 : vA0, S.o[1][0]); S.o[1][1] = ATT_MFMA(__builtin_bit_cast(bf16x8, pwx[ks]), (ks & 1) ? vB1 : vA1, S.o[1][1]); }
    }
    { const float l0 = S.l[0] + xor32(S.l[0], lane), l1 = S.l[1] + xor32(S.l[1], lane);
      if (hi == 0) { wsf[r32] = __builtin_amdgcn_rcpf(l0); wsf[32 + r32] = __builtin_amdgcn_rcpf(l1); } }
    asm volatile("s_waitcnt lgkmcnt(0)\n\ts_barrier" ::: "memory");
    int lane_e = lane; asm volatile("" : "+v"(lane_e));
    const int r32e = lane_e & 31, hie = lane_e >> 5;
    const float lam = tab[TB_LAM + layer], oml = tab[TB_LAM + 2 + layer];
#pragma unroll
    for (int r = 0; r < 16; ++r) { const int qq = crow(r, hie); const float f0 = wsf[qq], f1 = -lam * wsf[32 + qq];
#pragma unroll
        for (int d0 = 0; d0 < 2; ++d0) ost[qq * 68 + d0 * 32 + r32e] = S.o[0][d0][r] * f0 + S.o[1][d0][r] * f1; }
    LDS_WAIT();
    { const int rw = lane_e >> 1, hf = lane_e & 1; f32x4 xv[8]; float ss = 0.f;
#pragma unroll
      for (int j = 0; j < 8; ++j) { xv[j] = *(const LAS f32x4*)(ost + rw * 68 + hf * 32 + 4 * j); ss += (xv[j][0] * xv[j][0] + xv[j][1] * xv[j][1]) + (xv[j][2] * xv[j][2] + xv[j][3] * xv[j][3]); }
      ss += xor_swz<1>(ss);
      const float rs = __builtin_amdgcn_rsqf(ss * (1.f / 64.f) + EPS) * oml;
      const float* sw = F.in[13] + layer * 64 + hf * 32;
      const int qi = qb * 256 + wid * 32 + rw; const size_t orow = isctx ? (size_t)(NLAT + b * CL + qi) : (size_t)(b * T + qi);
      bf16_t* dst = (bf16_t*)(F.ws + WS_MIX) + orow * 1024 + 768 + h * 64 + hf * 32;
#pragma unroll
      for (int j = 0; j < 4; ++j) { const f32x4 a = xv[2 * j], c = xv[2 * j + 1]; const f32x4 wa = *(const f32x4*)(sw + 8 * j), wb = *(const f32x4*)(sw + 8 * j + 4);
          u32x4 w; w.x = pk2(a[0] * rs * wa[0], a[1] * rs * wa[1]); w.y = pk2(a[2] * rs * wa[2], a[3] * rs * wa[3]); w.z = pk2(c[0] * rs * wb[0], c[1] * rs * wb[1]); w.w = pk2(c[2] * rs * wb[2], c[3] * rs * wb[3]);
          *(u32x4*)(dst + 8 * j) = w; } }
    asm volatile("s_waitcnt lgkmcnt(0)\n\ts_barrier" ::: "memory");
#undef ATT_DMA4
}
}
template<int VAR>
__device__ __forceinline__ void phase_attn(Frame& F, int layer, int ulo, int uhi) {
    PHASE_IDS();
    __syncthreads();
    const int nunits = 512 + (layer == 0 ? 8 : 0);
    for (int u = blk_; u < nunits && u < uhi; u += F.G) {
        if (u < ulo) continue;
        if (u < 512) { const int bh = u & 7, qb = u >> 3; att::attn_unit<VAR>(F, lane, wave, layer, bh >> 2, bh & 3, false, qb); }
        else { const int bh = u - 512; att::attn_unit<VAR>(F, lane, wave, layer, bh >> 2, bh & 3, true, 0); }
    }
}

__device__ __forceinline__ void phase_route(Frame& F, int layer) {
    PHASE_IDS();
    const int wid = wave, G = F.G, blk = blk_;
    const int nrows = layer == 0 ? NROW : NLAT;
    constexpr int TP = 2064;
    LAS unsigned char* Th = F.lds; LAS unsigned char* Tl = F.lds + 16 * TP; LAS float* Pp = (LAS float*)(F.lds + 32 * TP);
    LAS int* hist = (LAS int*)(F.lds + LDS_TAB); LAS int* sbase = hist + 32; LAS unsigned* ent = (LAS unsigned*)(hist + 64); LAS float* entg = (LAS float*)(ent + 640);
    for (int i = tid; i < 64 + 640; i += NTHR) hist[i] = (i < 64) ? 0 : -1;
    LAS float* mv = (LAS float*)(F.lds + 32 * TP + 16384);
    { const float* mg = (const float*)(F.ws + WS_MODV) + (size_t)layer * 3 * 6 * 1024;
      for (int i = tid; i < 9 * 256; i += NTHR) { const int v = i >> 8, c4 = i & 255; *(LAS f32x4*)(mv + v * 1024 + 4 * c4) = *(const f32x4*)(mg + (size_t)((v / 3) * 6 + 2 + (v % 3)) * 1024 + 4 * c4); } }
    bf16x8 bh[4][2], bl[4][2];
    { const bf16_t* rwh = (const bf16_t*)(F.ws + WS_RWT) + (size_t)layer * 32768; const bf16_t* rwl = rwh + 2 * 32768;
#pragma unroll
      for (int ks = 0; ks < 4; ++ks)
#pragma unroll
        for (int nb = 0; nb < 2; ++nb) { const int o_ = (16 * nb + (lane & 15)) * 1024 + 128 * wid + 32 * ks + 8 * (lane >> 4); bh[ks][nb] = *(const bf16x8*)(rwh + o_); bl[ks][nb] = *(const bf16x8*)(rwl + o_); } }
    __syncthreads();
    const float* modv = (const float*)(F.ws + WS_MODV) + (size_t)layer * 3 * 6 * 1024;
    const bf16_t* yb = (const bf16_t*)(F.ws + WS_Y);
    float* x1b = (float*)(F.ws + WS_X1);
    const int nloc = (nrows - blk + G - 1) / G;
    const float rbias = F.in[16][layer * 32 + (lane & 31)];
    const int nbatch = (nloc + 15) >> 4;
    for (int it = 0; it < nbatch; ++it) { const int i0 = 16 * it + 2 * wid;
        f32x4 tk[2][4]; bool val[2];
#pragma unroll
        for (int q = 0; q < 2; ++q) {
            const int il = i0 + q; val[q] = il < nloc; const int r = val[q] ? blk + il * G : blk;
            const int w = row_which(r);
            const float* xs = (layer == 0) ? (r < NLAT ? F.in[0] + (size_t)r * D : F.in[2] + (size_t)(r - NLAT) * D) : x1b + (size_t)r * D;
            f32x4 x[4], y[4]; row_load(xs, lane, x);
#pragma unroll
            for (int j = 0; j < 4; ++j) { const u32x2 yy = *(const u32x2*)(yb + (size_t)r * D + 4 * lane + 256 * j); y[j] = (f32x4){bflo(yy.x), bfhi(yy.x), bflo(yy.y), bfhi(yy.y)}; }
            const float ry = __builtin_amdgcn_rsqf(row_sumsq(y) * (1.f / 1024.f) + EPS);
            const LAS float* c1 = mv + (w * 3 + 0) * 1024;
#pragma unroll
            for (int j = 0; j < 4; ++j) { const f32x4 cv = *(const LAS f32x4*)(c1 + 4 * lane + 256 * j); x[j] = x[j] + cv * (y[j] * ry); }
            if (val[q]) row_store(x1b + (size_t)r * D, lane, x);
            { const float rr_ = __builtin_amdgcn_rsqf(row_sumsq(x) * (1.f / 1024.f) + EPS); const LAS float* at_ = mv + (w * 3 + 1) * 1024; const LAS float* bt_ = mv + (w * 3 + 2) * 1024;
#pragma unroll
              for (int j = 0; j < 4; ++j) { const f32x4 av = *(const LAS f32x4*)(at_ + 4 * lane + 256 * j), bv = *(const LAS f32x4*)(bt_ + 4 * lane + 256 * j); tk[q][j] = x[j] * rr_ * av + bv; } }
            if (val[q]) {
                unsigned char* t8 = F.ws + WS_TOK8 + (size_t)r * D;
#pragma unroll
                for (int j = 0; j < 4; ++j) *(unsigned*)(t8 + 4 * lane + 256 * j) = pk4_fp8(tk[q][j][0], tk[q][j][1], tk[q][j][2], tk[q][j][3]); }
        }
#pragma unroll
        for (int q = 0; q < 2; ++q)
#pragma unroll
            for (int j = 0; j < 4; ++j) { unsigned hb[4], lb[4];
#pragma unroll
                for (int c = 0; c < 4; ++c) { hb[c] = f2bf(tk[q][j][c]); lb[c] = f2bf(tk[q][j][c] - __builtin_bit_cast(float, hb[c] << 16)); }
                const int off = (2 * wid + q) * TP + (4 * lane + 256 * j) * 2;
                *(LAS u32x2*)(Th + off) = (u32x2){hb[0] | (hb[1] << 16), hb[2] | (hb[3] << 16)}; *(LAS u32x2*)(Tl + off) = (u32x2){lb[0] | (lb[1] << 16), lb[2] | (lb[3] << 16)}; }
        __syncthreads();
        { f32x4 pacc[2]; pacc[0] = (f32x4){0.f, 0.f, 0.f, 0.f}; pacc[1] = pacc[0];
#pragma unroll
          for (int ks = 0; ks < 4; ++ks) { const int ao = (lane & 15) * TP + (128 * wid + 32 * ks + 8 * (lane >> 4)) * 2;
              const bf16x8 ah = *(const LAS bf16x8*)(Th + ao), al = *(const LAS bf16x8*)(Tl + ao);
#pragma unroll
              for (int nb = 0; nb < 2; ++nb) { pacc[nb] = __builtin_amdgcn_mfma_f32_16x16x32_bf16(ah, bh[ks][nb], pacc[nb], 0, 0, 0); pacc[nb] = __builtin_amdgcn_mfma_f32_16x16x32_bf16(al, bh[ks][nb], pacc[nb], 0, 0, 0);
                                               pacc[nb] = __builtin_amdgcn_mfma_f32_16x16x32_bf16(ah, bl[ks][nb], pacc[nb], 0, 0, 0); } }
#pragma unroll
          for (int nb = 0; nb < 2; ++nb)
#pragma unroll
              for (int r = 0; r < 4; ++r) Pp[(wid * 16 + 4 * (lane >> 4) + r) * 32 + 16 * nb + (lane & 15)] = pacc[nb][r]; }
        __syncthreads();
        float lg = 0.f;
#pragma unroll
        for (int w8 = 0; w8 < 8; ++w8) lg += Pp[(w8 * 16 + 2 * wid + (lane >> 5)) * 32 + (lane & 31)];
        lg += rbias;
#ifdef DBG_CHECK
        { const int q_ = lane >> 5; if (q_ == 0 ? val[0] : val[1]) ((float*)(F.ws + WS_END + 65536))[(size_t)(blk + (i0 + q_) * G) * 32 + (lane & 31)] = lg; }
#endif
        float tv[4]; int te[4];
#pragma unroll
        for (int k = 0; k < 4; ++k) {
            float m = lg;
            m = fmaxf(m, xor_swz<16>(m)); m = fmaxf(m, xor_swz<8>(m)); m = fmaxf(m, xor_swz<4>(m)); m = fmaxf(m, xor_swz<2>(m)); m = fmaxf(m, xor_swz<1>(m));
            const unsigned long long bal = __ballot(lg == m);
            const unsigned hb = (lane & 32) ? (unsigned)(bal >> 32) : (unsigned)bal;
            const int idx = __builtin_ctz(hb);
            tv[k] = m; te[k] = idx;
            if ((lane & 31) == idx) lg = -INFINITY;
        }
        float g[4]; { float s = 0.f;
#pragma unroll
            for (int k = 0; k < 4; ++k) { g[k] = __expf(tv[k] - tv[0]); s += g[k]; }
            const float inv = 1.f / s;
#pragma unroll
            for (int k = 0; k < 4; ++k) g[k] *= inv; }
        const int q = lane >> 5, k = lane & 31;
        if (k < 4 && (q == 0 ? val[0] : val[1])) {
            const int il = i0 + q; const int r = blk + il * G;
            const int ee = (k == 0) ? te[0] : (k == 1) ? te[1] : (k == 2) ? te[2] : te[3];
            const float gg = (k == 0) ? g[0] : (k == 1) ? g[1] : (k == 2) ? g[2] : g[3];
            entg[il * 4 + k] = gg;
            const int lp = __hip_atomic_fetch_add(hist + ee, 1, __ATOMIC_RELAXED, __HIP_MEMORY_SCOPE_WORKGROUP);
            ent[il * 4 + k] = (unsigned)ee | ((unsigned)lp << 8);
        }
    }
    __syncthreads();
    if (tid < 32) sbase[tid] = (int)__hip_atomic_fetch_add((unsigned*)F.ctl + CW_CNT + layer * 32 + tid, (unsigned)hist[tid], __ATOMIC_RELAXED, __HIP_MEMORY_SCOPE_AGENT);
    __syncthreads();
    int* slot = (int*)(F.ws + WS_SLOT);
    for (int i = tid; i < nloc * 4; i += NTHR) { const unsigned en = ent[i]; if (en != 0xffffffffu) { const int e = en & 255, pos = sbase[e] + (int)(en >> 8); const int r = blk + (i >> 2) * G;
        slot[e * CAP + pos] = r * 4 + (i & 3); ((float*)(F.ws + WS_SGATE))[e * CAP + pos] = entg[i]; ((int*)(F.ws + WS_GATE))[r * 4 + (i & 3)] = e | (pos << 8); } }
    __syncthreads();
}
__device__ __forceinline__ void moe_tables(Frame& F, int layer) {
    PHASE_IDS();
    LAS int* tab = (LAS int*)(F.lds + LDS_TAB);
    if (tid == 0) { int acc = 0;
        for (int e = 0; e < 32; ++e) { const int c = (int)__hip_atomic_load((unsigned*)F.ctl + CW_CNT + layer * 32 + e, __ATOMIC_RELAXED, __HIP_MEMORY_SCOPE_AGENT); tab[e] = acc; tab[33 + e] = c; acc += (c + 255) >> 8; }
        tab[32] = acc; }
    __syncthreads();
}
__device__ __forceinline__ void phase_combine(Frame& F, int layer) {
    PHASE_IDS();
    const int gw = blk_ * NWAVES + wave, NGW = F.G * NWAVES;
    const int nrows = layer == 0 ? NROW : NLAT;
    const bf16_t* yk = (const bf16_t*)(F.ws + WS_YK); float* x1b = (float*)(F.ws + WS_X1);
    LAS float* mv = (LAS float*)F.lds;
    { const float* mg = (const float*)(F.ws + WS_MODV);
      for (int i = tid; i < 9 * 256; i += NTHR) { const int v = i >> 8, c4 = i & 255, w = v / 3, k = v % 3;
          const float* src = (k == 0) ? mg + (size_t)((layer * 3 + w) * 6 + 5) * 1024 : mg + (size_t)((1 * 3 + w) * 6 + (k - 1)) * 1024;
          *(LAS f32x4*)(mv + v * 1024 + 4 * c4) = *(const f32x4*)(src + 4 * c4); } }
    moe_tables(F, layer);
    const LAS int* ttab = (const LAS int*)(F.lds + LDS_TAB); const int* epos = (const int*)(F.ws + WS_GATE);
    int epn[4];
#pragma unroll
    for (int k = 0; k < 4; ++k) epn[k] = (gw < nrows) ? epos[gw * 4 + k] : 0;
    for (int r = gw; r < nrows; r += NGW) {
        const int w = row_which(r);
        int srow[4];
#pragma unroll
        for (int k = 0; k < 4; ++k) { const int ep = __builtin_amdgcn_readfirstlane(epn[k]); srow[k] = 256 * ttab[ep & 255] + (ep >> 8); }
        if (r + NGW < nrows) {
#pragma unroll
            for (int k = 0; k < 4; ++k) epn[k] = epos[(r + NGW) * 4 + k];
        }
        f32x4 x[4]; row_load(x1b + (size_t)r * D, lane, x);
        f32x4 f[4];
#pragma unroll
        for (int j = 0; j < 4; ++j) f[j] = (f32x4){0.f, 0.f, 0.f, 0.f};
#pragma unroll
        for (int k = 0; k < 4; ++k)
#pragma unroll
            for (int j = 0; j < 4; ++j) { const u32x2 u = *(const u32x2*)(yk + (size_t)srow[k] * D + 4 * lane + 256 * j); f[j][0] += bflo(u.x); f[j][1] += bfhi(u.x); f[j][2] += bflo(u.y); f[j][3] += bfhi(u.y); }
        const float rf = __builtin_amdgcn_rsqf(row_sumsq(f) * (1.f / 1024.f) + EPS);
        const LAS float* c2 = mv + (w * 3 + 0) * 1024;
#pragma unroll
        for (int j = 0; j < 4; ++j) { const f32x4 cv = *(const LAS f32x4*)(c2 + 4 * lane + 256 * j); x[j] = x[j] + cv * (f[j] * rf); }
        if (layer == 1) row_store(F.out + (size_t)r * D, lane, x);
        else { row_store(x1b + (size_t)r * D, lane, x);
            const float rr_ = __builtin_amdgcn_rsqf(row_sumsq(x) * (1.f / 1024.f) + EPS); const LAS float* ah_ = mv + (w * 3 + 1) * 1024; const LAS float* bh_ = mv + (w * 3 + 2) * 1024;
            f32x4 o[4];
#pragma unroll
            for (int j = 0; j < 4; ++j) { const f32x4 av = *(const LAS f32x4*)(ah_ + 4 * lane + 256 * j), bv = *(const LAS f32x4*)(bh_ + 4 * lane + 256 * j); o[j] = x[j] * rr_ * av + bv; }
            row_store_bf16((bf16_t*)(F.ws + WS_H) + (size_t)r * D, lane, o); }
    }
}

struct Args { const float* in[21]; float* out; unsigned char* ws; int ph_lo, ph_hi; };
constexpr int PH_PER_LAYER = 10, NPHASE = 2 + 2 * PH_PER_LAYER;
template <int SUB> __global__ void __launch_bounds__(NTHR, 2) mk_fwd(Args args) {
    extern __shared__ __attribute__((aligned(16))) unsigned char lds_raw[];
    Frame F;
    F.lds = (LAS unsigned char*)lds_raw; F.ws = args.ws; F.out = args.out;
#pragma unroll
    for (int i = 0; i < 21; ++i) F.in[i] = args.in[i];
    F.ctl = (gu32*)(args.ws + WS_CTL);
    __builtin_amdgcn_s_setreg(1473, 1);
    F.tid = threadIdx.x; F.lane = F.tid & 63; F.wave = __builtin_amdgcn_readfirstlane(F.tid >> 6); F.G = gridDim.x; F.blk = blockIdx.x;
    volatile LAS unsigned* misc = (volatile LAS unsigned*)(F.lds + LDS_MISC);
    if (F.tid < 16) misc[F.tid] = 0u;
    __syncthreads();
    const int lo = args.ph_lo, hi = args.ph_hi;
    const bool use_bar = (hi - lo) > 1;
    XcdBarrier bar; bar.bar = (unsigned*)F.ctl + CW_BAR; bar.x = 0; bar.st = nullptr;
    if (use_bar) { bar = xcd_barrier_post((unsigned*)F.ctl + CW_BAR, misc + 8); if (F.tid == 0) xcd_barrier_census(bar); }
#define IN(k) (lo <= (k) && (k) < hi)
#define SEAM(k) do { if (IN(k) && IN((k) + 1)) xcd_barrier(bar); } while (0)
    if (PHON(0) && IN(0)) { for (int rep = 0; rep < NREP(0); ++rep) phase_prologue_a(F); } SEAM(0);
    if (PHON(1) && IN(1)) { for (int rep = 0; rep < NREP(1); ++rep) phase_prologue_b(F); } SEAM(1);
    for (int layer = 0; layer < 2; ++layer) {
        const int p0 = 2 + layer * PH_PER_LAYER;
        unsigned char* ws = F.ws;
        int blk_ = F.blk; asm volatile("" : "+s"(blk_));
        if (PHON(2) && IN(p0 + 0)) {
            pg8::DenseSched S; S.init(ws + WS_H, (bf16_t*)(ws + WS_WIN) + (size_t)layer * NIN * 1024, NROW, NIN, F.G, blk_);
            EpiInProj E{ws, (const float*)(ws + WS_TAB), (const float*)(ws + WS_ROPE), layer};
            for (int rep = 0; rep < NREP(2); ++rep) pg8::gemm_phase<EpiInProj, pg8::DenseSched, false>(F.lds, F.wave, S, E);
        } SEAM(p0 + 0);
        if (PHON(3) && IN(p0 + 1)) { if constexpr (SUB & 1) phase_scan2_a(F, layer); if constexpr (SUB & 2) phase_attn<0>(F, layer, 0, F.G); } SEAM(p0 + 1);
        if (PHON(4) && IN(p0 + 2)) { for (int rep = 0; rep < NREP(4); ++rep) phase_scan_b(F); } SEAM(p0 + 2);
        if (PHON(5) && IN(p0 + 3)) { if constexpr (SUB & 1) phase_scan2_c(F, layer); if constexpr (SUB & 2) phase_attn<0>(F, layer, F.G, 1 << 30); } SEAM(p0 + 3);
          if (IN(p0 + 4) && IN(p0 + 5) && !IN(p0 + 3)) xcd_barrier(bar);
        if (PHON(7) && IN(p0 + 5)) {
            pg8::DenseSched S; S.init(ws + WS_MIX, (bf16_t*)(ws + WS_WOUT) + (size_t)layer * 1024 * 1024, layer == 0 ? NROW : NLAT, 1024, F.G, blk_);
            EpiBf16Out E{(bf16_t*)(ws + WS_Y)};
            for (int rep = 0; rep < NREP(7); ++rep) pg8::gemm_phase<EpiBf16Out, pg8::DenseSched, false>(F.lds, F.wave, S, E);
        } SEAM(p0 + 5);
        if (PHON(8) && IN(p0 + 6)) { phase_route(F, layer); } SEAM(p0 + 6);
        if (PHON(9) && IN(p0 + 7)) {
            moe_tables(F, layer);
            pg8::MoeSched<8, true, 1024> S{(const char*)(ws + WS_TOK8), (const char*)(ws + WS_W1 + (size_t)layer * NE * 2048 * 1024), (const int*)(ws + WS_SLOT), (const LAS int*)(F.lds + LDS_TAB), F.G, blk_, (size_t)2048 * 1024};
            EpiSwiglu E{ws + WS_ACT, F.in[18] + (size_t)layer * NE * 2048};
            for (int rep = 0; rep < NREP(9); ++rep) pg8::gemm_phase<EpiSwiglu, pg8::MoeSched<8, true, 1024>, true, true>(F.lds, F.wave, S, E);
        } SEAM(p0 + 7);
        if (PHON(10) && IN(p0 + 8)) {
            moe_tables(F, layer);
            pg8::MoeSched<4, false, 1024> S{(const char*)(ws + WS_ACT), (const char*)(ws + WS_W2 + (size_t)layer * NE * 1024 * 1024), (const int*)(ws + WS_SLOT), (const LAS int*)(F.lds + LDS_TAB), F.G, blk_, (size_t)1024 * 1024};
            EpiMoeOut E{(bf16_t*)(ws + WS_YK), F.in[20] + (size_t)layer * NE * 1024, (const float*)(ws + WS_SGATE)};
            for (int rep = 0; rep < NREP(10); ++rep) pg8::gemm_phase<EpiMoeOut, pg8::MoeSched<4, false, 1024>, false, true>(F.lds, F.wave, S, E);
        } SEAM(p0 + 8);
        if (PHON(11) && IN(p0 + 9)) { phase_combine(F, layer); } SEAM(p0 + 9);
    }
#ifdef OVFL_PROBE
    int lane_z; asm volatile("v_mbcnt_lo_u32_b32 %0, -1, 0\n\tv_mbcnt_hi_u32_b32 %0, -1, %0" : "=v"(lane_z));
    if (hi == NPHASE && F.blk == 0 && F.wave == 0 && lane_z == 0) { int w = 0; float big = 1e6f, huge = 3e38f; asm volatile("" : "+v"(big), "+v"(huge));
      w = __builtin_amdgcn_cvt_pk_bf8_f32(big, huge, w, false); int w2 = 0; w2 = __builtin_amdgcn_cvt_pk_fp8_f32(big, huge, w2, false);
      if (((w & 0xffff) != 0x7B7B) || ((w2 & 0xffff) != 0x7E7E)) { asm volatile("s_waitcnt vmcnt(0)" ::: "memory"); F.out[5] = __builtin_nanf(""); } }
#endif
#undef IN
#undef SEAM
}


#ifdef DBG_CHECK
namespace dbg {
__device__ float blk_sum(float v, float* red) { const int t = threadIdx.x; red[t] = v; __syncthreads(); for (int o = 128; o > 0; o >>= 1) { if (t < o) red[t] += red[t + o]; __syncthreads(); } const float r = red[0]; __syncthreads(); return r; }
struct Ctx { const float* const* in; unsigned char* ws; float* red; };
__device__ float bfb(const unsigned char* ws, size_t off, size_t idx) { return bf2f(((const bf16_t*)(ws + off))[idx]); }
__device__ float zdot(const Ctx& c, int row, int ocol) {
    float a = 0.f; for (int k = threadIdx.x; k < 1024; k += 256) a += bfb(c.ws, WS_H, (size_t)row * 1024 + k) * c.in[7][(size_t)k * 4224 + ocol];
    return blk_sum(a, c.red);
}
__device__ void upd(float* flag, float got, float want) { const float e = fabsf(got - want) / (fabsf(want) + 0.05f); if (threadIdx.x == 0 && (e > *flag || !(e == e))) *flag = (e == e) ? e : 1e9f; }
__device__ float sc_buf(const Ctx& c, int which, int row, int col) { return bfb(c.ws, WS_SCAN + (size_t)which * SCAN_PITCH, (size_t)row * 384 + col); }
__device__ void naive_scan(const Ctx& c, const float* tab, int type, int b, int h, int dir, int n, float* S, float* o64) {
    const int t = threadIdx.x;
    for (int i = t; i < 4096; i += 256) S[i] = 0.f; __syncthreads();
    const float gam = tab[TB_GAM + 0 * 12 + dir * 6 + h];
    int lastrow = 0;
    for (int p = 0; p < n; ++p) {
        const int sc = p < 256 ? 0 : 1 + (p - 256) / 256, pl = p < 256 ? p : (p - 256) % 256; const int row = scan_row(sc, pl, dir, 0) + (sc == 0 ? b * CL : b * T); lastrow = row;
        for (int i = t; i < 4096; i += 256) { const int k = i >> 6, v = i & 63;
            const float kk = sc_buf(c, type ? SC_RK : (dir ? SC_KB : SC_KF), row, h * 64 + k), vv = sc_buf(c, type ? SC_RV : SC_HV, row, h * 64 + v);
            const float f = type ? gam : 1.f - kk; S[i] = f * S[i] + kk * vv; }
        __syncthreads();
    }
    if (t < 64) { float o = 0.f; for (int k = 0; k < 64; ++k) o += sc_buf(c, type ? SC_RQ : SC_HQ, lastrow, h * 64 + k) * S[k * 64 + t]; o64[t] = o; }
    __syncthreads();
}
__global__ void __launch_bounds__(256) k_check(Args args, float* flags) {
    __shared__ float red[256]; __shared__ float S[4096]; __shared__ float o1[64], o2[64];
    Ctx c{args.in, args.ws, red}; const int id = blockIdx.x, t = threadIdx.x; float* fl = flags + id;
    const float* tab = (const float*)(args.ws + WS_TAB);
    if (t == 0) { *fl = 0.f; if (id == 12) { flags[13] = 0.f; flags[14] = 0.f; flags[15] = 0.f; } } __syncthreads();
#define rows(i) ((i) == 0 ? 5 : (i) == 1 ? 20000 : 33000)
    if (id == 0) { for (int ri = 0; ri < 3; ++ri) for (int cc = 3; cc < 384; cc += 197) { const float z = zdot(c, rows(ri), cc); upd(fl, sc_buf(c, SC_HQ, rows(ri), cc), z); } }
    if (id == 1) { for (int ri = 0; ri < 3; ++ri) for (int cc = 3; cc < 384; cc += 197) { upd(fl, sc_buf(c, SC_HV, rows(ri), cc), zdot(c, rows(ri), 1152 + cc)); upd(fl, sc_buf(c, SC_RG, rows(ri), cc), zdot(c, rows(ri), 3072 + cc)); upd(fl, sc_buf(c, SC_HG, rows(ri), cc), zdot(c, rows(ri), 1536 + cc)); upd(fl, sc_buf(c, SC_RV, rows(ri), cc), zdot(c, rows(ri), 2688 + cc)); } }
    if (id == 2) { for (int ri = 0; ri < 3; ++ri) for (int cc = 3; cc < 384; cc += 197) { const float z1 = zdot(c, rows(ri), 384 + cc), z2 = zdot(c, rows(ri), 768 + cc); upd(fl, sc_buf(c, SC_KF, rows(ri), cc), 1.f / (1.f + expf(z1))); upd(fl, sc_buf(c, SC_KB, rows(ri), cc), 1.f / (1.f + expf(z2))); } }
    if (id == 3) { for (int ri = 0; ri < 3; ++ri) for (int hh = 0; hh < 6; hh += 5) for (int i = 1; i < 32; i += 13) for (int isk = 0; isk < 2; ++isk) { const int r = rows(ri); const bool ctx = r >= NLAT; const int tt = r & (T - 1);
            const float x1 = zdot(c, r, 1920 + 384 * isk + hh * 64 + i), x2 = zdot(c, r, 1920 + 384 * isk + hh * 64 + i + 32);
            const float ang = ctx ? 0.f : (float)tt * powf(10000.f, -(float)i / 32.f); const float cs = cosf(ang), sn = sinf(ang), scl = isk ? 0.125f : 1.f;
            upd(fl, sc_buf(c, isk ? SC_RK : SC_RQ, r, hh * 64 + 2 * i), (x1 * cs - x2 * sn) * scl); upd(fl, sc_buf(c, isk ? SC_RK : SC_RQ, r, hh * 64 + 2 * i + 1), (x2 * cs + x1 * sn) * scl); } }
    if (id == 4) { for (int ri = 0; ri < 3; ++ri) for (int mp = 0; mp < 8; mp += 7) for (int half = 0; half < 2; ++half) for (int j = 1; j < 8; j += 5) { const int r = rows(ri); const bool ctx = r >= NLAT; const int tt = ctx ? (r - NLAT) & 255 : r & (T - 1); const int bb = ctx ? (r - NLAT) >> 8 : r >> 14;
            const int pos = half ? (tt & 63) : (tt >> 6); const float ang = ctx ? 0.f : (float)pos * powf(10000.f, -(float)j / 8.f); const float cs = cosf(ang), sn = sinf(ang);
            { const float x1 = zdot(c, r, 3456 + mp * 32 + half * 16 + j), x2 = zdot(c, r, 3456 + mp * 32 + half * 16 + j + 8); const float scl = 0.17677669529663687f * LOG2E;
              const size_t qi = ctx ? ((size_t)(bb * 8 + mp) * CL + tt) * 32 + half * 16 + 2 * j : ((size_t)(bb * 8 + mp) * T + tt) * 32 + half * 16 + 2 * j;
              upd(fl, bfb(c.ws, ctx ? WS_QC : WS_QA, qi), (x1 * cs - x2 * sn) * scl); upd(fl, bfb(c.ws, ctx ? WS_QC : WS_QA, qi + 1), (x2 * cs + x1 * sn) * scl); }
            { const float x1 = zdot(c, r, 3712 + mp * 32 + half * 16 + j), x2 = zdot(c, r, 3712 + mp * 32 + half * 16 + j + 8);
              const int Lk = ctx ? tt : 256 + tt, tile = Lk >> 6, rr = Lk & 63, pw = half * 16 + 2 * j;
              const size_t ki = ((size_t)((bb * 8 + mp) * KT_TILES + tile) * 4 + (pw >> 3)) * 512 + rr * 8 + (pw & 7);
              upd(fl, bfb(c.ws, WS_KA, ki), x1 * cs - x2 * sn); upd(fl, bfb(c.ws, WS_KA, ki + 1), x2 * cs + x1 * sn); }
            { const int h4 = mp >> 1, w = half * 32 + j * 3; const float z = zdot(c, r, 3968 + h4 * 64 + w); const int Lk = ctx ? tt : 256 + tt, tile = Lk >> 6, rr = Lk & 63;
              upd(fl, bfb(c.ws, WS_VA, ((size_t)((bb * 4 + h4) * KT_TILES + tile) * 2 + (w >> 5)) * 2048 + rr * 32 + (w & 31)), z); } } }
    if (id == 5 || id == 6) {
        const int type = id - 5, b = 1, h = 2;
#define ts(i) ((i) == 0 ? 0 : (i) == 1 ? 1 : 300)
        for (int q = 0; q < 3; ++q) { naive_scan(c, tab, type, b, h, 0, 256 + ts(q) + 1, S, o1);
            if (t < 64) { const float got = ((const float*)(args.ws + WS_OSCR))[(size_t)(b * T + ts(q)) * 768 + type * 384 + h * 64 + t]; const float e = fabsf(got - o1[t]) / (fabsf(o1[t]) + 0.05f); if (e > 0.05f || !(e == e)) atomicMax((int*)fl, __float_as_int((e == e) ? e : 1e9f)); } __syncthreads(); }
    }
    if (id == 7 || id == 8) {
        const int type = id - 7, b = 1, h = 4;
        for (int q = 0; q < 2; ++q) {
            int row;
            if (q == 0) { naive_scan(c, tab, type, b, h, 0, 101, S, o1); naive_scan(c, tab, type, b, h, 1, 256 - 100, S, o2); row = NLAT + b * CL + 100; }
            else { naive_scan(c, tab, type, b, h, 1, 257, S, o2); row = b * T + T - 1; if (t < 64) o1[t] = ((const float*)(args.ws + WS_OSCR))[(size_t)row * 768 + type * 384 + h * 64 + t]; __syncthreads(); }
            float o = t < 64 ? o1[t] + o2[t] : 0.f; const float ss = blk_sum(o * o, red); const float r = rsqrtf(ss / 64.f + EPS);
            if (t < 64) { const float g = sc_buf(c, type ? SC_RG : SC_HG, row, h * 64 + t); const float want = o * r * args.in[type ? 11 : 9][t] * g / (1.f + expf(-g));
                const float got = bfb(c.ws, WS_MIX, (size_t)row * 1024 + type * 384 + h * 64 + t); const float e = fabsf(got - want) / (fabsf(want) + 0.05f); if (e > 0.05f || !(e == e)) atomicMax((int*)fl, __float_as_int((e == e) ? e : 1e9f)); }
            __syncthreads(); }
    }
    if (id == 9) {
        for (int q = 0; q < 2; ++q) { const bool ctx = q == 1; const int b = ctx ? 0 : 1, h = ctx ? 3 : 2, tq = ctx ? 77 : 5000; const int nk = ctx ? 256 : 16640;
            __shared__ float po[2][64]; __shared__ float pl[2];
            for (int m = 0; m < 2; ++m) { const int mp = b * 8 + 2 * h + m;
                float mx = -1e30f;
                for (int kk = t; kk < nk; kk += 256) { float sdot = 0.f; for (int d = 0; d < 32; ++d) { const float qv = bfb(c.ws, ctx ? WS_QC : WS_QA, ((size_t)mp * (ctx ? CL : T) + tq) * 32 + d); const float kv = bfb(c.ws, WS_KA, ((size_t)(mp * KT_TILES + (kk >> 6)) * 4 + (d >> 3)) * 512 + (kk & 63) * 8 + (d & 7)); sdot += qv * kv; } mx = fmaxf(mx, sdot); }
                red[t] = mx; __syncthreads(); for (int o = 128; o > 0; o >>= 1) { if (t < o) red[t] = fmaxf(red[t], red[t + o]); __syncthreads(); } mx = red[0]; __syncthreads();
                float ls = 0.f; float av[64];
_Pragma("unroll") for (int d = 0; d < 64; ++d) av[d] = 0.f;
                for (int kk = t; kk < nk; kk += 256) { float sdot = 0.f; for (int d = 0; d < 32; ++d) { const float qv = bfb(c.ws, ctx ? WS_QC : WS_QA, ((size_t)mp * (ctx ? CL : T) + tq) * 32 + d); const float kv = bfb(c.ws, WS_KA, ((size_t)(mp * KT_TILES + (kk >> 6)) * 4 + (d >> 3)) * 512 + (kk & 63) * 8 + (d & 7)); sdot += qv * kv; }
                    const float p = exp2f(sdot - mx); ls += p;
_Pragma("unroll") for (int d = 0; d < 64; ++d) av[d] += p * bfb(c.ws, WS_VA, ((size_t)((b * 4 + h) * KT_TILES + (kk >> 6)) * 2 + (d >> 5)) * 2048 + (kk & 63) * 32 + (d & 31)); }
                ls = blk_sum(ls, red);
_Pragma("unroll") for (int d = 0; d < 64; ++d) { const float sv = blk_sum(av[d], red); if (t == 0) po[m][d] = sv; } if (t == 0) pl[m] = ls; __syncthreads();
            }
            const float lam = tab[TB_LAM + 0], oml = tab[TB_LAM + 2];
            float o = t < 64 ? po[0][t] / pl[0] - lam * po[1][t] / pl[1] : 0.f; const float ss = blk_sum(o * o, red); const float r = rsqrtf(ss / 64.f + EPS);
            if (t < 64) { const float want = o * r * args.in[13][t] * oml; const size_t row = ctx ? (size_t)(NLAT + b * CL + tq) : (size_t)(b * T + tq); const float got = bfb(c.ws, WS_MIX, row * 1024 + 768 + h * 64 + t);
                const float e = fabsf(got - want) / (fabsf(want) + 0.05f); if (e > 0.05f || !(e == e)) atomicMax((int*)fl, __float_as_int((e == e) ? e : 1e9f)); }
            __syncthreads(); }
    }
    if (id == 10) { for (int ri = 0; ri < 3; ++ri) for (int cc = 7; cc < 1024; cc += 401) { float a = 0.f; for (int k = t; k < 1024; k += 256) a += bfb(c.ws, WS_MIX, (size_t)rows(ri) * 1024 + k) * args.in[14][(size_t)k * 1024 + cc]; a = blk_sum(a, red); upd(fl, ((const float*)(args.ws + WS_Y))[(size_t)rows(ri) * 1024 + cc], a); } }
    if (id == 11) {
        const float* modv = (const float*)(args.ws + WS_MODV);
        for (int ri = 0; ri < 3; ++ri) { const int r = rows(ri), w = row_which(r); const float* xs = r < NLAT ? args.in[0] + (size_t)r * D : args.in[2] + (size_t)(r - NLAT) * D; const float* y = (const float*)(args.ws + WS_Y) + (size_t)r * D;
            float sy = 0.f; for (int k = t; k < 1024; k += 256) sy += y[k] * y[k]; sy = blk_sum(sy, red); const float ry = rsqrtf(sy / 1024.f + EPS);
            float x1[4]; float sx = 0.f;
_Pragma("unroll") for (int q = 0; q < 4; ++q) { const int k = t + 256 * q; x1[q] = xs[k] + modv[(size_t)(w * 6 + 2) * 1024 + k] * y[k] * ry; sx += x1[q] * x1[q]; } sx = blk_sum(sx, red); const float rx = rsqrtf(sx / 1024.f + EPS);
_Pragma("unroll")
            for (int q = 0; q < 4; ++q) { const int k = t + 256 * q; const float tk = x1[q] * rx * modv[(size_t)(w * 6 + 3) * 1024 + k] + modv[(size_t)(w * 6 + 4) * 1024 + k];
                const float got = bfb(c.ws, WS_H, (size_t)r * 1024 + k), got1 = ((const float*)(args.ws + WS_X1))[(size_t)r * 1024 + k];
                const float e = fmaxf(fabsf(got - tk) / (fabsf(tk) + 0.05f), fabsf(got1 - x1[q]) / (fabsf(x1[q]) + 0.05f)); if (e > 0.05f || !(e == e)) atomicMax((int*)fl, __float_as_int((e == e) ? e : 1e9f)); }
            __syncthreads(); } }

    if (id == 12) {
        __shared__ float tokf[1024], lg[32], abuf[2048], actb[1024], yb[1024]; __shared__ int te[4]; __shared__ float tg[4]; __shared__ int spos;
        const unsigned* cnt = (const unsigned*)(args.ws + WS_CTL) + CW_CNT; const int* slot = (const int*)(args.ws + WS_SLOT);
        for (int ri = 0; ri < 3; ++ri) { const int r = rows(ri);
            for (int k = t; k < 1024; k += 256) tokf[k] = bfb(c.ws, WS_H, (size_t)r * 1024 + k); __syncthreads();
            if (t < 32) { float a = args.in[16][t]; for (int k = 0; k < 1024; ++k) a += tokf[k] * args.in[15][(size_t)k * 32 + t]; lg[t] = a; } __syncthreads();
            if (t < 32) { const float got = ((const float*)(args.ws + WS_END + 65536))[(size_t)r * 32 + t]; const float e = fabsf(got - lg[t]); if (e > 0.02f || !(e == e)) atomicMax((int*)(flags + 15), __float_as_int((e == e) ? 1.f + e : 1e9f)); } __syncthreads();
            if (t == 0) { float tv[4]; for (int k = 0; k < 4; ++k) { int bi = 0; float bv = -1e30f; for (int e = 0; e < 32; ++e) if (lg[e] > bv) { bv = lg[e]; bi = e; } te[k] = bi; tv[k] = bv; lg[bi] = -1e30f; }
                float sm = 0.f; for (int k = 0; k < 4; ++k) { tg[k] = expf(tv[k] - tv[0]); sm += tg[k]; } for (int k = 0; k < 4; ++k) tg[k] /= sm; } __syncthreads();
            if (t < 4) { const float got = ((const float*)(args.ws + WS_GATE))[(size_t)r * 4 + t]; const float e = fabsf(got - tg[t]) / (tg[t] + 0.01f); if (e > 0.05f || !(e == e)) atomicMax((int*)(flags + 12), __float_as_int((e == e) ? e : 1e9f)); }
            for (int k4 = 0; k4 < 4; ++k4) { const int e = te[k4]; const float* w1 = args.in[17] + (size_t)e * 1024 * 2048; const float* w2 = args.in[19] + (size_t)e * 1024 * 1024;
                for (int n = t; n < 2048; n += 256) { float a = args.in[18][(size_t)e * 2048 + n]; for (int k = 0; k < 1024; ++k) a += tokf[k] * w1[(size_t)k * 2048 + n]; abuf[n] = a; } __syncthreads();
                for (int j = t; j < 1024; j += 256) { const float g = fminf(abuf[2 * j], 7.f), l = fminf(fmaxf(abuf[2 * j + 1], -7.f), 7.f); actb[j] = g / (1.f + expf(-1.702f * g)) * (l + 1.f); } __syncthreads();
                for (int cc = t; cc < 1024; cc += 256) { float a = args.in[20][(size_t)e * 1024 + cc]; for (int j = 0; j < 1024; ++j) a += actb[j] * w2[(size_t)j * 1024 + cc]; yb[cc] = a * tg[k4]; } __syncthreads();
                if (t == 0) spos = -1; __syncthreads();
                const int ce = (int)cnt[e]; for (int p = t; p < ce; p += 256) if (slot[e * CAP + p] == r * 4 + k4) spos = p; __syncthreads();
                int ts0 = 0; for (int q = 0; q < e; ++q) ts0 += ((int)cnt[q] + 255) >> 8;
                float sqa = 0.f, sqy = 0.f; for (int k = t; k < 1024; k += 256) { sqa += actb[k] * actb[k]; sqy += yb[k] * yb[k]; } sqa = blk_sum(sqa, red); sqy = blk_sum(sqy, red); const float ra = sqrtf(sqa / 1024.f), ry = sqrtf(sqy / 1024.f);
                if (spos < 0) { if (t == 0) flags[13] = 7e8f; }
                else for (int k = t; k < 1024; k += 256) { const float got = bfb(c.ws, WS_ACT, ((size_t)ts0 * 256 + spos) * 1024 + k); const float er = fabsf(got - actb[k]) / (fabsf(actb[k]) + 0.2f * ra + 1e-6f); if (er > 0.05f || !(er == er)) atomicMax((int*)(flags + 13), __float_as_int((er == er) ? er : 1e9f)); }
                for (int k = t; k < 1024; k += 256) { const float got = bfb(c.ws, WS_YK, ((size_t)r * 4 + k4) * 1024 + k); const float er = fabsf(got - yb[k]) / (fabsf(yb[k]) + 0.2f * ry + 1e-6f); if (er > 0.05f || !(er == er)) atomicMax((int*)(flags + 14), __float_as_int((er == er) ? er : 1e9f)); }
                __syncthreads(); }
        } }
}
__global__ void k_out(Args args, const float* flags, int nchk, unsigned mask) {
    int code = 0; for (int i = nchk - 1; i >= 0; --i) if (((mask >> i) & 1u) && flags[i] > 0.05f) code = i + 1;
    const float sc = 1.f + (float)code;
    for (size_t i = (size_t)blockIdx.x * blockDim.x + threadIdx.x; i < (size_t)NLAT * D; i += (size_t)gridDim.x * blockDim.x) args.out[i] = args.in[0][i] * sc;
}
}
#endif

extern "C" void kernel_launch(void* const* d_in, const int* in_sizes, int n_in, void* d_out, int out_size, void* d_ws, size_t ws_size, hipStream_t stream) {
    static int grid = 0;
    if (grid == 0) {
        if (n_in != 21 || out_size != NLAT * D || ws_size < WS_END) { fprintf(stderr, "kernel_launch: unexpected shapes (n_in %d out %d ws %zu)\n", n_in, out_size, ws_size); grid = -1; return; }
        int dev = 0, cus = 0, per_cu = 0;
        if (hipGetDevice(&dev) != hipSuccess || hipDeviceGetAttribute(&cus, hipDeviceAttributeMultiprocessorCount, dev) != hipSuccess) { grid = -1; return; }
        if (hipFuncSetAttribute((const void*)mk_fwd<3>, hipFuncAttributeMaxDynamicSharedMemorySize, LDS_BYTES) != hipSuccess) { fprintf(stderr, "kernel_launch: hipFuncSetAttribute failed\n"); grid = -1; return; }
        if (hipOccupancyMaxActiveBlocksPerMultiprocessor(&per_cu, (const void*)mk_fwd<3>, NTHR, LDS_BYTES) != hipSuccess || per_cu < 1) fprintf(stderr, "kernel_launch: occupancy query reports %d\n", per_cu);
        (void)hipGetLastError();
        grid = cus;
    }
    if (grid < 0) return;
    if (hipMemsetAsync((char*)d_ws + WS_CTL, 0, CTL_ZERO_BYTES, stream) != hipSuccess) return;
    Args a{};
    for (int i = 0; i < 21; ++i) a.in[i] = (const float*)d_in[i];
    a.out = (float*)d_out; a.ws = (unsigned char*)d_ws;
#if MK_ONE_LAUNCH
    a.ph_lo = 0; a.ph_hi = NPHASE;
    hipLaunchKernelGGL(mk_fwd<3>, dim3(grid), dim3(NTHR), LDS_BYTES, stream, a);
#elif defined(DBG_CHECK)
    for (int p = 0; p < DBG_CHECK; ++p) { a.ph_lo = p; a.ph_hi = p + 1; hipLaunchKernelGGL(mk_fwd<3>, dim3(grid), dim3(NTHR), LDS_BYTES, stream, a); }
    float* flags = (float*)((char*)d_ws + WS_END);
    hipLaunchKernelGGL(dbg::k_check, dim3(13), dim3(256), 0, stream, a, flags);
    hipLaunchKernelGGL(dbg::k_out, dim3(1024), dim3(256), 0, stream, a, (const float*)flags, 16, (unsigned)DBG_MASK);
#else
    if (hipFuncSetAttribute((const void*)mk_fwd<PROBE_SUB>, hipFuncAttributeMaxDynamicSharedMemorySize, LDS_BYTES) != hipSuccess) return;
    for (int p = 0; p < NPHASE; ++p) { a.ph_lo = p; a.ph_hi = p + 1; hipLaunchKernelGGL(mk_fwd<3>, dim3(grid), dim3(NTHR), LDS_BYTES, stream, a);
        const int pid = p < 2 ? p : 2 + (p - 2) % PH_PER_LAYER;
        if (pid == PROBE_PH) hipLaunchKernelGGL(mk_fwd<PROBE_SUB>, dim3(grid), dim3(NTHR), LDS_BYTES, stream, a); }
#endif
}
```

```cpp
#include <hip/hip_runtime.h>
#include <cstdio>
#include <cstdint>
#include <cmath>

#ifndef DBG_MASK
#define DBG_MASK 0xf800
#endif
#ifndef PHMASK
#define PHMASK 0xfff
#endif
#define PHON(k) ((PHMASK >> (k)) & 1)
#ifndef REPMASK
#define REPMASK 0
#endif
#define NREP(k) (1 + ((REPMASK >> (k)) & 1))
#ifndef ATTVAR
#define ATTVAR -1
#endif
#ifndef MK_ONE_LAUNCH
#define MK_ONE_LAUNCH 1
#endif
#define PROBE_PH -1
#define PROBE_SUB 3

#define LAS __attribute__((address_space(3)))
#define GAS __attribute__((address_space(1)))
typedef unsigned short bf16_t;
typedef short bf16x8 __attribute__((ext_vector_type(8)));
typedef short s16x4 __attribute__((ext_vector_type(4)));
typedef float f32x2 __attribute__((ext_vector_type(2)));
typedef float f32x4 __attribute__((ext_vector_type(4)));
typedef float f32x16 __attribute__((ext_vector_type(16)));
typedef unsigned u32x2 __attribute__((ext_vector_type(2)));
typedef unsigned u32x4 __attribute__((ext_vector_type(4)));
typedef GAS unsigned gu32;
typedef int v4i __attribute__((ext_vector_type(4)));
typedef int v8i __attribute__((ext_vector_type(8)));

constexpr int NB = 2, T = 16384, CL = 256, D = 1024;
constexpr int NLAT = NB * T, NCTX = NB * CL, NROW = NLAT + NCTX;
constexpr int NE = 32, CAP = NROW;
constexpr int NIN = 4352;
constexpr int NSEQ = 48, NSC = 65;
constexpr int KT_TILES = 260;
constexpr float EPS = 1e-6f;
constexpr float LOG2E = 1.4426950408889634f;
constexpr int NWAVES = 8, NTHR = 512;

constexpr size_t MiB = 1u << 20;
constexpr size_t WS_CTL = 0, CTL_ZERO_BYTES = 64 * 1024;
constexpr size_t WS_MODV = 1 * MiB;
constexpr size_t WS_TAB = 1 * MiB + 256 * 1024;
constexpr size_t WS_RWT = 1 * MiB + 512 * 1024;
constexpr size_t WS_ROPE = 2 * MiB;
constexpr size_t WS_WIN = 6 * MiB;
constexpr size_t WS_WOUT = 23 * MiB;
constexpr size_t WS_W1 = 27 * MiB;
constexpr size_t WS_W2 = 283 * MiB;
constexpr size_t WS_X1 = 411 * MiB;
constexpr size_t WS_H = 541 * MiB;
constexpr size_t WS_SCAN = 606 * MiB;
constexpr size_t SCAN_PITCH = 25 * MiB;
constexpr size_t WS_QA = 831 * MiB;
constexpr size_t WS_QC = 847 * MiB;
constexpr size_t WS_KA = 848 * MiB;
constexpr size_t WS_VA = 865 * MiB;
constexpr size_t WS_SLOC = 882 * MiB;
constexpr size_t WS_SIN = 931 * MiB;
constexpr size_t WS_DEC = 980 * MiB;
constexpr size_t WS_OSCR = 981 * MiB;
constexpr size_t WS_MIX = 1079 * MiB;
constexpr size_t WS_Y = 1144 * MiB;
constexpr size_t WS_SLOT = 1274 * MiB;
constexpr size_t WS_GATE = 1279 * MiB;
constexpr size_t WS_ACT = 1280 * MiB;
constexpr size_t WS_YK = 1540 * MiB;
constexpr size_t WS_TOK8 = 1816 * MiB;
constexpr size_t WS_SGATE = 1850 * MiB;
constexpr size_t WS_END = 1856 * MiB;
enum { SC_KF = 0, SC_KB = 1, SC_RQ = 2, SC_RK = 3, SC_HQ = 4, SC_HV = 5, SC_HG = 6, SC_RV = 7, SC_RG = 8 };
constexpr int CW_TMO = 0, CW_BAR = 4096, CW_CNT = 8192;
constexpr int TB_LBT = 0;
constexpr int TB_LAM = 1024;
constexpr int TB_GAM = 1040;
constexpr int TB_AXR = 2048;
constexpr int TB_AXC = 2048 + 4096;

constexpr int LDS_BYTES = 147456;
constexpr int LDS_MISC = 131072 + 12288;
constexpr int LDS_TAB = 131072;

__device__ __forceinline__ unsigned f2bf(float f) { unsigned u = __builtin_bit_cast(unsigned, f); return (u + 0x7fffu + ((u >> 16) & 1u)) >> 16; }
__device__ __forceinline__ unsigned pk2(float lo, float hi) { return f2bf(lo) | (f2bf(hi) << 16); }
__device__ __forceinline__ float bf2f(unsigned short b) { return __builtin_bit_cast(float, (unsigned)b << 16); }
__device__ __forceinline__ float bflo(unsigned w) { return __builtin_bit_cast(float, w << 16); }
__device__ __forceinline__ float bfhi(unsigned w) { return __builtin_bit_cast(float, w & 0xffff0000u); }
typedef __bf16 bf16x2_t __attribute__((ext_vector_type(2)));
__device__ __forceinline__ unsigned trunc_pk_bf16(float lo, float hi) { return __builtin_amdgcn_perm(__builtin_bit_cast(unsigned, hi), __builtin_bit_cast(unsigned, lo), 0x07060302u); }
__device__ __forceinline__ unsigned cvt_pk_bf16(float lo, float hi) { const f32x2 v = {lo, hi}; const bf16x2_t b = __builtin_convertvector(v, bf16x2_t); return __builtin_bit_cast(unsigned, b); }
__device__ __forceinline__ float wave_sum_dpp(float v) {
#define DPP_ADD(ctrl, rmask) v += __builtin_bit_cast(float, __builtin_amdgcn_update_dpp(0, __builtin_bit_cast(int, v), ctrl, rmask, 0xF, false))
    DPP_ADD(0xB1, 0xF); DPP_ADD(0x4E, 0xF); DPP_ADD(0x141, 0xF); DPP_ADD(0x140, 0xF); DPP_ADD(0x142, 0xA); DPP_ADD(0x143, 0xC);
#undef DPP_ADD
    return __builtin_bit_cast(float, __builtin_amdgcn_readlane(__builtin_bit_cast(int, v), 63));
}
__device__ __forceinline__ float wave_sum(float v) { return wave_sum_dpp(v); }
template <int M> __device__ __forceinline__ float xor_swz(float v) { return __builtin_bit_cast(float, __builtin_amdgcn_ds_swizzle(__builtin_bit_cast(int, v), 0x1F | (M << 10))); }
__device__ __forceinline__ float xor32(float v, int lane) { return __builtin_bit_cast(float, __builtin_amdgcn_ds_bpermute((lane ^ 32) << 2, __builtin_bit_cast(int, v))); }
__device__ __forceinline__ float rdlane(float v, int l) { return __builtin_bit_cast(float, __builtin_amdgcn_readlane(__builtin_bit_cast(int, v), l)); }
__device__ __forceinline__ float sigmoidf_(float x) { return __builtin_amdgcn_rcpf(1.f + __builtin_amdgcn_exp2f(-LOG2E * x)); }
#define PHASE_IDS_W(WV) int lane; asm volatile("v_mbcnt_lo_u32_b32 %0, -1, 0\n\tv_mbcnt_hi_u32_b32 %0, -1, %0" : "=v"(lane)); int wave = (WV); asm volatile("" : "+s"(wave)); const int tid = wave * 64 + lane; (void)tid
#define PHASE_IDS() PHASE_IDS_W(F.wave); int blk_ = F.blk; asm volatile("" : "+s"(blk_))
__device__ __forceinline__ unsigned pk4_fp8(float a, float b, float c, float d) { int w = __builtin_bit_cast(int, a); w = __builtin_amdgcn_cvt_pk_fp8_f32(a, b, w, false); w = __builtin_amdgcn_cvt_pk_fp8_f32(c, d, w, true); return (unsigned)w; }
constexpr float W8_MUL = 64.f;
constexpr int SCALE_W8 = 0x79797979, SCALE_A8 = 0x7F7F7F7F;
#define LDS_WAIT() asm volatile("s_waitcnt lgkmcnt(0)" ::: "memory")
#define VM_WAIT() asm volatile("s_waitcnt vmcnt(0)" ::: "memory")

#define XB_TMO      128
#define XB_XCNT(j)  (256  + 64 * (j))
#define XB_XSUB(j)  (1280 + 64 * (j))
#define XB_XGEN(j)  (2304 + 64 * (j))
#define XB_TOP      3328
#define XB_TOPGEN   3392
#define XCD_BAR_WORDS 3456
#define XB_SPIN_CAP (1u << 22)
__device__ __forceinline__ unsigned xb_ld(unsigned* p)              { return __hip_atomic_load(p, __ATOMIC_RELAXED, __HIP_MEMORY_SCOPE_AGENT); }
__device__ __forceinline__ unsigned xb_add(unsigned* p, unsigned v) { return __hip_atomic_fetch_add(p, v, __ATOMIC_RELAXED, __HIP_MEMORY_SCOPE_AGENT); }
__device__ __forceinline__ unsigned xb_xcc_id() { return (unsigned)__builtin_amdgcn_s_getreg((3 << 11) | 20) & 0xFu; }
#define XB_SPIN(cond, bar) do { unsigned _sp = 0; while (cond) { __builtin_amdgcn_s_sleep(1); \
    if ((++_sp & 255u) == 0u) { if (xb_ld(&(bar)[XB_TMO])) break; if (_sp > XB_SPIN_CAP) { atomicAdd(&(bar)[XB_TMO], 1u); break; } } } } while (0)
struct XcdBarrier { unsigned* bar; unsigned x; volatile LAS unsigned* st; };
__device__ __forceinline__ XcdBarrier xcd_barrier_post(unsigned* bar, volatile LAS unsigned* st) {
    XcdBarrier b; b.bar = bar; b.x = xb_xcc_id(); b.st = st;
    if (threadIdx.x == 0) (void)xb_add(&bar[XB_XCNT(b.x)], 1u);
    return b;
}
__device__ __forceinline__ void xcd_barrier_complete(unsigned* bar, unsigned x, unsigned& nloc, unsigned& nx) {
    const unsigned G = gridDim.x * gridDim.y * gridDim.z;
    unsigned sum, cnt, mine, sp = 0u;
    for (;;) {
        sum = 0u; cnt = 0u; mine = 0u;
#pragma unroll
        for (unsigned j = 0; j < 16; ++j) { const unsigned c = xb_ld(&bar[XB_XCNT(j)]); sum += c; cnt += (c > 0u) ? 1u : 0u; mine = (j == x) ? c : mine; }
        if (sum == G) break;
        __builtin_amdgcn_s_sleep(1);
        if ((++sp & 255u) == 0u) { if (xb_ld(&bar[XB_TMO])) break; if (sp > XB_SPIN_CAP) { atomicAdd(&bar[XB_TMO], 1u); break; } }
    }
    nloc = mine > 0u ? mine : 1u; nx = cnt > 0u ? cnt : 1u;
}
__device__ __forceinline__ void xcd_barrier_census(const XcdBarrier& b) {
    unsigned nloc, nx; xcd_barrier_complete(b.bar, b.x, nloc, nx); b.st[0] = nloc; b.st[1] = nx;
}
__device__ __forceinline__ void xcd_barrier(const XcdBarrier& b) {
    asm volatile("s_waitcnt vmcnt(0)" ::: "memory");
    __syncthreads();
    if (threadIdx.x == 0) {
        unsigned* bar = b.bar;
        __builtin_amdgcn_s_waitcnt(0);
        const unsigned nloc = b.st[0], nx = b.st[1];
        const unsigned old = xb_add(&bar[XB_XSUB(b.x)], 1u);
        const unsigned gen = old / nloc;
        if (old + 1u == (gen + 1u) * nloc) {
            __builtin_amdgcn_fence(__ATOMIC_RELEASE, "agent");
            asm volatile("s_waitcnt vmcnt(0)" ::: "memory");
            const unsigned og = xb_add(&bar[XB_TOP], 1u);
            const unsigned tg = og / nx;
            if (og + 1u == (tg + 1u) * nx) xb_add(&bar[XB_TOPGEN], 1u);
            else XB_SPIN(xb_ld(&bar[XB_TOPGEN]) == tg, bar);
            __builtin_amdgcn_fence(__ATOMIC_ACQUIRE, "agent");
            xb_add(&bar[XB_XGEN(b.x)], 1u);
            asm volatile("s_waitcnt vmcnt(0)" ::: "memory");
        } else {
            XB_SPIN(xb_ld(&bar[XB_XGEN(b.x)]) == gen, bar);
            __builtin_amdgcn_fence(__ATOMIC_ACQUIRE, "agent");
            asm volatile("s_waitcnt vmcnt(0)" ::: "memory");
        }
    }
    __syncthreads();
}

struct Frame {
    LAS unsigned char* lds;
    unsigned char* ws;
    const float* in[21];
    float* out;
    gu32* ctl;
    int tid, lane, wave, G, blk;
};

__device__ __forceinline__ void glds16(const void* sbase, unsigned voff, unsigned lds_dst) { unsigned keep;
    asm volatile("s_mov_b32 %0, m0\n\ts_mov_b32 m0, %3\n\ts_nop 0\n\tglobal_load_lds_dwordx4 %1, %2\n\ts_mov_b32 m0, %0" : "=&s"(keep) : "v"(voff), "s"(sbase), "s"(lds_dst) : "memory"); }

namespace pg8 {
constexpr int BM = 256, BK = 64, HALF = 128, HTB = HALF * BK * 2, STAGE_BYTES = 8 * HTB, NXCD = 8, WGM = 8, K = 1024;
__host__ __device__ __forceinline__ int lds_byte(int r, int c) { const int st = (r >> 4) * 2 + (c >> 5), rr = r & 15, cc = c & 31, ob = rr * 64 + cc * 2; return st * 1024 + (ob ^ (((ob >> 9) & 1) << 5)); }
__host__ __device__ __forceinline__ void stage_rc(int b, int& R, int& C) { const int st = b / 1024, sb = b % 1024, swz = sb ^ (((sb >> 9) & 1) << 5); R = (st >> 1) * 16 + swz / 64; C = (st & 1) * 32 + (swz % 64) / 2; }
__host__ __device__ __forceinline__ int perm32(int rho) { const int n = rho >> 4, i = rho & 15; return 8 * (i >> 2) + 4 * n + (i & 3); }
struct Unit { int pm, pn, e, nvalid, sbase; };
template <class Epi, class Sched, bool GATHER, bool FP8 = false>
__device__ __forceinline__ void gemm_phase(LAS unsigned char* lds, int wave_id, const Sched& S, const Epi& E) {
    constexpr int KB = FP8 ? 1024 : 2048, NT = KB / 128;
    PHASE_IDS_W(wave_id); const int wid = wave, wr = wid >> 2, wc = wid & 3, fr = lane & 15, fq = lane >> 4;
    unsigned voffB[2], vA[2][2]; int R0, C0;
    { int R, C; stage_rc(tid * 16, R, C); R0 = R; C0 = C;
#pragma unroll
      for (int i = 0; i < 2; ++i) { const int Ri = R + 64 * i; const int Rb = Epi::PERM ? ((Ri & ~31) + perm32(Ri & 31)) : Ri; voffB[i] = (unsigned)(Rb * KB + C * 2);
#pragma unroll
          for (int h = 0; h < 2; ++h) vA[h][i] = (unsigned)((Ri + 128 * h) * KB + C * 2); } }
    const size_t kstep = (size_t)(BK * 2);
    const size_t hstep = (size_t)HALF * KB;
    const unsigned ldsw = (unsigned)wid * 1024u, lds0 = (unsigned)(uintptr_t)lds;
    const int aoff = lds_byte(wr * 64 + fr, fq * 8), boff = lds_byte(wc * 32 + fr, fq * 8);
#define PG8_SA(b, h) (((b) * 2 + (h)) * HTB)
#define PG8_SB(b, h) ((4 + (b) * 2 + (h)) * HTB)
#define PG8_STAGE(bufoff, gbase, voff) do { _Pragma("unroll") for (int _i = 0; _i < 2; ++_i) \
        glds16((const void*)(gbase), (voff)[_i], (unsigned)__builtin_amdgcn_readfirstlane(lds0 + (unsigned)(bufoff) + ldsw + _i * 8192)); } while (0)
#define PG8_LDA(dst, b, h) do { _Pragma("unroll") for (int m = 0; m < 4; ++m) { dst[m].lo = *(const LAS v4i*)(lds + PG8_SA(b, h) + aoff + m * 2048); dst[m].hi = *(const LAS v4i*)(lds + PG8_SA(b, h) + aoff + m * 2048 + 1024); } } while (0)
#define PG8_LDB(dst, b, h) do { _Pragma("unroll") for (int n = 0; n < 2; ++n) { dst[n].lo = *(const LAS v4i*)(lds + PG8_SB(b, h) + boff + n * 2048); dst[n].hi = *(const LAS v4i*)(lds + PG8_SB(b, h) + boff + n * 2048 + 1024); } } while (0)
#define PG8_MMA(ai, bj, At, Bt) do { __builtin_amdgcn_s_setprio(1); _Pragma("unroll") for (int m = 0; m < 4; ++m) _Pragma("unroll") for (int n = 0; n < 2; ++n) { \
        if constexpr (FP8) acc[ai][bj][m][n] = __builtin_amdgcn_mfma_scale_f32_16x16x128_f8f6f4(Bt[n], At[m], acc[ai][bj][m][n], 0, 0, 0, SCALE_W8, 0, SCALE_A8); \
        else { acc[ai][bj][m][n] = __builtin_amdgcn_mfma_f32_16x16x32_bf16(__builtin_bit_cast(bf16x8, (v4i)Bt[n].lo), __builtin_bit_cast(bf16x8, (v4i)At[m].lo), acc[ai][bj][m][n], 0, 0, 0); \
               acc[ai][bj][m][n] = __builtin_amdgcn_mfma_f32_16x16x32_bf16(__builtin_bit_cast(bf16x8, (v4i)Bt[n].hi), __builtin_bit_cast(bf16x8, (v4i)At[m].hi), acc[ai][bj][m][n], 0, 0, 0); } } \
        __builtin_amdgcn_s_setprio(0); } while (0)
#define PG8_WAIT_V(n) asm volatile("s_waitcnt vmcnt(" #n ")" ::: "memory")
#define PG8_WAIT_L(n) asm volatile("s_waitcnt lgkmcnt(" #n ")" ::: "memory")
#define PG8_BAR __builtin_amdgcn_s_barrier()
#define PG8_SCHED __builtin_amdgcn_sched_barrier(0)
    Unit cur, nxt; int ui = 0;
    if (!S.next(0, cur)) return;
    f32x4 acc[2][2][4][2];
#pragma unroll
    for (int a = 0; a < 2; ++a)
#pragma unroll
        for (int b = 0; b < 2; ++b)
#pragma unroll
            for (int m = 0; m < 4; ++m)
#pragma unroll
                for (int n = 0; n < 2; ++n) acc[a][b][m][n] = (f32x4){0.f, 0.f, 0.f, 0.f};
    v8i At[4], B0[2], B1[2];
    const char* cA = S.a_ptr(cur); const char* cB = S.b_ptr(cur);
    unsigned nvA[2][2];
    if constexpr (GATHER) S.a_off(cur, R0, C0, vA);
    PG8_STAGE(PG8_SB(0, 0), cB, voffB); PG8_STAGE(PG8_SB(0, 1), cB + hstep, voffB); PG8_STAGE(PG8_SA(0, 0), cA, vA[0]); PG8_STAGE(PG8_SA(0, 1), cA, vA[1]);
    if (wr == 1) PG8_BAR;
    PG8_WAIT_V(2); PG8_BAR;
    PG8_STAGE(PG8_SB(1, 0), cB + kstep, voffB); PG8_STAGE(PG8_SA(1, 0), cA + kstep, vA[0]); PG8_STAGE(PG8_SB(1, 1), cB + hstep + kstep, voffB);
    PG8_WAIT_V(6); PG8_BAR;
    for (;;) {
        const bool has_next = S.next(ui + 1, nxt);
        const char* nA = has_next ? S.a_ptr(nxt) : cA; const char* nB = has_next ? S.b_ptr(nxt) : cB;
        if constexpr (GATHER) { if (has_next) S.a_off(nxt, R0, C0, nvA); }
#pragma unroll 1
        for (int t = 0; t < NT; t += 2) {
            const bool last = (t == NT - 2);
            const char* a1 = cA + (size_t)(t + 1) * kstep;
            const char* a2 = last ? nA : cA + (size_t)(t + 2) * kstep; const char* b2 = last ? nB : cB + (size_t)(t + 2) * kstep;
            const char* a3 = a2 + kstep; const char* b3 = b2 + kstep;
            PG8_LDB(B0, 0, 0); PG8_LDB(B1, 0, 1); PG8_SCHED; PG8_LDA(At, 0, 0); PG8_STAGE(PG8_SA(1, 1), a1, vA[1]);
            if constexpr (GATHER) { if (last && has_next) {
#pragma unroll
                for (int h = 0; h < 2; ++h)
#pragma unroll
                    for (int i = 0; i < 2; ++i) vA[h][i] = nvA[h][i]; } }
            PG8_WAIT_V(8); PG8_WAIT_L(0); PG8_BAR; PG8_MMA(0, 0, At, B0); PG8_MMA(0, 1, At, B1); PG8_BAR; PG8_SCHED;
            PG8_LDA(At, 0, 1); PG8_STAGE(PG8_SB(0, 0), b2, voffB); PG8_STAGE(PG8_SB(0, 1), b2 + hstep, voffB); PG8_STAGE(PG8_SA(0, 0), a2, vA[0]);
            PG8_WAIT_V(8); PG8_WAIT_L(0); PG8_BAR; PG8_MMA(1, 0, At, B0); PG8_MMA(1, 1, At, B1); PG8_BAR; PG8_SCHED;
            PG8_LDB(B0, 1, 0); PG8_LDB(B1, 1, 1); PG8_SCHED; PG8_LDA(At, 1, 0); PG8_STAGE(PG8_SA(0, 1), a2, vA[1]);
            PG8_WAIT_V(8); PG8_WAIT_L(0); PG8_BAR; PG8_MMA(0, 0, At, B0); PG8_MMA(0, 1, At, B1); PG8_BAR; PG8_SCHED;
            PG8_LDA(At, 1, 1); PG8_STAGE(PG8_SB(1, 0), b3, voffB); PG8_STAGE(PG8_SB(1, 1), b3 + hstep, voffB); PG8_STAGE(PG8_SA(1, 0), a3, vA[0]);
            PG8_WAIT_V(8); PG8_WAIT_L(0); PG8_BAR; PG8_MMA(1, 0, At, B0); PG8_MMA(1, 1, At, B1); PG8_BAR; PG8_SCHED;
        }
        if (wr == 0) PG8_BAR;
        { int le; asm volatile("v_mbcnt_lo_u32_b32 %0, -1, 0\n\tv_mbcnt_hi_u32_b32 %0, -1, %0" : "=v"(le)); E(acc, cur, wr, wc, le & 15, le >> 4); }
        if (!has_next) break;
#pragma unroll
        for (int a = 0; a < 2; ++a)
#pragma unroll
            for (int b = 0; b < 2; ++b)
#pragma unroll
                for (int m = 0; m < 4; ++m)
#pragma unroll
                    for (int n = 0; n < 2; ++n) acc[a][b][m][n] = (f32x4){0.f, 0.f, 0.f, 0.f};
        cur = nxt; cA = nA; cB = nB; ++ui;
        if (wr == 1) PG8_BAR;
    }
    PG8_WAIT_V(0);
    PG8_BAR;
#undef PG8_SA
#undef PG8_SB
#undef PG8_STAGE
#undef PG8_LDA
#undef PG8_LDB
#undef PG8_MMA
#undef PG8_WAIT_V
#undef PG8_WAIT_L
#undef PG8_BAR
#undef PG8_SCHED
}

struct DenseSched {
    const char* A; const char* Bt; int nM, nN, nwg, G, c;
    __device__ __forceinline__ void init(const void* A_, const void* Bt_, int M, int N, int G_, int c_) { A = (const char*)A_; Bt = (const char*)Bt_; nM = M / BM; nN = N / BM; nwg = nM * nN; G = G_; c = c_; }
    __device__ __forceinline__ bool next(int i, Unit& u) const {
        const long L = (long)i * G + c; if (L >= nwg) return false;
        int wgid = (int)L; { const int q = nwg / NXCD, r = nwg % NXCD, xcd = wgid % NXCD, off = wgid / NXCD; wgid = (xcd < r ? xcd * (q + 1) : r * (q + 1) + (xcd - r) * q) + off; }
        const int nig = WGM * nN, gid = wgid / nig, fm = gid * WGM, gsz = (nM - fm) < WGM ? (nM - fm) : WGM;
        u.pm = fm + ((wgid % nig) % gsz); u.pn = (wgid % nig) / gsz; u.e = 0; u.nvalid = 256; u.sbase = 0; return true;
    }
    __device__ __forceinline__ const char* a_ptr(const Unit& u) const { return A + (size_t)u.pm * (BM * K * 2); }
    __device__ __forceinline__ const char* b_ptr(const Unit& u) const { return Bt + (size_t)u.pn * (BM * K * 2); }
    __device__ __forceinline__ void a_off(const Unit&, int, int, unsigned (&)[2][2]) const {}
};
template <int NPN, bool GATHER_A, int KB> struct MoeSched {
    const char* A; const char* Bt; const int* slot; const LAS int* tab; int G, c; size_t bstride;
    __device__ __forceinline__ bool next(int i, Unit& u) const {
        const int ntile = __builtin_amdgcn_readfirstlane(tab[32]);
        int mtg;
        if ((G & 7) == 0) { const int x = c & 7, j = (c >> 3) + (G >> 3) * i; u.pn = j % NPN; mtg = (j / NPN) * 8 + x; if (mtg >= ntile) return false; }
        else { const int lin = i * G + c; if (lin >= ntile * NPN) return false; u.pn = lin % NPN; mtg = lin / NPN; }
        int e = 0;
        while (e < 31 && __builtin_amdgcn_readfirstlane(tab[e + 1]) <= mtg) ++e;
        const int mtl = mtg - __builtin_amdgcn_readfirstlane(tab[e]); int nv = __builtin_amdgcn_readfirstlane(tab[33 + e]) - 256 * mtl; nv = nv > 256 ? 256 : nv;
        u.pm = mtg; u.e = e; u.nvalid = nv; u.sbase = e * CAP + 256 * mtl; return true;
    }
    __device__ __forceinline__ const char* a_ptr(const Unit& u) const { return GATHER_A ? A : A + (size_t)u.pm * (BM * KB); }
    __device__ __forceinline__ const char* b_ptr(const Unit& u) const { return Bt + (size_t)u.e * bstride + (size_t)u.pn * (BM * KB); }
    __device__ __forceinline__ void a_off(const Unit& u, int R0, int C0, unsigned (&v)[2][2]) const {
#pragma unroll
        for (int h = 0; h < 2; ++h)
#pragma unroll
            for (int i = 0; i < 2; ++i) { const int rl = h * 128 + R0 + 64 * i; const int id = (rl < u.nvalid) ? slot[u.sbase + rl] : 0; v[h][i] = (unsigned)(id >> 2) * (unsigned)KB + (unsigned)C0 * 2u; }
    }
};
}

struct EpiInProj {
    static constexpr bool PERM = true;
    unsigned char* ws; const float* tab; const float* rope; int layer;
    template <int TYPE> __device__ __forceinline__ void run(const f32x4 (&acc)[2][2][4][2], const pg8::Unit& u, int wr, int wc, int fr, int fq) const {
        asm volatile("" : "+v"(fr), "+v"(fq));
        const int pn = u.pn, pm = u.pm; const bool ctx = pm >= 128;
        const int bb = ctx ? (pm - 128) : (pm >> 6);
#pragma unroll
        for (int ai = 0; ai < 2; ++ai)
#pragma unroll
            for (int m = 0; m < 4; ++m) {
                const int rl = 128 * ai + 64 * wr + 16 * m + fr; const int row = pm * 256 + rl;
                const int tt = ctx ? rl : (row & (T - 1));
                const int Lk = ctx ? tt : 256 + tt; const int ktile = Lk >> 6, krr = Lk & 63;
#pragma unroll
                for (int bj = 0; bj < 2; ++bj) {
                    const int np = 256 * pn + 128 * bj + 32 * wc + 8 * fq;
                    f32x4 v0 = acc[ai][bj][m][0], v1 = acc[ai][bj][m][1];
                    bf16_t* dst;
                    if (TYPE == 0) {
                        const int dir = np >= 384, col = np - 384 * dir;
                        const f32x4 l0 = *(const f32x4*)(tab + TB_LBT + layer * 384 + col), l1 = *(const f32x4*)(tab + TB_LBT + layer * 384 + col + 4);
#pragma unroll
                        for (int q = 0; q < 4; ++q) { v0[q] = (1.f - l0[q]) * sigmoidf_(-v0[q]); v1[q] = (1.f - l1[q]) * sigmoidf_(-v1[q]); }
                        dst = (bf16_t*)(ws + WS_SCAN + (size_t)(dir ? SC_KB : SC_KF) * SCAN_PITCH) + (size_t)row * 384 + col;
                    } else if (TYPE == 1 || TYPE == 2) {
                        f32x4 cs = (f32x4){1.f, 1.f, 1.f, 1.f}, sn = (f32x4){0.f, 0.f, 0.f, 0.f}; float sc;
                        if (TYPE == 1) {
                            const int m2 = np - 768; const int isk = m2 >= 384, col = m2 - 384 * isk; const int w0 = col & 63;
                            if (!ctx) { cs = *(const f32x4*)(rope + (size_t)tt * 32 + (w0 >> 1)); sn = *(const f32x4*)(rope + (size_t)T * 32 + (size_t)tt * 32 + (w0 >> 1)); }
                            sc = isk ? 0.125f : 1.f;
                            dst = (bf16_t*)(ws + WS_SCAN + (size_t)(isk ? SC_RK : SC_RQ) * SCAN_PITCH) + (size_t)row * 384 + col;
                        } else {
                            const int m3 = np - 1536; const int isk = m3 >= 256, col = m3 - 256 * isk; const int map = col >> 5, w0 = col & 31;
                            if (!ctx) { const float* tb = (w0 < 16) ? (tab + TB_AXR + (tt >> 6) * 8 + (w0 >> 1)) : (tab + TB_AXC + (tt & 63) * 8 + ((w0 - 16) >> 1));
                                        const int so = (w0 < 16) ? 2048 : 512; cs = *(const f32x4*)tb; sn = *(const f32x4*)(tb + so); }
                            sc = isk ? 1.f : 0.17677669529663687f * LOG2E * 4.f;
                            if (isk) dst = (bf16_t*)(ws + WS_KA) + ((size_t)((bb * 8 + map) * KT_TILES + ktile) * 4 + (w0 >> 3)) * 512 + krr * 8;
                            else if (ctx) dst = (bf16_t*)(ws + WS_QC) + ((size_t)(bb * 8 + map) * CL + tt) * 32 + w0;
                            else dst = (bf16_t*)(ws + WS_QA) + ((size_t)(bb * 8 + map) * T + tt) * 32 + w0;
                        }
                        f32x4 o0, o1;
                        o0[0] = (v0[0] * cs[0] - v0[1] * sn[0]) * sc; o0[1] = (v0[1] * cs[0] + v0[0] * sn[0]) * sc;
                        o0[2] = (v0[2] * cs[1] - v0[3] * sn[1]) * sc; o0[3] = (v0[3] * cs[1] + v0[2] * sn[1]) * sc;
                        o1[0] = (v1[0] * cs[2] - v1[1] * sn[2]) * sc; o1[1] = (v1[1] * cs[2] + v1[0] * sn[2]) * sc;
                        o1[2] = (v1[2] * cs[3] - v1[3] * sn[3]) * sc; o1[3] = (v1[3] * cs[3] + v1[2] * sn[3]) * sc;
                        v0 = o0; v1 = o1;
                    } else {
                        const int m4 = np - 2048; const int seg = m4 / 384, col = m4 - 384 * seg;
                        if (m4 >= 2176) continue;
                        if (seg < 5) dst = (bf16_t*)(ws + WS_SCAN + (size_t)(SC_HQ + seg) * SCAN_PITCH) + (size_t)row * 384 + col;
                        else { const int h4 = col >> 6, w0 = col & 63;
                               const int k5 = krr & 31; unsigned char* vb = ws + WS_VA + (size_t)((bb * 4 + h4) * KT_TILES + ktile) * 4096 + (krr >> 5) * 2048 + (w0 >> 5) * 1024 + ((k5 >> 2) & 1) * 512 + (w0 & 31) * 16 + (k5 & 3) + 4 * (k5 >> 3);
                               const unsigned wa = pk4_fp8(v0[0] * 16.f, v0[1] * 16.f, v0[2] * 16.f, v0[3] * 16.f), wb = pk4_fp8(v1[0] * 16.f, v1[1] * 16.f, v1[2] * 16.f, v1[3] * 16.f);
#pragma unroll
                               for (int i = 0; i < 4; ++i) { vb[16 * i] = (unsigned char)(wa >> (8 * i)); vb[64 + 16 * i] = (unsigned char)(wb >> (8 * i)); }
                               continue; }
                    }
                    u32x4 w; w.x = cvt_pk_bf16(v0[0], v0[1]); w.y = cvt_pk_bf16(v0[2], v0[3]); w.z = cvt_pk_bf16(v1[0], v1[1]); w.w = cvt_pk_bf16(v1[2], v1[3]);
                    *(u32x4*)dst = w;
                }
                if (m == 3) asm volatile("" ::: "memory");
            }
    }
    __device__ __forceinline__ void operator()(const f32x4 (&acc)[2][2][4][2], const pg8::Unit& u, int wr, int wc, int fr, int fq) const {
        if (u.pn < 3) run<0>(acc, u, wr, wc, fr, fq); else if (u.pn < 6) run<1>(acc, u, wr, wc, fr, fq); else if (u.pn < 8) run<2>(acc, u, wr, wc, fr, fq); else run<3>(acc, u, wr, wc, fr, fq);
    }
};
struct EpiBf16Out {
    static constexpr bool PERM = true;
    bf16_t* C;
    __device__ __forceinline__ void operator()(const f32x4 (&acc)[2][2][4][2], const pg8::Unit& u, int wr, int wc, int fr, int fq) const {
        asm volatile("" : "+v"(fr), "+v"(fq));
        const int row0 = u.pm * 256 + wr * 64 + fr, col0 = u.pn * 256 + wc * 32 + 8 * fq;
#pragma unroll
        for (int ai = 0; ai < 2; ++ai)
#pragma unroll
            for (int m = 0; m < 4; ++m) { bf16_t* rowp = C + (size_t)(row0 + ai * 128 + m * 16) * D + col0;
#pragma unroll
                for (int bj = 0; bj < 2; ++bj) { const f32x4 v0 = acc[ai][bj][m][0], v1 = acc[ai][bj][m][1];
                    u32x4 w; w.x = cvt_pk_bf16(v0[0], v0[1]); w.y = cvt_pk_bf16(v0[2], v0[3]); w.z = cvt_pk_bf16(v1[0], v1[1]); w.w = cvt_pk_bf16(v1[2], v1[3]);
                    *(u32x4*)(rowp + bj * 128) = w; } }
    }
};
struct EpiSwiglu {
    static constexpr bool PERM = true;
    unsigned char* act; const float* b1;
    __device__ __forceinline__ void operator()(const f32x4 (&acc)[2][2][4][2], const pg8::Unit& u, int wr, int wc, int fr, int fq) const {
        asm volatile("" : "+v"(fr), "+v"(fq));
        const int j0 = 128 * u.pn + 32 * wc + 8 * fq;
        const float* bp = b1 + (size_t)u.e * 2048 + 2 * j0;
        f32x4 bq[4];
#pragma unroll
        for (int q = 0; q < 4; ++q) bq[q] = *(const f32x4*)(bp + 4 * q);
#pragma unroll
        for (int ai = 0; ai < 2; ++ai)
#pragma unroll
            for (int m = 0; m < 4; ++m) {
                const int rl = 128 * ai + 64 * wr + 16 * m + fr;
                float o[8];
#pragma unroll
                for (int n = 0; n < 2; ++n)
#pragma unroll
                    for (int q = 0; q < 4; ++q) { const int j = 4 * n + q;
                        float g = acc[ai][0][m][n][q] + bq[j >> 1][(j & 1) * 2], l = acc[ai][1][m][n][q] + bq[j >> 1][(j & 1) * 2 + 1];
                        g = fminf(g, 7.f); l = fminf(fmaxf(l, -7.f), 7.f);
                        o[j] = g * sigmoidf_(1.702f * g) * (l + 1.f); }
                u32x2 w; w.x = pk4_fp8(o[0], o[1], o[2], o[3]); w.y = pk4_fp8(o[4], o[5], o[6], o[7]);
                *(u32x2*)(act + (size_t)(u.pm * 256 + rl) * 1024 + j0) = w;
            }
    }
};
struct EpiMoeOut {
    static constexpr bool PERM = true;
    bf16_t* ys; const float* b2; const float* sgate;
    __device__ __forceinline__ void operator()(const f32x4 (&acc)[2][2][4][2], const pg8::Unit& u, int wr, int wc, int fr, int fq) const {
        asm volatile("" : "+v"(fr), "+v"(fq));
        const int c0 = 256 * u.pn + 32 * wc + 8 * fq;
        const float* bp = b2 + (size_t)u.e * 1024 + c0;
        f32x4 bv[2][2];
#pragma unroll
        for (int bj = 0; bj < 2; ++bj)
#pragma unroll
            for (int n = 0; n < 2; ++n) bv[bj][n] = *(const f32x4*)(bp + 128 * bj + 4 * n);
#pragma unroll
        for (int ai = 0; ai < 2; ++ai)
#pragma unroll
            for (int m = 0; m < 4; ++m) {
                const int rl = 128 * ai + 64 * wr + 16 * m + fr;
                const float g = (rl < u.nvalid) ? sgate[u.sbase + rl] : 0.f;
                bf16_t* rowp = ys + (size_t)(u.pm * 256 + rl) * 1024 + c0;
#pragma unroll
                for (int bj = 0; bj < 2; ++bj) { const f32x4 v0 = (acc[ai][bj][m][0] + bv[bj][0]) * g, v1 = (acc[ai][bj][m][1] + bv[bj][1]) * g;
                    u32x4 w; w.x = cvt_pk_bf16(v0[0], v0[1]); w.y = cvt_pk_bf16(v0[2], v0[3]); w.z = cvt_pk_bf16(v1[0], v1[1]); w.w = cvt_pk_bf16(v1[2], v1[3]);
                    *(u32x4*)(rowp + 128 * bj) = w; }
            }
    }
};

__device__ __forceinline__ int map_in(int n) {
    if (n < 384) return 2048 + n;
    if (n < 768) return n - 384;
    if (n < 1152) return 384 + (n - 768);
    if (n < 1536) return 2048 + 384 + (n - 1152);
    if (n < 1920) return 2048 + 768 + (n - 1536);
    if (n < 2688) { const int isk = n >= 2304; const int c = n - 1920 - 384 * isk; const int h = c >> 6, w = c & 63; const int wp = (w < 32) ? 2 * w : 2 * (w - 32) + 1; return 768 + 384 * isk + h * 64 + wp; }
    if (n < 3072) return 2048 + 1152 + (n - 2688);
    if (n < 3456) return 2048 + 1536 + (n - 3072);
    if (n < 3968) { const int isk = n >= 3712; const int c = n - 3456 - 256 * isk; const int h = c >> 5, w = c & 31; const int half = w >> 4, uu = w & 15; const int up = (uu < 8) ? 2 * uu : 2 * (uu - 8) + 1; return 1536 + 256 * isk + h * 32 + half * 16 + up; }
    return 2048 + 1920 + (n - 3968);
}
__device__ __forceinline__ int map_w1(int n) { const int j = n >> 1, lin = n & 1; return (j >> 7) * 256 + lin * 128 + (j & 127); }
template <int MAP> __device__ __forceinline__ void p0_transpose_item(const float* W, int Kd, int N, bf16_t* WT, LAS float* scr, int item, int lane) {
    const int nblk = N / 32, kb = item / nblk, nb = item % nblk, k0 = 64 * kb, n0 = 32 * nb;
    { f32x4 rv[8];
#pragma unroll
      for (int i = 0; i < 8; ++i) rv[i] = *(const f32x4*)(W + (size_t)(k0 + (lane >> 3) + 8 * i) * N + n0 + 4 * (lane & 7));
#pragma unroll
      for (int i = 0; i < 8; ++i) { LAS float* sp_ = scr + ((lane >> 3) + 8 * i) * 33 + 4 * (lane & 7); sp_[0] = rv[i][0]; sp_[1] = rv[i][1]; sp_[2] = rv[i][2]; sp_[3] = rv[i][3]; } }
    LDS_WAIT(); asm volatile("" ::: "memory");
    const int c = lane & 7;
#pragma unroll
    for (int j = 0; j < 4; ++j) { const int n = (lane >> 3) + 8 * j; const LAS float* s = scr + (8 * c) * 33 + n;
        u32x4 o; o.x = pk2(s[0 * 33], s[1 * 33]); o.y = pk2(s[2 * 33], s[3 * 33]); o.z = pk2(s[4 * 33], s[5 * 33]); o.w = pk2(s[6 * 33], s[7 * 33]);
        const int nn = n0 + n; const int dr = MAP == 1 ? map_in(nn) : (MAP == 2 ? map_w1(nn) : nn);
        *(u32x4*)(WT + (size_t)dr * Kd + k0 + 8 * c) = o; }
    LDS_WAIT(); asm volatile("" ::: "memory");
}
template <int MAP> __device__ __forceinline__ void p0_transpose_item_fp8(const float* W, int Kd, int N, unsigned char* WT, LAS float* scr, int item, int lane) {
    const int nblk = N / 32, kb = item / nblk, nb = item % nblk, k0 = 64 * kb, n0 = 32 * nb;
    { f32x4 rv[8];
#pragma unroll
      for (int i = 0; i < 8; ++i) rv[i] = *(const f32x4*)(W + (size_t)(k0 + (lane >> 3) + 8 * i) * N + n0 + 4 * (lane & 7));
#pragma unroll
      for (int i = 0; i < 8; ++i) { LAS float* sp_ = scr + ((lane >> 3) + 8 * i) * 33 + 4 * (lane & 7); sp_[0] = rv[i][0]; sp_[1] = rv[i][1]; sp_[2] = rv[i][2]; sp_[3] = rv[i][3]; } }
    LDS_WAIT(); asm volatile("" ::: "memory");
    const int n = lane >> 1, hf = lane & 1; const LAS float* sp = scr + (32 * hf) * 33 + n;
    u32x4 o0, o1;
#pragma unroll
    for (int q = 0; q < 4; ++q) { o0[q] = pk4_fp8(sp[(4 * q) * 33] * W8_MUL, sp[(4 * q + 1) * 33] * W8_MUL, sp[(4 * q + 2) * 33] * W8_MUL, sp[(4 * q + 3) * 33] * W8_MUL);
                                  o1[q] = pk4_fp8(sp[(16 + 4 * q) * 33] * W8_MUL, sp[(16 + 4 * q + 1) * 33] * W8_MUL, sp[(16 + 4 * q + 2) * 33] * W8_MUL, sp[(16 + 4 * q + 3) * 33] * W8_MUL); }
    const int nn = n0 + n; const int dr = MAP == 2 ? map_w1(nn) : nn;
    unsigned char* dp = WT + (size_t)dr * Kd + k0 + 32 * hf;
    *(u32x4*)dp = o0; *(u32x4*)(dp + 16) = o1;
    LDS_WAIT(); asm volatile("" ::: "memory");
}
__device__ __forceinline__ void phase_prologue_a(Frame& F) {
    PHASE_IDS();
    LAS float* scr = (LAS float*)(F.lds + wave * 16384);
    const int gw = blk_ * NWAVES + wave, NGW = F.G * NWAVES;
    unsigned char* ws = F.ws;
    constexpr int I_IN = 16 * 132, I_OUT = 16 * 32, I_W1 = 16 * 64, I_W2 = 16 * 32;
    constexpr int PER_L = I_IN + I_OUT + NE * (I_W1 + I_W2);
    for (int it = gw; it < 2 * PER_L; it += NGW) {
        const int l = it / PER_L; int r = it % PER_L;
        if (r < I_IN) { p0_transpose_item<1>(F.in[7] + (size_t)l * 1024 * 4224, 1024, 4224, (bf16_t*)(ws + WS_WIN) + (size_t)l * NIN * 1024, scr, r, lane); continue; } r -= I_IN;
        if (r < I_OUT) { p0_transpose_item<0>(F.in[14] + (size_t)l * 1024 * 1024, 1024, 1024, (bf16_t*)(ws + WS_WOUT) + (size_t)l * 1024 * 1024, scr, r, lane); continue; } r -= I_OUT;
        const int e = r / (I_W1 + I_W2); r -= e * (I_W1 + I_W2);
        if (r < I_W1) p0_transpose_item_fp8<2>(F.in[17] + ((size_t)l * NE + e) * 1024 * 2048, 1024, 2048, ws + WS_W1 + ((size_t)l * NE + e) * 2048 * 1024, scr, r, lane);
        else p0_transpose_item_fp8<0>(F.in[19] + ((size_t)l * NE + e) * 1024 * 1024, 1024, 1024, ws + WS_W2 + ((size_t)l * NE + e) * 1024 * 1024, scr, r - I_W1, lane);
    }
    for (int i = gw * 64 + lane; i < 2 * 128 * 1024 / 8; i += NGW * 64) { const int l = i / (128 * 128), rr = i % (128 * 128);
        *(u32x4*)((bf16_t*)(ws + WS_WIN) + ((size_t)l * NIN + 4224) * 1024 + (size_t)rr * 8) = (u32x4){0u, 0u, 0u, 0u}; }
    for (int it = gw; it < 2 * 96; it += NGW) {
        const int l = it / 96, n0 = (it % 96) * 64, n = n0 + lane;
        const float* mw = F.in[4] + (size_t)l * 1024 * 6144;
        float a0 = 0.f, a1 = 0.f, a2 = 0.f;
        for (int kb = 0; kb < 16; ++kb) {
            const int kk = kb * 64 + lane;
            float c0 = F.in[1][kk], c1 = F.in[1][1024 + kk], c2 = F.in[3][kk];
            c0 = c0 * sigmoidf_(c0); c1 = c1 * sigmoidf_(c1); c2 = c2 * sigmoidf_(c2);
#pragma unroll 8
            for (int j = 0; j < 64; ++j) { const float w = mw[(size_t)(kb * 64 + j) * 6144 + n]; a0 += rdlane(c0, j) * w; a1 += rdlane(c1, j) * w; a2 += rdlane(c2, j) * w; }
        }
        const float bias = F.in[5][l * 6144 + n];
        const int ch = n >> 10, col = n & 1023;
        const float* ng = F.in[6] + (size_t)l * 4096;
        float vals[3] = {a0 + bias, a1 + bias, a2 + bias};
#pragma unroll
        for (int w = 0; w < 3; ++w) { float v = vals[w];
            if (ch == 1) v = (1.f + v) * ng[col]; else if (ch == 2) v = v * ng[1024 + col]; else if (ch == 4) v = (1.f + v) * ng[2048 + col]; else if (ch == 5) v = v * ng[3072 + col];
            const int slot = (ch == 0) ? 1 : (ch == 1) ? 0 : (ch == 2) ? 2 : (ch == 3) ? 4 : (ch == 4) ? 3 : 5;
            ((float*)(ws + WS_MODV))[((size_t)(l * 3 + w) * 6 + slot) * 1024 + col] = v; }
    }
    float* tab = (float*)(ws + WS_TAB);
    const int gt = blk_ * NTHR + tid, NGT = F.G * NTHR;
    for (int i = gt; i < 2 * 384; i += NGT) { const int l = i / 384, c = i % 384; const float a = F.in[8][c], b = F.in[8][384 + c];
        tab[TB_LBT + i] = (l == 0) ? 0.f : 1.f / (1.f + expf(a - b)); }
    if (gt < 2) { const int l = gt; const float* lm = F.in[12] + l * 128; float s0 = 0.f, s1 = 0.f;
        for (int i = 0; i < 32; ++i) { s0 += lm[i] * lm[32 + i]; s1 += lm[64 + i] * lm[96 + i]; }
        const float li = 0.8f - 0.6f * expf(-0.3f * (float)l);
        tab[TB_LAM + l] = expf(s0) - expf(s1) + li; tab[TB_LAM + 2 + l] = 1.f - li; }
    if (gt < 24) tab[TB_GAM + gt] = 1.f - exp2f(-F.in[10][gt]);
    for (int i = gt; i < 256 * 8 + 64 * 8; i += NGT) {
        const bool isr = i < 2048; const int ii = isr ? i : i - 2048; const int pos = ii >> 3, j = ii & 7;
        const float inv = exp2f(-(float)j * (13.287712379549449f / 8.f));
        const double rev = (double)pos * (double)inv * 0.15915494309189535; const float fr = (float)(rev - floor(rev));
        const float cs = __builtin_amdgcn_cosf(fr), sn = __builtin_amdgcn_sinf(fr);
        if (isr) { tab[TB_AXR + ii] = cs; tab[TB_AXR + 2048 + ii] = sn; } else { tab[TB_AXC + ii] = cs; tab[TB_AXC + 512 + ii] = sn; }
    }
    float* rope = (float*)(ws + WS_ROPE);
    for (int i = gt; i < T * 32; i += NGT) { const int pos = i >> 5, j = i & 31;
        const float inv = exp2f(-(float)j * (13.287712379549449f / 32.f));
        const double rev = (double)pos * (double)inv * 0.15915494309189535; const float fr = (float)(rev - floor(rev));
        rope[i] = __builtin_amdgcn_cosf(fr); rope[(size_t)T * 32 + i] = __builtin_amdgcn_sinf(fr); }
    bf16_t* rwh = (bf16_t*)(ws + WS_RWT); bf16_t* rwl = rwh + 2 * 32 * 1024;
    for (int i = gt; i < 2 * 32 * 1024; i += NGT) { const int l = i >> 15, e = (i >> 10) & 31, c = i & 1023; const float wv = F.in[15][((size_t)l * 1024 + c) * 32 + e];
        const unsigned hb = f2bf(wv); rwh[i] = (bf16_t)hb; rwl[i] = (bf16_t)f2bf(wv - __builtin_bit_cast(float, hb << 16)); }
}

__device__ __forceinline__ float row_sumsq(const f32x4 (&v)[4]) {
    float s = 0.f;
#pragma unroll
    for (int j = 0; j < 4; ++j) s += (v[j][0] * v[j][0] + v[j][1] * v[j][1]) + (v[j][2] * v[j][2] + v[j][3] * v[j][3]);
    return wave_sum(s);
}
__device__ __forceinline__ void row_load(const float* p, int lane, f32x4 (&v)[4]) {
#pragma unroll
    for (int j = 0; j < 4; ++j) v[j] = *(const f32x4*)(p + 4 * lane + 256 * j);
}
__device__ __forceinline__ void row_store(float* p, int lane, const f32x4 (&v)[4]) {
#pragma unroll
    for (int j = 0; j < 4; ++j) *(f32x4*)(p + 4 * lane + 256 * j) = v[j];
}
__device__ __forceinline__ void row_store_bf16(bf16_t* p, int lane, const f32x4 (&v)[4]) {
#pragma unroll
    for (int j = 0; j < 4; ++j) { u32x2 w; w.x = pk2(v[j][0], v[j][1]); w.y = pk2(v[j][2], v[j][3]); *(u32x2*)(p + 4 * lane + 256 * j) = w; }
}
__device__ __forceinline__ int row_which(int r) { return r < NLAT ? (r >> 14) : 2; }
__device__ __forceinline__ void row_norm_mod(const f32x4 (&x)[4], const float* a, const float* b, int lane, f32x4 (&o)[4]) {
    const float r = __builtin_amdgcn_rsqf(row_sumsq(x) * (1.f / 1024.f) + EPS);
#pragma unroll
    for (int j = 0; j < 4; ++j) { const f32x4 av = *(const f32x4*)(a + 4 * lane + 256 * j), bv = *(const f32x4*)(b + 4 * lane + 256 * j); o[j] = x[j] * r * av + bv; }
}
__device__ __forceinline__ void phase_prologue_b(Frame& F) {
    PHASE_IDS();
    const int gw = blk_ * NWAVES + wave, NGW = F.G * NWAVES;
    const float* modv = (const float*)(F.ws + WS_MODV);
    for (int r = gw; r < NROW; r += NGW) {
        const float* src = r < NLAT ? F.in[0] + (size_t)r * D : F.in[2] + (size_t)(r - NLAT) * D;
        const int w = row_which(r);
        f32x4 x[4], o[4]; row_load(src, lane, x);
        row_norm_mod(x, modv + (size_t)(0 * 3 + w) * 6 * 1024, modv + ((size_t)(0 * 3 + w) * 6 + 1) * 1024, lane, o);
        row_store_bf16((bf16_t*)(F.ws + WS_H) + (size_t)r * D, lane, o);
    }
}

__device__ __forceinline__ int scan_row(int sc, int p, int dir, int b) {
    if (sc == 0) return NLAT + b * CL + (dir ? (CL - 1 - p) : p);
    const int tt = (sc - 1) * 256 + p; return b * T + (dir ? (T - 1 - tt) : tt);
}
template <int TYPE, bool WITHQ>
__device__ __forceinline__ float scan_step(float (&S)[64], const LAS float* kq, float vv, float gam) {
    float o = 0.f;
#pragma unroll
    for (int kg = 0; kg < 8; ++kg) {
        f32x4 kv[2], qv[2];
#pragma unroll
        for (int j = 0; j < 2; ++j) { kv[j] = *(const LAS f32x4*)(kq + kg * 8 + 4 * j); if (WITHQ) qv[j] = *(const LAS f32x4*)(kq + 64 + kg * 8 + 4 * j); }
#pragma unroll
        for (int j = 0; j < 8; ++j) { const int k = kg * 8 + j; const float kk = kv[j >> 2][j & 3];
            if (TYPE == 0) S[k] = __builtin_fmaf(kk, vv - S[k], S[k]); else S[k] = __builtin_fmaf(kk, vv, gam * S[k]);
            if (WITHQ) o = __builtin_fmaf(qv[j >> 2][j & 3], S[k], o); }
        asm volatile("" ::: "memory"); __builtin_amdgcn_sched_barrier(0);
    }
    return o;
}
__device__ __forceinline__ void phase_scan_a(Frame& F, int layer) {
    PHASE_IDS();
    const int gw = blk_ * NWAVES + wave, NGW = F.G * NWAVES;
    const float* tab = (const float*)(F.ws + WS_TAB);
    LAS float* scr = (LAS float*)(F.lds + wave * 2048);
    for (int wu = gw; wu < NSEQ * NSC; wu += NGW) {
        const int s = wu / NSC, sc = wu % NSC; const int type = s / 24, rem = s % 24, b = rem / 12, h = (rem % 12) >> 1, dir = rem & 1;
        const bf16_t* Kb = (const bf16_t*)(F.ws + WS_SCAN + (size_t)(type ? SC_RK : (dir ? SC_KB : SC_KF)) * SCAN_PITCH);
        const bf16_t* Vb = (const bf16_t*)(F.ws + WS_SCAN + (size_t)(type ? SC_RV : SC_HV) * SCAN_PITCH);
        unsigned co = (unsigned)(h * 64 + lane); asm volatile("" : "+v"(co));
        const float gam = tab[TB_GAM + layer * 12 + dir * 6 + h];
        float S[64];
#pragma unroll
        for (int k = 0; k < 64; ++k) S[k] = 0.f;
        float dprod = 1.f;
        float kc[4], vc[4], kn[4], vn[4];
#pragma unroll
        for (int i = 0; i < 4; ++i) { const unsigned ro = (unsigned)scan_row(sc, i, dir, b) * 384u + co; kc[i] = bf2f(Kb[ro]); vc[i] = bf2f(Vb[ro]); kn[i] = 0.f; vn[i] = 0.f; }
        for (int p0 = 0; p0 < 256; p0 += 4) {
            if (p0 + 4 < 256) {
#pragma unroll
                for (int i = 0; i < 4; ++i) { const unsigned ro = (unsigned)scan_row(sc, p0 + 4 + i, dir, b) * 384u + co; kn[i] = bf2f(Kb[ro]); vn[i] = bf2f(Vb[ro]); }
            }
#pragma unroll
            for (int i = 0; i < 4; ++i) scr[i * 128 + lane] = kc[i];
#pragma unroll
            for (int i = 0; i < 4; ++i) {
                if (type == 0) { dprod *= (1.f - kc[i]); (void)scan_step<0, false>(S, scr + i * 128, vc[i], gam); }
                else { dprod *= gam; (void)scan_step<1, false>(S, scr + i * 128, vc[i], gam); }
            }
#pragma unroll
            for (int i = 0; i < 4; ++i) { kc[i] = kn[i]; vc[i] = vn[i]; }
        }
        float* sl = (float*)(F.ws + WS_SLOC) + (size_t)wu * 4096 + lane;
#pragma unroll
        for (int k = 0; k < 64; ++k) { *sl = S[k]; sl += 64; asm volatile("" : "+v"(sl)); }
        ((float*)(F.ws + WS_DEC))[(size_t)wu * 64 + lane] = dprod;
    }
}
__device__ __forceinline__ void phase_scan_b(Frame& F) {
    const float* sloc = (const float*)(F.ws + WS_SLOC); const float* dec = (const float*)(F.ws + WS_DEC); float* sin_ = (float*)(F.ws + WS_SIN);
    PHASE_IDS();
    for (int idx = blk_ * NTHR + tid; idx < NSEQ * 4096; idx += F.G * NTHR) {
        const int s = idx >> 12, kv = idx & 4095, k = kv >> 6; float st = 0.f;
#pragma unroll 8
        for (int sc = 0; sc < NSC - 1; ++sc) { const size_t u = (size_t)s * NSC + sc; st = dec[u * 64 + k] * st + sloc[u * 4096 + kv]; sin_[(u + 1) * 4096 + kv] = st; }
    }
}
template <int TYPE, bool SECOND>
__device__ __forceinline__ void scan_dir(Frame& F, int lane_in, int wave, int layer, int b, int h, int dir, int sc, bool zero_state) {
    int lane = lane_in; asm volatile("" : "+v"(lane));
    const float* tab = (const float*)(F.ws + WS_TAB);
    const int s = TYPE * 24 + b * 12 + h * 2 + dir;
    const bf16_t* Kb = (const bf16_t*)(F.ws + WS_SCAN + (size_t)(TYPE ? SC_RK : (dir ? SC_KB : SC_KF)) * SCAN_PITCH);
    const bf16_t* Vb = (const bf16_t*)(F.ws + WS_SCAN + (size_t)(TYPE ? SC_RV : SC_HV) * SCAN_PITCH);
    const bf16_t* Qb = (const bf16_t*)(F.ws + WS_SCAN + (size_t)(TYPE ? SC_RQ : SC_HQ) * SCAN_PITCH);
    const bf16_t* Gb = (const bf16_t*)(F.ws + WS_SCAN + (size_t)(TYPE ? SC_RG : SC_HG) * SCAN_PITCH);
    float* oscr = (float*)(F.ws + WS_OSCR);
    bf16_t* mix = (bf16_t*)(F.ws + WS_MIX);
    unsigned co = (unsigned)(h * 64 + lane); asm volatile("" : "+v"(co));
    const unsigned co2 = co + TYPE * 384;
    const float gam = tab[TB_GAM + layer * 12 + dir * 6 + h];
    const float nw = F.in[TYPE ? 11 : 9][layer * 64 + lane];
    LAS float* scr = (LAS float*)(F.lds + wave * 2048);
    float S[64];
    if (zero_state) {
#pragma unroll
        for (int k = 0; k < 64; ++k) S[k] = 0.f;
    } else { const float* si = (const float*)(F.ws + WS_SIN) + ((size_t)s * NSC + sc) * 4096 + lane;
#pragma unroll
        for (int k = 0; k < 64; ++k) { S[k] = *si; si += 64; asm volatile("" : "+v"(si)); } }
    float kc[2], vc[2], qc[2], kn[2], vn[2], qn[2];
#pragma unroll
    for (int i = 0; i < 2; ++i) { const unsigned ro = (unsigned)scan_row(sc, i, dir, b) * 384u + co; kc[i] = bf2f(Kb[ro]); vc[i] = bf2f(Vb[ro]); qc[i] = bf2f(Qb[ro]); kn[i] = 0.f; vn[i] = 0.f; qn[i] = 0.f; }
    for (int p0 = 0; p0 < 256; p0 += 2) {
        if (p0 + 2 < 256) {
#pragma unroll
            for (int i = 0; i < 2; ++i) { const unsigned ro = (unsigned)scan_row(sc, p0 + 2 + i, dir, b) * 384u + co; kn[i] = bf2f(Kb[ro]); vn[i] = bf2f(Vb[ro]); qn[i] = bf2f(Qb[ro]); }
        }
#pragma unroll
        for (int i = 0; i < 2; ++i) { scr[i * 128 + lane] = kc[i]; scr[i * 128 + 64 + lane] = qc[i]; }
#pragma unroll
        for (int i = 0; i < 2; ++i) {
            float o = scan_step<TYPE, true>(S, scr + i * 128, vc[i], gam);
            const unsigned row = (unsigned)scan_row(sc, p0 + i, dir, b);
            if (!SECOND) oscr[row * 768u + co2] = o;
            else { o += oscr[row * 768u + co2];
                const float r = __builtin_amdgcn_rsqf(wave_sum_dpp(o * o) * (1.f / 64.f) + EPS);
                const float g = bf2f(Gb[row * 384u + co]);
                mix[row * 1024u + co2] = (bf16_t)f2bf(o * r * nw * g * sigmoidf_(g)); }
            asm volatile("" ::: "memory");
        }
#pragma unroll
        for (int i = 0; i < 2; ++i) { kc[i] = kn[i]; vc[i] = vn[i]; qc[i] = qn[i]; }
    }
}
__device__ __forceinline__ void phase_scan_c(Frame& F, int layer) {
    PHASE_IDS();
    const int gw = blk_ * NWAVES + wave, NGW = F.G * NWAVES;
    const bool need_ctx = layer == 0;
    for (int wu = gw; wu < 24 * NSC; wu += NGW) {
        const int sq = wu / NSC, blk = wu % NSC; const int type = sq / 12, b = (sq % 12) / 6, h = sq % 6;
        if (blk == 0 && !need_ctx) continue;
        const int scf = blk, scb = (blk == 0) ? 0 : 65 - blk;
        if (type == 0) { scan_dir<0, false>(F, lane, wave, layer, b, h, 0, scf, scf == 0); scan_dir<0, true>(F, lane, wave, layer, b, h, 1, scb, scb == 0); }
        else           { scan_dir<1, false>(F, lane, wave, layer, b, h, 0, scf, scf == 0); scan_dir<1, true>(F, lane, wave, layer, b, h, 1, scb, scb == 0); }
    }
}


namespace sc2 {
constexpr int WLDS = 8448;
__device__ __forceinline__ f32x4 mfma16(bf16x8 a, bf16x8 b, f32x4 c) { return __builtin_amdgcn_mfma_f32_16x16x32_bf16(a, b, c, 0, 0, 0); }
template <int TYPE, int MODE>
__device__ __forceinline__ void run(Frame& F, int lane_in, int wave, int layer, int b, int h, int dir, int sc, bool zero_state, int wu_out) {
    int lane = lane_in; asm volatile("" : "+v"(lane));
    const int g = lane >> 4, n = lane & 15;
    const float* tab = (const float*)(F.ws + WS_TAB);
    const int s = TYPE * 24 + b * 12 + h * 2 + dir;
    const bf16_t* Kb = (const bf16_t*)(F.ws + WS_SCAN + (size_t)(TYPE ? SC_RK : (dir ? SC_KB : SC_KF)) * SCAN_PITCH);
    const bf16_t* Vb = (const bf16_t*)(F.ws + WS_SCAN + (size_t)(TYPE ? SC_RV : SC_HV) * SCAN_PITCH);
    const bf16_t* Qb = (const bf16_t*)(F.ws + WS_SCAN + (size_t)(TYPE ? SC_RQ : SC_HQ) * SCAN_PITCH);
    const bf16_t* Gb = (const bf16_t*)(F.ws + WS_SCAN + (size_t)(TYPE ? SC_RG : SC_HG) * SCAN_PITCH);
    float* oscr = (float*)(F.ws + WS_OSCR);
    bf16_t* mix = (bf16_t*)(F.ws + WS_MIX);
    const unsigned co = (unsigned)(h * 64 + lane);
    const float lg2 = TYPE ? __builtin_amdgcn_logf(tab[TB_GAM + layer * 12 + dir * 6 + h]) : 0.f;
    LAS unsigned char* wl = F.lds + wave * WLDS;
    LAS bf16_t* QT = (LAS bf16_t*)wl; LAS bf16_t* KT = (LAS bf16_t*)(wl + 2048); LAS bf16_t* KPT = (LAS bf16_t*)(wl + 4096); LAS bf16_t* VT = (LAS bf16_t*)(wl + 6144); LAS float* DD = (LAS float*)(wl + 8192);
    f32x4 S[4][4];
    if (zero_state) {
#pragma unroll
        for (int kb = 0; kb < 4; ++kb)
#pragma unroll
            for (int vb = 0; vb < 4; ++vb) S[kb][vb] = (f32x4){0.f, 0.f, 0.f, 0.f};
    } else { const float* si = (const float*)(F.ws + WS_SIN) + ((size_t)s * NSC + sc) * 4096;
#pragma unroll
        for (int kb = 0; kb < 4; ++kb)
#pragma unroll
            for (int vb = 0; vb < 4; ++vb)
#pragma unroll
                for (int r = 0; r < 4; ++r) S[kb][vb][r] = si[(16 * kb + 4 * g + r) * 64 + 16 * vb + n]; }
    float dtot = 1.f;
    const float gam = TYPE ? tab[TB_GAM + layer * 12 + dir * 6 + h] : 0.f;
    unsigned short kr[16], vr[16], qr[16];
#pragma unroll
    for (int t = 0; t < 16; ++t) { const unsigned ro = (unsigned)scan_row(sc, t, dir, b) * 384u + co; kr[t] = Kb[ro]; vr[t] = Vb[ro]; if (MODE != 0) qr[t] = Qb[ro]; else qr[t] = 0; }
    for (int blk = 0; blk < 16; ++blk) {
        const unsigned row = (unsigned)scan_row(sc, 16 * blk + n, dir, b);
        const unsigned ob = row * 768u + (unsigned)(TYPE * 384 + h * 64 + 4 * g);
        f32x4 of[4]; u32x2 gg[4];
        if (MODE == 2) {
#pragma unroll
            for (int vb = 0; vb < 4; ++vb) { of[vb] = *(const f32x4*)(oscr + ob + 16 * vb); gg[vb] = *(const u32x2*)(Gb + row * 384u + (unsigned)(h * 64 + 16 * vb + 4 * g)); }
        }
        float ek[16]; float eq = 1.f;
#pragma unroll
        for (int t = 0; t < 16; ++t) { const float kk = bf2f(kr[t]);
            eq = fmaxf(eq * (TYPE == 0 ? 1.f - kk : gam), 7.9e-31f);
            ek[t] = __builtin_amdgcn_rcpf(eq);
            if (MODE != 0) { QT[t * 64 + lane] = (bf16_t)f2bf(bf2f(qr[t]) * eq); KT[t * 64 + lane] = (bf16_t)f2bf(kk * ek[t]); } }
        dtot *= eq; DD[lane] = eq;
        { u32x4 w0, w1, x0, x1;
#pragma unroll
          for (int q = 0; q < 4; ++q) {
              w0[q] = cvt_pk_bf16(bf2f(kr[2 * q]) * (eq * ek[2 * q]), bf2f(kr[2 * q + 1]) * (eq * ek[2 * q + 1]));
              w1[q] = cvt_pk_bf16(bf2f(kr[8 + 2 * q]) * (eq * ek[8 + 2 * q]), bf2f(kr[8 + 2 * q + 1]) * (eq * ek[8 + 2 * q + 1]));
              x0[q] = (unsigned)vr[2 * q] | ((unsigned)vr[2 * q + 1] << 16); x1[q] = (unsigned)vr[8 + 2 * q] | ((unsigned)vr[8 + 2 * q + 1] << 16); }
          *(LAS u32x4*)(KPT + lane * 16) = w0; *(LAS u32x4*)(KPT + lane * 16 + 8) = w1; *(LAS u32x4*)(VT + lane * 16) = x0; *(LAS u32x4*)(VT + lane * 16 + 8) = x1; }
        if (blk + 1 < 16) {
#pragma unroll
            for (int t = 0; t < 16; ++t) { const unsigned ro = (unsigned)scan_row(sc, 16 * (blk + 1) + t, dir, b) * 384u + co; kr[t] = Kb[ro]; vr[t] = Vb[ro]; if (MODE != 0) qr[t] = Qb[ro]; }
        }
        asm volatile("s_waitcnt lgkmcnt(0)" ::: "memory");
        if (MODE != 0) {
            f32x4 sct = (f32x4){0.f, 0.f, 0.f, 0.f};
#pragma unroll
            for (int ks = 0; ks < 2; ++ks) { const bf16x8 a = *(const LAS bf16x8*)(KT + n * 64 + 32 * ks + 8 * g), bq = *(const LAS bf16x8*)(QT + n * 64 + 32 * ks + 8 * g); sct = mfma16(a, bq, sct); }
#pragma unroll
            for (int r = 0; r < 4; ++r) sct[r] = (4 * g + r <= n) ? sct[r] : 0.f;
            u32x4 bs; bs.x = cvt_pk_bf16(sct[0], sct[1]); bs.y = cvt_pk_bf16(sct[2], sct[3]); bs.z = 0u; bs.w = 0u;
            f32x4 o[4];
#pragma unroll
            for (int vb = 0; vb < 4; ++vb) { const u32x2 lo = *(const LAS u32x2*)(VT + (16 * vb + n) * 16 + 4 * g); u32x4 av; av.x = lo.x; av.y = lo.y; av.z = 0u; av.w = 0u;
                o[vb] = mfma16(__builtin_bit_cast(bf16x8, av), __builtin_bit_cast(bf16x8, bs), (f32x4){0.f, 0.f, 0.f, 0.f}); }
#pragma unroll
            for (int ks = 0; ks < 2; ++ks) {
                const u32x2 q0 = *(const LAS u32x2*)(QT + n * 64 + 32 * ks + 4 * g), q1 = *(const LAS u32x2*)(QT + n * 64 + 32 * ks + 16 + 4 * g);
                u32x4 bq; bq.x = q0.x; bq.y = q0.y; bq.z = q1.x; bq.w = q1.y;
#pragma unroll
                for (int vb = 0; vb < 4; ++vb) { u32x4 av; av.x = cvt_pk_bf16(S[2 * ks][vb][0], S[2 * ks][vb][1]); av.y = cvt_pk_bf16(S[2 * ks][vb][2], S[2 * ks][vb][3]);
                    av.z = cvt_pk_bf16(S[2 * ks + 1][vb][0], S[2 * ks + 1][vb][1]); av.w = cvt_pk_bf16(S[2 * ks + 1][vb][2], S[2 * ks + 1][vb][3]);
                    o[vb] = mfma16(__builtin_bit_cast(bf16x8, av), __builtin_bit_cast(bf16x8, bq), o[vb]); }
            }
            if (MODE == 1) {
#pragma unroll
                for (int vb = 0; vb < 4; ++vb) *(f32x4*)(oscr + ob + 16 * vb) = o[vb];
            } else {
                float ss = 0.f;
#pragma unroll
                for (int vb = 0; vb < 4; ++vb) { o[vb] = o[vb] + of[vb]; ss += (o[vb][0] * o[vb][0] + o[vb][1] * o[vb][1]) + (o[vb][2] * o[vb][2] + o[vb][3] * o[vb][3]); }
                ss += xor_swz<16>(ss); ss += xor32(ss, lane);
                const float rn = __builtin_amdgcn_rsqf(ss * (1.f / 64.f) + EPS);
                const float* nw = F.in[TYPE ? 11 : 9] + layer * 64 + 4 * g;
#pragma unroll
                for (int vb = 0; vb < 4; ++vb) { const f32x4 w4 = *(const f32x4*)(nw + 16 * vb);
                    const float g0 = bflo(gg[vb].x), g1 = bfhi(gg[vb].x), g2 = bflo(gg[vb].y), g3 = bfhi(gg[vb].y);
                    u32x2 w; w.x = cvt_pk_bf16(o[vb][0] * rn * w4[0] * g0 * sigmoidf_(g0), o[vb][1] * rn * w4[1] * g1 * sigmoidf_(g1)); w.y = cvt_pk_bf16(o[vb][2] * rn * w4[2] * g2 * sigmoidf_(g2), o[vb][3] * rn * w4[3] * g3 * sigmoidf_(g3));
                    *(u32x2*)(mix + row * 1024u + (unsigned)(TYPE * 384 + h * 64 + 16 * vb + 4 * g)) = w; }
            }
        }
#pragma unroll
        for (int kb = 0; kb < 4; ++kb) { const f32x4 d4 = *(const LAS f32x4*)(DD + 16 * kb + 4 * g);
#pragma unroll
            for (int vb = 0; vb < 4; ++vb) S[kb][vb] = S[kb][vb] * d4; }
        { bf16x8 af[4], bfv[4];
#pragma unroll
          for (int q = 0; q < 4; ++q) { u32x4 a = *(const LAS u32x4*)(KPT + (16 * q + n) * 16 + 8 * (g & 1)), bq = *(const LAS u32x4*)(VT + (16 * q + n) * 16 + 8 * (g & 1));
              if (g >= 2) { a = (u32x4){0u, 0u, 0u, 0u}; bq = (u32x4){0u, 0u, 0u, 0u}; }
              af[q] = __builtin_bit_cast(bf16x8, a); bfv[q] = __builtin_bit_cast(bf16x8, bq); }
#pragma unroll
          for (int kb = 0; kb < 4; ++kb)
#pragma unroll
              for (int vb = 0; vb < 4; ++vb) S[kb][vb] = mfma16(af[kb], bfv[vb], S[kb][vb]); }
        asm volatile("s_waitcnt lgkmcnt(0)" ::: "memory");
    }
    if (MODE == 0) {
        float* sl = (float*)(F.ws + WS_SLOC) + (size_t)wu_out * 4096;
#pragma unroll
        for (int kb = 0; kb < 4; ++kb)
#pragma unroll
            for (int vb = 0; vb < 4; ++vb)
#pragma unroll
                for (int r = 0; r < 4; ++r) sl[(16 * kb + 4 * g + r) * 64 + 16 * vb + n] = S[kb][vb][r];
        ((float*)(F.ws + WS_DEC))[(size_t)wu_out * 64 + lane] = dtot;
    }
}
}
__device__ __forceinline__ void phase_scan2_a(Frame& F, int layer) {
    PHASE_IDS();
    const int gw = blk_ * NWAVES + wave, NGW = F.G * NWAVES;
    for (int wu = gw; wu < NSEQ * NSC; wu += NGW) {
        const int s = wu / NSC, sc = wu % NSC; const int type = s / 24, rem = s % 24, b = rem / 12, h = (rem % 12) >> 1, dir = rem & 1;
        if (type == 0) sc2::run<0, 0>(F, lane, wave, layer, b, h, dir, sc, true, wu); else sc2::run<1, 0>(F, lane, wave, layer, b, h, dir, sc, true, wu);
    }
}
__device__ __forceinline__ void phase_scan2_c(Frame& F, int layer) {
    PHASE_IDS();
    const int gw = blk_ * NWAVES + wave, NGW = F.G * NWAVES;
    const bool need_ctx = layer == 0;
    for (int wu = gw; wu < 24 * NSC; wu += NGW) {
        const int sq = wu / NSC, blk = wu % NSC; const int type = sq / 12, b = (sq % 12) / 6, h = sq % 6;
        if (blk == 0 && !need_ctx) continue;
        const int scf = blk, scb = (blk == 0) ? 0 : 65 - blk;
        if (type == 0) { sc2::run<0, 1>(F, lane, wave, layer, b, h, 0, scf, scf == 0, 0); sc2::run<0, 2>(F, lane, wave, layer, b, h, 1, scb, scb == 0, 0); }
        else           { sc2::run<1, 1>(F, lane, wave, layer, b, h, 0, scf, scf == 0, 0); sc2::run<1, 2>(F, lane, wave, layer, b, h, 1, scb, scb == 0, 0); }
    }
}

namespace att {
constexpr int SLOT = 32768, NS = 3, WSF_OFF = NS * SLOT, OST_OFF = 0, OST_W = 32 * 68 * 4;
__device__ __forceinline__ int crow(int r, int hi) { return (r & 3) + 8 * (r >> 2) + 4 * hi; }
typedef short v4i16_t __attribute__((ext_vector_type(4)));
typedef LAS const char* lds_cptr;
__device__ __forceinline__ s16x4 vtr(lds_cptr p) { return __builtin_bit_cast(s16x4, __builtin_amdgcn_ds_read_tr16_b64_v4i16((LAS v4i16_t*)p)); }
__device__ __forceinline__ float max3f(float a, float b, float c) { return __builtin_fmaxf(__builtin_fmaxf(a, b), c); }
__device__ __forceinline__ float hmax32(const f32x16& p0, const f32x16& p1) {
    float a = max3f(p0[0], p0[1], p1[0]), b = max3f(p0[2], p0[3], p1[1]); a = max3f(a, p1[2], p1[3]);
#pragma unroll
    for (int r = 4; r < 16; r += 4) { a = max3f(a, p0[r], p0[r + 1]); b = max3f(b, p0[r + 2], p0[r + 3]); a = max3f(a, p1[r], p1[r + 1]); b = max3f(b, p1[r + 2], p1[r + 3]); }
    const float m = __builtin_fmaxf(a, b);
    auto rr = __builtin_amdgcn_permlane32_swap(__builtin_bit_cast(unsigned, m), __builtin_bit_cast(unsigned, m), false, false);
    return __builtin_fmaxf(__builtin_bit_cast(float, rr[0]), __builtin_bit_cast(float, rr[1]));
}
#define ATT_WAIT_BAR(N) asm volatile("s_waitcnt vmcnt(" #N ") lgkmcnt(0)\n\ts_barrier" ::: "memory")
template<int VAR>
__device__ __forceinline__ void attn_unit(Frame& F, int lane_in, int wid, int layer, int b, int h, bool isctx, int qb) {
    int lane = lane_in; asm volatile("" : "+v"(lane));
    const int r32 = lane & 31, hi = lane >> 5;
    LAS unsigned char* lds = F.lds; const unsigned lds0 = (unsigned)(uintptr_t)lds;
    const float* tab = (const float*)(F.ws + WS_TAB);
    const int qrow = qb * 256 + wid * 32 + r32;
    bf16x8 qr[2][2];
#pragma unroll
    for (int m = 0; m < 2; ++m) { const int mp = b * 8 + 2 * h + m;
        const bf16_t* qp = isctx ? (const bf16_t*)(F.ws + WS_QC) + ((size_t)mp * CL + qrow) * 32 : (const bf16_t*)(F.ws + WS_QA) + ((size_t)mp * T + qrow) * 32;
#pragma unroll
        for (int d0 = 0; d0 < 2; ++d0) qr[m][d0] = *(const bf16x8*)(qp + d0 * 16 + hi * 8); }
    const int NTL = isctx ? 2 : KT_TILES / 2;
    const bf16_t* ksrc = (const bf16_t*)(F.ws + WS_KA) + (size_t)((b * 8 + 2 * h + (wid >> 2)) * KT_TILES) * 2048 + (wid & 3) * 512;
    const unsigned char* vsrc = F.ws + WS_VA + (size_t)((b * 4 + h) * KT_TILES) * 4096 + (wid >> 2) * 4096 + (wid & 3) * 1024;
    const unsigned dma_off = (unsigned)lane * 16u;
#define ATT_DMA(t, slot) do { _Pragma("unroll") for (int sb_ = 0; sb_ < 2; ++sb_) \
                              ::glds16(ksrc + (size_t)(2 * (t) + sb_) * 2048, dma_off, (unsigned)__builtin_amdgcn_readfirstlane(lds0 + (slot) * SLOT + sb_ * 16384 + wid * 1024)); \
                              ::glds16(vsrc + (size_t)(t) * 8192, dma_off, (unsigned)__builtin_amdgcn_readfirstlane(lds0 + (slot) * SLOT + (wid >> 2) * 16384 + 8192 + (wid & 3) * 1024)); } while (0)
    LAS float* wsf = (LAS float*)(lds + WSF_OFF) + wid * 128;
    LAS float* ost = (LAS float*)(lds + OST_OFF + wid * OST_W);
    f32x16 o[2][2];
#pragma unroll
    for (int m = 0; m < 2; ++m)
#pragma unroll
        for (int d = 0; d < 2; ++d) o[m][d] = f32x16{};
    constexpr float POFS = 60.5f, PTHR = 32.f;
    float mhat = 0.f;
    f32x16 lacc[2]; lacc[0] = f32x16{}; lacc[1] = f32x16{};
    v8i ones8; { int o8 = 0x38383838; asm volatile("" : "+v"(o8)); ones8 = (v8i){o8, o8, o8, o8, o8, o8, o8, o8}; asm volatile("" : "+v"(ones8)); }
    f32x16 negm; { float z_ = POFS; asm volatile("" : "+v"(z_));
#pragma unroll
      for (int r = 0; r < 16; ++r) negm[r] = z_; }
    ATT_DMA(0, 0); ATT_DMA(1, 1);
    asm volatile("" : "+v"(qr[0][0]), "+v"(qr[0][1]), "+v"(qr[1][0]), "+v"(qr[1][1]));
    int slot = 0;
    for (int t = 0; t < NTL; ++t) {
        if (t + 1 < NTL) { ATT_WAIT_BAR(3); } else { ATT_WAIT_BAR(0); }
        if (t + 2 < NTL) { const int s2 = slot >= 1 ? slot - 1 : 2; ATT_DMA(t + 2, s2); }
#pragma unroll
        for (int sub = 0; sub < 2; ++sub) {
        const lds_cptr base = (lds_cptr)lds + slot * SLOT + sub * 16384;
        f32x16 p[2][2];
#pragma unroll
        for (int m = 0; m < 2; ++m) {
            const lds_cptr kb = base + m * 4096 + hi * 1024 + r32 * 16;
            const bf16x8 k00 = VAR == 4 ? qr[m][0] : *(const LAS bf16x8*)(kb), k01 = VAR == 4 ? qr[m][1] : *(const LAS bf16x8*)(kb + 512), k10 = VAR == 4 ? qr[1 - m][0] : *(const LAS bf16x8*)(kb + 2048), k11 = VAR == 4 ? qr[1 - m][1] : *(const LAS bf16x8*)(kb + 2048 + 512);
            p[m][0] = __builtin_amdgcn_mfma_f32_32x32x16_bf16(k00, qr[m][0], negm, 0, 0, 0);
            p[m][1] = __builtin_amdgcn_mfma_f32_32x32x16_bf16(k01, qr[m][0], negm, 0, 0, 0);
            p[m][0] = __builtin_amdgcn_mfma_f32_32x32x16_bf16(k10, qr[m][1], p[m][0], 0, 0, 0);
            p[m][1] = __builtin_amdgcn_mfma_f32_32x32x16_bf16(k11, qr[m][1], p[m][1], 0, 0, 0);
        }
        v8i vf[2];
        if (sub == 0 && (t & 1) == 0) {
          const float rm = __builtin_fmaxf(hmax32(p[0][0], p[0][1]), hmax32(p[1][0], p[1][1])) - POFS;
          const bool first = (t == 0);
          if (first || __any(rm > PTHR)) {
              const float dl = first ? rm : fmaxf(rm, 0.f);
              mhat += dl;
#pragma unroll
              for (int r = 0; r < 16; ++r) { p[0][0][r] -= dl; p[0][1][r] -= dl; p[1][0][r] -= dl; p[1][1][r] -= dl; negm[r] = POFS - mhat; }
              asm volatile("" : "+v"(negm));
              if (!first) {
                  const float f = __builtin_amdgcn_exp2f(-0.25f * dl);
                  if (hi == 0) wsf[r32] = f;
                  LDS_WAIT();
#pragma unroll
                  for (int r = 0; r < 16; ++r) { const float fr_ = wsf[crow(r, hi)]; o[0][0][r] *= fr_; o[0][1][r] *= fr_; o[1][0][r] *= fr_; o[1][1][r] *= fr_; lacc[0][r] *= fr_; lacc[1][r] *= fr_; }
                  LDS_WAIT();
              }
          } }
#pragma unroll
        for (int m = 0; m < 2; ++m) {
            f32x16& p0 = p[m][0]; f32x16& p1 = p[m][1];
            v8i pw;
#pragma unroll
            for (int q = 0; q < 4; ++q) {
                unsigned wa = __builtin_amdgcn_cvt_pk_u8_f32(p0[4 * q], 0, 0u), wb = __builtin_amdgcn_cvt_pk_u8_f32(p1[4 * q], 0, 0u);
#pragma unroll
                for (int j = 1; j < 4; ++j) { wa = __builtin_amdgcn_cvt_pk_u8_f32(p0[4 * q + j], j, wa); wb = __builtin_amdgcn_cvt_pk_u8_f32(p1[4 * q + j], j, wb); }
                pw[q] = (int)wa; pw[4 + q] = (int)wb; }
            if (m == 0) {
                const lds_cptr vp0 = base + 8192 + hi * 512 + r32 * 16;
#pragma unroll
                for (int d0 = 0; d0 < 2; ++d0) { const u32x4 lo = *(const LAS u32x4*)(vp0 + d0 * 1024), hh = *(const LAS u32x4*)(vp0 + d0 * 1024 + 2048);
                    vf[d0] = (v8i){(int)lo.x, (int)lo.y, (int)lo.z, (int)lo.w, (int)hh.x, (int)hh.y, (int)hh.z, (int)hh.w}; }
            }
#pragma unroll
            for (int d0 = 0; d0 < 2; ++d0) o[m][d0] = __builtin_amdgcn_mfma_scale_f32_32x32x64_f8f6f4(pw, vf[d0], o[m][d0], 1, 0, 0, 0x7F7F7F7F, 0, 0x7B7B7B7B);
            lacc[m] = __builtin_amdgcn_mfma_scale_f32_32x32x64_f8f6f4(pw, ones8, lacc[m], 1, 0, 0, 0x7F7F7F7F, 0, 0x7F7F7F7F);
        }
        }
        slot = slot == 2 ? 0 : slot + 1;
    }
    asm volatile("s_waitcnt lgkmcnt(0)\n\ts_barrier" ::: "memory");
    int lane_e = lane; asm volatile("" : "+v"(lane_e));
    const int r32e = lane_e & 31, hie = lane_e >> 5;
    const float lam = tab[TB_LAM + layer], oml = tab[TB_LAM + 2 + layer];
#pragma unroll
    for (int r = 0; r < 16; ++r) { const int qq = crow(r, hie); const float f0 = __builtin_amdgcn_rcpf(lacc[0][r]), f1 = -lam * __builtin_amdgcn_rcpf(lacc[1][r]);
#pragma unroll
        for (int d0 = 0; d0 < 2; ++d0) ost[qq * 68 + d0 * 32 + r32e] = o[0][d0][r] * f0 + o[1][d0][r] * f1; }
    LDS_WAIT();
    { const int rw = lane_e >> 1, hf = lane_e & 1; f32x4 xv[8]; float ss = 0.f;
#pragma unroll
      for (int j = 0; j < 8; ++j) { xv[j] = *(const LAS f32x4*)(ost + rw * 68 + hf * 32 + 4 * j); ss += (xv[j][0] * xv[j][0] + xv[j][1] * xv[j][1]) + (xv[j][2] * xv[j][2] + xv[j][3] * xv[j][3]); }
      ss += xor_swz<1>(ss);
      const float rs = __builtin_amdgcn_rsqf(ss * (1.f / 64.f) + EPS) * oml;
      const float* sw = F.in[13] + layer * 64 + hf * 32;
      const int qi = qb * 256 + wid * 32 + rw; const size_t orow = isctx ? (size_t)(NLAT + b * CL + qi) : (size_t)(b * T + qi);
      bf16_t* dst = (bf16_t*)(F.ws + WS_MIX) + orow * 1024 + 768 + h * 64 + hf * 32;
#pragma unroll
      for (int j = 0; j < 4; ++j) { const f32x4 a = xv[2 * j], c = xv[2 * j + 1]; const f32x4 wa = *(const f32x4*)(sw + 8 * j), wb = *(const f32x4*)(sw + 8 * j + 4);
          u32x4 w; w.x = pk2(a[0] * rs * wa[0], a[1] * rs * wa[1]); w.y = pk2(a[2] * rs * wa[2], a[3] * rs * wa[3]); w.z = pk2(c[0] * rs * wb[0], c[1] * rs * wb[1]); w.w = pk2(c[2] * rs * wb[2], c[3] * rs * wb[3]);
          *(u32x4*)(dst + 8 * j) = w; } }
    asm volatile("s_waitcnt lgkmcnt(0)\n\ts_barrier" ::: "memory");
#undef ATT_DMA
}

#define ATT_SBAR() __builtin_amdgcn_sched_barrier(0)
#define ATT_MFMA(a, b, c) __builtin_amdgcn_mfma_f32_32x32x16_bf16(a, b, c, 0, 0, 0)
#define ATT_PV(a, b, c, sb) __builtin_amdgcn_mfma_scale_f32_32x32x64_f8f6f4(a, b, c, 1, 0, 0, 0x7F7F7F7F, 0, sb)
constexpr float POFS = 60.5f, PTHR = 32.f;
struct PState { f32x16 o[2][2]; f32x4 lacc[2]; f32x16 negm; bf16x8 qr[2][2]; float mhat; };
#define ATT_CVT8(p, e0, W, i0) do { unsigned a_ = __builtin_amdgcn_cvt_pk_u8_f32(p[e0], 0, 0u), b_ = __builtin_amdgcn_cvt_pk_u8_f32(p[(e0) + 4], 0, 0u); \
    _Pragma("unroll") for (int j_ = 1; j_ < 4; ++j_) { a_ = __builtin_amdgcn_cvt_pk_u8_f32(p[(e0) + j_], j_, a_); b_ = __builtin_amdgcn_cvt_pk_u8_f32(p[(e0) + 4 + j_], j_, b_); } \
    W[i0] = (int)a_; W[(i0) + 1] = (int)b_; } while (0)
template<int M, bool LOADV>
__device__ __forceinline__ void pstep(PState& S, f32x16& pa0, f32x16& pa1, f32x16& pb0, f32x16& pb1, bf16x8& kA, bf16x8& kB, v8i (&vf)[2], const v4i& sel4, lds_cptr vb, lds_cptr kc, lds_cptr kn, bool chk, LAS float* wsfw, int lane) {
    constexpr int MN = 1 - M;
    if (chk) {
        const float rm = hmax32(pa0, pa1) - POFS;
        if (__any(rm > PTHR)) {
            const int r32 = lane & 31, hi = lane >> 5;
            const float dl = fmaxf(rm, 0.f);
            S.mhat += dl;
#pragma unroll
            for (int r = 0; r < 16; ++r) { pa0[r] -= dl; pa1[r] -= dl; S.negm[r] = POFS - S.mhat; }
            const float f = __builtin_amdgcn_exp2f(-0.25f * dl);
            if (hi == 0) wsfw[r32] = f;
            LDS_WAIT();
#pragma unroll
            for (int r = 0; r < 16; ++r) { const float fr_ = wsfw[crow(r, hi)]; S.o[0][0][r] *= fr_; S.o[0][1][r] *= fr_; S.o[1][0][r] *= fr_; S.o[1][1][r] *= fr_; }
            { const float fl_ = wsfw[(lane & 15) + 16 * hi]; S.lacc[0] = S.lacc[0] * fl_; S.lacc[1] = S.lacc[1] * fl_; }
            LDS_WAIT();
        }
    }
    v8i pw;
    ATT_SBAR(); pb0 = ATT_MFMA(kA, S.qr[MN][0], S.negm); ATT_SBAR();
    kA = *(const LAS bf16x8*)(kc + 2048);
    if (LOADV) {
#pragma unroll
        for (int d0 = 0; d0 < 2; ++d0) { const u32x4 lo = *(const LAS u32x4*)(vb + d0 * 1024), hh = *(const LAS u32x4*)(vb + d0 * 1024 + 2048);
            vf[d0] = (v8i){(int)lo.x, (int)lo.y, (int)lo.z, (int)lo.w, (int)hh.x, (int)hh.y, (int)hh.z, (int)hh.w}; }
    }
    ATT_CVT8(pa0, 0, pw, 0);
    ATT_SBAR(); pb1 = ATT_MFMA(kB, S.qr[MN][0], S.negm); ATT_SBAR();
    kB = *(const LAS bf16x8*)(kc + 2048 + 512);
    ATT_CVT8(pa0, 8, pw, 2);
    ATT_SBAR(); pb0 = ATT_MFMA(kA, S.qr[MN][1], pb0); ATT_SBAR();
    kA = *(const LAS bf16x8*)(kn);
    ATT_CVT8(pa1, 0, pw, 4);
    ATT_SBAR(); pb1 = ATT_MFMA(kB, S.qr[MN][1], pb1); ATT_SBAR();
    kB = *(const LAS bf16x8*)(kn + 512);
    ATT_CVT8(pa1, 8, pw, 6);
    ATT_SBAR(); S.o[M][0] = ATT_PV(pw, vf[0], S.o[M][0], 0x7B7B7B7B);
    ATT_SBAR(); S.o[M][1] = ATT_PV(pw, vf[1], S.o[M][1], 0x7B7B7B7B);
    ATT_SBAR(); S.lacc[M] = __builtin_amdgcn_mfma_scale_f32_16x16x128_f8f6f4((v8i){sel4[0], sel4[1], sel4[2], sel4[3], 0, 0, 0, 0}, pw, S.lacc[M], 4, 1, 0, 0x7F7F7F7F, 0, 0x7F7F7F7F); ATT_SBAR();
}
__device__ __forceinline__ void attn_unit_p(Frame& F, int lane_in, int wid, int layer, int b, int h, bool isctx, int qb) {
    int lane = lane_in; asm volatile("" : "+v"(lane));
    const int r32 = lane & 31, hi = lane >> 5;
    LAS unsigned char* lds = F.lds; const unsigned lds0 = (unsigned)(uintptr_t)lds;
    const float* tab = (const float*)(F.ws + WS_TAB);
    const int qrow = qb * 256 + wid * 32 + r32;
    PState S;
#pragma unroll
    for (int m = 0; m < 2; ++m) { const int mp = b * 8 + 2 * h + m;
        const bf16_t* qp = isctx ? (const bf16_t*)(F.ws + WS_QC) + ((size_t)mp * CL + qrow) * 32 : (const bf16_t*)(F.ws + WS_QA) + ((size_t)mp * T + qrow) * 32;
#pragma unroll
        for (int d0 = 0; d0 < 2; ++d0) S.qr[m][d0] = *(const bf16x8*)(qp + d0 * 16 + hi * 8); }
    const int NTL = isctx ? 2 : KT_TILES / 2;
    const bf16_t* ksrc = (const bf16_t*)(F.ws + WS_KA) + (size_t)((b * 8 + 2 * h + (wid >> 2)) * KT_TILES) * 2048 + (wid & 3) * 512;
    const unsigned char* vsrc = F.ws + WS_VA + (size_t)((b * 4 + h) * KT_TILES) * 4096 + (wid >> 2) * 4096 + (wid & 3) * 1024;
    const unsigned dma_off = (unsigned)lane * 16u;
#define ATT_DMA(t, slot) do { _Pragma("unroll") for (int sb_ = 0; sb_ < 2; ++sb_) \
                              ::glds16(ksrc + (size_t)(2 * (t) + sb_) * 2048, dma_off, (unsigned)__builtin_amdgcn_readfirstlane(lds0 + (slot) * SLOT + sb_ * 16384 + wid * 1024)); \
                              ::glds16(vsrc + (size_t)(t) * 8192, dma_off, (unsigned)__builtin_amdgcn_readfirstlane(lds0 + (slot) * SLOT + (wid >> 2) * 16384 + 8192 + (wid & 3) * 1024)); } while (0)
    LAS float* wsf = (LAS float*)(lds + WSF_OFF) + wid * 128;
    LAS float* ost = (LAS float*)(lds + OST_OFF + wid * OST_W);
#pragma unroll
    for (int m = 0; m < 2; ++m) { S.o[m][0] = f32x16{}; S.o[m][1] = f32x16{}; S.lacc[m] = (f32x4){0.f, 0.f, 0.f, 0.f}; }
    S.mhat = 0.f;
    { float z_ = POFS; asm volatile("" : "+v"(z_));
#pragma unroll
      for (int r = 0; r < 16; ++r) S.negm[r] = z_; }
    v4i sel4; { int o4 = (((lane >> 4) ^ (lane >> 3)) & 1) ? 0 : 0x22222222; asm volatile("" : "+v"(o4)); sel4 = (v4i){o4, o4, o4, o4}; asm volatile("" : "+v"(sel4)); }
    ATT_DMA(0, 0); ATT_DMA(1, 1);
    asm volatile("" : "+v"(S.qr[0][0]), "+v"(S.qr[0][1]), "+v"(S.qr[1][0]), "+v"(S.qr[1][1]));
    const int koff = hi * 1024 + r32 * 16, voff = 8192 + hi * 512 + r32 * 16;
    ATT_WAIT_BAR(3);
    f32x16 pa0, pa1, pb0, pb1; bf16x8 kA, kB; v8i vf[2];
    {
        const lds_cptr kb = (lds_cptr)lds + koff;
        kA = *(const LAS bf16x8*)(kb); kB = *(const LAS bf16x8*)(kb + 512);
        pa0 = ATT_MFMA(kA, S.qr[0][0], S.negm); pa1 = ATT_MFMA(kB, S.qr[0][0], S.negm);
        ATT_SBAR();
        kA = *(const LAS bf16x8*)(kb + 2048); kB = *(const LAS bf16x8*)(kb + 2048 + 512);
        pa0 = ATT_MFMA(kA, S.qr[0][1], pa0); pa1 = ATT_MFMA(kB, S.qr[0][1], pa1);
        ATT_SBAR();
        kA = *(const LAS bf16x8*)(kb + 4096); kB = *(const LAS bf16x8*)(kb + 4096 + 512);
        const float rm = hmax32(pa0, pa1) - POFS; S.mhat = rm;
#pragma unroll
        for (int r = 0; r < 16; ++r) { pa0[r] -= rm; pa1[r] -= rm; S.negm[r] = POFS - rm; }
    }
    int slot = 0;
    for (int t = 0; t < NTL; ++t) {
        ATT_WAIT_BAR(0);
        if (t + 2 < NTL) { const int s2 = slot >= 1 ? slot - 1 : 2; ATT_DMA(t + 2, s2); }
        const int sn = slot == 2 ? 0 : slot + 1;
        const lds_cptr tb = (lds_cptr)lds + slot * SLOT, tn = (lds_cptr)lds + sn * SLOT;
        const bool chk = (t & 1) == 0;
        pstep<0, true >(S, pa0, pa1, pb0, pb1, kA, kB, vf, sel4, tb + voff,         tb + 4096 + koff,         tb + 16384 + koff,        chk && t > 0, wsf, lane);
        pstep<1, false>(S, pb0, pb1, pa0, pa1, kA, kB, vf, sel4, tb + voff,         tb + 16384 + koff,        tb + 16384 + 4096 + koff, chk,          wsf, lane);
        pstep<0, true >(S, pa0, pa1, pb0, pb1, kA, kB, vf, sel4, tb + 16384 + voff, tb + 16384 + 4096 + koff, tn + koff,                false,        wsf, lane);
        pstep<1, false>(S, pb0, pb1, pa0, pa1, kA, kB, vf, sel4, tb + 16384 + voff, tn + koff,                tn + 4096 + koff,         false,        wsf, lane);
        slot = sn;
    }
    asm volatile("s_waitcnt lgkmcnt(0)\n\ts_barrier" ::: "memory");
    int lane_e = lane; asm volatile("" : "+v"(lane_e));
    const int r32e = lane_e & 31, hie = lane_e >> 5;
    const float lam = tab[TB_LAM + layer], oml = tab[TB_LAM + 2 + layer];
    if ((lane_e & 16) == 0) { const int ql = (lane_e & 15) + 16 * hie; wsf[ql] = __builtin_amdgcn_rcpf(S.lacc[0][0]); wsf[32 + ql] = __builtin_amdgcn_rcpf(S.lacc[1][0]); }
    LDS_WAIT();
#pragma unroll
    for (int r = 0; r < 16; ++r) { const int qq = crow(r, hie); const float f0 = wsf[qq], f1 = -lam * wsf[32 + qq];
#pragma unroll
        for (int d0 = 0; d0 < 2; ++d0) ost[qq * 68 + d0 * 32 + r32e] = S.o[0][d0][r] * f0 + S.o[1][d0][r] * f1; }
    LDS_WAIT();
    { const int rw = lane_e >> 1, hf = lane_e & 1; f32x4 xv[8]; float ss = 0.f;
#pragma unroll
      for (int j = 0; j < 8; ++j) { xv[j] = *(const LAS f32x4*)(ost + rw * 68 + hf * 32 + 4 * j); ss += (xv[j][0] * xv[j][0] + xv[j][1] * xv[j][1]) + (xv[j][2] * xv[j][2] + xv[j][3] * xv[j][3]); }
      ss += xor_swz<1>(ss);
      const float rs = __builtin_amdgcn_rsqf(ss * (1.f / 64.f) + EPS) * oml;
      const float* sw = F.in[13] + layer * 64 + hf * 32;
      const int qi = qb * 256 + wid * 32 + rw; const size_t orow = isctx ? (size_t)(NLAT + b * CL + qi) : (size_t)(b * T + qi);
      bf16_t* dst = (bf16_t*)(F.ws + WS_MIX) + orow * 1024 + 768 + h * 64 + hf * 32;
#pragma unroll
      for (int j = 0; j < 4; ++j) { const f32x4 a = xv[2 * j], c = xv[2 * j + 1]; const f32x4 wa = *(const f32x4*)(sw + 8 * j), wb = *(const f32x4*)(sw + 8 * j + 4);
          u32x4 w; w.x = pk2(a[0] * rs * wa[0], a[1] * rs * wa[1]); w.y = pk2(a[2] * rs * wa[2], a[3] * rs * wa[3]); w.z = pk2(c[0] * rs * wb[0], c[1] * rs * wb[1]); w.w = pk2(c[2] * rs * wb[2], c[3] * rs * wb[3]);
          *(u32x4*)(dst + 8 * j) = w; } }
    asm volatile("s_waitcnt lgkmcnt(0)\n\ts_barrier" ::: "memory");
#undef ATT_DMA
}
}
template<int VAR>
__device__ __forceinline__ void phase_attn(Frame& F, int layer, int ulo, int uhi) {
    PHASE_IDS();
    __syncthreads();
    const int nunits = 512 + (layer == 0 ? 8 : 0);
    for (int u = blk_; u < nunits && u < uhi; u += F.G) {
        if (u < ulo) continue;
        if (u < 512) { const int bh = u & 7, qb = u >> 3; att::attn_unit_p(F, lane, wave, layer, bh >> 2, bh & 3, false, qb); }
        else { const int bh = u - 512; att::attn_unit_p(F, lane, wave, layer, bh >> 2, bh & 3, true, 0); }
    }
}

__device__ __forceinline__ void phase_route(Frame& F, int layer) {
    PHASE_IDS();
    const int wid = wave, G = F.G, blk = blk_;
    const int nrows = layer == 0 ? NROW : NLAT;
    constexpr int TP = 2064;
    LAS unsigned char* Th = F.lds; LAS unsigned char* Tl = F.lds + 16 * TP; LAS float* Pp = (LAS float*)(F.lds + 32 * TP);
    LAS int* hist = (LAS int*)(F.lds + LDS_TAB); LAS int* sbase = hist + 32; LAS unsigned* ent = (LAS unsigned*)(hist + 64); LAS float* entg = (LAS float*)(ent + 640);
    for (int i = tid; i < 64 + 640; i += NTHR) hist[i] = (i < 64) ? 0 : -1;
    LAS float* mv = (LAS float*)(F.lds + 32 * TP + 16384);
    { const float* mg = (const float*)(F.ws + WS_MODV) + (size_t)layer * 3 * 6 * 1024;
      for (int i = tid; i < 9 * 256; i += NTHR) { const int v = i >> 8, c4 = i & 255; *(LAS f32x4*)(mv + v * 1024 + 4 * c4) = *(const f32x4*)(mg + (size_t)((v / 3) * 6 + 2 + (v % 3)) * 1024 + 4 * c4); } }
    bf16x8 bh[4][2], bl[4][2];
    { const bf16_t* rwh = (const bf16_t*)(F.ws + WS_RWT) + (size_t)layer * 32768; const bf16_t* rwl = rwh + 2 * 32768;
#pragma unroll
      for (int ks = 0; ks < 4; ++ks)
#pragma unroll
        for (int nb = 0; nb < 2; ++nb) { const int o_ = (16 * nb + (lane & 15)) * 1024 + 128 * wid + 32 * ks + 8 * (lane >> 4); bh[ks][nb] = *(const bf16x8*)(rwh + o_); bl[ks][nb] = *(const bf16x8*)(rwl + o_); } }
    __syncthreads();
    const float* modv = (const float*)(F.ws + WS_MODV) + (size_t)layer * 3 * 6 * 1024;
    const bf16_t* yb = (const bf16_t*)(F.ws + WS_Y);
    float* x1b = (float*)(F.ws + WS_X1);
    const int nloc = (nrows - blk + G - 1) / G;
    const float rbias = F.in[16][layer * 32 + (lane & 31)];
    const int nbatch = (nloc + 15) >> 4;
    for (int it = 0; it < nbatch; ++it) { const int i0 = 16 * it + 2 * wid;
        f32x4 tk[2][4]; bool val[2];
#pragma unroll
        for (int q = 0; q < 2; ++q) {
            const int il = i0 + q; val[q] = il < nloc; const int r = val[q] ? blk + il * G : blk;
            const int w = row_which(r);
            const float* xs = (layer == 0) ? (r < NLAT ? F.in[0] + (size_t)r * D : F.in[2] + (size_t)(r - NLAT) * D) : x1b + (size_t)r * D;
            f32x4 x[4], y[4]; row_load(xs, lane, x);
#pragma unroll
            for (int j = 0; j < 4; ++j) { const u32x2 yy = *(const u32x2*)(yb + (size_t)r * D + 4 * lane + 256 * j); y[j] = (f32x4){bflo(yy.x), bfhi(yy.x), bflo(yy.y), bfhi(yy.y)}; }
            const float ry = __builtin_amdgcn_rsqf(row_sumsq(y) * (1.f / 1024.f) + EPS);
            const LAS float* c1 = mv + (w * 3 + 0) * 1024;
#pragma unroll
            for (int j = 0; j < 4; ++j) { const f32x4 cv = *(const LAS f32x4*)(c1 + 4 * lane + 256 * j); x[j] = x[j] + cv * (y[j] * ry); }
            if (val[q]) row_store(x1b + (size_t)r * D, lane, x);
            { const float rr_ = __builtin_amdgcn_rsqf(row_sumsq(x) * (1.f / 1024.f) + EPS); const LAS float* at_ = mv + (w * 3 + 1) * 1024; const LAS float* bt_ = mv + (w * 3 + 2) * 1024;
#pragma unroll
              for (int j = 0; j < 4; ++j) { const f32x4 av = *(const LAS f32x4*)(at_ + 4 * lane + 256 * j), bv = *(const LAS f32x4*)(bt_ + 4 * lane + 256 * j); tk[q][j] = x[j] * rr_ * av + bv; } }
            if (val[q]) {
                unsigned char* t8 = F.ws + WS_TOK8 + (size_t)r * D;
#pragma unroll
                for (int j = 0; j < 4; ++j) *(unsigned*)(t8 + 4 * lane + 256 * j) = pk4_fp8(tk[q][j][0], tk[q][j][1], tk[q][j][2], tk[q][j][3]); }
        }
#pragma unroll
        for (int q = 0; q < 2; ++q)
#pragma unroll
            for (int j = 0; j < 4; ++j) { unsigned hb[4], lb[4];
#pragma unroll
                for (int c = 0; c < 4; ++c) { hb[c] = f2bf(tk[q][j][c]); lb[c] = f2bf(tk[q][j][c] - __builtin_bit_cast(float, hb[c] << 16)); }
                const int off = (2 * wid + q) * TP + (4 * lane + 256 * j) * 2;
                *(LAS u32x2*)(Th + off) = (u32x2){hb[0] | (hb[1] << 16), hb[2] | (hb[3] << 16)}; *(LAS u32x2*)(Tl + off) = (u32x2){lb[0] | (lb[1] << 16), lb[2] | (lb[3] << 16)}; }
        __syncthreads();
        { f32x4 pacc[2]; pacc[0] = (f32x4){0.f, 0.f, 0.f, 0.f}; pacc[1] = pacc[0];
#pragma unroll
          for (int ks = 0; ks < 4; ++ks) { const int ao = (lane & 15) * TP + (128 * wid + 32 * ks + 8 * (lane >> 4)) * 2;
              const bf16x8 ah = *(const LAS bf16x8*)(Th + ao), al = *(const LAS bf16x8*)(Tl + ao);
#pragma unroll
              for (int nb = 0; nb < 2; ++nb) { pacc[nb] = __builtin_amdgcn_mfma_f32_16x16x32_bf16(ah, bh[ks][nb], pacc[nb], 0, 0, 0); pacc[nb] = __builtin_amdgcn_mfma_f32_16x16x32_bf16(al, bh[ks][nb], pacc[nb], 0, 0, 0);
                                               pacc[nb] = __builtin_amdgcn_mfma_f32_16x16x32_bf16(ah, bl[ks][nb], pacc[nb], 0, 0, 0); } }
#pragma unroll
          for (int nb = 0; nb < 2; ++nb)
#pragma unroll
              for (int r = 0; r < 4; ++r) Pp[(wid * 16 + 4 * (lane >> 4) + r) * 32 + 16 * nb + (lane & 15)] = pacc[nb][r]; }
        __syncthreads();
        float lg = 0.f;
#pragma unroll
        for (int w8 = 0; w8 < 8; ++w8) lg += Pp[(w8 * 16 + 2 * wid + (lane >> 5)) * 32 + (lane & 31)];
        lg += rbias;
#ifdef DBG_CHECK
        { const int q_ = lane >> 5; if (q_ == 0 ? val[0] : val[1]) ((float*)(F.ws + WS_END + 65536))[(size_t)(blk + (i0 + q_) * G) * 32 + (lane & 31)] = lg; }
#endif
        float tv[4]; int te[4];
#pragma unroll
        for (int k = 0; k < 4; ++k) {
            float m = lg;
            m = fmaxf(m, xor_swz<16>(m)); m = fmaxf(m, xor_swz<8>(m)); m = fmaxf(m, xor_swz<4>(m)); m = fmaxf(m, xor_swz<2>(m)); m = fmaxf(m, xor_swz<1>(m));
            const unsigned long long bal = __ballot(lg == m);
            const unsigned hb = (lane & 32) ? (unsigned)(bal >> 32) : (unsigned)bal;
            const int idx = __builtin_ctz(hb);
            tv[k] = m; te[k] = idx;
            if ((lane & 31) == idx) lg = -INFINITY;
        }
        float g[4]; { float s = 0.f;
#pragma unroll
            for (int k = 0; k < 4; ++k) { g[k] = __expf(tv[k] - tv[0]); s += g[k]; }
            const float inv = 1.f / s;
#pragma unroll
            for (int k = 0; k < 4; ++k) g[k] *= inv; }
        const int q = lane >> 5, k = lane & 31;
        if (k < 4 && (q == 0 ? val[0] : val[1])) {
            const int il = i0 + q; const int r = blk + il * G;
            const int ee = (k == 0) ? te[0] : (k == 1) ? te[1] : (k == 2) ? te[2] : te[3];
            const float gg = (k == 0) ? g[0] : (k == 1) ? g[1] : (k == 2) ? g[2] : g[3];
            entg[il * 4 + k] = gg;
            const int lp = __hip_atomic_fetch_add(hist + ee, 1, __ATOMIC_RELAXED, __HIP_MEMORY_SCOPE_WORKGROUP);
            ent[il * 4 + k] = (unsigned)ee | ((unsigned)lp << 8);
        }
    }
    __syncthreads();
    if (tid < 32) sbase[tid] = (int)__hip_atomic_fetch_add((unsigned*)F.ctl + CW_CNT + layer * 32 + tid, (unsigned)hist[tid], __ATOMIC_RELAXED, __HIP_MEMORY_SCOPE_AGENT);
    __syncthreads();
    int* slot = (int*)(F.ws + WS_SLOT);
    for (int i = tid; i < nloc * 4; i += NTHR) { const unsigned en = ent[i]; if (en != 0xffffffffu) { const int e = en & 255, pos = sbase[e] + (int)(en >> 8); const int r = blk + (i >> 2) * G;
        slot[e * CAP + pos] = r * 4 + (i & 3); ((float*)(F.ws + WS_SGATE))[e * CAP + pos] = entg[i]; ((int*)(F.ws + WS_GATE))[r * 4 + (i & 3)] = e | (pos << 8); } }
    __syncthreads();
}
__device__ __forceinline__ void moe_tables(Frame& F, int layer) {
    PHASE_IDS();
    LAS int* tab = (LAS int*)(F.lds + LDS_TAB);
    if (tid == 0) { int acc = 0;
        for (int e = 0; e < 32; ++e) { const int c = (int)__hip_atomic_load((unsigned*)F.ctl + CW_CNT + layer * 32 + e, __ATOMIC_RELAXED, __HIP_MEMORY_SCOPE_AGENT); tab[e] = acc; tab[33 + e] = c; acc += (c + 255) >> 8; }
        tab[32] = acc; }
    __syncthreads();
}
__device__ __forceinline__ void phase_combine(Frame& F, int layer) {
    PHASE_IDS();
    const int gw = blk_ * NWAVES + wave, NGW = F.G * NWAVES;
    const int nrows = layer == 0 ? NROW : NLAT;
    const bf16_t* yk = (const bf16_t*)(F.ws + WS_YK); float* x1b = (float*)(F.ws + WS_X1);
    LAS float* mv = (LAS float*)F.lds;
    { const float* mg = (const float*)(F.ws + WS_MODV);
      for (int i = tid; i < 9 * 256; i += NTHR) { const int v = i >> 8, c4 = i & 255, w = v / 3, k = v % 3;
          const float* src = (k == 0) ? mg + (size_t)((layer * 3 + w) * 6 + 5) * 1024 : mg + (size_t)((1 * 3 + w) * 6 + (k - 1)) * 1024;
          *(LAS f32x4*)(mv + v * 1024 + 4 * c4) = *(const f32x4*)(src + 4 * c4); } }
    moe_tables(F, layer);
    const LAS int* ttab = (const LAS int*)(F.lds + LDS_TAB); const int* epos = (const int*)(F.ws + WS_GATE);
    int epn[4];
#pragma unroll
    for (int k = 0; k < 4; ++k) epn[k] = (gw < nrows) ? epos[gw * 4 + k] : 0;
    for (int r = gw; r < nrows; r += NGW) {
        const int w = row_which(r);
        int srow[4];
#pragma unroll
        for (int k = 0; k < 4; ++k) { const int ep = __builtin_amdgcn_readfirstlane(epn[k]); srow[k] = 256 * ttab[ep & 255] + (ep >> 8); }
        if (r + NGW < nrows) {
#pragma unroll
            for (int k = 0; k < 4; ++k) epn[k] = epos[(r + NGW) * 4 + k];
        }
        f32x4 x[4]; row_load(x1b + (size_t)r * D, lane, x);
        f32x4 f[4];
#pragma unroll
        for (int j = 0; j < 4; ++j) f[j] = (f32x4){0.f, 0.f, 0.f, 0.f};
#pragma unroll
        for (int k = 0; k < 4; ++k)
#pragma unroll
            for (int j = 0; j < 4; ++j) { const u32x2 u = *(const u32x2*)(yk + (size_t)srow[k] * D + 4 * lane + 256 * j); f[j][0] += bflo(u.x); f[j][1] += bfhi(u.x); f[j][2] += bflo(u.y); f[j][3] += bfhi(u.y); }
        const float rf = __builtin_amdgcn_rsqf(row_sumsq(f) * (1.f / 1024.f) + EPS);
        const LAS float* c2 = mv + (w * 3 + 0) * 1024;
#pragma unroll
        for (int j = 0; j < 4; ++j) { const f32x4 cv = *(const LAS f32x4*)(c2 + 4 * lane + 256 * j); x[j] = x[j] + cv * (f[j] * rf); }
        if (layer == 1) row_store(F.out + (size_t)r * D, lane, x);
        else { row_store(x1b + (size_t)r * D, lane, x);
            const float rr_ = __builtin_amdgcn_rsqf(row_sumsq(x) * (1.f / 1024.f) + EPS); const LAS float* ah_ = mv + (w * 3 + 1) * 1024; const LAS float* bh_ = mv + (w * 3 + 2) * 1024;
            f32x4 o[4];
#pragma unroll
            for (int j = 0; j < 4; ++j) { const f32x4 av = *(const LAS f32x4*)(ah_ + 4 * lane + 256 * j), bv = *(const LAS f32x4*)(bh_ + 4 * lane + 256 * j); o[j] = x[j] * rr_ * av + bv; }
            row_store_bf16((bf16_t*)(F.ws + WS_H) + (size_t)r * D, lane, o); }
    }
}

struct Args { const float* in[21]; float* out; unsigned char* ws; int ph_lo, ph_hi; };
constexpr int PH_PER_LAYER = 10, NPHASE = 2 + 2 * PH_PER_LAYER;
template <int SUB> __global__ void __launch_bounds__(NTHR, 2) mk_fwd(Args args) {
    extern __shared__ __attribute__((aligned(16))) unsigned char lds_raw[];
    Frame F;
    F.lds = (LAS unsigned char*)lds_raw; F.ws = args.ws; F.out = args.out;
#pragma unroll
    for (int i = 0; i < 21; ++i) F.in[i] = args.in[i];
    F.ctl = (gu32*)(args.ws + WS_CTL);
    __builtin_amdgcn_s_setreg(1473, 1);
    F.tid = threadIdx.x; F.lane = F.tid & 63; F.wave = __builtin_amdgcn_readfirstlane(F.tid >> 6); F.G = gridDim.x; F.blk = blockIdx.x;
    volatile LAS unsigned* misc = (volatile LAS unsigned*)(F.lds + LDS_MISC);
    if (F.tid < 16) misc[F.tid] = 0u;
    __syncthreads();
    const int lo = args.ph_lo, hi = args.ph_hi;
    const bool use_bar = (hi - lo) > 1;
    XcdBarrier bar; bar.bar = (unsigned*)F.ctl + CW_BAR; bar.x = 0; bar.st = nullptr;
    if (use_bar) { bar = xcd_barrier_post((unsigned*)F.ctl + CW_BAR, misc + 8); if (F.tid == 0) xcd_barrier_census(bar); }
#define IN(k) (lo <= (k) && (k) < hi)
#define SEAM(k) do { if (IN(k) && IN((k) + 1)) xcd_barrier(bar); } while (0)
    if (PHON(0) && IN(0)) { for (int rep = 0; rep < NREP(0); ++rep) phase_prologue_a(F); } SEAM(0);
    if (PHON(1) && IN(1)) { for (int rep = 0; rep < NREP(1); ++rep) phase_prologue_b(F); } SEAM(1);
    for (int layer = 0; layer < 2; ++layer) {
        const int p0 = 2 + layer * PH_PER_LAYER;
        unsigned char* ws = F.ws;
        int blk_ = F.blk; asm volatile("" : "+s"(blk_));
        if (PHON(2) && IN(p0 + 0)) {
            pg8::DenseSched S; S.init(ws + WS_H, (bf16_t*)(ws + WS_WIN) + (size_t)layer * NIN * 1024, NROW, NIN, F.G, blk_);
            EpiInProj E{ws, (const float*)(ws + WS_TAB), (const float*)(ws + WS_ROPE), layer};
            for (int rep = 0; rep < NREP(2); ++rep) pg8::gemm_phase<EpiInProj, pg8::DenseSched, false>(F.lds, F.wave, S, E);
        } SEAM(p0 + 0);
        if (PHON(3) && IN(p0 + 1)) { if constexpr (SUB & 1) phase_scan2_a(F, layer); if constexpr (SUB & 2) phase_attn<0>(F, layer, 0, F.G); } SEAM(p0 + 1);
        if (PHON(4) && IN(p0 + 2)) { for (int rep = 0; rep < NREP(4); ++rep) phase_scan_b(F); } SEAM(p0 + 2);
        if (PHON(5) && IN(p0 + 3)) { if constexpr (SUB & 1) phase_scan2_c(F, layer); if constexpr (SUB & 2) phase_attn<0>(F, layer, F.G, 1 << 30); } SEAM(p0 + 3);
          if (IN(p0 + 4) && IN(p0 + 5) && !IN(p0 + 3)) xcd_barrier(bar);
        if (PHON(7) && IN(p0 + 5)) {
            pg8::DenseSched S; S.init(ws + WS_MIX, (bf16_t*)(ws + WS_WOUT) + (size_t)layer * 1024 * 1024, layer == 0 ? NROW : NLAT, 1024, F.G, blk_);
            EpiBf16Out E{(bf16_t*)(ws + WS_Y)};
            for (int rep = 0; rep < NREP(7); ++rep) pg8::gemm_phase<EpiBf16Out, pg8::DenseSched, false>(F.lds, F.wave, S, E);
        } SEAM(p0 + 5);
        if (PHON(8) && IN(p0 + 6)) { phase_route(F, layer); } SEAM(p0 + 6);
        if (PHON(9) && IN(p0 + 7)) {
            moe_tables(F, layer);
            pg8::MoeSched<8, true, 1024> S{(const char*)(ws + WS_TOK8), (const char*)(ws + WS_W1 + (size_t)layer * NE * 2048 * 1024), (const int*)(ws + WS_SLOT), (const LAS int*)(F.lds + LDS_TAB), F.G, blk_, (size_t)2048 * 1024};
            EpiSwiglu E{ws + WS_ACT, F.in[18] + (size_t)layer * NE * 2048};
            for (int rep = 0; rep < NREP(9); ++rep) pg8::gemm_phase<EpiSwiglu, pg8::MoeSched<8, true, 1024>, true, true>(F.lds, F.wave, S, E);
        } SEAM(p0 + 7);
        if (PHON(10) && IN(p0 + 8)) {
            moe_tables(F, layer);
            pg8::MoeSched<4, false, 1024> S{(const char*)(ws + WS_ACT), (const char*)(ws + WS_W2 + (size_t)layer * NE * 1024 * 1024), (const int*)(ws + WS_SLOT), (const LAS int*)(F.lds + LDS_TAB), F.G, blk_, (size_t)1024 * 1024};
            EpiMoeOut E{(bf16_t*)(ws + WS_YK), F.in[20] + (size_t)layer * NE * 1024, (const float*)(ws + WS_SGATE)};
            for (int rep = 0; rep < NREP(10); ++rep) pg8::gemm_phase<EpiMoeOut, pg8::MoeSched<4, false, 1024>, false, true>(F.lds, F.wave, S, E);
        } SEAM(p0 + 8);
        if (PHON(11) && IN(p0 + 9)) { phase_combine(F, layer); } SEAM(p0 + 9);
    }
#ifdef OVFL_PROBE
    int lane_z; asm volatile("v_mbcnt_lo_u32_b32 %0, -1, 0\n\tv_mbcnt_hi_u32_b32 %0, -1, %0" : "=v"(lane_z));
    if (hi == NPHASE && F.blk == 0 && F.wave == 0 && lane_z == 0) { int w = 0; float big = 1e6f, huge = 3e38f; asm volatile("" : "+v"(big), "+v"(huge));
      w = __builtin_amdgcn_cvt_pk_bf8_f32(big, huge, w, false); int w2 = 0; w2 = __builtin_amdgcn_cvt_pk_fp8_f32(big, huge, w2, false);
      if (((w & 0xffff) != 0x7B7B) || ((w2 & 0xffff) != 0x7E7E)) { asm volatile("s_waitcnt vmcnt(0)" ::: "memory"); F.out[5] = __builtin_nanf(""); } }
#endif
#undef IN
#undef SEAM
}


#ifdef DBG_CHECK
namespace dbg {
__device__ float blk_sum(float v, float* red) { const int t = threadIdx.x; red[t] = v; __syncthreads(); for (int o = 128; o > 0; o >>= 1) { if (t < o) red[t] += red[t + o]; __syncthreads(); } const float r = red[0]; __syncthreads(); return r; }
struct Ctx { const float* const* in; unsigned char* ws; float* red; };
__device__ float bfb(const unsigned char* ws, size_t off, size_t idx) { return bf2f(((const bf16_t*)(ws + off))[idx]); }
__device__ float zdot(const Ctx& c, int row, int ocol) {
    float a = 0.f; for (int k = threadIdx.x; k < 1024; k += 256) a += bfb(c.ws, WS_H, (size_t)row * 1024 + k) * c.in[7][(size_t)k * 4224 + ocol];
    return blk_sum(a, c.red);
}
__device__ void upd(float* flag, float got, float want) { const float e = fabsf(got - want) / (fabsf(want) + 0.05f); if (threadIdx.x == 0 && (e > *flag || !(e == e))) *flag = (e == e) ? e : 1e9f; }
__device__ float sc_buf(const Ctx& c, int which, int row, int col) { return bfb(c.ws, WS_SCAN + (size_t)which * SCAN_PITCH, (size_t)row * 384 + col); }
__device__ void naive_scan(const Ctx& c, const float* tab, int type, int b, int h, int dir, int n, float* S, float* o64) {
    const int t = threadIdx.x;
    for (int i = t; i < 4096; i += 256) S[i] = 0.f; __syncthreads();
    const float gam = tab[TB_GAM + 0 * 12 + dir * 6 + h];
    int lastrow = 0;
    for (int p = 0; p < n; ++p) {
        const int sc = p < 256 ? 0 : 1 + (p - 256) / 256, pl = p < 256 ? p : (p - 256) % 256; const int row = scan_row(sc, pl, dir, 0) + (sc == 0 ? b * CL : b * T); lastrow = row;
        for (int i = t; i < 4096; i += 256) { const int k = i >> 6, v = i & 63;
            const float kk = sc_buf(c, type ? SC_RK : (dir ? SC_KB : SC_KF), row, h * 64 + k), vv = sc_buf(c, type ? SC_RV : SC_HV, row, h * 64 + v);
            const float f = type ? gam : 1.f - kk; S[i] = f * S[i] + kk * vv; }
        __syncthreads();
    }
    if (t < 64) { float o = 0.f; for (int k = 0; k < 64; ++k) o += sc_buf(c, type ? SC_RQ : SC_HQ, lastrow, h * 64 + k) * S[k * 64 + t]; o64[t] = o; }
    __syncthreads();
}
__global__ void __launch_bounds__(256) k_check(Args args, float* flags) {
    __shared__ float red[256]; __shared__ float S[4096]; __shared__ float o1[64], o2[64];
    Ctx c{args.in, args.ws, red}; const int id = blockIdx.x, t = threadIdx.x; float* fl = flags + id;
    const float* tab = (const float*)(args.ws + WS_TAB);
    if (t == 0) { *fl = 0.f; if (id == 12) { flags[13] = 0.f; flags[14] = 0.f; flags[15] = 0.f; } } __syncthreads();
#define rows(i) ((i) == 0 ? 5 : (i) == 1 ? 20000 : 33000)
    if (id == 0) { for (int ri = 0; ri < 3; ++ri) for (int cc = 3; cc < 384; cc += 197) { const float z = zdot(c, rows(ri), cc); upd(fl, sc_buf(c, SC_HQ, rows(ri), cc), z); } }
    if (id == 1) { for (int ri = 0; ri < 3; ++ri) for (int cc = 3; cc < 384; cc += 197) { upd(fl, sc_buf(c, SC_HV, rows(ri), cc), zdot(c, rows(ri), 1152 + cc)); upd(fl, sc_buf(c, SC_RG, rows(ri), cc), zdot(c, rows(ri), 3072 + cc)); upd(fl, sc_buf(c, SC_HG, rows(ri), cc), zdot(c, rows(ri), 1536 + cc)); upd(fl, sc_buf(c, SC_RV, rows(ri), cc), zdot(c, rows(ri), 2688 + cc)); } }
    if (id == 2) { for (int ri = 0; ri < 3; ++ri) for (int cc = 3; cc < 384; cc += 197) { const float z1 = zdot(c, rows(ri), 384 + cc), z2 = zdot(c, rows(ri), 768 + cc); upd(fl, sc_buf(c, SC_KF, rows(ri), cc), 1.f / (1.f + expf(z1))); upd(fl, sc_buf(c, SC_KB, rows(ri), cc), 1.f / (1.f + expf(z2))); } }
    if (id == 3) { for (int ri = 0; ri < 3; ++ri) for (int hh = 0; hh < 6; hh += 5) for (int i = 1; i < 32; i += 13) for (int isk = 0; isk < 2; ++isk) { const int r = rows(ri); const bool ctx = r >= NLAT; const int tt = r & (T - 1);
            const float x1 = zdot(c, r, 1920 + 384 * isk + hh * 64 + i), x2 = zdot(c, r, 1920 + 384 * isk + hh * 64 + i + 32);
            const float ang = ctx ? 0.f : (float)tt * powf(10000.f, -(float)i / 32.f); const float cs = cosf(ang), sn = sinf(ang), scl = isk ? 0.125f : 1.f;
            upd(fl, sc_buf(c, isk ? SC_RK : SC_RQ, r, hh * 64 + 2 * i), (x1 * cs - x2 * sn) * scl); upd(fl, sc_buf(c, isk ? SC_RK : SC_RQ, r, hh * 64 + 2 * i + 1), (x2 * cs + x1 * sn) * scl); } }
    if (id == 4) { for (int ri = 0; ri < 3; ++ri) for (int mp = 0; mp < 8; mp += 7) for (int half = 0; half < 2; ++half) for (int j = 1; j < 8; j += 5) { const int r = rows(ri); const bool ctx = r >= NLAT; const int tt = ctx ? (r - NLAT) & 255 : r & (T - 1); const int bb = ctx ? (r - NLAT) >> 8 : r >> 14;
            const int pos = half ? (tt & 63) : (tt >> 6); const float ang = ctx ? 0.f : (float)pos * powf(10000.f, -(float)j / 8.f); const float cs = cosf(ang), sn = sinf(ang);
            { const float x1 = zdot(c, r, 3456 + mp * 32 + half * 16 + j), x2 = zdot(c, r, 3456 + mp * 32 + half * 16 + j + 8); const float scl = 0.17677669529663687f * LOG2E;
              const size_t qi = ctx ? ((size_t)(bb * 8 + mp) * CL + tt) * 32 + half * 16 + 2 * j : ((size_t)(bb * 8 + mp) * T + tt) * 32 + half * 16 + 2 * j;
              upd(fl, bfb(c.ws, ctx ? WS_QC : WS_QA, qi), (x1 * cs - x2 * sn) * scl); upd(fl, bfb(c.ws, ctx ? WS_QC : WS_QA, qi + 1), (x2 * cs + x1 * sn) * scl); }
            { const float x1 = zdot(c, r, 3712 + mp * 32 + half * 16 + j), x2 = zdot(c, r, 3712 + mp * 32 + half * 16 + j + 8);
              const int Lk = ctx ? tt : 256 + tt, tile = Lk >> 6, rr = Lk & 63, pw = half * 16 + 2 * j;
              const size_t ki = ((size_t)((bb * 8 + mp) * KT_TILES + tile) * 4 + (pw >> 3)) * 512 + rr * 8 + (pw & 7);
              upd(fl, bfb(c.ws, WS_KA, ki), x1 * cs - x2 * sn); upd(fl, bfb(c.ws, WS_KA, ki + 1), x2 * cs + x1 * sn); }
            { const int h4 = mp >> 1, w = half * 32 + j * 3; const float z = zdot(c, r, 3968 + h4 * 64 + w); const int Lk = ctx ? tt : 256 + tt, tile = Lk >> 6, rr = Lk & 63;
              upd(fl, bfb(c.ws, WS_VA, ((size_t)((bb * 4 + h4) * KT_TILES + tile) * 2 + (w >> 5)) * 2048 + rr * 32 + (w & 31)), z); } } }
    if (id == 5 || id == 6) {
        const int type = id - 5, b = 1, h = 2;
#define ts(i) ((i) == 0 ? 0 : (i) == 1 ? 1 : 300)
        for (int q = 0; q < 3; ++q) { naive_scan(c, tab, type, b, h, 0, 256 + ts(q) + 1, S, o1);
            if (t < 64) { const float got = ((const float*)(args.ws + WS_OSCR))[(size_t)(b * T + ts(q)) * 768 + type * 384 + h * 64 + t]; const float e = fabsf(got - o1[t]) / (fabsf(o1[t]) + 0.05f); if (e > 0.05f || !(e == e)) atomicMax((int*)fl, __float_as_int((e == e) ? e : 1e9f)); } __syncthreads(); }
    }
    if (id == 7 || id == 8) {
        const int type = id - 7, b = 1, h = 4;
        for (int q = 0; q < 2; ++q) {
            int row;
            if (q == 0) { naive_scan(c, tab, type, b, h, 0, 101, S, o1); naive_scan(c, tab, type, b, h, 1, 256 - 100, S, o2); row = NLAT + b * CL + 100; }
            else { naive_scan(c, tab, type, b, h, 1, 257, S, o2); row = b * T + T - 1; if (t < 64) o1[t] = ((const float*)(args.ws + WS_OSCR))[(size_t)row * 768 + type * 384 + h * 64 + t]; __syncthreads(); }
            float o = t < 64 ? o1[t] + o2[t] : 0.f; const float ss = blk_sum(o * o, red); const float r = rsqrtf(ss / 64.f + EPS);
            if (t < 64) { const float g = sc_buf(c, type ? SC_RG : SC_HG, row, h * 64 + t); const float want = o * r * args.in[type ? 11 : 9][t] * g / (1.f + expf(-g));
                const float got = bfb(c.ws, WS_MIX, (size_t)row * 1024 + type * 384 + h * 64 + t); const float e = fabsf(got - want) / (fabsf(want) + 0.05f); if (e > 0.05f || !(e == e)) atomicMax((int*)fl, __float_as_int((e == e) ? e : 1e9f)); }
            __syncthreads(); }
    }
    if (id == 9) {
        for (int q = 0; q < 2; ++q) { const bool ctx = q == 1; const int b = ctx ? 0 : 1, h = ctx ? 3 : 2, tq = ctx ? 77 : 5000; const int nk = ctx ? 256 : 16640;
            __shared__ float po[2][64]; __shared__ float pl[2];
            for (int m = 0; m < 2; ++m) { const int mp = b * 8 + 2 * h + m;
                float mx = -1e30f;
                for (int kk = t; kk < nk; kk += 256) { float sdot = 0.f; for (int d = 0; d < 32; ++d) { const float qv = bfb(c.ws, ctx ? WS_QC : WS_QA, ((size_t)mp * (ctx ? CL : T) + tq) * 32 + d); const float kv = bfb(c.ws, WS_KA, ((size_t)(mp * KT_TILES + (kk >> 6)) * 4 + (d >> 3)) * 512 + (kk & 63) * 8 + (d & 7)); sdot += qv * kv; } mx = fmaxf(mx, sdot); }
                red[t] = mx; __syncthreads(); for (int o = 128; o > 0; o >>= 1) { if (t < o) red[t] = fmaxf(red[t], red[t + o]); __syncthreads(); } mx = red[0]; __syncthreads();
                float ls = 0.f; float av[64];
_Pragma("unroll") for (int d = 0; d < 64; ++d) av[d] = 0.f;
                for (int kk = t; kk < nk; kk += 256) { float sdot = 0.f; for (int d = 0; d < 32; ++d) { const float qv = bfb(c.ws, ctx ? WS_QC : WS_QA, ((size_t)mp * (ctx ? CL : T) + tq) * 32 + d); const float kv = bfb(c.ws, WS_KA, ((size_t)(mp * KT_TILES + (kk >> 6)) * 4 + (d >> 3)) * 512 + (kk & 63) * 8 + (d & 7)); sdot += qv * kv; }
                    const float p = exp2f(sdot - mx); ls += p;
_Pragma("unroll") for (int d = 0; d < 64; ++d) av[d] += p * bfb(c.ws, WS_VA, ((size_t)((b * 4 + h) * KT_TILES + (kk >> 6)) * 2 + (d >> 5)) * 2048 + (kk & 63) * 32 + (d & 31)); }
                ls = blk_sum(ls, red);
_Pragma("unroll") for (int d = 0; d < 64; ++d) { const float sv = blk_sum(av[d], red); if (t == 0) po[m][d] = sv; } if (t == 0) pl[m] = ls; __syncthreads();
            }
            const float lam = tab[TB_LAM + 0], oml = tab[TB_LAM + 2];
            float o = t < 64 ? po[0][t] / pl[0] - lam * po[1][t] / pl[1] : 0.f; const float ss = blk_sum(o * o, red); const float r = rsqrtf(ss / 64.f + EPS);
            if (t < 64) { const float want = o * r * args.in[13][t] * oml; const size_t row = ctx ? (size_t)(NLAT + b * CL + tq) : (size_t)(b * T + tq); const float got = bfb(c.ws, WS_MIX, row * 1024 + 768 + h * 64 + t);
                const float e = fabsf(got - want) / (fabsf(want) + 0.05f); if (e > 0.05f || !(e == e)) atomicMax((int*)fl, __float_as_int((e == e) ? e : 1e9f)); }
            __syncthreads(); }
    }
    if (id == 10) { for (int ri = 0; ri < 3; ++ri) for (int cc = 7; cc < 1024; cc += 401) { float a = 0.f; for (int k = t; k < 1024; k += 256) a += bfb(c.ws, WS_MIX, (size_t)rows(ri) * 1024 + k) * args.in[14][(size_t)k * 1024 + cc]; a = blk_sum(a, red); upd(fl, ((const float*)(args.ws + WS_Y))[(size_t)rows(ri) * 1024 + cc], a); } }
    if (id == 11) {
        const float* modv = (const float*)(args.ws + WS_MODV);
        for (int ri = 0; ri < 3; ++ri) { const int r = rows(ri), w = row_which(r); const float* xs = r < NLAT ? args.in[0] + (size_t)r * D : args.in[2] + (size_t)(r - NLAT) * D; const float* y = (const float*)(args.ws + WS_Y) + (size_t)r * D;
            float sy = 0.f; for (int k = t; k < 1024; k += 256) sy += y[k] * y[k]; sy = blk_sum(sy, red); const float ry = rsqrtf(sy / 1024.f + EPS);
            float x1[4]; float sx = 0.f;
_Pragma("unroll") for (int q = 0; q < 4; ++q) { const int k = t + 256 * q; x1[q] = xs[k] + modv[(size_t)(w * 6 + 2) * 1024 + k] * y[k] * ry; sx += x1[q] * x1[q]; } sx = blk_sum(sx, red); const float rx = rsqrtf(sx / 1024.f + EPS);
_Pragma("unroll")
            for (int q = 0; q < 4; ++q) { const int k = t + 256 * q; const float tk = x1[q] * rx * modv[(size_t)(w * 6 + 3) * 1024 + k] + modv[(size_t)(w * 6 + 4) * 1024 + k];
                const float got = bfb(c.ws, WS_H, (size_t)r * 1024 + k), got1 = ((const float*)(args.ws + WS_X1))[(size_t)r * 1024 + k];
                const float e = fmaxf(fabsf(got - tk) / (fabsf(tk) + 0.05f), fabsf(got1 - x1[q]) / (fabsf(x1[q]) + 0.05f)); if (e > 0.05f || !(e == e)) atomicMax((int*)fl, __float_as_int((e == e) ? e : 1e9f)); }
            __syncthreads(); } }

    if (id == 12) {
        __shared__ float tokf[1024], lg[32], abuf[2048], actb[1024], yb[1024]; __shared__ int te[4]; __shared__ float tg[4]; __shared__ int spos;
        const unsigned* cnt = (const unsigned*)(args.ws + WS_CTL) + CW_CNT; const int* slot = (const int*)(args.ws + WS_SLOT);
        for (int ri = 0; ri < 3; ++ri) { const int r = rows(ri);
            for (int k = t; k < 1024; k += 256) tokf[k] = bfb(c.ws, WS_H, (size_t)r * 1024 + k); __syncthreads();
            if (t < 32) { float a = args.in[16][t]; for (int k = 0; k < 1024; ++k) a += tokf[k] * args.in[15][(size_t)k * 32 + t]; lg[t] = a; } __syncthreads();
            if (t < 32) { const float got = ((const float*)(args.ws + WS_END + 65536))[(size_t)r * 32 + t]; const float e = fabsf(got - lg[t]); if (e > 0.02f || !(e == e)) atomicMax((int*)(flags + 15), __float_as_int((e == e) ? 1.f + e : 1e9f)); } __syncthreads();
            if (t == 0) { float tv[4]; for (int k = 0; k < 4; ++k) { int bi = 0; float bv = -1e30f; for (int e = 0; e < 32; ++e) if (lg[e] > bv) { bv = lg[e]; bi = e; } te[k] = bi; tv[k] = bv; lg[bi] = -1e30f; }
                float sm = 0.f; for (int k = 0; k < 4; ++k) { tg[k] = expf(tv[k] - tv[0]); sm += tg[k]; } for (int k = 0; k < 4; ++k) tg[k] /= sm; } __syncthreads();
            if (t < 4) { const float got = ((const float*)(args.ws + WS_GATE))[(size_t)r * 4 + t]; const float e = fabsf(got - tg[t]) / (tg[t] + 0.01f); if (e > 0.05f || !(e == e)) atomicMax((int*)(flags + 12), __float_as_int((e == e) ? e : 1e9f)); }
            for (int k4 = 0; k4 < 4; ++k4) { const int e = te[k4]; const float* w1 = args.in[17] + (size_t)e * 1024 * 2048; const float* w2 = args.in[19] + (size_t)e * 1024 * 1024;
                for (int n = t; n < 2048; n += 256) { float a = args.in[18][(size_t)e * 2048 + n]; for (int k = 0; k < 1024; ++k) a += tokf[k] * w1[(size_t)k * 2048 + n]; abuf[n] = a; } __syncthreads();
                for (int j = t; j < 1024; j += 256) { const float g = fminf(abuf[2 * j], 7.f), l = fminf(fmaxf(abuf[2 * j + 1], -7.f), 7.f); actb[j] = g / (1.f + expf(-1.702f * g)) * (l + 1.f); } __syncthreads();
                for (int cc = t; cc < 1024; cc += 256) { float a = args.in[20][(size_t)e * 1024 + cc]; for (int j = 0; j < 1024; ++j) a += actb[j] * w2[(size_t)j * 1024 + cc]; yb[cc] = a * tg[k4]; } __syncthreads();
                if (t == 0) spos = -1; __syncthreads();
                const int ce = (int)cnt[e]; for (int p = t; p < ce; p += 256) if (slot[e * CAP + p] == r * 4 + k4) spos = p; __syncthreads();
                int ts0 = 0; for (int q = 0; q < e; ++q) ts0 += ((int)cnt[q] + 255) >> 8;
                float sqa = 0.f, sqy = 0.f; for (int k = t; k < 1024; k += 256) { sqa += actb[k] * actb[k]; sqy += yb[k] * yb[k]; } sqa = blk_sum(sqa, red); sqy = blk_sum(sqy, red); const float ra = sqrtf(sqa / 1024.f), ry = sqrtf(sqy / 1024.f);
                if (spos < 0) { if (t == 0) flags[13] = 7e8f; }
                else for (int k = t; k < 1024; k += 256) { const float got = bfb(c.ws, WS_ACT, ((size_t)ts0 * 256 + spos) * 1024 + k); const float er = fabsf(got - actb[k]) / (fabsf(actb[k]) + 0.2f * ra + 1e-6f); if (er > 0.05f || !(er == er)) atomicMax((int*)(flags + 13), __float_as_int((er == er) ? er : 1e9f)); }
                for (int k = t; k < 1024; k += 256) { const float got = bfb(c.ws, WS_YK, ((size_t)r * 4 + k4) * 1024 + k); const float er = fabsf(got - yb[k]) / (fabsf(yb[k]) + 0.2f * ry + 1e-6f); if (er > 0.05f || !(er == er)) atomicMax((int*)(flags + 14), __float_as_int((er == er) ? er : 1e9f)); }
                __syncthreads(); }
        } }
}
__global__ void k_out(Args args, const float* flags, int nchk, unsigned mask) {
    int code = 0; for (int i = nchk - 1; i >= 0; --i) if (((mask >> i) & 1u) && flags[i] > 0.05f) code = i + 1;
    const float sc = 1.f + (float)code;
    for (size_t i = (size_t)blockIdx.x * blockDim.x + threadIdx.x; i < (size_t)NLAT * D; i += (size_t)gridDim.x * blockDim.x) args.out[i] = args.in[0][i] * sc;
}
}
#endif

extern "C" void kernel_launch(void* const* d_in, const int* in_sizes, int n_in, void* d_out, int out_size, void* d_ws, size_t ws_size, hipStream_t stream) {
    static int grid = 0;
    if (grid == 0) {
        if (n_in != 21 || out_size != NLAT * D || ws_size < WS_END) { fprintf(stderr, "kernel_launch: unexpected shapes (n_in %d out %d ws %zu)\n", n_in, out_size, ws_size); grid = -1; return; }
        int dev = 0, cus = 0, per_cu = 0;
        if (hipGetDevice(&dev) != hipSuccess || hipDeviceGetAttribute(&cus, hipDeviceAttributeMultiprocessorCount, dev) != hipSuccess) { grid = -1; return; }
        if (hipFuncSetAttribute((const void*)mk_fwd<3>, hipFuncAttributeMaxDynamicSharedMemorySize, LDS_BYTES) != hipSuccess) { fprintf(stderr, "kernel_launch: hipFuncSetAttribute failed\n"); grid = -1; return; }
        if (hipOccupancyMaxActiveBlocksPerMultiprocessor(&per_cu, (const void*)mk_fwd<3>, NTHR, LDS_BYTES) != hipSuccess || per_cu < 1) fprintf(stderr, "kernel_launch: occupancy query reports %d\n", per_cu);
        (void)hipGetLastError();
        grid = cus;
    }
    if (grid < 0) return;
    if (hipMemsetAsync((char*)d_ws + WS_CTL, 0, CTL_ZERO_BYTES, stream) != hipSuccess) return;
    Args a{};
    for (int i = 0; i < 21; ++i) a.in[i] = (const float*)d_in[i];
    a.out = (float*)d_out; a.ws = (unsigned char*)d_ws;
#if MK_ONE_LAUNCH
    a.ph_lo = 0; a.ph_hi = NPHASE;
    hipLaunchKernelGGL(mk_fwd<3>, dim3(grid), dim3(NTHR), LDS_BYTES, stream, a);
#elif defined(DBG_CHECK)
    for (int p = 0; p < DBG_CHECK; ++p) { a.ph_lo = p; a.ph_hi = p + 1; hipLaunchKernelGGL(mk_fwd<3>, dim3(grid), dim3(NTHR), LDS_BYTES, stream, a); }
    float* flags = (float*)((char*)d_ws + WS_END);
    hipLaunchKernelGGL(dbg::k_check, dim3(13), dim3(256), 0, stream, a, flags);
    hipLaunchKernelGGL(dbg::k_out, dim3(1024), dim3(256), 0, stream, a, (const float*)flags, 16, (unsigned)DBG_MASK);
#else
    if (hipFuncSetAttribute((const void*)mk_fwd<PROBE_SUB>, hipFuncAttributeMaxDynamicSharedMemorySize, LDS_BYTES) != hipSuccess) return;
    for (int p = 0; p < NPHASE; ++p) { a.ph_lo = p; a.ph_hi = p + 1; hipLaunchKernelGGL(mk_fwd<3>, dim3(grid), dim3(NTHR), LDS_BYTES, stream, a);
        const int pid = p < 2 ? p : 2 + (p - 2) % PH_PER_LAYER;
        if (pid == PROBE_PH) hipLaunchKernelGGL(mk_fwd<PROBE_SUB>, dim3(grid), dim3(NTHR), LDS_BYTES, stream, a); }
#endif
}
```

```cpp
#include <hip/hip_runtime.h>
#include <cstdio>
#include <cstdint>
#include <cmath>

#ifndef DBG_MASK
#define DBG_MASK 0xf800
#endif
#ifndef PHMASK
#define PHMASK 0xfff
#endif
#define PHON(k) ((PHMASK >> (k)) & 1)
#ifndef REPMASK
#define REPMASK 0
#endif
#define NREP(k) (1 + ((REPMASK >> (k)) & 1))
#ifndef ATTVAR
#define ATTVAR -1
#endif
#ifndef MK_ONE_LAUNCH
#define MK_ONE_LAUNCH 1
#endif
#define MAIN_SUB 3
#define PROBE_PH -1
#define PROBE_SUB 3
#define PROBE_REP 1

#define LAS __attribute__((address_space(3)))
#define GAS __attribute__((address_space(1)))
typedef unsigned short bf16_t;
typedef short bf16x8 __attribute__((ext_vector_type(8)));
typedef short s16x4 __attribute__((ext_vector_type(4)));
typedef float f32x2 __attribute__((ext_vector_type(2)));
typedef float f32x4 __attribute__((ext_vector_type(4)));
typedef float f32x16 __attribute__((ext_vector_type(16)));
typedef unsigned u32x2 __attribute__((ext_vector_type(2)));
typedef unsigned u32x4 __attribute__((ext_vector_type(4)));
typedef GAS unsigned gu32;
typedef int v4i __attribute__((ext_vector_type(4)));
typedef int v8i __attribute__((ext_vector_type(8)));

constexpr int NB = 2, T = 16384, CL = 256, D = 1024;
constexpr int NLAT = NB * T, NCTX = NB * CL, NROW = NLAT + NCTX;
constexpr int NE = 32, CAP = NROW;
constexpr int NIN = 4352;
constexpr int NSEQ = 48, NSC = 65;
constexpr int KT_TILES = 260;
constexpr float EPS = 1e-6f;
constexpr float LOG2E = 1.4426950408889634f;
constexpr int NWAVES = 8, NTHR = 512;

constexpr size_t MiB = 1u << 20;
constexpr size_t WS_CTL = 0, CTL_ZERO_BYTES = 64 * 1024;
constexpr size_t WS_MODV = 1 * MiB;
constexpr size_t WS_TAB = 1 * MiB + 256 * 1024;
constexpr size_t WS_RWT = 1 * MiB + 512 * 1024;
constexpr size_t WS_ROPE = 2 * MiB;
constexpr size_t WS_WIN = 6 * MiB;
constexpr size_t WS_WOUT = 23 * MiB;
constexpr size_t WS_W1 = 27 * MiB;
constexpr size_t WS_W2 = 283 * MiB;
constexpr size_t WS_X1 = 411 * MiB;
constexpr size_t WS_H = 541 * MiB;
constexpr size_t WS_SCAN = 606 * MiB;
constexpr size_t SCAN_PITCH = 25 * MiB;
constexpr size_t WS_QA = 831 * MiB;
constexpr size_t WS_QC = 847 * MiB;
constexpr size_t WS_KA = 848 * MiB;
constexpr size_t WS_VA = 865 * MiB;
constexpr size_t WS_SLOC = 882 * MiB;
constexpr size_t WS_SIN = 931 * MiB;
constexpr size_t WS_DEC = 980 * MiB;
constexpr size_t WS_OSCR = 981 * MiB;
constexpr size_t WS_MIX = 1079 * MiB;
constexpr size_t WS_Y = 1144 * MiB;
constexpr size_t WS_SLOT = 1274 * MiB;
constexpr size_t WS_GATE = 1279 * MiB;
constexpr size_t WS_ACT = 1280 * MiB;
constexpr size_t WS_YK = 1540 * MiB;
constexpr size_t WS_TOK8 = 1816 * MiB;
constexpr size_t WS_SGATE = 1850 * MiB;
constexpr size_t WS_END = 1856 * MiB;
enum { SC_KF = 0, SC_KB = 1, SC_RQ = 2, SC_RK = 3, SC_HQ = 4, SC_HV = 5, SC_HG = 6, SC_RV = 7, SC_RG = 8 };
constexpr int CW_TMO = 0, CW_BAR = 4096, CW_CNT = 8192;
constexpr int TB_LBT = 0;
constexpr int TB_LAM = 1024;
constexpr int TB_GAM = 1040;
constexpr int TB_AXR = 2048;
constexpr int TB_AXC = 2048 + 4096;

constexpr int LDS_BYTES = 147456;
constexpr int LDS_MISC = 131072 + 12288;
constexpr int LDS_TAB = 131072;

__device__ __forceinline__ unsigned f2bf(float f) { unsigned u = __builtin_bit_cast(unsigned, f); return (u + 0x7fffu + ((u >> 16) & 1u)) >> 16; }
__device__ __forceinline__ float bf2f(unsigned short b) { return __builtin_bit_cast(float, (unsigned)b << 16); }
__device__ __forceinline__ float bflo(unsigned w) { return __builtin_bit_cast(float, w << 16); }
__device__ __forceinline__ float bfhi(unsigned w) { return __builtin_bit_cast(float, w & 0xffff0000u); }
typedef __bf16 bf16x2_t __attribute__((ext_vector_type(2)));
__device__ __forceinline__ unsigned trunc_pk_bf16(float lo, float hi) { return __builtin_amdgcn_perm(__builtin_bit_cast(unsigned, hi), __builtin_bit_cast(unsigned, lo), 0x07060302u); }
__device__ __forceinline__ unsigned cvt_pk_bf16(float lo, float hi) { const f32x2 v = {lo, hi}; const bf16x2_t b = __builtin_convertvector(v, bf16x2_t); return __builtin_bit_cast(unsigned, b); }
__device__ __forceinline__ unsigned pk2(float lo, float hi) { return cvt_pk_bf16(lo, hi); }
__device__ __forceinline__ float wave_sum_dpp(float v) {
#define DPP_ADD(ctrl, rmask) v += __builtin_bit_cast(float, __builtin_amdgcn_update_dpp(0, __builtin_bit_cast(int, v), ctrl, rmask, 0xF, false))
    DPP_ADD(0xB1, 0xF); DPP_ADD(0x4E, 0xF); DPP_ADD(0x141, 0xF); DPP_ADD(0x140, 0xF); DPP_ADD(0x142, 0xA); DPP_ADD(0x143, 0xC);
#undef DPP_ADD
    return __builtin_bit_cast(float, __builtin_amdgcn_readlane(__builtin_bit_cast(int, v), 63));
}
__device__ __forceinline__ float wave_sum(float v) { return wave_sum_dpp(v); }
template <int M> __device__ __forceinline__ float xor_swz(float v) { return __builtin_bit_cast(float, __builtin_amdgcn_ds_swizzle(__builtin_bit_cast(int, v), 0x1F | (M << 10))); }
__device__ __forceinline__ float xor32(float v, int lane) { return __builtin_bit_cast(float, __builtin_amdgcn_ds_bpermute((lane ^ 32) << 2, __builtin_bit_cast(int, v))); }
__device__ __forceinline__ float rdlane(float v, int l) { return __builtin_bit_cast(float, __builtin_amdgcn_readlane(__builtin_bit_cast(int, v), l)); }
__device__ __forceinline__ float sigmoidf_(float x) { return __builtin_amdgcn_rcpf(1.f + __builtin_amdgcn_exp2f(-LOG2E * x)); }
#define PHASE_IDS_W(WV) int lane; asm volatile("v_mbcnt_lo_u32_b32 %0, -1, 0\n\tv_mbcnt_hi_u32_b32 %0, -1, %0" : "=v"(lane)); int wave = (WV); asm volatile("" : "+s"(wave)); const int tid = wave * 64 + lane; (void)tid
#define PHASE_IDS() PHASE_IDS_W(F.wave); int blk_ = F.blk; asm volatile("" : "+s"(blk_))
__device__ __forceinline__ unsigned pk4_fp8(float a, float b, float c, float d) { int w = __builtin_bit_cast(int, a); w = __builtin_amdgcn_cvt_pk_fp8_f32(a, b, w, false); w = __builtin_amdgcn_cvt_pk_fp8_f32(c, d, w, true); return (unsigned)w; }
constexpr float W8_MUL = 64.f;
constexpr int SCALE_W8 = 0x79797979, SCALE_A8 = 0x7F7F7F7F;
#define LDS_WAIT() asm volatile("s_waitcnt lgkmcnt(0)" ::: "memory")
#define VM_WAIT() asm volatile("s_waitcnt vmcnt(0)" ::: "memory")

#define XB_TMO      128
#define XB_XCNT(j)  (256  + 64 * (j))
#define XB_XSUB(j)  (1280 + 64 * (j))
#define XB_XGEN(j)  (2304 + 64 * (j))
#define XB_TOP      3328
#define XB_TOPGEN   3392
#define XCD_BAR_WORDS 3456
#define XB_SPIN_CAP (1u << 22)
__device__ __forceinline__ unsigned xb_ld(unsigned* p)              { return __hip_atomic_load(p, __ATOMIC_RELAXED, __HIP_MEMORY_SCOPE_AGENT); }
__device__ __forceinline__ unsigned xb_add(unsigned* p, unsigned v) { return __hip_atomic_fetch_add(p, v, __ATOMIC_RELAXED, __HIP_MEMORY_SCOPE_AGENT); }
__device__ __forceinline__ unsigned xb_xcc_id() { return (unsigned)__builtin_amdgcn_s_getreg((3 << 11) | 20) & 0xFu; }
#define XB_SPIN(cond, bar) do { unsigned _sp = 0; while (cond) { __builtin_amdgcn_s_sleep(1); \
    if ((++_sp & 255u) == 0u) { if (xb_ld(&(bar)[XB_TMO])) break; if (_sp > XB_SPIN_CAP) { atomicAdd(&(bar)[XB_TMO], 1u); break; } } } } while (0)
struct XcdBarrier { unsigned* bar; unsigned x; volatile LAS unsigned* st; };
__device__ __forceinline__ XcdBarrier xcd_barrier_post(unsigned* bar, volatile LAS unsigned* st) {
    XcdBarrier b; b.bar = bar; b.x = xb_xcc_id(); b.st = st;
    if (threadIdx.x == 0) (void)xb_add(&bar[XB_XCNT(b.x)], 1u);
    return b;
}
__device__ __forceinline__ void xcd_barrier_complete(unsigned* bar, unsigned x, unsigned& nloc, unsigned& nx) {
    const unsigned G = gridDim.x * gridDim.y * gridDim.z;
    unsigned sum, cnt, mine, sp = 0u;
    for (;;) {
        sum = 0u; cnt = 0u; mine = 0u;
#pragma unroll
        for (unsigned j = 0; j < 16; ++j) { const unsigned c = xb_ld(&bar[XB_XCNT(j)]); sum += c; cnt += (c > 0u) ? 1u : 0u; mine = (j == x) ? c : mine; }
        if (sum == G) break;
        __builtin_amdgcn_s_sleep(1);
        if ((++sp & 255u) == 0u) { if (xb_ld(&bar[XB_TMO])) break; if (sp > XB_SPIN_CAP) { atomicAdd(&bar[XB_TMO], 1u); break; } }
    }
    nloc = mine > 0u ? mine : 1u; nx = cnt > 0u ? cnt : 1u;
}
__device__ __forceinline__ void xcd_barrier_census(const XcdBarrier& b) {
    unsigned nloc, nx; xcd_barrier_complete(b.bar, b.x, nloc, nx); b.st[0] = nloc; b.st[1] = nx;
}
__device__ __forceinline__ void xcd_barrier(const XcdBarrier& b) {
    asm volatile("s_waitcnt vmcnt(0)" ::: "memory");
    __syncthreads();
    if (threadIdx.x == 0) {
        unsigned* bar = b.bar;
        __builtin_amdgcn_s_waitcnt(0);
        const unsigned nloc = b.st[0], nx = b.st[1];
        const unsigned old = xb_add(&bar[XB_XSUB(b.x)], 1u);
        const unsigned gen = old / nloc;
        if (old + 1u == (gen + 1u) * nloc) {
            __builtin_amdgcn_fence(__ATOMIC_RELEASE, "agent");
            asm volatile("s_waitcnt vmcnt(0)" ::: "memory");
            const unsigned og = xb_add(&bar[XB_TOP], 1u);
            const unsigned tg = og / nx;
            if (og + 1u == (tg + 1u) * nx) xb_add(&bar[XB_TOPGEN], 1u);
            else XB_SPIN(xb_ld(&bar[XB_TOPGEN]) == tg, bar);
            __builtin_amdgcn_fence(__ATOMIC_ACQUIRE, "agent");
            xb_add(&bar[XB_XGEN(b.x)], 1u);
            asm volatile("s_waitcnt vmcnt(0)" ::: "memory");
        } else {
            XB_SPIN(xb_ld(&bar[XB_XGEN(b.x)]) == gen, bar);
            __builtin_amdgcn_fence(__ATOMIC_ACQUIRE, "agent");
            asm volatile("s_waitcnt vmcnt(0)" ::: "memory");
        }
    }
    __syncthreads();
}

#ifndef STAG_STEP
#define STAG_STEP 0
#endif
#ifndef STAG_SHORT
#define STAG_SHORT 13000
#endif
#define STAG_EN_IN ((SUB & 8) != 0)
#define STAG_EN_OUT ((SUB & 16) != 0)
#define STAG_EN_G2 ((SUB & 32) != 0)
__device__ __forceinline__ void stagger_ns(int ns) {
    if (ns <= 0) return;
    const unsigned long long t0 = __builtin_amdgcn_s_memrealtime(), dt = (unsigned long long)(ns / 10);
    while (__builtin_amdgcn_s_memrealtime() - t0 < dt) __builtin_amdgcn_s_sleep(8);
}
__device__ __forceinline__ void stagger_dense(int nwg, int G, int c) {
    const int cnt = (nwg - c + G - 1) / G, nmax = (nwg + G - 1) / G;
    stagger_ns(c * STAG_STEP + (cnt < nmax ? STAG_SHORT : 0));
}
struct Frame {
    LAS unsigned char* lds;
    unsigned char* ws;
    const float* in[21];
    float* out;
    gu32* ctl;
    int tid, lane, wave, G, blk;
};

__device__ __forceinline__ void glds16(const void* sbase, unsigned voff, unsigned lds_dst) { unsigned keep;
    asm volatile("s_mov_b32 %0, m0\n\ts_mov_b32 m0, %3\n\ts_nop 0\n\tglobal_load_lds_dwordx4 %1, %2\n\ts_mov_b32 m0, %0" : "=&s"(keep) : "v"(voff), "s"(sbase), "s"(lds_dst) : "memory"); }

namespace pg8 {
constexpr int BM = 256, BK = 64, HALF = 128, HTB = HALF * BK * 2, STAGE_BYTES = 8 * HTB, NXCD = 8, WGM = 8, K = 1024;
__host__ __device__ __forceinline__ int lds_byte(int r, int c) { const int st = (r >> 4) * 2 + (c >> 5), rr = r & 15, cc = c & 31, ob = rr * 64 + cc * 2; return st * 1024 + (ob ^ (((ob >> 9) & 1) << 5)); }
__host__ __device__ __forceinline__ void stage_rc(int b, int& R, int& C) { const int st = b / 1024, sb = b % 1024, swz = sb ^ (((sb >> 9) & 1) << 5); R = (st >> 1) * 16 + swz / 64; C = (st & 1) * 32 + (swz % 64) / 2; }
__host__ __device__ __forceinline__ int perm32(int rho) { const int n = rho >> 4, i = rho & 15; return 8 * (i >> 2) + 4 * n + (i & 3); }
struct Unit { int pm, pn, e, nvalid, sbase; };
template <class Epi, class Sched, bool GATHER, bool FP8 = false, bool NOEPI = false>
__device__ __forceinline__ void gemm_phase(LAS unsigned char* lds, int wave_id, const Sched& S, const Epi& E) {
    constexpr int KB = FP8 ? 1024 : 2048, NT = KB / 128;
    PHASE_IDS_W(wave_id); const int wid = wave, wr = wid >> 2, wc = wid & 3, fr = lane & 15, fq = lane >> 4;
    unsigned voffB[2], vA[2][2]; int R0, C0;
    { int R, C; stage_rc(tid * 16, R, C); R0 = R; C0 = C;
#pragma unroll
      for (int i = 0; i < 2; ++i) { const int Ri = R + 64 * i; const int Rb = Epi::PERM ? ((Ri & ~31) + perm32(Ri & 31)) : Ri; voffB[i] = (unsigned)(Rb * KB + C * 2);
#pragma unroll
          for (int h = 0; h < 2; ++h) vA[h][i] = (unsigned)((Ri + 128 * h) * KB + C * 2); } }
    const size_t kstep = (size_t)(BK * 2);
    const size_t hstep = (size_t)HALF * KB;
    const unsigned ldsw = (unsigned)wid * 1024u, lds0 = (unsigned)(uintptr_t)lds;
    const int aoff = lds_byte(wr * 64 + fr, fq * 8), boff = lds_byte(wc * 32 + fr, fq * 8);
#define PG8_SA(b, h) (((b) * 2 + (h)) * HTB)
#define PG8_SB(b, h) ((4 + (b) * 2 + (h)) * HTB)
#define PG8_STAGE(bufoff, gbase, voff) do { _Pragma("unroll") for (int _i = 0; _i < 2; ++_i) \
        glds16((const void*)(gbase), (voff)[_i], (unsigned)__builtin_amdgcn_readfirstlane(lds0 + (unsigned)(bufoff) + ldsw + _i * 8192)); } while (0)
#define PG8_LDA(dst, b, h) do { _Pragma("unroll") for (int m = 0; m < 4; ++m) { dst[m].lo = *(const LAS v4i*)(lds + PG8_SA(b, h) + aoff + m * 2048); dst[m].hi = *(const LAS v4i*)(lds + PG8_SA(b, h) + aoff + m * 2048 + 1024); } } while (0)
#define PG8_LDB(dst, b, h) do { _Pragma("unroll") for (int n = 0; n < 2; ++n) { dst[n].lo = *(const LAS v4i*)(lds + PG8_SB(b, h) + boff + n * 2048); dst[n].hi = *(const LAS v4i*)(lds + PG8_SB(b, h) + boff + n * 2048 + 1024); } } while (0)
#define PG8_MMA(ai, bj, At, Bt) do { __builtin_amdgcn_s_setprio(1); _Pragma("unroll") for (int m = 0; m < 4; ++m) _Pragma("unroll") for (int n = 0; n < 2; ++n) { \
        if constexpr (FP8) acc[ai][bj][m][n] = __builtin_amdgcn_mfma_scale_f32_16x16x128_f8f6f4(Bt[n], At[m], acc[ai][bj][m][n], 0, 0, 0, SCALE_W8, 0, SCALE_A8); \
        else { acc[ai][bj][m][n] = __builtin_amdgcn_mfma_f32_16x16x32_bf16(__builtin_bit_cast(bf16x8, (v4i)Bt[n].lo), __builtin_bit_cast(bf16x8, (v4i)At[m].lo), acc[ai][bj][m][n], 0, 0, 0); \
               acc[ai][bj][m][n] = __builtin_amdgcn_mfma_f32_16x16x32_bf16(__builtin_bit_cast(bf16x8, (v4i)Bt[n].hi), __builtin_bit_cast(bf16x8, (v4i)At[m].hi), acc[ai][bj][m][n], 0, 0, 0); } } \
        __builtin_amdgcn_s_setprio(0); } while (0)
#define PG8_WAIT_V(n) asm volatile("s_waitcnt vmcnt(" #n ")" ::: "memory")
#define PG8_WAIT_L(n) asm volatile("s_waitcnt lgkmcnt(" #n ")" ::: "memory")
#define PG8_BAR __builtin_amdgcn_s_barrier()
#define PG8_SCHED __builtin_amdgcn_sched_barrier(0)
    Unit cur, nxt; int ui = 0;
    if (!S.next(0, cur)) return;
    f32x4 acc[2][2][4][2];
#pragma unroll
    for (int a = 0; a < 2; ++a)
#pragma unroll
        for (int b = 0; b < 2; ++b)
#pragma unroll
            for (int m = 0; m < 4; ++m)
#pragma unroll
                for (int n = 0; n < 2; ++n) acc[a][b][m][n] = (f32x4){0.f, 0.f, 0.f, 0.f};
    v8i At[4], B0[2], B1[2];
    const char* cA = S.a_ptr(cur); const char* cB = S.b_ptr(cur);
    unsigned nvA[2][2];
    if constexpr (GATHER) S.a_off(cur, R0, C0, vA);
    PG8_STAGE(PG8_SB(0, 0), cB, voffB); PG8_STAGE(PG8_SB(0, 1), cB + hstep, voffB); PG8_STAGE(PG8_SA(0, 0), cA, vA[0]); PG8_STAGE(PG8_SA(0, 1), cA, vA[1]);
    if (wr == 1) PG8_BAR;
    PG8_WAIT_V(2); PG8_BAR;
    PG8_STAGE(PG8_SB(1, 0), cB + kstep, voffB); PG8_STAGE(PG8_SA(1, 0), cA + kstep, vA[0]); PG8_STAGE(PG8_SB(1, 1), cB + hstep + kstep, voffB);
    PG8_WAIT_V(6); PG8_BAR;
    for (;;) {
        const bool has_next = S.next(ui + 1, nxt);
        const char* nA = has_next ? S.a_ptr(nxt) : cA; const char* nB = has_next ? S.b_ptr(nxt) : cB;
        if constexpr (GATHER) { if (has_next) S.a_off(nxt, R0, C0, nvA); }
#pragma unroll 1
        for (int t = 0; t < NT; t += 2) {
            const bool last = (t == NT - 2);
            const char* a1 = cA + (size_t)(t + 1) * kstep;
            const char* a2 = last ? nA : cA + (size_t)(t + 2) * kstep; const char* b2 = last ? nB : cB + (size_t)(t + 2) * kstep;
            const char* a3 = a2 + kstep; const char* b3 = b2 + kstep;
            PG8_LDB(B0, 0, 0); PG8_LDB(B1, 0, 1); PG8_SCHED; PG8_LDA(At, 0, 0); PG8_STAGE(PG8_SA(1, 1), a1, vA[1]);
            if constexpr (GATHER) { if (last && has_next) {
#pragma unroll
                for (int h = 0; h < 2; ++h)
#pragma unroll
                    for (int i = 0; i < 2; ++i) vA[h][i] = nvA[h][i]; } }
            PG8_WAIT_V(8); PG8_WAIT_L(0); PG8_BAR; PG8_MMA(0, 0, At, B0); PG8_MMA(0, 1, At, B1); PG8_BAR; PG8_SCHED;
            PG8_LDA(At, 0, 1); PG8_STAGE(PG8_SB(0, 0), b2, voffB); PG8_STAGE(PG8_SB(0, 1), b2 + hstep, voffB); PG8_STAGE(PG8_SA(0, 0), a2, vA[0]);
            PG8_WAIT_V(8); PG8_WAIT_L(0); PG8_BAR; PG8_MMA(1, 0, At, B0); PG8_MMA(1, 1, At, B1); PG8_BAR; PG8_SCHED;
            PG8_LDB(B0, 1, 0); PG8_LDB(B1, 1, 1); PG8_SCHED; PG8_LDA(At, 1, 0); PG8_STAGE(PG8_SA(0, 1), a2, vA[1]);
            PG8_WAIT_V(8); PG8_WAIT_L(0); PG8_BAR; PG8_MMA(0, 0, At, B0); PG8_MMA(0, 1, At, B1); PG8_BAR; PG8_SCHED;
            PG8_LDA(At, 1, 1); PG8_STAGE(PG8_SB(1, 0), b3, voffB); PG8_STAGE(PG8_SB(1, 1), b3 + hstep, voffB); PG8_STAGE(PG8_SA(1, 0), a3, vA[0]);
            PG8_WAIT_V(8); PG8_WAIT_L(0); PG8_BAR; PG8_MMA(1, 0, At, B0); PG8_MMA(1, 1, At, B1); PG8_BAR; PG8_SCHED;
        }
        if (wr == 0) PG8_BAR;
        if constexpr (NOEPI) {
#pragma unroll
            for (int a = 0; a < 2; ++a)
#pragma unroll
                for (int b = 0; b < 2; ++b)
#pragma unroll
                    for (int m = 0; m < 4; ++m)
#pragma unroll
                        for (int n = 0; n < 2; ++n) asm volatile("" :: "v"(acc[a][b][m][n]));
        } else
        { int le; asm volatile("v_mbcnt_lo_u32_b32 %0, -1, 0\n\tv_mbcnt_hi_u32_b32 %0, -1, %0" : "=v"(le)); E(acc, cur, wr, wc, le & 15, le >> 4); }
        if (!has_next) break;
#pragma unroll
        for (int a = 0; a < 2; ++a)
#pragma unroll
            for (int b = 0; b < 2; ++b)
#pragma unroll
                for (int m = 0; m < 4; ++m)
#pragma unroll
                    for (int n = 0; n < 2; ++n) acc[a][b][m][n] = (f32x4){0.f, 0.f, 0.f, 0.f};
        cur = nxt; cA = nA; cB = nB; ++ui;
        if (wr == 1) PG8_BAR;
    }
    PG8_WAIT_V(0);
    PG8_BAR;
#undef PG8_SA
#undef PG8_SB
#undef PG8_STAGE
#undef PG8_LDA
#undef PG8_LDB
#undef PG8_MMA
#undef PG8_WAIT_V
#undef PG8_WAIT_L
#undef PG8_BAR
#undef PG8_SCHED
}

struct DenseSched {
    const char* A; const char* Bt; int nM, nN, nwg, G, c;
    __device__ __forceinline__ void init(const void* A_, const void* Bt_, int M, int N, int G_, int c_) { A = (const char*)A_; Bt = (const char*)Bt_; nM = M / BM; nN = N / BM; nwg = nM * nN; G = G_; c = c_; }
    __device__ __forceinline__ bool next(int i, Unit& u) const {
        const long L = (long)i * G + c; if (L >= nwg) return false;
        int wgid = (int)L; { const int q = nwg / NXCD, r = nwg % NXCD, xcd = wgid % NXCD, off = wgid / NXCD; wgid = (xcd < r ? xcd * (q + 1) : r * (q + 1) + (xcd - r) * q) + off; }
        const int nig = WGM * nN, gid = wgid / nig, fm = gid * WGM, gsz = (nM - fm) < WGM ? (nM - fm) : WGM;
        u.pm = fm + ((wgid % nig) % gsz); u.pn = (wgid % nig) / gsz; u.e = 0; u.nvalid = 256; u.sbase = 0; return true;
    }
    __device__ __forceinline__ const char* a_ptr(const Unit& u) const { return A + (size_t)u.pm * (BM * K * 2); }
    __device__ __forceinline__ const char* b_ptr(const Unit& u) const { return Bt + (size_t)u.pn * (BM * K * 2); }
    __device__ __forceinline__ void a_off(const Unit&, int, int, unsigned (&)[2][2]) const {}
};
template <int NPN, bool GATHER_A, int KB> struct MoeSched {
    const char* A; const char* Bt; const int* slot; const LAS int* tab; int G, c; size_t bstride;
    __device__ __forceinline__ bool next(int i, Unit& u) const {
        const int ntile = __builtin_amdgcn_readfirstlane(tab[32]);
        int mtg;
        if ((G & 7) == 0) { const int x = c & 7, j = (c >> 3) + (G >> 3) * i; u.pn = j % NPN; mtg = (j / NPN) * 8 + x; if (mtg >= ntile) return false; }
        else { const int lin = i * G + c; if (lin >= ntile * NPN) return false; u.pn = lin % NPN; mtg = lin / NPN; }
        int e = 0;
        while (e < 31 && __builtin_amdgcn_readfirstlane(tab[e + 1]) <= mtg) ++e;
        const int mtl = mtg - __builtin_amdgcn_readfirstlane(tab[e]); int nv = __builtin_amdgcn_readfirstlane(tab[33 + e]) - 256 * mtl; nv = nv > 256 ? 256 : nv;
        u.pm = mtg; u.e = e; u.nvalid = nv; u.sbase = e * CAP + 256 * mtl; return true;
    }
    __device__ __forceinline__ const char* a_ptr(const Unit& u) const { return GATHER_A ? A : A + (size_t)u.pm * (BM * KB); }
    __device__ __forceinline__ const char* b_ptr(const Unit& u) const { return Bt + (size_t)u.e * bstride + (size_t)u.pn * (BM * KB); }
    __device__ __forceinline__ void a_off(const Unit& u, int R0, int C0, unsigned (&v)[2][2]) const {
#pragma unroll
        for (int h = 0; h < 2; ++h)
#pragma unroll
            for (int i = 0; i < 2; ++i) { const int rl = h * 128 + R0 + 64 * i; const int id = (rl < u.nvalid) ? slot[u.sbase + rl] : 0; v[h][i] = (unsigned)(id >> 2) * (unsigned)KB + (unsigned)C0 * 2u; }
    }
};
}

struct EpiInProj {
    static constexpr bool PERM = true;
    unsigned char* ws; const float* tab; const float* rope; int layer;
    template <int TYPE> __device__ __forceinline__ void run(const f32x4 (&acc)[2][2][4][2], const pg8::Unit& u, int wr, int wc, int fr, int fq) const {
        asm volatile("" : "+v"(fr), "+v"(fq));
        const int pn = u.pn, pm = u.pm; const bool ctx = pm >= 128;
        const int bb = ctx ? (pm - 128) : (pm >> 6);
#pragma unroll
        for (int ai = 0; ai < 2; ++ai)
#pragma unroll
            for (int m = 0; m < 4; ++m) {
                const int rl = 128 * ai + 64 * wr + 16 * m + fr; const int row = pm * 256 + rl;
                const int tt = ctx ? rl : (row & (T - 1));
                const int Lk = ctx ? tt : 256 + tt; const int ktile = Lk >> 6, krr = Lk & 63;
#pragma unroll
                for (int bj = 0; bj < 2; ++bj) {
                    const int np = 256 * pn + 128 * bj + 32 * wc + 8 * fq;
                    f32x4 v0 = acc[ai][bj][m][0], v1 = acc[ai][bj][m][1];
                    bf16_t* dst;
                    if (TYPE == 0) {
                        const int dir = np >= 384, col = np - 384 * dir;
                        const f32x4 l0 = *(const f32x4*)(tab + TB_LBT + layer * 384 + col), l1 = *(const f32x4*)(tab + TB_LBT + layer * 384 + col + 4);
#pragma unroll
                        for (int q = 0; q < 4; ++q) { v0[q] = (1.f - l0[q]) * sigmoidf_(-v0[q]); v1[q] = (1.f - l1[q]) * sigmoidf_(-v1[q]); }
                        dst = (bf16_t*)(ws + WS_SCAN + (size_t)(dir ? SC_KB : SC_KF) * SCAN_PITCH) + (size_t)row * 384 + col;
                    } else if (TYPE == 1 || TYPE == 2) {
                        f32x4 cs = (f32x4){1.f, 1.f, 1.f, 1.f}, sn = (f32x4){0.f, 0.f, 0.f, 0.f}; float sc;
                        if (TYPE == 1) {
                            const int m2 = np - 768; const int isk = m2 >= 384, col = m2 - 384 * isk; const int w0 = col & 63;
                            if (!ctx) { cs = *(const f32x4*)(rope + (size_t)tt * 32 + (w0 >> 1)); sn = *(const f32x4*)(rope + (size_t)T * 32 + (size_t)tt * 32 + (w0 >> 1)); }
                            sc = isk ? 0.125f : 1.f;
                            dst = (bf16_t*)(ws + WS_SCAN + (size_t)(isk ? SC_RK : SC_RQ) * SCAN_PITCH) + (size_t)row * 384 + col;
                        } else {
                            const int m3 = np - 1536; const int isk = m3 >= 256, col = m3 - 256 * isk; const int map = col >> 5, w0 = col & 31;
                            if (!ctx) { const float* tb = (w0 < 16) ? (tab + TB_AXR + (tt >> 6) * 8 + (w0 >> 1)) : (tab + TB_AXC + (tt & 63) * 8 + ((w0 - 16) >> 1));
                                        const int so = (w0 < 16) ? 2048 : 512; cs = *(const f32x4*)tb; sn = *(const f32x4*)(tb + so); }
                            sc = isk ? 1.f : 0.17677669529663687f * LOG2E * 4.f;
                            if (isk) dst = (bf16_t*)(ws + WS_KA) + ((size_t)((bb * 8 + map) * KT_TILES + ktile) * 4 + (w0 >> 3)) * 512 + krr * 8;
                            else if (ctx) dst = (bf16_t*)(ws + WS_QC) + ((size_t)(bb * 8 + map) * CL + tt) * 32 + w0;
                            else dst = (bf16_t*)(ws + WS_QA) + ((size_t)(bb * 8 + map) * T + tt) * 32 + w0;
                        }
                        f32x4 o0, o1;
                        o0[0] = (v0[0] * cs[0] - v0[1] * sn[0]) * sc; o0[1] = (v0[1] * cs[0] + v0[0] * sn[0]) * sc;
                        o0[2] = (v0[2] * cs[1] - v0[3] * sn[1]) * sc; o0[3] = (v0[3] * cs[1] + v0[2] * sn[1]) * sc;
                        o1[0] = (v1[0] * cs[2] - v1[1] * sn[2]) * sc; o1[1] = (v1[1] * cs[2] + v1[0] * sn[2]) * sc;
                        o1[2] = (v1[2] * cs[3] - v1[3] * sn[3]) * sc; o1[3] = (v1[3] * cs[3] + v1[2] * sn[3]) * sc;
                        v0 = o0; v1 = o1;
                    } else {
                        const int m4 = np - 2048; const int seg = m4 / 384, col = m4 - 384 * seg;
                        if (m4 >= 2176) continue;
                        if (seg < 5) dst = (bf16_t*)(ws + WS_SCAN + (size_t)(SC_HQ + seg) * SCAN_PITCH) + (size_t)row * 384 + col;
                        else { const int h4 = col >> 6, w0 = col & 63;
                               const int k5 = krr & 31; unsigned char* vb = ws + WS_VA + (size_t)((bb * 4 + h4) * KT_TILES + ktile) * 4096 + (krr >> 5) * 2048 + (w0 >> 5) * 1024 + ((k5 >> 2) & 1) * 512 + (w0 & 31) * 16 + (k5 & 3) + 4 * (k5 >> 3);
                               const unsigned wa = pk4_fp8(v0[0] * 16.f, v0[1] * 16.f, v0[2] * 16.f, v0[3] * 16.f), wb = pk4_fp8(v1[0] * 16.f, v1[1] * 16.f, v1[2] * 16.f, v1[3] * 16.f);
#pragma unroll
                               for (int i = 0; i < 4; ++i) { vb[16 * i] = (unsigned char)(wa >> (8 * i)); vb[64 + 16 * i] = (unsigned char)(wb >> (8 * i)); }
                               continue; }
                    }
                    u32x4 w; w.x = cvt_pk_bf16(v0[0], v0[1]); w.y = cvt_pk_bf16(v0[2], v0[3]); w.z = cvt_pk_bf16(v1[0], v1[1]); w.w = cvt_pk_bf16(v1[2], v1[3]);
                    *(u32x4*)dst = w;
                }
                if (m == 3) asm volatile("" ::: "memory");
            }
    }
    __device__ __forceinline__ void operator()(const f32x4 (&acc)[2][2][4][2], const pg8::Unit& u, int wr, int wc, int fr, int fq) const {
        if (u.pn < 3) run<0>(acc, u, wr, wc, fr, fq); else if (u.pn < 6) run<1>(acc, u, wr, wc, fr, fq); else if (u.pn < 8) run<2>(acc, u, wr, wc, fr, fq); else run<3>(acc, u, wr, wc, fr, fq);
    }
};
template <bool NOST = false> struct EpiBf16OutT {
    static constexpr bool PERM = true;
    bf16_t* C;
    __device__ __forceinline__ void operator()(const f32x4 (&acc)[2][2][4][2], const pg8::Unit& u, int wr, int wc, int fr, int fq) const {
        asm volatile("" : "+v"(fr), "+v"(fq));
        const int row0 = u.pm * 256 + wr * 64 + fr, col0 = u.pn * 256 + wc * 32 + 8 * fq;
#pragma unroll
        for (int ai = 0; ai < 2; ++ai)
#pragma unroll
            for (int m = 0; m < 4; ++m) { bf16_t* rowp = C + (size_t)(row0 + ai * 128 + m * 16) * D + col0;
#pragma unroll
                for (int bj = 0; bj < 2; ++bj) { const f32x4 v0 = acc[ai][bj][m][0], v1 = acc[ai][bj][m][1];
                    u32x4 w; w.x = cvt_pk_bf16(v0[0], v0[1]); w.y = cvt_pk_bf16(v0[2], v0[3]); w.z = cvt_pk_bf16(v1[0], v1[1]); w.w = cvt_pk_bf16(v1[2], v1[3]);
                    if (NOST) asm volatile("" :: "v"(w)); else *(u32x4*)(rowp + bj * 128) = w; } }
    }
};
typedef EpiBf16OutT<false> EpiBf16Out;
struct EpiSwiglu {
    static constexpr bool PERM = true;
    unsigned char* act; const float* b1;
    __device__ __forceinline__ void operator()(const f32x4 (&acc)[2][2][4][2], const pg8::Unit& u, int wr, int wc, int fr, int fq) const {
        asm volatile("" : "+v"(fr), "+v"(fq));
        const int j0 = 128 * u.pn + 32 * wc + 8 * fq;
        const float* bp = b1 + (size_t)u.e * 2048 + 2 * j0;
        f32x4 bq[4];
#pragma unroll
        for (int q = 0; q < 4; ++q) bq[q] = *(const f32x4*)(bp + 4 * q);
#pragma unroll
        for (int ai = 0; ai < 2; ++ai)
#pragma unroll
            for (int m = 0; m < 4; ++m) {
                const int rl = 128 * ai + 64 * wr + 16 * m + fr;
                float o[8];
#pragma unroll
                for (int n = 0; n < 2; ++n)
#pragma unroll
                    for (int q = 0; q < 4; ++q) { const int j = 4 * n + q;
                        float g = acc[ai][0][m][n][q] + bq[j >> 1][(j & 1) * 2], l = acc[ai][1][m][n][q] + bq[j >> 1][(j & 1) * 2 + 1];
                        g = fminf(g, 7.f); l = fminf(fmaxf(l, -7.f), 7.f);
                        o[j] = g * sigmoidf_(1.702f * g) * (l + 1.f); }
                u32x2 w; w.x = pk4_fp8(o[0], o[1], o[2], o[3]); w.y = pk4_fp8(o[4], o[5], o[6], o[7]);
                *(u32x2*)(act + (size_t)(u.pm * 256 + rl) * 1024 + j0) = w;
            }
    }
};
template <int NOST = 0> struct EpiMoeOutT {
    static constexpr bool PERM = true;
    unsigned char* ys; const float* b2; const float* sgate;
    __device__ __forceinline__ void operator()(const f32x4 (&acc)[2][2][4][2], const pg8::Unit& u, int wr, int wc, int fr, int fq) const {
        asm volatile("" : "+v"(fr), "+v"(fq));
        const int c0 = 256 * u.pn + 32 * wc + 8 * fq;
        const float* bp = b2 + (size_t)u.e * 1024 + c0;
        f32x4 bv[2][2];
#pragma unroll
        for (int bj = 0; bj < 2; ++bj)
#pragma unroll
            for (int n = 0; n < 2; ++n) bv[bj][n] = *(const f32x4*)(bp + 128 * bj + 4 * n);
#pragma unroll
        for (int ai = 0; ai < 2; ++ai)
#pragma unroll
            for (int m = 0; m < 4; ++m) {
                const int rl = 128 * ai + 64 * wr + 16 * m + fr;
                const float g = (rl < u.nvalid) ? sgate[u.sbase + rl] * 16.f : 0.f;
                unsigned char* rowp = ys + (size_t)(u.pm * 256 + rl) * 1024 + c0;
                if (NOST == 2) rowp = ys - (WS_YK - WS_OSCR) + (size_t)(blockIdx.x * 64 + (rl & 63)) * 1024 + c0;
#pragma unroll
                for (int bj = 0; bj < 2; ++bj) { const f32x4 v0 = (acc[ai][bj][m][0] + bv[bj][0]) * g, v1 = (acc[ai][bj][m][1] + bv[bj][1]) * g;
                    u32x2 w; w.x = pk4_fp8(v0[0], v0[1], v0[2], v0[3]); w.y = pk4_fp8(v1[0], v1[1], v1[2], v1[3]);
                    if (NOST == 1) asm volatile("" :: "v"(w)); else *(u32x2*)(rowp + 128 * bj) = w; }
            }
    }
};
typedef EpiMoeOutT<0> EpiMoeOut;

__device__ __forceinline__ int map_in(int n) {
    if (n < 384) return 2048 + n;
    if (n < 768) return n - 384;
    if (n < 1152) return 384 + (n - 768);
    if (n < 1536) return 2048 + 384 + (n - 1152);
    if (n < 1920) return 2048 + 768 + (n - 1536);
    if (n < 2688) { const int isk = n >= 2304; const int c = n - 1920 - 384 * isk; const int h = c >> 6, w = c & 63; const int wp = (w < 32) ? 2 * w : 2 * (w - 32) + 1; return 768 + 384 * isk + h * 64 + wp; }
    if (n < 3072) return 2048 + 1152 + (n - 2688);
    if (n < 3456) return 2048 + 1536 + (n - 3072);
    if (n < 3968) { const int isk = n >= 3712; const int c = n - 3456 - 256 * isk; const int h = c >> 5, w = c & 31; const int half = w >> 4, uu = w & 15; const int up = (uu < 8) ? 2 * uu : 2 * (uu - 8) + 1; return 1536 + 256 * isk + h * 32 + half * 16 + up; }
    return 2048 + 1920 + (n - 3968);
}
__device__ __forceinline__ int map_w1(int n) { const int j = n >> 1, lin = n & 1; return (j >> 7) * 256 + lin * 128 + (j & 127); }
template <int MAP> __device__ __forceinline__ void p0_transpose_item(const float* W, int Kd, int N, bf16_t* WT, LAS float* scr, int item, int lane) {
    const int nblk = N / 32, kb = item / nblk, nb = item % nblk, k0 = 64 * kb, n0 = 32 * nb;
    { f32x4 rv[8];
#pragma unroll
      for (int i = 0; i < 8; ++i) rv[i] = *(const f32x4*)(W + (size_t)(k0 + (lane >> 3) + 8 * i) * N + n0 + 4 * (lane & 7));
#pragma unroll
      for (int i = 0; i < 8; ++i) { LAS float* sp_ = scr + ((lane >> 3) + 8 * i) * 33 + 4 * (lane & 7); sp_[0] = rv[i][0]; sp_[1] = rv[i][1]; sp_[2] = rv[i][2]; sp_[3] = rv[i][3]; } }
    LDS_WAIT(); asm volatile("" ::: "memory");
    const int c = lane & 7;
#pragma unroll
    for (int j = 0; j < 4; ++j) { const int n = (lane >> 3) + 8 * j; const LAS float* s = scr + (8 * c) * 33 + n;
        u32x4 o; o.x = pk2(s[0 * 33], s[1 * 33]); o.y = pk2(s[2 * 33], s[3 * 33]); o.z = pk2(s[4 * 33], s[5 * 33]); o.w = pk2(s[6 * 33], s[7 * 33]);
        const int nn = n0 + n; const int dr = MAP == 1 ? map_in(nn) : (MAP == 2 ? map_w1(nn) : nn);
        *(u32x4*)(WT + (size_t)dr * Kd + k0 + 8 * c) = o; }
    LDS_WAIT(); asm volatile("" ::: "memory");
}
template <int MAP> __device__ __forceinline__ void p0_transpose_item_fp8(const float* W, int Kd, int N, unsigned char* WT, LAS float* scr, int item, int lane) {
    const int nblk = N / 32, kb = item / nblk, nb = item % nblk, k0 = 64 * kb, n0 = 32 * nb;
    { f32x4 rv[8];
#pragma unroll
      for (int i = 0; i < 8; ++i) rv[i] = *(const f32x4*)(W + (size_t)(k0 + (lane >> 3) + 8 * i) * N + n0 + 4 * (lane & 7));
#pragma unroll
      for (int i = 0; i < 8; ++i) { LAS float* sp_ = scr + ((lane >> 3) + 8 * i) * 33 + 4 * (lane & 7); sp_[0] = rv[i][0]; sp_[1] = rv[i][1]; sp_[2] = rv[i][2]; sp_[3] = rv[i][3]; } }
    LDS_WAIT(); asm volatile("" ::: "memory");
    const int n = lane >> 1, hf = lane & 1; const LAS float* sp = scr + (32 * hf) * 33 + n;
    u32x4 o0, o1;
#pragma unroll
    for (int q = 0; q < 4; ++q) { o0[q] = pk4_fp8(sp[(4 * q) * 33] * W8_MUL, sp[(4 * q + 1) * 33] * W8_MUL, sp[(4 * q + 2) * 33] * W8_MUL, sp[(4 * q + 3) * 33] * W8_MUL);
                                  o1[q] = pk4_fp8(sp[(16 + 4 * q) * 33] * W8_MUL, sp[(16 + 4 * q + 1) * 33] * W8_MUL, sp[(16 + 4 * q + 2) * 33] * W8_MUL, sp[(16 + 4 * q + 3) * 33] * W8_MUL); }
    const int nn = n0 + n; const int dr = MAP == 2 ? map_w1(nn) : nn;
    unsigned char* dp = WT + (size_t)dr * Kd + k0 + 32 * hf;
    *(u32x4*)dp = o0; *(u32x4*)(dp + 16) = o1;
    LDS_WAIT(); asm volatile("" ::: "memory");
}
struct P0Item { const float* W; int N, kind, l, e, k0, n0; };
__device__ __forceinline__ P0Item p0_decode(const Frame& F, int it) {
    constexpr int I_IN = 16 * 132, I_OUT = 16 * 32, I_W1 = 16 * 64, I_W2 = 16 * 32, PER_L = I_IN + I_OUT + NE * (I_W1 + I_W2);
    P0Item d; d.l = it / PER_L; int r = it % PER_L; d.e = 0; int item;
    if (r < I_IN) { d.kind = 0; d.N = 4224; d.W = F.in[7] + (size_t)d.l * 1024 * 4224; item = r; }
    else if (r < I_IN + I_OUT) { d.kind = 1; d.N = 1024; d.W = F.in[14] + (size_t)d.l * 1024 * 1024; item = r - I_IN; }
    else { r -= I_IN + I_OUT; d.e = r / (I_W1 + I_W2); r -= d.e * (I_W1 + I_W2);
        if (r < I_W1) { d.kind = 2; d.N = 2048; d.W = F.in[17] + ((size_t)d.l * NE + d.e) * 1024 * 2048; item = r; }
        else { d.kind = 3; d.N = 1024; d.W = F.in[19] + ((size_t)d.l * NE + d.e) * 1024 * 1024; item = r - I_W1; } }
    const int nblk = d.N / 32; d.k0 = 64 * (item / nblk); d.n0 = 32 * (item % nblk); return d;
}
__device__ __forceinline__ void p0_issue(const P0Item& d, int lane, f32x4 (&rv)[8]) {
#pragma unroll
    for (int i = 0; i < 8; ++i) rv[i] = *(const f32x4*)(d.W + (size_t)(d.k0 + (lane >> 3) + 8 * i) * d.N + d.n0 + 4 * (lane & 7));
}
__device__ __forceinline__ void p0_finish(const Frame& F, const P0Item& d, LAS float* scr, int lane, const f32x4 (&rv)[8]) {
#pragma unroll
    for (int i = 0; i < 8; ++i) { LAS float* sp_ = scr + ((lane >> 3) + 8 * i) * 33 + 4 * (lane & 7); sp_[0] = rv[i][0]; sp_[1] = rv[i][1]; sp_[2] = rv[i][2]; sp_[3] = rv[i][3]; }
    LDS_WAIT(); asm volatile("" ::: "memory");
    if (d.kind < 2) {
        bf16_t* WT = d.kind == 0 ? (bf16_t*)(F.ws + WS_WIN) + (size_t)d.l * NIN * 1024 : (bf16_t*)(F.ws + WS_WOUT) + (size_t)d.l * 1024 * 1024;
        const int c = lane & 7;
#pragma unroll
        for (int j = 0; j < 4; ++j) { const int n = (lane >> 3) + 8 * j; const LAS float* s_ = scr + (8 * c) * 33 + n;
            u32x4 o; o.x = pk2(s_[0 * 33], s_[1 * 33]); o.y = pk2(s_[2 * 33], s_[3 * 33]); o.z = pk2(s_[4 * 33], s_[5 * 33]); o.w = pk2(s_[6 * 33], s_[7 * 33]);
            const int nn = d.n0 + n; const int dr = d.kind == 0 ? map_in(nn) : nn;
            *(u32x4*)(WT + (size_t)dr * 1024 + d.k0 + 8 * c) = o; }
    } else {
        unsigned char* WT = d.kind == 2 ? F.ws + WS_W1 + ((size_t)d.l * NE + d.e) * 2048 * 1024 : F.ws + WS_W2 + ((size_t)d.l * NE + d.e) * 1024 * 1024;
        const int n = lane >> 1, hf = lane & 1; const LAS float* sp = scr + (32 * hf) * 33 + n;
        u32x4 o0, o1;
#pragma unroll
        for (int q = 0; q < 4; ++q) { o0[q] = pk4_fp8(sp[(4 * q) * 33] * W8_MUL, sp[(4 * q + 1) * 33] * W8_MUL, sp[(4 * q + 2) * 33] * W8_MUL, sp[(4 * q + 3) * 33] * W8_MUL);
                                      o1[q] = pk4_fp8(sp[(16 + 4 * q) * 33] * W8_MUL, sp[(16 + 4 * q + 1) * 33] * W8_MUL, sp[(16 + 4 * q + 2) * 33] * W8_MUL, sp[(16 + 4 * q + 3) * 33] * W8_MUL); }
        const int nn = d.n0 + n; const int dr = d.kind == 2 ? map_w1(nn) : nn;
        unsigned char* dp = WT + (size_t)dr * 1024 + d.k0 + 32 * hf;
        *(u32x4*)dp = o0; *(u32x4*)(dp + 16) = o1;
    }
    LDS_WAIT(); asm volatile("" ::: "memory");
}
#ifndef P0_QA
#define P0_QA 8
#endif
#ifndef P0_QC
#define P0_QC 64
#endif
#ifndef P0_QI
#define P0_QI 6
#endif
#ifndef P0_QO
#define P0_QO 6
#endif
constexpr int P0_NFIX = 16 * 132 + 16 * 32, P0_NMOE = NE * (16 * 64 + 16 * 32), P0_PER_L = P0_NFIX + P0_NMOE;
struct P0Split { int thrA, idleA, NA, thrC, idleC, NC, thrI, shortI, NI, thrO, shortO, NO; };
__device__ __forceinline__ int p0_min(int a, int b) { return a < b ? a : b; }
__device__ __forceinline__ P0Split p0_split(int G, int layer) {
    P0Split p; const int NGW = G * NWAVES, UA = NSEQ * NSC, RA = (UA + NGW - 1) / NGW, UC = 24 * NSC, RC = (UC + NGW - 1) / NGW;
    p.thrA = UA - (RA - 1) * NGW; p.idleA = NGW - p.thrA; p.thrC = UC - (RC - 1) * NGW; p.idleC = NGW - p.thrC;
    const int nI = (NROW / 256) * (NIN / 256), rI = (nI + G - 1) / G, nO = ((layer == 0 ? NROW : NLAT) / 256) * 4, rO = (nO + G - 1) / G;
    p.thrI = nI - (rI - 1) * G; p.shortI = G - p.thrI; p.thrO = nO - (rO - 1) * G; p.shortO = G - p.thrO;
    int left = P0_NMOE;
    p.NA = p0_min(p.idleA * P0_QA, left); left -= p.NA; p.NC = p0_min(p.idleC * P0_QC, left); left -= p.NC;
    p.NI = p0_min(p.shortI * NWAVES * P0_QI, left); left -= p.NI; p.NO = p0_min(p.shortO * NWAVES * P0_QO, left); return p;
}
__device__ __forceinline__ void p0_run(const Frame& F, LAS float* scr, int lane, int base, int first, int step, int limit) {
    if (step <= 0) return;
    int v = first; if (v >= limit) return;
    P0Item cur = p0_decode(F, base + v), nxt = cur; f32x4 ra[8], rb[8];
    p0_issue(cur, lane, ra);
    for (; v < limit; v += step) {
        const bool hn = v + step < limit;
        if (hn) { nxt = p0_decode(F, base + v + step); p0_issue(nxt, lane, rb); }
        p0_finish(F, cur, scr, lane, ra);
        if (hn) { cur = nxt;
#pragma unroll
            for (int i = 0; i < 8; ++i) ra[i] = rb[i]; }
    }
}
__device__ __forceinline__ void phase_prologue_a(Frame& F) {
    PHASE_IDS();
    LAS float* scr = (LAS float*)(F.lds + wave * 16384);
    const int gw = blk_ * NWAVES + wave, NGW = F.G * NWAVES;
    unsigned char* ws = F.ws;
    for (int l = 0; l < 2; ++l) { const P0Split sp = p0_split(F.G, l); const int done = sp.NA + sp.NC + sp.NI + sp.NO, rem = P0_NMOE - done;
        p0_run(F, scr, lane, l * P0_PER_L, gw, NGW, P0_NFIX);
        p0_run(F, scr, lane, l * P0_PER_L + P0_NFIX + done, gw, NGW, rem); }
    for (int i = gw * 64 + lane; i < 2 * 128 * 1024 / 8; i += NGW * 64) { const int l = i / (128 * 128), rr = i % (128 * 128);
        *(u32x4*)((bf16_t*)(ws + WS_WIN) + ((size_t)l * NIN + 4224) * 1024 + (size_t)rr * 8) = (u32x4){0u, 0u, 0u, 0u}; }
    { LAS float* part = (LAS float*)(F.lds + 131072);
      for (int it = blk_; it < 2 * 96; it += F.G) {
        const int l = it / 96, n0 = (it % 96) * 64, n = n0 + lane;
        const float* mw = F.in[4] + (size_t)l * 1024 * 6144 + (size_t)(128 * wave) * 6144 + n;
        float a0 = 0.f, a1 = 0.f, a2 = 0.f;
#pragma unroll 1
        for (int kb = 0; kb < 2; ++kb) {
            const int kk = 128 * wave + 64 * kb + lane;
            float c0 = F.in[1][kk], c1 = F.in[1][1024 + kk], c2 = F.in[3][kk];
            c0 = c0 * sigmoidf_(c0); c1 = c1 * sigmoidf_(c1); c2 = c2 * sigmoidf_(c2);
#pragma unroll 1
            for (int j0 = 0; j0 < 64; j0 += 16) { float wv[16];
#pragma unroll
                for (int j = 0; j < 16; ++j) wv[j] = mw[(size_t)(64 * kb + j0 + j) * 6144];
#pragma unroll
                for (int j = 0; j < 16; ++j) { a0 += rdlane(c0, j0 + j) * wv[j]; a1 += rdlane(c1, j0 + j) * wv[j]; a2 += rdlane(c2, j0 + j) * wv[j]; } }
        }
        part[(wave * 3 + 0) * 64 + lane] = a0; part[(wave * 3 + 1) * 64 + lane] = a1; part[(wave * 3 + 2) * 64 + lane] = a2;
        __syncthreads();
        if (wave == 0) {
            float vals[3];
#pragma unroll
            for (int w = 0; w < 3; ++w) { float sacc = 0.f;
#pragma unroll
                for (int q = 0; q < 8; ++q) sacc += part[(q * 3 + w) * 64 + lane]; vals[w] = sacc + F.in[5][l * 6144 + n]; }
            const int ch = n >> 10, col = n & 1023;
            const float* ng = F.in[6] + (size_t)l * 4096;
#pragma unroll
            for (int w = 0; w < 3; ++w) { float v = vals[w];
                if (ch == 1) v = (1.f + v) * ng[col]; else if (ch == 2) v = v * ng[1024 + col]; else if (ch == 4) v = (1.f + v) * ng[2048 + col]; else if (ch == 5) v = v * ng[3072 + col];
                const int slot = (ch == 0) ? 1 : (ch == 1) ? 0 : (ch == 2) ? 2 : (ch == 3) ? 4 : (ch == 4) ? 3 : 5;
                ((float*)(ws + WS_MODV))[((size_t)(l * 3 + w) * 6 + slot) * 1024 + col] = v; }
        }
        __syncthreads();
      } }
    float* tab = (float*)(ws + WS_TAB);
    const int gt = blk_ * NTHR + tid, NGT = F.G * NTHR;
    for (int i = gt; i < 2 * 384; i += NGT) { const int l = i / 384, c = i % 384; const float a = F.in[8][c], b = F.in[8][384 + c];
        tab[TB_LBT + i] = (l == 0) ? 0.f : 1.f / (1.f + expf(a - b)); }
    if (gt < 2) { const int l = gt; const float* lm = F.in[12] + l * 128; float s0 = 0.f, s1 = 0.f;
        for (int i = 0; i < 32; ++i) { s0 += lm[i] * lm[32 + i]; s1 += lm[64 + i] * lm[96 + i]; }
        const float li = 0.8f - 0.6f * expf(-0.3f * (float)l);
        tab[TB_LAM + l] = expf(s0) - expf(s1) + li; tab[TB_LAM + 2 + l] = 1.f - li; }
    if (gt < 24) tab[TB_GAM + gt] = 1.f - exp2f(-F.in[10][gt]);
    for (int i = gt; i < 256 * 8 + 64 * 8; i += NGT) {
        const bool isr = i < 2048; const int ii = isr ? i : i - 2048; const int pos = ii >> 3, j = ii & 7;
        const float inv = exp2f(-(float)j * (13.287712379549449f / 8.f));
        const double rev = (double)pos * (double)inv * 0.15915494309189535; const float fr = (float)(rev - floor(rev));
        const float cs = __builtin_amdgcn_cosf(fr), sn = __builtin_amdgcn_sinf(fr);
        if (isr) { tab[TB_AXR + ii] = cs; tab[TB_AXR + 2048 + ii] = sn; } else { tab[TB_AXC + ii] = cs; tab[TB_AXC + 512 + ii] = sn; }
    }
    float* rope = (float*)(ws + WS_ROPE);
    for (int i = gt; i < T * 32; i += NGT) { const int pos = i >> 5, j = i & 31;
        const float inv = exp2f(-(float)j * (13.287712379549449f / 32.f));
        const double rev = (double)pos * (double)inv * 0.15915494309189535; const float fr = (float)(rev - floor(rev));
        rope[i] = __builtin_amdgcn_cosf(fr); rope[(size_t)T * 32 + i] = __builtin_amdgcn_sinf(fr); }
    bf16_t* rwh = (bf16_t*)(ws + WS_RWT); bf16_t* rwl = rwh + 2 * 32 * 1024;
    for (int i = gt; i < 2 * 32 * 1024; i += NGT) { const int l = i >> 15, e = (i >> 10) & 31, c = i & 1023; const float wv = F.in[15][((size_t)l * 1024 + c) * 32 + e];
        const unsigned hb = f2bf(wv); rwh[i] = (bf16_t)hb; rwl[i] = (bf16_t)f2bf(wv - __builtin_bit_cast(float, hb << 16)); }
}

__device__ __forceinline__ float row_sumsq(const f32x4 (&v)[4]) {
    float s = 0.f;
#pragma unroll
    for (int j = 0; j < 4; ++j) s += (v[j][0] * v[j][0] + v[j][1] * v[j][1]) + (v[j][2] * v[j][2] + v[j][3] * v[j][3]);
    return wave_sum(s);
}
__device__ __forceinline__ void row_load(const float* p, int lane, f32x4 (&v)[4]) {
#pragma unroll
    for (int j = 0; j < 4; ++j) v[j] = *(const f32x4*)(p + 4 * lane + 256 * j);
}
__device__ __forceinline__ void row_store(float* p, int lane, const f32x4 (&v)[4]) {
#pragma unroll
    for (int j = 0; j < 4; ++j) *(f32x4*)(p + 4 * lane + 256 * j) = v[j];
}
__device__ __forceinline__ void row_store_bf16(bf16_t* p, int lane, const f32x4 (&v)[4]) {
#pragma unroll
    for (int j = 0; j < 4; ++j) { u32x2 w; w.x = pk2(v[j][0], v[j][1]); w.y = pk2(v[j][2], v[j][3]); *(u32x2*)(p + 4 * lane + 256 * j) = w; }
}
__device__ __forceinline__ void row_load_bf16(const bf16_t* p, int lane, f32x4 (&v)[4]) {
#pragma unroll
    for (int j = 0; j < 4; ++j) { const u32x2 w = *(const u32x2*)(p + 4 * lane + 256 * j); v[j] = (f32x4){bflo(w.x), bfhi(w.x), bflo(w.y), bfhi(w.y)}; }
}
__device__ __forceinline__ int row_which(int r) { return r < NLAT ? (r >> 14) : 2; }
__device__ __forceinline__ void row_norm_mod(const f32x4 (&x)[4], const float* a, const float* b, int lane, f32x4 (&o)[4]) {
    const float r = __builtin_amdgcn_rsqf(row_sumsq(x) * (1.f / 1024.f) + EPS);
#pragma unroll
    for (int j = 0; j < 4; ++j) { const f32x4 av = *(const f32x4*)(a + 4 * lane + 256 * j), bv = *(const f32x4*)(b + 4 * lane + 256 * j); o[j] = x[j] * r * av + bv; }
}
__device__ __forceinline__ void phase_prologue_b(Frame& F) {
    PHASE_IDS();
    const int gw = blk_ * NWAVES + wave, NGW = F.G * NWAVES;
    const float* modv = (const float*)(F.ws + WS_MODV);
    f32x4 xc[4], xn[4];
    if (gw < NROW) row_load(gw < NLAT ? F.in[0] + (size_t)gw * D : F.in[2] + (size_t)(gw - NLAT) * D, lane, xc);
    for (int r = gw; r < NROW; r += NGW) {
        const int rn = r + NGW;
        if (rn < NROW) row_load(rn < NLAT ? F.in[0] + (size_t)rn * D : F.in[2] + (size_t)(rn - NLAT) * D, lane, xn);
        const int w = row_which(r);
        f32x4 o[4];
        row_norm_mod(xc, modv + (size_t)(0 * 3 + w) * 6 * 1024, modv + ((size_t)(0 * 3 + w) * 6 + 1) * 1024, lane, o);
        row_store_bf16((bf16_t*)(F.ws + WS_H) + (size_t)r * D, lane, o);
#pragma unroll
        for (int j = 0; j < 4; ++j) xc[j] = xn[j];
    }
}

__device__ __forceinline__ int scan_row(int sc, int p, int dir, int b) {
    if (sc == 0) return NLAT + b * CL + (dir ? (CL - 1 - p) : p);
    const int tt = (sc - 1) * 256 + p; return b * T + (dir ? (T - 1 - tt) : tt);
}
template <int TYPE, bool WITHQ>
__device__ __forceinline__ float scan_step(float (&S)[64], const LAS float* kq, float vv, float gam) {
    float o = 0.f;
#pragma unroll
    for (int kg = 0; kg < 8; ++kg) {
        f32x4 kv[2], qv[2];
#pragma unroll
        for (int j = 0; j < 2; ++j) { kv[j] = *(const LAS f32x4*)(kq + kg * 8 + 4 * j); if (WITHQ) qv[j] = *(const LAS f32x4*)(kq + 64 + kg * 8 + 4 * j); }
#pragma unroll
        for (int j = 0; j < 8; ++j) { const int k = kg * 8 + j; const float kk = kv[j >> 2][j & 3];
            if (TYPE == 0) S[k] = __builtin_fmaf(kk, vv - S[k], S[k]); else S[k] = __builtin_fmaf(kk, vv, gam * S[k]);
            if (WITHQ) o = __builtin_fmaf(qv[j >> 2][j & 3], S[k], o); }
        asm volatile("" ::: "memory"); __builtin_amdgcn_sched_barrier(0);
    }
    return o;
}
__device__ __forceinline__ void phase_scan_a(Frame& F, int layer) {
    PHASE_IDS();
    const int gw = blk_ * NWAVES + wave, NGW = F.G * NWAVES;
    const float* tab = (const float*)(F.ws + WS_TAB);
    LAS float* scr = (LAS float*)(F.lds + wave * 2048);
    for (int wu = gw; wu < NSEQ * NSC; wu += NGW) {
        const int s = wu / NSC, sc = wu % NSC; const int type = s / 24, rem = s % 24, b = rem / 12, h = (rem % 12) >> 1, dir = rem & 1;
        const bf16_t* Kb = (const bf16_t*)(F.ws + WS_SCAN + (size_t)(type ? SC_RK : (dir ? SC_KB : SC_KF)) * SCAN_PITCH);
        const bf16_t* Vb = (const bf16_t*)(F.ws + WS_SCAN + (size_t)(type ? SC_RV : SC_HV) * SCAN_PITCH);
        unsigned co = (unsigned)(h * 64 + lane); asm volatile("" : "+v"(co));
        const float gam = tab[TB_GAM + layer * 12 + dir * 6 + h];
        float S[64];
#pragma unroll
        for (int k = 0; k < 64; ++k) S[k] = 0.f;
        float dprod = 1.f;
        float kc[4], vc[4], kn[4], vn[4];
#pragma unroll
        for (int i = 0; i < 4; ++i) { const unsigned ro = (unsigned)scan_row(sc, i, dir, b) * 384u + co; kc[i] = bf2f(Kb[ro]); vc[i] = bf2f(Vb[ro]); kn[i] = 0.f; vn[i] = 0.f; }
        for (int p0 = 0; p0 < 256; p0 += 4) {
            if (p0 + 4 < 256) {
#pragma unroll
                for (int i = 0; i < 4; ++i) { const unsigned ro = (unsigned)scan_row(sc, p0 + 4 + i, dir, b) * 384u + co; kn[i] = bf2f(Kb[ro]); vn[i] = bf2f(Vb[ro]); }
            }
#pragma unroll
            for (int i = 0; i < 4; ++i) scr[i * 128 + lane] = kc[i];
#pragma unroll
            for (int i = 0; i < 4; ++i) {
                if (type == 0) { dprod *= (1.f - kc[i]); (void)scan_step<0, false>(S, scr + i * 128, vc[i], gam); }
                else { dprod *= gam; (void)scan_step<1, false>(S, scr + i * 128, vc[i], gam); }
            }
#pragma unroll
            for (int i = 0; i < 4; ++i) { kc[i] = kn[i]; vc[i] = vn[i]; }
        }
        float* sl = (float*)(F.ws + WS_SLOC) + (size_t)wu * 4096 + lane;
#pragma unroll
        for (int k = 0; k < 64; ++k) { *sl = S[k]; sl += 64; asm volatile("" : "+v"(sl)); }
        ((float*)(F.ws + WS_DEC))[(size_t)wu * 64 + lane] = dprod;
    }
}
__device__ __forceinline__ void phase_scan_b(Frame& F) {
    const float* sloc = (const float*)(F.ws + WS_SLOC); const float* dec = (const float*)(F.ws + WS_DEC); float* sin_ = (float*)(F.ws + WS_SIN);
    PHASE_IDS();
    if (tid < 384) for (int idx = blk_ * 384 + tid; idx < NSEQ * 2048; idx += F.G * 384) {
        const int s = idx >> 11, kv = (idx & 2047) * 2, k = kv >> 6; f32x2 st = {0.f, 0.f};
        const float* dp = dec + (size_t)s * NSC * 64 + k; const float* sp = sloc + (size_t)s * NSC * 4096 + kv; float* op = sin_ + ((size_t)s * NSC + 1) * 4096 + kv;
#pragma unroll 1
        for (int c0 = 0; c0 < NSC - 1; c0 += 16) {
            float d[16]; f32x2 v[16];
#pragma unroll
            for (int i = 0; i < 16; ++i) { d[i] = dp[(c0 + i) * 64]; v[i] = *(const f32x2*)(sp + (size_t)(c0 + i) * 4096); }
#pragma unroll
            for (int i = 0; i < 16; ++i) { st = st * d[i] + v[i]; *(f32x2*)(op + (size_t)(c0 + i) * 4096) = st; }
        }
    }
}
template <int TYPE, bool SECOND>
__device__ __forceinline__ void scan_dir(Frame& F, int lane_in, int wave, int layer, int b, int h, int dir, int sc, bool zero_state) {
    int lane = lane_in; asm volatile("" : "+v"(lane));
    const float* tab = (const float*)(F.ws + WS_TAB);
    const int s = TYPE * 24 + b * 12 + h * 2 + dir;
    const bf16_t* Kb = (const bf16_t*)(F.ws + WS_SCAN + (size_t)(TYPE ? SC_RK : (dir ? SC_KB : SC_KF)) * SCAN_PITCH);
    const bf16_t* Vb = (const bf16_t*)(F.ws + WS_SCAN + (size_t)(TYPE ? SC_RV : SC_HV) * SCAN_PITCH);
    const bf16_t* Qb = (const bf16_t*)(F.ws + WS_SCAN + (size_t)(TYPE ? SC_RQ : SC_HQ) * SCAN_PITCH);
    const bf16_t* Gb = (const bf16_t*)(F.ws + WS_SCAN + (size_t)(TYPE ? SC_RG : SC_HG) * SCAN_PITCH);
    float* oscr = (float*)(F.ws + WS_OSCR);
    bf16_t* mix = (bf16_t*)(F.ws + WS_MIX);
    unsigned co = (unsigned)(h * 64 + lane); asm volatile("" : "+v"(co));
    const unsigned co2 = co + TYPE * 384;
    const float gam = tab[TB_GAM + layer * 12 + dir * 6 + h];
    const float nw = F.in[TYPE ? 11 : 9][layer * 64 + lane];
    LAS float* scr = (LAS float*)(F.lds + wave * 2048);
    float S[64];
    if (zero_state) {
#pragma unroll
        for (int k = 0; k < 64; ++k) S[k] = 0.f;
    } else { const float* si = (const float*)(F.ws + WS_SIN) + ((size_t)s * NSC + sc) * 4096 + lane;
#pragma unroll
        for (int k = 0; k < 64; ++k) { S[k] = *si; si += 64; asm volatile("" : "+v"(si)); } }
    float kc[2], vc[2], qc[2], kn[2], vn[2], qn[2];
#pragma unroll
    for (int i = 0; i < 2; ++i) { const unsigned ro = (unsigned)scan_row(sc, i, dir, b) * 384u + co; kc[i] = bf2f(Kb[ro]); vc[i] = bf2f(Vb[ro]); qc[i] = bf2f(Qb[ro]); kn[i] = 0.f; vn[i] = 0.f; qn[i] = 0.f; }
    for (int p0 = 0; p0 < 256; p0 += 2) {
        if (p0 + 2 < 256) {
#pragma unroll
            for (int i = 0; i < 2; ++i) { const unsigned ro = (unsigned)scan_row(sc, p0 + 2 + i, dir, b) * 384u + co; kn[i] = bf2f(Kb[ro]); vn[i] = bf2f(Vb[ro]); qn[i] = bf2f(Qb[ro]); }
        }
#pragma unroll
        for (int i = 0; i < 2; ++i) { scr[i * 128 + lane] = kc[i]; scr[i * 128 + 64 + lane] = qc[i]; }
#pragma unroll
        for (int i = 0; i < 2; ++i) {
            float o = scan_step<TYPE, true>(S, scr + i * 128, vc[i], gam);
            const unsigned row = (unsigned)scan_row(sc, p0 + i, dir, b);
            if (!SECOND) oscr[row * 768u + co2] = o;
            else { o += oscr[row * 768u + co2];
                const float r = __builtin_amdgcn_rsqf(wave_sum_dpp(o * o) * (1.f / 64.f) + EPS);
                const float g = bf2f(Gb[row * 384u + co]);
                mix[row * 1024u + co2] = (bf16_t)f2bf(o * r * nw * g * sigmoidf_(g)); }
            asm volatile("" ::: "memory");
        }
#pragma unroll
        for (int i = 0; i < 2; ++i) { kc[i] = kn[i]; vc[i] = vn[i]; qc[i] = qn[i]; }
    }
}
__device__ __forceinline__ void phase_scan_c(Frame& F, int layer) {
    PHASE_IDS();
    const int gw = blk_ * NWAVES + wave, NGW = F.G * NWAVES;
    const bool need_ctx = layer == 0;
    for (int wu = gw; wu < 24 * NSC; wu += NGW) {
        const int sq = wu / NSC, blk = wu % NSC; const int type = sq / 12, b = (sq % 12) / 6, h = sq % 6;
        if (blk == 0 && !need_ctx) continue;
        const int scf = blk, scb = (blk == 0) ? 0 : 65 - blk;
        if (type == 0) { scan_dir<0, false>(F, lane, wave, layer, b, h, 0, scf, scf == 0); scan_dir<0, true>(F, lane, wave, layer, b, h, 1, scb, scb == 0); }
        else           { scan_dir<1, false>(F, lane, wave, layer, b, h, 0, scf, scf == 0); scan_dir<1, true>(F, lane, wave, layer, b, h, 1, scb, scb == 0); }
    }
}


namespace sc2 {
constexpr int WLDS = 8448;
__device__ __forceinline__ f32x4 mfma16(bf16x8 a, bf16x8 b, f32x4 c) { return __builtin_amdgcn_mfma_f32_16x16x32_bf16(a, b, c, 0, 0, 0); }
template <int TYPE, int MODE>
__device__ __forceinline__ void run(Frame& F, int lane_in, int wave, int layer, int b, int h, int dir, int sc, bool zero_state, int wu_out) {
    int lane = lane_in; asm volatile("" : "+v"(lane));
    const int g = lane >> 4, n = lane & 15;
    const float* tab = (const float*)(F.ws + WS_TAB);
    const int s = TYPE * 24 + b * 12 + h * 2 + dir;
    const bf16_t* Kb = (const bf16_t*)(F.ws + WS_SCAN + (size_t)(TYPE ? SC_RK : (dir ? SC_KB : SC_KF)) * SCAN_PITCH);
    const bf16_t* Vb = (const bf16_t*)(F.ws + WS_SCAN + (size_t)(TYPE ? SC_RV : SC_HV) * SCAN_PITCH);
    const bf16_t* Qb = (const bf16_t*)(F.ws + WS_SCAN + (size_t)(TYPE ? SC_RQ : SC_HQ) * SCAN_PITCH);
    const bf16_t* Gb = (const bf16_t*)(F.ws + WS_SCAN + (size_t)(TYPE ? SC_RG : SC_HG) * SCAN_PITCH);
    float* oscr = (float*)(F.ws + WS_OSCR);
    bf16_t* mix = (bf16_t*)(F.ws + WS_MIX);
    const unsigned co = (unsigned)(h * 64 + lane);
    const float lg2 = TYPE ? __builtin_amdgcn_logf(tab[TB_GAM + layer * 12 + dir * 6 + h]) : 0.f;
    LAS unsigned char* wl = F.lds + wave * WLDS;
    LAS bf16_t* QT = (LAS bf16_t*)wl; LAS bf16_t* KT = (LAS bf16_t*)(wl + 2048); LAS bf16_t* KPT = (LAS bf16_t*)(wl + 4096); LAS bf16_t* VT = (LAS bf16_t*)(wl + 6144); LAS float* DD = (LAS float*)(wl + 8192);
    f32x4 S[4][4];
    if (zero_state) {
#pragma unroll
        for (int kb = 0; kb < 4; ++kb)
#pragma unroll
            for (int vb = 0; vb < 4; ++vb) S[kb][vb] = (f32x4){0.f, 0.f, 0.f, 0.f};
    } else { const float* si = (const float*)(F.ws + WS_SIN) + ((size_t)s * NSC + sc) * 4096;
#pragma unroll
        for (int kb = 0; kb < 4; ++kb)
#pragma unroll
            for (int vb = 0; vb < 4; ++vb)
#pragma unroll
                for (int r = 0; r < 4; ++r) S[kb][vb][r] = si[(16 * kb + 4 * g + r) * 64 + 16 * vb + n]; }
    float dtot = 1.f;
    const float gam = TYPE ? tab[TB_GAM + layer * 12 + dir * 6 + h] : 0.f;
    unsigned short kr[16], vr[16], qr[16];
#pragma unroll
    for (int t = 0; t < 16; ++t) { const unsigned ro = (unsigned)scan_row(sc, t, dir, b) * 384u + co; kr[t] = Kb[ro]; vr[t] = Vb[ro]; if (MODE != 0) qr[t] = Qb[ro]; else qr[t] = 0; }
    for (int blk = 0; blk < 16; ++blk) {
        const unsigned row = (unsigned)scan_row(sc, 16 * blk + n, dir, b);
        const unsigned ob = row * 768u + (unsigned)(TYPE * 384 + h * 64 + 4 * g);
        f32x4 of[4]; u32x2 gg[4];
        if (MODE == 2) {
#pragma unroll
            for (int vb = 0; vb < 4; ++vb) { of[vb] = *(const f32x4*)(oscr + ob + 16 * vb); gg[vb] = *(const u32x2*)(Gb + row * 384u + (unsigned)(h * 64 + 16 * vb + 4 * g)); }
        }
        float ek[16]; float eq = 1.f;
#pragma unroll
        for (int t = 0; t < 16; ++t) { const float kk = bf2f(kr[t]);
            eq = fmaxf(eq * (TYPE == 0 ? 1.f - kk : gam), 7.9e-31f);
            ek[t] = __builtin_amdgcn_rcpf(eq);
            if (MODE != 0) { const unsigned w_ = cvt_pk_bf16(bf2f(qr[t]) * eq, kk * ek[t]); QT[t * 64 + lane] = (bf16_t)(w_ & 0xffffu); KT[t * 64 + lane] = (bf16_t)(w_ >> 16); } }
        dtot *= eq; DD[lane] = eq;
        { u32x4 w0, w1, x0, x1;
#pragma unroll
          for (int q = 0; q < 4; ++q) {
              w0[q] = cvt_pk_bf16(bf2f(kr[2 * q]) * (eq * ek[2 * q]), bf2f(kr[2 * q + 1]) * (eq * ek[2 * q + 1]));
              w1[q] = cvt_pk_bf16(bf2f(kr[8 + 2 * q]) * (eq * ek[8 + 2 * q]), bf2f(kr[8 + 2 * q + 1]) * (eq * ek[8 + 2 * q + 1]));
              x0[q] = (unsigned)vr[2 * q] | ((unsigned)vr[2 * q + 1] << 16); x1[q] = (unsigned)vr[8 + 2 * q] | ((unsigned)vr[8 + 2 * q + 1] << 16); }
          *(LAS u32x4*)(KPT + lane * 16) = w0; *(LAS u32x4*)(KPT + lane * 16 + 8) = w1; *(LAS u32x4*)(VT + lane * 16) = x0; *(LAS u32x4*)(VT + lane * 16 + 8) = x1; }
        if (blk + 1 < 16) {
#pragma unroll
            for (int t = 0; t < 16; ++t) { const unsigned ro = (unsigned)scan_row(sc, 16 * (blk + 1) + t, dir, b) * 384u + co; kr[t] = Kb[ro]; vr[t] = Vb[ro]; if (MODE != 0) qr[t] = Qb[ro]; }
        }
        asm volatile("s_waitcnt lgkmcnt(0)" ::: "memory");
        if (MODE != 0) {
            f32x4 sct = (f32x4){0.f, 0.f, 0.f, 0.f};
#pragma unroll
            for (int ks = 0; ks < 2; ++ks) { const bf16x8 a = *(const LAS bf16x8*)(KT + n * 64 + 32 * ks + 8 * g), bq = *(const LAS bf16x8*)(QT + n * 64 + 32 * ks + 8 * g); sct = mfma16(a, bq, sct); }
#pragma unroll
            for (int r = 0; r < 4; ++r) sct[r] = (4 * g + r <= n) ? sct[r] : 0.f;
            u32x4 bs; bs.x = cvt_pk_bf16(sct[0], sct[1]); bs.y = cvt_pk_bf16(sct[2], sct[3]); bs.z = 0u; bs.w = 0u;
            f32x4 o[4];
#pragma unroll
            for (int vb = 0; vb < 4; ++vb) { const u32x2 lo = *(const LAS u32x2*)(VT + (16 * vb + n) * 16 + 4 * g); u32x4 av; av.x = lo.x; av.y = lo.y; av.z = 0u; av.w = 0u;
                o[vb] = mfma16(__builtin_bit_cast(bf16x8, av), __builtin_bit_cast(bf16x8, bs), (f32x4){0.f, 0.f, 0.f, 0.f}); }
#pragma unroll
            for (int ks = 0; ks < 2; ++ks) {
                const u32x2 q0 = *(const LAS u32x2*)(QT + n * 64 + 32 * ks + 4 * g), q1 = *(const LAS u32x2*)(QT + n * 64 + 32 * ks + 16 + 4 * g);
                u32x4 bq; bq.x = q0.x; bq.y = q0.y; bq.z = q1.x; bq.w = q1.y;
#pragma unroll
                for (int vb = 0; vb < 4; ++vb) { u32x4 av; av.x = cvt_pk_bf16(S[2 * ks][vb][0], S[2 * ks][vb][1]); av.y = cvt_pk_bf16(S[2 * ks][vb][2], S[2 * ks][vb][3]);
                    av.z = cvt_pk_bf16(S[2 * ks + 1][vb][0], S[2 * ks + 1][vb][1]); av.w = cvt_pk_bf16(S[2 * ks + 1][vb][2], S[2 * ks + 1][vb][3]);
                    o[vb] = mfma16(__builtin_bit_cast(bf16x8, av), __builtin_bit_cast(bf16x8, bq), o[vb]); }
            }
            if (MODE == 1) {
#pragma unroll
                for (int vb = 0; vb < 4; ++vb) *(f32x4*)(oscr + ob + 16 * vb) = o[vb];
            } else {
                float ss = 0.f;
#pragma unroll
                for (int vb = 0; vb < 4; ++vb) { o[vb] = o[vb] + of[vb]; ss += (o[vb][0] * o[vb][0] + o[vb][1] * o[vb][1]) + (o[vb][2] * o[vb][2] + o[vb][3] * o[vb][3]); }
                ss += xor_swz<16>(ss); ss += xor32(ss, lane);
                const float rn = __builtin_amdgcn_rsqf(ss * (1.f / 64.f) + EPS);
                const float* nw = F.in[TYPE ? 11 : 9] + layer * 64 + 4 * g;
#pragma unroll
                for (int vb = 0; vb < 4; ++vb) { const f32x4 w4 = *(const f32x4*)(nw + 16 * vb);
                    const float g0 = bflo(gg[vb].x), g1 = bfhi(gg[vb].x), g2 = bflo(gg[vb].y), g3 = bfhi(gg[vb].y);
                    u32x2 w; w.x = cvt_pk_bf16(o[vb][0] * rn * w4[0] * g0 * sigmoidf_(g0), o[vb][1] * rn * w4[1] * g1 * sigmoidf_(g1)); w.y = cvt_pk_bf16(o[vb][2] * rn * w4[2] * g2 * sigmoidf_(g2), o[vb][3] * rn * w4[3] * g3 * sigmoidf_(g3));
                    *(u32x2*)(mix + row * 1024u + (unsigned)(TYPE * 384 + h * 64 + 16 * vb + 4 * g)) = w; }
            }
        }
#pragma unroll
        for (int kb = 0; kb < 4; ++kb) { const f32x4 d4 = *(const LAS f32x4*)(DD + 16 * kb + 4 * g);
#pragma unroll
            for (int vb = 0; vb < 4; ++vb) S[kb][vb] = S[kb][vb] * d4; }
        { bf16x8 af[4], bfv[4];
#pragma unroll
          for (int q = 0; q < 4; ++q) { u32x4 a = *(const LAS u32x4*)(KPT + (16 * q + n) * 16 + 8 * (g & 1)), bq = *(const LAS u32x4*)(VT + (16 * q + n) * 16 + 8 * (g & 1));
              if (g >= 2) { a = (u32x4){0u, 0u, 0u, 0u}; bq = (u32x4){0u, 0u, 0u, 0u}; }
              af[q] = __builtin_bit_cast(bf16x8, a); bfv[q] = __builtin_bit_cast(bf16x8, bq); }
#pragma unroll
          for (int kb = 0; kb < 4; ++kb)
#pragma unroll
              for (int vb = 0; vb < 4; ++vb) S[kb][vb] = mfma16(af[kb], bfv[vb], S[kb][vb]); }
        asm volatile("s_waitcnt lgkmcnt(0)" ::: "memory");
    }
    if (MODE == 0) {
        float* sl = (float*)(F.ws + WS_SLOC) + (size_t)wu_out * 4096;
#pragma unroll
        for (int kb = 0; kb < 4; ++kb)
#pragma unroll
            for (int vb = 0; vb < 4; ++vb)
#pragma unroll
                for (int r = 0; r < 4; ++r) sl[(16 * kb + 4 * g + r) * 64 + 16 * vb + n] = S[kb][vb][r];
        ((float*)(F.ws + WS_DEC))[(size_t)wu_out * 64 + lane] = dtot;
    }
}
constexpr int WLDS0 = 10240;
template <int TYPE>
__device__ __forceinline__ void run0(Frame& F, int lane_in, int wave, int layer, int b, int h, int dir, int sc, int wu_out) {
    int lane = lane_in; asm volatile("" : "+v"(lane));
    const int g = lane >> 4, n = lane & 15;
    const float* tab = (const float*)(F.ws + WS_TAB);
    const bf16_t* Kb = (const bf16_t*)(F.ws + WS_SCAN + (size_t)(TYPE ? SC_RK : (dir ? SC_KB : SC_KF)) * SCAN_PITCH);
    const bf16_t* Vb = (const bf16_t*)(F.ws + WS_SCAN + (size_t)(TYPE ? SC_RV : SC_HV) * SCAN_PITCH);
    const unsigned co = (unsigned)(h * 64 + lane);
    const float gam = TYPE ? tab[TB_GAM + layer * 12 + dir * 6 + h] : 0.f;
    LAS unsigned char* wl = F.lds + wave * WLDS0;
    LAS unsigned char* KP = wl; LAS unsigned char* VT = wl + 5120;
    f32x4 S[4][4];
#pragma unroll
    for (int kb = 0; kb < 4; ++kb)
#pragma unroll
        for (int vb = 0; vb < 4; ++vb) S[kb][vb] = (f32x4){0.f, 0.f, 0.f, 0.f};
    float r = 1.f;
    unsigned short kr[32], vr[32];
#pragma unroll
    for (int i = 0; i < 32; ++i) { const unsigned ro = (unsigned)scan_row(sc, 255 - i, dir, b) * 384u + co; kr[i] = Kb[ro]; vr[i] = Vb[ro]; }
    for (int blk = 0; blk < 8; ++blk) {
        u32x4 kw[4], vw[4];
#pragma unroll
        for (int j = 0; j < 16; ++j) { const float k0 = bf2f(kr[2 * j]), k1 = bf2f(kr[2 * j + 1]);
            const float a0 = k0 * r; r *= (TYPE == 0 ? 1.f - k0 : gam); const float a1 = k1 * r; r *= (TYPE == 0 ? 1.f - k1 : gam);
            kw[j >> 2][j & 3] = cvt_pk_bf16(a0, a1); vw[j >> 2][j & 3] = (unsigned)vr[2 * j] | ((unsigned)vr[2 * j + 1] << 16); }
#pragma unroll
        for (int q = 0; q < 4; ++q) { *(LAS u32x4*)(KP + lane * 80 + 16 * q) = kw[q]; *(LAS u32x4*)(VT + lane * 80 + 16 * q) = vw[q]; }
        if (blk + 1 < 8) {
#pragma unroll
            for (int i = 0; i < 32; ++i) { const unsigned ro = (unsigned)scan_row(sc, 255 - 32 * (blk + 1) - i, dir, b) * 384u + co; kr[i] = Kb[ro]; vr[i] = Vb[ro]; }
        }
        asm volatile("s_waitcnt lgkmcnt(0)" ::: "memory");
        { bf16x8 af[4], bfv[4];
#pragma unroll
          for (int q = 0; q < 4; ++q) { af[q] = __builtin_bit_cast(bf16x8, *(const LAS u32x4*)(KP + (16 * q + n) * 80 + 16 * g)); bfv[q] = __builtin_bit_cast(bf16x8, *(const LAS u32x4*)(VT + (16 * q + n) * 80 + 16 * g)); }
#pragma unroll
          for (int kb = 0; kb < 4; ++kb)
#pragma unroll
              for (int vb = 0; vb < 4; ++vb) S[kb][vb] = mfma16(af[kb], bfv[vb], S[kb][vb]); }
        asm volatile("s_waitcnt lgkmcnt(0)" ::: "memory");
    }
    float* sl = (float*)(F.ws + WS_SLOC) + (size_t)wu_out * 4096;
#pragma unroll
    for (int kb = 0; kb < 4; ++kb)
#pragma unroll
        for (int vb = 0; vb < 4; ++vb)
#pragma unroll
            for (int rr = 0; rr < 4; ++rr) sl[(16 * kb + 4 * g + rr) * 64 + 16 * vb + n] = S[kb][vb][rr];
    ((float*)(F.ws + WS_DEC))[(size_t)wu_out * 64 + lane] = r;
}
}
__device__ __forceinline__ void phase_scan2_a(Frame& F, int layer) {
    PHASE_IDS();
    const int gw = blk_ * NWAVES + wave, NGW = F.G * NWAVES;
    for (int wu = gw; wu < NSEQ * NSC; wu += NGW) {
        const int s = wu / NSC, sc = wu % NSC; const int type = s / 24, rem = s % 24, b = rem / 12, h = (rem % 12) >> 1, dir = rem & 1;
        if (type == 0) sc2::run0<0>(F, lane, wave, layer, b, h, dir, sc, wu); else sc2::run0<1>(F, lane, wave, layer, b, h, dir, sc, wu);
    }
    { const P0Split sp = p0_split(F.G, layer);
      if (gw >= sp.thrA) p0_run(F, (LAS float*)(F.lds + wave * sc2::WLDS0), lane, layer * P0_PER_L + P0_NFIX, gw - sp.thrA, sp.idleA, sp.NA); }
}
__device__ __forceinline__ void phase_scan2_c(Frame& F, int layer) {
    PHASE_IDS();
    const int gw = blk_ * NWAVES + wave, NGW = F.G * NWAVES;
    const bool need_ctx = layer == 0;
    for (int wu = gw; wu < 24 * NSC; wu += NGW) {
        const int sq = wu / NSC, blk = wu % NSC; const int type = sq / 12, b = (sq % 12) / 6, h = sq % 6;
        if (blk == 0 && !need_ctx) continue;
        const int scf = blk, scb = (blk == 0) ? 0 : 65 - blk;
        if (type == 0) { sc2::run<0, 1>(F, lane, wave, layer, b, h, 0, scf, scf == 0, 0); sc2::run<0, 2>(F, lane, wave, layer, b, h, 1, scb, scb == 0, 0); }
        else           { sc2::run<1, 1>(F, lane, wave, layer, b, h, 0, scf, scf == 0, 0); sc2::run<1, 2>(F, lane, wave, layer, b, h, 1, scb, scb == 0, 0); }
    }
    { const P0Split sp = p0_split(F.G, layer);
      if (gw >= sp.thrC) p0_run(F, (LAS float*)(F.lds + 67584 + wave * 8448), lane, layer * P0_PER_L + P0_NFIX + sp.NA, gw - sp.thrC, sp.idleC, sp.NC); }
}

namespace att {
constexpr int SLOT = 32768, NS = 3, WSF_OFF = NS * SLOT, OST_OFF = 0, OST_W = 32 * 68 * 4;
__device__ __forceinline__ int crow(int r, int hi) { return (r & 3) + 8 * (r >> 2) + 4 * hi; }
typedef short v4i16_t __attribute__((ext_vector_type(4)));
typedef LAS const char* lds_cptr;
__device__ __forceinline__ s16x4 vtr(lds_cptr p) { return __builtin_bit_cast(s16x4, __builtin_amdgcn_ds_read_tr16_b64_v4i16((LAS v4i16_t*)p)); }
__device__ __forceinline__ float max3f(float a, float b, float c) { return __builtin_fmaxf(__builtin_fmaxf(a, b), c); }
__device__ __forceinline__ float hmax32(const f32x16& p0, const f32x16& p1) {
    float a = max3f(p0[0], p0[1], p1[0]), b = max3f(p0[2], p0[3], p1[1]); a = max3f(a, p1[2], p1[3]);
#pragma unroll
    for (int r = 4; r < 16; r += 4) { a = max3f(a, p0[r], p0[r + 1]); b = max3f(b, p0[r + 2], p0[r + 3]); a = max3f(a, p1[r], p1[r + 1]); b = max3f(b, p1[r + 2], p1[r + 3]); }
    const float m = __builtin_fmaxf(a, b);
    auto rr = __builtin_amdgcn_permlane32_swap(__builtin_bit_cast(unsigned, m), __builtin_bit_cast(unsigned, m), false, false);
    return __builtin_fmaxf(__builtin_bit_cast(float, rr[0]), __builtin_bit_cast(float, rr[1]));
}
#define ATT_WAIT_BAR(N) asm volatile("s_waitcnt vmcnt(" #N ") lgkmcnt(0)\n\ts_barrier" ::: "memory")
template<int VAR>
__device__ __forceinline__ void attn_unit(Frame& F, int lane_in, int wid, int layer, int b, int h, bool isctx, int qb) {
    int lane = lane_in; asm volatile("" : "+v"(lane));
    const int r32 = lane & 31, hi = lane >> 5;
    LAS unsigned char* lds = F.lds; const unsigned lds0 = (unsigned)(uintptr_t)lds;
    const float* tab = (const float*)(F.ws + WS_TAB);
    const int qrow = qb * 256 + wid * 32 + r32;
    bf16x8 qr[2][2];
#pragma unroll
    for (int m = 0; m < 2; ++m) { const int mp = b * 8 + 2 * h + m;
        const bf16_t* qp = isctx ? (const bf16_t*)(F.ws + WS_QC) + ((size_t)mp * CL + qrow) * 32 : (const bf16_t*)(F.ws + WS_QA) + ((size_t)mp * T + qrow) * 32;
#pragma unroll
        for (int d0 = 0; d0 < 2; ++d0) qr[m][d0] = *(const bf16x8*)(qp + d0 * 16 + hi * 8); }
    const int NTL = isctx ? 2 : KT_TILES / 2;
    const bf16_t* ksrc = (const bf16_t*)(F.ws + WS_KA) + (size_t)((b * 8 + 2 * h + (wid >> 2)) * KT_TILES) * 2048 + (wid & 3) * 512;
    const unsigned char* vsrc = F.ws + WS_VA + (size_t)((b * 4 + h) * KT_TILES) * 4096 + (wid >> 2) * 4096 + (wid & 3) * 1024;
    const unsigned dma_off = (unsigned)lane * 16u;
#define ATT_DMA(t, slot) do { _Pragma("unroll") for (int sb_ = 0; sb_ < 2; ++sb_) \
                              ::glds16(ksrc + (size_t)(2 * (t) + sb_) * 2048, dma_off, (unsigned)__builtin_amdgcn_readfirstlane(lds0 + (slot) * SLOT + sb_ * 16384 + wid * 1024)); \
                              ::glds16(vsrc + (size_t)(t) * 8192, dma_off, (unsigned)__builtin_amdgcn_readfirstlane(lds0 + (slot) * SLOT + (wid >> 2) * 16384 + 8192 + (wid & 3) * 1024)); } while (0)
    LAS float* wsf = (LAS float*)(lds + WSF_OFF) + wid * 128;
    LAS float* ost = (LAS float*)(lds + OST_OFF + wid * OST_W);
    f32x16 o[2][2];
#pragma unroll
    for (int m = 0; m < 2; ++m)
#pragma unroll
        for (int d = 0; d < 2; ++d) o[m][d] = f32x16{};
    constexpr float POFS = 60.5f, PTHR = 32.f;
    float mhat = 0.f;
    f32x16 lacc[2]; lacc[0] = f32x16{}; lacc[1] = f32x16{};
    v8i ones8; { int o8 = 0x38383838; asm volatile("" : "+v"(o8)); ones8 = (v8i){o8, o8, o8, o8, o8, o8, o8, o8}; asm volatile("" : "+v"(ones8)); }
    f32x16 negm; { float z_ = POFS; asm volatile("" : "+v"(z_));
#pragma unroll
      for (int r = 0; r < 16; ++r) negm[r] = z_; }
    ATT_DMA(0, 0); ATT_DMA(1, 1);
    asm volatile("" : "+v"(qr[0][0]), "+v"(qr[0][1]), "+v"(qr[1][0]), "+v"(qr[1][1]));
    int slot = 0;
    for (int t = 0; t < NTL; ++t) {
        if (t + 1 < NTL) { ATT_WAIT_BAR(3); } else { ATT_WAIT_BAR(0); }
        if (t + 2 < NTL) { const int s2 = slot >= 1 ? slot - 1 : 2; ATT_DMA(t + 2, s2); }
#pragma unroll
        for (int sub = 0; sub < 2; ++sub) {
        const lds_cptr base = (lds_cptr)lds + slot * SLOT + sub * 16384;
        f32x16 p[2][2];
#pragma unroll
        for (int m = 0; m < 2; ++m) {
            const lds_cptr kb = base + m * 4096 + hi * 1024 + r32 * 16;
            const bf16x8 k00 = VAR == 4 ? qr[m][0] : *(const LAS bf16x8*)(kb), k01 = VAR == 4 ? qr[m][1] : *(const LAS bf16x8*)(kb + 512), k10 = VAR == 4 ? qr[1 - m][0] : *(const LAS bf16x8*)(kb + 2048), k11 = VAR == 4 ? qr[1 - m][1] : *(const LAS bf16x8*)(kb + 2048 + 512);
            p[m][0] = __builtin_amdgcn_mfma_f32_32x32x16_bf16(k00, qr[m][0], negm, 0, 0, 0);
            p[m][1] = __builtin_amdgcn_mfma_f32_32x32x16_bf16(k01, qr[m][0], negm, 0, 0, 0);
            p[m][0] = __builtin_amdgcn_mfma_f32_32x32x16_bf16(k10, qr[m][1], p[m][0], 0, 0, 0);
            p[m][1] = __builtin_amdgcn_mfma_f32_32x32x16_bf16(k11, qr[m][1], p[m][1], 0, 0, 0);
        }
        v8i vf[2];
        if (sub == 0 && (t & 1) == 0) {
          const float rm = __builtin_fmaxf(hmax32(p[0][0], p[0][1]), hmax32(p[1][0], p[1][1])) - POFS;
          const bool first = (t == 0);
          if (first || __any(rm > PTHR)) {
              const float dl = first ? rm : fmaxf(rm, 0.f);
              mhat += dl;
#pragma unroll
              for (int r = 0; r < 16; ++r) { p[0][0][r] -= dl; p[0][1][r] -= dl; p[1][0][r] -= dl; p[1][1][r] -= dl; negm[r] = POFS - mhat; }
              asm volatile("" : "+v"(negm));
              if (!first) {
                  const float f = __builtin_amdgcn_exp2f(-0.25f * dl);
                  if (hi == 0) wsf[r32] = f;
                  LDS_WAIT();
#pragma unroll
                  for (int r = 0; r < 16; ++r) { const float fr_ = wsf[crow(r, hi)]; o[0][0][r] *= fr_; o[0][1][r] *= fr_; o[1][0][r] *= fr_; o[1][1][r] *= fr_; lacc[0][r] *= fr_; lacc[1][r] *= fr_; }
                  LDS_WAIT();
              }
          } }
#pragma unroll
        for (int m = 0; m < 2; ++m) {
            f32x16& p0 = p[m][0]; f32x16& p1 = p[m][1];
            v8i pw;
#pragma unroll
            for (int q = 0; q < 4; ++q) {
                unsigned wa = __builtin_amdgcn_cvt_pk_u8_f32(p0[4 * q], 0, 0u), wb = __builtin_amdgcn_cvt_pk_u8_f32(p1[4 * q], 0, 0u);
#pragma unroll
                for (int j = 1; j < 4; ++j) { wa = __builtin_amdgcn_cvt_pk_u8_f32(p0[4 * q + j], j, wa); wb = __builtin_amdgcn_cvt_pk_u8_f32(p1[4 * q + j], j, wb); }
                pw[q] = (int)wa; pw[4 + q] = (int)wb; }
            if (m == 0) {
                const lds_cptr vp0 = base + 8192 + hi * 512 + r32 * 16;
#pragma unroll
                for (int d0 = 0; d0 < 2; ++d0) { const u32x4 lo = *(const LAS u32x4*)(vp0 + d0 * 1024), hh = *(const LAS u32x4*)(vp0 + d0 * 1024 + 2048);
                    vf[d0] = (v8i){(int)lo.x, (int)lo.y, (int)lo.z, (int)lo.w, (int)hh.x, (int)hh.y, (int)hh.z, (int)hh.w}; }
            }
#pragma unroll
            for (int d0 = 0; d0 < 2; ++d0) o[m][d0] = __builtin_amdgcn_mfma_scale_f32_32x32x64_f8f6f4(pw, vf[d0], o[m][d0], 1, 0, 0, 0x7F7F7F7F, 0, 0x7B7B7B7B);
            lacc[m] = __builtin_amdgcn_mfma_scale_f32_32x32x64_f8f6f4(pw, ones8, lacc[m], 1, 0, 0, 0x7F7F7F7F, 0, 0x7F7F7F7F);
        }
        }
        slot = slot == 2 ? 0 : slot + 1;
    }
    asm volatile("s_waitcnt lgkmcnt(0)\n\ts_barrier" ::: "memory");
    int lane_e = lane; asm volatile("" : "+v"(lane_e));
    const int r32e = lane_e & 31, hie = lane_e >> 5;
    const float lam = tab[TB_LAM + layer], oml = tab[TB_LAM + 2 + layer];
#pragma unroll
    for (int r = 0; r < 16; ++r) { const int qq = crow(r, hie); const float f0 = __builtin_amdgcn_rcpf(lacc[0][r]), f1 = -lam * __builtin_amdgcn_rcpf(lacc[1][r]);
#pragma unroll
        for (int d0 = 0; d0 < 2; ++d0) ost[qq * 68 + d0 * 32 + r32e] = o[0][d0][r] * f0 + o[1][d0][r] * f1; }
    LDS_WAIT();
    { const int rw = lane_e >> 1, hf = lane_e & 1; f32x4 xv[8]; float ss = 0.f;
#pragma unroll
      for (int j = 0; j < 8; ++j) { xv[j] = *(const LAS f32x4*)(ost + rw * 68 + hf * 32 + 4 * j); ss += (xv[j][0] * xv[j][0] + xv[j][1] * xv[j][1]) + (xv[j][2] * xv[j][2] + xv[j][3] * xv[j][3]); }
      ss += xor_swz<1>(ss);
      const float rs = __builtin_amdgcn_rsqf(ss * (1.f / 64.f) + EPS) * oml;
      const float* sw = F.in[13] + layer * 64 + hf * 32;
      const int qi = qb * 256 + wid * 32 + rw; const size_t orow = isctx ? (size_t)(NLAT + b * CL + qi) : (size_t)(b * T + qi);
      bf16_t* dst = (bf16_t*)(F.ws + WS_MIX) + orow * 1024 + 768 + h * 64 + hf * 32;
#pragma unroll
      for (int j = 0; j < 4; ++j) { const f32x4 a = xv[2 * j], c = xv[2 * j + 1]; const f32x4 wa = *(const f32x4*)(sw + 8 * j), wb = *(const f32x4*)(sw + 8 * j + 4);
          u32x4 w; w.x = pk2(a[0] * rs * wa[0], a[1] * rs * wa[1]); w.y = pk2(a[2] * rs * wa[2], a[3] * rs * wa[3]); w.z = pk2(c[0] * rs * wb[0], c[1] * rs * wb[1]); w.w = pk2(c[2] * rs * wb[2], c[3] * rs * wb[3]);
          *(u32x4*)(dst + 8 * j) = w; } }
    asm volatile("s_waitcnt lgkmcnt(0)\n\ts_barrier" ::: "memory");
#undef ATT_DMA
}

#define ATT_SBAR() __builtin_amdgcn_sched_barrier(0)
#define ATT_MFMA(a, b, c) __builtin_amdgcn_mfma_f32_32x32x16_bf16(a, b, c, 0, 0, 0)
#define ATT_PV(a, b, c, sb) __builtin_amdgcn_mfma_scale_f32_32x32x64_f8f6f4(a, b, c, 1, 0, 0, 0x7F7F7F7F, 0, sb)
constexpr float POFS = 60.5f, PTHR = 32.f;
struct PState { f32x16 o[2][2]; f32x4 lacc[2]; f32x16 negm; bf16x8 qr[2][2]; float mhat; };
#define ATT_CVT8(p, e0, W, i0) do { unsigned a_ = __builtin_amdgcn_cvt_pk_u8_f32(p[e0], 0, 0u), b_ = __builtin_amdgcn_cvt_pk_u8_f32(p[(e0) + 4], 0, 0u); \
    _Pragma("unroll") for (int j_ = 1; j_ < 4; ++j_) { a_ = __builtin_amdgcn_cvt_pk_u8_f32(p[(e0) + j_], j_, a_); b_ = __builtin_amdgcn_cvt_pk_u8_f32(p[(e0) + 4 + j_], j_, b_); } \
    W[i0] = (int)a_; W[(i0) + 1] = (int)b_; } while (0)
template<int M, bool LOADV>
__device__ __forceinline__ void pstep(PState& S, f32x16& pa0, f32x16& pa1, f32x16& pb0, f32x16& pb1, bf16x8& kA, bf16x8& kB, v8i (&vf)[2], const v4i& sel4, lds_cptr vb, lds_cptr kc, lds_cptr kn, bool chk, LAS float* wsfw, int lane) {
    constexpr int MN = 1 - M;
    if (chk) {
        const float rm = hmax32(pa0, pa1) - POFS;
        if (__any(rm > PTHR)) {
            const int r32 = lane & 31, hi = lane >> 5;
            const float dl = fmaxf(rm, 0.f);
            S.mhat += dl;
#pragma unroll
            for (int r = 0; r < 16; ++r) { pa0[r] -= dl; pa1[r] -= dl; S.negm[r] = POFS - S.mhat; }
            const float f = __builtin_amdgcn_exp2f(-0.25f * dl);
            if (hi == 0) wsfw[r32] = f;
            LDS_WAIT();
#pragma unroll
            for (int r = 0; r < 16; ++r) { const float fr_ = wsfw[crow(r, hi)]; S.o[0][0][r] *= fr_; S.o[0][1][r] *= fr_; S.o[1][0][r] *= fr_; S.o[1][1][r] *= fr_; }
            { const float fl_ = wsfw[(lane & 15) + 16 * hi]; S.lacc[0] = S.lacc[0] * fl_; S.lacc[1] = S.lacc[1] * fl_; }
            LDS_WAIT();
        }
    }
    v8i pw;
    ATT_SBAR(); pb0 = ATT_MFMA(kA, S.qr[MN][0], S.negm); ATT_SBAR();
    kA = *(const LAS bf16x8*)(kc + 2048);
    if (LOADV) {
#pragma unroll
        for (int d0 = 0; d0 < 2; ++d0) { const u32x4 lo = *(const LAS u32x4*)(vb + d0 * 1024), hh = *(const LAS u32x4*)(vb + d0 * 1024 + 2048);
            vf[d0] = (v8i){(int)lo.x, (int)lo.y, (int)lo.z, (int)lo.w, (int)hh.x, (int)hh.y, (int)hh.z, (int)hh.w}; }
    }
    ATT_CVT8(pa0, 0, pw, 0);
    ATT_SBAR(); pb1 = ATT_MFMA(kB, S.qr[MN][0], S.negm); ATT_SBAR();
    kB = *(const LAS bf16x8*)(kc + 2048 + 512);
    ATT_CVT8(pa0, 8, pw, 2);
    ATT_SBAR(); pb0 = ATT_MFMA(kA, S.qr[MN][1], pb0); ATT_SBAR();
    kA = *(const LAS bf16x8*)(kn);
    ATT_CVT8(pa1, 0, pw, 4);
    ATT_SBAR(); pb1 = ATT_MFMA(kB, S.qr[MN][1], pb1); ATT_SBAR();
    kB = *(const LAS bf16x8*)(kn + 512);
    ATT_CVT8(pa1, 8, pw, 6);
    ATT_SBAR(); S.o[M][0] = ATT_PV(pw, vf[0], S.o[M][0], 0x7B7B7B7B);
    ATT_SBAR(); S.o[M][1] = ATT_PV(pw, vf[1], S.o[M][1], 0x7B7B7B7B);
    ATT_SBAR(); S.lacc[M] = __builtin_amdgcn_mfma_scale_f32_16x16x128_f8f6f4((v8i){sel4[0], sel4[1], sel4[2], sel4[3], 0, 0, 0, 0}, pw, S.lacc[M], 4, 1, 0, 0x7F7F7F7F, 0, 0x7F7F7F7F); ATT_SBAR();
}
__device__ __forceinline__ void attn_unit_p(Frame& F, int lane_in, int wid, int layer, int b, int h, bool isctx, int qb) {
    int lane = lane_in; asm volatile("" : "+v"(lane));
    const int r32 = lane & 31, hi = lane >> 5;
    LAS unsigned char* lds = F.lds; const unsigned lds0 = (unsigned)(uintptr_t)lds;
    const float* tab = (const float*)(F.ws + WS_TAB);
    const int qrow = qb * 256 + wid * 32 + r32;
    PState S;
#pragma unroll
    for (int m = 0; m < 2; ++m) { const int mp = b * 8 + 2 * h + m;
        const bf16_t* qp = isctx ? (const bf16_t*)(F.ws + WS_QC) + ((size_t)mp * CL + qrow) * 32 : (const bf16_t*)(F.ws + WS_QA) + ((size_t)mp * T + qrow) * 32;
#pragma unroll
        for (int d0 = 0; d0 < 2; ++d0) S.qr[m][d0] = *(const bf16x8*)(qp + d0 * 16 + hi * 8); }
    const int NTL = isctx ? 2 : KT_TILES / 2;
    const bf16_t* ksrc = (const bf16_t*)(F.ws + WS_KA) + (size_t)((b * 8 + 2 * h + (wid >> 2)) * KT_TILES) * 2048 + (wid & 3) * 512;
    const unsigned char* vsrc = F.ws + WS_VA + (size_t)((b * 4 + h) * KT_TILES) * 4096 + (wid >> 2) * 4096 + (wid & 3) * 1024;
    const unsigned dma_off = (unsigned)lane * 16u;
#define ATT_DMA(t, slot) do { _Pragma("unroll") for (int sb_ = 0; sb_ < 2; ++sb_) \
                              ::glds16(ksrc + (size_t)(2 * (t) + sb_) * 2048, dma_off, (unsigned)__builtin_amdgcn_readfirstlane(lds0 + (slot) * SLOT + sb_ * 16384 + wid * 1024)); \
                              ::glds16(vsrc + (size_t)(t) * 8192, dma_off, (unsigned)__builtin_amdgcn_readfirstlane(lds0 + (slot) * SLOT + (wid >> 2) * 16384 + 8192 + (wid & 3) * 1024)); } while (0)
    LAS float* wsf = (LAS float*)(lds + WSF_OFF) + wid * 128;
    LAS float* ost = (LAS float*)(lds + OST_OFF + wid * OST_W);
#pragma unroll
    for (int m = 0; m < 2; ++m) { S.o[m][0] = f32x16{}; S.o[m][1] = f32x16{}; S.lacc[m] = (f32x4){0.f, 0.f, 0.f, 0.f}; }
    S.mhat = 0.f;
    { float z_ = POFS; asm volatile("" : "+v"(z_));
#pragma unroll
      for (int r = 0; r < 16; ++r) S.negm[r] = z_; }
    v4i sel4; { int o4 = (((lane >> 4) ^ (lane >> 3)) & 1) ? 0 : 0x22222222; asm volatile("" : "+v"(o4)); sel4 = (v4i){o4, o4, o4, o4}; asm volatile("" : "+v"(sel4)); }
    ATT_DMA(0, 0); ATT_DMA(1, 1);
    asm volatile("" : "+v"(S.qr[0][0]), "+v"(S.qr[0][1]), "+v"(S.qr[1][0]), "+v"(S.qr[1][1]));
    const int koff = hi * 1024 + r32 * 16, voff = 8192 + hi * 512 + r32 * 16;
    ATT_WAIT_BAR(3);
    f32x16 pa0, pa1, pb0, pb1; bf16x8 kA, kB; v8i vf[2];
    {
        const lds_cptr kb = (lds_cptr)lds + koff;
        kA = *(const LAS bf16x8*)(kb); kB = *(const LAS bf16x8*)(kb + 512);
        pa0 = ATT_MFMA(kA, S.qr[0][0], S.negm); pa1 = ATT_MFMA(kB, S.qr[0][0], S.negm);
        ATT_SBAR();
        kA = *(const LAS bf16x8*)(kb + 2048); kB = *(const LAS bf16x8*)(kb + 2048 + 512);
        pa0 = ATT_MFMA(kA, S.qr[0][1], pa0); pa1 = ATT_MFMA(kB, S.qr[0][1], pa1);
        ATT_SBAR();
        kA = *(const LAS bf16x8*)(kb + 4096); kB = *(const LAS bf16x8*)(kb + 4096 + 512);
        const float rm = hmax32(pa0, pa1) - POFS; S.mhat = rm;
#pragma unroll
        for (int r = 0; r < 16; ++r) { pa0[r] -= rm; pa1[r] -= rm; S.negm[r] = POFS - rm; }
    }
    int slot = 0;
    for (int t = 0; t < NTL; ++t) {
        ATT_WAIT_BAR(0);
        if (t + 2 < NTL) { const int s2 = slot >= 1 ? slot - 1 : 2; ATT_DMA(t + 2, s2); }
        const int sn = slot == 2 ? 0 : slot + 1;
        const lds_cptr tb = (lds_cptr)lds + slot * SLOT, tn = (lds_cptr)lds + sn * SLOT;
        const bool chk = (t & 1) == 0;
        pstep<0, true >(S, pa0, pa1, pb0, pb1, kA, kB, vf, sel4, tb + voff,         tb + 4096 + koff,         tb + 16384 + koff,        chk && t > 0, wsf, lane);
        pstep<1, false>(S, pb0, pb1, pa0, pa1, kA, kB, vf, sel4, tb + voff,         tb + 16384 + koff,        tb + 16384 + 4096 + koff, chk,          wsf, lane);
        pstep<0, true >(S, pa0, pa1, pb0, pb1, kA, kB, vf, sel4, tb + 16384 + voff, tb + 16384 + 4096 + koff, tn + koff,                false,        wsf, lane);
        pstep<1, false>(S, pb0, pb1, pa0, pa1, kA, kB, vf, sel4, tb + 16384 + voff, tn + koff,                tn + 4096 + koff,         false,        wsf, lane);
        slot = sn;
    }
    asm volatile("s_waitcnt lgkmcnt(0)\n\ts_barrier" ::: "memory");
    int lane_e = lane; asm volatile("" : "+v"(lane_e));
    const int r32e = lane_e & 31, hie = lane_e >> 5;
    const float lam = tab[TB_LAM + layer], oml = tab[TB_LAM + 2 + layer];
    if ((lane_e & 16) == 0) { const int ql = (lane_e & 15) + 16 * hie; wsf[ql] = __builtin_amdgcn_rcpf(S.lacc[0][0]); wsf[32 + ql] = __builtin_amdgcn_rcpf(S.lacc[1][0]); }
    LDS_WAIT();
#pragma unroll
    for (int r = 0; r < 16; ++r) { const int qq = crow(r, hie); const float f0 = wsf[qq], f1 = -lam * wsf[32 + qq];
#pragma unroll
        for (int d0 = 0; d0 < 2; ++d0) ost[qq * 68 + d0 * 32 + r32e] = S.o[0][d0][r] * f0 + S.o[1][d0][r] * f1; }
    LDS_WAIT();
    { const int rw = lane_e >> 1, hf = lane_e & 1; f32x4 xv[8]; float ss = 0.f;
#pragma unroll
      for (int j = 0; j < 8; ++j) { xv[j] = *(const LAS f32x4*)(ost + rw * 68 + hf * 32 + 4 * j); ss += (xv[j][0] * xv[j][0] + xv[j][1] * xv[j][1]) + (xv[j][2] * xv[j][2] + xv[j][3] * xv[j][3]); }
      ss += xor_swz<1>(ss);
      const float rs = __builtin_amdgcn_rsqf(ss * (1.f / 64.f) + EPS) * oml;
      const float* sw = F.in[13] + layer * 64 + hf * 32;
      const int qi = qb * 256 + wid * 32 + rw; const size_t orow = isctx ? (size_t)(NLAT + b * CL + qi) : (size_t)(b * T + qi);
      bf16_t* dst = (bf16_t*)(F.ws + WS_MIX) + orow * 1024 + 768 + h * 64 + hf * 32;
#pragma unroll
      for (int j = 0; j < 4; ++j) { const f32x4 a = xv[2 * j], c = xv[2 * j + 1]; const f32x4 wa = *(const f32x4*)(sw + 8 * j), wb = *(const f32x4*)(sw + 8 * j + 4);
          u32x4 w; w.x = pk2(a[0] * rs * wa[0], a[1] * rs * wa[1]); w.y = pk2(a[2] * rs * wa[2], a[3] * rs * wa[3]); w.z = pk2(c[0] * rs * wb[0], c[1] * rs * wb[1]); w.w = pk2(c[2] * rs * wb[2], c[3] * rs * wb[3]);
          *(u32x4*)(dst + 8 * j) = w; } }
    asm volatile("s_waitcnt lgkmcnt(0)\n\ts_barrier" ::: "memory");
#undef ATT_DMA
}
}
template<int VAR>
__device__ __forceinline__ void phase_attn(Frame& F, int layer, int ulo, int uhi) {
    PHASE_IDS();
    __syncthreads();
    const int nunits = 512 + (layer == 0 ? 8 : 0);
    for (int u = blk_; u < nunits && u < uhi; u += F.G) {
        if (u < ulo) continue;
        if (u < 512) { const int bh = u & 7, qb = u >> 3; att::attn_unit_p(F, lane, wave, layer, bh >> 2, bh & 3, false, qb); }
        else { const int bh = u - 512; att::attn_unit_p(F, lane, wave, layer, bh >> 2, bh & 3, true, 0); }
    }
}

__device__ __forceinline__ void phase_route(Frame& F, int layer) {
    PHASE_IDS();
    const int wid = wave, G = F.G, blk = blk_;
    const int nrows = layer == 0 ? NROW : NLAT;
    constexpr int TP = 2064;
    LAS unsigned char* Th = F.lds; LAS unsigned char* Tl = F.lds + 16 * TP; LAS float* Pp = (LAS float*)(F.lds + 32 * TP);
    LAS int* hist = (LAS int*)(F.lds + LDS_TAB); LAS int* sbase = hist + 32; LAS unsigned* ent = (LAS unsigned*)(hist + 64); LAS float* entg = (LAS float*)(ent + 640);
    for (int i = tid; i < 64 + 640; i += NTHR) hist[i] = (i < 64) ? 0 : -1;
    LAS float* mv = (LAS float*)(F.lds + 32 * TP + 16384);
    { const float* mg = (const float*)(F.ws + WS_MODV) + (size_t)layer * 3 * 6 * 1024;
      for (int i = tid; i < 9 * 256; i += NTHR) { const int v = i >> 8, c4 = i & 255; *(LAS f32x4*)(mv + v * 1024 + 4 * c4) = *(const f32x4*)(mg + (size_t)((v / 3) * 6 + 2 + (v % 3)) * 1024 + 4 * c4); } }
    bf16x8 bh[4][2], bl[4][2];
    { const bf16_t* rwh = (const bf16_t*)(F.ws + WS_RWT) + (size_t)layer * 32768; const bf16_t* rwl = rwh + 2 * 32768;
#pragma unroll
      for (int ks = 0; ks < 4; ++ks)
#pragma unroll
        for (int nb = 0; nb < 2; ++nb) { const int o_ = (16 * nb + (lane & 15)) * 1024 + 128 * wid + 32 * ks + 8 * (lane >> 4); bh[ks][nb] = *(const bf16x8*)(rwh + o_); bl[ks][nb] = *(const bf16x8*)(rwl + o_); } }
    __syncthreads();
    const float* modv = (const float*)(F.ws + WS_MODV) + (size_t)layer * 3 * 6 * 1024;
    const bf16_t* yb = (const bf16_t*)(F.ws + WS_Y);
    bf16_t* x1b = (bf16_t*)(F.ws + WS_X1);
    const int nloc = (nrows - blk + G - 1) / G;
    const float rbias = F.in[16][layer * 32 + (lane & 31)];
    const int nbatch = (nloc + 15) >> 4;
    for (int it = 0; it < nbatch; ++it) { const int i0 = 16 * it + 2 * wid;
        f32x4 tk[2][4]; bool val[2];
#pragma unroll
        for (int q = 0; q < 2; ++q) {
            const int il = i0 + q; val[q] = il < nloc; const int r = val[q] ? blk + il * G : blk;
            const int w = row_which(r);
            f32x4 x[4], y[4];
            if (layer == 0) row_load(r < NLAT ? F.in[0] + (size_t)r * D : F.in[2] + (size_t)(r - NLAT) * D, lane, x); else row_load_bf16(x1b + (size_t)r * D, lane, x);
#pragma unroll
            for (int j = 0; j < 4; ++j) { const u32x2 yy = *(const u32x2*)(yb + (size_t)r * D + 4 * lane + 256 * j); y[j] = (f32x4){bflo(yy.x), bfhi(yy.x), bflo(yy.y), bfhi(yy.y)}; }
            const float ry = __builtin_amdgcn_rsqf(row_sumsq(y) * (1.f / 1024.f) + EPS);
            const LAS float* c1 = mv + (w * 3 + 0) * 1024;
#pragma unroll
            for (int j = 0; j < 4; ++j) { const f32x4 cv = *(const LAS f32x4*)(c1 + 4 * lane + 256 * j); x[j] = x[j] + cv * (y[j] * ry); }
            if (val[q]) row_store_bf16(x1b + (size_t)r * D, lane, x);
            { const float rr_ = __builtin_amdgcn_rsqf(row_sumsq(x) * (1.f / 1024.f) + EPS); const LAS float* at_ = mv + (w * 3 + 1) * 1024; const LAS float* bt_ = mv + (w * 3 + 2) * 1024;
#pragma unroll
              for (int j = 0; j < 4; ++j) { const f32x4 av = *(const LAS f32x4*)(at_ + 4 * lane + 256 * j), bv = *(const LAS f32x4*)(bt_ + 4 * lane + 256 * j); tk[q][j] = x[j] * rr_ * av + bv; } }
            if (val[q]) {
                unsigned char* t8 = F.ws + WS_TOK8 + (size_t)r * D;
#pragma unroll
                for (int j = 0; j < 4; ++j) *(unsigned*)(t8 + 4 * lane + 256 * j) = pk4_fp8(tk[q][j][0], tk[q][j][1], tk[q][j][2], tk[q][j][3]); }
        }
#pragma unroll
        for (int q = 0; q < 2; ++q)
#pragma unroll
            for (int j = 0; j < 4; ++j) { unsigned hb[4], lb[4];
#pragma unroll
                for (int c = 0; c < 4; ++c) { hb[c] = f2bf(tk[q][j][c]); lb[c] = f2bf(tk[q][j][c] - __builtin_bit_cast(float, hb[c] << 16)); }
                const int off = (2 * wid + q) * TP + (4 * lane + 256 * j) * 2;
                *(LAS u32x2*)(Th + off) = (u32x2){hb[0] | (hb[1] << 16), hb[2] | (hb[3] << 16)}; *(LAS u32x2*)(Tl + off) = (u32x2){lb[0] | (lb[1] << 16), lb[2] | (lb[3] << 16)}; }
        __syncthreads();
        { f32x4 pacc[2]; pacc[0] = (f32x4){0.f, 0.f, 0.f, 0.f}; pacc[1] = pacc[0];
#pragma unroll
          for (int ks = 0; ks < 4; ++ks) { const int ao = (lane & 15) * TP + (128 * wid + 32 * ks + 8 * (lane >> 4)) * 2;
              const bf16x8 ah = *(const LAS bf16x8*)(Th + ao), al = *(const LAS bf16x8*)(Tl + ao);
#pragma unroll
              for (int nb = 0; nb < 2; ++nb) { pacc[nb] = __builtin_amdgcn_mfma_f32_16x16x32_bf16(ah, bh[ks][nb], pacc[nb], 0, 0, 0); pacc[nb] = __builtin_amdgcn_mfma_f32_16x16x32_bf16(al, bh[ks][nb], pacc[nb], 0, 0, 0);
                                               pacc[nb] = __builtin_amdgcn_mfma_f32_16x16x32_bf16(ah, bl[ks][nb], pacc[nb], 0, 0, 0); } }
#pragma unroll
          for (int nb = 0; nb < 2; ++nb)
#pragma unroll
              for (int r = 0; r < 4; ++r) Pp[(wid * 16 + 4 * (lane >> 4) + r) * 32 + 16 * nb + (lane & 15)] = pacc[nb][r]; }
        __syncthreads();
        float lg = 0.f;
#pragma unroll
        for (int w8 = 0; w8 < 8; ++w8) lg += Pp[(w8 * 16 + 2 * wid + (lane >> 5)) * 32 + (lane & 31)];
        lg += rbias;
#ifdef DBG_CHECK
        { const int q_ = lane >> 5; if (q_ == 0 ? val[0] : val[1]) ((float*)(F.ws + WS_END + 65536))[(size_t)(blk + (i0 + q_) * G) * 32 + (lane & 31)] = lg; }
#endif
        float tv[4]; int te[4];
#pragma unroll
        for (int k = 0; k < 4; ++k) {
            float m = lg;
            m = fmaxf(m, xor_swz<16>(m)); m = fmaxf(m, xor_swz<8>(m)); m = fmaxf(m, xor_swz<4>(m)); m = fmaxf(m, xor_swz<2>(m)); m = fmaxf(m, xor_swz<1>(m));
            const unsigned long long bal = __ballot(lg == m);
            const unsigned hb = (lane & 32) ? (unsigned)(bal >> 32) : (unsigned)bal;
            const int idx = __builtin_ctz(hb);
            tv[k] = m; te[k] = idx;
            if ((lane & 31) == idx) lg = -INFINITY;
        }
        float g[4]; { float s = 0.f;
#pragma unroll
            for (int k = 0; k < 4; ++k) { g[k] = __expf(tv[k] - tv[0]); s += g[k]; }
            const float inv = 1.f / s;
#pragma unroll
            for (int k = 0; k < 4; ++k) g[k] *= inv; }
        const int q = lane >> 5, k = lane & 31;
        if (k < 4 && (q == 0 ? val[0] : val[1])) {
            const int il = i0 + q; const int r = blk + il * G;
            const int ee = (k == 0) ? te[0] : (k == 1) ? te[1] : (k == 2) ? te[2] : te[3];
            const float gg = (k == 0) ? g[0] : (k == 1) ? g[1] : (k == 2) ? g[2] : g[3];
            entg[il * 4 + k] = gg;
            const int lp = __hip_atomic_fetch_add(hist + ee, 1, __ATOMIC_RELAXED, __HIP_MEMORY_SCOPE_WORKGROUP);
            ent[il * 4 + k] = (unsigned)ee | ((unsigned)lp << 8);
        }
    }
    __syncthreads();
    if (tid < 32) sbase[tid] = (int)__hip_atomic_fetch_add((unsigned*)F.ctl + CW_CNT + layer * 32 + tid, (unsigned)hist[tid], __ATOMIC_RELAXED, __HIP_MEMORY_SCOPE_AGENT);
    __syncthreads();
    int* slot = (int*)(F.ws + WS_SLOT);
    for (int i = tid; i < nloc * 4; i += NTHR) { const unsigned en = ent[i]; if (en != 0xffffffffu) { const int e = en & 255, pos = sbase[e] + (int)(en >> 8); const int r = blk + (i >> 2) * G;
        slot[e * CAP + pos] = r * 4 + (i & 3); ((float*)(F.ws + WS_SGATE))[e * CAP + pos] = entg[i]; ((int*)(F.ws + WS_GATE))[r * 4 + (i & 3)] = e | (pos << 8); } }
    __syncthreads();
}
__device__ __forceinline__ void moe_tables(Frame& F, int layer) {
    PHASE_IDS();
    LAS int* tab = (LAS int*)(F.lds + LDS_TAB);
    if (tid == 0) { int acc = 0;
        for (int e = 0; e < 32; ++e) { const int c = (int)__hip_atomic_load((unsigned*)F.ctl + CW_CNT + layer * 32 + e, __ATOMIC_RELAXED, __HIP_MEMORY_SCOPE_AGENT); tab[e] = acc; tab[33 + e] = c; acc += (c + 255) >> 8; }
        tab[32] = acc; }
    __syncthreads();
}
__device__ __forceinline__ void phase_combine(Frame& F, int layer) {
    PHASE_IDS();
    const int gw = blk_ * NWAVES + wave, NGW = F.G * NWAVES;
    const int nrows = layer == 0 ? NROW : NLAT;
    const unsigned char* yk = F.ws + WS_YK; bf16_t* x1b = (bf16_t*)(F.ws + WS_X1);
    LAS float* mv = (LAS float*)F.lds;
    { const float* mg = (const float*)(F.ws + WS_MODV);
      for (int i = tid; i < 9 * 256; i += NTHR) { const int v = i >> 8, c4 = i & 255, w = v / 3, k = v % 3;
          const float* src = (k == 0) ? mg + (size_t)((layer * 3 + w) * 6 + 5) * 1024 : mg + (size_t)((1 * 3 + w) * 6 + (k - 1)) * 1024;
          *(LAS f32x4*)(mv + v * 1024 + 4 * c4) = *(const f32x4*)(src + 4 * c4); } }
    moe_tables(F, layer);
    const LAS int* ttab = (const LAS int*)(F.lds + LDS_TAB); const int* epos = (const int*)(F.ws + WS_GATE);
#define CMB_ISSUE(R, EP, YB, XB) do { _Pragma("unroll") for (int k = 0; k < 4; ++k) { const int ep = __builtin_amdgcn_readfirstlane(EP[k]); const unsigned char* yr = yk + (size_t)(256 * ttab[ep & 255] + (ep >> 8)) * D + 4 * lane; \
        _Pragma("unroll") for (int j = 0; j < 4; ++j) YB[k][j] = *(const unsigned*)(yr + 256 * j); } \
        _Pragma("unroll") for (int j = 0; j < 4; ++j) XB[j] = *(const u32x2*)(x1b + (size_t)(R) * D + 4 * lane + 256 * j); } while (0)
    int epn[4]; unsigned yb[4][4]; u32x2 xb[4];
#pragma unroll
    for (int k = 0; k < 4; ++k) epn[k] = (gw < nrows) ? epos[gw * 4 + k] : 0;
    if (gw < nrows) CMB_ISSUE(gw, epn, yb, xb);
    if (gw + NGW < nrows) {
#pragma unroll
        for (int k = 0; k < 4; ++k) epn[k] = epos[(gw + NGW) * 4 + k];
    }
    for (int r = gw; r < nrows; r += NGW) {
        const int w = row_which(r), rn = r + NGW;
        unsigned yn[4][4]; u32x2 xn[4];
        if (rn < nrows) {
            CMB_ISSUE(rn, epn, yn, xn);
            if (rn + NGW < nrows) {
#pragma unroll
                for (int k = 0; k < 4; ++k) epn[k] = epos[(rn + NGW) * 4 + k];
            }
        }
        f32x4 x[4], f[4];
#pragma unroll
        for (int j = 0; j < 4; ++j) { x[j] = (f32x4){bflo(xb[j].x), bfhi(xb[j].x), bflo(xb[j].y), bfhi(xb[j].y)}; f[j] = (f32x4){0.f, 0.f, 0.f, 0.f}; }
#pragma unroll
        for (int k = 0; k < 4; ++k)
#pragma unroll
            for (int j = 0; j < 4; ++j) { const unsigned u = yb[k][j];
                const f32x2 lo = __builtin_amdgcn_cvt_pk_f32_fp8((int)u, false), hi = __builtin_amdgcn_cvt_pk_f32_fp8((int)u, true); f[j][0] += lo[0]; f[j][1] += lo[1]; f[j][2] += hi[0]; f[j][3] += hi[1]; }
#pragma unroll
        for (int j = 0; j < 4; ++j) f[j] = f[j] * 0.0625f;
        const float rf = __builtin_amdgcn_rsqf(row_sumsq(f) * (1.f / 1024.f) + EPS);
        const LAS float* c2 = mv + (w * 3 + 0) * 1024;
#pragma unroll
        for (int j = 0; j < 4; ++j) { const f32x4 cv = *(const LAS f32x4*)(c2 + 4 * lane + 256 * j); x[j] = x[j] + cv * (f[j] * rf); }
        if (layer == 1) row_store(F.out + (size_t)r * D, lane, x);
        else { row_store_bf16(x1b + (size_t)r * D, lane, x);
            const float rr_ = __builtin_amdgcn_rsqf(row_sumsq(x) * (1.f / 1024.f) + EPS); const LAS float* ah_ = mv + (w * 3 + 1) * 1024; const LAS float* bh_ = mv + (w * 3 + 2) * 1024;
            f32x4 o[4];
#pragma unroll
            for (int j = 0; j < 4; ++j) { const f32x4 av = *(const LAS f32x4*)(ah_ + 4 * lane + 256 * j), bv = *(const LAS f32x4*)(bh_ + 4 * lane + 256 * j); o[j] = x[j] * rr_ * av + bv; }
            row_store_bf16((bf16_t*)(F.ws + WS_H) + (size_t)r * D, lane, o); }
#pragma unroll
        for (int k = 0; k < 4; ++k)
#pragma unroll
            for (int j = 0; j < 4; ++j) yb[k][j] = yn[k][j];
#pragma unroll
        for (int j = 0; j < 4; ++j) xb[j] = xn[j];
    }
#undef CMB_ISSUE
}

__device__ __forceinline__ void gemm_tail_copy(Frame& F, int layer, int which) {
    PHASE_IDS();
    const P0Split sp = p0_split(F.G, layer);
    const int thr = which ? sp.thrO : sp.thrI, nshort = which ? sp.shortO : sp.shortI, n = which ? sp.NO : sp.NI, off = sp.NA + sp.NC + (which ? sp.NI : 0);
    if (nshort > 0 && blk_ >= thr) p0_run(F, (LAS float*)(F.lds + wave * 16384), lane, layer * P0_PER_L + P0_NFIX + off, (blk_ - thr) * NWAVES + wave, nshort * NWAVES, n);
}

struct Args { const float* in[21]; float* out; unsigned char* ws; int ph_lo, ph_hi; };
constexpr int PH_PER_LAYER = 10, NPHASE = 2 + 2 * PH_PER_LAYER;
template <int SUB> __global__ void __launch_bounds__(NTHR, 2) mk_fwd(Args args) {
    extern __shared__ __attribute__((aligned(16))) unsigned char lds_raw[];
    Frame F;
    F.lds = (LAS unsigned char*)lds_raw; F.ws = args.ws; F.out = args.out;
#pragma unroll
    for (int i = 0; i < 21; ++i) F.in[i] = args.in[i];
    F.ctl = (gu32*)(args.ws + WS_CTL);
    __builtin_amdgcn_s_setreg(1473, 1);
    F.tid = threadIdx.x; F.lane = F.tid & 63; F.wave = __builtin_amdgcn_readfirstlane(F.tid >> 6); F.G = gridDim.x; F.blk = blockIdx.x;
    volatile LAS unsigned* misc = (volatile LAS unsigned*)(F.lds + LDS_MISC);
    if (F.tid < 16) misc[F.tid] = 0u;
    __syncthreads();
    const int lo = args.ph_lo, hi = args.ph_hi;
    const bool use_bar = (hi - lo) > 1;
    XcdBarrier bar; bar.bar = (unsigned*)F.ctl + CW_BAR; bar.x = 0; bar.st = nullptr;
    if (use_bar) { bar = xcd_barrier_post((unsigned*)F.ctl + CW_BAR, misc + 8); if (F.tid == 0) xcd_barrier_census(bar); }
#define IN(k) (lo <= (k) && (k) < hi)
#define SEAM(k) do { if (IN(k) && IN((k) + 1)) xcd_barrier(bar); } while (0)
    if (PHON(0) && IN(0)) { for (int rep = 0; rep < NREP(0); ++rep) phase_prologue_a(F); } SEAM(0);
    if (PHON(1) && IN(1)) { for (int rep = 0; rep < NREP(1); ++rep) phase_prologue_b(F); } SEAM(1);
    for (int layer = 0; layer < 2; ++layer) {
        const int p0 = 2 + layer * PH_PER_LAYER;
        unsigned char* ws = F.ws;
        int blk_ = F.blk; asm volatile("" : "+s"(blk_));
        if (PHON(2) && IN(p0 + 0)) {
            pg8::DenseSched S; S.init(ws + WS_H, (bf16_t*)(ws + WS_WIN) + (size_t)layer * NIN * 1024, NROW, NIN, F.G, blk_);
            EpiInProj E{ws, (const float*)(ws + WS_TAB), (const float*)(ws + WS_ROPE), layer};
            if (STAG_EN_IN) stagger_dense((NROW / 256) * (NIN / 256), F.G, blk_);
            for (int rep = 0; rep < NREP(2); ++rep) pg8::gemm_phase<EpiInProj, pg8::DenseSched, false, false, (SUB & 4) != 0>(F.lds, F.wave, S, E);
            gemm_tail_copy(F, layer, 0);
        } SEAM(p0 + 0);
        if (PHON(3) && IN(p0 + 1)) { if constexpr (SUB & 1) phase_scan2_a(F, layer); if constexpr (SUB & 2) phase_attn<0>(F, layer, 0, F.G); } SEAM(p0 + 1);
        if (PHON(4) && IN(p0 + 2)) { for (int rep = 0; rep < NREP(4); ++rep) phase_scan_b(F); } SEAM(p0 + 2);
        if (PHON(5) && IN(p0 + 3)) { if constexpr (SUB & 1) phase_scan2_c(F, layer); if constexpr (SUB & 2) phase_attn<0>(F, layer, F.G, 1 << 30); } SEAM(p0 + 3);
          if (IN(p0 + 4) && IN(p0 + 5) && !IN(p0 + 3)) xcd_barrier(bar);
        if (PHON(7) && IN(p0 + 5)) {
            pg8::DenseSched S; S.init(ws + WS_MIX, (bf16_t*)(ws + WS_WOUT) + (size_t)layer * 1024 * 1024, layer == 0 ? NROW : NLAT, 1024, F.G, blk_);
            EpiBf16OutT<(SUB & 64) != 0> E{(bf16_t*)(ws + WS_Y)};
            { const int nwg = ((layer == 0 ? NROW : NLAT) / 256) * 4; if (STAG_EN_OUT && (nwg % F.G)) stagger_dense(nwg, F.G, blk_); }
            for (int rep = 0; rep < NREP(7); ++rep) pg8::gemm_phase<EpiBf16OutT<(SUB & 64) != 0>, pg8::DenseSched, false, false, (SUB & 4) != 0>(F.lds, F.wave, S, E);
            gemm_tail_copy(F, layer, 1);
        } SEAM(p0 + 5);
        if (PHON(8) && IN(p0 + 6)) { phase_route(F, layer); } SEAM(p0 + 6);
        if (PHON(9) && IN(p0 + 7)) {
            moe_tables(F, layer);
            pg8::MoeSched<8, true, 1024> S{(const char*)(ws + WS_TOK8), (const char*)(ws + WS_W1 + (size_t)layer * NE * 2048 * 1024), (const int*)(ws + WS_SLOT), (const LAS int*)(F.lds + LDS_TAB), F.G, blk_, (size_t)2048 * 1024};
            EpiSwiglu E{ws + WS_ACT, F.in[18] + (size_t)layer * NE * 2048};
            for (int rep = 0; rep < NREP(9); ++rep) pg8::gemm_phase<EpiSwiglu, pg8::MoeSched<8, true, 1024>, true, true, (SUB & 4) != 0>(F.lds, F.wave, S, E);
        } SEAM(p0 + 7);
        if (PHON(10) && IN(p0 + 8)) {
            moe_tables(F, layer);
            pg8::MoeSched<4, false, 1024> S{(const char*)(ws + WS_ACT), (const char*)(ws + WS_W2 + (size_t)layer * NE * 1024 * 1024), (const int*)(ws + WS_SLOT), (const LAS int*)(F.lds + LDS_TAB), F.G, blk_, (size_t)1024 * 1024};
            EpiMoeOutT<((SUB & 64) ? 1 : (SUB & 128) ? 2 : 0)> E{ws + WS_YK, F.in[20] + (size_t)layer * NE * 1024, (const float*)(ws + WS_SGATE)};
            if (STAG_EN_G2 && (F.G & 7) == 0) { const int ntile = __builtin_amdgcn_readfirstlane(((const LAS int*)(F.lds + LDS_TAB))[32]), per = F.G >> 2;
                const int rem = ntile - 8 * (blk_ >> 5) - (blk_ & 7), cnt = rem > 0 ? (rem + per - 1) / per : 0, nmax = (ntile + per - 1) / per;
                stagger_ns(blk_ * STAG_STEP + (cnt < nmax ? STAG_SHORT : 0)); }
            for (int rep = 0; rep < NREP(10); ++rep) pg8::gemm_phase<EpiMoeOutT<((SUB & 64) ? 1 : (SUB & 128) ? 2 : 0)>, pg8::MoeSched<4, false, 1024>, false, true, (SUB & 4) != 0>(F.lds, F.wave, S, E);
        } SEAM(p0 + 8);
        if (PHON(11) && IN(p0 + 9)) { phase_combine(F, layer); } SEAM(p0 + 9);
    }
#ifdef OVFL_PROBE
    int lane_z; asm volatile("v_mbcnt_lo_u32_b32 %0, -1, 0\n\tv_mbcnt_hi_u32_b32 %0, -1, %0" : "=v"(lane_z));
    if (hi == NPHASE && F.blk == 0 && F.wave == 0 && lane_z == 0) { int w = 0; float big = 1e6f, huge = 3e38f; asm volatile("" : "+v"(big), "+v"(huge));
      w = __builtin_amdgcn_cvt_pk_bf8_f32(big, huge, w, false); int w2 = 0; w2 = __builtin_amdgcn_cvt_pk_fp8_f32(big, huge, w2, false);
      if (((w & 0xffff) != 0x7B7B) || ((w2 & 0xffff) != 0x7E7E)) { asm volatile("s_waitcnt vmcnt(0)" ::: "memory"); F.out[5] = __builtin_nanf(""); } }
#endif
#undef IN
#undef SEAM
}


#ifdef DBG_CHECK
namespace dbg {
__device__ float blk_sum(float v, float* red) { const int t = threadIdx.x; red[t] = v; __syncthreads(); for (int o = 128; o > 0; o >>= 1) { if (t < o) red[t] += red[t + o]; __syncthreads(); } const float r = red[0]; __syncthreads(); return r; }
struct Ctx { const float* const* in; unsigned char* ws; float* red; };
__device__ float bfb(const unsigned char* ws, size_t off, size_t idx) { return bf2f(((const bf16_t*)(ws + off))[idx]); }
__device__ float zdot(const Ctx& c, int row, int ocol) {
    float a = 0.f; for (int k = threadIdx.x; k < 1024; k += 256) a += bfb(c.ws, WS_H, (size_t)row * 1024 + k) * c.in[7][(size_t)k * 4224 + ocol];
    return blk_sum(a, c.red);
}
__device__ void upd(float* flag, float got, float want) { const float e = fabsf(got - want) / (fabsf(want) + 0.05f); if (threadIdx.x == 0 && (e > *flag || !(e == e))) *flag = (e == e) ? e : 1e9f; }
__device__ float sc_buf(const Ctx& c, int which, int row, int col) { return bfb(c.ws, WS_SCAN + (size_t)which * SCAN_PITCH, (size_t)row * 384 + col); }
__device__ void naive_scan(const Ctx& c, const float* tab, int type, int b, int h, int dir, int n, float* S, float* o64) {
    const int t = threadIdx.x;
    for (int i = t; i < 4096; i += 256) S[i] = 0.f; __syncthreads();
    const float gam = tab[TB_GAM + 0 * 12 + dir * 6 + h];
    int lastrow = 0;
    for (int p = 0; p < n; ++p) {
        const int sc = p < 256 ? 0 : 1 + (p - 256) / 256, pl = p < 256 ? p : (p - 256) % 256; const int row = scan_row(sc, pl, dir, 0) + (sc == 0 ? b * CL : b * T); lastrow = row;
        for (int i = t; i < 4096; i += 256) { const int k = i >> 6, v = i & 63;
            const float kk = sc_buf(c, type ? SC_RK : (dir ? SC_KB : SC_KF), row, h * 64 + k), vv = sc_buf(c, type ? SC_RV : SC_HV, row, h * 64 + v);
            const float f = type ? gam : 1.f - kk; S[i] = f * S[i] + kk * vv; }
        __syncthreads();
    }
    if (t < 64) { float o = 0.f; for (int k = 0; k < 64; ++k) o += sc_buf(c, type ? SC_RQ : SC_HQ, lastrow, h * 64 + k) * S[k * 64 + t]; o64[t] = o; }
    __syncthreads();
}
__global__ void __launch_bounds__(256) k_check(Args args, float* flags) {
    __shared__ float red[256]; __shared__ float S[4096]; __shared__ float o1[64], o2[64];
    Ctx c{args.in, args.ws, red}; const int id = blockIdx.x, t = threadIdx.x; float* fl = flags + id;
    const float* tab = (const float*)(args.ws + WS_TAB);
    if (t == 0) { *fl = 0.f; if (id == 12) { flags[13] = 0.f; flags[14] = 0.f; flags[15] = 0.f; } } __syncthreads();
#define rows(i) ((i) == 0 ? 5 : (i) == 1 ? 20000 : 33000)
    if (id == 0) { for (int ri = 0; ri < 3; ++ri) for (int cc = 3; cc < 384; cc += 197) { const float z = zdot(c, rows(ri), cc); upd(fl, sc_buf(c, SC_HQ, rows(ri), cc), z); } }
    if (id == 1) { for (int ri = 0; ri < 3; ++ri) for (int cc = 3; cc < 384; cc += 197) { upd(fl, sc_buf(c, SC_HV, rows(ri), cc), zdot(c, rows(ri), 1152 + cc)); upd(fl, sc_buf(c, SC_RG, rows(ri), cc), zdot(c, rows(ri), 3072 + cc)); upd(fl, sc_buf(c, SC_HG, rows(ri), cc), zdot(c, rows(ri), 1536 + cc)); upd(fl, sc_buf(c, SC_RV, rows(ri), cc), zdot(c, rows(ri), 2688 + cc)); } }
    if (id == 2) { for (int ri = 0; ri < 3; ++ri) for (int cc = 3; cc < 384; cc += 197) { const float z1 = zdot(c, rows(ri), 384 + cc), z2 = zdot(c, rows(ri), 768 + cc); upd(fl, sc_buf(c, SC_KF, rows(ri), cc), 1.f / (1.f + expf(z1))); upd(fl, sc_buf(c, SC_KB, rows(ri), cc), 1.f / (1.f + expf(z2))); } }
    if (id == 3) { for (int ri = 0; ri < 3; ++ri) for (int hh = 0; hh < 6; hh += 5) for (int i = 1; i < 32; i += 13) for (int isk = 0; isk < 2; ++isk) { const int r = rows(ri); const bool ctx = r >= NLAT; const int tt = r & (T - 1);
            const float x1 = zdot(c, r, 1920 + 384 * isk + hh * 64 + i), x2 = zdot(c, r, 1920 + 384 * isk + hh * 64 + i + 32);
            const float ang = ctx ? 0.f : (float)tt * powf(10000.f, -(float)i / 32.f); const float cs = cosf(ang), sn = sinf(ang), scl = isk ? 0.125f : 1.f;
            upd(fl, sc_buf(c, isk ? SC_RK : SC_RQ, r, hh * 64 + 2 * i), (x1 * cs - x2 * sn) * scl); upd(fl, sc_buf(c, isk ? SC_RK : SC_RQ, r, hh * 64 + 2 * i + 1), (x2 * cs + x1 * sn) * scl); } }
    if (id == 4) { for (int ri = 0; ri < 3; ++ri) for (int mp = 0; mp < 8; mp += 7) for (int half = 0; half < 2; ++half) for (int j = 1; j < 8; j += 5) { const int r = rows(ri); const bool ctx = r >= NLAT; const int tt = ctx ? (r - NLAT) & 255 : r & (T - 1); const int bb = ctx ? (r - NLAT) >> 8 : r >> 14;
            const int pos = half ? (tt & 63) : (tt >> 6); const float ang = ctx ? 0.f : (float)pos * powf(10000.f, -(float)j / 8.f); const float cs = cosf(ang), sn = sinf(ang);
            { const float x1 = zdot(c, r, 3456 + mp * 32 + half * 16 + j), x2 = zdot(c, r, 3456 + mp * 32 + half * 16 + j + 8); const float scl = 0.17677669529663687f * LOG2E;
              const size_t qi = ctx ? ((size_t)(bb * 8 + mp) * CL + tt) * 32 + half * 16 + 2 * j : ((size_t)(bb * 8 + mp) * T + tt) * 32 + half * 16 + 2 * j;
              upd(fl, bfb(c.ws, ctx ? WS_QC : WS_QA, qi), (x1 * cs - x2 * sn) * scl); upd(fl, bfb(c.ws, ctx ? WS_QC : WS_QA, qi + 1), (x2 * cs + x1 * sn) * scl); }
            { const float x1 = zdot(c, r, 3712 + mp * 32 + half * 16 + j), x2 = zdot(c, r, 3712 + mp * 32 + half * 16 + j + 8);
              const int Lk = ctx ? tt : 256 + tt, tile = Lk >> 6, rr = Lk & 63, pw = half * 16 + 2 * j;
              const size_t ki = ((size_t)((bb * 8 + mp) * KT_TILES + tile) * 4 + (pw >> 3)) * 512 + rr * 8 + (pw & 7);
              upd(fl, bfb(c.ws, WS_KA, ki), x1 * cs - x2 * sn); upd(fl, bfb(c.ws, WS_KA, ki + 1), x2 * cs + x1 * sn); }
            { const int h4 = mp >> 1, w = half * 32 + j * 3; const float z = zdot(c, r, 3968 + h4 * 64 + w); const int Lk = ctx ? tt : 256 + tt, tile = Lk >> 6, rr = Lk & 63;
              upd(fl, bfb(c.ws, WS_VA, ((size_t)((bb * 4 + h4) * KT_TILES + tile) * 2 + (w >> 5)) * 2048 + rr * 32 + (w & 31)), z); } } }
    if (id == 5 || id == 6) {
        const int type = id - 5, b = 1, h = 2;
#define ts(i) ((i) == 0 ? 0 : (i) == 1 ? 1 : 300)
        for (int q = 0; q < 3; ++q) { naive_scan(c, tab, type, b, h, 0, 256 + ts(q) + 1, S, o1);
            if (t < 64) { const float got = ((const float*)(args.ws + WS_OSCR))[(size_t)(b * T + ts(q)) * 768 + type * 384 + h * 64 + t]; const float e = fabsf(got - o1[t]) / (fabsf(o1[t]) + 0.05f); if (e > 0.05f || !(e == e)) atomicMax((int*)fl, __float_as_int((e == e) ? e : 1e9f)); } __syncthreads(); }
    }
    if (id == 7 || id == 8) {
        const int type = id - 7, b = 1, h = 4;
        for (int q = 0; q < 2; ++q) {
            int row;
            if (q == 0) { naive_scan(c, tab, type, b, h, 0, 101, S, o1); naive_scan(c, tab, type, b, h, 1, 256 - 100, S, o2); row = NLAT + b * CL + 100; }
            else { naive_scan(c, tab, type, b, h, 1, 257, S, o2); row = b * T + T - 1; if (t < 64) o1[t] = ((const float*)(args.ws + WS_OSCR))[(size_t)row * 768 + type * 384 + h * 64 + t]; __syncthreads(); }
            float o = t < 64 ? o1[t] + o2[t] : 0.f; const float ss = blk_sum(o * o, red); const float r = rsqrtf(ss / 64.f + EPS);
            if (t < 64) { const float g = sc_buf(c, type ? SC_RG : SC_HG, row, h * 64 + t); const float want = o * r * args.in[type ? 11 : 9][t] * g / (1.f + expf(-g));
                const float got = bfb(c.ws, WS_MIX, (size_t)row * 1024 + type * 384 + h * 64 + t); const float e = fabsf(got - want) / (fabsf(want) + 0.05f); if (e > 0.05f || !(e == e)) atomicMax((int*)fl, __float_as_int((e == e) ? e : 1e9f)); }
            __syncthreads(); }
    }
    if (id == 9) {
        for (int q = 0; q < 2; ++q) { const bool ctx = q == 1; const int b = ctx ? 0 : 1, h = ctx ? 3 : 2, tq = ctx ? 77 : 5000; const int nk = ctx ? 256 : 16640;
            __shared__ float po[2][64]; __shared__ float pl[2];
            for (int m = 0; m < 2; ++m) { const int mp = b * 8 + 2 * h + m;
                float mx = -1e30f;
                for (int kk = t; kk < nk; kk += 256) { float sdot = 0.f; for (int d = 0; d < 32; ++d) { const float qv = bfb(c.ws, ctx ? WS_QC : WS_QA, ((size_t)mp * (ctx ? CL : T) + tq) * 32 + d); const float kv = bfb(c.ws, WS_KA, ((size_t)(mp * KT_TILES + (kk >> 6)) * 4 + (d >> 3)) * 512 + (kk & 63) * 8 + (d & 7)); sdot += qv * kv; } mx = fmaxf(mx, sdot); }
                red[t] = mx; __syncthreads(); for (int o = 128; o > 0; o >>= 1) { if (t < o) red[t] = fmaxf(red[t], red[t + o]); __syncthreads(); } mx = red[0]; __syncthreads();
                float ls = 0.f; float av[64];
_Pragma("unroll") for (int d = 0; d < 64; ++d) av[d] = 0.f;
                for (int kk = t; kk < nk; kk += 256) { float sdot = 0.f; for (int d = 0; d < 32; ++d) { const float qv = bfb(c.ws, ctx ? WS_QC : WS_QA, ((size_t)mp * (ctx ? CL : T) + tq) * 32 + d); const float kv = bfb(c.ws, WS_KA, ((size_t)(mp * KT_TILES + (kk >> 6)) * 4 + (d >> 3)) * 512 + (kk & 63) * 8 + (d & 7)); sdot += qv * kv; }
                    const float p = exp2f(sdot - mx); ls += p;
_Pragma("unroll") for (int d = 0; d < 64; ++d) av[d] += p * bfb(c.ws, WS_VA, ((size_t)((b * 4 + h) * KT_TILES + (kk >> 6)) * 2 + (d >> 5)) * 2048 + (kk & 63) * 32 + (d & 31)); }
                ls = blk_sum(ls, red);
_Pragma("unroll") for (int d = 0; d < 64; ++d) { const float sv = blk_sum(av[d], red); if (t == 0) po[m][d] = sv; } if (t == 0) pl[m] = ls; __syncthreads();
            }
            const float lam = tab[TB_LAM + 0], oml = tab[TB_LAM + 2];
            float o = t < 64 ? po[0][t] / pl[0] - lam * po[1][t] / pl[1] : 0.f; const float ss = blk_sum(o * o, red); const float r = rsqrtf(ss / 64.f + EPS);
            if (t < 64) { const float want = o * r * args.in[13][t] * oml; const size_t row = ctx ? (size_t)(NLAT + b * CL + tq) : (size_t)(b * T + tq); const float got = bfb(c.ws, WS_MIX, row * 1024 + 768 + h * 64 + t);
                const float e = fabsf(got - want) / (fabsf(want) + 0.05f); if (e > 0.05f || !(e == e)) atomicMax((int*)fl, __float_as_int((e == e) ? e : 1e9f)); }
            __syncthreads(); }
    }
    if (id == 10) { for (int ri = 0; ri < 3; ++ri) for (int cc = 7; cc < 1024; cc += 401) { float a = 0.f; for (int k = t; k < 1024; k += 256) a += bfb(c.ws, WS_MIX, (size_t)rows(ri) * 1024 + k) * args.in[14][(size_t)k * 1024 + cc]; a = blk_sum(a, red); upd(fl, ((const float*)(args.ws + WS_Y))[(size_t)rows(ri) * 1024 + cc], a); } }
    if (id == 11) {
        const float* modv = (const float*)(args.ws + WS_MODV);
        for (int ri = 0; ri < 3; ++ri) { const int r = rows(ri), w = row_which(r); const float* xs = r < NLAT ? args.in[0] + (size_t)r * D : args.in[2] + (size_t)(r - NLAT) * D; const float* y = (const float*)(args.ws + WS_Y) + (size_t)r * D;
            float sy = 0.f; for (int k = t; k < 1024; k += 256) sy += y[k] * y[k]; sy = blk_sum(sy, red); const float ry = rsqrtf(sy / 1024.f + EPS);
            float x1[4]; float sx = 0.f;
_Pragma("unroll") for (int q = 0; q < 4; ++q) { const int k = t + 256 * q; x1[q] = xs[k] + modv[(size_t)(w * 6 + 2) * 1024 + k] * y[k] * ry; sx += x1[q] * x1[q]; } sx = blk_sum(sx, red); const float rx = rsqrtf(sx / 1024.f + EPS);
_Pragma("unroll")
            for (int q = 0; q < 4; ++q) { const int k = t + 256 * q; const float tk = x1[q] * rx * modv[(size_t)(w * 6 + 3) * 1024 + k] + modv[(size_t)(w * 6 + 4) * 1024 + k];
                const float got = bfb(c.ws, WS_H, (size_t)r * 1024 + k), got1 = ((const float*)(args.ws + WS_X1))[(size_t)r * 1024 + k];
                const float e = fmaxf(fabsf(got - tk) / (fabsf(tk) + 0.05f), fabsf(got1 - x1[q]) / (fabsf(x1[q]) + 0.05f)); if (e > 0.05f || !(e == e)) atomicMax((int*)fl, __float_as_int((e == e) ? e : 1e9f)); }
            __syncthreads(); } }

    if (id == 12) {
        __shared__ float tokf[1024], lg[32], abuf[2048], actb[1024], yb[1024]; __shared__ int te[4]; __shared__ float tg[4]; __shared__ int spos;
        const unsigned* cnt = (const unsigned*)(args.ws + WS_CTL) + CW_CNT; const int* slot = (const int*)(args.ws + WS_SLOT);
        for (int ri = 0; ri < 3; ++ri) { const int r = rows(ri);
            for (int k = t; k < 1024; k += 256) tokf[k] = bfb(c.ws, WS_H, (size_t)r * 1024 + k); __syncthreads();
            if (t < 32) { float a = args.in[16][t]; for (int k = 0; k < 1024; ++k) a += tokf[k] * args.in[15][(size_t)k * 32 + t]; lg[t] = a; } __syncthreads();
            if (t < 32) { const float got = ((const float*)(args.ws + WS_END + 65536))[(size_t)r * 32 + t]; const float e = fabsf(got - lg[t]); if (e > 0.02f || !(e == e)) atomicMax((int*)(flags + 15), __float_as_int((e == e) ? 1.f + e : 1e9f)); } __syncthreads();
            if (t == 0) { float tv[4]; for (int k = 0; k < 4; ++k) { int bi = 0; float bv = -1e30f; for (int e = 0; e < 32; ++e) if (lg[e] > bv) { bv = lg[e]; bi = e; } te[k] = bi; tv[k] = bv; lg[bi] = -1e30f; }
                float sm = 0.f; for (int k = 0; k < 4; ++k) { tg[k] = expf(tv[k] - tv[0]); sm += tg[k]; } for (int k = 0; k < 4; ++k) tg[k] /= sm; } __syncthreads();
            if (t < 4) { const float got = ((const float*)(args.ws + WS_GATE))[(size_t)r * 4 + t]; const float e = fabsf(got - tg[t]) / (tg[t] + 0.01f); if (e > 0.05f || !(e == e)) atomicMax((int*)(flags + 12), __float_as_int((e == e) ? e : 1e9f)); }
            for (int k4 = 0; k4 < 4; ++k4) { const int e = te[k4]; const float* w1 = args.in[17] + (size_t)e * 1024 * 2048; const float* w2 = args.in[19] + (size_t)e * 1024 * 1024;
                for (int n = t; n < 2048; n += 256) { float a = args.in[18][(size_t)e * 2048 + n]; for (int k = 0; k < 1024; ++k) a += tokf[k] * w1[(size_t)k * 2048 + n]; abuf[n] = a; } __syncthreads();
                for (int j = t; j < 1024; j += 256) { const float g = fminf(abuf[2 * j], 7.f), l = fminf(fmaxf(abuf[2 * j + 1], -7.f), 7.f); actb[j] = g / (1.f + expf(-1.702f * g)) * (l + 1.f); } __syncthreads();
                for (int cc = t; cc < 1024; cc += 256) { float a = args.in[20][(size_t)e * 1024 + cc]; for (int j = 0; j < 1024; ++j) a += actb[j] * w2[(size_t)j * 1024 + cc]; yb[cc] = a * tg[k4]; } __syncthreads();
                if (t == 0) spos = -1; __syncthreads();
                const int ce = (int)cnt[e]; for (int p = t; p < ce; p += 256) if (slot[e * CAP + p] == r * 4 + k4) spos = p; __syncthreads();
                int ts0 = 0; for (int q = 0; q < e; ++q) ts0 += ((int)cnt[q] + 255) >> 8;
                float sqa = 0.f, sqy = 0.f; for (int k = t; k < 1024; k += 256) { sqa += actb[k] * actb[k]; sqy += yb[k] * yb[k]; } sqa = blk_sum(sqa, red); sqy = blk_sum(sqy, red); const float ra = sqrtf(sqa / 1024.f), ry = sqrtf(sqy / 1024.f);
                if (spos < 0) { if (t == 0) flags[13] = 7e8f; }
                else for (int k = t; k < 1024; k += 256) { const float got = bfb(c.ws, WS_ACT, ((size_t)ts0 * 256 + spos) * 1024 + k); const float er = fabsf(got - actb[k]) / (fabsf(actb[k]) + 0.2f * ra + 1e-6f); if (er > 0.05f || !(er == er)) atomicMax((int*)(flags + 13), __float_as_int((er == er) ? er : 1e9f)); }
                for (int k = t; k < 1024; k += 256) { const float got = bfb(c.ws, WS_YK, ((size_t)r * 4 + k4) * 1024 + k); const float er = fabsf(got - yb[k]) / (fabsf(yb[k]) + 0.2f * ry + 1e-6f); if (er > 0.05f || !(er == er)) atomicMax((int*)(flags + 14), __float_as_int((er == er) ? er : 1e9f)); }
                __syncthreads(); }
        } }
}
__global__ void k_out(Args args, const float* flags, int nchk, unsigned mask) {
    int code = 0; for (int i = nchk - 1; i >= 0; --i) if (((mask >> i) & 1u) && flags[i] > 0.05f) code = i + 1;
    const float sc = 1.f + (float)code;
    for (size_t i = (size_t)blockIdx.x * blockDim.x + threadIdx.x; i < (size_t)NLAT * D; i += (size_t)gridDim.x * blockDim.x) args.out[i] = args.in[0][i] * sc;
}
}
#endif

extern "C" void kernel_launch(void* const* d_in, const int* in_sizes, int n_in, void* d_out, int out_size, void* d_ws, size_t ws_size, hipStream_t stream) {
    static int grid = 0;
    if (grid == 0) {
        if (n_in != 21 || out_size != NLAT * D || ws_size < WS_END) { fprintf(stderr, "kernel_launch: unexpected shapes (n_in %d out %d ws %zu)\n", n_in, out_size, ws_size); grid = -1; return; }
        int dev = 0, cus = 0, per_cu = 0;
        if (hipGetDevice(&dev) != hipSuccess || hipDeviceGetAttribute(&cus, hipDeviceAttributeMultiprocessorCount, dev) != hipSuccess) { grid = -1; return; }
        if (hipFuncSetAttribute((const void*)mk_fwd<MAIN_SUB>, hipFuncAttributeMaxDynamicSharedMemorySize, LDS_BYTES) != hipSuccess) { fprintf(stderr, "kernel_launch: hipFuncSetAttribute failed\n"); grid = -1; return; }
        if (hipOccupancyMaxActiveBlocksPerMultiprocessor(&per_cu, (const void*)mk_fwd<MAIN_SUB>, NTHR, LDS_BYTES) != hipSuccess || per_cu < 1) fprintf(stderr, "kernel_launch: occupancy query reports %d\n", per_cu);
        (void)hipGetLastError();
        grid = cus;
    }
    if (grid < 0) return;
    if (hipMemsetAsync((char*)d_ws + WS_CTL, 0, CTL_ZERO_BYTES, stream) != hipSuccess) return;
    Args a{};
    for (int i = 0; i < 21; ++i) a.in[i] = (const float*)d_in[i];
    a.out = (float*)d_out; a.ws = (unsigned char*)d_ws;
#if MK_ONE_LAUNCH
    a.ph_lo = 0; a.ph_hi = NPHASE;
    hipLaunchKernelGGL(mk_fwd<MAIN_SUB>, dim3(grid), dim3(NTHR), LDS_BYTES, stream, a);
#elif defined(DBG_CHECK)
    for (int p = 0; p < DBG_CHECK; ++p) { a.ph_lo = p; a.ph_hi = p + 1; hipLaunchKernelGGL(mk_fwd<MAIN_SUB>, dim3(grid), dim3(NTHR), LDS_BYTES, stream, a); }
    float* flags = (float*)((char*)d_ws + WS_END);
    hipLaunchKernelGGL(dbg::k_check, dim3(13), dim3(256), 0, stream, a, flags);
    hipLaunchKernelGGL(dbg::k_out, dim3(1024), dim3(256), 0, stream, a, (const float*)flags, 16, (unsigned)DBG_MASK);
#else
    if (hipFuncSetAttribute((const void*)mk_fwd<PROBE_SUB>, hipFuncAttributeMaxDynamicSharedMemorySize, LDS_BYTES) != hipSuccess) return;
    for (int p = 0; p < NPHASE; ++p) { a.ph_lo = p; a.ph_hi = p + 1; hipLaunchKernelGGL(mk_fwd<MAIN_SUB>, dim3(grid), dim3(NTHR), LDS_BYTES, stream, a);
        const int pid = p < 2 ? p : 2 + (p - 2) % PH_PER_LAYER;
        if (pid == PROBE_PH) for (int rep = 0; rep < PROBE_REP; ++rep) hipLaunchKernelGGL(mk_fwd<PROBE_SUB>, dim3(grid), dim3(NTHR), LDS_BYTES, stream, a); }
#endif
}
```

```cpp
#include <hip/hip_runtime.h>
#include <cstdio>
#include <cstdint>
#include <cmath>

#ifndef DBG_MASK
#define DBG_MASK 0xf800
#endif
#ifndef PHMASK
#define PHMASK 0xfff
#endif
#define PHON(k) ((PHMASK >> (k)) & 1)
#ifndef REPMASK
#define REPMASK 0
#endif
#define NREP(k) (1 + ((REPMASK >> (k)) & 1))
#ifndef ATTVAR
#define ATTVAR -1
#endif
#ifndef MK_ONE_LAUNCH
#define MK_ONE_LAUNCH 1
#endif
#define MAIN_SUB 3
#define PROBE_PH -1
#define PROBE_SUB 3
#define PROBE_REP 1

#define LAS __attribute__((address_space(3)))
#define GAS __attribute__((address_space(1)))
typedef unsigned short bf16_t;
typedef short bf16x8 __attribute__((ext_vector_type(8)));
typedef short s16x4 __attribute__((ext_vector_type(4)));
typedef float f32x2 __attribute__((ext_vector_type(2)));
typedef float f32x4 __attribute__((ext_vector_type(4)));
typedef float f32x16 __attribute__((ext_vector_type(16)));
typedef unsigned u32x2 __attribute__((ext_vector_type(2)));
typedef unsigned u32x4 __attribute__((ext_vector_type(4)));
typedef GAS unsigned gu32;
typedef int v4i __attribute__((ext_vector_type(4)));
typedef int v8i __attribute__((ext_vector_type(8)));

constexpr int NB = 2, T = 16384, CL = 256, D = 1024;
constexpr int NLAT = NB * T, NCTX = NB * CL, NROW = NLAT + NCTX;
constexpr int NE = 32, CAP = NROW;
constexpr int NIN = 4352;
constexpr int NSEQ = 48, NSC = 65;
constexpr int KT_TILES = 260;
constexpr float EPS = 1e-6f;
constexpr float LOG2E = 1.4426950408889634f;
constexpr int NWAVES = 8, NTHR = 512;

constexpr size_t MiB = 1u << 20;
constexpr size_t WS_CTL = 0, CTL_ZERO_BYTES = 64 * 1024;
constexpr size_t WS_MODV = 1 * MiB;
constexpr size_t WS_TAB = 1 * MiB + 256 * 1024;
constexpr size_t WS_RWT = 1 * MiB + 512 * 1024;
constexpr size_t WS_ROPE = 2 * MiB;
constexpr size_t WS_WIN = 6 * MiB;
constexpr size_t WS_WOUT = 23 * MiB;
constexpr size_t WS_W1 = 27 * MiB;
constexpr size_t WS_W2 = 283 * MiB;
constexpr size_t WS_X1 = 411 * MiB;
constexpr size_t WS_H = 541 * MiB;
constexpr size_t WS_SCAN = 606 * MiB;
constexpr size_t SCAN_PITCH = 25 * MiB;
constexpr size_t WS_QA = 831 * MiB;
constexpr size_t WS_QC = 847 * MiB;
constexpr size_t WS_KA = 848 * MiB;
constexpr size_t WS_VA = 865 * MiB;
constexpr size_t WS_SLOC = 882 * MiB;
constexpr size_t WS_SIN = 931 * MiB;
constexpr size_t WS_DEC = 980 * MiB;
constexpr size_t WS_OSCR = 981 * MiB;
constexpr size_t WS_MIX = 1079 * MiB;
constexpr size_t WS_Y = 1144 * MiB;
constexpr size_t WS_SLOT = 1274 * MiB;
constexpr size_t WS_GATE = 1279 * MiB;
constexpr size_t WS_ACT = 1280 * MiB;
constexpr size_t WS_YK = 1540 * MiB;
constexpr size_t WS_TOK8 = 1816 * MiB;
constexpr size_t WS_SGATE = 1850 * MiB;
constexpr size_t WS_END = 1856 * MiB;
enum { SC_KF = 0, SC_KB = 1, SC_RQ = 2, SC_RK = 3, SC_HQ = 4, SC_HV = 5, SC_HG = 6, SC_RV = 7, SC_RG = 8 };
constexpr int CW_TMO = 0, CW_BAR = 4096, CW_CNT = 8192;
constexpr int TB_LBT = 0;
constexpr int TB_LAM = 1024;
constexpr int TB_GAM = 1040;
constexpr int TB_AXR = 2048;
constexpr int TB_AXC = 2048 + 4096;

constexpr int LDS_BYTES = 147456;
constexpr int LDS_MISC = 131072 + 12288;
constexpr int LDS_TAB = 131072;

__device__ __forceinline__ unsigned f2bf(float f) { unsigned u = __builtin_bit_cast(unsigned, f); return (u + 0x7fffu + ((u >> 16) & 1u)) >> 16; }
__device__ __forceinline__ float bf2f(unsigned short b) { return __builtin_bit_cast(float, (unsigned)b << 16); }
__device__ __forceinline__ float bflo(unsigned w) { return __builtin_bit_cast(float, w << 16); }
__device__ __forceinline__ float bfhi(unsigned w) { return __builtin_bit_cast(float, w & 0xffff0000u); }
typedef __bf16 bf16x2_t __attribute__((ext_vector_type(2)));
__device__ __forceinline__ unsigned trunc_pk_bf16(float lo, float hi) { return __builtin_amdgcn_perm(__builtin_bit_cast(unsigned, hi), __builtin_bit_cast(unsigned, lo), 0x07060302u); }
__device__ __forceinline__ unsigned cvt_pk_bf16(float lo, float hi) { const f32x2 v = {lo, hi}; const bf16x2_t b = __builtin_convertvector(v, bf16x2_t); return __builtin_bit_cast(unsigned, b); }
__device__ __forceinline__ unsigned pk2(float lo, float hi) { return cvt_pk_bf16(lo, hi); }
__device__ __forceinline__ float wave_sum_dpp(float v) {
#define DPP_ADD(ctrl, rmask) v += __builtin_bit_cast(float, __builtin_amdgcn_update_dpp(0, __builtin_bit_cast(int, v), ctrl, rmask, 0xF, false))
    DPP_ADD(0xB1, 0xF); DPP_ADD(0x4E, 0xF); DPP_ADD(0x141, 0xF); DPP_ADD(0x140, 0xF); DPP_ADD(0x142, 0xA); DPP_ADD(0x143, 0xC);
#undef DPP_ADD
    return __builtin_bit_cast(float, __builtin_amdgcn_readlane(__builtin_bit_cast(int, v), 63));
}
__device__ __forceinline__ float wave_sum(float v) { return wave_sum_dpp(v); }
template <int M> __device__ __forceinline__ float xor_swz(float v) { return __builtin_bit_cast(float, __builtin_amdgcn_ds_swizzle(__builtin_bit_cast(int, v), 0x1F | (M << 10))); }
__device__ __forceinline__ float xor32(float v, int lane) { return __builtin_bit_cast(float, __builtin_amdgcn_ds_bpermute((lane ^ 32) << 2, __builtin_bit_cast(int, v))); }
__device__ __forceinline__ float rdlane(float v, int l) { return __builtin_bit_cast(float, __builtin_amdgcn_readlane(__builtin_bit_cast(int, v), l)); }
__device__ __forceinline__ float sigmoidf_(float x) { return __builtin_amdgcn_rcpf(1.f + __builtin_amdgcn_exp2f(-LOG2E * x)); }
#define PHASE_IDS_W(WV) int lane; asm volatile("v_mbcnt_lo_u32_b32 %0, -1, 0\n\tv_mbcnt_hi_u32_b32 %0, -1, %0" : "=v"(lane)); int wave = (WV); asm volatile("" : "+s"(wave)); const int tid = wave * 64 + lane; (void)tid
#define PHASE_IDS() PHASE_IDS_W(F.wave); int blk_ = F.blk; asm volatile("" : "+s"(blk_))
__device__ __forceinline__ unsigned pk4_fp8(float a, float b, float c, float d) { int w = __builtin_bit_cast(int, a); w = __builtin_amdgcn_cvt_pk_fp8_f32(a, b, w, false); w = __builtin_amdgcn_cvt_pk_fp8_f32(c, d, w, true); return (unsigned)w; }
constexpr float W8_MUL = 64.f;
constexpr int SCALE_W8 = 0x79797979, SCALE_A8 = 0x7F7F7F7F;
#define LDS_WAIT() asm volatile("s_waitcnt lgkmcnt(0)" ::: "memory")
#define VM_WAIT() asm volatile("s_waitcnt vmcnt(0)" ::: "memory")

#define XB_TMO      128
#define XB_XCNT(j)  (256  + 64 * (j))
#define XB_XSUB(j)  (1280 + 64 * (j))
#define XB_XGEN(j)  (2304 + 64 * (j))
#define XB_TOP      3328
#define XB_TOPGEN   3392
#define XCD_BAR_WORDS 3456
#define XB_SPIN_CAP (1u << 22)
__device__ __forceinline__ unsigned xb_ld(unsigned* p)              { return __hip_atomic_load(p, __ATOMIC_RELAXED, __HIP_MEMORY_SCOPE_AGENT); }
__device__ __forceinline__ unsigned xb_add(unsigned* p, unsigned v) { return __hip_atomic_fetch_add(p, v, __ATOMIC_RELAXED, __HIP_MEMORY_SCOPE_AGENT); }
__device__ __forceinline__ unsigned xb_xcc_id() { return (unsigned)__builtin_amdgcn_s_getreg((3 << 11) | 20) & 0xFu; }
#define XB_SPIN(cond, bar) do { unsigned _sp = 0; while (cond) { __builtin_amdgcn_s_sleep(1); \
    if ((++_sp & 255u) == 0u) { if (xb_ld(&(bar)[XB_TMO])) break; if (_sp > XB_SPIN_CAP) { atomicAdd(&(bar)[XB_TMO], 1u); break; } } } } while (0)
struct XcdBarrier { unsigned* bar; unsigned x; volatile LAS unsigned* st; };
__device__ __forceinline__ XcdBarrier xcd_barrier_post(unsigned* bar, volatile LAS unsigned* st) {
    XcdBarrier b; b.bar = bar; b.x = xb_xcc_id(); b.st = st;
    if (threadIdx.x == 0) (void)xb_add(&bar[XB_XCNT(b.x)], 1u);
    return b;
}
__device__ __forceinline__ void xcd_barrier_complete(unsigned* bar, unsigned x, unsigned& nloc, unsigned& nx) {
    const unsigned G = gridDim.x * gridDim.y * gridDim.z;
    unsigned sum, cnt, mine, sp = 0u;
    for (;;) {
        sum = 0u; cnt = 0u; mine = 0u;
#pragma unroll
        for (unsigned j = 0; j < 16; ++j) { const unsigned c = xb_ld(&bar[XB_XCNT(j)]); sum += c; cnt += (c > 0u) ? 1u : 0u; mine = (j == x) ? c : mine; }
        if (sum == G) break;
        __builtin_amdgcn_s_sleep(1);
        if ((++sp & 255u) == 0u) { if (xb_ld(&bar[XB_TMO])) break; if (sp > XB_SPIN_CAP) { atomicAdd(&bar[XB_TMO], 1u); break; } }
    }
    nloc = mine > 0u ? mine : 1u; nx = cnt > 0u ? cnt : 1u;
}
__device__ __forceinline__ void xcd_barrier_census(const XcdBarrier& b) {
    unsigned nloc, nx; xcd_barrier_complete(b.bar, b.x, nloc, nx); b.st[0] = nloc; b.st[1] = nx;
}
__device__ __forceinline__ void xcd_barrier(const XcdBarrier& b) {
    asm volatile("s_waitcnt vmcnt(0)" ::: "memory");
    __syncthreads();
    if (threadIdx.x == 0) {
        unsigned* bar = b.bar;
        __builtin_amdgcn_s_waitcnt(0);
        const unsigned nloc = b.st[0], nx = b.st[1];
        const unsigned old = xb_add(&bar[XB_XSUB(b.x)], 1u);
        const unsigned gen = old / nloc;
        if (old + 1u == (gen + 1u) * nloc) {
            __builtin_amdgcn_fence(__ATOMIC_RELEASE, "agent");
            asm volatile("s_waitcnt vmcnt(0)" ::: "memory");
            const unsigned og = xb_add(&bar[XB_TOP], 1u);
            const unsigned tg = og / nx;
            if (og + 1u == (tg + 1u) * nx) xb_add(&bar[XB_TOPGEN], 1u);
            else XB_SPIN(xb_ld(&bar[XB_TOPGEN]) == tg, bar);
            __builtin_amdgcn_fence(__ATOMIC_ACQUIRE, "agent");
            xb_add(&bar[XB_XGEN(b.x)], 1u);
            asm volatile("s_waitcnt vmcnt(0)" ::: "memory");
        } else {
            XB_SPIN(xb_ld(&bar[XB_XGEN(b.x)]) == gen, bar);
            __builtin_amdgcn_fence(__ATOMIC_ACQUIRE, "agent");
            asm volatile("s_waitcnt vmcnt(0)" ::: "memory");
        }
    }
    __syncthreads();
}

#ifndef STAG_STEP
#define STAG_STEP 0
#endif
#ifndef STAG_SHORT
#define STAG_SHORT 13000
#endif
#define STAG_EN_IN ((SUB & 8) != 0)
#define STAG_EN_OUT ((SUB & 16) != 0)
#define STAG_EN_G2 ((SUB & 32) != 0)
__device__ __forceinline__ void stagger_ns(int ns) {
    if (ns <= 0) return;
    const unsigned long long t0 = __builtin_amdgcn_s_memrealtime(), dt = (unsigned long long)(ns / 10);
    while (__builtin_amdgcn_s_memrealtime() - t0 < dt) __builtin_amdgcn_s_sleep(8);
}
__device__ __forceinline__ void stagger_dense(int nwg, int G, int c) {
    const int cnt = (nwg - c + G - 1) / G, nmax = (nwg + G - 1) / G;
    stagger_ns(c * STAG_STEP + (cnt < nmax ? STAG_SHORT : 0));
}
struct Frame {
    LAS unsigned char* lds;
    unsigned char* ws;
    const float* in[21];
    float* out;
    gu32* ctl;
    int tid, lane, wave, G, blk;
};

__device__ __forceinline__ void glds16(const void* sbase, unsigned voff, unsigned lds_dst) { unsigned keep;
    asm volatile("s_mov_b32 %0, m0\n\ts_mov_b32 m0, %3\n\ts_nop 0\n\tglobal_load_lds_dwordx4 %1, %2\n\ts_mov_b32 m0, %0" : "=&s"(keep) : "v"(voff), "s"(sbase), "s"(lds_dst) : "memory"); }

namespace pg8 {
constexpr int BM = 256, BK = 64, HALF = 128, HTB = HALF * BK * 2, STAGE_BYTES = 8 * HTB, NXCD = 8, WGM = 8, K = 1024;
__host__ __device__ __forceinline__ int lds_byte(int r, int c) { const int st = (r >> 4) * 2 + (c >> 5), rr = r & 15, cc = c & 31, ob = rr * 64 + cc * 2; return st * 1024 + (ob ^ (((ob >> 9) & 1) << 5)); }
__host__ __device__ __forceinline__ void stage_rc(int b, int& R, int& C) { const int st = b / 1024, sb = b % 1024, swz = sb ^ (((sb >> 9) & 1) << 5); R = (st >> 1) * 16 + swz / 64; C = (st & 1) * 32 + (swz % 64) / 2; }
__host__ __device__ __forceinline__ int perm32(int rho) { const int n = rho >> 4, i = rho & 15; return 8 * (i >> 2) + 4 * n + (i & 3); }
struct Unit { int pm, pn, e, nvalid, sbase; };
template <class Epi, class Sched, bool GATHER, bool FP8 = false, bool NOEPI = false>
__device__ __forceinline__ void gemm_phase(LAS unsigned char* lds, int wave_id, const Sched& S, const Epi& E) {
    constexpr int KB = FP8 ? 1024 : 2048, NT = KB / 128;
    PHASE_IDS_W(wave_id); const int wid = wave, wr = wid >> 2, wc = wid & 3, fr = lane & 15, fq = lane >> 4;
    unsigned voffB[2], vA[2][2]; int R0, C0;
    { int R, C; stage_rc(tid * 16, R, C); R0 = R; C0 = C;
#pragma unroll
      for (int i = 0; i < 2; ++i) { const int Ri = R + 64 * i; const int Rb = Epi::PERM ? ((Ri & ~31) + perm32(Ri & 31)) : Ri; voffB[i] = (unsigned)(Rb * KB + C * 2);
#pragma unroll
          for (int h = 0; h < 2; ++h) vA[h][i] = (unsigned)((Ri + 128 * h) * KB + C * 2); } }
    const size_t kstep = (size_t)(BK * 2);
    const size_t hstep = (size_t)HALF * KB;
    const unsigned ldsw = (unsigned)wid * 1024u, lds0 = (unsigned)(uintptr_t)lds;
    const int aoff = lds_byte(wr * 64 + fr, fq * 8), boff = lds_byte(wc * 32 + fr, fq * 8);
#define PG8_SA(b, h) (((b) * 2 + (h)) * HTB)
#define PG8_SB(b, h) ((4 + (b) * 2 + (h)) * HTB)
#define PG8_STAGE(bufoff, gbase, voff) do { _Pragma("unroll") for (int _i = 0; _i < 2; ++_i) \
        glds16((const void*)(gbase), (voff)[_i], (unsigned)__builtin_amdgcn_readfirstlane(lds0 + (unsigned)(bufoff) + ldsw + _i * 8192)); } while (0)
#define PG8_LDA(dst, b, h) do { _Pragma("unroll") for (int m = 0; m < 4; ++m) { dst[m].lo = *(const LAS v4i*)(lds + PG8_SA(b, h) + aoff + m * 2048); dst[m].hi = *(const LAS v4i*)(lds + PG8_SA(b, h) + aoff + m * 2048 + 1024); } } while (0)
#define PG8_LDB(dst, b, h) do { _Pragma("unroll") for (int n = 0; n < 2; ++n) { dst[n].lo = *(const LAS v4i*)(lds + PG8_SB(b, h) + boff + n * 2048); dst[n].hi = *(const LAS v4i*)(lds + PG8_SB(b, h) + boff + n * 2048 + 1024); } } while (0)
#define PG8_MMA(ai, bj, At, Bt) do { __builtin_amdgcn_s_setprio(1); _Pragma("unroll") for (int m = 0; m < 4; ++m) _Pragma("unroll") for (int n = 0; n < 2; ++n) { \
        if constexpr (FP8) acc[ai][bj][m][n] = __builtin_amdgcn_mfma_scale_f32_16x16x128_f8f6f4(Bt[n], At[m], acc[ai][bj][m][n], 0, 0, 0, SCALE_W8, 0, SCALE_A8); \
        else { acc[ai][bj][m][n] = __builtin_amdgcn_mfma_f32_16x16x32_bf16(__builtin_bit_cast(bf16x8, (v4i)Bt[n].lo), __builtin_bit_cast(bf16x8, (v4i)At[m].lo), acc[ai][bj][m][n], 0, 0, 0); \
               acc[ai][bj][m][n] = __builtin_amdgcn_mfma_f32_16x16x32_bf16(__builtin_bit_cast(bf16x8, (v4i)Bt[n].hi), __builtin_bit_cast(bf16x8, (v4i)At[m].hi), acc[ai][bj][m][n], 0, 0, 0); } } \
        __builtin_amdgcn_s_setprio(0); } while (0)
#define PG8_WAIT_V(n) asm volatile("s_waitcnt vmcnt(" #n ")" ::: "memory")
#define PG8_WAIT_L(n) asm volatile("s_waitcnt lgkmcnt(" #n ")" ::: "memory")
#define PG8_BAR __builtin_amdgcn_s_barrier()
#define PG8_SCHED __builtin_amdgcn_sched_barrier(0)
    Unit cur, nxt; int ui = 0;
    if (!S.next(0, cur)) return;
    f32x4 acc[2][2][4][2];
#pragma unroll
    for (int a = 0; a < 2; ++a)
#pragma unroll
        for (int b = 0; b < 2; ++b)
#pragma unroll
            for (int m = 0; m < 4; ++m)
#pragma unroll
                for (int n = 0; n < 2; ++n) acc[a][b][m][n] = (f32x4){0.f, 0.f, 0.f, 0.f};
    v8i At[4], B0[2], B1[2];
    const char* cA = S.a_ptr(cur); const char* cB = S.b_ptr(cur);
    unsigned nvA[2][2];
    if constexpr (GATHER) S.a_off(cur, R0, C0, vA);
    PG8_STAGE(PG8_SB(0, 0), cB, voffB); PG8_STAGE(PG8_SB(0, 1), cB + hstep, voffB); PG8_STAGE(PG8_SA(0, 0), cA, vA[0]); PG8_STAGE(PG8_SA(0, 1), cA, vA[1]);
    if (wr == 1) PG8_BAR;
    PG8_WAIT_V(2); PG8_BAR;
    PG8_STAGE(PG8_SB(1, 0), cB + kstep, voffB); PG8_STAGE(PG8_SA(1, 0), cA + kstep, vA[0]); PG8_STAGE(PG8_SB(1, 1), cB + hstep + kstep, voffB);
    PG8_WAIT_V(6); PG8_BAR;
    for (;;) {
        const bool has_next = S.next(ui + 1, nxt);
        const char* nA = has_next ? S.a_ptr(nxt) : cA; const char* nB = has_next ? S.b_ptr(nxt) : cB;
        if constexpr (GATHER) { if (has_next) S.a_off(nxt, R0, C0, nvA); }
#pragma unroll 1
        for (int t = 0; t < NT; t += 2) {
            const bool last = (t == NT - 2);
            const char* a1 = cA + (size_t)(t + 1) * kstep;
            const char* a2 = last ? nA : cA + (size_t)(t + 2) * kstep; const char* b2 = last ? nB : cB + (size_t)(t + 2) * kstep;
            const char* a3 = a2 + kstep; const char* b3 = b2 + kstep;
            PG8_LDB(B0, 0, 0); PG8_LDB(B1, 0, 1); PG8_SCHED; PG8_LDA(At, 0, 0); PG8_STAGE(PG8_SA(1, 1), a1, vA[1]);
            if constexpr (GATHER) { if (last && has_next) {
#pragma unroll
                for (int h = 0; h < 2; ++h)
#pragma unroll
                    for (int i = 0; i < 2; ++i) vA[h][i] = nvA[h][i]; } }
            PG8_WAIT_V(8); PG8_WAIT_L(0); PG8_BAR; PG8_MMA(0, 0, At, B0); PG8_MMA(0, 1, At, B1); PG8_BAR; PG8_SCHED;
            PG8_LDA(At, 0, 1); PG8_STAGE(PG8_SB(0, 0), b2, voffB); PG8_STAGE(PG8_SB(0, 1), b2 + hstep, voffB); PG8_STAGE(PG8_SA(0, 0), a2, vA[0]);
            PG8_WAIT_V(8); PG8_WAIT_L(0); PG8_BAR; PG8_MMA(1, 0, At, B0); PG8_MMA(1, 1, At, B1); PG8_BAR; PG8_SCHED;
            PG8_LDB(B0, 1, 0); PG8_LDB(B1, 1, 1); PG8_SCHED; PG8_LDA(At, 1, 0); PG8_STAGE(PG8_SA(0, 1), a2, vA[1]);
            PG8_WAIT_V(8); PG8_WAIT_L(0); PG8_BAR; PG8_MMA(0, 0, At, B0); PG8_MMA(0, 1, At, B1); PG8_BAR; PG8_SCHED;
            PG8_LDA(At, 1, 1); PG8_STAGE(PG8_SB(1, 0), b3, voffB); PG8_STAGE(PG8_SB(1, 1), b3 + hstep, voffB); PG8_STAGE(PG8_SA(1, 0), a3, vA[0]);
            PG8_WAIT_V(8); PG8_WAIT_L(0); PG8_BAR; PG8_MMA(1, 0, At, B0); PG8_MMA(1, 1, At, B1); PG8_BAR; PG8_SCHED;
        }
        if (wr == 0) PG8_BAR;
        if constexpr (NOEPI) {
#pragma unroll
            for (int a = 0; a < 2; ++a)
#pragma unroll
                for (int b = 0; b < 2; ++b)
#pragma unroll
                    for (int m = 0; m < 4; ++m)
#pragma unroll
                        for (int n = 0; n < 2; ++n) asm volatile("" :: "v"(acc[a][b][m][n]));
        } else
        { int le; asm volatile("v_mbcnt_lo_u32_b32 %0, -1, 0\n\tv_mbcnt_hi_u32_b32 %0, -1, %0" : "=v"(le)); E(acc, cur, wr, wc, le & 15, le >> 4); }
        if (!has_next) break;
#pragma unroll
        for (int a = 0; a < 2; ++a)
#pragma unroll
            for (int b = 0; b < 2; ++b)
#pragma unroll
                for (int m = 0; m < 4; ++m)
#pragma unroll
                    for (int n = 0; n < 2; ++n) acc[a][b][m][n] = (f32x4){0.f, 0.f, 0.f, 0.f};
        cur = nxt; cA = nA; cB = nB; ++ui;
        if (wr == 1) PG8_BAR;
    }
    PG8_WAIT_V(0);
    PG8_BAR;
#undef PG8_SA
#undef PG8_SB
#undef PG8_STAGE
#undef PG8_LDA
#undef PG8_LDB
#undef PG8_MMA
#undef PG8_WAIT_V
#undef PG8_WAIT_L
#undef PG8_BAR
#undef PG8_SCHED
}

struct DenseSched {
    const char* A; const char* Bt; int nM, nN, nwg, G, c;
    __device__ __forceinline__ void init(const void* A_, const void* Bt_, int M, int N, int G_, int c_) { A = (const char*)A_; Bt = (const char*)Bt_; nM = M / BM; nN = N / BM; nwg = nM * nN; G = G_; c = c_; }
    __device__ __forceinline__ bool next(int i, Unit& u) const {
        const long L = (long)i * G + c; if (L >= nwg) return false;
        int wgid = (int)L; { const int q = nwg / NXCD, r = nwg % NXCD, xcd = wgid % NXCD, off = wgid / NXCD; wgid = (xcd < r ? xcd * (q + 1) : r * (q + 1) + (xcd - r) * q) + off; }
        const int nig = WGM * nN, gid = wgid / nig, fm = gid * WGM, gsz = (nM - fm) < WGM ? (nM - fm) : WGM;
        u.pm = fm + ((wgid % nig) % gsz); u.pn = (wgid % nig) / gsz; u.e = 0; u.nvalid = 256; u.sbase = 0; return true;
    }
    __device__ __forceinline__ const char* a_ptr(const Unit& u) const { return A + (size_t)u.pm * (BM * K * 2); }
    __device__ __forceinline__ const char* b_ptr(const Unit& u) const { return Bt + (size_t)u.pn * (BM * K * 2); }
    __device__ __forceinline__ void a_off(const Unit&, int, int, unsigned (&)[2][2]) const {}
};
template <int NPN, bool GATHER_A, int KB> struct MoeSched {
    const char* A; const char* Bt; const int* slot; const LAS int* tab; int G, c; size_t bstride;
    __device__ __forceinline__ bool next(int i, Unit& u) const {
        const int ntile = __builtin_amdgcn_readfirstlane(tab[32]);
        int mtg;
        if ((G & 7) == 0) { const int x = c & 7, j = (c >> 3) + (G >> 3) * i; u.pn = j % NPN; mtg = (j / NPN) * 8 + x; if (mtg >= ntile) return false; }
        else { const int lin = i * G + c; if (lin >= ntile * NPN) return false; u.pn = lin % NPN; mtg = lin / NPN; }
        int e = 0;
        while (e < 31 && __builtin_amdgcn_readfirstlane(tab[e + 1]) <= mtg) ++e;
        const int mtl = mtg - __builtin_amdgcn_readfirstlane(tab[e]); int nv = __builtin_amdgcn_readfirstlane(tab[33 + e]) - 256 * mtl; nv = nv > 256 ? 256 : nv;
        u.pm = mtg; u.e = e; u.nvalid = nv; u.sbase = e * CAP + 256 * mtl; return true;
    }
    __device__ __forceinline__ const char* a_ptr(const Unit& u) const { return GATHER_A ? A : A + (size_t)u.pm * (BM * KB); }
    __device__ __forceinline__ const char* b_ptr(const Unit& u) const { return Bt + (size_t)u.e * bstride + (size_t)u.pn * (BM * KB); }
    __device__ __forceinline__ void a_off(const Unit& u, int R0, int C0, unsigned (&v)[2][2]) const {
#pragma unroll
        for (int h = 0; h < 2; ++h)
#pragma unroll
            for (int i = 0; i < 2; ++i) { const int rl = h * 128 + R0 + 64 * i; const int id = (rl < u.nvalid) ? slot[u.sbase + rl] : 0; v[h][i] = (unsigned)(id >> 2) * (unsigned)KB + (unsigned)C0 * 2u; }
    }
};
}

struct EpiInProj {
    static constexpr bool PERM = true;
    unsigned char* ws; const float* tab; const float* rope; int layer;
    template <int TYPE> __device__ __forceinline__ void run(const f32x4 (&acc)[2][2][4][2], const pg8::Unit& u, int wr, int wc, int fr, int fq) const {
        asm volatile("" : "+v"(fr), "+v"(fq));
        const int pn = u.pn, pm = u.pm; const bool ctx = pm >= 128;
        const int bb = ctx ? (pm - 128) : (pm >> 6);
#pragma unroll
        for (int ai = 0; ai < 2; ++ai)
#pragma unroll
            for (int m = 0; m < 4; ++m) {
                const int rl = 128 * ai + 64 * wr + 16 * m + fr; const int row = pm * 256 + rl;
                const int tt = ctx ? rl : (row & (T - 1));
                const int Lk = ctx ? tt : 256 + tt; const int ktile = Lk >> 6, krr = Lk & 63;
#pragma unroll
                for (int bj = 0; bj < 2; ++bj) {
                    const int np = 256 * pn + 128 * bj + 32 * wc + 8 * fq;
                    f32x4 v0 = acc[ai][bj][m][0], v1 = acc[ai][bj][m][1];
                    bf16_t* dst;
                    if (TYPE == 0) {
                        const int dir = np >= 384, col = np - 384 * dir;
                        const f32x4 l0 = *(const f32x4*)(tab + TB_LBT + layer * 384 + col), l1 = *(const f32x4*)(tab + TB_LBT + layer * 384 + col + 4);
#pragma unroll
                        for (int q = 0; q < 4; ++q) { v0[q] = (1.f - l0[q]) * sigmoidf_(-v0[q]); v1[q] = (1.f - l1[q]) * sigmoidf_(-v1[q]); }
                        dst = (bf16_t*)(ws + WS_SCAN + (size_t)(dir ? SC_KB : SC_KF) * SCAN_PITCH) + (size_t)row * 384 + col;
                    } else if (TYPE == 1 || TYPE == 2) {
                        f32x4 cs = (f32x4){1.f, 1.f, 1.f, 1.f}, sn = (f32x4){0.f, 0.f, 0.f, 0.f}; float sc;
                        if (TYPE == 1) {
                            const int m2 = np - 768; const int isk = m2 >= 384, col = m2 - 384 * isk; const int w0 = col & 63;
                            if (!ctx) { cs = *(const f32x4*)(rope + (size_t)tt * 32 + (w0 >> 1)); sn = *(const f32x4*)(rope + (size_t)T * 32 + (size_t)tt * 32 + (w0 >> 1)); }
                            sc = isk ? 0.125f : 1.f;
                            dst = (bf16_t*)(ws + WS_SCAN + (size_t)(isk ? SC_RK : SC_RQ) * SCAN_PITCH) + (size_t)row * 384 + col;
                        } else {
                            const int m3 = np - 1536; const int isk = m3 >= 256, col = m3 - 256 * isk; const int map = col >> 5, w0 = col & 31;
                            if (!ctx) { const float* tb = (w0 < 16) ? (tab + TB_AXR + (tt >> 6) * 8 + (w0 >> 1)) : (tab + TB_AXC + (tt & 63) * 8 + ((w0 - 16) >> 1));
                                        const int so = (w0 < 16) ? 2048 : 512; cs = *(const f32x4*)tb; sn = *(const f32x4*)(tb + so); }
                            sc = isk ? 1.f : 0.17677669529663687f * LOG2E * 4.f;
                            if (isk) dst = (bf16_t*)(ws + WS_KA) + ((size_t)((bb * 8 + map) * KT_TILES + ktile) * 4 + (w0 >> 3)) * 512 + krr * 8;
                            else if (ctx) dst = (bf16_t*)(ws + WS_QC) + ((size_t)(bb * 8 + map) * CL + tt) * 32 + w0;
                            else dst = (bf16_t*)(ws + WS_QA) + ((size_t)(bb * 8 + map) * T + tt) * 32 + w0;
                        }
                        f32x4 o0, o1;
                        o0[0] = (v0[0] * cs[0] - v0[1] * sn[0]) * sc; o0[1] = (v0[1] * cs[0] + v0[0] * sn[0]) * sc;
                        o0[2] = (v0[2] * cs[1] - v0[3] * sn[1]) * sc; o0[3] = (v0[3] * cs[1] + v0[2] * sn[1]) * sc;
                        o1[0] = (v1[0] * cs[2] - v1[1] * sn[2]) * sc; o1[1] = (v1[1] * cs[2] + v1[0] * sn[2]) * sc;
                        o1[2] = (v1[2] * cs[3] - v1[3] * sn[3]) * sc; o1[3] = (v1[3] * cs[3] + v1[2] * sn[3]) * sc;
                        v0 = o0; v1 = o1;
                    } else {
                        const int m4 = np - 2048; const int seg = m4 / 384, col = m4 - 384 * seg;
                        if (m4 >= 2176) continue;
                        if (seg < 5) dst = (bf16_t*)(ws + WS_SCAN + (size_t)(SC_HQ + seg) * SCAN_PITCH) + (size_t)row * 384 + col;
                        else { const int h4 = col >> 6, w0 = col & 63;
                               const int k5 = krr & 31; unsigned char* vb = ws + WS_VA + (size_t)((bb * 4 + h4) * KT_TILES + ktile) * 4096 + (krr >> 5) * 2048 + (w0 >> 5) * 1024 + ((k5 >> 2) & 1) * 512 + (w0 & 31) * 16 + (k5 & 3) + 4 * (k5 >> 3);
                               const unsigned wa = pk4_fp8(v0[0] * 16.f, v0[1] * 16.f, v0[2] * 16.f, v0[3] * 16.f), wb = pk4_fp8(v1[0] * 16.f, v1[1] * 16.f, v1[2] * 16.f, v1[3] * 16.f);
#pragma unroll
                               for (int i = 0; i < 4; ++i) { vb[16 * i] = (unsigned char)(wa >> (8 * i)); vb[64 + 16 * i] = (unsigned char)(wb >> (8 * i)); }
                               continue; }
                    }
                    u32x4 w; w.x = cvt_pk_bf16(v0[0], v0[1]); w.y = cvt_pk_bf16(v0[2], v0[3]); w.z = cvt_pk_bf16(v1[0], v1[1]); w.w = cvt_pk_bf16(v1[2], v1[3]);
                    *(u32x4*)dst = w;
                }
                if (m == 3) asm volatile("" ::: "memory");
            }
    }
    __device__ __forceinline__ void operator()(const f32x4 (&acc)[2][2][4][2], const pg8::Unit& u, int wr, int wc, int fr, int fq) const {
        if (u.pn < 3) run<0>(acc, u, wr, wc, fr, fq); else if (u.pn < 6) run<1>(acc, u, wr, wc, fr, fq); else if (u.pn < 8) run<2>(acc, u, wr, wc, fr, fq); else run<3>(acc, u, wr, wc, fr, fq);
    }
};
template <bool NOST = false> struct EpiBf16OutT {
    static constexpr bool PERM = true;
    bf16_t* C;
    __device__ __forceinline__ void operator()(const f32x4 (&acc)[2][2][4][2], const pg8::Unit& u, int wr, int wc, int fr, int fq) const {
        asm volatile("" : "+v"(fr), "+v"(fq));
        const int row0 = u.pm * 256 + wr * 64 + fr, col0 = u.pn * 256 + wc * 32 + 8 * fq;
#pragma unroll
        for (int ai = 0; ai < 2; ++ai)
#pragma unroll
            for (int m = 0; m < 4; ++m) { bf16_t* rowp = C + (size_t)(row0 + ai * 128 + m * 16) * D + col0;
#pragma unroll
                for (int bj = 0; bj < 2; ++bj) { const f32x4 v0 = acc[ai][bj][m][0], v1 = acc[ai][bj][m][1];
                    u32x4 w; w.x = cvt_pk_bf16(v0[0], v0[1]); w.y = cvt_pk_bf16(v0[2], v0[3]); w.z = cvt_pk_bf16(v1[0], v1[1]); w.w = cvt_pk_bf16(v1[2], v1[3]);
                    if (NOST) asm volatile("" :: "v"(w)); else *(u32x4*)(rowp + bj * 128) = w; } }
    }
};
typedef EpiBf16OutT<false> EpiBf16Out;
struct EpiSwiglu {
    static constexpr bool PERM = true;
    unsigned char* act; const float* b1;
    __device__ __forceinline__ void operator()(const f32x4 (&acc)[2][2][4][2], const pg8::Unit& u, int wr, int wc, int fr, int fq) const {
        asm volatile("" : "+v"(fr), "+v"(fq));
        const int j0 = 128 * u.pn + 32 * wc + 8 * fq;
        const float* bp = b1 + (size_t)u.e * 2048 + 2 * j0;
        f32x4 bq[4];
#pragma unroll
        for (int q = 0; q < 4; ++q) bq[q] = *(const f32x4*)(bp + 4 * q);
#pragma unroll
        for (int ai = 0; ai < 2; ++ai)
#pragma unroll
            for (int m = 0; m < 4; ++m) {
                const int rl = 128 * ai + 64 * wr + 16 * m + fr;
                float o[8];
#pragma unroll
                for (int n = 0; n < 2; ++n)
#pragma unroll
                    for (int q = 0; q < 4; ++q) { const int j = 4 * n + q;
                        float g = acc[ai][0][m][n][q] + bq[j >> 1][(j & 1) * 2], l = acc[ai][1][m][n][q] + bq[j >> 1][(j & 1) * 2 + 1];
                        g = fminf(g, 7.f); l = fminf(fmaxf(l, -7.f), 7.f);
                        o[j] = g * sigmoidf_(1.702f * g) * (l + 1.f); }
                u32x2 w; w.x = pk4_fp8(o[0], o[1], o[2], o[3]); w.y = pk4_fp8(o[4], o[5], o[6], o[7]);
                *(u32x2*)(act + (size_t)(u.pm * 256 + rl) * 1024 + j0) = w;
            }
    }
};
template <int NOST = 0> struct EpiMoeOutT {
    static constexpr bool PERM = true;
    unsigned char* ys; const float* b2; const float* sgate;
    __device__ __forceinline__ void operator()(const f32x4 (&acc)[2][2][4][2], const pg8::Unit& u, int wr, int wc, int fr, int fq) const {
        asm volatile("" : "+v"(fr), "+v"(fq));
        const int c0 = 256 * u.pn + 32 * wc + 8 * fq;
        const float* bp = b2 + (size_t)u.e * 1024 + c0;
        f32x4 bv[2][2];
#pragma unroll
        for (int bj = 0; bj < 2; ++bj)
#pragma unroll
            for (int n = 0; n < 2; ++n) bv[bj][n] = *(const f32x4*)(bp + 128 * bj + 4 * n);
#pragma unroll
        for (int ai = 0; ai < 2; ++ai)
#pragma unroll
            for (int m = 0; m < 4; ++m) {
                const int rl = 128 * ai + 64 * wr + 16 * m + fr;
                const float g = (rl < u.nvalid) ? sgate[u.sbase + rl] * 16.f : 0.f;
                unsigned char* rowp = ys + (size_t)(u.pm * 256 + rl) * 1024 + c0;
                if (NOST == 2) rowp = ys - (WS_YK - WS_OSCR) + (size_t)(blockIdx.x * 64 + (rl & 63)) * 1024 + c0;
#pragma unroll
                for (int bj = 0; bj < 2; ++bj) { const f32x4 v0 = (acc[ai][bj][m][0] + bv[bj][0]) * g, v1 = (acc[ai][bj][m][1] + bv[bj][1]) * g;
                    u32x2 w; w.x = pk4_fp8(v0[0], v0[1], v0[2], v0[3]); w.y = pk4_fp8(v1[0], v1[1], v1[2], v1[3]);
                    if (NOST == 1) asm volatile("" :: "v"(w)); else *(u32x2*)(rowp + 128 * bj) = w; }
            }
    }
};
typedef EpiMoeOutT<0> EpiMoeOut;

__device__ __forceinline__ int map_in(int n) {
    if (n < 384) return 2048 + n;
    if (n < 768) return n - 384;
    if (n < 1152) return 384 + (n - 768);
    if (n < 1536) return 2048 + 384 + (n - 1152);
    if (n < 1920) return 2048 + 768 + (n - 1536);
    if (n < 2688) { const int isk = n >= 2304; const int c = n - 1920 - 384 * isk; const int h = c >> 6, w = c & 63; const int wp = (w < 32) ? 2 * w : 2 * (w - 32) + 1; return 768 + 384 * isk + h * 64 + wp; }
    if (n < 3072) return 2048 + 1152 + (n - 2688);
    if (n < 3456) return 2048 + 1536 + (n - 3072);
    if (n < 3968) { const int isk = n >= 3712; const int c = n - 3456 - 256 * isk; const int h = c >> 5, w = c & 31; const int half = w >> 4, uu = w & 15; const int up = (uu < 8) ? 2 * uu : 2 * (uu - 8) + 1; return 1536 + 256 * isk + h * 32 + half * 16 + up; }
    return 2048 + 1920 + (n - 3968);
}
__device__ __forceinline__ int map_w1(int n) { const int j = n >> 1, lin = n & 1; return (j >> 7) * 256 + lin * 128 + (j & 127); }
template <int MAP> __device__ __forceinline__ void p0_transpose_item(const float* W, int Kd, int N, bf16_t* WT, LAS float* scr, int item, int lane) {
    const int nblk = N / 32, kb = item / nblk, nb = item % nblk, k0 = 64 * kb, n0 = 32 * nb;
    { f32x4 rv[8];
#pragma unroll
      for (int i = 0; i < 8; ++i) rv[i] = *(const f32x4*)(W + (size_t)(k0 + (lane >> 3) + 8 * i) * N + n0 + 4 * (lane & 7));
#pragma unroll
      for (int i = 0; i < 8; ++i) { LAS float* sp_ = scr + ((lane >> 3) + 8 * i) * 33 + 4 * (lane & 7); sp_[0] = rv[i][0]; sp_[1] = rv[i][1]; sp_[2] = rv[i][2]; sp_[3] = rv[i][3]; } }
    LDS_WAIT(); asm volatile("" ::: "memory");
    const int c = lane & 7;
#pragma unroll
    for (int j = 0; j < 4; ++j) { const int n = (lane >> 3) + 8 * j; const LAS float* s = scr + (8 * c) * 33 + n;
        u32x4 o; o.x = pk2(s[0 * 33], s[1 * 33]); o.y = pk2(s[2 * 33], s[3 * 33]); o.z = pk2(s[4 * 33], s[5 * 33]); o.w = pk2(s[6 * 33], s[7 * 33]);
        const int nn = n0 + n; const int dr = MAP == 1 ? map_in(nn) : (MAP == 2 ? map_w1(nn) : nn);
        *(u32x4*)(WT + (size_t)dr * Kd + k0 + 8 * c) = o; }
    LDS_WAIT(); asm volatile("" ::: "memory");
}
template <int MAP> __device__ __forceinline__ void p0_transpose_item_fp8(const float* W, int Kd, int N, unsigned char* WT, LAS float* scr, int item, int lane) {
    const int nblk = N / 32, kb = item / nblk, nb = item % nblk, k0 = 64 * kb, n0 = 32 * nb;
    { f32x4 rv[8];
#pragma unroll
      for (int i = 0; i < 8; ++i) rv[i] = *(const f32x4*)(W + (size_t)(k0 + (lane >> 3) + 8 * i) * N + n0 + 4 * (lane & 7));
#pragma unroll
      for (int i = 0; i < 8; ++i) { LAS float* sp_ = scr + ((lane >> 3) + 8 * i) * 33 + 4 * (lane & 7); sp_[0] = rv[i][0]; sp_[1] = rv[i][1]; sp_[2] = rv[i][2]; sp_[3] = rv[i][3]; } }
    LDS_WAIT(); asm volatile("" ::: "memory");
    const int n = lane >> 1, hf = lane & 1; const LAS float* sp = scr + (32 * hf) * 33 + n;
    u32x4 o0, o1;
#pragma unroll
    for (int q = 0; q < 4; ++q) { o0[q] = pk4_fp8(sp[(4 * q) * 33] * W8_MUL, sp[(4 * q + 1) * 33] * W8_MUL, sp[(4 * q + 2) * 33] * W8_MUL, sp[(4 * q + 3) * 33] * W8_MUL);
                                  o1[q] = pk4_fp8(sp[(16 + 4 * q) * 33] * W8_MUL, sp[(16 + 4 * q + 1) * 33] * W8_MUL, sp[(16 + 4 * q + 2) * 33] * W8_MUL, sp[(16 + 4 * q + 3) * 33] * W8_MUL); }
    const int nn = n0 + n; const int dr = MAP == 2 ? map_w1(nn) : nn;
    unsigned char* dp = WT + (size_t)dr * Kd + k0 + 32 * hf;
    *(u32x4*)dp = o0; *(u32x4*)(dp + 16) = o1;
    LDS_WAIT(); asm volatile("" ::: "memory");
}
struct P0Item { const float* W; int N, kind, l, e, k0, n0; };
__device__ __forceinline__ P0Item p0_decode(const Frame& F, int it) {
    constexpr int I_IN = 16 * 132, I_OUT = 16 * 32, I_W1 = 16 * 64, I_W2 = 16 * 32, PER_L = I_IN + I_OUT + NE * (I_W1 + I_W2);
    P0Item d; d.l = it / PER_L; int r = it % PER_L; d.e = 0; int item;
    if (r < I_IN) { d.kind = 0; d.N = 4224; d.W = F.in[7] + (size_t)d.l * 1024 * 4224; item = r; }
    else if (r < I_IN + I_OUT) { d.kind = 1; d.N = 1024; d.W = F.in[14] + (size_t)d.l * 1024 * 1024; item = r - I_IN; }
    else { r -= I_IN + I_OUT; d.e = r / (I_W1 + I_W2); r -= d.e * (I_W1 + I_W2);
        if (r < I_W1) { d.kind = 2; d.N = 2048; d.W = F.in[17] + ((size_t)d.l * NE + d.e) * 1024 * 2048; item = r; }
        else { d.kind = 3; d.N = 1024; d.W = F.in[19] + ((size_t)d.l * NE + d.e) * 1024 * 1024; item = r - I_W1; } }
    const int nblk = d.N / 32; d.k0 = 64 * (item / nblk); d.n0 = 32 * (item % nblk); return d;
}
__device__ __forceinline__ void p0_issue(const P0Item& d, int lane, f32x4 (&rv)[8]) {
#pragma unroll
    for (int i = 0; i < 8; ++i) rv[i] = *(const f32x4*)(d.W + (size_t)(d.k0 + (lane >> 3) + 8 * i) * d.N + d.n0 + 4 * (lane & 7));
}
__device__ __forceinline__ void p0_finish(const Frame& F, const P0Item& d, LAS float* scr, int lane, const f32x4 (&rv)[8]) {
#pragma unroll
    for (int i = 0; i < 8; ++i) { LAS float* sp_ = scr + ((lane >> 3) + 8 * i) * 33 + 4 * (lane & 7); sp_[0] = rv[i][0]; sp_[1] = rv[i][1]; sp_[2] = rv[i][2]; sp_[3] = rv[i][3]; }
    LDS_WAIT(); asm volatile("" ::: "memory");
    if (d.kind < 2) {
        bf16_t* WT = d.kind == 0 ? (bf16_t*)(F.ws + WS_WIN) + (size_t)d.l * NIN * 1024 : (bf16_t*)(F.ws + WS_WOUT) + (size_t)d.l * 1024 * 1024;
        const int c = lane & 7;
#pragma unroll
        for (int j = 0; j < 4; ++j) { const int n = (lane >> 3) + 8 * j; const LAS float* s_ = scr + (8 * c) * 33 + n;
            u32x4 o; o.x = pk2(s_[0 * 33], s_[1 * 33]); o.y = pk2(s_[2 * 33], s_[3 * 33]); o.z = pk2(s_[4 * 33], s_[5 * 33]); o.w = pk2(s_[6 * 33], s_[7 * 33]);
            const int nn = d.n0 + n; const int dr = d.kind == 0 ? map_in(nn) : nn;
            *(u32x4*)(WT + (size_t)dr * 1024 + d.k0 + 8 * c) = o; }
    } else {
        unsigned char* WT = d.kind == 2 ? F.ws + WS_W1 + ((size_t)d.l * NE + d.e) * 2048 * 1024 : F.ws + WS_W2 + ((size_t)d.l * NE + d.e) * 1024 * 1024;
        const int n = lane >> 1, hf = lane & 1; const LAS float* sp = scr + (32 * hf) * 33 + n;
        u32x4 o0, o1;
#pragma unroll
        for (int q = 0; q < 4; ++q) { o0[q] = pk4_fp8(sp[(4 * q) * 33] * W8_MUL, sp[(4 * q + 1) * 33] * W8_MUL, sp[(4 * q + 2) * 33] * W8_MUL, sp[(4 * q + 3) * 33] * W8_MUL);
                                      o1[q] = pk4_fp8(sp[(16 + 4 * q) * 33] * W8_MUL, sp[(16 + 4 * q + 1) * 33] * W8_MUL, sp[(16 + 4 * q + 2) * 33] * W8_MUL, sp[(16 + 4 * q + 3) * 33] * W8_MUL); }
        const int nn = d.n0 + n; const int dr = d.kind == 2 ? map_w1(nn) : nn;
        unsigned char* dp = WT + (size_t)dr * 1024 + d.k0 + 32 * hf;
        *(u32x4*)dp = o0; *(u32x4*)(dp + 16) = o1;
    }
    LDS_WAIT(); asm volatile("" ::: "memory");
}
#ifndef P0_QA
#define P0_QA 8
#endif
#ifndef P0_QC
#define P0_QC 56
#endif
#ifndef P0_QI
#define P0_QI 6
#endif
#ifndef P0_QO
#define P0_QO 6
#endif
constexpr int P0_NFIX = 16 * 132 + 16 * 32, P0_NMOE = NE * (16 * 64 + 16 * 32), P0_PER_L = P0_NFIX + P0_NMOE;
struct P0Split { int thrA, idleA, NA, thrC, idleC, NC, thrI, shortI, NI, thrO, shortO, NO; };
__device__ __forceinline__ int p0_min(int a, int b) { return a < b ? a : b; }
__device__ __forceinline__ P0Split p0_split(int G, int layer) {
    P0Split p; const int NGW = G * NWAVES, UA = NSEQ * NSC, RA = (UA + NGW - 1) / NGW, UC = 24 * NSC, RC = (UC + NGW - 1) / NGW;
    p.thrA = UA - (RA - 1) * NGW; p.idleA = NGW - p.thrA; p.thrC = UC - (RC - 1) * NGW; p.idleC = NGW - p.thrC;
    const int nI = (NROW / 256) * (NIN / 256), rI = (nI + G - 1) / G, nO = ((layer == 0 ? NROW : NLAT) / 256) * 4, rO = (nO + G - 1) / G;
    p.thrI = nI - (rI - 1) * G; p.shortI = G - p.thrI; p.thrO = nO - (rO - 1) * G; p.shortO = G - p.thrO;
    int left = P0_NMOE;
    p.NA = p0_min(p.idleA * P0_QA, left); left -= p.NA; p.NC = p0_min(p.idleC * P0_QC, left); left -= p.NC;
    p.NI = p0_min(p.shortI * NWAVES * P0_QI, left); left -= p.NI; p.NO = p0_min(p.shortO * NWAVES * P0_QO, left); return p;
}
__device__ __forceinline__ void p0_run(const Frame& F, LAS float* scr, int lane, int base, int first, int step, int limit) {
    if (step <= 0) return;
    int v = first; if (v >= limit) return;
    P0Item cur = p0_decode(F, base + v), nxt = cur; f32x4 ra[8], rb[8];
    p0_issue(cur, lane, ra);
    for (; v < limit; v += step) {
        const bool hn = v + step < limit;
        if (hn) { nxt = p0_decode(F, base + v + step); p0_issue(nxt, lane, rb); }
        p0_finish(F, cur, scr, lane, ra);
        if (hn) { cur = nxt;
#pragma unroll
            for (int i = 0; i < 8; ++i) ra[i] = rb[i]; }
    }
}
__device__ __forceinline__ void phase_prologue_a(Frame& F) {
    PHASE_IDS();
    LAS float* scr = (LAS float*)(F.lds + wave * 16384);
    const int gw = blk_ * NWAVES + wave, NGW = F.G * NWAVES;
    unsigned char* ws = F.ws;
    for (int l = 0; l < 2; ++l) { const P0Split sp = p0_split(F.G, l); const int done = sp.NA + sp.NC + sp.NI + sp.NO, rem = P0_NMOE - done;
        p0_run(F, scr, lane, l * P0_PER_L, gw, NGW, P0_NFIX);
        p0_run(F, scr, lane, l * P0_PER_L + P0_NFIX + done, gw, NGW, rem); }
    for (int i = gw * 64 + lane; i < 2 * 128 * 1024 / 8; i += NGW * 64) { const int l = i / (128 * 128), rr = i % (128 * 128);
        *(u32x4*)((bf16_t*)(ws + WS_WIN) + ((size_t)l * NIN + 4224) * 1024 + (size_t)rr * 8) = (u32x4){0u, 0u, 0u, 0u}; }
    { LAS float* part = (LAS float*)(F.lds + 131072);
      for (int it = blk_; it < 2 * 96; it += F.G) {
        const int l = it / 96, n0 = (it % 96) * 64, n = n0 + lane;
        const float* mw = F.in[4] + (size_t)l * 1024 * 6144 + (size_t)(128 * wave) * 6144 + n;
        float a0 = 0.f, a1 = 0.f, a2 = 0.f;
#pragma unroll 1
        for (int kb = 0; kb < 2; ++kb) {
            const int kk = 128 * wave + 64 * kb + lane;
            float c0 = F.in[1][kk], c1 = F.in[1][1024 + kk], c2 = F.in[3][kk];
            c0 = c0 * sigmoidf_(c0); c1 = c1 * sigmoidf_(c1); c2 = c2 * sigmoidf_(c2);
#pragma unroll 1
            for (int j0 = 0; j0 < 64; j0 += 16) { float wv[16];
#pragma unroll
                for (int j = 0; j < 16; ++j) wv[j] = mw[(size_t)(64 * kb + j0 + j) * 6144];
#pragma unroll
                for (int j = 0; j < 16; ++j) { a0 += rdlane(c0, j0 + j) * wv[j]; a1 += rdlane(c1, j0 + j) * wv[j]; a2 += rdlane(c2, j0 + j) * wv[j]; } }
        }
        part[(wave * 3 + 0) * 64 + lane] = a0; part[(wave * 3 + 1) * 64 + lane] = a1; part[(wave * 3 + 2) * 64 + lane] = a2;
        __syncthreads();
        if (wave == 0) {
            float vals[3];
#pragma unroll
            for (int w = 0; w < 3; ++w) { float sacc = 0.f;
#pragma unroll
                for (int q = 0; q < 8; ++q) sacc += part[(q * 3 + w) * 64 + lane]; vals[w] = sacc + F.in[5][l * 6144 + n]; }
            const int ch = n >> 10, col = n & 1023;
            const float* ng = F.in[6] + (size_t)l * 4096;
#pragma unroll
            for (int w = 0; w < 3; ++w) { float v = vals[w];
                if (ch == 1) v = (1.f + v) * ng[col]; else if (ch == 2) v = v * ng[1024 + col]; else if (ch == 4) v = (1.f + v) * ng[2048 + col]; else if (ch == 5) v = v * ng[3072 + col];
                const int slot = (ch == 0) ? 1 : (ch == 1) ? 0 : (ch == 2) ? 2 : (ch == 3) ? 4 : (ch == 4) ? 3 : 5;
                ((float*)(ws + WS_MODV))[((size_t)(l * 3 + w) * 6 + slot) * 1024 + col] = v; }
        }
        __syncthreads();
      } }
    float* tab = (float*)(ws + WS_TAB);
    const int gt = blk_ * NTHR + tid, NGT = F.G * NTHR;
    for (int i = gt; i < 2 * 384; i += NGT) { const int l = i / 384, c = i % 384; const float a = F.in[8][c], b = F.in[8][384 + c];
        tab[TB_LBT + i] = (l == 0) ? 0.f : 1.f / (1.f + expf(a - b)); }
    if (gt < 2) { const int l = gt; const float* lm = F.in[12] + l * 128; float s0 = 0.f, s1 = 0.f;
        for (int i = 0; i < 32; ++i) { s0 += lm[i] * lm[32 + i]; s1 += lm[64 + i] * lm[96 + i]; }
        const float li = 0.8f - 0.6f * expf(-0.3f * (float)l);
        tab[TB_LAM + l] = expf(s0) - expf(s1) + li; tab[TB_LAM + 2 + l] = 1.f - li; }
    if (gt < 24) tab[TB_GAM + gt] = 1.f - exp2f(-F.in[10][gt]);
    for (int i = gt; i < 256 * 8 + 64 * 8; i += NGT) {
        const bool isr = i < 2048; const int ii = isr ? i : i - 2048; const int pos = ii >> 3, j = ii & 7;
        const float inv = exp2f(-(float)j * (13.287712379549449f / 8.f));
        const double rev = (double)pos * (double)inv * 0.15915494309189535; const float fr = (float)(rev - floor(rev));
        const float cs = __builtin_amdgcn_cosf(fr), sn = __builtin_amdgcn_sinf(fr);
        if (isr) { tab[TB_AXR + ii] = cs; tab[TB_AXR + 2048 + ii] = sn; } else { tab[TB_AXC + ii] = cs; tab[TB_AXC + 512 + ii] = sn; }
    }
    float* rope = (float*)(ws + WS_ROPE);
    for (int i = gt; i < T * 32; i += NGT) { const int pos = i >> 5, j = i & 31;
        const float inv = exp2f(-(float)j * (13.287712379549449f / 32.f));
        const double rev = (double)pos * (double)inv * 0.15915494309189535; const float fr = (float)(rev - floor(rev));
        rope[i] = __builtin_amdgcn_cosf(fr); rope[(size_t)T * 32 + i] = __builtin_amdgcn_sinf(fr); }
    bf16_t* rwh = (bf16_t*)(ws + WS_RWT); bf16_t* rwl = rwh + 2 * 32 * 1024;
    for (int i = gt; i < 2 * 32 * 1024; i += NGT) { const int l = i >> 15, e = (i >> 10) & 31, c = i & 1023; const float wv = F.in[15][((size_t)l * 1024 + c) * 32 + e];
        const unsigned hb = f2bf(wv); rwh[i] = (bf16_t)hb; rwl[i] = (bf16_t)f2bf(wv - __builtin_bit_cast(float, hb << 16)); }
}

__device__ __forceinline__ float row_sumsq(const f32x4 (&v)[4]) {
    float s = 0.f;
#pragma unroll
    for (int j = 0; j < 4; ++j) s += (v[j][0] * v[j][0] + v[j][1] * v[j][1]) + (v[j][2] * v[j][2] + v[j][3] * v[j][3]);
    return wave_sum(s);
}
__device__ __forceinline__ void row_load(const float* p, int lane, f32x4 (&v)[4]) {
#pragma unroll
    for (int j = 0; j < 4; ++j) v[j] = *(const f32x4*)(p + 4 * lane + 256 * j);
}
__device__ __forceinline__ void row_store(float* p, int lane, const f32x4 (&v)[4]) {
#pragma unroll
    for (int j = 0; j < 4; ++j) *(f32x4*)(p + 4 * lane + 256 * j) = v[j];
}
__device__ __forceinline__ void row_store_bf16(bf16_t* p, int lane, const f32x4 (&v)[4]) {
#pragma unroll
    for (int j = 0; j < 4; ++j) { u32x2 w; w.x = pk2(v[j][0], v[j][1]); w.y = pk2(v[j][2], v[j][3]); *(u32x2*)(p + 4 * lane + 256 * j) = w; }
}
__device__ __forceinline__ void row_load_bf16(const bf16_t* p, int lane, f32x4 (&v)[4]) {
#pragma unroll
    for (int j = 0; j < 4; ++j) { const u32x2 w = *(const u32x2*)(p + 4 * lane + 256 * j); v[j] = (f32x4){bflo(w.x), bfhi(w.x), bflo(w.y), bfhi(w.y)}; }
}
__device__ __forceinline__ int row_which(int r) { return r < NLAT ? (r >> 14) : 2; }
__device__ __forceinline__ void row_norm_mod(const f32x4 (&x)[4], const float* a, const float* b, int lane, f32x4 (&o)[4]) {
    const float r = __builtin_amdgcn_rsqf(row_sumsq(x) * (1.f / 1024.f) + EPS);
#pragma unroll
    for (int j = 0; j < 4; ++j) { const f32x4 av = *(const f32x4*)(a + 4 * lane + 256 * j), bv = *(const f32x4*)(b + 4 * lane + 256 * j); o[j] = x[j] * r * av + bv; }
}
__device__ __forceinline__ void phase_prologue_b(Frame& F) {
    PHASE_IDS();
    const int gw = blk_ * NWAVES + wave, NGW = F.G * NWAVES;
    const float* modv = (const float*)(F.ws + WS_MODV);
    f32x4 xc[4], xn[4];
    if (gw < NROW) row_load(gw < NLAT ? F.in[0] + (size_t)gw * D : F.in[2] + (size_t)(gw - NLAT) * D, lane, xc);
    for (int r = gw; r < NROW; r += NGW) {
        const int rn = r + NGW;
        if (rn < NROW) row_load(rn < NLAT ? F.in[0] + (size_t)rn * D : F.in[2] + (size_t)(rn - NLAT) * D, lane, xn);
        const int w = row_which(r);
        f32x4 o[4];
        row_norm_mod(xc, modv + (size_t)(0 * 3 + w) * 6 * 1024, modv + ((size_t)(0 * 3 + w) * 6 + 1) * 1024, lane, o);
        row_store_bf16((bf16_t*)(F.ws + WS_H) + (size_t)r * D, lane, o);
#pragma unroll
        for (int j = 0; j < 4; ++j) xc[j] = xn[j];
    }
}

__device__ __forceinline__ int scan_row(int sc, int p, int dir, int b) {
    if (sc == 0) return NLAT + b * CL + (dir ? (CL - 1 - p) : p);
    const int tt = (sc - 1) * 256 + p; return b * T + (dir ? (T - 1 - tt) : tt);
}
template <int TYPE, bool WITHQ>
__device__ __forceinline__ float scan_step(float (&S)[64], const LAS float* kq, float vv, float gam) {
    float o = 0.f;
#pragma unroll
    for (int kg = 0; kg < 8; ++kg) {
        f32x4 kv[2], qv[2];
#pragma unroll
        for (int j = 0; j < 2; ++j) { kv[j] = *(const LAS f32x4*)(kq + kg * 8 + 4 * j); if (WITHQ) qv[j] = *(const LAS f32x4*)(kq + 64 + kg * 8 + 4 * j); }
#pragma unroll
        for (int j = 0; j < 8; ++j) { const int k = kg * 8 + j; const float kk = kv[j >> 2][j & 3];
            if (TYPE == 0) S[k] = __builtin_fmaf(kk, vv - S[k], S[k]); else S[k] = __builtin_fmaf(kk, vv, gam * S[k]);
            if (WITHQ) o = __builtin_fmaf(qv[j >> 2][j & 3], S[k], o); }
        asm volatile("" ::: "memory"); __builtin_amdgcn_sched_barrier(0);
    }
    return o;
}
__device__ __forceinline__ void phase_scan_a(Frame& F, int layer) {
    PHASE_IDS();
    const int gw = blk_ * NWAVES + wave, NGW = F.G * NWAVES;
    const float* tab = (const float*)(F.ws + WS_TAB);
    LAS float* scr = (LAS float*)(F.lds + wave * 2048);
    for (int wu = gw; wu < NSEQ * NSC; wu += NGW) {
        const int s = wu / NSC, sc = wu % NSC; const int type = s / 24, rem = s % 24, b = rem / 12, h = (rem % 12) >> 1, dir = rem & 1;
        const bf16_t* Kb = (const bf16_t*)(F.ws + WS_SCAN + (size_t)(type ? SC_RK : (dir ? SC_KB : SC_KF)) * SCAN_PITCH);
        const bf16_t* Vb = (const bf16_t*)(F.ws + WS_SCAN + (size_t)(type ? SC_RV : SC_HV) * SCAN_PITCH);
        unsigned co = (unsigned)(h * 64 + lane); asm volatile("" : "+v"(co));
        const float gam = tab[TB_GAM + layer * 12 + dir * 6 + h];
        float S[64];
#pragma unroll
        for (int k = 0; k < 64; ++k) S[k] = 0.f;
        float dprod = 1.f;
        float kc[4], vc[4], kn[4], vn[4];
#pragma unroll
        for (int i = 0; i < 4; ++i) { const unsigned ro = (unsigned)scan_row(sc, i, dir, b) * 384u + co; kc[i] = bf2f(Kb[ro]); vc[i] = bf2f(Vb[ro]); kn[i] = 0.f; vn[i] = 0.f; }
        for (int p0 = 0; p0 < 256; p0 += 4) {
            if (p0 + 4 < 256) {
#pragma unroll
                for (int i = 0; i < 4; ++i) { const unsigned ro = (unsigned)scan_row(sc, p0 + 4 + i, dir, b) * 384u + co; kn[i] = bf2f(Kb[ro]); vn[i] = bf2f(Vb[ro]); }
            }
#pragma unroll
            for (int i = 0; i < 4; ++i) scr[i * 128 + lane] = kc[i];
#pragma unroll
            for (int i = 0; i < 4; ++i) {
                if (type == 0) { dprod *= (1.f - kc[i]); (void)scan_step<0, false>(S, scr + i * 128, vc[i], gam); }
                else { dprod *= gam; (void)scan_step<1, false>(S, scr + i * 128, vc[i], gam); }
            }
#pragma unroll
            for (int i = 0; i < 4; ++i) { kc[i] = kn[i]; vc[i] = vn[i]; }
        }
        float* sl = (float*)(F.ws + WS_SLOC) + (size_t)wu * 4096 + lane;
#pragma unroll
        for (int k = 0; k < 64; ++k) { *sl = S[k]; sl += 64; asm volatile("" : "+v"(sl)); }
        ((float*)(F.ws + WS_DEC))[(size_t)wu * 64 + lane] = dprod;
    }
}
__device__ __forceinline__ void phase_scan_b(Frame& F) {
    const float* sloc = (const float*)(F.ws + WS_SLOC); const float* dec = (const float*)(F.ws + WS_DEC); float* sin_ = (float*)(F.ws + WS_SIN);
    PHASE_IDS();
    if (tid < 384) for (int idx = blk_ * 384 + tid; idx < NSEQ * 2048; idx += F.G * 384) {
        const int s = idx >> 11, kv = (idx & 2047) * 2, k = kv >> 6; f32x2 st = {0.f, 0.f};
        const float* dp = dec + (size_t)s * NSC * 64 + k; const float* sp = sloc + (size_t)s * NSC * 4096 + kv; float* op = sin_ + ((size_t)s * NSC + 1) * 4096 + kv;
#pragma unroll 1
        for (int c0 = 0; c0 < NSC - 1; c0 += 16) {
            float d[16]; f32x2 v[16];
#pragma unroll
            for (int i = 0; i < 16; ++i) { d[i] = dp[(c0 + i) * 64]; v[i] = *(const f32x2*)(sp + (size_t)(c0 + i) * 4096); }
#pragma unroll
            for (int i = 0; i < 16; ++i) { st = st * d[i] + v[i]; *(f32x2*)(op + (size_t)(c0 + i) * 4096) = st; }
        }
    }
}
template <int TYPE, bool SECOND>
__device__ __forceinline__ void scan_dir(Frame& F, int lane_in, int wave, int layer, int b, int h, int dir, int sc, bool zero_state) {
    int lane = lane_in; asm volatile("" : "+v"(lane));
    const float* tab = (const float*)(F.ws + WS_TAB);
    const int s = TYPE * 24 + b * 12 + h * 2 + dir;
    const bf16_t* Kb = (const bf16_t*)(F.ws + WS_SCAN + (size_t)(TYPE ? SC_RK : (dir ? SC_KB : SC_KF)) * SCAN_PITCH);
    const bf16_t* Vb = (const bf16_t*)(F.ws + WS_SCAN + (size_t)(TYPE ? SC_RV : SC_HV) * SCAN_PITCH);
    const bf16_t* Qb = (const bf16_t*)(F.ws + WS_SCAN + (size_t)(TYPE ? SC_RQ : SC_HQ) * SCAN_PITCH);
    const bf16_t* Gb = (const bf16_t*)(F.ws + WS_SCAN + (size_t)(TYPE ? SC_RG : SC_HG) * SCAN_PITCH);
    float* oscr = (float*)(F.ws + WS_OSCR);
    bf16_t* mix = (bf16_t*)(F.ws + WS_MIX);
    unsigned co = (unsigned)(h * 64 + lane); asm volatile("" : "+v"(co));
    const unsigned co2 = co + TYPE * 384;
    const float gam = tab[TB_GAM + layer * 12 + dir * 6 + h];
    const float nw = F.in[TYPE ? 11 : 9][layer * 64 + lane];
    LAS float* scr = (LAS float*)(F.lds + wave * 2048);
    float S[64];
    if (zero_state) {
#pragma unroll
        for (int k = 0; k < 64; ++k) S[k] = 0.f;
    } else { const float* si = (const float*)(F.ws + WS_SIN) + ((size_t)s * NSC + sc) * 4096 + lane;
#pragma unroll
        for (int k = 0; k < 64; ++k) { S[k] = *si; si += 64; asm volatile("" : "+v"(si)); } }
    float kc[2], vc[2], qc[2], kn[2], vn[2], qn[2];
#pragma unroll
    for (int i = 0; i < 2; ++i) { const unsigned ro = (unsigned)scan_row(sc, i, dir, b) * 384u + co; kc[i] = bf2f(Kb[ro]); vc[i] = bf2f(Vb[ro]); qc[i] = bf2f(Qb[ro]); kn[i] = 0.f; vn[i] = 0.f; qn[i] = 0.f; }
    for (int p0 = 0; p0 < 256; p0 += 2) {
        if (p0 + 2 < 256) {
#pragma unroll
            for (int i = 0; i < 2; ++i) { const unsigned ro = (unsigned)scan_row(sc, p0 + 2 + i, dir, b) * 384u + co; kn[i] = bf2f(Kb[ro]); vn[i] = bf2f(Vb[ro]); qn[i] = bf2f(Qb[ro]); }
        }
#pragma unroll
        for (int i = 0; i < 2; ++i) { scr[i * 128 + lane] = kc[i]; scr[i * 128 + 64 + lane] = qc[i]; }
#pragma unroll
        for (int i = 0; i < 2; ++i) {
            float o = scan_step<TYPE, true>(S, scr + i * 128, vc[i], gam);
            const unsigned row = (unsigned)scan_row(sc, p0 + i, dir, b);
            if (!SECOND) oscr[row * 768u + co2] = o;
            else { o += oscr[row * 768u + co2];
                const float r = __builtin_amdgcn_rsqf(wave_sum_dpp(o * o) * (1.f / 64.f) + EPS);
                const float g = bf2f(Gb[row * 384u + co]);
                mix[row * 1024u + co2] = (bf16_t)f2bf(o * r * nw * g * sigmoidf_(g)); }
            asm volatile("" ::: "memory");
        }
#pragma unroll
        for (int i = 0; i < 2; ++i) { kc[i] = kn[i]; vc[i] = vn[i]; qc[i] = qn[i]; }
    }
}
__device__ __forceinline__ void phase_scan_c(Frame& F, int layer) {
    PHASE_IDS();
    const int gw = blk_ * NWAVES + wave, NGW = F.G * NWAVES;
    const bool need_ctx = layer == 0;
    for (int wu = gw; wu < 24 * NSC; wu += NGW) {
        const int sq = wu / NSC, blk = wu % NSC; const int type = sq / 12, b = (sq % 12) / 6, h = sq % 6;
        if (blk == 0 && !need_ctx) continue;
        const int scf = blk, scb = (blk == 0) ? 0 : 65 - blk;
        if (type == 0) { scan_dir<0, false>(F, lane, wave, layer, b, h, 0, scf, scf == 0); scan_dir<0, true>(F, lane, wave, layer, b, h, 1, scb, scb == 0); }
        else           { scan_dir<1, false>(F, lane, wave, layer, b, h, 0, scf, scf == 0); scan_dir<1, true>(F, lane, wave, layer, b, h, 1, scb, scb == 0); }
    }
}


namespace sc2 {
constexpr int WLDS = 8448;
__device__ __forceinline__ f32x4 mfma16(bf16x8 a, bf16x8 b, f32x4 c) { return __builtin_amdgcn_mfma_f32_16x16x32_bf16(a, b, c, 0, 0, 0); }
template <int TYPE, int MODE>
__device__ __forceinline__ void run(Frame& F, int lane_in, int wave, int layer, int b, int h, int dir, int sc, bool zero_state, int wu_out) {
    int lane = lane_in; asm volatile("" : "+v"(lane));
    const int g = lane >> 4, n = lane & 15;
    const float* tab = (const float*)(F.ws + WS_TAB);
    const int s = TYPE * 24 + b * 12 + h * 2 + dir;
    const bf16_t* Kb = (const bf16_t*)(F.ws + WS_SCAN + (size_t)(TYPE ? SC_RK : (dir ? SC_KB : SC_KF)) * SCAN_PITCH);
    const bf16_t* Vb = (const bf16_t*)(F.ws + WS_SCAN + (size_t)(TYPE ? SC_RV : SC_HV) * SCAN_PITCH);
    const bf16_t* Qb = (const bf16_t*)(F.ws + WS_SCAN + (size_t)(TYPE ? SC_RQ : SC_HQ) * SCAN_PITCH);
    const bf16_t* Gb = (const bf16_t*)(F.ws + WS_SCAN + (size_t)(TYPE ? SC_RG : SC_HG) * SCAN_PITCH);
    float* oscr = (float*)(F.ws + WS_OSCR);
    bf16_t* mix = (bf16_t*)(F.ws + WS_MIX);
    const unsigned co = (unsigned)(h * 64 + lane);
    const float lg2 = TYPE ? __builtin_amdgcn_logf(tab[TB_GAM + layer * 12 + dir * 6 + h]) : 0.f;
    LAS unsigned char* wl = F.lds + wave * WLDS;
    LAS bf16_t* QT = (LAS bf16_t*)wl; LAS bf16_t* KT = (LAS bf16_t*)(wl + 2048); LAS bf16_t* KPT = (LAS bf16_t*)(wl + 4096); LAS bf16_t* VT = (LAS bf16_t*)(wl + 6144); LAS float* DD = (LAS float*)(wl + 8192);
    f32x4 S[4][4];
    if (zero_state) {
#pragma unroll
        for (int kb = 0; kb < 4; ++kb)
#pragma unroll
            for (int vb = 0; vb < 4; ++vb) S[kb][vb] = (f32x4){0.f, 0.f, 0.f, 0.f};
    } else { const float* si = (const float*)(F.ws + WS_SIN) + ((size_t)s * NSC + sc) * 4096;
#pragma unroll
        for (int kb = 0; kb < 4; ++kb)
#pragma unroll
            for (int vb = 0; vb < 4; ++vb)
#pragma unroll
                for (int r = 0; r < 4; ++r) S[kb][vb][r] = si[(16 * kb + 4 * g + r) * 64 + 16 * vb + n]; }
    float dtot = 1.f;
    const float gam = TYPE ? tab[TB_GAM + layer * 12 + dir * 6 + h] : 0.f;
    unsigned short kr[16], vr[16], qr[16];
#pragma unroll
    for (int t = 0; t < 16; ++t) { const unsigned ro = (unsigned)scan_row(sc, t, dir, b) * 384u + co; kr[t] = Kb[ro]; vr[t] = Vb[ro]; if (MODE != 0) qr[t] = Qb[ro]; else qr[t] = 0; }
    for (int blk = 0; blk < 16; ++blk) {
        const unsigned row = (unsigned)scan_row(sc, 16 * blk + n, dir, b);
        const unsigned ob = row * 768u + (unsigned)(TYPE * 384 + h * 64 + 4 * g);
        f32x4 of[4]; u32x2 gg[4];
        if (MODE == 2) {
#pragma unroll
            for (int vb = 0; vb < 4; ++vb) { of[vb] = *(const f32x4*)(oscr + ob + 16 * vb); gg[vb] = *(const u32x2*)(Gb + row * 384u + (unsigned)(h * 64 + 16 * vb + 4 * g)); }
        }
        float ek[16]; float eq = 1.f;
#pragma unroll
        for (int t = 0; t < 16; ++t) { const float kk = bf2f(kr[t]);
            eq = fmaxf(eq * (TYPE == 0 ? 1.f - kk : gam), 7.9e-31f);
            ek[t] = __builtin_amdgcn_rcpf(eq);
            if (MODE != 0) { const unsigned w_ = cvt_pk_bf16(bf2f(qr[t]) * eq, kk * ek[t]); QT[t * 64 + lane] = (bf16_t)(w_ & 0xffffu); KT[t * 64 + lane] = (bf16_t)(w_ >> 16); } }
        dtot *= eq; DD[lane] = eq;
        { u32x4 w0, w1, x0, x1;
#pragma unroll
          for (int q = 0; q < 4; ++q) {
              w0[q] = cvt_pk_bf16(bf2f(kr[2 * q]) * (eq * ek[2 * q]), bf2f(kr[2 * q + 1]) * (eq * ek[2 * q + 1]));
              w1[q] = cvt_pk_bf16(bf2f(kr[8 + 2 * q]) * (eq * ek[8 + 2 * q]), bf2f(kr[8 + 2 * q + 1]) * (eq * ek[8 + 2 * q + 1]));
              x0[q] = (unsigned)vr[2 * q] | ((unsigned)vr[2 * q + 1] << 16); x1[q] = (unsigned)vr[8 + 2 * q] | ((unsigned)vr[8 + 2 * q + 1] << 16); }
          *(LAS u32x4*)(KPT + lane * 16) = w0; *(LAS u32x4*)(KPT + lane * 16 + 8) = w1; *(LAS u32x4*)(VT + lane * 16) = x0; *(LAS u32x4*)(VT + lane * 16 + 8) = x1; }
        if (blk + 1 < 16) {
#pragma unroll
            for (int t = 0; t < 16; ++t) { const unsigned ro = (unsigned)scan_row(sc, 16 * (blk + 1) + t, dir, b) * 384u + co; kr[t] = Kb[ro]; vr[t] = Vb[ro]; if (MODE != 0) qr[t] = Qb[ro]; }
        }
        asm volatile("s_waitcnt lgkmcnt(0)" ::: "memory");
        if (MODE != 0) {
            f32x4 sct = (f32x4){0.f, 0.f, 0.f, 0.f};
#pragma unroll
            for (int ks = 0; ks < 2; ++ks) { const bf16x8 a = *(const LAS bf16x8*)(KT + n * 64 + 32 * ks + 8 * g), bq = *(const LAS bf16x8*)(QT + n * 64 + 32 * ks + 8 * g); sct = mfma16(a, bq, sct); }
#pragma unroll
            for (int r = 0; r < 4; ++r) sct[r] = (4 * g + r <= n) ? sct[r] : 0.f;
            u32x4 bs; bs.x = cvt_pk_bf16(sct[0], sct[1]); bs.y = cvt_pk_bf16(sct[2], sct[3]); bs.z = 0u; bs.w = 0u;
            f32x4 o[4];
#pragma unroll
            for (int vb = 0; vb < 4; ++vb) { const u32x2 lo = *(const LAS u32x2*)(VT + (16 * vb + n) * 16 + 4 * g); u32x4 av; av.x = lo.x; av.y = lo.y; av.z = 0u; av.w = 0u;
                o[vb] = mfma16(__builtin_bit_cast(bf16x8, av), __builtin_bit_cast(bf16x8, bs), (f32x4){0.f, 0.f, 0.f, 0.f}); }
#pragma unroll
            for (int ks = 0; ks < 2; ++ks) {
                const u32x2 q0 = *(const LAS u32x2*)(QT + n * 64 + 32 * ks + 4 * g), q1 = *(const LAS u32x2*)(QT + n * 64 + 32 * ks + 16 + 4 * g);
                u32x4 bq; bq.x = q0.x; bq.y = q0.y; bq.z = q1.x; bq.w = q1.y;
#pragma unroll
                for (int vb = 0; vb < 4; ++vb) { u32x4 av; av.x = cvt_pk_bf16(S[2 * ks][vb][0], S[2 * ks][vb][1]); av.y = cvt_pk_bf16(S[2 * ks][vb][2], S[2 * ks][vb][3]);
                    av.z = cvt_pk_bf16(S[2 * ks + 1][vb][0], S[2 * ks + 1][vb][1]); av.w = cvt_pk_bf16(S[2 * ks + 1][vb][2], S[2 * ks + 1][vb][3]);
                    o[vb] = mfma16(__builtin_bit_cast(bf16x8, av), __builtin_bit_cast(bf16x8, bq), o[vb]); }
            }
            if (MODE == 1) {
#pragma unroll
                for (int vb = 0; vb < 4; ++vb) *(f32x4*)(oscr + ob + 16 * vb) = o[vb];
            } else {
                float ss = 0.f;
#pragma unroll
                for (int vb = 0; vb < 4; ++vb) { o[vb] = o[vb] + of[vb]; ss += (o[vb][0] * o[vb][0] + o[vb][1] * o[vb][1]) + (o[vb][2] * o[vb][2] + o[vb][3] * o[vb][3]); }
                ss += xor_swz<16>(ss); ss += xor32(ss, lane);
                const float rn = __builtin_amdgcn_rsqf(ss * (1.f / 64.f) + EPS);
                const float* nw = F.in[TYPE ? 11 : 9] + layer * 64 + 4 * g;
#pragma unroll
                for (int vb = 0; vb < 4; ++vb) { const f32x4 w4 = *(const f32x4*)(nw + 16 * vb);
                    const float g0 = bflo(gg[vb].x), g1 = bfhi(gg[vb].x), g2 = bflo(gg[vb].y), g3 = bfhi(gg[vb].y);
                    u32x2 w; w.x = cvt_pk_bf16(o[vb][0] * rn * w4[0] * g0 * sigmoidf_(g0), o[vb][1] * rn * w4[1] * g1 * sigmoidf_(g1)); w.y = cvt_pk_bf16(o[vb][2] * rn * w4[2] * g2 * sigmoidf_(g2), o[vb][3] * rn * w4[3] * g3 * sigmoidf_(g3));
                    *(u32x2*)(mix + row * 1024u + (unsigned)(TYPE * 384 + h * 64 + 16 * vb + 4 * g)) = w; }
            }
        }
#pragma unroll
        for (int kb = 0; kb < 4; ++kb) { const f32x4 d4 = *(const LAS f32x4*)(DD + 16 * kb + 4 * g);
#pragma unroll
            for (int vb = 0; vb < 4; ++vb) S[kb][vb] = S[kb][vb] * d4; }
        { bf16x8 af[4], bfv[4];
#pragma unroll
          for (int q = 0; q < 4; ++q) { u32x4 a = *(const LAS u32x4*)(KPT + (16 * q + n) * 16 + 8 * (g & 1)), bq = *(const LAS u32x4*)(VT + (16 * q + n) * 16 + 8 * (g & 1));
              if (g >= 2) { a = (u32x4){0u, 0u, 0u, 0u}; bq = (u32x4){0u, 0u, 0u, 0u}; }
              af[q] = __builtin_bit_cast(bf16x8, a); bfv[q] = __builtin_bit_cast(bf16x8, bq); }
#pragma unroll
          for (int kb = 0; kb < 4; ++kb)
#pragma unroll
              for (int vb = 0; vb < 4; ++vb) S[kb][vb] = mfma16(af[kb], bfv[vb], S[kb][vb]); }
        asm volatile("s_waitcnt lgkmcnt(0)" ::: "memory");
    }
    if (MODE == 0) {
        float* sl = (float*)(F.ws + WS_SLOC) + (size_t)wu_out * 4096;
#pragma unroll
        for (int kb = 0; kb < 4; ++kb)
#pragma unroll
            for (int vb = 0; vb < 4; ++vb)
#pragma unroll
                for (int r = 0; r < 4; ++r) sl[(16 * kb + 4 * g + r) * 64 + 16 * vb + n] = S[kb][vb][r];
        ((float*)(F.ws + WS_DEC))[(size_t)wu_out * 64 + lane] = dtot;
    }
}
constexpr int WLDS0 = 10240;
template <int TYPE>
__device__ __forceinline__ void run0(Frame& F, int lane_in, int wave, int layer, int b, int h, int dir, int sc, int wu_out) {
    int lane = lane_in; asm volatile("" : "+v"(lane));
    const int g = lane >> 4, n = lane & 15;
    const float* tab = (const float*)(F.ws + WS_TAB);
    const bf16_t* Kb = (const bf16_t*)(F.ws + WS_SCAN + (size_t)(TYPE ? SC_RK : (dir ? SC_KB : SC_KF)) * SCAN_PITCH);
    const bf16_t* Vb = (const bf16_t*)(F.ws + WS_SCAN + (size_t)(TYPE ? SC_RV : SC_HV) * SCAN_PITCH);
    const unsigned co = (unsigned)(h * 64 + lane);
    const float gam = TYPE ? tab[TB_GAM + layer * 12 + dir * 6 + h] : 0.f;
    LAS unsigned char* wl = F.lds + wave * WLDS0;
    LAS unsigned char* KP = wl; LAS unsigned char* VT = wl + 5120;
    f32x4 S[4][4];
#pragma unroll
    for (int kb = 0; kb < 4; ++kb)
#pragma unroll
        for (int vb = 0; vb < 4; ++vb) S[kb][vb] = (f32x4){0.f, 0.f, 0.f, 0.f};
    float r = 1.f;
    unsigned short kr[32], vr[32];
#pragma unroll
    for (int i = 0; i < 32; ++i) { const unsigned ro = (unsigned)scan_row(sc, 255 - i, dir, b) * 384u + co; kr[i] = Kb[ro]; vr[i] = Vb[ro]; }
    for (int blk = 0; blk < 8; ++blk) {
        u32x4 kw[4], vw[4];
#pragma unroll
        for (int j = 0; j < 16; ++j) { const float k0 = bf2f(kr[2 * j]), k1 = bf2f(kr[2 * j + 1]);
            const float a0 = k0 * r; r *= (TYPE == 0 ? 1.f - k0 : gam); const float a1 = k1 * r; r *= (TYPE == 0 ? 1.f - k1 : gam);
            kw[j >> 2][j & 3] = cvt_pk_bf16(a0, a1); vw[j >> 2][j & 3] = (unsigned)vr[2 * j] | ((unsigned)vr[2 * j + 1] << 16); }
#pragma unroll
        for (int q = 0; q < 4; ++q) { *(LAS u32x4*)(KP + lane * 80 + 16 * q) = kw[q]; *(LAS u32x4*)(VT + lane * 80 + 16 * q) = vw[q]; }
        if (blk + 1 < 8) {
#pragma unroll
            for (int i = 0; i < 32; ++i) { const unsigned ro = (unsigned)scan_row(sc, 255 - 32 * (blk + 1) - i, dir, b) * 384u + co; kr[i] = Kb[ro]; vr[i] = Vb[ro]; }
        }
        asm volatile("s_waitcnt lgkmcnt(0)" ::: "memory");
        { bf16x8 af[4], bfv[4];
#pragma unroll
          for (int q = 0; q < 4; ++q) { af[q] = __builtin_bit_cast(bf16x8, *(const LAS u32x4*)(KP + (16 * q + n) * 80 + 16 * g)); bfv[q] = __builtin_bit_cast(bf16x8, *(const LAS u32x4*)(VT + (16 * q + n) * 80 + 16 * g)); }
#pragma unroll
          for (int kb = 0; kb < 4; ++kb)
#pragma unroll
              for (int vb = 0; vb < 4; ++vb) S[kb][vb] = mfma16(af[kb], bfv[vb], S[kb][vb]); }
        asm volatile("s_waitcnt lgkmcnt(0)" ::: "memory");
    }
    float* sl = (float*)(F.ws + WS_SLOC) + (size_t)wu_out * 4096;
#pragma unroll
    for (int kb = 0; kb < 4; ++kb)
#pragma unroll
        for (int vb = 0; vb < 4; ++vb)
#pragma unroll
            for (int rr = 0; rr < 4; ++rr) sl[(16 * kb + 4 * g + rr) * 64 + 16 * vb + n] = S[kb][vb][rr];
    ((float*)(F.ws + WS_DEC))[(size_t)wu_out * 64 + lane] = r;
}
}
__device__ __forceinline__ void phase_scan2_a(Frame& F, int layer) {
    PHASE_IDS();
    const int gw = blk_ * NWAVES + wave, NGW = F.G * NWAVES;
    for (int wu = gw; wu < NSEQ * NSC; wu += NGW) {
        const int s = wu / NSC, sc = wu % NSC; const int type = s / 24, rem = s % 24, b = rem / 12, h = (rem % 12) >> 1, dir = rem & 1;
        if (type == 0) sc2::run0<0>(F, lane, wave, layer, b, h, dir, sc, wu); else sc2::run0<1>(F, lane, wave, layer, b, h, dir, sc, wu);
    }
    { const P0Split sp = p0_split(F.G, layer);
      if (gw >= sp.thrA) p0_run(F, (LAS float*)(F.lds + wave * sc2::WLDS0), lane, layer * P0_PER_L + P0_NFIX, gw - sp.thrA, sp.idleA, sp.NA); }
}
__device__ __forceinline__ void phase_scan2_c(Frame& F, int layer) {
    PHASE_IDS();
    const int gw = blk_ * NWAVES + wave, NGW = F.G * NWAVES;
    const bool need_ctx = layer == 0;
    for (int wu = gw; wu < 24 * NSC; wu += NGW) {
        const int sq = wu / NSC, blk = wu % NSC; const int type = sq / 12, b = (sq % 12) / 6, h = sq % 6;
        if (blk == 0 && !need_ctx) continue;
        const int scf = blk, scb = (blk == 0) ? 0 : 65 - blk;
        if (type == 0) { sc2::run<0, 1>(F, lane, wave, layer, b, h, 0, scf, scf == 0, 0); sc2::run<0, 2>(F, lane, wave, layer, b, h, 1, scb, scb == 0, 0); }
        else           { sc2::run<1, 1>(F, lane, wave, layer, b, h, 0, scf, scf == 0, 0); sc2::run<1, 2>(F, lane, wave, layer, b, h, 1, scb, scb == 0, 0); }
    }
    { const P0Split sp = p0_split(F.G, layer);
      if (gw >= sp.thrC) p0_run(F, (LAS float*)(F.lds + 67584 + wave * 8448), lane, layer * P0_PER_L + P0_NFIX + sp.NA, gw - sp.thrC, sp.idleC, sp.NC); }
}

namespace att {
constexpr int SLOT = 32768, NS = 3, WSF_OFF = NS * SLOT, OST_OFF = 0, OST_W = 32 * 68 * 4;
__device__ __forceinline__ int crow(int r, int hi) { return (r & 3) + 8 * (r >> 2) + 4 * hi; }
typedef short v4i16_t __attribute__((ext_vector_type(4)));
typedef LAS const char* lds_cptr;
__device__ __forceinline__ s16x4 vtr(lds_cptr p) { return __builtin_bit_cast(s16x4, __builtin_amdgcn_ds_read_tr16_b64_v4i16((LAS v4i16_t*)p)); }
__device__ __forceinline__ float max3f(float a, float b, float c) { return __builtin_fmaxf(__builtin_fmaxf(a, b), c); }
__device__ __forceinline__ float hmax32(const f32x16& p0, const f32x16& p1) {
    float a = max3f(p0[0], p0[1], p1[0]), b = max3f(p0[2], p0[3], p1[1]); a = max3f(a, p1[2], p1[3]);
#pragma unroll
    for (int r = 4; r < 16; r += 4) { a = max3f(a, p0[r], p0[r + 1]); b = max3f(b, p0[r + 2], p0[r + 3]); a = max3f(a, p1[r], p1[r + 1]); b = max3f(b, p1[r + 2], p1[r + 3]); }
    const float m = __builtin_fmaxf(a, b);
    auto rr = __builtin_amdgcn_permlane32_swap(__builtin_bit_cast(unsigned, m), __builtin_bit_cast(unsigned, m), false, false);
    return __builtin_fmaxf(__builtin_bit_cast(float, rr[0]), __builtin_bit_cast(float, rr[1]));
}
#define ATT_WAIT_BAR(N) asm volatile("s_waitcnt vmcnt(" #N ") lgkmcnt(0)\n\ts_barrier" ::: "memory")
template<int VAR>
__device__ __forceinline__ void attn_unit(Frame& F, int lane_in, int wid, int layer, int b, int h, bool isctx, int qb) {
    int lane = lane_in; asm volatile("" : "+v"(lane));
    const int r32 = lane & 31, hi = lane >> 5;
    LAS unsigned char* lds = F.lds; const unsigned lds0 = (unsigned)(uintptr_t)lds;
    const float* tab = (const float*)(F.ws + WS_TAB);
    const int qrow = qb * 256 + wid * 32 + r32;
    bf16x8 qr[2][2];
#pragma unroll
    for (int m = 0; m < 2; ++m) { const int mp = b * 8 + 2 * h + m;
        const bf16_t* qp = isctx ? (const bf16_t*)(F.ws + WS_QC) + ((size_t)mp * CL + qrow) * 32 : (const bf16_t*)(F.ws + WS_QA) + ((size_t)mp * T + qrow) * 32;
#pragma unroll
        for (int d0 = 0; d0 < 2; ++d0) qr[m][d0] = *(const bf16x8*)(qp + d0 * 16 + hi * 8); }
    const int NTL = isctx ? 2 : KT_TILES / 2;
    const bf16_t* ksrc = (const bf16_t*)(F.ws + WS_KA) + (size_t)((b * 8 + 2 * h + (wid >> 2)) * KT_TILES) * 2048 + (wid & 3) * 512;
    const unsigned char* vsrc = F.ws + WS_VA + (size_t)((b * 4 + h) * KT_TILES) * 4096 + (wid >> 2) * 4096 + (wid & 3) * 1024;
    const unsigned dma_off = (unsigned)lane * 16u;
#define ATT_DMA(t, slot) do { _Pragma("unroll") for (int sb_ = 0; sb_ < 2; ++sb_) \
                              ::glds16(ksrc + (size_t)(2 * (t) + sb_) * 2048, dma_off, (unsigned)__builtin_amdgcn_readfirstlane(lds0 + (slot) * SLOT + sb_ * 16384 + wid * 1024)); \
                              ::glds16(vsrc + (size_t)(t) * 8192, dma_off, (unsigned)__builtin_amdgcn_readfirstlane(lds0 + (slot) * SLOT + (wid >> 2) * 16384 + 8192 + (wid & 3) * 1024)); } while (0)
    LAS float* wsf = (LAS float*)(lds + WSF_OFF) + wid * 128;
    LAS float* ost = (LAS float*)(lds + OST_OFF + wid * OST_W);
    f32x16 o[2][2];
#pragma unroll
    for (int m = 0; m < 2; ++m)
#pragma unroll
        for (int d = 0; d < 2; ++d) o[m][d] = f32x16{};
    constexpr float POFS = 60.5f, PTHR = 32.f;
    float mhat = 0.f;
    f32x16 lacc[2]; lacc[0] = f32x16{}; lacc[1] = f32x16{};
    v8i ones8; { int o8 = 0x38383838; asm volatile("" : "+v"(o8)); ones8 = (v8i){o8, o8, o8, o8, o8, o8, o8, o8}; asm volatile("" : "+v"(ones8)); }
    f32x16 negm; { float z_ = POFS; asm volatile("" : "+v"(z_));
#pragma unroll
      for (int r = 0; r < 16; ++r) negm[r] = z_; }
    ATT_DMA(0, 0); ATT_DMA(1, 1);
    asm volatile("" : "+v"(qr[0][0]), "+v"(qr[0][1]), "+v"(qr[1][0]), "+v"(qr[1][1]));
    int slot = 0;
    for (int t = 0; t < NTL; ++t) {
        if (t + 1 < NTL) { ATT_WAIT_BAR(3); } else { ATT_WAIT_BAR(0); }
        if (t + 2 < NTL) { const int s2 = slot >= 1 ? slot - 1 : 2; ATT_DMA(t + 2, s2); }
#pragma unroll
        for (int sub = 0; sub < 2; ++sub) {
        const lds_cptr base = (lds_cptr)lds + slot * SLOT + sub * 16384;
        f32x16 p[2][2];
#pragma unroll
        for (int m = 0; m < 2; ++m) {
            const lds_cptr kb = base + m * 4096 + hi * 1024 + r32 * 16;
            const bf16x8 k00 = VAR == 4 ? qr[m][0] : *(const LAS bf16x8*)(kb), k01 = VAR == 4 ? qr[m][1] : *(const LAS bf16x8*)(kb + 512), k10 = VAR == 4 ? qr[1 - m][0] : *(const LAS bf16x8*)(kb + 2048), k11 = VAR == 4 ? qr[1 - m][1] : *(const LAS bf16x8*)(kb + 2048 + 512);
            p[m][0] = __builtin_amdgcn_mfma_f32_32x32x16_bf16(k00, qr[m][0], negm, 0, 0, 0);
            p[m][1] = __builtin_amdgcn_mfma_f32_32x32x16_bf16(k01, qr[m][0], negm, 0, 0, 0);
            p[m][0] = __builtin_amdgcn_mfma_f32_32x32x16_bf16(k10, qr[m][1], p[m][0], 0, 0, 0);
            p[m][1] = __builtin_amdgcn_mfma_f32_32x32x16_bf16(k11, qr[m][1], p[m][1], 0, 0, 0);
        }
        v8i vf[2];
        if (sub == 0 && (t & 1) == 0) {
          const float rm = __builtin_fmaxf(hmax32(p[0][0], p[0][1]), hmax32(p[1][0], p[1][1])) - POFS;
          const bool first = (t == 0);
          if (first || __any(rm > PTHR)) {
              const float dl = first ? rm : fmaxf(rm, 0.f);
              mhat += dl;
#pragma unroll
              for (int r = 0; r < 16; ++r) { p[0][0][r] -= dl; p[0][1][r] -= dl; p[1][0][r] -= dl; p[1][1][r] -= dl; negm[r] = POFS - mhat; }
              asm volatile("" : "+v"(negm));
              if (!first) {
                  const float f = __builtin_amdgcn_exp2f(-0.25f * dl);
                  if (hi == 0) wsf[r32] = f;
                  LDS_WAIT();
#pragma unroll
                  for (int r = 0; r < 16; ++r) { const float fr_ = wsf[crow(r, hi)]; o[0][0][r] *= fr_; o[0][1][r] *= fr_; o[1][0][r] *= fr_; o[1][1][r] *= fr_; lacc[0][r] *= fr_; lacc[1][r] *= fr_; }
                  LDS_WAIT();
              }
          } }
#pragma unroll
        for (int m = 0; m < 2; ++m) {
            f32x16& p0 = p[m][0]; f32x16& p1 = p[m][1];
            v8i pw;
#pragma unroll
            for (int q = 0; q < 4; ++q) {
                unsigned wa = __builtin_amdgcn_cvt_pk_u8_f32(p0[4 * q], 0, 0u), wb = __builtin_amdgcn_cvt_pk_u8_f32(p1[4 * q], 0, 0u);
#pragma unroll
                for (int j = 1; j < 4; ++j) { wa = __builtin_amdgcn_cvt_pk_u8_f32(p0[4 * q + j], j, wa); wb = __builtin_amdgcn_cvt_pk_u8_f32(p1[4 * q + j], j, wb); }
                pw[q] = (int)wa; pw[4 + q] = (int)wb; }
            if (m == 0) {
                const lds_cptr vp0 = base + 8192 + hi * 512 + r32 * 16;
#pragma unroll
                for (int d0 = 0; d0 < 2; ++d0) { const u32x4 lo = *(const LAS u32x4*)(vp0 + d0 * 1024), hh = *(const LAS u32x4*)(vp0 + d0 * 1024 + 2048);
                    vf[d0] = (v8i){(int)lo.x, (int)lo.y, (int)lo.z, (int)lo.w, (int)hh.x, (int)hh.y, (int)hh.z, (int)hh.w}; }
            }
#pragma unroll
            for (int d0 = 0; d0 < 2; ++d0) o[m][d0] = __builtin_amdgcn_mfma_scale_f32_32x32x64_f8f6f4(pw, vf[d0], o[m][d0], 1, 0, 0, 0x7F7F7F7F, 0, 0x7B7B7B7B);
            lacc[m] = __builtin_amdgcn_mfma_scale_f32_32x32x64_f8f6f4(pw, ones8, lacc[m], 1, 0, 0, 0x7F7F7F7F, 0, 0x7F7F7F7F);
        }
        }
        slot = slot == 2 ? 0 : slot + 1;
    }
    asm volatile("s_waitcnt lgkmcnt(0)\n\ts_barrier" ::: "memory");
    int lane_e = lane; asm volatile("" : "+v"(lane_e));
    const int r32e = lane_e & 31, hie = lane_e >> 5;
    const float lam = tab[TB_LAM + layer], oml = tab[TB_LAM + 2 + layer];
#pragma unroll
    for (int r = 0; r < 16; ++r) { const int qq = crow(r, hie); const float f0 = __builtin_amdgcn_rcpf(lacc[0][r]), f1 = -lam * __builtin_amdgcn_rcpf(lacc[1][r]);
#pragma unroll
        for (int d0 = 0; d0 < 2; ++d0) ost[qq * 68 + d0 * 32 + r32e] = o[0][d0][r] * f0 + o[1][d0][r] * f1; }
    LDS_WAIT();
    { const int rw = lane_e >> 1, hf = lane_e & 1; f32x4 xv[8]; float ss = 0.f;
#pragma unroll
      for (int j = 0; j < 8; ++j) { xv[j] = *(const LAS f32x4*)(ost + rw * 68 + hf * 32 + 4 * j); ss += (xv[j][0] * xv[j][0] + xv[j][1] * xv[j][1]) + (xv[j][2] * xv[j][2] + xv[j][3] * xv[j][3]); }
      ss += xor_swz<1>(ss);
      const float rs = __builtin_amdgcn_rsqf(ss * (1.f / 64.f) + EPS) * oml;
      const float* sw = F.in[13] + layer * 64 + hf * 32;
      const int qi = qb * 256 + wid * 32 + rw; const size_t orow = isctx ? (size_t)(NLAT + b * CL + qi) : (size_t)(b * T + qi);
      bf16_t* dst = (bf16_t*)(F.ws + WS_MIX) + orow * 1024 + 768 + h * 64 + hf * 32;
#pragma unroll
      for (int j = 0; j < 4; ++j) { const f32x4 a = xv[2 * j], c = xv[2 * j + 1]; const f32x4 wa = *(const f32x4*)(sw + 8 * j), wb = *(const f32x4*)(sw + 8 * j + 4);
          u32x4 w; w.x = pk2(a[0] * rs * wa[0], a[1] * rs * wa[1]); w.y = pk2(a[2] * rs * wa[2], a[3] * rs * wa[3]); w.z = pk2(c[0] * rs * wb[0], c[1] * rs * wb[1]); w.w = pk2(c[2] * rs * wb[2], c[3] * rs * wb[3]);
          *(u32x4*)(dst + 8 * j) = w; } }
    asm volatile("s_waitcnt lgkmcnt(0)\n\ts_barrier" ::: "memory");
#undef ATT_DMA
}

#define ATT_SBAR() __builtin_amdgcn_sched_barrier(0)
#define ATT_MFMA(a, b, c) __builtin_amdgcn_mfma_f32_32x32x16_bf16(a, b, c, 0, 0, 0)
#define ATT_PV(a, b, c, sb) __builtin_amdgcn_mfma_scale_f32_32x32x64_f8f6f4(a, b, c, 1, 0, 0, 0x7F7F7F7F, 0, sb)
constexpr float POFS = 60.5f, PTHR = 32.f;
struct PState { f32x16 o[2][2]; f32x4 lacc[2]; f32x16 negm; bf16x8 qr[2][2]; float mhat; };
#define ATT_CVT8(p, e0, W, i0) do { unsigned a_ = __builtin_amdgcn_cvt_pk_u8_f32(p[e0], 0, 0u), b_ = __builtin_amdgcn_cvt_pk_u8_f32(p[(e0) + 4], 0, 0u); \
    _Pragma("unroll") for (int j_ = 1; j_ < 4; ++j_) { a_ = __builtin_amdgcn_cvt_pk_u8_f32(p[(e0) + j_], j_, a_); b_ = __builtin_amdgcn_cvt_pk_u8_f32(p[(e0) + 4 + j_], j_, b_); } \
    W[i0] = (int)a_; W[(i0) + 1] = (int)b_; } while (0)
template<int M, bool LOADV>
__device__ __forceinline__ void pstep(PState& S, f32x16& pa0, f32x16& pa1, f32x16& pb0, f32x16& pb1, bf16x8& kA, bf16x8& kB, v8i (&vf)[2], const v4i& sel4, lds_cptr vb, lds_cptr kc, lds_cptr kn, bool chk, LAS float* wsfw, int lane) {
    constexpr int MN = 1 - M;
    if (chk) {
        const float rm = hmax32(pa0, pa1) - POFS;
        if (__any(rm > PTHR)) {
            const int r32 = lane & 31, hi = lane >> 5;
            const float dl = fmaxf(rm, 0.f);
            S.mhat += dl;
#pragma unroll
            for (int r = 0; r < 16; ++r) { pa0[r] -= dl; pa1[r] -= dl; S.negm[r] = POFS - S.mhat; }
            const float f = __builtin_amdgcn_exp2f(-0.25f * dl);
            if (hi == 0) wsfw[r32] = f;
            LDS_WAIT();
#pragma unroll
            for (int r = 0; r < 16; ++r) { const float fr_ = wsfw[crow(r, hi)]; S.o[0][0][r] *= fr_; S.o[0][1][r] *= fr_; S.o[1][0][r] *= fr_; S.o[1][1][r] *= fr_; }
            { const float fl_ = wsfw[(lane & 15) + 16 * hi]; S.lacc[0] = S.lacc[0] * fl_; S.lacc[1] = S.lacc[1] * fl_; }
            LDS_WAIT();
        }
    }
    v8i pw;
    ATT_SBAR(); pb0 = ATT_MFMA(kA, S.qr[MN][0], S.negm); ATT_SBAR();
    kA = *(const LAS bf16x8*)(kc + 2048);
    if (LOADV) {
#pragma unroll
        for (int d0 = 0; d0 < 2; ++d0) { const u32x4 lo = *(const LAS u32x4*)(vb + d0 * 1024), hh = *(const LAS u32x4*)(vb + d0 * 1024 + 2048);
            vf[d0] = (v8i){(int)lo.x, (int)lo.y, (int)lo.z, (int)lo.w, (int)hh.x, (int)hh.y, (int)hh.z, (int)hh.w}; }
    }
    ATT_CVT8(pa0, 0, pw, 0);
    ATT_SBAR(); pb1 = ATT_MFMA(kB, S.qr[MN][0], S.negm); ATT_SBAR();
    kB = *(const LAS bf16x8*)(kc + 2048 + 512);
    ATT_CVT8(pa0, 8, pw, 2);
    ATT_SBAR(); pb0 = ATT_MFMA(kA, S.qr[MN][1], pb0); ATT_SBAR();
    kA = *(const LAS bf16x8*)(kn);
    ATT_CVT8(pa1, 0, pw, 4);
    ATT_SBAR(); pb1 = ATT_MFMA(kB, S.qr[MN][1], pb1); ATT_SBAR();
    kB = *(const LAS bf16x8*)(kn + 512);
    ATT_CVT8(pa1, 8, pw, 6);
    ATT_SBAR(); S.o[M][0] = ATT_PV(pw, vf[0], S.o[M][0], 0x7B7B7B7B);
    ATT_SBAR(); S.o[M][1] = ATT_PV(pw, vf[1], S.o[M][1], 0x7B7B7B7B);
    ATT_SBAR(); S.lacc[M] = __builtin_amdgcn_mfma_scale_f32_16x16x128_f8f6f4((v8i){sel4[0], sel4[1], sel4[2], sel4[3], 0, 0, 0, 0}, pw, S.lacc[M], 4, 1, 0, 0x7F7F7F7F, 0, 0x7F7F7F7F); ATT_SBAR();
}
__device__ __forceinline__ void attn_unit_p(Frame& F, int lane_in, int wid, int layer, int b, int h, bool isctx, int qb) {
    int lane = lane_in; asm volatile("" : "+v"(lane));
    const int r32 = lane & 31, hi = lane >> 5;
    LAS unsigned char* lds = F.lds; const unsigned lds0 = (unsigned)(uintptr_t)lds;
    const float* tab = (const float*)(F.ws + WS_TAB);
    const int qrow = qb * 256 + wid * 32 + r32;
    PState S;
#pragma unroll
    for (int m = 0; m < 2; ++m) { const int mp = b * 8 + 2 * h + m;
        const bf16_t* qp = isctx ? (const bf16_t*)(F.ws + WS_QC) + ((size_t)mp * CL + qrow) * 32 : (const bf16_t*)(F.ws + WS_QA) + ((size_t)mp * T + qrow) * 32;
#pragma unroll
        for (int d0 = 0; d0 < 2; ++d0) S.qr[m][d0] = *(const bf16x8*)(qp + d0 * 16 + hi * 8); }
    const int NTL = isctx ? 2 : KT_TILES / 2;
    const bf16_t* ksrc = (const bf16_t*)(F.ws + WS_KA) + (size_t)((b * 8 + 2 * h + (wid >> 2)) * KT_TILES) * 2048 + (wid & 3) * 512;
    const unsigned char* vsrc = F.ws + WS_VA + (size_t)((b * 4 + h) * KT_TILES) * 4096 + (wid >> 2) * 4096 + (wid & 3) * 1024;
    const unsigned dma_off = (unsigned)lane * 16u;
#define ATT_DMA(t, slot) do { _Pragma("unroll") for (int sb_ = 0; sb_ < 2; ++sb_) \
                              ::glds16(ksrc + (size_t)(2 * (t) + sb_) * 2048, dma_off, (unsigned)__builtin_amdgcn_readfirstlane(lds0 + (slot) * SLOT + sb_ * 16384 + wid * 1024)); \
                              ::glds16(vsrc + (size_t)(t) * 8192, dma_off, (unsigned)__builtin_amdgcn_readfirstlane(lds0 + (slot) * SLOT + (wid >> 2) * 16384 + 8192 + (wid & 3) * 1024)); } while (0)
    LAS float* wsf = (LAS float*)(lds + WSF_OFF) + wid * 128;
    LAS float* ost = (LAS float*)(lds + OST_OFF + wid * OST_W);
#pragma unroll
    for (int m = 0; m < 2; ++m) { S.o[m][0] = f32x16{}; S.o[m][1] = f32x16{}; S.lacc[m] = (f32x4){0.f, 0.f, 0.f, 0.f}; }
    S.mhat = 0.f;
    { float z_ = POFS; asm volatile("" : "+v"(z_));
#pragma unroll
      for (int r = 0; r < 16; ++r) S.negm[r] = z_; }
    v4i sel4; { int o4 = (((lane >> 4) ^ (lane >> 3)) & 1) ? 0 : 0x22222222; asm volatile("" : "+v"(o4)); sel4 = (v4i){o4, o4, o4, o4}; asm volatile("" : "+v"(sel4)); }
    ATT_DMA(0, 0); ATT_DMA(1, 1);
    asm volatile("" : "+v"(S.qr[0][0]), "+v"(S.qr[0][1]), "+v"(S.qr[1][0]), "+v"(S.qr[1][1]));
    const int koff = hi * 1024 + r32 * 16, voff = 8192 + hi * 512 + r32 * 16;
    ATT_WAIT_BAR(3);
    f32x16 pa0, pa1, pb0, pb1; bf16x8 kA, kB; v8i vf[2];
    {
        const lds_cptr kb = (lds_cptr)lds + koff;
        kA = *(const LAS bf16x8*)(kb); kB = *(const LAS bf16x8*)(kb + 512);
        pa0 = ATT_MFMA(kA, S.qr[0][0], S.negm); pa1 = ATT_MFMA(kB, S.qr[0][0], S.negm);
        ATT_SBAR();
        kA = *(const LAS bf16x8*)(kb + 2048); kB = *(const LAS bf16x8*)(kb + 2048 + 512);
        pa0 = ATT_MFMA(kA, S.qr[0][1], pa0); pa1 = ATT_MFMA(kB, S.qr[0][1], pa1);
        ATT_SBAR();
        kA = *(const LAS bf16x8*)(kb + 4096); kB = *(const LAS bf16x8*)(kb + 4096 + 512);
        const float rm = hmax32(pa0, pa1) - POFS; S.mhat = rm;
#pragma unroll
        for (int r = 0; r < 16; ++r) { pa0[r] -= rm; pa1[r] -= rm; S.negm[r] = POFS - rm; }
    }
    int slot = 0;
    for (int t = 0; t < NTL; ++t) {
        ATT_WAIT_BAR(0);
        if (t + 2 < NTL) { const int s2 = slot >= 1 ? slot - 1 : 2; ATT_DMA(t + 2, s2); }
        const int sn = slot == 2 ? 0 : slot + 1;
        const lds_cptr tb = (lds_cptr)lds + slot * SLOT, tn = (lds_cptr)lds + sn * SLOT;
        const bool chk = (t & 1) == 0;
        pstep<0, true >(S, pa0, pa1, pb0, pb1, kA, kB, vf, sel4, tb + voff,         tb + 4096 + koff,         tb + 16384 + koff,        chk && t > 0, wsf, lane);
        pstep<1, false>(S, pb0, pb1, pa0, pa1, kA, kB, vf, sel4, tb + voff,         tb + 16384 + koff,        tb + 16384 + 4096 + koff, chk,          wsf, lane);
        pstep<0, true >(S, pa0, pa1, pb0, pb1, kA, kB, vf, sel4, tb + 16384 + voff, tb + 16384 + 4096 + koff, tn + koff,                false,        wsf, lane);
        pstep<1, false>(S, pb0, pb1, pa0, pa1, kA, kB, vf, sel4, tb + 16384 + voff, tn + koff,                tn + 4096 + koff,         false,        wsf, lane);
        slot = sn;
    }
    asm volatile("s_waitcnt lgkmcnt(0)\n\ts_barrier" ::: "memory");
    int lane_e = lane; asm volatile("" : "+v"(lane_e));
    const int r32e = lane_e & 31, hie = lane_e >> 5;
    const float lam = tab[TB_LAM + layer], oml = tab[TB_LAM + 2 + layer];
    if ((lane_e & 16) == 0) { const int ql = (lane_e & 15) + 16 * hie; wsf[ql] = __builtin_amdgcn_rcpf(S.lacc[0][0]); wsf[32 + ql] = __builtin_amdgcn_rcpf(S.lacc[1][0]); }
    LDS_WAIT();
#pragma unroll
    for (int r = 0; r < 16; ++r) { const int qq = crow(r, hie); const float f0 = wsf[qq], f1 = -lam * wsf[32 + qq];
#pragma unroll
        for (int d0 = 0; d0 < 2; ++d0) ost[qq * 68 + d0 * 32 + r32e] = S.o[0][d0][r] * f0 + S.o[1][d0][r] * f1; }
    LDS_WAIT();
    { const int rw = lane_e >> 1, hf = lane_e & 1; f32x4 xv[8]; float ss = 0.f;
#pragma unroll
      for (int j = 0; j < 8; ++j) { xv[j] = *(const LAS f32x4*)(ost + rw * 68 + hf * 32 + 4 * j); ss += (xv[j][0] * xv[j][0] + xv[j][1] * xv[j][1]) + (xv[j][2] * xv[j][2] + xv[j][3] * xv[j][3]); }
      ss += xor_swz<1>(ss);
      const float rs = __builtin_amdgcn_rsqf(ss * (1.f / 64.f) + EPS) * oml;
      const float* sw = F.in[13] + layer * 64 + hf * 32;
      const int qi = qb * 256 + wid * 32 + rw; const size_t orow = isctx ? (size_t)(NLAT + b * CL + qi) : (size_t)(b * T + qi);
      bf16_t* dst = (bf16_t*)(F.ws + WS_MIX) + orow * 1024 + 768 + h * 64 + hf * 32;
#pragma unroll
      for (int j = 0; j < 4; ++j) { const f32x4 a = xv[2 * j], c = xv[2 * j + 1]; const f32x4 wa = *(const f32x4*)(sw + 8 * j), wb = *(const f32x4*)(sw + 8 * j + 4);
          u32x4 w; w.x = pk2(a[0] * rs * wa[0], a[1] * rs * wa[1]); w.y = pk2(a[2] * rs * wa[2], a[3] * rs * wa[3]); w.z = pk2(c[0] * rs * wb[0], c[1] * rs * wb[1]); w.w = pk2(c[2] * rs * wb[2], c[3] * rs * wb[3]);
          *(u32x4*)(dst + 8 * j) = w; } }
    asm volatile("s_waitcnt lgkmcnt(0)\n\ts_barrier" ::: "memory");
#undef ATT_DMA
}
}
template<int VAR>
__device__ __forceinline__ void phase_attn(Frame& F, int layer, int ulo, int uhi) {
    PHASE_IDS();
    __syncthreads();
    const int nunits = 512 + (layer == 0 ? 8 : 0);
    for (int u = blk_; u < nunits && u < uhi; u += F.G) {
        if (u < ulo) continue;
        if (u < 512) { const int bh = u & 7, qb = u >> 3; att::attn_unit_p(F, lane, wave, layer, bh >> 2, bh & 3, false, qb); }
        else { const int bh = u - 512; att::attn_unit_p(F, lane, wave, layer, bh >> 2, bh & 3, true, 0); }
    }
}

__device__ __forceinline__ void phase_route(Frame& F, int layer) {
    PHASE_IDS();
    const int wid = wave, G = F.G, blk = blk_;
    const int nrows = layer == 0 ? NROW : NLAT;
    constexpr int TP = 2064;
    LAS unsigned char* Th = F.lds; LAS unsigned char* Tl = F.lds + 16 * TP; LAS float* Pp = (LAS float*)(F.lds + 32 * TP);
    LAS int* hist = (LAS int*)(F.lds + LDS_TAB); LAS int* sbase = hist + 32; LAS unsigned* ent = (LAS unsigned*)(hist + 64); LAS float* entg = (LAS float*)(ent + 640);
    for (int i = tid; i < 64 + 640; i += NTHR) hist[i] = (i < 64) ? 0 : -1;
    LAS float* mv = (LAS float*)(F.lds + 32 * TP + 16384);
    { const float* mg = (const float*)(F.ws + WS_MODV) + (size_t)layer * 3 * 6 * 1024;
      for (int i = tid; i < 9 * 256; i += NTHR) { const int v = i >> 8, c4 = i & 255; *(LAS f32x4*)(mv + v * 1024 + 4 * c4) = *(const f32x4*)(mg + (size_t)((v / 3) * 6 + 2 + (v % 3)) * 1024 + 4 * c4); } }
    bf16x8 bh[4][2], bl[4][2];
    { const bf16_t* rwh = (const bf16_t*)(F.ws + WS_RWT) + (size_t)layer * 32768; const bf16_t* rwl = rwh + 2 * 32768;
#pragma unroll
      for (int ks = 0; ks < 4; ++ks)
#pragma unroll
        for (int nb = 0; nb < 2; ++nb) { const int o_ = (16 * nb + (lane & 15)) * 1024 + 128 * wid + 32 * ks + 8 * (lane >> 4); bh[ks][nb] = *(const bf16x8*)(rwh + o_); bl[ks][nb] = *(const bf16x8*)(rwl + o_); } }
    __syncthreads();
    const float* modv = (const float*)(F.ws + WS_MODV) + (size_t)layer * 3 * 6 * 1024;
    const bf16_t* yb = (const bf16_t*)(F.ws + WS_Y);
    bf16_t* x1b = (bf16_t*)(F.ws + WS_X1);
    const int nloc = (nrows - blk + G - 1) / G;
    const float rbias = F.in[16][layer * 32 + (lane & 31)];
    const int nbatch = (nloc + 15) >> 4;
    for (int it = 0; it < nbatch; ++it) { const int i0 = 16 * it + 2 * wid;
        f32x4 tk[2][4]; bool val[2];
#pragma unroll
        for (int q = 0; q < 2; ++q) {
            const int il = i0 + q; val[q] = il < nloc; const int r = val[q] ? blk + il * G : blk;
            const int w = row_which(r);
            f32x4 x[4], y[4];
            if (layer == 0) row_load(r < NLAT ? F.in[0] + (size_t)r * D : F.in[2] + (size_t)(r - NLAT) * D, lane, x); else row_load_bf16(x1b + (size_t)r * D, lane, x);
#pragma unroll
            for (int j = 0; j < 4; ++j) { const u32x2 yy = *(const u32x2*)(yb + (size_t)r * D + 4 * lane + 256 * j); y[j] = (f32x4){bflo(yy.x), bfhi(yy.x), bflo(yy.y), bfhi(yy.y)}; }
            const float ry = __builtin_amdgcn_rsqf(row_sumsq(y) * (1.f / 1024.f) + EPS);
            const LAS float* c1 = mv + (w * 3 + 0) * 1024;
#pragma unroll
            for (int j = 0; j < 4; ++j) { const f32x4 cv = *(const LAS f32x4*)(c1 + 4 * lane + 256 * j); x[j] = x[j] + cv * (y[j] * ry); }
            if (val[q]) row_store_bf16(x1b + (size_t)r * D, lane, x);
            { const float rr_ = __builtin_amdgcn_rsqf(row_sumsq(x) * (1.f / 1024.f) + EPS); const LAS float* at_ = mv + (w * 3 + 1) * 1024; const LAS float* bt_ = mv + (w * 3 + 2) * 1024;
#pragma unroll
              for (int j = 0; j < 4; ++j) { const f32x4 av = *(const LAS f32x4*)(at_ + 4 * lane + 256 * j), bv = *(const LAS f32x4*)(bt_ + 4 * lane + 256 * j); tk[q][j] = x[j] * rr_ * av + bv; } }
            if (val[q]) {
                unsigned char* t8 = F.ws + WS_TOK8 + (size_t)r * D;
#pragma unroll
                for (int j = 0; j < 4; ++j) *(unsigned*)(t8 + 4 * lane + 256 * j) = pk4_fp8(tk[q][j][0], tk[q][j][1], tk[q][j][2], tk[q][j][3]); }
        }
#pragma unroll
        for (int q = 0; q < 2; ++q)
#pragma unroll
            for (int j = 0; j < 4; ++j) { unsigned hb[4], lb[4];
#pragma unroll
                for (int c = 0; c < 4; ++c) { hb[c] = f2bf(tk[q][j][c]); lb[c] = f2bf(tk[q][j][c] - __builtin_bit_cast(float, hb[c] << 16)); }
                const int off = (2 * wid + q) * TP + (4 * lane + 256 * j) * 2;
                *(LAS u32x2*)(Th + off) = (u32x2){hb[0] | (hb[1] << 16), hb[2] | (hb[3] << 16)}; *(LAS u32x2*)(Tl + off) = (u32x2){lb[0] | (lb[1] << 16), lb[2] | (lb[3] << 16)}; }
        __syncthreads();
        { f32x4 pacc[2]; pacc[0] = (f32x4){0.f, 0.f, 0.f, 0.f}; pacc[1] = pacc[0];
#pragma unroll
          for (int ks = 0; ks < 4; ++ks) { const int ao = (lane & 15) * TP + (128 * wid + 32 * ks + 8 * (lane >> 4)) * 2;
              const bf16x8 ah = *(const LAS bf16x8*)(Th + ao), al = *(const LAS bf16x8*)(Tl + ao);
#pragma unroll
              for (int nb = 0; nb < 2; ++nb) { pacc[nb] = __builtin_amdgcn_mfma_f32_16x16x32_bf16(ah, bh[ks][nb], pacc[nb], 0, 0, 0); pacc[nb] = __builtin_amdgcn_mfma_f32_16x16x32_bf16(al, bh[ks][nb], pacc[nb], 0, 0, 0);
                                               pacc[nb] = __builtin_amdgcn_mfma_f32_16x16x32_bf16(ah, bl[ks][nb], pacc[nb], 0, 0, 0); } }
#pragma unroll
          for (int nb = 0; nb < 2; ++nb)
#pragma unroll
              for (int r = 0; r < 4; ++r) Pp[(wid * 16 + 4 * (lane >> 4) + r) * 32 + 16 * nb + (lane & 15)] = pacc[nb][r]; }
        __syncthreads();
        float lg = 0.f;
#pragma unroll
        for (int w8 = 0; w8 < 8; ++w8) lg += Pp[(w8 * 16 + 2 * wid + (lane >> 5)) * 32 + (lane & 31)];
        lg += rbias;
#ifdef DBG_CHECK
        { const int q_ = lane >> 5; if (q_ == 0 ? val[0] : val[1]) ((float*)(F.ws + WS_END + 65536))[(size_t)(blk + (i0 + q_) * G) * 32 + (lane & 31)] = lg; }
#endif
        float tv[4]; int te[4];
#pragma unroll
        for (int k = 0; k < 4; ++k) {
            float m = lg;
            m = fmaxf(m, xor_swz<16>(m)); m = fmaxf(m, xor_swz<8>(m)); m = fmaxf(m, xor_swz<4>(m)); m = fmaxf(m, xor_swz<2>(m)); m = fmaxf(m, xor_swz<1>(m));
            const unsigned long long bal = __ballot(lg == m);
            const unsigned hb = (lane & 32) ? (unsigned)(bal >> 32) : (unsigned)bal;
            const int idx = __builtin_ctz(hb);
            tv[k] = m; te[k] = idx;
            if ((lane & 31) == idx) lg = -INFINITY;
        }
        float g[4]; { float s = 0.f;
#pragma unroll
            for (int k = 0; k < 4; ++k) { g[k] = __expf(tv[k] - tv[0]); s += g[k]; }
            const float inv = 1.f / s;
#pragma unroll
            for (int k = 0; k < 4; ++k) g[k] *= inv; }
        const int q = lane >> 5, k = lane & 31;
        if (k < 4 && (q == 0 ? val[0] : val[1])) {
            const int il = i0 + q; const int r = blk + il * G;
            const int ee = (k == 0) ? te[0] : (k == 1) ? te[1] : (k == 2) ? te[2] : te[3];
            const float gg = (k == 0) ? g[0] : (k == 1) ? g[1] : (k == 2) ? g[2] : g[3];
            entg[il * 4 + k] = gg;
            const int lp = __hip_atomic_fetch_add(hist + ee, 1, __ATOMIC_RELAXED, __HIP_MEMORY_SCOPE_WORKGROUP);
            ent[il * 4 + k] = (unsigned)ee | ((unsigned)lp << 8);
        }
    }
    __syncthreads();
    if (tid < 32) sbase[tid] = (int)__hip_atomic_fetch_add((unsigned*)F.ctl + CW_CNT + layer * 32 + tid, (unsigned)hist[tid], __ATOMIC_RELAXED, __HIP_MEMORY_SCOPE_AGENT);
    __syncthreads();
    int* slot = (int*)(F.ws + WS_SLOT);
    for (int i = tid; i < nloc * 4; i += NTHR) { const unsigned en = ent[i]; if (en != 0xffffffffu) { const int e = en & 255, pos = sbase[e] + (int)(en >> 8); const int r = blk + (i >> 2) * G;
        slot[e * CAP + pos] = r * 4 + (i & 3); ((float*)(F.ws + WS_SGATE))[e * CAP + pos] = entg[i]; ((int*)(F.ws + WS_GATE))[r * 4 + (i & 3)] = e | (pos << 8); } }
    __syncthreads();
}
__device__ __forceinline__ void moe_tables(Frame& F, int layer) {
    PHASE_IDS();
    LAS int* tab = (LAS int*)(F.lds + LDS_TAB);
    if (tid == 0) { int acc = 0;
        for (int e = 0; e < 32; ++e) { const int c = (int)__hip_atomic_load((unsigned*)F.ctl + CW_CNT + layer * 32 + e, __ATOMIC_RELAXED, __HIP_MEMORY_SCOPE_AGENT); tab[e] = acc; tab[33 + e] = c; acc += (c + 255) >> 8; }
        tab[32] = acc; }
    __syncthreads();
}
__device__ __forceinline__ void phase_combine(Frame& F, int layer) {
    PHASE_IDS();
    const int gw = blk_ * NWAVES + wave, NGW = F.G * NWAVES;
    const int nrows = layer == 0 ? NROW : NLAT;
    const unsigned char* yk = F.ws + WS_YK; bf16_t* x1b = (bf16_t*)(F.ws + WS_X1);
    LAS float* mv = (LAS float*)F.lds;
    { const float* mg = (const float*)(F.ws + WS_MODV);
      for (int i = tid; i < 9 * 256; i += NTHR) { const int v = i >> 8, c4 = i & 255, w = v / 3, k = v % 3;
          const float* src = (k == 0) ? mg + (size_t)((layer * 3 + w) * 6 + 5) * 1024 : mg + (size_t)((1 * 3 + w) * 6 + (k - 1)) * 1024;
          *(LAS f32x4*)(mv + v * 1024 + 4 * c4) = *(const f32x4*)(src + 4 * c4); } }
    moe_tables(F, layer);
    const LAS int* ttab = (const LAS int*)(F.lds + LDS_TAB); const int* epos = (const int*)(F.ws + WS_GATE);
#define CMB_ISSUE(R, EP, YB, XB) do { _Pragma("unroll") for (int k = 0; k < 4; ++k) { const int ep = __builtin_amdgcn_readfirstlane(EP[k]); const unsigned char* yr = yk + (size_t)(256 * ttab[ep & 255] + (ep >> 8)) * D + 4 * lane; \
        _Pragma("unroll") for (int j = 0; j < 4; ++j) YB[k][j] = *(const unsigned*)(yr + 256 * j); } \
        _Pragma("unroll") for (int j = 0; j < 4; ++j) XB[j] = *(const u32x2*)(x1b + (size_t)(R) * D + 4 * lane + 256 * j); } while (0)
    int epn[4]; unsigned yb[4][4]; u32x2 xb[4];
#pragma unroll
    for (int k = 0; k < 4; ++k) epn[k] = (gw < nrows) ? epos[gw * 4 + k] : 0;
    if (gw < nrows) CMB_ISSUE(gw, epn, yb, xb);
    if (gw + NGW < nrows) {
#pragma unroll
        for (int k = 0; k < 4; ++k) epn[k] = epos[(gw + NGW) * 4 + k];
    }
    for (int r = gw; r < nrows; r += NGW) {
        const int w = row_which(r), rn = r + NGW;
        unsigned yn[4][4]; u32x2 xn[4];
        if (rn < nrows) {
            CMB_ISSUE(rn, epn, yn, xn);
            if (rn + NGW < nrows) {
#pragma unroll
                for (int k = 0; k < 4; ++k) epn[k] = epos[(rn + NGW) * 4 + k];
            }
        }
        f32x4 x[4], f[4];
#pragma unroll
        for (int j = 0; j < 4; ++j) { x[j] = (f32x4){bflo(xb[j].x), bfhi(xb[j].x), bflo(xb[j].y), bfhi(xb[j].y)}; f[j] = (f32x4){0.f, 0.f, 0.f, 0.f}; }
#pragma unroll
        for (int k = 0; k < 4; ++k)
#pragma unroll
            for (int j = 0; j < 4; ++j) { const unsigned u = yb[k][j];
                const f32x2 lo = __builtin_amdgcn_cvt_pk_f32_fp8((int)u, false), hi = __builtin_amdgcn_cvt_pk_f32_fp8((int)u, true); f[j][0] += lo[0]; f[j][1] += lo[1]; f[j][2] += hi[0]; f[j][3] += hi[1]; }
#pragma unroll
        for (int j = 0; j < 4; ++j) f[j] = f[j] * 0.0625f;
        const float rf = __builtin_amdgcn_rsqf(row_sumsq(f) * (1.f / 1024.f) + EPS);
        const LAS float* c2 = mv + (w * 3 + 0) * 1024;
#pragma unroll
        for (int j = 0; j < 4; ++j) { const f32x4 cv = *(const LAS f32x4*)(c2 + 4 * lane + 256 * j); x[j] = x[j] + cv * (f[j] * rf); }
        if (layer == 1) row_store(F.out + (size_t)r * D, lane, x);
        else { row_store_bf16(x1b + (size_t)r * D, lane, x);
            const float rr_ = __builtin_amdgcn_rsqf(row_sumsq(x) * (1.f / 1024.f) + EPS); const LAS float* ah_ = mv + (w * 3 + 1) * 1024; const LAS float* bh_ = mv + (w * 3 + 2) * 1024;
            f32x4 o[4];
#pragma unroll
            for (int j = 0; j < 4; ++j) { const f32x4 av = *(const LAS f32x4*)(ah_ + 4 * lane + 256 * j), bv = *(const LAS f32x4*)(bh_ + 4 * lane + 256 * j); o[j] = x[j] * rr_ * av + bv; }
            row_store_bf16((bf16_t*)(F.ws + WS_H) + (size_t)r * D, lane, o); }
#pragma unroll
        for (int k = 0; k < 4; ++k)
#pragma unroll
            for (int j = 0; j < 4; ++j) yb[k][j] = yn[k][j];
#pragma unroll
        for (int j = 0; j < 4; ++j) xb[j] = xn[j];
    }
#undef CMB_ISSUE
}

__device__ __forceinline__ void gemm_tail_copy(Frame& F, int layer, int which) {
    PHASE_IDS();
    const P0Split sp = p0_split(F.G, layer);
    const int thr = which ? sp.thrO : sp.thrI, nshort = which ? sp.shortO : sp.shortI, n = which ? sp.NO : sp.NI, off = sp.NA + sp.NC + (which ? sp.NI : 0);
    if (nshort > 0 && blk_ >= thr) p0_run(F, (LAS float*)(F.lds + wave * 16384), lane, layer * P0_PER_L + P0_NFIX + off, (blk_ - thr) * NWAVES + wave, nshort * NWAVES, n);
}

struct Args { const float* in[21]; float* out; unsigned char* ws; int ph_lo, ph_hi; };
constexpr int PH_PER_LAYER = 10, NPHASE = 2 + 2 * PH_PER_LAYER;
template <int SUB> __global__ void __launch_bounds__(NTHR, 2) mk_fwd(Args args) {
    extern __shared__ __attribute__((aligned(16))) unsigned char lds_raw[];
    Frame F;
    F.lds = (LAS unsigned char*)lds_raw; F.ws = args.ws; F.out = args.out;
#pragma unroll
    for (int i = 0; i < 21; ++i) F.in[i] = args.in[i];
    F.ctl = (gu32*)(args.ws + WS_CTL);
    __builtin_amdgcn_s_setreg(1473, 1);
    F.tid = threadIdx.x; F.lane = F.tid & 63; F.wave = __builtin_amdgcn_readfirstlane(F.tid >> 6); F.G = gridDim.x; F.blk = blockIdx.x;
    volatile LAS unsigned* misc = (volatile LAS unsigned*)(F.lds + LDS_MISC);
    if (F.tid < 16) misc[F.tid] = 0u;
    __syncthreads();
    const int lo = args.ph_lo, hi = args.ph_hi;
    const bool use_bar = (hi - lo) > 1;
    XcdBarrier bar; bar.bar = (unsigned*)F.ctl + CW_BAR; bar.x = 0; bar.st = nullptr;
    if (use_bar) { bar = xcd_barrier_post((unsigned*)F.ctl + CW_BAR, misc + 8); if (F.tid == 0) xcd_barrier_census(bar); }
#define IN(k) (lo <= (k) && (k) < hi)
#define SEAM(k) do { if (IN(k) && IN((k) + 1)) xcd_barrier(bar); } while (0)
    if (PHON(0) && IN(0)) { for (int rep = 0; rep < NREP(0); ++rep) phase_prologue_a(F); } SEAM(0);
    if (PHON(1) && IN(1)) { for (int rep = 0; rep < NREP(1); ++rep) phase_prologue_b(F); } SEAM(1);
    for (int layer = 0; layer < 2; ++layer) {
        const int p0 = 2 + layer * PH_PER_LAYER;
        unsigned char* ws = F.ws;
        int blk_ = F.blk; asm volatile("" : "+s"(blk_));
        if (PHON(2) && IN(p0 + 0)) {
            pg8::DenseSched S; S.init(ws + WS_H, (bf16_t*)(ws + WS_WIN) + (size_t)layer * NIN * 1024, NROW, NIN, F.G, blk_);
            EpiInProj E{ws, (const float*)(ws + WS_TAB), (const float*)(ws + WS_ROPE), layer};
            if (STAG_EN_IN) stagger_dense((NROW / 256) * (NIN / 256), F.G, blk_);
            for (int rep = 0; rep < NREP(2); ++rep) pg8::gemm_phase<EpiInProj, pg8::DenseSched, false, false, (SUB & 4) != 0>(F.lds, F.wave, S, E);
            gemm_tail_copy(F, layer, 0);
        } SEAM(p0 + 0);
        if (PHON(3) && IN(p0 + 1)) { if constexpr (SUB & 1) phase_scan2_a(F, layer); if constexpr (SUB & 2) phase_attn<0>(F, layer, 0, F.G); } SEAM(p0 + 1);
        if (PHON(4) && IN(p0 + 2)) { for (int rep = 0; rep < NREP(4); ++rep) phase_scan_b(F); } SEAM(p0 + 2);
        if (PHON(5) && IN(p0 + 3)) { if constexpr (SUB & 1) phase_scan2_c(F, layer); if constexpr (SUB & 2) phase_attn<0>(F, layer, F.G, 1 << 30); } SEAM(p0 + 3);
          if (IN(p0 + 4) && IN(p0 + 5) && !IN(p0 + 3)) xcd_barrier(bar);
        if (PHON(7) && IN(p0 + 5)) {
            pg8::DenseSched S; S.init(ws + WS_MIX, (bf16_t*)(ws + WS_WOUT) + (size_t)layer * 1024 * 1024, layer == 0 ? NROW : NLAT, 1024, F.G, blk_);
            EpiBf16OutT<(SUB & 64) != 0> E{(bf16_t*)(ws + WS_Y)};
            { const int nwg = ((layer == 0 ? NROW : NLAT) / 256) * 4; if (STAG_EN_OUT && (nwg % F.G)) stagger_dense(nwg, F.G, blk_); }
            for (int rep = 0; rep < NREP(7); ++rep) pg8::gemm_phase<EpiBf16OutT<(SUB & 64) != 0>, pg8::DenseSched, false, false, (SUB & 4) != 0>(F.lds, F.wave, S, E);
            gemm_tail_copy(F, layer, 1);
        } SEAM(p0 + 5);
        if (PHON(8) && IN(p0 + 6)) { phase_route(F, layer); } SEAM(p0 + 6);
        if (PHON(9) && IN(p0 + 7)) {
            moe_tables(F, layer);
            pg8::MoeSched<8, true, 1024> S{(const char*)(ws + WS_TOK8), (const char*)(ws + WS_W1 + (size_t)layer * NE * 2048 * 1024), (const int*)(ws + WS_SLOT), (const LAS int*)(F.lds + LDS_TAB), F.G, blk_, (size_t)2048 * 1024};
            EpiSwiglu E{ws + WS_ACT, F.in[18] + (size_t)layer * NE * 2048};
            for (int rep = 0; rep < NREP(9); ++rep) pg8::gemm_phase<EpiSwiglu, pg8::MoeSched<8, true, 1024>, true, true, (SUB & 4) != 0>(F.lds, F.wave, S, E);
        } SEAM(p0 + 7);
        if (PHON(10) && IN(p0 + 8)) {
            moe_tables(F, layer);
            pg8::MoeSched<4, false, 1024> S{(const char*)(ws + WS_ACT), (const char*)(ws + WS_W2 + (size_t)layer * NE * 1024 * 1024), (const int*)(ws + WS_SLOT), (const LAS int*)(F.lds + LDS_TAB), F.G, blk_, (size_t)1024 * 1024};
            EpiMoeOutT<((SUB & 64) ? 1 : (SUB & 128) ? 2 : 0)> E{ws + WS_YK, F.in[20] + (size_t)layer * NE * 1024, (const float*)(ws + WS_SGATE)};
            if (STAG_EN_G2 && (F.G & 7) == 0) { const int ntile = __builtin_amdgcn_readfirstlane(((const LAS int*)(F.lds + LDS_TAB))[32]), per = F.G >> 2;
                const int rem = ntile - 8 * (blk_ >> 5) - (blk_ & 7), cnt = rem > 0 ? (rem + per - 1) / per : 0, nmax = (ntile + per - 1) / per;
                stagger_ns(blk_ * STAG_STEP + (cnt < nmax ? STAG_SHORT : 0)); }
            for (int rep = 0; rep < NREP(10); ++rep) pg8::gemm_phase<EpiMoeOutT<((SUB & 64) ? 1 : (SUB & 128) ? 2 : 0)>, pg8::MoeSched<4, false, 1024>, false, true, (SUB & 4) != 0>(F.lds, F.wave, S, E);
        } SEAM(p0 + 8);
        if (PHON(11) && IN(p0 + 9)) { phase_combine(F, layer); } SEAM(p0 + 9);
    }
#ifdef OVFL_PROBE
    int lane_z; asm volatile("v_mbcnt_lo_u32_b32 %0, -1, 0\n\tv_mbcnt_hi_u32_b32 %0, -1, %0" : "=v"(lane_z));
    if (hi == NPHASE && F.blk == 0 && F.wave == 0 && lane_z == 0) { int w = 0; float big = 1e6f, huge = 3e38f; asm volatile("" : "+v"(big), "+v"(huge));
      w = __builtin_amdgcn_cvt_pk_bf8_f32(big, huge, w, false); int w2 = 0; w2 = __builtin_amdgcn_cvt_pk_fp8_f32(big, huge, w2, false);
      if (((w & 0xffff) != 0x7B7B) || ((w2 & 0xffff) != 0x7E7E)) { asm volatile("s_waitcnt vmcnt(0)" ::: "memory"); F.out[5] = __builtin_nanf(""); } }
#endif
#undef IN
#undef SEAM
}


#ifdef DBG_CHECK
namespace dbg {
__device__ float blk_sum(float v, float* red) { const int t = threadIdx.x; red[t] = v; __syncthreads(); for (int o = 128; o > 0; o >>= 1) { if (t < o) red[t] += red[t + o]; __syncthreads(); } const float r = red[0]; __syncthreads(); return r; }
struct Ctx { const float* const* in; unsigned char* ws; float* red; };
__device__ float bfb(const unsigned char* ws, size_t off, size_t idx) { return bf2f(((const bf16_t*)(ws + off))[idx]); }
__device__ float zdot(const Ctx& c, int row, int ocol) {
    float a = 0.f; for (int k = threadIdx.x; k < 1024; k += 256) a += bfb(c.ws, WS_H, (size_t)row * 1024 + k) * c.in[7][(size_t)k * 4224 + ocol];
    return blk_sum(a, c.red);
}
__device__ void upd(float* flag, float got, float want) { const float e = fabsf(got - want) / (fabsf(want) + 0.05f); if (threadIdx.x == 0 && (e > *flag || !(e == e))) *flag = (e == e) ? e : 1e9f; }
__device__ float sc_buf(const Ctx& c, int which, int row, int col) { return bfb(c.ws, WS_SCAN + (size_t)which * SCAN_PITCH, (size_t)row * 384 + col); }
__device__ void naive_scan(const Ctx& c, const float* tab, int type, int b, int h, int dir, int n, float* S, float* o64) {
    const int t = threadIdx.x;
    for (int i = t; i < 4096; i += 256) S[i] = 0.f; __syncthreads();
    const float gam = tab[TB_GAM + 0 * 12 + dir * 6 + h];
    int lastrow = 0;
    for (int p = 0; p < n; ++p) {
        const int sc = p < 256 ? 0 : 1 + (p - 256) / 256, pl = p < 256 ? p : (p - 256) % 256; const int row = scan_row(sc, pl, dir, 0) + (sc == 0 ? b * CL : b * T); lastrow = row;
        for (int i = t; i < 4096; i += 256) { const int k = i >> 6, v = i & 63;
            const float kk = sc_buf(c, type ? SC_RK : (dir ? SC_KB : SC_KF), row, h * 64 + k), vv = sc_buf(c, type ? SC_RV : SC_HV, row, h * 64 + v);
            const float f = type ? gam : 1.f - kk; S[i] = f * S[i] + kk * vv; }
        __syncthreads();
    }
    if (t < 64) { float o = 0.f; for (int k = 0; k < 64; ++k) o += sc_buf(c, type ? SC_RQ : SC_HQ, lastrow, h * 64 + k) * S[k * 64 + t]; o64[t] = o; }
    __syncthreads();
}
__global__ void __launch_bounds__(256) k_check(Args args, float* flags) {
    __shared__ float red[256]; __shared__ float S[4096]; __shared__ float o1[64], o2[64];
    Ctx c{args.in, args.ws, red}; const int id = blockIdx.x, t = threadIdx.x; float* fl = flags + id;
    const float* tab = (const float*)(args.ws + WS_TAB);
    if (t == 0) { *fl = 0.f; if (id == 12) { flags[13] = 0.f; flags[14] = 0.f; flags[15] = 0.f; } } __syncthreads();
#define rows(i) ((i) == 0 ? 5 : (i) == 1 ? 20000 : 33000)
    if (id == 0) { for (int ri = 0; ri < 3; ++ri) for (int cc = 3; cc < 384; cc += 197) { const float z = zdot(c, rows(ri), cc); upd(fl, sc_buf(c, SC_HQ, rows(ri), cc), z); } }
    if (id == 1) { for (int ri = 0; ri < 3; ++ri) for (int cc = 3; cc < 384; cc += 197) { upd(fl, sc_buf(c, SC_HV, rows(ri), cc), zdot(c, rows(ri), 1152 + cc)); upd(fl, sc_buf(c, SC_RG, rows(ri), cc), zdot(c, rows(ri), 3072 + cc)); upd(fl, sc_buf(c, SC_HG, rows(ri), cc), zdot(c, rows(ri), 1536 + cc)); upd(fl, sc_buf(c, SC_RV, rows(ri), cc), zdot(c, rows(ri), 2688 + cc)); } }
    if (id == 2) { for (int ri = 0; ri < 3; ++ri) for (int cc = 3; cc < 384; cc += 197) { const float z1 = zdot(c, rows(ri), 384 + cc), z2 = zdot(c, rows(ri), 768 + cc); upd(fl, sc_buf(c, SC_KF, rows(ri), cc), 1.f / (1.f + expf(z1))); upd(fl, sc_buf(c, SC_KB, rows(ri), cc), 1.f / (1.f + expf(z2))); } }
    if (id == 3) { for (int ri = 0; ri < 3; ++ri) for (int hh = 0; hh < 6; hh += 5) for (int i = 1; i < 32; i += 13) for (int isk = 0; isk < 2; ++isk) { const int r = rows(ri); const bool ctx = r >= NLAT; const int tt = r & (T - 1);
            const float x1 = zdot(c, r, 1920 + 384 * isk + hh * 64 + i), x2 = zdot(c, r, 1920 + 384 * isk + hh * 64 + i + 32);
            const float ang = ctx ? 0.f : (float)tt * powf(10000.f, -(float)i / 32.f); const float cs = cosf(ang), sn = sinf(ang), scl = isk ? 0.125f : 1.f;
            upd(fl, sc_buf(c, isk ? SC_RK : SC_RQ, r, hh * 64 + 2 * i), (x1 * cs - x2 * sn) * scl); upd(fl, sc_buf(c, isk ? SC_RK : SC_RQ, r, hh * 64 + 2 * i + 1), (x2 * cs + x1 * sn) * scl); } }
    if (id == 4) { for (int ri = 0; ri < 3; ++ri) for (int mp = 0; mp < 8; mp += 7) for (int half = 0; half < 2; ++half) for (int j = 1; j < 8; j += 5) { const int r = rows(ri); const bool ctx = r >= NLAT; const int tt = ctx ? (r - NLAT) & 255 : r & (T - 1); const int bb = ctx ? (r - NLAT) >> 8 : r >> 14;
            const int pos = half ? (tt & 63) : (tt >> 6); const float ang = ctx ? 0.f : (float)pos * powf(10000.f, -(float)j / 8.f); const float cs = cosf(ang), sn = sinf(ang);
            { const float x1 = zdot(c, r, 3456 + mp * 32 + half * 16 + j), x2 = zdot(c, r, 3456 + mp * 32 + half * 16 + j + 8); const float scl = 0.17677669529663687f * LOG2E;
              const size_t qi = ctx ? ((size_t)(bb * 8 + mp) * CL + tt) * 32 + half * 16 + 2 * j : ((size_t)(bb * 8 + mp) * T + tt) * 32 + half * 16 + 2 * j;
              upd(fl, bfb(c.ws, ctx ? WS_QC : WS_QA, qi), (x1 * cs - x2 * sn) * scl); upd(fl, bfb(c.ws, ctx ? WS_QC : WS_QA, qi + 1), (x2 * cs + x1 * sn) * scl); }
            { const float x1 = zdot(c, r, 3712 + mp * 32 + half * 16 + j), x2 = zdot(c, r, 3712 + mp * 32 + half * 16 + j + 8);
              const int Lk = ctx ? tt : 256 + tt, tile = Lk >> 6, rr = Lk & 63, pw = half * 16 + 2 * j;
              const size_t ki = ((size_t)((bb * 8 + mp) * KT_TILES + tile) * 4 + (pw >> 3)) * 512 + rr * 8 + (pw & 7);
              upd(fl, bfb(c.ws, WS_KA, ki), x1 * cs - x2 * sn); upd(fl, bfb(c.ws, WS_KA, ki + 1), x2 * cs + x1 * sn); }
            { const int h4 = mp >> 1, w = half * 32 + j * 3; const float z = zdot(c, r, 3968 + h4 * 64 + w); const int Lk = ctx ? tt : 256 + tt, tile = Lk >> 6, rr = Lk & 63;
              upd(fl, bfb(c.ws, WS_VA, ((size_t)((bb * 4 + h4) * KT_TILES + tile) * 2 + (w >> 5)) * 2048 + rr * 32 + (w & 31)), z); } } }
    if (id == 5 || id == 6) {
        const int type = id - 5, b = 1, h = 2;
#define ts(i) ((i) == 0 ? 0 : (i) == 1 ? 1 : 300)
        for (int q = 0; q < 3; ++q) { naive_scan(c, tab, type, b, h, 0, 256 + ts(q) + 1, S, o1);
            if (t < 64) { const float got = ((const float*)(args.ws + WS_OSCR))[(size_t)(b * T + ts(q)) * 768 + type * 384 + h * 64 + t]; const float e = fabsf(got - o1[t]) / (fabsf(o1[t]) + 0.05f); if (e > 0.05f || !(e == e)) atomicMax((int*)fl, __float_as_int((e == e) ? e : 1e9f)); } __syncthreads(); }
    }
    if (id == 7 || id == 8) {
        const int type = id - 7, b = 1, h = 4;
        for (int q = 0; q < 2; ++q) {
            int row;
            if (q == 0) { naive_scan(c, tab, type, b, h, 0, 101, S, o1); naive_scan(c, tab, type, b, h, 1, 256 - 100, S, o2); row = NLAT + b * CL + 100; }
            else { naive_scan(c, tab, type, b, h, 1, 257, S, o2); row = b * T + T - 1; if (t < 64) o1[t] = ((const float*)(args.ws + WS_OSCR))[(size_t)row * 768 + type * 384 + h * 64 + t]; __syncthreads(); }
            float o = t < 64 ? o1[t] + o2[t] : 0.f; const float ss = blk_sum(o * o, red); const float r = rsqrtf(ss / 64.f + EPS);
            if (t < 64) { const float g = sc_buf(c, type ? SC_RG : SC_HG, row, h * 64 + t); const float want = o * r * args.in[type ? 11 : 9][t] * g / (1.f + expf(-g));
                const float got = bfb(c.ws, WS_MIX, (size_t)row * 1024 + type * 384 + h * 64 + t); const float e = fabsf(got - want) / (fabsf(want) + 0.05f); if (e > 0.05f || !(e == e)) atomicMax((int*)fl, __float_as_int((e == e) ? e : 1e9f)); }
            __syncthreads(); }
    }
    if (id == 9) {
        for (int q = 0; q < 2; ++q) { const bool ctx = q == 1; const int b = ctx ? 0 : 1, h = ctx ? 3 : 2, tq = ctx ? 77 : 5000; const int nk = ctx ? 256 : 16640;
            __shared__ float po[2][64]; __shared__ float pl[2];
            for (int m = 0; m < 2; ++m) { const int mp = b * 8 + 2 * h + m;
                float mx = -1e30f;
                for (int kk = t; kk < nk; kk += 256) { float sdot = 0.f; for (int d = 0; d < 32; ++d) { const float qv = bfb(c.ws, ctx ? WS_QC : WS_QA, ((size_t)mp * (ctx ? CL : T) + tq) * 32 + d); const float kv = bfb(c.ws, WS_KA, ((size_t)(mp * KT_TILES + (kk >> 6)) * 4 + (d >> 3)) * 512 + (kk & 63) * 8 + (d & 7)); sdot += qv * kv; } mx = fmaxf(mx, sdot); }
                red[t] = mx; __syncthreads(); for (int o = 128; o > 0; o >>= 1) { if (t < o) red[t] = fmaxf(red[t], red[t + o]); __syncthreads(); } mx = red[0]; __syncthreads();
                float ls = 0.f; float av[64];
_Pragma("unroll") for (int d = 0; d < 64; ++d) av[d] = 0.f;
                for (int kk = t; kk < nk; kk += 256) { float sdot = 0.f; for (int d = 0; d < 32; ++d) { const float qv = bfb(c.ws, ctx ? WS_QC : WS_QA, ((size_t)mp * (ctx ? CL : T) + tq) * 32 + d); const float kv = bfb(c.ws, WS_KA, ((size_t)(mp * KT_TILES + (kk >> 6)) * 4 + (d >> 3)) * 512 + (kk & 63) * 8 + (d & 7)); sdot += qv * kv; }
                    const float p = exp2f(sdot - mx); ls += p;
_Pragma("unroll") for (int d = 0; d < 64; ++d) av[d] += p * bfb(c.ws, WS_VA, ((size_t)((b * 4 + h) * KT_TILES + (kk >> 6)) * 2 + (d >> 5)) * 2048 + (kk & 63) * 32 + (d & 31)); }
                ls = blk_sum(ls, red);
_Pragma("unroll") for (int d = 0; d < 64; ++d) { const float sv = blk_sum(av[d], red); if (t == 0) po[m][d] = sv; } if (t == 0) pl[m] = ls; __syncthreads();
            }
            const float lam = tab[TB_LAM + 0], oml = tab[TB_LAM + 2];
            float o = t < 64 ? po[0][t] / pl[0] - lam * po[1][t] / pl[1] : 0.f; const float ss = blk_sum(o * o, red); const float r = rsqrtf(ss / 64.f + EPS);
            if (t < 64) { const float want = o * r * args.in[13][t] * oml; const size_t row = ctx ? (size_t)(NLAT + b * CL + tq) : (size_t)(b * T + tq); const float got = bfb(c.ws, WS_MIX, row * 1024 + 768 + h * 64 + t);
                const float e = fabsf(got - want) / (fabsf(want) + 0.05f); if (e > 0.05f || !(e == e)) atomicMax((int*)fl, __float_as_int((e == e) ? e : 1e9f)); }
            __syncthreads(); }
    }
    if (id == 10) { for (int ri = 0; ri < 3; ++ri) for (int cc = 7; cc < 1024; cc += 401) { float a = 0.f; for (int k = t; k < 1024; k += 256) a += bfb(c.ws, WS_MIX, (size_t)rows(ri) * 1024 + k) * args.in[14][(size_t)k * 1024 + cc]; a = blk_sum(a, red); upd(fl, ((const float*)(args.ws + WS_Y))[(size_t)rows(ri) * 1024 + cc], a); } }
    if (id == 11) {
        const float* modv = (const float*)(args.ws + WS_MODV);
        for (int ri = 0; ri < 3; ++ri) { const int r = rows(ri), w = row_which(r); const float* xs = r < NLAT ? args.in[0] + (size_t)r * D : args.in[2] + (size_t)(r - NLAT) * D; const float* y = (const float*)(args.ws + WS_Y) + (size_t)r * D;
            float sy = 0.f; for (int k = t; k < 1024; k += 256) sy += y[k] * y[k]; sy = blk_sum(sy, red); const float ry = rsqrtf(sy / 1024.f + EPS);
            float x1[4]; float sx = 0.f;
_Pragma("unroll") for (int q = 0; q < 4; ++q) { const int k = t + 256 * q; x1[q] = xs[k] + modv[(size_t)(w * 6 + 2) * 1024 + k] * y[k] * ry; sx += x1[q] * x1[q]; } sx = blk_sum(sx, red); const float rx = rsqrtf(sx / 1024.f + EPS);
_Pragma("unroll")
            for (int q = 0; q < 4; ++q) { const int k = t + 256 * q; const float tk = x1[q] * rx * modv[(size_t)(w * 6 + 3) * 1024 + k] + modv[(size_t)(w * 6 + 4) * 1024 + k];
                const float got = bfb(c.ws, WS_H, (size_t)r * 1024 + k), got1 = ((const float*)(args.ws + WS_X1))[(size_t)r * 1024 + k];
                const float e = fmaxf(fabsf(got - tk) / (fabsf(tk) + 0.05f), fabsf(got1 - x1[q]) / (fabsf(x1[q]) + 0.05f)); if (e > 0.05f || !(e == e)) atomicMax((int*)fl, __float_as_int((e == e) ? e : 1e9f)); }
            __syncthreads(); } }

    if (id == 12) {
        __shared__ float tokf[1024], lg[32], abuf[2048], actb[1024], yb[1024]; __shared__ int te[4]; __shared__ float tg[4]; __shared__ int spos;
        const unsigned* cnt = (const unsigned*)(args.ws + WS_CTL) + CW_CNT; const int* slot = (const int*)(args.ws + WS_SLOT);
        for (int ri = 0; ri < 3; ++ri) { const int r = rows(ri);
            for (int k = t; k < 1024; k += 256) tokf[k] = bfb(c.ws, WS_H, (size_t)r * 1024 + k); __syncthreads();
            if (t < 32) { float a = args.in[16][t]; for (int k = 0; k < 1024; ++k) a += tokf[k] * args.in[15][(size_t)k * 32 + t]; lg[t] = a; } __syncthreads();
            if (t < 32) { const float got = ((const float*)(args.ws + WS_END + 65536))[(size_t)r * 32 + t]; const float e = fabsf(got - lg[t]); if (e > 0.02f || !(e == e)) atomicMax((int*)(flags + 15), __float_as_int((e == e) ? 1.f + e : 1e9f)); } __syncthreads();
            if (t == 0) { float tv[4]; for (int k = 0; k < 4; ++k) { int bi = 0; float bv = -1e30f; for (int e = 0; e < 32; ++e) if (lg[e] > bv) { bv = lg[e]; bi = e; } te[k] = bi; tv[k] = bv; lg[bi] = -1e30f; }
                float sm = 0.f; for (int k = 0; k < 4; ++k) { tg[k] = expf(tv[k] - tv[0]); sm += tg[k]; } for (int k = 0; k < 4; ++k) tg[k] /= sm; } __syncthreads();
            if (t < 4) { const float got = ((const float*)(args.ws + WS_GATE))[(size_t)r * 4 + t]; const float e = fabsf(got - tg[t]) / (tg[t] + 0.01f); if (e > 0.05f || !(e == e)) atomicMax((int*)(flags + 12), __float_as_int((e == e) ? e : 1e9f)); }
            for (int k4 = 0; k4 < 4; ++k4) { const int e = te[k4]; const float* w1 = args.in[17] + (size_t)e * 1024 * 2048; const float* w2 = args.in[19] + (size_t)e * 1024 * 1024;
                for (int n = t; n < 2048; n += 256) { float a = args.in[18][(size_t)e * 2048 + n]; for (int k = 0; k < 1024; ++k) a += tokf[k] * w1[(size_t)k * 2048 + n]; abuf[n] = a; } __syncthreads();
                for (int j = t; j < 1024; j += 256) { const float g = fminf(abuf[2 * j], 7.f), l = fminf(fmaxf(abuf[2 * j + 1], -7.f), 7.f); actb[j] = g / (1.f + expf(-1.702f * g)) * (l + 1.f); } __syncthreads();
                for (int cc = t; cc < 1024; cc += 256) { float a = args.in[20][(size_t)e * 1024 + cc]; for (int j = 0; j < 1024; ++j) a += actb[j] * w2[(size_t)j * 1024 + cc]; yb[cc] = a * tg[k4]; } __syncthreads();
                if (t == 0) spos = -1; __syncthreads();
                const int ce = (int)cnt[e]; for (int p = t; p < ce; p += 256) if (slot[e * CAP + p] == r * 4 + k4) spos = p; __syncthreads();
                int ts0 = 0; for (int q = 0; q < e; ++q) ts0 += ((int)cnt[q] + 255) >> 8;
                float sqa = 0.f, sqy = 0.f; for (int k = t; k < 1024; k += 256) { sqa += actb[k] * actb[k]; sqy += yb[k] * yb[k]; } sqa = blk_sum(sqa, red); sqy = blk_sum(sqy, red); const float ra = sqrtf(sqa / 1024.f), ry = sqrtf(sqy / 1024.f);
                if (spos < 0) { if (t == 0) flags[13] = 7e8f; }
                else for (int k = t; k < 1024; k += 256) { const float got = bfb(c.ws, WS_ACT, ((size_t)ts0 * 256 + spos) * 1024 + k); const float er = fabsf(got - actb[k]) / (fabsf(actb[k]) + 0.2f * ra + 1e-6f); if (er > 0.05f || !(er == er)) atomicMax((int*)(flags + 13), __float_as_int((er == er) ? er : 1e9f)); }
                for (int k = t; k < 1024; k += 256) { const float got = bfb(c.ws, WS_YK, ((size_t)r * 4 + k4) * 1024 + k); const float er = fabsf(got - yb[k]) / (fabsf(yb[k]) + 0.2f * ry + 1e-6f); if (er > 0.05f || !(er == er)) atomicMax((int*)(flags + 14), __float_as_int((er == er) ? er : 1e9f)); }
                __syncthreads(); }
        } }
}
__global__ void k_out(Args args, const float* flags, int nchk, unsigned mask) {
    int code = 0; for (int i = nchk - 1; i >= 0; --i) if (((mask >> i) & 1u) && flags[i] > 0.05f) code = i + 1;
    const float sc = 1.f + (float)code;
    for (size_t i = (size_t)blockIdx.x * blockDim.x + threadIdx.x; i < (size_t)NLAT * D; i += (size_t)gridDim.x * blockDim.x) args.out[i] = args.in[0][i] * sc;
}
}
#endif

extern "C" void kernel_launch(void* const* d_in, const int* in_sizes, int n_in, void* d_out, int out_size, void* d_ws, size_t ws_size, hipStream_t stream) {
    static int grid = 0;
    if (grid == 0) {
        if (n_in != 21 || out_size != NLAT * D || ws_size < WS_END) { fprintf(stderr, "kernel_launch: unexpected shapes (n_in %d out %d ws %zu)\n", n_in, out_size, ws_size); grid = -1; return; }
        int dev = 0, cus = 0, per_cu = 0;
        if (hipGetDevice(&dev) != hipSuccess || hipDeviceGetAttribute(&cus, hipDeviceAttributeMultiprocessorCount, dev) != hipSuccess) { grid = -1; return; }
        if (hipFuncSetAttribute((const void*)mk_fwd<MAIN_SUB>, hipFuncAttributeMaxDynamicSharedMemorySize, LDS_BYTES) != hipSuccess) { fprintf(stderr, "kernel_launch: hipFuncSetAttribute failed\n"); grid = -1; return; }
        if (hipOccupancyMaxActiveBlocksPerMultiprocessor(&per_cu, (const void*)mk_fwd<MAIN_SUB>, NTHR, LDS_BYTES) != hipSuccess || per_cu < 1) fprintf(stderr, "kernel_launch: occupancy query reports %d\n", per_cu);
        (void)hipGetLastError();
        grid = cus;
    }
    if (grid < 0) return;
    if (hipMemsetAsync((char*)d_ws + WS_CTL, 0, CTL_ZERO_BYTES, stream) != hipSuccess) return;
    Args a{};
    for (int i = 0; i < 21; ++i) a.in[i] = (const float*)d_in[i];
    a.out = (float*)d_out; a.ws = (unsigned char*)d_ws;
#if MK_ONE_LAUNCH
    a.ph_lo = 0; a.ph_hi = NPHASE;
    hipLaunchKernelGGL(mk_fwd<MAIN_SUB>, dim3(grid), dim3(NTHR), LDS_BYTES, stream, a);
#elif defined(DBG_CHECK)
    for (int p = 0; p < DBG_CHECK; ++p) { a.ph_lo = p; a.ph_hi = p + 1; hipLaunchKernelGGL(mk_fwd<MAIN_SUB>, dim3(grid), dim3(NTHR), LDS_BYTES, stream, a); }
    float* flags = (float*)((char*)d_ws + WS_END);
    hipLaunchKernelGGL(dbg::k_check, dim3(13), dim3(256), 0, stream, a, flags);
    hipLaunchKernelGGL(dbg::k_out, dim3(1024), dim3(256), 0, stream, a, (const float*)flags, 16, (unsigned)DBG_MASK);
#else
    if (hipFuncSetAttribute((const void*)mk_fwd<PROBE_SUB>, hipFuncAttributeMaxDynamicSharedMemorySize, LDS_BYTES) != hipSuccess) return;
    for (int p = 0; p < NPHASE; ++p) { a.ph_lo = p; a.ph_hi = p + 1; hipLaunchKernelGGL(mk_fwd<MAIN_SUB>, dim3(grid), dim3(NTHR), LDS_BYTES, stream, a);
        const int pid = p < 2 ? p : 2 + (p - 2) % PH_PER_LAYER;
        if (pid == PROBE_PH) for (int rep = 0; rep < PROBE_REP; ++rep) hipLaunchKernelGGL(mk_fwd<PROBE_SUB>, dim3(grid), dim3(NTHR), LDS_BYTES, stream, a); }
#endif
}
```

```cpp
#include <hip/hip_runtime.h>
#include <cstdio>
#include <cstdint>
#include <cmath>

#ifndef DBG_MASK
#define DBG_MASK 0xf800
#endif
#ifndef PHMASK
#define PHMASK 0xfff
#endif
#define PHON(k) ((PHMASK >> (k)) & 1)
#ifndef REPMASK
#define REPMASK 0
#endif
#define NREP(k) (1 + ((REPMASK >> (k)) & 1))
#ifndef ATTVAR
#define ATTVAR -1
#endif
#ifndef MK_ONE_LAUNCH
#define MK_ONE_LAUNCH 1
#endif
#define MAIN_SUB 3
#define PROBE_PH -1
#define PROBE_SUB 3
#define PROBE_REP 1

#define LAS __attribute__((address_space(3)))
#define GAS __attribute__((address_space(1)))
typedef unsigned short bf16_t;
typedef short bf16x8 __attribute__((ext_vector_type(8)));
typedef short s16x4 __attribute__((ext_vector_type(4)));
typedef float f32x2 __attribute__((ext_vector_type(2)));
typedef float f32x4 __attribute__((ext_vector_type(4)));
typedef float f32x16 __attribute__((ext_vector_type(16)));
typedef unsigned u32x2 __attribute__((ext_vector_type(2)));
typedef unsigned u32x4 __attribute__((ext_vector_type(4)));
typedef GAS unsigned gu32;
typedef int v4i __attribute__((ext_vector_type(4)));
typedef int v8i __attribute__((ext_vector_type(8)));

constexpr int NB = 2, T = 16384, CL = 256, D = 1024;
constexpr int NLAT = NB * T, NCTX = NB * CL, NROW = NLAT + NCTX;
constexpr int NE = 32, CAP = NROW;
constexpr int NIN = 4352;
constexpr int NSEQ = 48, NSC = 65;
constexpr int KT_TILES = 260;
constexpr float EPS = 1e-6f;
constexpr float LOG2E = 1.4426950408889634f;
constexpr int NWAVES = 8, NTHR = 512;

constexpr size_t MiB = 1u << 20;
constexpr size_t WS_CTL = 0, CTL_ZERO_BYTES = 64 * 1024;
constexpr size_t WS_MODV = 1 * MiB;
constexpr size_t WS_TAB = 1 * MiB + 256 * 1024;
constexpr size_t WS_RWT = 1 * MiB + 512 * 1024;
constexpr size_t WS_ROPE = 2 * MiB;
constexpr size_t WS_WIN = 6 * MiB;
constexpr size_t WS_WOUT = 23 * MiB;
constexpr size_t WS_W1 = 27 * MiB;
constexpr size_t WS_W2 = 283 * MiB;
constexpr size_t WS_X1 = 411 * MiB;
constexpr size_t WS_H = 541 * MiB;
constexpr size_t WS_SCAN = 606 * MiB;
constexpr size_t SCAN_PITCH = 25 * MiB;
constexpr size_t WS_QA = 831 * MiB;
constexpr size_t WS_QC = 847 * MiB;
constexpr size_t WS_KA = 848 * MiB;
constexpr size_t WS_VA = 865 * MiB;
constexpr size_t WS_SLOC = 882 * MiB;
constexpr size_t WS_SIN = 931 * MiB;
constexpr size_t WS_DEC = 980 * MiB;
constexpr size_t WS_OSCR = 981 * MiB;
constexpr size_t WS_MIX = 1079 * MiB;
constexpr size_t WS_Y = 1144 * MiB;
constexpr size_t WS_SLOT = 1274 * MiB;
constexpr size_t WS_GATE = 1279 * MiB;
constexpr size_t WS_ACT = 1280 * MiB;
constexpr size_t WS_YK = 1540 * MiB;
constexpr size_t WS_TOK8 = 1816 * MiB;
constexpr size_t WS_SGATE = 1850 * MiB;
constexpr size_t WS_END = 1856 * MiB;
enum { SC_KF = 0, SC_KB = 1, SC_RQ = 2, SC_RK = 3, SC_HQ = 4, SC_HV = 5, SC_HG = 6, SC_RV = 7, SC_RG = 8 };
constexpr int CW_TMO = 0, CW_BAR = 4096, CW_CNT = 8192;
constexpr int TB_LBT = 0;
constexpr int TB_LAM = 1024;
constexpr int TB_GAM = 1040;
constexpr int TB_AXR = 2048;
constexpr int TB_AXC = 2048 + 4096;

constexpr int LDS_BYTES = 147456;
constexpr int LDS_MISC = 131072 + 12288;
constexpr int LDS_TAB = 131072;

__device__ __forceinline__ unsigned f2bf(float f) { unsigned u = __builtin_bit_cast(unsigned, f); return (u + 0x7fffu + ((u >> 16) & 1u)) >> 16; }
__device__ __forceinline__ float bf2f(unsigned short b) { return __builtin_bit_cast(float, (unsigned)b << 16); }
__device__ __forceinline__ float bflo(unsigned w) { return __builtin_bit_cast(float, w << 16); }
__device__ __forceinline__ float bfhi(unsigned w) { return __builtin_bit_cast(float, w & 0xffff0000u); }
typedef __bf16 bf16x2_t __attribute__((ext_vector_type(2)));
__device__ __forceinline__ unsigned trunc_pk_bf16(float lo, float hi) { return __builtin_amdgcn_perm(__builtin_bit_cast(unsigned, hi), __builtin_bit_cast(unsigned, lo), 0x07060302u); }
__device__ __forceinline__ unsigned cvt_pk_bf16(float lo, float hi) { const f32x2 v = {lo, hi}; const bf16x2_t b = __builtin_convertvector(v, bf16x2_t); return __builtin_bit_cast(unsigned, b); }
__device__ __forceinline__ unsigned pk2(float lo, float hi) { return cvt_pk_bf16(lo, hi); }
__device__ __forceinline__ float wave_sum_dpp(float v) {
#define DPP_ADD(ctrl, rmask) v += __builtin_bit_cast(float, __builtin_amdgcn_update_dpp(0, __builtin_bit_cast(int, v), ctrl, rmask, 0xF, false))
    DPP_ADD(0xB1, 0xF); DPP_ADD(0x4E, 0xF); DPP_ADD(0x141, 0xF); DPP_ADD(0x140, 0xF); DPP_ADD(0x142, 0xA); DPP_ADD(0x143, 0xC);
#undef DPP_ADD
    return __builtin_bit_cast(float, __builtin_amdgcn_readlane(__builtin_bit_cast(int, v), 63));
}
__device__ __forceinline__ float wave_sum(float v) { return wave_sum_dpp(v); }
template <int M> __device__ __forceinline__ float xor_swz(float v) { return __builtin_bit_cast(float, __builtin_amdgcn_ds_swizzle(__builtin_bit_cast(int, v), 0x1F | (M << 10))); }
__device__ __forceinline__ float xor32(float v, int lane) { return __builtin_bit_cast(float, __builtin_amdgcn_ds_bpermute((lane ^ 32) << 2, __builtin_bit_cast(int, v))); }
__device__ __forceinline__ float rdlane(float v, int l) { return __builtin_bit_cast(float, __builtin_amdgcn_readlane(__builtin_bit_cast(int, v), l)); }
__device__ __forceinline__ float sigmoidf_(float x) { return __builtin_amdgcn_rcpf(1.f + __builtin_amdgcn_exp2f(-LOG2E * x)); }
#define PHASE_IDS_W(WV) int lane; asm volatile("v_mbcnt_lo_u32_b32 %0, -1, 0\n\tv_mbcnt_hi_u32_b32 %0, -1, %0" : "=v"(lane)); int wave = (WV); asm volatile("" : "+s"(wave)); const int tid = wave * 64 + lane; (void)tid
#define PHASE_IDS() PHASE_IDS_W(F.wave); int blk_ = F.blk; asm volatile("" : "+s"(blk_))
__device__ __forceinline__ unsigned pk4_fp8(float a, float b, float c, float d) { int w = __builtin_bit_cast(int, a); w = __builtin_amdgcn_cvt_pk_fp8_f32(a, b, w, false); w = __builtin_amdgcn_cvt_pk_fp8_f32(c, d, w, true); return (unsigned)w; }
constexpr float W8_MUL = 64.f;
constexpr int SCALE_W8 = 0x79797979, SCALE_A8 = 0x7F7F7F7F;
#define LDS_WAIT() asm volatile("s_waitcnt lgkmcnt(0)" ::: "memory")
#define VM_WAIT() asm volatile("s_waitcnt vmcnt(0)" ::: "memory")

#define XB_TMO      128
#define XB_XCNT(j)  (256  + 64 * (j))
#define XB_XSUB(j)  (1280 + 64 * (j))
#define XB_XGEN(j)  (2304 + 64 * (j))
#define XB_TOP      3328
#define XB_TOPGEN   3392
#define XCD_BAR_WORDS 3456
#define XB_SPIN_CAP (1u << 22)
__device__ __forceinline__ unsigned xb_ld(unsigned* p)              { return __hip_atomic_load(p, __ATOMIC_RELAXED, __HIP_MEMORY_SCOPE_AGENT); }
__device__ __forceinline__ unsigned xb_add(unsigned* p, unsigned v) { return __hip_atomic_fetch_add(p, v, __ATOMIC_RELAXED, __HIP_MEMORY_SCOPE_AGENT); }
__device__ __forceinline__ unsigned xb_xcc_id() { return (unsigned)__builtin_amdgcn_s_getreg((3 << 11) | 20) & 0xFu; }
#define XB_SPIN(cond, bar) do { unsigned _sp = 0; while (cond) { __builtin_amdgcn_s_sleep(1); \
    if ((++_sp & 255u) == 0u) { if (xb_ld(&(bar)[XB_TMO])) break; if (_sp > XB_SPIN_CAP) { atomicAdd(&(bar)[XB_TMO], 1u); break; } } } } while (0)
struct XcdBarrier { unsigned* bar; unsigned x; volatile LAS unsigned* st; };
__device__ __forceinline__ XcdBarrier xcd_barrier_post(unsigned* bar, volatile LAS unsigned* st) {
    XcdBarrier b; b.bar = bar; b.x = xb_xcc_id(); b.st = st;
    if (threadIdx.x == 0) (void)xb_add(&bar[XB_XCNT(b.x)], 1u);
    return b;
}
__device__ __forceinline__ void xcd_barrier_complete(unsigned* bar, unsigned x, unsigned& nloc, unsigned& nx) {
    const unsigned G = gridDim.x * gridDim.y * gridDim.z;
    unsigned sum, cnt, mine, sp = 0u;
    for (;;) {
        sum = 0u; cnt = 0u; mine = 0u;
#pragma unroll
        for (unsigned j = 0; j < 16; ++j) { const unsigned c = xb_ld(&bar[XB_XCNT(j)]); sum += c; cnt += (c > 0u) ? 1u : 0u; mine = (j == x) ? c : mine; }
        if (sum == G) break;
        __builtin_amdgcn_s_sleep(1);
        if ((++sp & 255u) == 0u) { if (xb_ld(&bar[XB_TMO])) break; if (sp > XB_SPIN_CAP) { atomicAdd(&bar[XB_TMO], 1u); break; } }
    }
    nloc = mine > 0u ? mine : 1u; nx = cnt > 0u ? cnt : 1u;
}
__device__ __forceinline__ void xcd_barrier_census(const XcdBarrier& b) {
    unsigned nloc, nx; xcd_barrier_complete(b.bar, b.x, nloc, nx); b.st[0] = nloc; b.st[1] = nx;
}
__device__ __forceinline__ void xcd_barrier(const XcdBarrier& b) {
    asm volatile("s_waitcnt vmcnt(0)" ::: "memory");
    __syncthreads();
    if (threadIdx.x == 0) {
        unsigned* bar = b.bar;
        __builtin_amdgcn_s_waitcnt(0);
        const unsigned nloc = b.st[0], nx = b.st[1];
        const unsigned old = xb_add(&bar[XB_XSUB(b.x)], 1u);
        const unsigned gen = old / nloc;
        if (old + 1u == (gen + 1u) * nloc) {
            __builtin_amdgcn_fence(__ATOMIC_RELEASE, "agent");
            asm volatile("s_waitcnt vmcnt(0)" ::: "memory");
            const unsigned og = xb_add(&bar[XB_TOP], 1u);
            const unsigned tg = og / nx;
            if (og + 1u == (tg + 1u) * nx) xb_add(&bar[XB_TOPGEN], 1u);
            else XB_SPIN(xb_ld(&bar[XB_TOPGEN]) == tg, bar);
            __builtin_amdgcn_fence(__ATOMIC_ACQUIRE, "agent");
            xb_add(&bar[XB_XGEN(b.x)], 1u);
            asm volatile("s_waitcnt vmcnt(0)" ::: "memory");
        } else {
            XB_SPIN(xb_ld(&bar[XB_XGEN(b.x)]) == gen, bar);
            __builtin_amdgcn_fence(__ATOMIC_ACQUIRE, "agent");
            asm volatile("s_waitcnt vmcnt(0)" ::: "memory");
        }
    }
    __syncthreads();
}

#ifndef STAG_STEP
#define STAG_STEP 0
#endif
#ifndef STAG_SHORT
#define STAG_SHORT 13000
#endif
#define STAG_EN_IN ((SUB & 8) != 0)
#define STAG_EN_OUT ((SUB & 16) != 0)
#define STAG_EN_G2 ((SUB & 32) != 0)
__device__ __forceinline__ void stagger_ns(int ns) {
    if (ns <= 0) return;
    const unsigned long long t0 = __builtin_amdgcn_s_memrealtime(), dt = (unsigned long long)(ns / 10);
    while (__builtin_amdgcn_s_memrealtime() - t0 < dt) __builtin_amdgcn_s_sleep(8);
}
__device__ __forceinline__ void stagger_dense(int nwg, int G, int c) {
    const int cnt = (nwg - c + G - 1) / G, nmax = (nwg + G - 1) / G;
    stagger_ns(c * STAG_STEP + (cnt < nmax ? STAG_SHORT : 0));
}
struct Frame {
    LAS unsigned char* lds;
    unsigned char* ws;
    const float* in[21];
    float* out;
    gu32* ctl;
    int tid, lane, wave, G, blk;
};

__device__ __forceinline__ void glds16(const void* sbase, unsigned voff, unsigned lds_dst) { unsigned keep;
    asm volatile("s_mov_b32 %0, m0\n\ts_mov_b32 m0, %3\n\ts_nop 0\n\tglobal_load_lds_dwordx4 %1, %2\n\ts_mov_b32 m0, %0" : "=&s"(keep) : "v"(voff), "s"(sbase), "s"(lds_dst) : "memory"); }

namespace pg8 {
constexpr int BM = 256, BK = 64, HALF = 128, HTB = HALF * BK * 2, STAGE_BYTES = 8 * HTB, NXCD = 8, WGM = 8, K = 1024;
__host__ __device__ __forceinline__ int lds_byte(int r, int c) { const int st = (r >> 4) * 2 + (c >> 5), rr = r & 15, cc = c & 31, ob = rr * 64 + cc * 2; return st * 1024 + (ob ^ (((ob >> 9) & 1) << 5)); }
__host__ __device__ __forceinline__ void stage_rc(int b, int& R, int& C) { const int st = b / 1024, sb = b % 1024, swz = sb ^ (((sb >> 9) & 1) << 5); R = (st >> 1) * 16 + swz / 64; C = (st & 1) * 32 + (swz % 64) / 2; }
__host__ __device__ __forceinline__ int perm32(int rho) { const int n = rho >> 4, i = rho & 15; return 8 * (i >> 2) + 4 * n + (i & 3); }
struct Unit { int pm, pn, e, nvalid, sbase; };
template <class Epi, class Sched, bool GATHER, bool FP8 = false, bool NOEPI = false>
__device__ __forceinline__ void gemm_phase(LAS unsigned char* lds, int wave_id, const Sched& S, const Epi& E) {
    constexpr int KB = FP8 ? 1024 : 2048, NT = KB / 128;
    PHASE_IDS_W(wave_id); const int wid = wave, wr = wid >> 2, wc = wid & 3, fr = lane & 15, fq = lane >> 4;
    unsigned voffB[2], vA[2][2]; int R0, C0;
    { int R, C; stage_rc(tid * 16, R, C); R0 = R; C0 = C;
#pragma unroll
      for (int i = 0; i < 2; ++i) { const int Ri = R + 64 * i; const int Rb = (int)Epi::PERM == 2 ? (64 * (Ri >> 5) + 16 * ((Ri & 15) >> 2) + 4 * ((Ri >> 4) & 1) + (Ri & 3)) : Epi::PERM ? ((Ri & ~31) + perm32(Ri & 31)) : Ri; voffB[i] = (unsigned)(Rb * KB + C * 2);
#pragma unroll
          for (int h = 0; h < 2; ++h) vA[h][i] = (unsigned)((Ri + 128 * h) * KB + C * 2); } }
    const size_t kstep = (size_t)(BK * 2);
    const size_t hstep = (int)Epi::PERM == 2 ? (size_t)8 * KB : (size_t)HALF * KB;
    const unsigned ldsw = (unsigned)wid * 1024u, lds0 = (unsigned)(uintptr_t)lds;
    const int aoff = lds_byte(wr * 64 + fr, fq * 8), boff = lds_byte(wc * 32 + fr, fq * 8);
#define PG8_SA(b, h) (((b) * 2 + (h)) * HTB)
#define PG8_SB(b, h) ((4 + (b) * 2 + (h)) * HTB)
#define PG8_STAGE(bufoff, gbase, voff) do { _Pragma("unroll") for (int _i = 0; _i < 2; ++_i) \
        glds16((const void*)(gbase), (voff)[_i], (unsigned)__builtin_amdgcn_readfirstlane(lds0 + (unsigned)(bufoff) + ldsw + _i * 8192)); } while (0)
#define PG8_LDA(dst, b, h) do { _Pragma("unroll") for (int m = 0; m < 4; ++m) { dst[m].lo = *(const LAS v4i*)(lds + PG8_SA(b, h) + aoff + m * 2048); dst[m].hi = *(const LAS v4i*)(lds + PG8_SA(b, h) + aoff + m * 2048 + 1024); } } while (0)
#define PG8_LDB(dst, b, h) do { _Pragma("unroll") for (int n = 0; n < 2; ++n) { dst[n].lo = *(const LAS v4i*)(lds + PG8_SB(b, h) + boff + n * 2048); dst[n].hi = *(const LAS v4i*)(lds + PG8_SB(b, h) + boff + n * 2048 + 1024); } } while (0)
#define PG8_MMA(ai, bj, At, Bt) do { __builtin_amdgcn_s_setprio(1); _Pragma("unroll") for (int m = 0; m < 4; ++m) _Pragma("unroll") for (int n = 0; n < 2; ++n) { \
        if constexpr (FP8) acc[ai][bj][m][n] = __builtin_amdgcn_mfma_scale_f32_16x16x128_f8f6f4(Bt[n], At[m], acc[ai][bj][m][n], 0, 0, 0, SCALE_W8, 0, SCALE_A8); \
        else { acc[ai][bj][m][n] = __builtin_amdgcn_mfma_f32_16x16x32_bf16(__builtin_bit_cast(bf16x8, (v4i)Bt[n].lo), __builtin_bit_cast(bf16x8, (v4i)At[m].lo), acc[ai][bj][m][n], 0, 0, 0); \
               acc[ai][bj][m][n] = __builtin_amdgcn_mfma_f32_16x16x32_bf16(__builtin_bit_cast(bf16x8, (v4i)Bt[n].hi), __builtin_bit_cast(bf16x8, (v4i)At[m].hi), acc[ai][bj][m][n], 0, 0, 0); } } \
        __builtin_amdgcn_s_setprio(0); } while (0)
#define PG8_WAIT_V(n) asm volatile("s_waitcnt vmcnt(" #n ")" ::: "memory")
#define PG8_WAIT_L(n) asm volatile("s_waitcnt lgkmcnt(" #n ")" ::: "memory")
#define PG8_BAR __builtin_amdgcn_s_barrier()
#define PG8_SCHED __builtin_amdgcn_sched_barrier(0)
    Unit cur, nxt; int ui = 0;
    if (!S.next(0, cur)) return;
    f32x4 acc[2][2][4][2];
#pragma unroll
    for (int a = 0; a < 2; ++a)
#pragma unroll
        for (int b = 0; b < 2; ++b)
#pragma unroll
            for (int m = 0; m < 4; ++m)
#pragma unroll
                for (int n = 0; n < 2; ++n) acc[a][b][m][n] = (f32x4){0.f, 0.f, 0.f, 0.f};
    v8i At[4], B0[2], B1[2];
    const char* cA = S.a_ptr(cur); const char* cB = S.b_ptr(cur);
    unsigned nvA[2][2];
    if constexpr (GATHER) S.a_off(cur, R0, C0, vA);
    PG8_STAGE(PG8_SB(0, 0), cB, voffB); PG8_STAGE(PG8_SB(0, 1), cB + hstep, voffB); PG8_STAGE(PG8_SA(0, 0), cA, vA[0]); PG8_STAGE(PG8_SA(0, 1), cA, vA[1]);
    if (wr == 1) PG8_BAR;
    PG8_WAIT_V(2); PG8_BAR;
    PG8_STAGE(PG8_SB(1, 0), cB + kstep, voffB); PG8_STAGE(PG8_SA(1, 0), cA + kstep, vA[0]); PG8_STAGE(PG8_SB(1, 1), cB + hstep + kstep, voffB);
    PG8_WAIT_V(6); PG8_BAR;
    for (;;) {
        const bool has_next = S.next(ui + 1, nxt);
        const char* nA = has_next ? S.a_ptr(nxt) : cA; const char* nB = has_next ? S.b_ptr(nxt) : cB;
        if constexpr (GATHER) { if (has_next) S.a_off(nxt, R0, C0, nvA); }
#pragma unroll 1
        for (int t = 0; t < NT; t += 2) {
            const bool last = (t == NT - 2);
            const char* a1 = cA + (size_t)(t + 1) * kstep;
            const char* a2 = last ? nA : cA + (size_t)(t + 2) * kstep; const char* b2 = last ? nB : cB + (size_t)(t + 2) * kstep;
            const char* a3 = a2 + kstep; const char* b3 = b2 + kstep;
            PG8_LDB(B0, 0, 0); PG8_LDB(B1, 0, 1); PG8_SCHED; PG8_LDA(At, 0, 0); PG8_STAGE(PG8_SA(1, 1), a1, vA[1]);
            if constexpr (GATHER) { if (last && has_next) {
#pragma unroll
                for (int h = 0; h < 2; ++h)
#pragma unroll
                    for (int i = 0; i < 2; ++i) vA[h][i] = nvA[h][i]; } }
            PG8_WAIT_V(8); PG8_WAIT_L(0); PG8_BAR; PG8_MMA(0, 0, At, B0); PG8_MMA(0, 1, At, B1); PG8_BAR; PG8_SCHED;
            PG8_LDA(At, 0, 1); PG8_STAGE(PG8_SB(0, 0), b2, voffB); PG8_STAGE(PG8_SB(0, 1), b2 + hstep, voffB); PG8_STAGE(PG8_SA(0, 0), a2, vA[0]);
            PG8_WAIT_V(8); PG8_WAIT_L(0); PG8_BAR; PG8_MMA(1, 0, At, B0); PG8_MMA(1, 1, At, B1); PG8_BAR; PG8_SCHED;
            PG8_LDB(B0, 1, 0); PG8_LDB(B1, 1, 1); PG8_SCHED; PG8_LDA(At, 1, 0); PG8_STAGE(PG8_SA(0, 1), a2, vA[1]);
            PG8_WAIT_V(8); PG8_WAIT_L(0); PG8_BAR; PG8_MMA(0, 0, At, B0); PG8_MMA(0, 1, At, B1); PG8_BAR; PG8_SCHED;
            PG8_LDA(At, 1, 1); PG8_STAGE(PG8_SB(1, 0), b3, voffB); PG8_STAGE(PG8_SB(1, 1), b3 + hstep, voffB); PG8_STAGE(PG8_SA(1, 0), a3, vA[0]);
            PG8_WAIT_V(8); PG8_WAIT_L(0); PG8_BAR; PG8_MMA(1, 0, At, B0); PG8_MMA(1, 1, At, B1); PG8_BAR; PG8_SCHED;
        }
        if (wr == 0) PG8_BAR;
        if constexpr (NOEPI) {
#pragma unroll
            for (int a = 0; a < 2; ++a)
#pragma unroll
                for (int b = 0; b < 2; ++b)
#pragma unroll
                    for (int m = 0; m < 4; ++m)
#pragma unroll
                        for (int n = 0; n < 2; ++n) asm volatile("" :: "v"(acc[a][b][m][n]));
        } else
        { int le; asm volatile("v_mbcnt_lo_u32_b32 %0, -1, 0\n\tv_mbcnt_hi_u32_b32 %0, -1, %0" : "=v"(le)); E(acc, cur, wr, wc, le & 15, le >> 4); }
        if (!has_next) break;
#pragma unroll
        for (int a = 0; a < 2; ++a)
#pragma unroll
            for (int b = 0; b < 2; ++b)
#pragma unroll
                for (int m = 0; m < 4; ++m)
#pragma unroll
                    for (int n = 0; n < 2; ++n) acc[a][b][m][n] = (f32x4){0.f, 0.f, 0.f, 0.f};
        cur = nxt; cA = nA; cB = nB; ++ui;
        if (wr == 1) PG8_BAR;
    }
    PG8_WAIT_V(0);
    PG8_BAR;
#undef PG8_SA
#undef PG8_SB
#undef PG8_STAGE
#undef PG8_LDA
#undef PG8_LDB
#undef PG8_MMA
#undef PG8_WAIT_V
#undef PG8_WAIT_L
#undef PG8_BAR
#undef PG8_SCHED
}

struct DenseSched {
    const char* A; const char* Bt; int nM, nN, nwg, G, c;
    __device__ __forceinline__ void init(const void* A_, const void* Bt_, int M, int N, int G_, int c_) { A = (const char*)A_; Bt = (const char*)Bt_; nM = M / BM; nN = N / BM; nwg = nM * nN; G = G_; c = c_; }
    __device__ __forceinline__ bool next(int i, Unit& u) const {
        const long L = (long)i * G + c; if (L >= nwg) return false;
        int wgid = (int)L; { const int q = nwg / NXCD, r = nwg % NXCD, xcd = wgid % NXCD, off = wgid / NXCD; wgid = (xcd < r ? xcd * (q + 1) : r * (q + 1) + (xcd - r) * q) + off; }
        const int nig = WGM * nN, gid = wgid / nig, fm = gid * WGM, gsz = (nM - fm) < WGM ? (nM - fm) : WGM;
        u.pm = fm + ((wgid % nig) % gsz); u.pn = (wgid % nig) / gsz; u.e = 0; u.nvalid = 256; u.sbase = 0; return true;
    }
    __device__ __forceinline__ const char* a_ptr(const Unit& u) const { return A + (size_t)u.pm * (BM * K * 2); }
    __device__ __forceinline__ const char* b_ptr(const Unit& u) const { return Bt + (size_t)u.pn * (BM * K * 2); }
    __device__ __forceinline__ void a_off(const Unit&, int, int, unsigned (&)[2][2]) const {}
};
template <int NPN, bool GATHER_A, int KB> struct MoeSched {
    const char* A; const char* Bt; const int* slot; const LAS int* tab; int G, c; size_t bstride;
    __device__ __forceinline__ bool next(int i, Unit& u) const {
        const int ntile = __builtin_amdgcn_readfirstlane(tab[32]);
        int mtg;
        if ((G & 7) == 0) { const int x = c & 7, j = (c >> 3) + (G >> 3) * i; u.pn = j % NPN; mtg = (j / NPN) * 8 + x; if (mtg >= ntile) return false; }
        else { const int lin = i * G + c; if (lin >= ntile * NPN) return false; u.pn = lin % NPN; mtg = lin / NPN; }
        int e = 0;
        while (e < 31 && __builtin_amdgcn_readfirstlane(tab[e + 1]) <= mtg) ++e;
        const int mtl = mtg - __builtin_amdgcn_readfirstlane(tab[e]); int nv = __builtin_amdgcn_readfirstlane(tab[33 + e]) - 256 * mtl; nv = nv > 256 ? 256 : nv;
        u.pm = mtg; u.e = e; u.nvalid = nv; u.sbase = e * CAP + 256 * mtl; return true;
    }
    __device__ __forceinline__ const char* a_ptr(const Unit& u) const { return GATHER_A ? A : A + (size_t)u.pm * (BM * KB); }
    __device__ __forceinline__ const char* b_ptr(const Unit& u) const { return Bt + (size_t)u.e * bstride + (size_t)u.pn * (BM * KB); }
    __device__ __forceinline__ void a_off(const Unit& u, int R0, int C0, unsigned (&v)[2][2]) const {
#pragma unroll
        for (int h = 0; h < 2; ++h)
#pragma unroll
            for (int i = 0; i < 2; ++i) { const int rl = h * 128 + R0 + 64 * i; const int id = (rl < u.nvalid) ? slot[u.sbase + rl] : 0; v[h][i] = (unsigned)(id >> 2) * (unsigned)KB + (unsigned)C0 * 2u; }
    }
};
}

struct EpiInProj {
    static constexpr bool PERM = true;
    unsigned char* ws; const float* tab; const float* rope; int layer;
    template <int TYPE> __device__ __forceinline__ void run(const f32x4 (&acc)[2][2][4][2], const pg8::Unit& u, int wr, int wc, int fr, int fq) const {
        asm volatile("" : "+v"(fr), "+v"(fq));
        const int pn = u.pn, pm = u.pm; const bool ctx = pm >= 128;
        const int bb = ctx ? (pm - 128) : (pm >> 6);
#pragma unroll
        for (int ai = 0; ai < 2; ++ai)
#pragma unroll
            for (int m = 0; m < 4; ++m) {
                const int rl = 128 * ai + 64 * wr + 16 * m + fr; const int row = pm * 256 + rl;
                const int tt = ctx ? rl : (row & (T - 1));
                const int Lk = ctx ? tt : 256 + tt; const int ktile = Lk >> 6, krr = Lk & 63;
#pragma unroll
                for (int bj = 0; bj < 2; ++bj) {
                    const int np = 256 * pn + 128 * bj + 32 * wc + 8 * fq;
                    f32x4 v0 = acc[ai][bj][m][0], v1 = acc[ai][bj][m][1];
                    bf16_t* dst;
                    if (TYPE == 0) {
                        const int dir = np >= 384, col = np - 384 * dir;
                        const f32x4 l0 = *(const f32x4*)(tab + TB_LBT + layer * 384 + col), l1 = *(const f32x4*)(tab + TB_LBT + layer * 384 + col + 4);
#pragma unroll
                        for (int q = 0; q < 4; ++q) { v0[q] = (1.f - l0[q]) * sigmoidf_(-v0[q]); v1[q] = (1.f - l1[q]) * sigmoidf_(-v1[q]); }
                        dst = (bf16_t*)(ws + WS_SCAN + (size_t)(dir ? SC_KB : SC_KF) * SCAN_PITCH) + (size_t)row * 384 + col;
                    } else if (TYPE == 1 || TYPE == 2) {
                        f32x4 cs = (f32x4){1.f, 1.f, 1.f, 1.f}, sn = (f32x4){0.f, 0.f, 0.f, 0.f}; float sc;
                        if (TYPE == 1) {
                            const int m2 = np - 768; const int isk = m2 >= 384, col = m2 - 384 * isk; const int w0 = col & 63;
                            if (!ctx) { cs = *(const f32x4*)(rope + (size_t)tt * 32 + (w0 >> 1)); sn = *(const f32x4*)(rope + (size_t)T * 32 + (size_t)tt * 32 + (w0 >> 1)); }
                            sc = isk ? 0.125f : 1.f;
                            dst = (bf16_t*)(ws + WS_SCAN + (size_t)(isk ? SC_RK : SC_RQ) * SCAN_PITCH) + (size_t)row * 384 + col;
                        } else {
                            const int m3 = np - 1536; const int isk = m3 >= 256, col = m3 - 256 * isk; const int map = col >> 5, w0 = col & 31;
                            if (!ctx) { const float* tb = (w0 < 16) ? (tab + TB_AXR + (tt >> 6) * 8 + (w0 >> 1)) : (tab + TB_AXC + (tt & 63) * 8 + ((w0 - 16) >> 1));
                                        const int so = (w0 < 16) ? 2048 : 512; cs = *(const f32x4*)tb; sn = *(const f32x4*)(tb + so); }
                            sc = isk ? 1.f : 0.17677669529663687f * LOG2E * 4.f;
                            if (isk) dst = (bf16_t*)(ws + WS_KA) + ((size_t)((bb * 8 + map) * KT_TILES + ktile) * 4 + (w0 >> 3)) * 512 + krr * 8;
                            else if (ctx) dst = (bf16_t*)(ws + WS_QC) + ((size_t)(bb * 8 + map) * CL + tt) * 32 + w0;
                            else dst = (bf16_t*)(ws + WS_QA) + ((size_t)(bb * 8 + map) * T + tt) * 32 + w0;
                        }
                        f32x4 o0, o1;
                        o0[0] = (v0[0] * cs[0] - v0[1] * sn[0]) * sc; o0[1] = (v0[1] * cs[0] + v0[0] * sn[0]) * sc;
                        o0[2] = (v0[2] * cs[1] - v0[3] * sn[1]) * sc; o0[3] = (v0[3] * cs[1] + v0[2] * sn[1]) * sc;
                        o1[0] = (v1[0] * cs[2] - v1[1] * sn[2]) * sc; o1[1] = (v1[1] * cs[2] + v1[0] * sn[2]) * sc;
                        o1[2] = (v1[2] * cs[3] - v1[3] * sn[3]) * sc; o1[3] = (v1[3] * cs[3] + v1[2] * sn[3]) * sc;
                        v0 = o0; v1 = o1;
                    } else {
                        const int m4 = np - 2048; const int seg = m4 / 384, col = m4 - 384 * seg;
                        if (m4 >= 2176) continue;
                        if (seg < 5) dst = (bf16_t*)(ws + WS_SCAN + (size_t)(SC_HQ + seg) * SCAN_PITCH) + (size_t)row * 384 + col;
                        else { const int h4 = col >> 6, w0 = col & 63;
                               const int k5 = krr & 31; unsigned char* vb = ws + WS_VA + (size_t)((bb * 4 + h4) * KT_TILES + ktile) * 4096 + (krr >> 5) * 2048 + (w0 >> 5) * 1024 + ((k5 >> 2) & 1) * 512 + (w0 & 31) * 16 + (k5 & 3) + 4 * (k5 >> 3);
                               const unsigned wa = pk4_fp8(v0[0] * 16.f, v0[1] * 16.f, v0[2] * 16.f, v0[3] * 16.f), wb = pk4_fp8(v1[0] * 16.f, v1[1] * 16.f, v1[2] * 16.f, v1[3] * 16.f);
#pragma unroll
                               for (int i = 0; i < 4; ++i) { vb[16 * i] = (unsigned char)(wa >> (8 * i)); vb[64 + 16 * i] = (unsigned char)(wb >> (8 * i)); }
                               continue; }
                    }
                    u32x4 w; w.x = cvt_pk_bf16(v0[0], v0[1]); w.y = cvt_pk_bf16(v0[2], v0[3]); w.z = cvt_pk_bf16(v1[0], v1[1]); w.w = cvt_pk_bf16(v1[2], v1[3]);
                    *(u32x4*)dst = w;
                }
                if (m == 3) asm volatile("" ::: "memory");
            }
    }
    __device__ __forceinline__ void operator()(const f32x4 (&acc)[2][2][4][2], const pg8::Unit& u, int wr, int wc, int fr, int fq) const {
        if (u.pn < 3) run<0>(acc, u, wr, wc, fr, fq); else if (u.pn < 6) run<1>(acc, u, wr, wc, fr, fq); else if (u.pn < 8) run<2>(acc, u, wr, wc, fr, fq); else run<3>(acc, u, wr, wc, fr, fq);
    }
};
template <bool NOST = false> struct EpiBf16OutT {
    static constexpr bool PERM = true;
    bf16_t* C;
    __device__ __forceinline__ void operator()(const f32x4 (&acc)[2][2][4][2], const pg8::Unit& u, int wr, int wc, int fr, int fq) const {
        asm volatile("" : "+v"(fr), "+v"(fq));
        const int row0 = u.pm * 256 + wr * 64 + fr, col0 = u.pn * 256 + wc * 32 + 8 * fq;
#pragma unroll
        for (int ai = 0; ai < 2; ++ai)
#pragma unroll
            for (int m = 0; m < 4; ++m) { bf16_t* rowp = C + (size_t)(row0 + ai * 128 + m * 16) * D + col0;
#pragma unroll
                for (int bj = 0; bj < 2; ++bj) { const f32x4 v0 = acc[ai][bj][m][0], v1 = acc[ai][bj][m][1];
                    u32x4 w; w.x = cvt_pk_bf16(v0[0], v0[1]); w.y = cvt_pk_bf16(v0[2], v0[3]); w.z = cvt_pk_bf16(v1[0], v1[1]); w.w = cvt_pk_bf16(v1[2], v1[3]);
                    if (NOST) asm volatile("" :: "v"(w)); else *(u32x4*)(rowp + bj * 128) = w; } }
    }
};
typedef EpiBf16OutT<false> EpiBf16Out;
struct EpiSwiglu {
    static constexpr bool PERM = true;
    unsigned char* act; const float* b1;
    __device__ __forceinline__ void operator()(const f32x4 (&acc)[2][2][4][2], const pg8::Unit& u, int wr, int wc, int fr, int fq) const {
        asm volatile("" : "+v"(fr), "+v"(fq));
        const int j0 = 128 * u.pn + 32 * wc + 8 * fq;
        const float* bp = b1 + (size_t)u.e * 2048 + 2 * j0;
        f32x4 bq[4];
#pragma unroll
        for (int q = 0; q < 4; ++q) bq[q] = *(const f32x4*)(bp + 4 * q);
#pragma unroll
        for (int ai = 0; ai < 2; ++ai)
#pragma unroll
            for (int m = 0; m < 4; ++m) {
                const int rl = 128 * ai + 64 * wr + 16 * m + fr;
                float o[8];
#pragma unroll
                for (int n = 0; n < 2; ++n)
#pragma unroll
                    for (int q = 0; q < 4; ++q) { const int j = 4 * n + q;
                        float g = acc[ai][0][m][n][q] + bq[j >> 1][(j & 1) * 2], l = acc[ai][1][m][n][q] + bq[j >> 1][(j & 1) * 2 + 1];
                        g = fminf(g, 7.f); l = fminf(fmaxf(l, -7.f), 7.f);
                        o[j] = g * sigmoidf_(1.702f * g) * (l + 1.f); }
                u32x2 w; w.x = pk4_fp8(o[0], o[1], o[2], o[3]); w.y = pk4_fp8(o[4], o[5], o[6], o[7]);
                *(u32x2*)(act + (size_t)(u.pm * 256 + rl) * 1024 + j0) = w;
            }
    }
};
template <int NOST = 0> struct EpiMoeOutT {
    static constexpr int PERM = 2;
    unsigned char* ys; const float* b2; const float* sgate;
    __device__ __forceinline__ void operator()(const f32x4 (&acc)[2][2][4][2], const pg8::Unit& u, int wr, int wc, int fr, int fq) const {
        asm volatile("" : "+v"(fr), "+v"(fq));
        const int c0 = 256 * u.pn + 64 * wc + 16 * fq;
        const float* bp = b2 + (size_t)u.e * 1024 + c0;
        f32x4 bv[4];
#pragma unroll
        for (int q = 0; q < 4; ++q) bv[q] = *(const f32x4*)(bp + 4 * q);
#pragma unroll
        for (int ai = 0; ai < 2; ++ai)
#pragma unroll
            for (int m = 0; m < 4; ++m) {
                const int rl = 128 * ai + 64 * wr + 16 * m + fr;
                const float g = (rl < u.nvalid) ? sgate[u.sbase + rl] * 16.f : 0.f;
                unsigned char* rowp = ys + (size_t)(u.pm * 256 + rl) * 1024 + c0;
                if (NOST == 2) rowp = ys - (WS_YK - WS_OSCR) + (size_t)(blockIdx.x * 64 + (rl & 63)) * 1024 + c0;
                u32x4 w;
#pragma unroll
                for (int bj = 0; bj < 2; ++bj)
#pragma unroll
                    for (int n = 0; n < 2; ++n) { const f32x4 v = (acc[ai][bj][m][n] + bv[2 * bj + n]) * g; w[2 * bj + n] = pk4_fp8(v[0], v[1], v[2], v[3]); }
                if (NOST == 1) asm volatile("" :: "v"(w)); else *(u32x4*)rowp = w;
            }
    }
};
typedef EpiMoeOutT<0> EpiMoeOut;

__device__ __forceinline__ int map_in(int n) {
    if (n < 384) return 2048 + n;
    if (n < 768) return n - 384;
    if (n < 1152) return 384 + (n - 768);
    if (n < 1536) return 2048 + 384 + (n - 1152);
    if (n < 1920) return 2048 + 768 + (n - 1536);
    if (n < 2688) { const int isk = n >= 2304; const int c = n - 1920 - 384 * isk; const int h = c >> 6, w = c & 63; const int wp = (w < 32) ? 2 * w : 2 * (w - 32) + 1; return 768 + 384 * isk + h * 64 + wp; }
    if (n < 3072) return 2048 + 1152 + (n - 2688);
    if (n < 3456) return 2048 + 1536 + (n - 3072);
    if (n < 3968) { const int isk = n >= 3712; const int c = n - 3456 - 256 * isk; const int h = c >> 5, w = c & 31; const int half = w >> 4, uu = w & 15; const int up = (uu < 8) ? 2 * uu : 2 * (uu - 8) + 1; return 1536 + 256 * isk + h * 32 + half * 16 + up; }
    return 2048 + 1920 + (n - 3968);
}
__device__ __forceinline__ int map_w1(int n) { const int j = n >> 1, lin = n & 1; return (j >> 7) * 256 + lin * 128 + (j & 127); }
template <int MAP> __device__ __forceinline__ void p0_transpose_item(const float* W, int Kd, int N, bf16_t* WT, LAS float* scr, int item, int lane) {
    const int nblk = N / 32, kb = item / nblk, nb = item % nblk, k0 = 64 * kb, n0 = 32 * nb;
    { f32x4 rv[8];
#pragma unroll
      for (int i = 0; i < 8; ++i) rv[i] = *(const f32x4*)(W + (size_t)(k0 + (lane >> 3) + 8 * i) * N + n0 + 4 * (lane & 7));
#pragma unroll
      for (int i = 0; i < 8; ++i) { LAS float* sp_ = scr + ((lane >> 3) + 8 * i) * 33 + 4 * (lane & 7); sp_[0] = rv[i][0]; sp_[1] = rv[i][1]; sp_[2] = rv[i][2]; sp_[3] = rv[i][3]; } }
    LDS_WAIT(); asm volatile("" ::: "memory");
    const int c = lane & 7;
#pragma unroll
    for (int j = 0; j < 4; ++j) { const int n = (lane >> 3) + 8 * j; const LAS float* s = scr + (8 * c) * 33 + n;
        u32x4 o; o.x = pk2(s[0 * 33], s[1 * 33]); o.y = pk2(s[2 * 33], s[3 * 33]); o.z = pk2(s[4 * 33], s[5 * 33]); o.w = pk2(s[6 * 33], s[7 * 33]);
        const int nn = n0 + n; const int dr = MAP == 1 ? map_in(nn) : (MAP == 2 ? map_w1(nn) : nn);
        *(u32x4*)(WT + (size_t)dr * Kd + k0 + 8 * c) = o; }
    LDS_WAIT(); asm volatile("" ::: "memory");
}
template <int MAP> __device__ __forceinline__ void p0_transpose_item_fp8(const float* W, int Kd, int N, unsigned char* WT, LAS float* scr, int item, int lane) {
    const int nblk = N / 32, kb = item / nblk, nb = item % nblk, k0 = 64 * kb, n0 = 32 * nb;
    { f32x4 rv[8];
#pragma unroll
      for (int i = 0; i < 8; ++i) rv[i] = *(const f32x4*)(W + (size_t)(k0 + (lane >> 3) + 8 * i) * N + n0 + 4 * (lane & 7));
#pragma unroll
      for (int i = 0; i < 8; ++i) { LAS float* sp_ = scr + ((lane >> 3) + 8 * i) * 33 + 4 * (lane & 7); sp_[0] = rv[i][0]; sp_[1] = rv[i][1]; sp_[2] = rv[i][2]; sp_[3] = rv[i][3]; } }
    LDS_WAIT(); asm volatile("" ::: "memory");
    const int n = lane >> 1, hf = lane & 1; const LAS float* sp = scr + (32 * hf) * 33 + n;
    u32x4 o0, o1;
#pragma unroll
    for (int q = 0; q < 4; ++q) { o0[q] = pk4_fp8(sp[(4 * q) * 33] * W8_MUL, sp[(4 * q + 1) * 33] * W8_MUL, sp[(4 * q + 2) * 33] * W8_MUL, sp[(4 * q + 3) * 33] * W8_MUL);
                                  o1[q] = pk4_fp8(sp[(16 + 4 * q) * 33] * W8_MUL, sp[(16 + 4 * q + 1) * 33] * W8_MUL, sp[(16 + 4 * q + 2) * 33] * W8_MUL, sp[(16 + 4 * q + 3) * 33] * W8_MUL); }
    const int nn = n0 + n; const int dr = MAP == 2 ? map_w1(nn) : nn;
    unsigned char* dp = WT + (size_t)dr * Kd + k0 + 32 * hf;
    *(u32x4*)dp = o0; *(u32x4*)(dp + 16) = o1;
    LDS_WAIT(); asm volatile("" ::: "memory");
}
struct P0Item { const float* W; int N, kind, l, e, k0, n0; };
__device__ __forceinline__ P0Item p0_decode(const Frame& F, int it) {
    constexpr int I_IN = 16 * 132, I_OUT = 16 * 32, I_W1 = 16 * 64, I_W2 = 16 * 32, PER_L = I_IN + I_OUT + NE * (I_W1 + I_W2);
    P0Item d; d.l = it / PER_L; int r = it % PER_L; d.e = 0; int item;
    if (r < I_IN) { d.kind = 0; d.N = 4224; d.W = F.in[7] + (size_t)d.l * 1024 * 4224; item = r; }
    else if (r < I_IN + I_OUT) { d.kind = 1; d.N = 1024; d.W = F.in[14] + (size_t)d.l * 1024 * 1024; item = r - I_IN; }
    else { r -= I_IN + I_OUT; d.e = r / (I_W1 + I_W2); r -= d.e * (I_W1 + I_W2);
        if (r < I_W1) { d.kind = 2; d.N = 2048; d.W = F.in[17] + ((size_t)d.l * NE + d.e) * 1024 * 2048; item = r; }
        else { d.kind = 3; d.N = 1024; d.W = F.in[19] + ((size_t)d.l * NE + d.e) * 1024 * 1024; item = r - I_W1; } }
    const int nblk = d.N / 32; d.k0 = 64 * (item / nblk); d.n0 = 32 * (item % nblk); return d;
}
__device__ __forceinline__ void p0_issue(const P0Item& d, int lane, f32x4 (&rv)[8]) {
#pragma unroll
    for (int i = 0; i < 8; ++i) rv[i] = *(const f32x4*)(d.W + (size_t)(d.k0 + (lane >> 3) + 8 * i) * d.N + d.n0 + 4 * (lane & 7));
}
__device__ __forceinline__ void p0_finish(const Frame& F, const P0Item& d, LAS float* scr, int lane, const f32x4 (&rv)[8]) {
#pragma unroll
    for (int i = 0; i < 8; ++i) { LAS float* sp_ = scr + ((lane >> 3) + 8 * i) * 33 + 4 * (lane & 7); sp_[0] = rv[i][0]; sp_[1] = rv[i][1]; sp_[2] = rv[i][2]; sp_[3] = rv[i][3]; }
    LDS_WAIT(); asm volatile("" ::: "memory");
    if (d.kind < 2) {
        bf16_t* WT = d.kind == 0 ? (bf16_t*)(F.ws + WS_WIN) + (size_t)d.l * NIN * 1024 : (bf16_t*)(F.ws + WS_WOUT) + (size_t)d.l * 1024 * 1024;
        const int c = lane & 7;
#pragma unroll
        for (int j = 0; j < 4; ++j) { const int n = (lane >> 3) + 8 * j; const LAS float* s_ = scr + (8 * c) * 33 + n;
            u32x4 o; o.x = pk2(s_[0 * 33], s_[1 * 33]); o.y = pk2(s_[2 * 33], s_[3 * 33]); o.z = pk2(s_[4 * 33], s_[5 * 33]); o.w = pk2(s_[6 * 33], s_[7 * 33]);
            const int nn = d.n0 + n; const int dr = d.kind == 0 ? map_in(nn) : nn;
            *(u32x4*)(WT + (size_t)dr * 1024 + d.k0 + 8 * c) = o; }
    } else {
        unsigned char* WT = d.kind == 2 ? F.ws + WS_W1 + ((size_t)d.l * NE + d.e) * 2048 * 1024 : F.ws + WS_W2 + ((size_t)d.l * NE + d.e) * 1024 * 1024;
        const int n = lane >> 1, hf = lane & 1; const LAS float* sp = scr + (32 * hf) * 33 + n;
        u32x4 o0, o1;
#pragma unroll
        for (int q = 0; q < 4; ++q) { o0[q] = pk4_fp8(sp[(4 * q) * 33] * W8_MUL, sp[(4 * q + 1) * 33] * W8_MUL, sp[(4 * q + 2) * 33] * W8_MUL, sp[(4 * q + 3) * 33] * W8_MUL);
                                      o1[q] = pk4_fp8(sp[(16 + 4 * q) * 33] * W8_MUL, sp[(16 + 4 * q + 1) * 33] * W8_MUL, sp[(16 + 4 * q + 2) * 33] * W8_MUL, sp[(16 + 4 * q + 3) * 33] * W8_MUL); }
        const int nn = d.n0 + n; const int dr = d.kind == 2 ? map_w1(nn) : nn;
        unsigned char* dp = WT + (size_t)dr * 1024 + d.k0 + 32 * hf;
        *(u32x4*)dp = o0; *(u32x4*)(dp + 16) = o1;
    }
    LDS_WAIT(); asm volatile("" ::: "memory");
}
#ifndef P0_QA
#define P0_QA 8
#endif
#ifndef P0_QC
#define P0_QC 56
#endif
#ifndef P0_QI
#define P0_QI 6
#endif
#ifndef P0_QO
#define P0_QO 6
#endif
constexpr int P0_NFIX = 16 * 132 + 16 * 32, P0_NMOE = NE * (16 * 64 + 16 * 32), P0_PER_L = P0_NFIX + P0_NMOE;
struct P0Split { int thrA, idleA, NA, thrC, idleC, NC, thrI, shortI, NI, thrO, shortO, NO; };
__device__ __forceinline__ int p0_min(int a, int b) { return a < b ? a : b; }
__device__ __forceinline__ P0Split p0_split(int G, int layer) {
    P0Split p; const int NGW = G * NWAVES, UA = NSEQ * NSC, RA = (UA + NGW - 1) / NGW, UC = 24 * NSC, RC = (UC + NGW - 1) / NGW;
    p.thrA = UA - (RA - 1) * NGW; p.idleA = NGW - p.thrA; p.thrC = UC - (RC - 1) * NGW; p.idleC = NGW - p.thrC;
    const int nI = (NROW / 256) * (NIN / 256), rI = (nI + G - 1) / G, nO = ((layer == 0 ? NROW : NLAT) / 256) * 4, rO = (nO + G - 1) / G;
    p.thrI = nI - (rI - 1) * G; p.shortI = G - p.thrI; p.thrO = nO - (rO - 1) * G; p.shortO = G - p.thrO;
    int left = P0_NMOE;
    p.NA = p0_min(p.idleA * P0_QA, left); left -= p.NA; p.NC = p0_min(p.idleC * P0_QC, left); left -= p.NC;
    p.NI = p0_min(p.shortI * NWAVES * P0_QI, left); left -= p.NI; p.NO = p0_min(p.shortO * NWAVES * P0_QO, left); return p;
}
__device__ __forceinline__ void p0_run(const Frame& F, LAS float* scr, int lane, int base, int first, int step, int limit) {
    if (step <= 0) return;
    int v = first; if (v >= limit) return;
    P0Item cur = p0_decode(F, base + v), nxt = cur; f32x4 ra[8], rb[8];
    p0_issue(cur, lane, ra);
    for (; v < limit; v += step) {
        const bool hn = v + step < limit;
        if (hn) { nxt = p0_decode(F, base + v + step); p0_issue(nxt, lane, rb); }
        p0_finish(F, cur, scr, lane, ra);
        if (hn) { cur = nxt;
#pragma unroll
            for (int i = 0; i < 8; ++i) ra[i] = rb[i]; }
    }
}
__device__ __forceinline__ void phase_prologue_a(Frame& F) {
    PHASE_IDS();
    LAS float* scr = (LAS float*)(F.lds + wave * 16384);
    const int gw = blk_ * NWAVES + wave, NGW = F.G * NWAVES;
    unsigned char* ws = F.ws;
    for (int l = 0; l < 2; ++l) { const P0Split sp = p0_split(F.G, l); const int done = sp.NA + sp.NC + sp.NI + sp.NO, rem = P0_NMOE - done;
        p0_run(F, scr, lane, l * P0_PER_L, gw, NGW, P0_NFIX);
        p0_run(F, scr, lane, l * P0_PER_L + P0_NFIX + done, gw, NGW, rem); }
    for (int i = gw * 64 + lane; i < 2 * 128 * 1024 / 8; i += NGW * 64) { const int l = i / (128 * 128), rr = i % (128 * 128);
        *(u32x4*)((bf16_t*)(ws + WS_WIN) + ((size_t)l * NIN + 4224) * 1024 + (size_t)rr * 8) = (u32x4){0u, 0u, 0u, 0u}; }
    { LAS float* part = (LAS float*)(F.lds + 131072);
      for (int it = blk_; it < 2 * 96; it += F.G) {
        const int l = it / 96, n0 = (it % 96) * 64, n = n0 + lane;
        const float* mw = F.in[4] + (size_t)l * 1024 * 6144 + (size_t)(128 * wave) * 6144 + n;
        float a0 = 0.f, a1 = 0.f, a2 = 0.f;
#pragma unroll 1
        for (int kb = 0; kb < 2; ++kb) {
            const int kk = 128 * wave + 64 * kb + lane;
            float c0 = F.in[1][kk], c1 = F.in[1][1024 + kk], c2 = F.in[3][kk];
            c0 = c0 * sigmoidf_(c0); c1 = c1 * sigmoidf_(c1); c2 = c2 * sigmoidf_(c2);
#pragma unroll 1
            for (int j0 = 0; j0 < 64; j0 += 16) { float wv[16];
#pragma unroll
                for (int j = 0; j < 16; ++j) wv[j] = mw[(size_t)(64 * kb + j0 + j) * 6144];
#pragma unroll
                for (int j = 0; j < 16; ++j) { a0 += rdlane(c0, j0 + j) * wv[j]; a1 += rdlane(c1, j0 + j) * wv[j]; a2 += rdlane(c2, j0 + j) * wv[j]; } }
        }
        part[(wave * 3 + 0) * 64 + lane] = a0; part[(wave * 3 + 1) * 64 + lane] = a1; part[(wave * 3 + 2) * 64 + lane] = a2;
        __syncthreads();
        if (wave == 0) {
            float vals[3];
#pragma unroll
            for (int w = 0; w < 3; ++w) { float sacc = 0.f;
#pragma unroll
                for (int q = 0; q < 8; ++q) sacc += part[(q * 3 + w) * 64 + lane]; vals[w] = sacc + F.in[5][l * 6144 + n]; }
            const int ch = n >> 10, col = n & 1023;
            const float* ng = F.in[6] + (size_t)l * 4096;
#pragma unroll
            for (int w = 0; w < 3; ++w) { float v = vals[w];
                if (ch == 1) v = (1.f + v) * ng[col]; else if (ch == 2) v = v * ng[1024 + col]; else if (ch == 4) v = (1.f + v) * ng[2048 + col]; else if (ch == 5) v = v * ng[3072 + col];
                const int slot = (ch == 0) ? 1 : (ch == 1) ? 0 : (ch == 2) ? 2 : (ch == 3) ? 4 : (ch == 4) ? 3 : 5;
                ((float*)(ws + WS_MODV))[((size_t)(l * 3 + w) * 6 + slot) * 1024 + col] = v; }
        }
        __syncthreads();
      } }
    float* tab = (float*)(ws + WS_TAB);
    const int gt = blk_ * NTHR + tid, NGT = F.G * NTHR;
    for (int i = gt; i < 2 * 384; i += NGT) { const int l = i / 384, c = i % 384; const float a = F.in[8][c], b = F.in[8][384 + c];
        tab[TB_LBT + i] = (l == 0) ? 0.f : 1.f / (1.f + expf(a - b)); }
    if (gt < 2) { const int l = gt; const float* lm = F.in[12] + l * 128; float s0 = 0.f, s1 = 0.f;
        for (int i = 0; i < 32; ++i) { s0 += lm[i] * lm[32 + i]; s1 += lm[64 + i] * lm[96 + i]; }
        const float li = 0.8f - 0.6f * expf(-0.3f * (float)l);
        tab[TB_LAM + l] = expf(s0) - expf(s1) + li; tab[TB_LAM + 2 + l] = 1.f - li; }
    if (gt < 24) tab[TB_GAM + gt] = 1.f - exp2f(-F.in[10][gt]);
    for (int i = gt; i < 256 * 8 + 64 * 8; i += NGT) {
        const bool isr = i < 2048; const int ii = isr ? i : i - 2048; const int pos = ii >> 3, j = ii & 7;
        const float inv = exp2f(-(float)j * (13.287712379549449f / 8.f));
        const double rev = (double)pos * (double)inv * 0.15915494309189535; const float fr = (float)(rev - floor(rev));
        const float cs = __builtin_amdgcn_cosf(fr), sn = __builtin_amdgcn_sinf(fr);
        if (isr) { tab[TB_AXR + ii] = cs; tab[TB_AXR + 2048 + ii] = sn; } else { tab[TB_AXC + ii] = cs; tab[TB_AXC + 512 + ii] = sn; }
    }
    float* rope = (float*)(ws + WS_ROPE);
    for (int i = gt; i < T * 32; i += NGT) { const int pos = i >> 5, j = i & 31;
        const float inv = exp2f(-(float)j * (13.287712379549449f / 32.f));
        const double rev = (double)pos * (double)inv * 0.15915494309189535; const float fr = (float)(rev - floor(rev));
        rope[i] = __builtin_amdgcn_cosf(fr); rope[(size_t)T * 32 + i] = __builtin_amdgcn_sinf(fr); }
    bf16_t* rwh = (bf16_t*)(ws + WS_RWT); bf16_t* rwl = rwh + 2 * 32 * 1024;
    for (int i = gt; i < 2 * 32 * 1024; i += NGT) { const int l = i >> 15, e = (i >> 10) & 31, c = i & 1023; const float wv = F.in[15][((size_t)l * 1024 + c) * 32 + e];
        const unsigned hb = f2bf(wv); rwh[i] = (bf16_t)hb; rwl[i] = (bf16_t)f2bf(wv - __builtin_bit_cast(float, hb << 16)); }
}

__device__ __forceinline__ float row_sumsq(const f32x4 (&v)[4]) {
    float s = 0.f;
#pragma unroll
    for (int j = 0; j < 4; ++j) s += (v[j][0] * v[j][0] + v[j][1] * v[j][1]) + (v[j][2] * v[j][2] + v[j][3] * v[j][3]);
    return wave_sum(s);
}
__device__ __forceinline__ void row_load(const float* p, int lane, f32x4 (&v)[4]) {
#pragma unroll
    for (int j = 0; j < 4; ++j) v[j] = *(const f32x4*)(p + 4 * lane + 256 * j);
}
__device__ __forceinline__ void row_store(float* p, int lane, const f32x4 (&v)[4]) {
#pragma unroll
    for (int j = 0; j < 4; ++j) *(f32x4*)(p + 4 * lane + 256 * j) = v[j];
}
__device__ __forceinline__ void row_store_bf16(bf16_t* p, int lane, const f32x4 (&v)[4]) {
#pragma unroll
    for (int j = 0; j < 4; ++j) { u32x2 w; w.x = pk2(v[j][0], v[j][1]); w.y = pk2(v[j][2], v[j][3]); *(u32x2*)(p + 4 * lane + 256 * j) = w; }
}
__device__ __forceinline__ void row_load_bf16(const bf16_t* p, int lane, f32x4 (&v)[4]) {
#pragma unroll
    for (int j = 0; j < 4; ++j) { const u32x2 w = *(const u32x2*)(p + 4 * lane + 256 * j); v[j] = (f32x4){bflo(w.x), bfhi(w.x), bflo(w.y), bfhi(w.y)}; }
}
__device__ __forceinline__ int row_which(int r) { return r < NLAT ? (r >> 14) : 2; }
__device__ __forceinline__ void row_norm_mod(const f32x4 (&x)[4], const float* a, const float* b, int lane, f32x4 (&o)[4]) {
    const float r = __builtin_amdgcn_rsqf(row_sumsq(x) * (1.f / 1024.f) + EPS);
#pragma unroll
    for (int j = 0; j < 4; ++j) { const f32x4 av = *(const f32x4*)(a + 4 * lane + 256 * j), bv = *(const f32x4*)(b + 4 * lane + 256 * j); o[j] = x[j] * r * av + bv; }
}
__device__ __forceinline__ void phase_prologue_b(Frame& F) {
    PHASE_IDS();
    const int gw = blk_ * NWAVES + wave, NGW = F.G * NWAVES;
    const float* modv = (const float*)(F.ws + WS_MODV);
    f32x4 xc[4], xn[4];
    if (gw < NROW) row_load(gw < NLAT ? F.in[0] + (size_t)gw * D : F.in[2] + (size_t)(gw - NLAT) * D, lane, xc);
    for (int r = gw; r < NROW; r += NGW) {
        const int rn = r + NGW;
        if (rn < NROW) row_load(rn < NLAT ? F.in[0] + (size_t)rn * D : F.in[2] + (size_t)(rn - NLAT) * D, lane, xn);
        const int w = row_which(r);
        f32x4 o[4];
        row_norm_mod(xc, modv + (size_t)(0 * 3 + w) * 6 * 1024, modv + ((size_t)(0 * 3 + w) * 6 + 1) * 1024, lane, o);
        row_store_bf16((bf16_t*)(F.ws + WS_H) + (size_t)r * D, lane, o);
#pragma unroll
        for (int j = 0; j < 4; ++j) xc[j] = xn[j];
    }
}

__device__ __forceinline__ int scan_row(int sc, int p, int dir, int b) {
    if (sc == 0) return NLAT + b * CL + (dir ? (CL - 1 - p) : p);
    const int tt = (sc - 1) * 256 + p; return b * T + (dir ? (T - 1 - tt) : tt);
}
template <int TYPE, bool WITHQ>
__device__ __forceinline__ float scan_step(float (&S)[64], const LAS float* kq, float vv, float gam) {
    float o = 0.f;
#pragma unroll
    for (int kg = 0; kg < 8; ++kg) {
        f32x4 kv[2], qv[2];
#pragma unroll
        for (int j = 0; j < 2; ++j) { kv[j] = *(const LAS f32x4*)(kq + kg * 8 + 4 * j); if (WITHQ) qv[j] = *(const LAS f32x4*)(kq + 64 + kg * 8 + 4 * j); }
#pragma unroll
        for (int j = 0; j < 8; ++j) { const int k = kg * 8 + j; const float kk = kv[j >> 2][j & 3];
            if (TYPE == 0) S[k] = __builtin_fmaf(kk, vv - S[k], S[k]); else S[k] = __builtin_fmaf(kk, vv, gam * S[k]);
            if (WITHQ) o = __builtin_fmaf(qv[j >> 2][j & 3], S[k], o); }
        asm volatile("" ::: "memory"); __builtin_amdgcn_sched_barrier(0);
    }
    return o;
}
__device__ __forceinline__ void phase_scan_a(Frame& F, int layer) {
    PHASE_IDS();
    const int gw = blk_ * NWAVES + wave, NGW = F.G * NWAVES;
    const float* tab = (const float*)(F.ws + WS_TAB);
    LAS float* scr = (LAS float*)(F.lds + wave * 2048);
    for (int wu = gw; wu < NSEQ * NSC; wu += NGW) {
        const int s = wu / NSC, sc = wu % NSC; const int type = s / 24, rem = s % 24, b = rem / 12, h = (rem % 12) >> 1, dir = rem & 1;
        const bf16_t* Kb = (const bf16_t*)(F.ws + WS_SCAN + (size_t)(type ? SC_RK : (dir ? SC_KB : SC_KF)) * SCAN_PITCH);
        const bf16_t* Vb = (const bf16_t*)(F.ws + WS_SCAN + (size_t)(type ? SC_RV : SC_HV) * SCAN_PITCH);
        unsigned co = (unsigned)(h * 64 + lane); asm volatile("" : "+v"(co));
        const float gam = tab[TB_GAM + layer * 12 + dir * 6 + h];
        float S[64];
#pragma unroll
        for (int k = 0; k < 64; ++k) S[k] = 0.f;
        float dprod = 1.f;
        float kc[4], vc[4], kn[4], vn[4];
#pragma unroll
        for (int i = 0; i < 4; ++i) { const unsigned ro = (unsigned)scan_row(sc, i, dir, b) * 384u + co; kc[i] = bf2f(Kb[ro]); vc[i] = bf2f(Vb[ro]); kn[i] = 0.f; vn[i] = 0.f; }
        for (int p0 = 0; p0 < 256; p0 += 4) {
            if (p0 + 4 < 256) {
#pragma unroll
                for (int i = 0; i < 4; ++i) { const unsigned ro = (unsigned)scan_row(sc, p0 + 4 + i, dir, b) * 384u + co; kn[i] = bf2f(Kb[ro]); vn[i] = bf2f(Vb[ro]); }
            }
#pragma unroll
            for (int i = 0; i < 4; ++i) scr[i * 128 + lane] = kc[i];
#pragma unroll
            for (int i = 0; i < 4; ++i) {
                if (type == 0) { dprod *= (1.f - kc[i]); (void)scan_step<0, false>(S, scr + i * 128, vc[i], gam); }
                else { dprod *= gam; (void)scan_step<1, false>(S, scr + i * 128, vc[i], gam); }
            }
#pragma unroll
            for (int i = 0; i < 4; ++i) { kc[i] = kn[i]; vc[i] = vn[i]; }
        }
        float* sl = (float*)(F.ws + WS_SLOC) + (size_t)wu * 4096 + lane;
#pragma unroll
        for (int k = 0; k < 64; ++k) { *sl = S[k]; sl += 64; asm volatile("" : "+v"(sl)); }
        ((float*)(F.ws + WS_DEC))[(size_t)wu * 64 + lane] = dprod;
    }
}
__device__ __forceinline__ void phase_scan_b(Frame& F) {
    const float* sloc = (const float*)(F.ws + WS_SLOC); const float* dec = (const float*)(F.ws + WS_DEC); float* sin_ = (float*)(F.ws + WS_SIN);
    PHASE_IDS();
    if (tid < 384) for (int idx = blk_ * 384 + tid; idx < NSEQ * 2048; idx += F.G * 384) {
        const int s = idx >> 11, kv = (idx & 2047) * 2, k = kv >> 6; f32x2 st = {0.f, 0.f};
        const float* dp = dec + (size_t)s * NSC * 64 + k; const float* sp = sloc + (size_t)s * NSC * 4096 + kv; float* op = sin_ + ((size_t)s * NSC + 1) * 4096 + kv;
#pragma unroll 1
        for (int c0 = 0; c0 < NSC - 1; c0 += 16) {
            float d[16]; f32x2 v[16];
#pragma unroll
            for (int i = 0; i < 16; ++i) { d[i] = dp[(c0 + i) * 64]; v[i] = *(const f32x2*)(sp + (size_t)(c0 + i) * 4096); }
#pragma unroll
            for (int i = 0; i < 16; ++i) { st = st * d[i] + v[i]; *(f32x2*)(op + (size_t)(c0 + i) * 4096) = st; }
        }
    }
}
template <int TYPE, bool SECOND>
__device__ __forceinline__ void scan_dir(Frame& F, int lane_in, int wave, int layer, int b, int h, int dir, int sc, bool zero_state) {
    int lane = lane_in; asm volatile("" : "+v"(lane));
    const float* tab = (const float*)(F.ws + WS_TAB);
    const int s = TYPE * 24 + b * 12 + h * 2 + dir;
    const bf16_t* Kb = (const bf16_t*)(F.ws + WS_SCAN + (size_t)(TYPE ? SC_RK : (dir ? SC_KB : SC_KF)) * SCAN_PITCH);
    const bf16_t* Vb = (const bf16_t*)(F.ws + WS_SCAN + (size_t)(TYPE ? SC_RV : SC_HV) * SCAN_PITCH);
    const bf16_t* Qb = (const bf16_t*)(F.ws + WS_SCAN + (size_t)(TYPE ? SC_RQ : SC_HQ) * SCAN_PITCH);
    const bf16_t* Gb = (const bf16_t*)(F.ws + WS_SCAN + (size_t)(TYPE ? SC_RG : SC_HG) * SCAN_PITCH);
    float* oscr = (float*)(F.ws + WS_OSCR);
    bf16_t* mix = (bf16_t*)(F.ws + WS_MIX);
    unsigned co = (unsigned)(h * 64 + lane); asm volatile("" : "+v"(co));
    const unsigned co2 = co + TYPE * 384;
    const float gam = tab[TB_GAM + layer * 12 + dir * 6 + h];
    const float nw = F.in[TYPE ? 11 : 9][layer * 64 + lane];
    LAS float* scr = (LAS float*)(F.lds + wave * 2048);
    float S[64];
    if (zero_state) {
#pragma unroll
        for (int k = 0; k < 64; ++k) S[k] = 0.f;
    } else { const float* si = (const float*)(F.ws + WS_SIN) + ((size_t)s * NSC + sc) * 4096 + lane;
#pragma unroll
        for (int k = 0; k < 64; ++k) { S[k] = *si; si += 64; asm volatile("" : "+v"(si)); } }
    float kc[2], vc[2], qc[2], kn[2], vn[2], qn[2];
#pragma unroll
    for (int i = 0; i < 2; ++i) { const unsigned ro = (unsigned)scan_row(sc, i, dir, b) * 384u + co; kc[i] = bf2f(Kb[ro]); vc[i] = bf2f(Vb[ro]); qc[i] = bf2f(Qb[ro]); kn[i] = 0.f; vn[i] = 0.f; qn[i] = 0.f; }
    for (int p0 = 0; p0 < 256; p0 += 2) {
        if (p0 + 2 < 256) {
#pragma unroll
            for (int i = 0; i < 2; ++i) { const unsigned ro = (unsigned)scan_row(sc, p0 + 2 + i, dir, b) * 384u + co; kn[i] = bf2f(Kb[ro]); vn[i] = bf2f(Vb[ro]); qn[i] = bf2f(Qb[ro]); }
        }
#pragma unroll
        for (int i = 0; i < 2; ++i) { scr[i * 128 + lane] = kc[i]; scr[i * 128 + 64 + lane] = qc[i]; }
#pragma unroll
        for (int i = 0; i < 2; ++i) {
            float o = scan_step<TYPE, true>(S, scr + i * 128, vc[i], gam);
            const unsigned row = (unsigned)scan_row(sc, p0 + i, dir, b);
            if (!SECOND) oscr[row * 768u + co2] = o;
            else { o += oscr[row * 768u + co2];
                const float r = __builtin_amdgcn_rsqf(wave_sum_dpp(o * o) * (1.f / 64.f) + EPS);
                const float g = bf2f(Gb[row * 384u + co]);
                mix[row * 1024u + co2] = (bf16_t)f2bf(o * r * nw * g * sigmoidf_(g)); }
            asm volatile("" ::: "memory");
        }
#pragma unroll
        for (int i = 0; i < 2; ++i) { kc[i] = kn[i]; vc[i] = vn[i]; qc[i] = qn[i]; }
    }
}
__device__ __forceinline__ void phase_scan_c(Frame& F, int layer) {
    PHASE_IDS();
    const int gw = blk_ * NWAVES + wave, NGW = F.G * NWAVES;
    const bool need_ctx = layer == 0;
    for (int wu = gw; wu < 24 * NSC; wu += NGW) {
        const int sq = wu / NSC, blk = wu % NSC; const int type = sq / 12, b = (sq % 12) / 6, h = sq % 6;
        if (blk == 0 && !need_ctx) continue;
        const int scf = blk, scb = (blk == 0) ? 0 : 65 - blk;
        if (type == 0) { scan_dir<0, false>(F, lane, wave, layer, b, h, 0, scf, scf == 0); scan_dir<0, true>(F, lane, wave, layer, b, h, 1, scb, scb == 0); }
        else           { scan_dir<1, false>(F, lane, wave, layer, b, h, 0, scf, scf == 0); scan_dir<1, true>(F, lane, wave, layer, b, h, 1, scb, scb == 0); }
    }
}


namespace sc2 {
constexpr int WLDS = 8448;
__device__ __forceinline__ f32x4 mfma16(bf16x8 a, bf16x8 b, f32x4 c) { return __builtin_amdgcn_mfma_f32_16x16x32_bf16(a, b, c, 0, 0, 0); }
template <int TYPE, int MODE>
__device__ __forceinline__ void run(Frame& F, int lane_in, int wave, int layer, int b, int h, int dir, int sc, bool zero_state, int wu_out) {
    int lane = lane_in; asm volatile("" : "+v"(lane));
    const int g = lane >> 4, n = lane & 15;
    const float* tab = (const float*)(F.ws + WS_TAB);
    const int s = TYPE * 24 + b * 12 + h * 2 + dir;
    const bf16_t* Kb = (const bf16_t*)(F.ws + WS_SCAN + (size_t)(TYPE ? SC_RK : (dir ? SC_KB : SC_KF)) * SCAN_PITCH);
    const bf16_t* Vb = (const bf16_t*)(F.ws + WS_SCAN + (size_t)(TYPE ? SC_RV : SC_HV) * SCAN_PITCH);
    const bf16_t* Qb = (const bf16_t*)(F.ws + WS_SCAN + (size_t)(TYPE ? SC_RQ : SC_HQ) * SCAN_PITCH);
    const bf16_t* Gb = (const bf16_t*)(F.ws + WS_SCAN + (size_t)(TYPE ? SC_RG : SC_HG) * SCAN_PITCH);
    float* oscr = (float*)(F.ws + WS_OSCR);
    bf16_t* mix = (bf16_t*)(F.ws + WS_MIX);
    const unsigned co = (unsigned)(h * 64 + lane);
    const float lg2 = TYPE ? __builtin_amdgcn_logf(tab[TB_GAM + layer * 12 + dir * 6 + h]) : 0.f;
    LAS unsigned char* wl = F.lds + wave * WLDS;
    LAS bf16_t* QT = (LAS bf16_t*)wl; LAS bf16_t* KT = (LAS bf16_t*)(wl + 2048); LAS bf16_t* KPT = (LAS bf16_t*)(wl + 4096); LAS bf16_t* VT = (LAS bf16_t*)(wl + 6144); LAS float* DD = (LAS float*)(wl + 8192);
    f32x4 S[4][4];
    if (zero_state) {
#pragma unroll
        for (int kb = 0; kb < 4; ++kb)
#pragma unroll
            for (int vb = 0; vb < 4; ++vb) S[kb][vb] = (f32x4){0.f, 0.f, 0.f, 0.f};
    } else { const float* si = (const float*)(F.ws + WS_SIN) + ((size_t)s * NSC + sc) * 4096;
#pragma unroll
        for (int kb = 0; kb < 4; ++kb)
#pragma unroll
            for (int vb = 0; vb < 4; ++vb)
#pragma unroll
                for (int r = 0; r < 4; ++r) S[kb][vb][r] = si[(16 * kb + 4 * g + r) * 64 + 16 * vb + n]; }
    float dtot = 1.f;
    const float gam = TYPE ? tab[TB_GAM + layer * 12 + dir * 6 + h] : 0.f;
    unsigned short kr[16], vr[16], qr[16];
#pragma unroll
    for (int t = 0; t < 16; ++t) { const unsigned ro = (unsigned)scan_row(sc, t, dir, b) * 384u + co; kr[t] = Kb[ro]; vr[t] = Vb[ro]; if (MODE != 0) qr[t] = Qb[ro]; else qr[t] = 0; }
    for (int blk = 0; blk < 16; ++blk) {
        const unsigned row = (unsigned)scan_row(sc, 16 * blk + n, dir, b);
        const unsigned ob = row * 768u + (unsigned)(TYPE * 384 + h * 64 + 4 * g);
        f32x4 of[4]; u32x2 gg[4];
        if (MODE == 2) {
#pragma unroll
            for (int vb = 0; vb < 4; ++vb) { of[vb] = *(const f32x4*)(oscr + ob + 16 * vb); gg[vb] = *(const u32x2*)(Gb + row * 384u + (unsigned)(h * 64 + 16 * vb + 4 * g)); }
        }
        float ek[16]; float eq = 1.f;
#pragma unroll
        for (int t = 0; t < 16; ++t) { const float kk = bf2f(kr[t]);
            eq = fmaxf(eq * (TYPE == 0 ? 1.f - kk : gam), 7.9e-31f);
            ek[t] = __builtin_amdgcn_rcpf(eq);
            if (MODE != 0) { const unsigned w_ = cvt_pk_bf16(bf2f(qr[t]) * eq, kk * ek[t]); QT[t * 64 + lane] = (bf16_t)(w_ & 0xffffu); KT[t * 64 + lane] = (bf16_t)(w_ >> 16); } }
        dtot *= eq; DD[lane] = eq;
        { u32x4 w0, w1, x0, x1;
#pragma unroll
          for (int q = 0; q < 4; ++q) {
              w0[q] = cvt_pk_bf16(bf2f(kr[2 * q]) * (eq * ek[2 * q]), bf2f(kr[2 * q + 1]) * (eq * ek[2 * q + 1]));
              w1[q] = cvt_pk_bf16(bf2f(kr[8 + 2 * q]) * (eq * ek[8 + 2 * q]), bf2f(kr[8 + 2 * q + 1]) * (eq * ek[8 + 2 * q + 1]));
              x0[q] = (unsigned)vr[2 * q] | ((unsigned)vr[2 * q + 1] << 16); x1[q] = (unsigned)vr[8 + 2 * q] | ((unsigned)vr[8 + 2 * q + 1] << 16); }
          *(LAS u32x4*)(KPT + lane * 16) = w0; *(LAS u32x4*)(KPT + lane * 16 + 8) = w1; *(LAS u32x4*)(VT + lane * 16) = x0; *(LAS u32x4*)(VT + lane * 16 + 8) = x1; }
        if (blk + 1 < 16) {
#pragma unroll
            for (int t = 0; t < 16; ++t) { const unsigned ro = (unsigned)scan_row(sc, 16 * (blk + 1) + t, dir, b) * 384u + co; kr[t] = Kb[ro]; vr[t] = Vb[ro]; if (MODE != 0) qr[t] = Qb[ro]; }
        }
        asm volatile("s_waitcnt lgkmcnt(0)" ::: "memory");
        if (MODE != 0) {
            f32x4 sct = (f32x4){0.f, 0.f, 0.f, 0.f};
#pragma unroll
            for (int ks = 0; ks < 2; ++ks) { const bf16x8 a = *(const LAS bf16x8*)(KT + n * 64 + 32 * ks + 8 * g), bq = *(const LAS bf16x8*)(QT + n * 64 + 32 * ks + 8 * g); sct = mfma16(a, bq, sct); }
#pragma unroll
            for (int r = 0; r < 4; ++r) sct[r] = (4 * g + r <= n) ? sct[r] : 0.f;
            u32x4 bs; bs.x = cvt_pk_bf16(sct[0], sct[1]); bs.y = cvt_pk_bf16(sct[2], sct[3]); bs.z = 0u; bs.w = 0u;
            f32x4 o[4];
#pragma unroll
            for (int vb = 0; vb < 4; ++vb) { const u32x2 lo = *(const LAS u32x2*)(VT + (16 * vb + n) * 16 + 4 * g); u32x4 av; av.x = lo.x; av.y = lo.y; av.z = 0u; av.w = 0u;
                o[vb] = mfma16(__builtin_bit_cast(bf16x8, av), __builtin_bit_cast(bf16x8, bs), (f32x4){0.f, 0.f, 0.f, 0.f}); }
#pragma unroll
            for (int ks = 0; ks < 2; ++ks) {
                const u32x2 q0 = *(const LAS u32x2*)(QT + n * 64 + 32 * ks + 4 * g), q1 = *(const LAS u32x2*)(QT + n * 64 + 32 * ks + 16 + 4 * g);
                u32x4 bq; bq.x = q0.x; bq.y = q0.y; bq.z = q1.x; bq.w = q1.y;
#pragma unroll
                for (int vb = 0; vb < 4; ++vb) { u32x4 av; av.x = cvt_pk_bf16(S[2 * ks][vb][0], S[2 * ks][vb][1]); av.y = cvt_pk_bf16(S[2 * ks][vb][2], S[2 * ks][vb][3]);
                    av.z = cvt_pk_bf16(S[2 * ks + 1][vb][0], S[2 * ks + 1][vb][1]); av.w = cvt_pk_bf16(S[2 * ks + 1][vb][2], S[2 * ks + 1][vb][3]);
                    o[vb] = mfma16(__builtin_bit_cast(bf16x8, av), __builtin_bit_cast(bf16x8, bq), o[vb]); }
            }
            if (MODE == 1) {
#pragma unroll
                for (int vb = 0; vb < 4; ++vb) *(f32x4*)(oscr + ob + 16 * vb) = o[vb];
            } else {
                float ss = 0.f;
#pragma unroll
                for (int vb = 0; vb < 4; ++vb) { o[vb] = o[vb] + of[vb]; ss += (o[vb][0] * o[vb][0] + o[vb][1] * o[vb][1]) + (o[vb][2] * o[vb][2] + o[vb][3] * o[vb][3]); }
                ss += xor_swz<16>(ss); ss += xor32(ss, lane);
                const float rn = __builtin_amdgcn_rsqf(ss * (1.f / 64.f) + EPS);
                const float* nw = F.in[TYPE ? 11 : 9] + layer * 64 + 4 * g;
#pragma unroll
                for (int vb = 0; vb < 4; ++vb) { const f32x4 w4 = *(const f32x4*)(nw + 16 * vb);
                    const float g0 = bflo(gg[vb].x), g1 = bfhi(gg[vb].x), g2 = bflo(gg[vb].y), g3 = bfhi(gg[vb].y);
                    u32x2 w; w.x = cvt_pk_bf16(o[vb][0] * rn * w4[0] * g0 * sigmoidf_(g0), o[vb][1] * rn * w4[1] * g1 * sigmoidf_(g1)); w.y = cvt_pk_bf16(o[vb][2] * rn * w4[2] * g2 * sigmoidf_(g2), o[vb][3] * rn * w4[3] * g3 * sigmoidf_(g3));
                    *(u32x2*)(mix + row * 1024u + (unsigned)(TYPE * 384 + h * 64 + 16 * vb + 4 * g)) = w; }
            }
        }
#pragma unroll
        for (int kb = 0; kb < 4; ++kb) { const f32x4 d4 = *(const LAS f32x4*)(DD + 16 * kb + 4 * g);
#pragma unroll
            for (int vb = 0; vb < 4; ++vb) S[kb][vb] = S[kb][vb] * d4; }
        { bf16x8 af[4], bfv[4];
#pragma unroll
          for (int q = 0; q < 4; ++q) { u32x4 a = *(const LAS u32x4*)(KPT + (16 * q + n) * 16 + 8 * (g & 1)), bq = *(const LAS u32x4*)(VT + (16 * q + n) * 16 + 8 * (g & 1));
              if (g >= 2) { a = (u32x4){0u, 0u, 0u, 0u}; bq = (u32x4){0u, 0u, 0u, 0u}; }
              af[q] = __builtin_bit_cast(bf16x8, a); bfv[q] = __builtin_bit_cast(bf16x8, bq); }
#pragma unroll
          for (int kb = 0; kb < 4; ++kb)
#pragma unroll
              for (int vb = 0; vb < 4; ++vb) S[kb][vb] = mfma16(af[kb], bfv[vb], S[kb][vb]); }
        asm volatile("s_waitcnt lgkmcnt(0)" ::: "memory");
    }
    if (MODE == 0) {
        float* sl = (float*)(F.ws + WS_SLOC) + (size_t)wu_out * 4096;
#pragma unroll
        for (int kb = 0; kb < 4; ++kb)
#pragma unroll
            for (int vb = 0; vb < 4; ++vb)
#pragma unroll
                for (int r = 0; r < 4; ++r) sl[(16 * kb + 4 * g + r) * 64 + 16 * vb + n] = S[kb][vb][r];
        ((float*)(F.ws + WS_DEC))[(size_t)wu_out * 64 + lane] = dtot;
    }
}
constexpr int WLDS0 = 10240;
template <int TYPE>
__device__ __forceinline__ void run0(Frame& F, int lane_in, int wave, int layer, int b, int h, int dir, int sc, int wu_out) {
    int lane = lane_in; asm volatile("" : "+v"(lane));
    const int g = lane >> 4, n = lane & 15;
    const float* tab = (const float*)(F.ws + WS_TAB);
    const bf16_t* Kb = (const bf16_t*)(F.ws + WS_SCAN + (size_t)(TYPE ? SC_RK : (dir ? SC_KB : SC_KF)) * SCAN_PITCH);
    const bf16_t* Vb = (const bf16_t*)(F.ws + WS_SCAN + (size_t)(TYPE ? SC_RV : SC_HV) * SCAN_PITCH);
    const unsigned co = (unsigned)(h * 64 + lane);
    const float gam = TYPE ? tab[TB_GAM + layer * 12 + dir * 6 + h] : 0.f;
    LAS unsigned char* wl = F.lds + wave * WLDS0;
    LAS unsigned char* KP = wl; LAS unsigned char* VT = wl + 5120;
    f32x4 S[4][4];
#pragma unroll
    for (int kb = 0; kb < 4; ++kb)
#pragma unroll
        for (int vb = 0; vb < 4; ++vb) S[kb][vb] = (f32x4){0.f, 0.f, 0.f, 0.f};
    float r = 1.f;
    unsigned short kr[32], vr[32];
#pragma unroll
    for (int i = 0; i < 32; ++i) { const unsigned ro = (unsigned)scan_row(sc, 255 - i, dir, b) * 384u + co; kr[i] = Kb[ro]; vr[i] = Vb[ro]; }
    for (int blk = 0; blk < 8; ++blk) {
        u32x4 kw[4], vw[4];
#pragma unroll
        for (int j = 0; j < 16; ++j) { const float k0 = bf2f(kr[2 * j]), k1 = bf2f(kr[2 * j + 1]);
            const float a0 = k0 * r; r *= (TYPE == 0 ? 1.f - k0 : gam); const float a1 = k1 * r; r *= (TYPE == 0 ? 1.f - k1 : gam);
            kw[j >> 2][j & 3] = cvt_pk_bf16(a0, a1); vw[j >> 2][j & 3] = (unsigned)vr[2 * j] | ((unsigned)vr[2 * j + 1] << 16); }
#pragma unroll
        for (int q = 0; q < 4; ++q) { *(LAS u32x4*)(KP + lane * 80 + 16 * q) = kw[q]; *(LAS u32x4*)(VT + lane * 80 + 16 * q) = vw[q]; }
        if (blk + 1 < 8) {
#pragma unroll
            for (int i = 0; i < 32; ++i) { const unsigned ro = (unsigned)scan_row(sc, 255 - 32 * (blk + 1) - i, dir, b) * 384u + co; kr[i] = Kb[ro]; vr[i] = Vb[ro]; }
        }
        asm volatile("s_waitcnt lgkmcnt(0)" ::: "memory");
        { bf16x8 af[4], bfv[4];
#pragma unroll
          for (int q = 0; q < 4; ++q) { af[q] = __builtin_bit_cast(bf16x8, *(const LAS u32x4*)(KP + (16 * q + n) * 80 + 16 * g)); bfv[q] = __builtin_bit_cast(bf16x8, *(const LAS u32x4*)(VT + (16 * q + n) * 80 + 16 * g)); }
#pragma unroll
          for (int kb = 0; kb < 4; ++kb)
#pragma unroll
              for (int vb = 0; vb < 4; ++vb) S[kb][vb] = mfma16(af[kb], bfv[vb], S[kb][vb]); }
        asm volatile("s_waitcnt lgkmcnt(0)" ::: "memory");
    }
    float* sl = (float*)(F.ws + WS_SLOC) + (size_t)wu_out * 4096;
#pragma unroll
    for (int kb = 0; kb < 4; ++kb)
#pragma unroll
        for (int vb = 0; vb < 4; ++vb)
#pragma unroll
            for (int rr = 0; rr < 4; ++rr) sl[(16 * kb + 4 * g + rr) * 64 + 16 * vb + n] = S[kb][vb][rr];
    ((float*)(F.ws + WS_DEC))[(size_t)wu_out * 64 + lane] = r;
}
}
__device__ __forceinline__ void phase_scan2_a(Frame& F, int layer) {
    PHASE_IDS();
    const int gw = blk_ * NWAVES + wave, NGW = F.G * NWAVES;
    for (int wu = gw; wu < NSEQ * NSC; wu += NGW) {
        const int s = wu / NSC, sc = wu % NSC; const int type = s / 24, rem = s % 24, b = rem / 12, h = (rem % 12) >> 1, dir = rem & 1;
        if (type == 0) sc2::run0<0>(F, lane, wave, layer, b, h, dir, sc, wu); else sc2::run0<1>(F, lane, wave, layer, b, h, dir, sc, wu);
    }
    { const P0Split sp = p0_split(F.G, layer);
      if (gw >= sp.thrA) p0_run(F, (LAS float*)(F.lds + wave * sc2::WLDS0), lane, layer * P0_PER_L + P0_NFIX, gw - sp.thrA, sp.idleA, sp.NA); }
}
__device__ __forceinline__ void phase_scan2_c(Frame& F, int layer) {
    PHASE_IDS();
    const int gw = blk_ * NWAVES + wave, NGW = F.G * NWAVES;
    const bool need_ctx = layer == 0;
    for (int wu = gw; wu < 24 * NSC; wu += NGW) {
        const int sq = wu / NSC, blk = wu % NSC; const int type = sq / 12, b = (sq % 12) / 6, h = sq % 6;
        if (blk == 0 && !need_ctx) continue;
        const int scf = blk, scb = (blk == 0) ? 0 : 65 - blk;
        if (type == 0) { sc2::run<0, 1>(F, lane, wave, layer, b, h, 0, scf, scf == 0, 0); sc2::run<0, 2>(F, lane, wave, layer, b, h, 1, scb, scb == 0, 0); }
        else           { sc2::run<1, 1>(F, lane, wave, layer, b, h, 0, scf, scf == 0, 0); sc2::run<1, 2>(F, lane, wave, layer, b, h, 1, scb, scb == 0, 0); }
    }
    { const P0Split sp = p0_split(F.G, layer);
      if (gw >= sp.thrC) p0_run(F, (LAS float*)(F.lds + 67584 + wave * 8448), lane, layer * P0_PER_L + P0_NFIX + sp.NA, gw - sp.thrC, sp.idleC, sp.NC); }
}

namespace att {
constexpr int SLOT = 32768, NS = 3, WSF_OFF = NS * SLOT, OST_OFF = 0, OST_W = 32 * 68 * 4;
__device__ __forceinline__ int crow(int r, int hi) { return (r & 3) + 8 * (r >> 2) + 4 * hi; }
typedef short v4i16_t __attribute__((ext_vector_type(4)));
typedef LAS const char* lds_cptr;
__device__ __forceinline__ s16x4 vtr(lds_cptr p) { return __builtin_bit_cast(s16x4, __builtin_amdgcn_ds_read_tr16_b64_v4i16((LAS v4i16_t*)p)); }
__device__ __forceinline__ float max3f(float a, float b, float c) { return __builtin_fmaxf(__builtin_fmaxf(a, b), c); }
__device__ __forceinline__ float hmax32(const f32x16& p0, const f32x16& p1) {
    float a = max3f(p0[0], p0[1], p1[0]), b = max3f(p0[2], p0[3], p1[1]); a = max3f(a, p1[2], p1[3]);
#pragma unroll
    for (int r = 4; r < 16; r += 4) { a = max3f(a, p0[r], p0[r + 1]); b = max3f(b, p0[r + 2], p0[r + 3]); a = max3f(a, p1[r], p1[r + 1]); b = max3f(b, p1[r + 2], p1[r + 3]); }
    const float m = __builtin_fmaxf(a, b);
    auto rr = __builtin_amdgcn_permlane32_swap(__builtin_bit_cast(unsigned, m), __builtin_bit_cast(unsigned, m), false, false);
    return __builtin_fmaxf(__builtin_bit_cast(float, rr[0]), __builtin_bit_cast(float, rr[1]));
}
#define ATT_WAIT_BAR(N) asm volatile("s_waitcnt vmcnt(" #N ") lgkmcnt(0)\n\ts_barrier" ::: "memory")
template<int VAR>
__device__ __forceinline__ void attn_unit(Frame& F, int lane_in, int wid, int layer, int b, int h, bool isctx, int qb) {
    int lane = lane_in; asm volatile("" : "+v"(lane));
    const int r32 = lane & 31, hi = lane >> 5;
    LAS unsigned char* lds = F.lds; const unsigned lds0 = (unsigned)(uintptr_t)lds;
    const float* tab = (const float*)(F.ws + WS_TAB);
    const int qrow = qb * 256 + wid * 32 + r32;
    bf16x8 qr[2][2];
#pragma unroll
    for (int m = 0; m < 2; ++m) { const int mp = b * 8 + 2 * h + m;
        const bf16_t* qp = isctx ? (const bf16_t*)(F.ws + WS_QC) + ((size_t)mp * CL + qrow) * 32 : (const bf16_t*)(F.ws + WS_QA) + ((size_t)mp * T + qrow) * 32;
#pragma unroll
        for (int d0 = 0; d0 < 2; ++d0) qr[m][d0] = *(const bf16x8*)(qp + d0 * 16 + hi * 8); }
    const int NTL = isctx ? 2 : KT_TILES / 2;
    const bf16_t* ksrc = (const bf16_t*)(F.ws + WS_KA) + (size_t)((b * 8 + 2 * h + (wid >> 2)) * KT_TILES) * 2048 + (wid & 3) * 512;
    const unsigned char* vsrc = F.ws + WS_VA + (size_t)((b * 4 + h) * KT_TILES) * 4096 + (wid >> 2) * 4096 + (wid & 3) * 1024;
    const unsigned dma_off = (unsigned)lane * 16u;
#define ATT_DMA(t, slot) do { _Pragma("unroll") for (int sb_ = 0; sb_ < 2; ++sb_) \
                              ::glds16(ksrc + (size_t)(2 * (t) + sb_) * 2048, dma_off, (unsigned)__builtin_amdgcn_readfirstlane(lds0 + (slot) * SLOT + sb_ * 16384 + wid * 1024)); \
                              ::glds16(vsrc + (size_t)(t) * 8192, dma_off, (unsigned)__builtin_amdgcn_readfirstlane(lds0 + (slot) * SLOT + (wid >> 2) * 16384 + 8192 + (wid & 3) * 1024)); } while (0)
    LAS float* wsf = (LAS float*)(lds + WSF_OFF) + wid * 128;
    LAS float* ost = (LAS float*)(lds + OST_OFF + wid * OST_W);
    f32x16 o[2][2];
#pragma unroll
    for (int m = 0; m < 2; ++m)
#pragma unroll
        for (int d = 0; d < 2; ++d) o[m][d] = f32x16{};
    constexpr float POFS = 60.5f, PTHR = 32.f;
    float mhat = 0.f;
    f32x16 lacc[2]; lacc[0] = f32x16{}; lacc[1] = f32x16{};
    v8i ones8; { int o8 = 0x38383838; asm volatile("" : "+v"(o8)); ones8 = (v8i){o8, o8, o8, o8, o8, o8, o8, o8}; asm volatile("" : "+v"(ones8)); }
    f32x16 negm; { float z_ = POFS; asm volatile("" : "+v"(z_));
#pragma unroll
      for (int r = 0; r < 16; ++r) negm[r] = z_; }
    ATT_DMA(0, 0); ATT_DMA(1, 1);
    asm volatile("" : "+v"(qr[0][0]), "+v"(qr[0][1]), "+v"(qr[1][0]), "+v"(qr[1][1]));
    int slot = 0;
    for (int t = 0; t < NTL; ++t) {
        if (t + 1 < NTL) { ATT_WAIT_BAR(3); } else { ATT_WAIT_BAR(0); }
        if (t + 2 < NTL) { const int s2 = slot >= 1 ? slot - 1 : 2; ATT_DMA(t + 2, s2); }
#pragma unroll
        for (int sub = 0; sub < 2; ++sub) {
        const lds_cptr base = (lds_cptr)lds + slot * SLOT + sub * 16384;
        f32x16 p[2][2];
#pragma unroll
        for (int m = 0; m < 2; ++m) {
            const lds_cptr kb = base + m * 4096 + hi * 1024 + r32 * 16;
            const bf16x8 k00 = VAR == 4 ? qr[m][0] : *(const LAS bf16x8*)(kb), k01 = VAR == 4 ? qr[m][1] : *(const LAS bf16x8*)(kb + 512), k10 = VAR == 4 ? qr[1 - m][0] : *(const LAS bf16x8*)(kb + 2048), k11 = VAR == 4 ? qr[1 - m][1] : *(const LAS bf16x8*)(kb + 2048 + 512);
            p[m][0] = __builtin_amdgcn_mfma_f32_32x32x16_bf16(k00, qr[m][0], negm, 0, 0, 0);
            p[m][1] = __builtin_amdgcn_mfma_f32_32x32x16_bf16(k01, qr[m][0], negm, 0, 0, 0);
            p[m][0] = __builtin_amdgcn_mfma_f32_32x32x16_bf16(k10, qr[m][1], p[m][0], 0, 0, 0);
            p[m][1] = __builtin_amdgcn_mfma_f32_32x32x16_bf16(k11, qr[m][1], p[m][1], 0, 0, 0);
        }
        v8i vf[2];
        if (sub == 0 && (t & 1) == 0) {
          const float rm = __builtin_fmaxf(hmax32(p[0][0], p[0][1]), hmax32(p[1][0], p[1][1])) - POFS;
          const bool first = (t == 0);
          if (first || __any(rm > PTHR)) {
              const float dl = first ? rm : fmaxf(rm, 0.f);
              mhat += dl;
#pragma unroll
              for (int r = 0; r < 16; ++r) { p[0][0][r] -= dl; p[0][1][r] -= dl; p[1][0][r] -= dl; p[1][1][r] -= dl; negm[r] = POFS - mhat; }
              asm volatile("" : "+v"(negm));
              if (!first) {
                  const float f = __builtin_amdgcn_exp2f(-0.25f * dl);
                  if (hi == 0) wsf[r32] = f;
                  LDS_WAIT();
#pragma unroll
                  for (int r = 0; r < 16; ++r) { const float fr_ = wsf[crow(r, hi)]; o[0][0][r] *= fr_; o[0][1][r] *= fr_; o[1][0][r] *= fr_; o[1][1][r] *= fr_; lacc[0][r] *= fr_; lacc[1][r] *= fr_; }
                  LDS_WAIT();
              }
          } }
#pragma unroll
        for (int m = 0; m < 2; ++m) {
            f32x16& p0 = p[m][0]; f32x16& p1 = p[m][1];
            v8i pw;
#pragma unroll
            for (int q = 0; q < 4; ++q) {
                unsigned wa = __builtin_amdgcn_cvt_pk_u8_f32(p0[4 * q], 0, 0u), wb = __builtin_amdgcn_cvt_pk_u8_f32(p1[4 * q], 0, 0u);
#pragma unroll
                for (int j = 1; j < 4; ++j) { wa = __builtin_amdgcn_cvt_pk_u8_f32(p0[4 * q + j], j, wa); wb = __builtin_amdgcn_cvt_pk_u8_f32(p1[4 * q + j], j, wb); }
                pw[q] = (int)wa; pw[4 + q] = (int)wb; }
            if (m == 0) {
                const lds_cptr vp0 = base + 8192 + hi * 512 + r32 * 16;
#pragma unroll
                for (int d0 = 0; d0 < 2; ++d0) { const u32x4 lo = *(const LAS u32x4*)(vp0 + d0 * 1024), hh = *(const LAS u32x4*)(vp0 + d0 * 1024 + 2048);
                    vf[d0] = (v8i){(int)lo.x, (int)lo.y, (int)lo.z, (int)lo.w, (int)hh.x, (int)hh.y, (int)hh.z, (int)hh.w}; }
            }
#pragma unroll
            for (int d0 = 0; d0 < 2; ++d0) o[m][d0] = __builtin_amdgcn_mfma_scale_f32_32x32x64_f8f6f4(pw, vf[d0], o[m][d0], 1, 0, 0, 0x7F7F7F7F, 0, 0x7B7B7B7B);
            lacc[m] = __builtin_amdgcn_mfma_scale_f32_32x32x64_f8f6f4(pw, ones8, lacc[m], 1, 0, 0, 0x7F7F7F7F, 0, 0x7F7F7F7F);
        }
        }
        slot = slot == 2 ? 0 : slot + 1;
    }
    asm volatile("s_waitcnt lgkmcnt(0)\n\ts_barrier" ::: "memory");
    int lane_e = lane; asm volatile("" : "+v"(lane_e));
    const int r32e = lane_e & 31, hie = lane_e >> 5;
    const float lam = tab[TB_LAM + layer], oml = tab[TB_LAM + 2 + layer];
#pragma unroll
    for (int r = 0; r < 16; ++r) { const int qq = crow(r, hie); const float f0 = __builtin_amdgcn_rcpf(lacc[0][r]), f1 = -lam * __builtin_amdgcn_rcpf(lacc[1][r]);
#pragma unroll
        for (int d0 = 0; d0 < 2; ++d0) ost[qq * 68 + d0 * 32 + r32e] = o[0][d0][r] * f0 + o[1][d0][r] * f1; }
    LDS_WAIT();
    { const int rw = lane_e >> 1, hf = lane_e & 1; f32x4 xv[8]; float ss = 0.f;
#pragma unroll
      for (int j = 0; j < 8; ++j) { xv[j] = *(const LAS f32x4*)(ost + rw * 68 + hf * 32 + 4 * j); ss += (xv[j][0] * xv[j][0] + xv[j][1] * xv[j][1]) + (xv[j][2] * xv[j][2] + xv[j][3] * xv[j][3]); }
      ss += xor_swz<1>(ss);
      const float rs = __builtin_amdgcn_rsqf(ss * (1.f / 64.f) + EPS) * oml;
      const float* sw = F.in[13] + layer * 64 + hf * 32;
      const int qi = qb * 256 + wid * 32 + rw; const size_t orow = isctx ? (size_t)(NLAT + b * CL + qi) : (size_t)(b * T + qi);
      bf16_t* dst = (bf16_t*)(F.ws + WS_MIX) + orow * 1024 + 768 + h * 64 + hf * 32;
#pragma unroll
      for (int j = 0; j < 4; ++j) { const f32x4 a = xv[2 * j], c = xv[2 * j + 1]; const f32x4 wa = *(const f32x4*)(sw + 8 * j), wb = *(const f32x4*)(sw + 8 * j + 4);
          u32x4 w; w.x = pk2(a[0] * rs * wa[0], a[1] * rs * wa[1]); w.y = pk2(a[2] * rs * wa[2], a[3] * rs * wa[3]); w.z = pk2(c[0] * rs * wb[0], c[1] * rs * wb[1]); w.w = pk2(c[2] * rs * wb[2], c[3] * rs * wb[3]);
          *(u32x4*)(dst + 8 * j) = w; } }
    asm volatile("s_waitcnt lgkmcnt(0)\n\ts_barrier" ::: "memory");
#undef ATT_DMA
}

#define ATT_SBAR() __builtin_amdgcn_sched_barrier(0)
#define ATT_MFMA(a, b, c) __builtin_amdgcn_mfma_f32_32x32x16_bf16(a, b, c, 0, 0, 0)
#define ATT_PV(a, b, c, sb) __builtin_amdgcn_mfma_scale_f32_32x32x64_f8f6f4(a, b, c, 1, 0, 0, 0x7F7F7F7F, 0, sb)
constexpr float POFS = 60.5f, PTHR = 32.f;
struct PState { f32x16 o[2][2]; f32x4 lacc[2]; f32x16 negm; bf16x8 qr[2][2]; float mhat; };
#define ATT_CVT8(p, e0, W, i0) do { unsigned a_ = __builtin_amdgcn_cvt_pk_u8_f32(p[e0], 0, 0u), b_ = __builtin_amdgcn_cvt_pk_u8_f32(p[(e0) + 4], 0, 0u); \
    _Pragma("unroll") for (int j_ = 1; j_ < 4; ++j_) { a_ = __builtin_amdgcn_cvt_pk_u8_f32(p[(e0) + j_], j_, a_); b_ = __builtin_amdgcn_cvt_pk_u8_f32(p[(e0) + 4 + j_], j_, b_); } \
    W[i0] = (int)a_; W[(i0) + 1] = (int)b_; } while (0)
template<int M, bool LOADV>
__device__ __forceinline__ void pstep(PState& S, f32x16& pa0, f32x16& pa1, f32x16& pb0, f32x16& pb1, bf16x8& kA, bf16x8& kB, v8i (&vf)[2], const v4i& sel4, lds_cptr vb, lds_cptr kc, lds_cptr kn, bool chk, LAS float* wsfw, int lane) {
    constexpr int MN = 1 - M;
    if (chk) {
        const float rm = hmax32(pa0, pa1) - POFS;
        if (__any(rm > PTHR)) {
            const int r32 = lane & 31, hi = lane >> 5;
            const float dl = fmaxf(rm, 0.f);
            S.mhat += dl;
#pragma unroll
            for (int r = 0; r < 16; ++r) { pa0[r] -= dl; pa1[r] -= dl; S.negm[r] = POFS - S.mhat; }
            const float f = __builtin_amdgcn_exp2f(-0.25f * dl);
            if (hi == 0) wsfw[r32] = f;
            LDS_WAIT();
#pragma unroll
            for (int r = 0; r < 16; ++r) { const float fr_ = wsfw[crow(r, hi)]; S.o[0][0][r] *= fr_; S.o[0][1][r] *= fr_; S.o[1][0][r] *= fr_; S.o[1][1][r] *= fr_; }
            { const float fl_ = wsfw[(lane & 15) + 16 * hi]; S.lacc[0] = S.lacc[0] * fl_; S.lacc[1] = S.lacc[1] * fl_; }
            LDS_WAIT();
        }
    }
    v8i pw;
    ATT_SBAR(); pb0 = ATT_MFMA(kA, S.qr[MN][0], S.negm); ATT_SBAR();
    kA = *(const LAS bf16x8*)(kc + 2048);
    if (LOADV) {
#pragma unroll
        for (int d0 = 0; d0 < 2; ++d0) { const u32x4 lo = *(const LAS u32x4*)(vb + d0 * 1024), hh = *(const LAS u32x4*)(vb + d0 * 1024 + 2048);
            vf[d0] = (v8i){(int)lo.x, (int)lo.y, (int)lo.z, (int)lo.w, (int)hh.x, (int)hh.y, (int)hh.z, (int)hh.w}; }
    }
    ATT_CVT8(pa0, 0, pw, 0);
    ATT_SBAR(); pb1 = ATT_MFMA(kB, S.qr[MN][0], S.negm); ATT_SBAR();
    kB = *(const LAS bf16x8*)(kc + 2048 + 512);
    ATT_CVT8(pa0, 8, pw, 2);
    ATT_SBAR(); pb0 = ATT_MFMA(kA, S.qr[MN][1], pb0); ATT_SBAR();
    kA = *(const LAS bf16x8*)(kn);
    ATT_CVT8(pa1, 0, pw, 4);
    ATT_SBAR(); pb1 = ATT_MFMA(kB, S.qr[MN][1], pb1); ATT_SBAR();
    kB = *(const LAS bf16x8*)(kn + 512);
    ATT_CVT8(pa1, 8, pw, 6);
    ATT_SBAR(); S.o[M][0] = ATT_PV(pw, vf[0], S.o[M][0], 0x7B7B7B7B);
    ATT_SBAR(); S.o[M][1] = ATT_PV(pw, vf[1], S.o[M][1], 0x7B7B7B7B);
    ATT_SBAR(); S.lacc[M] = __builtin_amdgcn_mfma_scale_f32_16x16x128_f8f6f4((v8i){sel4[0], sel4[1], sel4[2], sel4[3], 0, 0, 0, 0}, pw, S.lacc[M], 4, 1, 0, 0x7F7F7F7F, 0, 0x7F7F7F7F); ATT_SBAR();
}
__device__ __forceinline__ void attn_unit_p(Frame& F, int lane_in, int wid, int layer, int b, int h, bool isctx, int qb) {
    int lane = lane_in; asm volatile("" : "+v"(lane));
    const int r32 = lane & 31, hi = lane >> 5;
    LAS unsigned char* lds = F.lds; const unsigned lds0 = (unsigned)(uintptr_t)lds;
    const float* tab = (const float*)(F.ws + WS_TAB);
    const int qrow = qb * 256 + wid * 32 + r32;
    PState S;
#pragma unroll
    for (int m = 0; m < 2; ++m) { const int mp = b * 8 + 2 * h + m;
        const bf16_t* qp = isctx ? (const bf16_t*)(F.ws + WS_QC) + ((size_t)mp * CL + qrow) * 32 : (const bf16_t*)(F.ws + WS_QA) + ((size_t)mp * T + qrow) * 32;
#pragma unroll
        for (int d0 = 0; d0 < 2; ++d0) S.qr[m][d0] = *(const bf16x8*)(qp + d0 * 16 + hi * 8); }
    const int NTL = isctx ? 2 : KT_TILES / 2;
    const bf16_t* ksrc = (const bf16_t*)(F.ws + WS_KA) + (size_t)((b * 8 + 2 * h + (wid >> 2)) * KT_TILES) * 2048 + (wid & 3) * 512;
    const unsigned char* vsrc = F.ws + WS_VA + (size_t)((b * 4 + h) * KT_TILES) * 4096 + (wid >> 2) * 4096 + (wid & 3) * 1024;
    const unsigned dma_off = (unsigned)lane * 16u;
#define ATT_DMA(t, slot) do { _Pragma("unroll") for (int sb_ = 0; sb_ < 2; ++sb_) \
                              ::glds16(ksrc + (size_t)(2 * (t) + sb_) * 2048, dma_off, (unsigned)__builtin_amdgcn_readfirstlane(lds0 + (slot) * SLOT + sb_ * 16384 + wid * 1024)); \
                              ::glds16(vsrc + (size_t)(t) * 8192, dma_off, (unsigned)__builtin_amdgcn_readfirstlane(lds0 + (slot) * SLOT + (wid >> 2) * 16384 + 8192 + (wid & 3) * 1024)); } while (0)
    LAS float* wsf = (LAS float*)(lds + WSF_OFF) + wid * 128;
    LAS float* ost = (LAS float*)(lds + OST_OFF + wid * OST_W);
#pragma unroll
    for (int m = 0; m < 2; ++m) { S.o[m][0] = f32x16{}; S.o[m][1] = f32x16{}; S.lacc[m] = (f32x4){0.f, 0.f, 0.f, 0.f}; }
    S.mhat = 0.f;
    { float z_ = POFS; asm volatile("" : "+v"(z_));
#pragma unroll
      for (int r = 0; r < 16; ++r) S.negm[r] = z_; }
    v4i sel4; { int o4 = (((lane >> 4) ^ (lane >> 3)) & 1) ? 0 : 0x22222222; asm volatile("" : "+v"(o4)); sel4 = (v4i){o4, o4, o4, o4}; asm volatile("" : "+v"(sel4)); }
    ATT_DMA(0, 0); ATT_DMA(1, 1);
    asm volatile("" : "+v"(S.qr[0][0]), "+v"(S.qr[0][1]), "+v"(S.qr[1][0]), "+v"(S.qr[1][1]));
    const int koff = hi * 1024 + r32 * 16, voff = 8192 + hi * 512 + r32 * 16;
    ATT_WAIT_BAR(3);
    f32x16 pa0, pa1, pb0, pb1; bf16x8 kA, kB; v8i vf[2];
    {
        const lds_cptr kb = (lds_cptr)lds + koff;
        kA = *(const LAS bf16x8*)(kb); kB = *(const LAS bf16x8*)(kb + 512);
        pa0 = ATT_MFMA(kA, S.qr[0][0], S.negm); pa1 = ATT_MFMA(kB, S.qr[0][0], S.negm);
        ATT_SBAR();
        kA = *(const LAS bf16x8*)(kb + 2048); kB = *(const LAS bf16x8*)(kb + 2048 + 512);
        pa0 = ATT_MFMA(kA, S.qr[0][1], pa0); pa1 = ATT_MFMA(kB, S.qr[0][1], pa1);
        ATT_SBAR();
        kA = *(const LAS bf16x8*)(kb + 4096); kB = *(const LAS bf16x8*)(kb + 4096 + 512);
        const float rm = hmax32(pa0, pa1) - POFS; S.mhat = rm;
#pragma unroll
        for (int r = 0; r < 16; ++r) { pa0[r] -= rm; pa1[r] -= rm; S.negm[r] = POFS - rm; }
    }
    int slot = 0;
    for (int t = 0; t < NTL; ++t) {
        ATT_WAIT_BAR(0);
        if (t + 2 < NTL) { const int s2 = slot >= 1 ? slot - 1 : 2; ATT_DMA(t + 2, s2); }
        const int sn = slot == 2 ? 0 : slot + 1;
        const lds_cptr tb = (lds_cptr)lds + slot * SLOT, tn = (lds_cptr)lds + sn * SLOT;
        const bool chk = (t & 1) == 0;
        pstep<0, true >(S, pa0, pa1, pb0, pb1, kA, kB, vf, sel4, tb + voff,         tb + 4096 + koff,         tb + 16384 + koff,        chk && t > 0, wsf, lane);
        pstep<1, false>(S, pb0, pb1, pa0, pa1, kA, kB, vf, sel4, tb + voff,         tb + 16384 + koff,        tb + 16384 + 4096 + koff, chk,          wsf, lane);
        pstep<0, true >(S, pa0, pa1, pb0, pb1, kA, kB, vf, sel4, tb + 16384 + voff, tb + 16384 + 4096 + koff, tn + koff,                false,        wsf, lane);
        pstep<1, false>(S, pb0, pb1, pa0, pa1, kA, kB, vf, sel4, tb + 16384 + voff, tn + koff,                tn + 4096 + koff,         false,        wsf, lane);
        slot = sn;
    }
    asm volatile("s_waitcnt lgkmcnt(0)\n\ts_barrier" ::: "memory");
    int lane_e = lane; asm volatile("" : "+v"(lane_e));
    const int r32e = lane_e & 31, hie = lane_e >> 5;
    const float lam = tab[TB_LAM + layer], oml = tab[TB_LAM + 2 + layer];
    if ((lane_e & 16) == 0) { const int ql = (lane_e & 15) + 16 * hie; wsf[ql] = __builtin_amdgcn_rcpf(S.lacc[0][0]); wsf[32 + ql] = __builtin_amdgcn_rcpf(S.lacc[1][0]); }
    LDS_WAIT();
#pragma unroll
    for (int r = 0; r < 16; ++r) { const int qq = crow(r, hie); const float f0 = wsf[qq], f1 = -lam * wsf[32 + qq];
#pragma unroll
        for (int d0 = 0; d0 < 2; ++d0) ost[qq * 68 + d0 * 32 + r32e] = S.o[0][d0][r] * f0 + S.o[1][d0][r] * f1; }
    LDS_WAIT();
    { const int rw = lane_e >> 1, hf = lane_e & 1; f32x4 xv[8]; float ss = 0.f;
#pragma unroll
      for (int j = 0; j < 8; ++j) { xv[j] = *(const LAS f32x4*)(ost + rw * 68 + hf * 32 + 4 * j); ss += (xv[j][0] * xv[j][0] + xv[j][1] * xv[j][1]) + (xv[j][2] * xv[j][2] + xv[j][3] * xv[j][3]); }
      ss += xor_swz<1>(ss);
      const float rs = __builtin_amdgcn_rsqf(ss * (1.f / 64.f) + EPS) * oml;
      const float* sw = F.in[13] + layer * 64 + hf * 32;
      const int qi = qb * 256 + wid * 32 + rw; const size_t orow = isctx ? (size_t)(NLAT + b * CL + qi) : (size_t)(b * T + qi);
      bf16_t* dst = (bf16_t*)(F.ws + WS_MIX) + orow * 1024 + 768 + h * 64 + hf * 32;
#pragma unroll
      for (int j = 0; j < 4; ++j) { const f32x4 a = xv[2 * j], c = xv[2 * j + 1]; const f32x4 wa = *(const f32x4*)(sw + 8 * j), wb = *(const f32x4*)(sw + 8 * j + 4);
          u32x4 w; w.x = pk2(a[0] * rs * wa[0], a[1] * rs * wa[1]); w.y = pk2(a[2] * rs * wa[2], a[3] * rs * wa[3]); w.z = pk2(c[0] * rs * wb[0], c[1] * rs * wb[1]); w.w = pk2(c[2] * rs * wb[2], c[3] * rs * wb[3]);
          *(u32x4*)(dst + 8 * j) = w; } }
    asm volatile("s_waitcnt lgkmcnt(0)\n\ts_barrier" ::: "memory");
#undef ATT_DMA
}
}
template<int VAR>
__device__ __forceinline__ void phase_attn(Frame& F, int layer, int ulo, int uhi) {
    PHASE_IDS();
    __syncthreads();
    const int nunits = 512 + (layer == 0 ? 8 : 0);
    for (int u = blk_; u < nunits && u < uhi; u += F.G) {
        if (u < ulo) continue;
        if (u < 512) { const int bh = u & 7, qb = u >> 3; att::attn_unit_p(F, lane, wave, layer, bh >> 2, bh & 3, false, qb); }
        else { const int bh = u - 512; att::attn_unit_p(F, lane, wave, layer, bh >> 2, bh & 3, true, 0); }
    }
}

__device__ __forceinline__ void phase_route(Frame& F, int layer) {
    PHASE_IDS();
    const int wid = wave, G = F.G, blk = blk_;
    const int nrows = layer == 0 ? NROW : NLAT;
    constexpr int TP = 2064;
    LAS unsigned char* Th = F.lds; LAS unsigned char* Tl = F.lds + 16 * TP; LAS float* Pp = (LAS float*)(F.lds + 32 * TP);
    LAS int* hist = (LAS int*)(F.lds + LDS_TAB); LAS int* sbase = hist + 32; LAS unsigned* ent = (LAS unsigned*)(hist + 64); LAS float* entg = (LAS float*)(ent + 640);
    for (int i = tid; i < 64 + 640; i += NTHR) hist[i] = (i < 64) ? 0 : -1;
    LAS float* mv = (LAS float*)(F.lds + 32 * TP + 16384);
    { const float* mg = (const float*)(F.ws + WS_MODV) + (size_t)layer * 3 * 6 * 1024;
      for (int i = tid; i < 9 * 256; i += NTHR) { const int v = i >> 8, c4 = i & 255; *(LAS f32x4*)(mv + v * 1024 + 4 * c4) = *(const f32x4*)(mg + (size_t)((v / 3) * 6 + 2 + (v % 3)) * 1024 + 4 * c4); } }
    bf16x8 bh[4][2], bl[4][2];
    { const bf16_t* rwh = (const bf16_t*)(F.ws + WS_RWT) + (size_t)layer * 32768; const bf16_t* rwl = rwh + 2 * 32768;
#pragma unroll
      for (int ks = 0; ks < 4; ++ks)
#pragma unroll
        for (int nb = 0; nb < 2; ++nb) { const int o_ = (16 * nb + (lane & 15)) * 1024 + 128 * wid + 32 * ks + 8 * (lane >> 4); bh[ks][nb] = *(const bf16x8*)(rwh + o_); bl[ks][nb] = *(const bf16x8*)(rwl + o_); } }
    __syncthreads();
    const float* modv = (const float*)(F.ws + WS_MODV) + (size_t)layer * 3 * 6 * 1024;
    const bf16_t* yb = (const bf16_t*)(F.ws + WS_Y);
    bf16_t* x1b = (bf16_t*)(F.ws + WS_X1);
    const int nloc = (nrows - blk + G - 1) / G;
    const float rbias = F.in[16][layer * 32 + (lane & 31)];
    const int nbatch = (nloc + 15) >> 4;
    for (int it = 0; it < nbatch; ++it) { const int i0 = 16 * it + 2 * wid;
        f32x4 tk[2][4]; bool val[2];
#pragma unroll
        for (int q = 0; q < 2; ++q) {
            const int il = i0 + q; val[q] = il < nloc; const int r = val[q] ? blk + il * G : blk;
            const int w = row_which(r);
            f32x4 x[4], y[4];
            if (layer == 0) row_load(r < NLAT ? F.in[0] + (size_t)r * D : F.in[2] + (size_t)(r - NLAT) * D, lane, x); else row_load_bf16(x1b + (size_t)r * D, lane, x);
#pragma unroll
            for (int j = 0; j < 4; ++j) { const u32x2 yy = *(const u32x2*)(yb + (size_t)r * D + 4 * lane + 256 * j); y[j] = (f32x4){bflo(yy.x), bfhi(yy.x), bflo(yy.y), bfhi(yy.y)}; }
            const float ry = __builtin_amdgcn_rsqf(row_sumsq(y) * (1.f / 1024.f) + EPS);
            const LAS float* c1 = mv + (w * 3 + 0) * 1024;
#pragma unroll
            for (int j = 0; j < 4; ++j) { const f32x4 cv = *(const LAS f32x4*)(c1 + 4 * lane + 256 * j); x[j] = x[j] + cv * (y[j] * ry); }
            if (val[q]) row_store_bf16(x1b + (size_t)r * D, lane, x);
            { const float rr_ = __builtin_amdgcn_rsqf(row_sumsq(x) * (1.f / 1024.f) + EPS); const LAS float* at_ = mv + (w * 3 + 1) * 1024; const LAS float* bt_ = mv + (w * 3 + 2) * 1024;
#pragma unroll
              for (int j = 0; j < 4; ++j) { const f32x4 av = *(const LAS f32x4*)(at_ + 4 * lane + 256 * j), bv = *(const LAS f32x4*)(bt_ + 4 * lane + 256 * j); tk[q][j] = x[j] * rr_ * av + bv; } }
            if (val[q]) {
                unsigned char* t8 = F.ws + WS_TOK8 + (size_t)r * D;
#pragma unroll
                for (int j = 0; j < 4; ++j) *(unsigned*)(t8 + 4 * lane + 256 * j) = pk4_fp8(tk[q][j][0], tk[q][j][1], tk[q][j][2], tk[q][j][3]); }
        }
#pragma unroll
        for (int q = 0; q < 2; ++q)
#pragma unroll
            for (int j = 0; j < 4; ++j) { unsigned hb[4], lb[4];
#pragma unroll
                for (int c = 0; c < 4; ++c) { hb[c] = f2bf(tk[q][j][c]); lb[c] = f2bf(tk[q][j][c] - __builtin_bit_cast(float, hb[c] << 16)); }
                const int off = (2 * wid + q) * TP + (4 * lane + 256 * j) * 2;
                *(LAS u32x2*)(Th + off) = (u32x2){hb[0] | (hb[1] << 16), hb[2] | (hb[3] << 16)}; *(LAS u32x2*)(Tl + off) = (u32x2){lb[0] | (lb[1] << 16), lb[2] | (lb[3] << 16)}; }
        __syncthreads();
        { f32x4 pacc[2]; pacc[0] = (f32x4){0.f, 0.f, 0.f, 0.f}; pacc[1] = pacc[0];
#pragma unroll
          for (int ks = 0; ks < 4; ++ks) { const int ao = (lane & 15) * TP + (128 * wid + 32 * ks + 8 * (lane >> 4)) * 2;
              const bf16x8 ah = *(const LAS bf16x8*)(Th + ao), al = *(const LAS bf16x8*)(Tl + ao);
#pragma unroll
              for (int nb = 0; nb < 2; ++nb) { pacc[nb] = __builtin_amdgcn_mfma_f32_16x16x32_bf16(ah, bh[ks][nb], pacc[nb], 0, 0, 0); pacc[nb] = __builtin_amdgcn_mfma_f32_16x16x32_bf16(al, bh[ks][nb], pacc[nb], 0, 0, 0);
                                               pacc[nb] = __builtin_amdgcn_mfma_f32_16x16x32_bf16(ah, bl[ks][nb], pacc[nb], 0, 0, 0); } }
#pragma unroll
          for (int nb = 0; nb < 2; ++nb)
#pragma unroll
              for (int r = 0; r < 4; ++r) Pp[(wid * 16 + 4 * (lane >> 4) + r) * 32 + 16 * nb + (lane & 15)] = pacc[nb][r]; }
        __syncthreads();
        float lg = 0.f;
#pragma unroll
        for (int w8 = 0; w8 < 8; ++w8) lg += Pp[(w8 * 16 + 2 * wid + (lane >> 5)) * 32 + (lane & 31)];
        lg += rbias;
#ifdef DBG_CHECK
        { const int q_ = lane >> 5; if (q_ == 0 ? val[0] : val[1]) ((float*)(F.ws + WS_END + 65536))[(size_t)(blk + (i0 + q_) * G) * 32 + (lane & 31)] = lg; }
#endif
        float tv[4]; int te[4];
#pragma unroll
        for (int k = 0; k < 4; ++k) {
            float m = lg;
            m = fmaxf(m, xor_swz<16>(m)); m = fmaxf(m, xor_swz<8>(m)); m = fmaxf(m, xor_swz<4>(m)); m = fmaxf(m, xor_swz<2>(m)); m = fmaxf(m, xor_swz<1>(m));
            const unsigned long long bal = __ballot(lg == m);
            const unsigned hb = (lane & 32) ? (unsigned)(bal >> 32) : (unsigned)bal;
            const int idx = __builtin_ctz(hb);
            tv[k] = m; te[k] = idx;
            if ((lane & 31) == idx) lg = -INFINITY;
        }
        float g[4]; { float s = 0.f;
#pragma unroll
            for (int k = 0; k < 4; ++k) { g[k] = __expf(tv[k] - tv[0]); s += g[k]; }
            const float inv = 1.f / s;
#pragma unroll
            for (int k = 0; k < 4; ++k) g[k] *= inv; }
        const int q = lane >> 5, k = lane & 31;
        if (k < 4 && (q == 0 ? val[0] : val[1])) {
            const int il = i0 + q; const int r = blk + il * G;
            const int ee = (k == 0) ? te[0] : (k == 1) ? te[1] : (k == 2) ? te[2] : te[3];
            const float gg = (k == 0) ? g[0] : (k == 1) ? g[1] : (k == 2) ? g[2] : g[3];
            entg[il * 4 + k] = gg;
            const int lp = __hip_atomic_fetch_add(hist + ee, 1, __ATOMIC_RELAXED, __HIP_MEMORY_SCOPE_WORKGROUP);
            ent[il * 4 + k] = (unsigned)ee | ((unsigned)lp << 8);
        }
    }
    __syncthreads();
    if (tid < 32) sbase[tid] = (int)__hip_atomic_fetch_add((unsigned*)F.ctl + CW_CNT + layer * 32 + tid, (unsigned)hist[tid], __ATOMIC_RELAXED, __HIP_MEMORY_SCOPE_AGENT);
    __syncthreads();
    int* slot = (int*)(F.ws + WS_SLOT);
    for (int i = tid; i < nloc * 4; i += NTHR) { const unsigned en = ent[i]; if (en != 0xffffffffu) { const int e = en & 255, pos = sbase[e] + (int)(en >> 8); const int r = blk + (i >> 2) * G;
        slot[e * CAP + pos] = r * 4 + (i & 3); ((float*)(F.ws + WS_SGATE))[e * CAP + pos] = entg[i]; ((int*)(F.ws + WS_GATE))[r * 4 + (i & 3)] = e | (pos << 8); } }
    __syncthreads();
}
__device__ __forceinline__ void moe_tables(Frame& F, int layer) {
    PHASE_IDS();
    LAS int* tab = (LAS int*)(F.lds + LDS_TAB);
    if (tid == 0) { int acc = 0;
        for (int e = 0; e < 32; ++e) { const int c = (int)__hip_atomic_load((unsigned*)F.ctl + CW_CNT + layer * 32 + e, __ATOMIC_RELAXED, __HIP_MEMORY_SCOPE_AGENT); tab[e] = acc; tab[33 + e] = c; acc += (c + 255) >> 8; }
        tab[32] = acc; }
    __syncthreads();
}
__device__ __forceinline__ void phase_combine(Frame& F, int layer) {
    PHASE_IDS();
    const int gw = blk_ * NWAVES + wave, NGW = F.G * NWAVES;
    const int nrows = layer == 0 ? NROW : NLAT;
    const unsigned char* yk = F.ws + WS_YK; bf16_t* x1b = (bf16_t*)(F.ws + WS_X1);
    LAS float* mv = (LAS float*)F.lds;
    { const float* mg = (const float*)(F.ws + WS_MODV);
      for (int i = tid; i < 9 * 256; i += NTHR) { const int v = i >> 8, c4 = i & 255, w = v / 3, k = v % 3;
          const float* src = (k == 0) ? mg + (size_t)((layer * 3 + w) * 6 + 5) * 1024 : mg + (size_t)((1 * 3 + w) * 6 + (k - 1)) * 1024;
          *(LAS f32x4*)(mv + v * 1024 + 4 * c4) = *(const f32x4*)(src + 4 * c4); } }
    moe_tables(F, layer);
    const LAS int* ttab = (const LAS int*)(F.lds + LDS_TAB); const int* epos = (const int*)(F.ws + WS_GATE);
#define CMB_ISSUE(R, EP, YB, XB) do { _Pragma("unroll") for (int k = 0; k < 4; ++k) { const int ep = __builtin_amdgcn_readfirstlane(EP[k]); const unsigned char* yr = yk + (size_t)(256 * ttab[ep & 255] + (ep >> 8)) * D + 4 * lane; \
        _Pragma("unroll") for (int j = 0; j < 4; ++j) YB[k][j] = *(const unsigned*)(yr + 256 * j); } \
        _Pragma("unroll") for (int j = 0; j < 4; ++j) XB[j] = *(const u32x2*)(x1b + (size_t)(R) * D + 4 * lane + 256 * j); } while (0)
    int epn[4]; unsigned yb[4][4]; u32x2 xb[4];
#pragma unroll
    for (int k = 0; k < 4; ++k) epn[k] = (gw < nrows) ? epos[gw * 4 + k] : 0;
    if (gw < nrows) CMB_ISSUE(gw, epn, yb, xb);
    if (gw + NGW < nrows) {
#pragma unroll
        for (int k = 0; k < 4; ++k) epn[k] = epos[(gw + NGW) * 4 + k];
    }
    for (int r = gw; r < nrows; r += NGW) {
        const int w = row_which(r), rn = r + NGW;
        unsigned yn[4][4]; u32x2 xn[4];
        if (rn < nrows) {
            CMB_ISSUE(rn, epn, yn, xn);
            if (rn + NGW < nrows) {
#pragma unroll
                for (int k = 0; k < 4; ++k) epn[k] = epos[(rn + NGW) * 4 + k];
            }
        }
        f32x4 x[4], f[4];
#pragma unroll
        for (int j = 0; j < 4; ++j) { x[j] = (f32x4){bflo(xb[j].x), bfhi(xb[j].x), bflo(xb[j].y), bfhi(xb[j].y)}; f[j] = (f32x4){0.f, 0.f, 0.f, 0.f}; }
#pragma unroll
        for (int k = 0; k < 4; ++k)
#pragma unroll
            for (int j = 0; j < 4; ++j) { const unsigned u = yb[k][j];
                const f32x2 lo = __builtin_amdgcn_cvt_pk_f32_fp8((int)u, false), hi = __builtin_amdgcn_cvt_pk_f32_fp8((int)u, true); f[j][0] += lo[0]; f[j][1] += lo[1]; f[j][2] += hi[0]; f[j][3] += hi[1]; }
#pragma unroll
        for (int j = 0; j < 4; ++j) f[j] = f[j] * 0.0625f;
        const float rf = __builtin_amdgcn_rsqf(row_sumsq(f) * (1.f / 1024.f) + EPS);
        const LAS float* c2 = mv + (w * 3 + 0) * 1024;
#pragma unroll
        for (int j = 0; j < 4; ++j) { const f32x4 cv = *(const LAS f32x4*)(c2 + 4 * lane + 256 * j); x[j] = x[j] + cv * (f[j] * rf); }
        if (layer == 1) row_store(F.out + (size_t)r * D, lane, x);
        else { row_store_bf16(x1b + (size_t)r * D, lane, x);
            const float rr_ = __builtin_amdgcn_rsqf(row_sumsq(x) * (1.f / 1024.f) + EPS); const LAS float* ah_ = mv + (w * 3 + 1) * 1024; const LAS float* bh_ = mv + (w * 3 + 2) * 1024;
            f32x4 o[4];
#pragma unroll
            for (int j = 0; j < 4; ++j) { const f32x4 av = *(const LAS f32x4*)(ah_ + 4 * lane + 256 * j), bv = *(const LAS f32x4*)(bh_ + 4 * lane + 256 * j); o[j] = x[j] * rr_ * av + bv; }
            row_store_bf16((bf16_t*)(F.ws + WS_H) + (size_t)r * D, lane, o); }
#pragma unroll
        for (int k = 0; k < 4; ++k)
#pragma unroll
            for (int j = 0; j < 4; ++j) yb[k][j] = yn[k][j];
#pragma unroll
        for (int j = 0; j < 4; ++j) xb[j] = xn[j];
    }
#undef CMB_ISSUE
}

__device__ __forceinline__ void gemm_tail_copy(Frame& F, int layer, int which) {
    PHASE_IDS();
    const P0Split sp = p0_split(F.G, layer);
    const int thr = which ? sp.thrO : sp.thrI, nshort = which ? sp.shortO : sp.shortI, n = which ? sp.NO : sp.NI, off = sp.NA + sp.NC + (which ? sp.NI : 0);
    if (nshort > 0 && blk_ >= thr) p0_run(F, (LAS float*)(F.lds + wave * 16384), lane, layer * P0_PER_L + P0_NFIX + off, (blk_ - thr) * NWAVES + wave, nshort * NWAVES, n);
}

struct Args { const float* in[21]; float* out; unsigned char* ws; int ph_lo, ph_hi; };
constexpr int PH_PER_LAYER = 10, NPHASE = 2 + 2 * PH_PER_LAYER;
template <int SUB> __global__ void __launch_bounds__(NTHR, 2) mk_fwd(Args args) {
    extern __shared__ __attribute__((aligned(16))) unsigned char lds_raw[];
    Frame F;
    F.lds = (LAS unsigned char*)lds_raw; F.ws = args.ws; F.out = args.out;
#pragma unroll
    for (int i = 0; i < 21; ++i) F.in[i] = args.in[i];
    F.ctl = (gu32*)(args.ws + WS_CTL);
    __builtin_amdgcn_s_setreg(1473, 1);
    F.tid = threadIdx.x; F.lane = F.tid & 63; F.wave = __builtin_amdgcn_readfirstlane(F.tid >> 6); F.G = gridDim.x; F.blk = blockIdx.x;
    volatile LAS unsigned* misc = (volatile LAS unsigned*)(F.lds + LDS_MISC);
    if (F.tid < 16) misc[F.tid] = 0u;
    __syncthreads();
    const int lo = args.ph_lo, hi = args.ph_hi;
    const bool use_bar = (hi - lo) > 1;
    XcdBarrier bar; bar.bar = (unsigned*)F.ctl + CW_BAR; bar.x = 0; bar.st = nullptr;
    if (use_bar) { bar = xcd_barrier_post((unsigned*)F.ctl + CW_BAR, misc + 8); if (F.tid == 0) xcd_barrier_census(bar); }
#define IN(k) (lo <= (k) && (k) < hi)
#define SEAM(k) do { if (IN(k) && IN((k) + 1)) xcd_barrier(bar); } while (0)
    if (PHON(0) && IN(0)) { for (int rep = 0; rep < NREP(0); ++rep) phase_prologue_a(F); } SEAM(0);
    if (PHON(1) && IN(1)) { for (int rep = 0; rep < NREP(1); ++rep) phase_prologue_b(F); } SEAM(1);
    for (int layer = 0; layer < 2; ++layer) {
        const int p0 = 2 + layer * PH_PER_LAYER;
        unsigned char* ws = F.ws;
        int blk_ = F.blk; asm volatile("" : "+s"(blk_));
        if (PHON(2) && IN(p0 + 0)) {
            pg8::DenseSched S; S.init(ws + WS_H, (bf16_t*)(ws + WS_WIN) + (size_t)layer * NIN * 1024, NROW, NIN, F.G, blk_);
            EpiInProj E{ws, (const float*)(ws + WS_TAB), (const float*)(ws + WS_ROPE), layer};
            if (STAG_EN_IN) stagger_dense((NROW / 256) * (NIN / 256), F.G, blk_);
            for (int rep = 0; rep < NREP(2); ++rep) pg8::gemm_phase<EpiInProj, pg8::DenseSched, false, false, (SUB & 4) != 0>(F.lds, F.wave, S, E);
            gemm_tail_copy(F, layer, 0);
        } SEAM(p0 + 0);
        if (PHON(3) && IN(p0 + 1)) { if constexpr (SUB & 1) phase_scan2_a(F, layer); if constexpr (SUB & 2) phase_attn<0>(F, layer, 0, F.G); } SEAM(p0 + 1);
        if (PHON(4) && IN(p0 + 2)) { for (int rep = 0; rep < NREP(4); ++rep) phase_scan_b(F); } SEAM(p0 + 2);
        if (PHON(5) && IN(p0 + 3)) { if constexpr (SUB & 1) phase_scan2_c(F, layer); if constexpr (SUB & 2) phase_attn<0>(F, layer, F.G, 1 << 30); } SEAM(p0 + 3);
          if (IN(p0 + 4) && IN(p0 + 5) && !IN(p0 + 3)) xcd_barrier(bar);
        if (PHON(7) && IN(p0 + 5)) {
            pg8::DenseSched S; S.init(ws + WS_MIX, (bf16_t*)(ws + WS_WOUT) + (size_t)layer * 1024 * 1024, layer == 0 ? NROW : NLAT, 1024, F.G, blk_);
            EpiBf16OutT<(SUB & 64) != 0> E{(bf16_t*)(ws + WS_Y)};
            { const int nwg = ((layer == 0 ? NROW : NLAT) / 256) * 4; if (STAG_EN_OUT && (nwg % F.G)) stagger_dense(nwg, F.G, blk_); }
            for (int rep = 0; rep < NREP(7); ++rep) pg8::gemm_phase<EpiBf16OutT<(SUB & 64) != 0>, pg8::DenseSched, false, false, (SUB & 4) != 0>(F.lds, F.wave, S, E);
            gemm_tail_copy(F, layer, 1);
        } SEAM(p0 + 5);
        if (PHON(8) && IN(p0 + 6)) { phase_route(F, layer); } SEAM(p0 + 6);
        if (PHON(9) && IN(p0 + 7)) {
            moe_tables(F, layer);
            pg8::MoeSched<8, true, 1024> S{(const char*)(ws + WS_TOK8), (const char*)(ws + WS_W1 + (size_t)layer * NE * 2048 * 1024), (const int*)(ws + WS_SLOT), (const LAS int*)(F.lds + LDS_TAB), F.G, blk_, (size_t)2048 * 1024};
            EpiSwiglu E{ws + WS_ACT, F.in[18] + (size_t)layer * NE * 2048};
            for (int rep = 0; rep < NREP(9); ++rep) pg8::gemm_phase<EpiSwiglu, pg8::MoeSched<8, true, 1024>, true, true, (SUB & 4) != 0>(F.lds, F.wave, S, E);
        } SEAM(p0 + 7);
        if (PHON(10) && IN(p0 + 8)) {
            moe_tables(F, layer);
            pg8::MoeSched<4, false, 1024> S{(const char*)(ws + WS_ACT), (const char*)(ws + WS_W2 + (size_t)layer * NE * 1024 * 1024), (const int*)(ws + WS_SLOT), (const LAS int*)(F.lds + LDS_TAB), F.G, blk_, (size_t)1024 * 1024};
            EpiMoeOutT<((SUB & 64) ? 1 : (SUB & 128) ? 2 : 0)> E{ws + WS_YK, F.in[20] + (size_t)layer * NE * 1024, (const float*)(ws + WS_SGATE)};
            if (STAG_EN_G2 && (F.G & 7) == 0) { const int ntile = __builtin_amdgcn_readfirstlane(((const LAS int*)(F.lds + LDS_TAB))[32]), per = F.G >> 2;
                const int rem = ntile - 8 * (blk_ >> 5) - (blk_ & 7), cnt = rem > 0 ? (rem + per - 1) / per : 0, nmax = (ntile + per - 1) / per;
                stagger_ns(blk_ * STAG_STEP + (cnt < nmax ? STAG_SHORT : 0)); }
            for (int rep = 0; rep < NREP(10); ++rep) pg8::gemm_phase<EpiMoeOutT<((SUB & 64) ? 1 : (SUB & 128) ? 2 : 0)>, pg8::MoeSched<4, false, 1024>, false, true, (SUB & 4) != 0>(F.lds, F.wave, S, E);
        } SEAM(p0 + 8);
        if (PHON(11) && IN(p0 + 9)) { phase_combine(F, layer); } SEAM(p0 + 9);
    }
#ifdef OVFL_PROBE
    int lane_z; asm volatile("v_mbcnt_lo_u32_b32 %0, -1, 0\n\tv_mbcnt_hi_u32_b32 %0, -1, %0" : "=v"(lane_z));
    if (hi == NPHASE && F.blk == 0 && F.wave == 0 && lane_z == 0) { int w = 0; float big = 1e6f, huge = 3e38f; asm volatile("" : "+v"(big), "+v"(huge));
      w = __builtin_amdgcn_cvt_pk_bf8_f32(big, huge, w, false); int w2 = 0; w2 = __builtin_amdgcn_cvt_pk_fp8_f32(big, huge, w2, false);
      if (((w & 0xffff) != 0x7B7B) || ((w2 & 0xffff) != 0x7E7E)) { asm volatile("s_waitcnt vmcnt(0)" ::: "memory"); F.out[5] = __builtin_nanf(""); } }
#endif
#undef IN
#undef SEAM
}


#ifdef DBG_CHECK
namespace dbg {
__device__ float blk_sum(float v, float* red) { const int t = threadIdx.x; red[t] = v; __syncthreads(); for (int o = 128; o > 0; o >>= 1) { if (t < o) red[t] += red[t + o]; __syncthreads(); } const float r = red[0]; __syncthreads(); return r; }
struct Ctx { const float* const* in; unsigned char* ws; float* red; };
__device__ float bfb(const unsigned char* ws, size_t off, size_t idx) { return bf2f(((const bf16_t*)(ws + off))[idx]); }
__device__ float zdot(const Ctx& c, int row, int ocol) {
    float a = 0.f; for (int k = threadIdx.x; k < 1024; k += 256) a += bfb(c.ws, WS_H, (size_t)row * 1024 + k) * c.in[7][(size_t)k * 4224 + ocol];
    return blk_sum(a, c.red);
}
__device__ void upd(float* flag, float got, float want) { const float e = fabsf(got - want) / (fabsf(want) + 0.05f); if (threadIdx.x == 0 && (e > *flag || !(e == e))) *flag = (e == e) ? e : 1e9f; }
__device__ float sc_buf(const Ctx& c, int which, int row, int col) { return bfb(c.ws, WS_SCAN + (size_t)which * SCAN_PITCH, (size_t)row * 384 + col); }
__device__ void naive_scan(const Ctx& c, const float* tab, int type, int b, int h, int dir, int n, float* S, float* o64) {
    const int t = threadIdx.x;
    for (int i = t; i < 4096; i += 256) S[i] = 0.f; __syncthreads();
    const float gam = tab[TB_GAM + 0 * 12 + dir * 6 + h];
    int lastrow = 0;
    for (int p = 0; p < n; ++p) {
        const int sc = p < 256 ? 0 : 1 + (p - 256) / 256, pl = p < 256 ? p : (p - 256) % 256; const int row = scan_row(sc, pl, dir, 0) + (sc == 0 ? b * CL : b * T); lastrow = row;
        for (int i = t; i < 4096; i += 256) { const int k = i >> 6, v = i & 63;
            const float kk = sc_buf(c, type ? SC_RK : (dir ? SC_KB : SC_KF), row, h * 64 + k), vv = sc_buf(c, type ? SC_RV : SC_HV, row, h * 64 + v);
            const float f = type ? gam : 1.f - kk; S[i] = f * S[i] + kk * vv; }
        __syncthreads();
    }
    if (t < 64) { float o = 0.f; for (int k = 0; k < 64; ++k) o += sc_buf(c, type ? SC_RQ : SC_HQ, lastrow, h * 64 + k) * S[k * 64 + t]; o64[t] = o; }
    __syncthreads();
}
__global__ void __launch_bounds__(256) k_check(Args args, float* flags) {
    __shared__ float red[256]; __shared__ float S[4096]; __shared__ float o1[64], o2[64];
    Ctx c{args.in, args.ws, red}; const int id = blockIdx.x, t = threadIdx.x; float* fl = flags + id;
    const float* tab = (const float*)(args.ws + WS_TAB);
    if (t == 0) { *fl = 0.f; if (id == 12) { flags[13] = 0.f; flags[14] = 0.f; flags[15] = 0.f; } } __syncthreads();
#define rows(i) ((i) == 0 ? 5 : (i) == 1 ? 20000 : 33000)
    if (id == 0) { for (int ri = 0; ri < 3; ++ri) for (int cc = 3; cc < 384; cc += 197) { const float z = zdot(c, rows(ri), cc); upd(fl, sc_buf(c, SC_HQ, rows(ri), cc), z); } }
    if (id == 1) { for (int ri = 0; ri < 3; ++ri) for (int cc = 3; cc < 384; cc += 197) { upd(fl, sc_buf(c, SC_HV, rows(ri), cc), zdot(c, rows(ri), 1152 + cc)); upd(fl, sc_buf(c, SC_RG, rows(ri), cc), zdot(c, rows(ri), 3072 + cc)); upd(fl, sc_buf(c, SC_HG, rows(ri), cc), zdot(c, rows(ri), 1536 + cc)); upd(fl, sc_buf(c, SC_RV, rows(ri), cc), zdot(c, rows(ri), 2688 + cc)); } }
    if (id == 2) { for (int ri = 0; ri < 3; ++ri) for (int cc = 3; cc < 384; cc += 197) { const float z1 = zdot(c, rows(ri), 384 + cc), z2 = zdot(c, rows(ri), 768 + cc); upd(fl, sc_buf(c, SC_KF, rows(ri), cc), 1.f / (1.f + expf(z1))); upd(fl, sc_buf(c, SC_KB, rows(ri), cc), 1.f / (1.f + expf(z2))); } }
    if (id == 3) { for (int ri = 0; ri < 3; ++ri) for (int hh = 0; hh < 6; hh += 5) for (int i = 1; i < 32; i += 13) for (int isk = 0; isk < 2; ++isk) { const int r = rows(ri); const bool ctx = r >= NLAT; const int tt = r & (T - 1);
            const float x1 = zdot(c, r, 1920 + 384 * isk + hh * 64 + i), x2 = zdot(c, r, 1920 + 384 * isk + hh * 64 + i + 32);
            const float ang = ctx ? 0.f : (float)tt * powf(10000.f, -(float)i / 32.f); const float cs = cosf(ang), sn = sinf(ang), scl = isk ? 0.125f : 1.f;
            upd(fl, sc_buf(c, isk ? SC_RK : SC_RQ, r, hh * 64 + 2 * i), (x1 * cs - x2 * sn) * scl); upd(fl, sc_buf(c, isk ? SC_RK : SC_RQ, r, hh * 64 + 2 * i + 1), (x2 * cs + x1 * sn) * scl); } }
    if (id == 4) { for (int ri = 0; ri < 3; ++ri) for (int mp = 0; mp < 8; mp += 7) for (int half = 0; half < 2; ++half) for (int j = 1; j < 8; j += 5) { const int r = rows(ri); const bool ctx = r >= NLAT; const int tt = ctx ? (r - NLAT) & 255 : r & (T - 1); const int bb = ctx ? (r - NLAT) >> 8 : r >> 14;
            const int pos = half ? (tt & 63) : (tt >> 6); const float ang = ctx ? 0.f : (float)pos * powf(10000.f, -(float)j / 8.f); const float cs = cosf(ang), sn = sinf(ang);
            { const float x1 = zdot(c, r, 3456 + mp * 32 + half * 16 + j), x2 = zdot(c, r, 3456 + mp * 32 + half * 16 + j + 8); const float scl = 0.17677669529663687f * LOG2E;
              const size_t qi = ctx ? ((size_t)(bb * 8 + mp) * CL + tt) * 32 + half * 16 + 2 * j : ((size_t)(bb * 8 + mp) * T + tt) * 32 + half * 16 + 2 * j;
              upd(fl, bfb(c.ws, ctx ? WS_QC : WS_QA, qi), (x1 * cs - x2 * sn) * scl); upd(fl, bfb(c.ws, ctx ? WS_QC : WS_QA, qi + 1), (x2 * cs + x1 * sn) * scl); }
            { const float x1 = zdot(c, r, 3712 + mp * 32 + half * 16 + j), x2 = zdot(c, r, 3712 + mp * 32 + half * 16 + j + 8);
              const int Lk = ctx ? tt : 256 + tt, tile = Lk >> 6, rr = Lk & 63, pw = half * 16 + 2 * j;
              const size_t ki = ((size_t)((bb * 8 + mp) * KT_TILES + tile) * 4 + (pw >> 3)) * 512 + rr * 8 + (pw & 7);
              upd(fl, bfb(c.ws, WS_KA, ki), x1 * cs - x2 * sn); upd(fl, bfb(c.ws, WS_KA, ki + 1), x2 * cs + x1 * sn); }
            { const int h4 = mp >> 1, w = half * 32 + j * 3; const float z = zdot(c, r, 3968 + h4 * 64 + w); const int Lk = ctx ? tt : 256 + tt, tile = Lk >> 6, rr = Lk & 63;
              upd(fl, bfb(c.ws, WS_VA, ((size_t)((bb * 4 + h4) * KT_TILES + tile) * 2 + (w >> 5)) * 2048 + rr * 32 + (w & 31)), z); } } }
    if (id == 5 || id == 6) {
        const int type = id - 5, b = 1, h = 2;
#define ts(i) ((i) == 0 ? 0 : (i) == 1 ? 1 : 300)
        for (int q = 0; q < 3; ++q) { naive_scan(c, tab, type, b, h, 0, 256 + ts(q) + 1, S, o1);
            if (t < 64) { const float got = ((const float*)(args.ws + WS_OSCR))[(size_t)(b * T + ts(q)) * 768 + type * 384 + h * 64 + t]; const float e = fabsf(got - o1[t]) / (fabsf(o1[t]) + 0.05f); if (e > 0.05f || !(e == e)) atomicMax((int*)fl, __float_as_int((e == e) ? e : 1e9f)); } __syncthreads(); }
    }
    if (id == 7 || id == 8) {
        const int type = id - 7, b = 1, h = 4;
        for (int q = 0; q < 2; ++q) {
            int row;
            if (q == 0) { naive_scan(c, tab, type, b, h, 0, 101, S, o1); naive_scan(c, tab, type, b, h, 1, 256 - 100, S, o2); row = NLAT + b * CL + 100; }
            else { naive_scan(c, tab, type, b, h, 1, 257, S, o2); row = b * T + T - 1; if (t < 64) o1[t] = ((const float*)(args.ws + WS_OSCR))[(size_t)row * 768 + type * 384 + h * 64 + t]; __syncthreads(); }
            float o = t < 64 ? o1[t] + o2[t] : 0.f; const float ss = blk_sum(o * o, red); const float r = rsqrtf(ss / 64.f + EPS);
            if (t < 64) { const float g = sc_buf(c, type ? SC_RG : SC_HG, row, h * 64 + t); const float want = o * r * args.in[type ? 11 : 9][t] * g / (1.f + expf(-g));
                const float got = bfb(c.ws, WS_MIX, (size_t)row * 1024 + type * 384 + h * 64 + t); const float e = fabsf(got - want) / (fabsf(want) + 0.05f); if (e > 0.05f || !(e == e)) atomicMax((int*)fl, __float_as_int((e == e) ? e : 1e9f)); }
            __syncthreads(); }
    }
    if (id == 9) {
        for (int q = 0; q < 2; ++q) { const bool ctx = q == 1; const int b = ctx ? 0 : 1, h = ctx ? 3 : 2, tq = ctx ? 77 : 5000; const int nk = ctx ? 256 : 16640;
            __shared__ float po[2][64]; __shared__ float pl[2];
            for (int m = 0; m < 2; ++m) { const int mp = b * 8 + 2 * h + m;
                float mx = -1e30f;
                for (int kk = t; kk < nk; kk += 256) { float sdot = 0.f; for (int d = 0; d < 32; ++d) { const float qv = bfb(c.ws, ctx ? WS_QC : WS_QA, ((size_t)mp * (ctx ? CL : T) + tq) * 32 + d); const float kv = bfb(c.ws, WS_KA, ((size_t)(mp * KT_TILES + (kk >> 6)) * 4 + (d >> 3)) * 512 + (kk & 63) * 8 + (d & 7)); sdot += qv * kv; } mx = fmaxf(mx, sdot); }
                red[t] = mx; __syncthreads(); for (int o = 128; o > 0; o >>= 1) { if (t < o) red[t] = fmaxf(red[t], red[t + o]); __syncthreads(); } mx = red[0]; __syncthreads();
                float ls = 0.f; float av[64];
_Pragma("unroll") for (int d = 0; d < 64; ++d) av[d] = 0.f;
                for (int kk = t; kk < nk; kk += 256) { float sdot = 0.f; for (int d = 0; d < 32; ++d) { const float qv = bfb(c.ws, ctx ? WS_QC : WS_QA, ((size_t)mp * (ctx ? CL : T) + tq) * 32 + d); const float kv = bfb(c.ws, WS_KA, ((size_t)(mp * KT_TILES + (kk >> 6)) * 4 + (d >> 3)) * 512 + (kk & 63) * 8 + (d & 7)); sdot += qv * kv; }
                    const float p = exp2f(sdot - mx); ls += p;
_Pragma("unroll") for (int d = 0; d < 64; ++d) av[d] += p * bfb(c.ws, WS_VA, ((size_t)((b * 4 + h) * KT_TILES + (kk >> 6)) * 2 + (d >> 5)) * 2048 + (kk & 63) * 32 + (d & 31)); }
                ls = blk_sum(ls, red);
_Pragma("unroll") for (int d = 0; d < 64; ++d) { const float sv = blk_sum(av[d], red); if (t == 0) po[m][d] = sv; } if (t == 0) pl[m] = ls; __syncthreads();
            }
            const float lam = tab[TB_LAM + 0], oml = tab[TB_LAM + 2];
            float o = t < 64 ? po[0][t] / pl[0] - lam * po[1][t] / pl[1] : 0.f; const float ss = blk_sum(o * o, red); const float r = rsqrtf(ss / 64.f + EPS);
            if (t < 64) { const float want = o * r * args.in[13][t] * oml; const size_t row = ctx ? (size_t)(NLAT + b * CL + tq) : (size_t)(b * T + tq); const float got = bfb(c.ws, WS_MIX, row * 1024 + 768 + h * 64 + t);
                const float e = fabsf(got - want) / (fabsf(want) + 0.05f); if (e > 0.05f || !(e == e)) atomicMax((int*)fl, __float_as_int((e == e) ? e : 1e9f)); }
            __syncthreads(); }
    }
    if (id == 10) { for (int ri = 0; ri < 3; ++ri) for (int cc = 7; cc < 1024; cc += 401) { float a = 0.f; for (int k = t; k < 1024; k += 256) a += bfb(c.ws, WS_MIX, (size_t)rows(ri) * 1024 + k) * args.in[14][(size_t)k * 1024 + cc]; a = blk_sum(a, red); upd(fl, ((const float*)(args.ws + WS_Y))[(size_t)rows(ri) * 1024 + cc], a); } }
    if (id == 11) {
        const float* modv = (const float*)(args.ws + WS_MODV);
        for (int ri = 0; ri < 3; ++ri) { const int r = rows(ri), w = row_which(r); const float* xs = r < NLAT ? args.in[0] + (size_t)r * D : args.in[2] + (size_t)(r - NLAT) * D; const float* y = (const float*)(args.ws + WS_Y) + (size_t)r * D;
            float sy = 0.f; for (int k = t; k < 1024; k += 256) sy += y[k] * y[k]; sy = blk_sum(sy, red); const float ry = rsqrtf(sy / 1024.f + EPS);
            float x1[4]; float sx = 0.f;
_Pragma("unroll") for (int q = 0; q < 4; ++q) { const int k = t + 256 * q; x1[q] = xs[k] + modv[(size_t)(w * 6 + 2) * 1024 + k] * y[k] * ry; sx += x1[q] * x1[q]; } sx = blk_sum(sx, red); const float rx = rsqrtf(sx / 1024.f + EPS);
_Pragma("unroll")
            for (int q = 0; q < 4; ++q) { const int k = t + 256 * q; const float tk = x1[q] * rx * modv[(size_t)(w * 6 + 3) * 1024 + k] + modv[(size_t)(w * 6 + 4) * 1024 + k];
                const float got = bfb(c.ws, WS_H, (size_t)r * 1024 + k), got1 = ((const float*)(args.ws + WS_X1))[(size_t)r * 1024 + k];
                const float e = fmaxf(fabsf(got - tk) / (fabsf(tk) + 0.05f), fabsf(got1 - x1[q]) / (fabsf(x1[q]) + 0.05f)); if (e > 0.05f || !(e == e)) atomicMax((int*)fl, __float_as_int((e == e) ? e : 1e9f)); }
            __syncthreads(); } }

    if (id == 12) {
        __shared__ float tokf[1024], lg[32], abuf[2048], actb[1024], yb[1024]; __shared__ int te[4]; __shared__ float tg[4]; __shared__ int spos;
        const unsigned* cnt = (const unsigned*)(args.ws + WS_CTL) + CW_CNT; const int* slot = (const int*)(args.ws + WS_SLOT);
        for (int ri = 0; ri < 3; ++ri) { const int r = rows(ri);
            for (int k = t; k < 1024; k += 256) tokf[k] = bfb(c.ws, WS_H, (size_t)r * 1024 + k); __syncthreads();
            if (t < 32) { float a = args.in[16][t]; for (int k = 0; k < 1024; ++k) a += tokf[k] * args.in[15][(size_t)k * 32 + t]; lg[t] = a; } __syncthreads();
            if (t < 32) { const float got = ((const float*)(args.ws + WS_END + 65536))[(size_t)r * 32 + t]; const float e = fabsf(got - lg[t]); if (e > 0.02f || !(e == e)) atomicMax((int*)(flags + 15), __float_as_int((e == e) ? 1.f + e : 1e9f)); } __syncthreads();
            if (t == 0) { float tv[4]; for (int k = 0; k < 4; ++k) { int bi = 0; float bv = -1e30f; for (int e = 0; e < 32; ++e) if (lg[e] > bv) { bv = lg[e]; bi = e; } te[k] = bi; tv[k] = bv; lg[bi] = -1e30f; }
                float sm = 0.f; for (int k = 0; k < 4; ++k) { tg[k] = expf(tv[k] - tv[0]); sm += tg[k]; } for (int k = 0; k < 4; ++k) tg[k] /= sm; } __syncthreads();
            if (t < 4) { const float got = ((const float*)(args.ws + WS_GATE))[(size_t)r * 4 + t]; const float e = fabsf(got - tg[t]) / (tg[t] + 0.01f); if (e > 0.05f || !(e == e)) atomicMax((int*)(flags + 12), __float_as_int((e == e) ? e : 1e9f)); }
            for (int k4 = 0; k4 < 4; ++k4) { const int e = te[k4]; const float* w1 = args.in[17] + (size_t)e * 1024 * 2048; const float* w2 = args.in[19] + (size_t)e * 1024 * 1024;
                for (int n = t; n < 2048; n += 256) { float a = args.in[18][(size_t)e * 2048 + n]; for (int k = 0; k < 1024; ++k) a += tokf[k] * w1[(size_t)k * 2048 + n]; abuf[n] = a; } __syncthreads();
                for (int j = t; j < 1024; j += 256) { const float g = fminf(abuf[2 * j], 7.f), l = fminf(fmaxf(abuf[2 * j + 1], -7.f), 7.f); actb[j] = g / (1.f + expf(-1.702f * g)) * (l + 1.f); } __syncthreads();
                for (int cc = t; cc < 1024; cc += 256) { float a = args.in[20][(size_t)e * 1024 + cc]; for (int j = 0; j < 1024; ++j) a += actb[j] * w2[(size_t)j * 1024 + cc]; yb[cc] = a * tg[k4]; } __syncthreads();
                if (t == 0) spos = -1; __syncthreads();
                const int ce = (int)cnt[e]; for (int p = t; p < ce; p += 256) if (slot[e * CAP + p] == r * 4 + k4) spos = p; __syncthreads();
                int ts0 = 0; for (int q = 0; q < e; ++q) ts0 += ((int)cnt[q] + 255) >> 8;
                float sqa = 0.f, sqy = 0.f; for (int k = t; k < 1024; k += 256) { sqa += actb[k] * actb[k]; sqy += yb[k] * yb[k]; } sqa = blk_sum(sqa, red); sqy = blk_sum(sqy, red); const float ra = sqrtf(sqa / 1024.f), ry = sqrtf(sqy / 1024.f);
                if (spos < 0) { if (t == 0) flags[13] = 7e8f; }
                else for (int k = t; k < 1024; k += 256) { const float got = bfb(c.ws, WS_ACT, ((size_t)ts0 * 256 + spos) * 1024 + k); const float er = fabsf(got - actb[k]) / (fabsf(actb[k]) + 0.2f * ra + 1e-6f); if (er > 0.05f || !(er == er)) atomicMax((int*)(flags + 13), __float_as_int((er == er) ? er : 1e9f)); }
                for (int k = t; k < 1024; k += 256) { const float got = bfb(c.ws, WS_YK, ((size_t)r * 4 + k4) * 1024 + k); const float er = fabsf(got - yb[k]) / (fabsf(yb[k]) + 0.2f * ry + 1e-6f); if (er > 0.05f || !(er == er)) atomicMax((int*)(flags + 14), __float_as_int((er == er) ? er : 1e9f)); }
                __syncthreads(); }
        } }
}
__global__ void k_out(Args args, const float* flags, int nchk, unsigned mask) {
    int code = 0; for (int i = nchk - 1; i >= 0; --i) if (((mask >> i) & 1u) && flags[i] > 0.05f) code = i + 1;
    const float sc = 1.f + (float)code;
    for (size_t i = (size_t)blockIdx.x * blockDim.x + threadIdx.x; i < (size_t)NLAT * D; i += (size_t)gridDim.x * blockDim.x) args.out[i] = args.in[0][i] * sc;
}
}
#endif

extern "C" void kernel_launch(void* const* d_in, const int* in_sizes, int n_in, void* d_out, int out_size, void* d_ws, size_t ws_size, hipStream_t stream) {
    static int grid = 0;
    if (grid == 0) {
        if (n_in != 21 || out_size != NLAT * D || ws_size < WS_END) { fprintf(stderr, "kernel_launch: unexpected shapes (n_in %d out %d ws %zu)\n", n_in, out_size, ws_size); grid = -1; return; }
        int dev = 0, cus = 0, per_cu = 0;
        if (hipGetDevice(&dev) != hipSuccess || hipDeviceGetAttribute(&cus, hipDeviceAttributeMultiprocessorCount, dev) != hipSuccess) { grid = -1; return; }
        if (hipFuncSetAttribute((const void*)mk_fwd<MAIN_SUB>, hipFuncAttributeMaxDynamicSharedMemorySize, LDS_BYTES) != hipSuccess) { fprintf(stderr, "kernel_launch: hipFuncSetAttribute failed\n"); grid = -1; return; }
        if (hipOccupancyMaxActiveBlocksPerMultiprocessor(&per_cu, (const void*)mk_fwd<MAIN_SUB>, NTHR, LDS_BYTES) != hipSuccess || per_cu < 1) fprintf(stderr, "kernel_launch: occupancy query reports %d\n", per_cu);
        (void)hipGetLastError();
        grid = cus;
    }
    if (grid < 0) return;
    if (hipMemsetAsync((char*)d_ws + WS_CTL, 0, CTL_ZERO_BYTES, stream) != hipSuccess) return;
    Args a{};
    for (int i = 0; i < 21; ++i) a.in[i] = (const float*)d_in[i];
    a.out = (float*)d_out; a.ws = (unsigned char*)d_ws;
#if MK_ONE_LAUNCH
    a.ph_lo = 0; a.ph_hi = NPHASE;
    hipLaunchKernelGGL(mk_fwd<MAIN_SUB>, dim3(grid), dim3(NTHR), LDS_BYTES, stream, a);
#elif defined(DBG_CHECK)
    for (int p = 0; p < DBG_CHECK; ++p) { a.ph_lo = p; a.ph_hi = p + 1; hipLaunchKernelGGL(mk_fwd<MAIN_SUB>, dim3(grid), dim3(NTHR), LDS_BYTES, stream, a); }
    float* flags = (float*)((char*)d_ws + WS_END);
    hipLaunchKernelGGL(dbg::k_check, dim3(13), dim3(256), 0, stream, a, flags);
    hipLaunchKernelGGL(dbg::k_out, dim3(1024), dim3(256), 0, stream, a, (const float*)flags, 16, (unsigned)DBG_MASK);
#else
    if (hipFuncSetAttribute((const void*)mk_fwd<PROBE_SUB>, hipFuncAttributeMaxDynamicSharedMemorySize, LDS_BYTES) != hipSuccess) return;
    for (int p = 0; p < NPHASE; ++p) { a.ph_lo = p; a.ph_hi = p + 1; hipLaunchKernelGGL(mk_fwd<MAIN_SUB>, dim3(grid), dim3(NTHR), LDS_BYTES, stream, a);
        const int pid = p < 2 ? p : 2 + (p - 2) % PH_PER_LAYER;
        if (pid == PROBE_PH) for (int rep = 0; rep < PROBE_REP; ++rep) hipLaunchKernelGGL(mk_fwd<PROBE_SUB>, dim3(grid), dim3(NTHR), LDS_BYTES, stream, a); }
#endif
}
```

```cpp
#include <hip/hip_runtime.h>
#include <cstdio>
#include <cstdint>
#include <cmath>

#ifndef DBG_MASK
#define DBG_MASK 0xf800
#endif
#ifndef PHMASK
#define PHMASK 0xfff
#endif
#define PHON(k) ((PHMASK >> (k)) & 1)
#ifndef REPMASK
#define REPMASK 0
#endif
#define NREP(k) (1 + ((REPMASK >> (k)) & 1))
#ifndef ATTVAR
#define ATTVAR -1
#endif
#ifndef MK_ONE_LAUNCH
#define MK_ONE_LAUNCH 1
#endif
#define MAIN_SUB 3
#define PROBE_PH -1
#define PROBE_SUB 3
#define PROBE_REP 1

#define LAS __attribute__((address_space(3)))
#define GAS __attribute__((address_space(1)))
typedef unsigned short bf16_t;
typedef short bf16x8 __attribute__((ext_vector_type(8)));
typedef short s16x4 __attribute__((ext_vector_type(4)));
typedef float f32x2 __attribute__((ext_vector_type(2)));
typedef float f32x4 __attribute__((ext_vector_type(4)));
typedef float f32x16 __attribute__((ext_vector_type(16)));
typedef unsigned u32x2 __attribute__((ext_vector_type(2)));
typedef unsigned u32x4 __attribute__((ext_vector_type(4)));
typedef GAS unsigned gu32;
typedef int v4i __attribute__((ext_vector_type(4)));
typedef int v8i __attribute__((ext_vector_type(8)));

constexpr int NB = 2, T = 16384, CL = 256, D = 1024;
constexpr int NLAT = NB * T, NCTX = NB * CL, NROW = NLAT + NCTX;
constexpr int NE = 32, CAP = NROW;
constexpr int NIN = 4352;
constexpr int NSEQ = 48, NSC = 65;
constexpr int KT_TILES = 260;
constexpr float EPS = 1e-6f;
constexpr float LOG2E = 1.4426950408889634f;
constexpr int NWAVES = 8, NTHR = 512;

constexpr size_t MiB = 1u << 20;
constexpr size_t WS_CTL = 0, CTL_ZERO_BYTES = 64 * 1024;
constexpr size_t WS_MODV = 1 * MiB;
constexpr size_t WS_TAB = 1 * MiB + 256 * 1024;
constexpr size_t WS_RWT = 1 * MiB + 512 * 1024;
constexpr size_t WS_ROPE = 2 * MiB;
constexpr size_t WS_WIN = 6 * MiB;
constexpr size_t WS_WOUT = 23 * MiB;
constexpr size_t WS_W1 = 27 * MiB;
constexpr size_t WS_W2 = 283 * MiB;
constexpr size_t WS_X1 = 411 * MiB;
constexpr size_t WS_H = 541 * MiB;
constexpr size_t WS_SCAN = 606 * MiB;
constexpr size_t SCAN_PITCH = 25 * MiB;
constexpr size_t WS_QA = 831 * MiB;
constexpr size_t WS_QC = 847 * MiB;
constexpr size_t WS_KA = 848 * MiB;
constexpr size_t WS_VA = 865 * MiB;
constexpr size_t WS_SLOC = 882 * MiB;
constexpr size_t WS_SIN = 931 * MiB;
constexpr size_t WS_DEC = 980 * MiB;
constexpr size_t WS_OSCR = 981 * MiB;
constexpr size_t WS_MIX = 1079 * MiB;
constexpr size_t WS_Y = 1144 * MiB;
constexpr size_t WS_SLOT = 1274 * MiB;
constexpr size_t WS_GATE = 1279 * MiB;
constexpr size_t WS_ACT = 1280 * MiB;
constexpr size_t WS_YK = 1540 * MiB;
constexpr size_t WS_TOK8 = 1816 * MiB;
constexpr size_t WS_SGATE = 1850 * MiB;
constexpr size_t WS_END = 1856 * MiB;
enum { SC_KF = 0, SC_KB = 1, SC_RQ = 2, SC_RK = 3, SC_HQ = 4, SC_HV = 5, SC_HG = 6, SC_RV = 7, SC_RG = 8 };
constexpr int CW_TMO = 0, CW_BAR = 4096, CW_CNT = 8192;
constexpr int TB_LBT = 0;
constexpr int TB_LAM = 1024;
constexpr int TB_GAM = 1040;
constexpr int TB_AXR = 2048;
constexpr int TB_AXC = 2048 + 4096;

constexpr int LDS_BYTES = 147456;
constexpr int LDS_MISC = 131072 + 12288;
constexpr int LDS_TAB = 131072;

__device__ __forceinline__ unsigned f2bf(float f) { unsigned u = __builtin_bit_cast(unsigned, f); return (u + 0x7fffu + ((u >> 16) & 1u)) >> 16; }
__device__ __forceinline__ float bf2f(unsigned short b) { return __builtin_bit_cast(float, (unsigned)b << 16); }
__device__ __forceinline__ float bflo(unsigned w) { return __builtin_bit_cast(float, w << 16); }
__device__ __forceinline__ float bfhi(unsigned w) { return __builtin_bit_cast(float, w & 0xffff0000u); }
typedef __bf16 bf16x2_t __attribute__((ext_vector_type(2)));
__device__ __forceinline__ unsigned trunc_pk_bf16(float lo, float hi) { return __builtin_amdgcn_perm(__builtin_bit_cast(unsigned, hi), __builtin_bit_cast(unsigned, lo), 0x07060302u); }
__device__ __forceinline__ unsigned cvt_pk_bf16(float lo, float hi) { const f32x2 v = {lo, hi}; const bf16x2_t b = __builtin_convertvector(v, bf16x2_t); return __builtin_bit_cast(unsigned, b); }
__device__ __forceinline__ unsigned pk2(float lo, float hi) { return cvt_pk_bf16(lo, hi); }
__device__ __forceinline__ float wave_sum_dpp(float v) {
#define DPP_ADD(ctrl, rmask) v += __builtin_bit_cast(float, __builtin_amdgcn_update_dpp(0, __builtin_bit_cast(int, v), ctrl, rmask, 0xF, false))
    DPP_ADD(0xB1, 0xF); DPP_ADD(0x4E, 0xF); DPP_ADD(0x141, 0xF); DPP_ADD(0x140, 0xF); DPP_ADD(0x142, 0xA); DPP_ADD(0x143, 0xC);
#undef DPP_ADD
    return __builtin_bit_cast(float, __builtin_amdgcn_readlane(__builtin_bit_cast(int, v), 63));
}
__device__ __forceinline__ float wave_sum(float v) { return wave_sum_dpp(v); }
template <int M> __device__ __forceinline__ float xor_swz(float v) { return __builtin_bit_cast(float, __builtin_amdgcn_ds_swizzle(__builtin_bit_cast(int, v), 0x1F | (M << 10))); }
__device__ __forceinline__ float xor32(float v, int lane) { return __builtin_bit_cast(float, __builtin_amdgcn_ds_bpermute((lane ^ 32) << 2, __builtin_bit_cast(int, v))); }
__device__ __forceinline__ float rdlane(float v, int l) { return __builtin_bit_cast(float, __builtin_amdgcn_readlane(__builtin_bit_cast(int, v), l)); }
__device__ __forceinline__ float sigmoidf_(float x) { return __builtin_amdgcn_rcpf(1.f + __builtin_amdgcn_exp2f(-LOG2E * x)); }
#define PHASE_IDS_W(WV) int lane; asm volatile("v_mbcnt_lo_u32_b32 %0, -1, 0\n\tv_mbcnt_hi_u32_b32 %0, -1, %0" : "=v"(lane)); int wave = (WV); asm volatile("" : "+s"(wave)); const int tid = wave * 64 + lane; (void)tid
#define PHASE_IDS() PHASE_IDS_W(F.wave); int blk_ = F.blk; asm volatile("" : "+s"(blk_))
__device__ __forceinline__ unsigned pk4_fp8(float a, float b, float c, float d) { int w = __builtin_bit_cast(int, a); w = __builtin_amdgcn_cvt_pk_fp8_f32(a, b, w, false); w = __builtin_amdgcn_cvt_pk_fp8_f32(c, d, w, true); return (unsigned)w; }
constexpr float W8_MUL = 64.f;
constexpr float W8_INV = 1.f / 64.f;
#define LDS_WAIT() asm volatile("s_waitcnt lgkmcnt(0)" ::: "memory")
#define VM_WAIT() asm volatile("s_waitcnt vmcnt(0)" ::: "memory")

#define XB_TMO      128
#define XB_XCNT(j)  (256  + 64 * (j))
#define XB_XSUB(j)  (1280 + 64 * (j))
#define XB_XGEN(j)  (2304 + 64 * (j))
#define XB_TOP      3328
#define XB_TOPGEN   3392
#define XCD_BAR_WORDS 3456
#define XB_SPIN_CAP (1u << 22)
__device__ __forceinline__ unsigned xb_ld(unsigned* p)              { return __hip_atomic_load(p, __ATOMIC_RELAXED, __HIP_MEMORY_SCOPE_AGENT); }
__device__ __forceinline__ unsigned xb_add(unsigned* p, unsigned v) { return __hip_atomic_fetch_add(p, v, __ATOMIC_RELAXED, __HIP_MEMORY_SCOPE_AGENT); }
__device__ __forceinline__ unsigned xb_xcc_id() { return (unsigned)__builtin_amdgcn_s_getreg((3 << 11) | 20) & 0xFu; }
#define XB_SPIN(cond, bar) do { unsigned _sp = 0; while (cond) { __builtin_amdgcn_s_sleep(1); \
    if ((++_sp & 255u) == 0u) { if (xb_ld(&(bar)[XB_TMO])) break; if (_sp > XB_SPIN_CAP) { atomicAdd(&(bar)[XB_TMO], 1u); break; } } } } while (0)
struct XcdBarrier { unsigned* bar; unsigned x; volatile LAS unsigned* st; };
__device__ __forceinline__ XcdBarrier xcd_barrier_post(unsigned* bar, volatile LAS unsigned* st) {
    XcdBarrier b; b.bar = bar; b.x = xb_xcc_id(); b.st = st;
    if (threadIdx.x == 0) (void)xb_add(&bar[XB_XCNT(b.x)], 1u);
    return b;
}
__device__ __forceinline__ void xcd_barrier_complete(unsigned* bar, unsigned x, unsigned& nloc, unsigned& nx) {
    const unsigned G = gridDim.x * gridDim.y * gridDim.z;
    unsigned sum, cnt, mine, sp = 0u;
    for (;;) {
        sum = 0u; cnt = 0u; mine = 0u;
#pragma unroll
        for (unsigned j = 0; j < 16; ++j) { const unsigned c = xb_ld(&bar[XB_XCNT(j)]); sum += c; cnt += (c > 0u) ? 1u : 0u; mine = (j == x) ? c : mine; }
        if (sum == G) break;
        __builtin_amdgcn_s_sleep(1);
        if ((++sp & 255u) == 0u) { if (xb_ld(&bar[XB_TMO])) break; if (sp > XB_SPIN_CAP) { atomicAdd(&bar[XB_TMO], 1u); break; } }
    }
    nloc = mine > 0u ? mine : 1u; nx = cnt > 0u ? cnt : 1u;
}
__device__ __forceinline__ void xcd_barrier_census(const XcdBarrier& b) {
    unsigned nloc, nx; xcd_barrier_complete(b.bar, b.x, nloc, nx); b.st[0] = nloc; b.st[1] = nx;
}
__device__ __forceinline__ void xcd_barrier(const XcdBarrier& b) {
    asm volatile("s_waitcnt vmcnt(0)" ::: "memory");
    __syncthreads();
    if (threadIdx.x == 0) {
        unsigned* bar = b.bar;
        __builtin_amdgcn_s_waitcnt(0);
        const unsigned nloc = b.st[0], nx = b.st[1];
        const unsigned old = xb_add(&bar[XB_XSUB(b.x)], 1u);
        const unsigned gen = old / nloc;
        if (old + 1u == (gen + 1u) * nloc) {
            __builtin_amdgcn_fence(__ATOMIC_RELEASE, "agent");
            asm volatile("s_waitcnt vmcnt(0)" ::: "memory");
            const unsigned og = xb_add(&bar[XB_TOP], 1u);
            const unsigned tg = og / nx;
            if (og + 1u == (tg + 1u) * nx) xb_add(&bar[XB_TOPGEN], 1u);
            else XB_SPIN(xb_ld(&bar[XB_TOPGEN]) == tg, bar);
            __builtin_amdgcn_fence(__ATOMIC_ACQUIRE, "agent");
            xb_add(&bar[XB_XGEN(b.x)], 1u);
            asm volatile("s_waitcnt vmcnt(0)" ::: "memory");
        } else {
            XB_SPIN(xb_ld(&bar[XB_XGEN(b.x)]) == gen, bar);
            __builtin_amdgcn_fence(__ATOMIC_ACQUIRE, "agent");
            asm volatile("s_waitcnt vmcnt(0)" ::: "memory");
        }
    }
    __syncthreads();
}

#ifndef STAG_STEP
#define STAG_STEP 0
#endif
#ifndef STAG_SHORT
#define STAG_SHORT 13000
#endif
#define STAG_EN_IN ((SUB & 8) != 0)
#define STAG_EN_OUT ((SUB & 16) != 0)
#define STAG_EN_G2 ((SUB & 32) != 0)
__device__ __forceinline__ void stagger_ns(int ns) {
    if (ns <= 0) return;
    const unsigned long long t0 = __builtin_amdgcn_s_memrealtime(), dt = (unsigned long long)(ns / 10);
    while (__builtin_amdgcn_s_memrealtime() - t0 < dt) __builtin_amdgcn_s_sleep(8);
}
__device__ __forceinline__ void stagger_dense(int nwg, int G, int c) {
    const int cnt = (nwg - c + G - 1) / G, nmax = (nwg + G - 1) / G;
    stagger_ns(c * STAG_STEP + (cnt < nmax ? STAG_SHORT : 0));
}
struct Frame {
    LAS unsigned char* lds;
    unsigned char* ws;
    const float* in[21];
    float* out;
    gu32* ctl;
    int tid, lane, wave, G, blk;
};

__device__ __forceinline__ void glds16(const void* sbase, unsigned voff, unsigned lds_dst) { unsigned keep;
    asm volatile("s_mov_b32 %0, m0\n\ts_mov_b32 m0, %3\n\ts_nop 0\n\tglobal_load_lds_dwordx4 %1, %2\n\ts_mov_b32 m0, %0" : "=&s"(keep) : "v"(voff), "s"(sbase), "s"(lds_dst) : "memory"); }

namespace pg8 {
constexpr int BM = 256, BK = 64, HALF = 128, HTB = HALF * BK * 2, STAGE_BYTES = 8 * HTB, NXCD = 8, WGM = 8, K = 1024;
__host__ __device__ __forceinline__ int lds_byte(int r, int c) { const int st = (r >> 4) * 2 + (c >> 5), rr = r & 15, cc = c & 31, ob = rr * 64 + cc * 2; return st * 1024 + (ob ^ (((ob >> 9) & 1) << 5)); }
__host__ __device__ __forceinline__ void stage_rc(int b, int& R, int& C) { const int st = b / 1024, sb = b % 1024, swz = sb ^ (((sb >> 9) & 1) << 5); R = (st >> 1) * 16 + swz / 64; C = (st & 1) * 32 + (swz % 64) / 2; }
__host__ __device__ __forceinline__ int perm32(int rho) { const int n = rho >> 4, i = rho & 15; return 8 * (i >> 2) + 4 * n + (i & 3); }
struct Unit { int pm, pn, e, nvalid, sbase; };
template <class Epi, class Sched, bool GATHER, bool FP8 = false, bool NOEPI = false>
__device__ __forceinline__ void gemm_phase(LAS unsigned char* lds, int wave_id, const Sched& S, const Epi& E) {
    constexpr int KB = FP8 ? 1024 : 2048, NT = KB / 128;
    PHASE_IDS_W(wave_id); const int wid = wave, wr = wid >> 2, wc = wid & 3, fr = lane & 15, fq = lane >> 4;
    unsigned voffB[2], vA[2][2]; int R0, C0;
    { int R, C; stage_rc(tid * 16, R, C); R0 = R; C0 = C;
#pragma unroll
      for (int i = 0; i < 2; ++i) { const int Ri = R + 64 * i; const int Rb = (int)Epi::PERM == 2 ? (64 * (Ri >> 5) + 16 * ((Ri & 15) >> 2) + 4 * ((Ri >> 4) & 1) + (Ri & 3)) : Epi::PERM ? ((Ri & ~31) + perm32(Ri & 31)) : Ri; voffB[i] = (unsigned)(Rb * KB + C * 2);
#pragma unroll
          for (int h = 0; h < 2; ++h) vA[h][i] = (unsigned)((Ri + 128 * h) * KB + C * 2); } }
    const size_t kstep = (size_t)(BK * 2);
    const size_t hstep = (int)Epi::PERM == 2 ? (size_t)8 * KB : (size_t)HALF * KB;
    const unsigned ldsw = (unsigned)wid * 1024u, lds0 = (unsigned)(uintptr_t)lds;
    const int aoff = lds_byte(wr * 64 + fr, fq * 8), boff = lds_byte(wc * 32 + fr, fq * 8);
#define PG8_SA(b, h) (((b) * 2 + (h)) * HTB)
#define PG8_SB(b, h) ((4 + (b) * 2 + (h)) * HTB)
#define PG8_STAGE(bufoff, gbase, voff) do { _Pragma("unroll") for (int _i = 0; _i < 2; ++_i) \
        glds16((const void*)(gbase), (voff)[_i], (unsigned)__builtin_amdgcn_readfirstlane(lds0 + (unsigned)(bufoff) + ldsw + _i * 8192)); } while (0)
#define PG8_LDA(dst, b, h) do { _Pragma("unroll") for (int m = 0; m < 4; ++m) { dst[m].lo = *(const LAS v4i*)(lds + PG8_SA(b, h) + aoff + m * 2048); dst[m].hi = *(const LAS v4i*)(lds + PG8_SA(b, h) + aoff + m * 2048 + 1024); } } while (0)
#define PG8_LDB(dst, b, h) do { _Pragma("unroll") for (int n = 0; n < 2; ++n) { dst[n].lo = *(const LAS v4i*)(lds + PG8_SB(b, h) + boff + n * 2048); dst[n].hi = *(const LAS v4i*)(lds + PG8_SB(b, h) + boff + n * 2048 + 1024); } } while (0)
#define PG8_MMA(ai, bj, At, Bt) do { __builtin_amdgcn_s_setprio(1); _Pragma("unroll") for (int m = 0; m < 4; ++m) _Pragma("unroll") for (int n = 0; n < 2; ++n) { \
        if constexpr (FP8) acc[ai][bj][m][n] = __builtin_amdgcn_mfma_scale_f32_16x16x128_f8f6f4(Bt[n], At[m], acc[ai][bj][m][n], 0, 0, 0, 0, 0, 0);     \
        else { acc[ai][bj][m][n] = __builtin_amdgcn_mfma_f32_16x16x32_bf16(__builtin_bit_cast(bf16x8, (v4i)Bt[n].lo), __builtin_bit_cast(bf16x8, (v4i)At[m].lo), acc[ai][bj][m][n], 0, 0, 0); \
               acc[ai][bj][m][n] = __builtin_amdgcn_mfma_f32_16x16x32_bf16(__builtin_bit_cast(bf16x8, (v4i)Bt[n].hi), __builtin_bit_cast(bf16x8, (v4i)At[m].hi), acc[ai][bj][m][n], 0, 0, 0); } } \
        __builtin_amdgcn_s_setprio(0); } while (0)
#define PG8_WAIT_V(n) asm volatile("s_waitcnt vmcnt(" #n ")" ::: "memory")
#define PG8_WAIT_L(n) asm volatile("s_waitcnt lgkmcnt(" #n ")" ::: "memory")
#define PG8_BAR __builtin_amdgcn_s_barrier()
#define PG8_SCHED __builtin_amdgcn_sched_barrier(0)
    Unit cur, nxt; int ui = 0;
    if (!S.next(0, cur)) return;
    f32x4 acc[2][2][4][2];
#pragma unroll
    for (int a = 0; a < 2; ++a)
#pragma unroll
        for (int b = 0; b < 2; ++b)
#pragma unroll
            for (int m = 0; m < 4; ++m)
#pragma unroll
                for (int n = 0; n < 2; ++n) acc[a][b][m][n] = (f32x4){0.f, 0.f, 0.f, 0.f};
    v8i At[4], B0[2], B1[2];
    const char* cA = S.a_ptr(cur); const char* cB = S.b_ptr(cur);
    unsigned nvA[2][2];
    if constexpr (GATHER) S.a_off(cur, R0, C0, vA);
    PG8_STAGE(PG8_SB(0, 0), cB, voffB); PG8_STAGE(PG8_SB(0, 1), cB + hstep, voffB); PG8_STAGE(PG8_SA(0, 0), cA, vA[0]); PG8_STAGE(PG8_SA(0, 1), cA, vA[1]);
    if (wr == 1) PG8_BAR;
    PG8_WAIT_V(2); PG8_BAR;
    PG8_STAGE(PG8_SB(1, 0), cB + kstep, voffB); PG8_STAGE(PG8_SA(1, 0), cA + kstep, vA[0]); PG8_STAGE(PG8_SB(1, 1), cB + hstep + kstep, voffB);
    PG8_WAIT_V(6); PG8_BAR;
    for (;;) {
        const bool has_next = S.next(ui + 1, nxt);
        const char* nA = has_next ? S.a_ptr(nxt) : cA; const char* nB = has_next ? S.b_ptr(nxt) : cB;
        if constexpr (GATHER) { if (has_next) S.a_off(nxt, R0, C0, nvA); }
#pragma unroll 1
        for (int t = 0; t < NT; t += 2) {
            const bool last = (t == NT - 2);
            const char* a1 = cA + (size_t)(t + 1) * kstep;
            const char* a2 = last ? nA : cA + (size_t)(t + 2) * kstep; const char* b2 = last ? nB : cB + (size_t)(t + 2) * kstep;
            const char* a3 = a2 + kstep; const char* b3 = b2 + kstep;
            PG8_LDB(B0, 0, 0); PG8_LDB(B1, 0, 1); PG8_SCHED; PG8_LDA(At, 0, 0); PG8_STAGE(PG8_SA(1, 1), a1, vA[1]);
            if constexpr (GATHER) { if (last && has_next) {
#pragma unroll
                for (int h = 0; h < 2; ++h)
#pragma unroll
                    for (int i = 0; i < 2; ++i) vA[h][i] = nvA[h][i]; } }
            PG8_WAIT_V(8); PG8_WAIT_L(0); PG8_BAR; PG8_MMA(0, 0, At, B0); PG8_MMA(0, 1, At, B1); PG8_BAR; PG8_SCHED;
            PG8_LDA(At, 0, 1); PG8_STAGE(PG8_SB(0, 0), b2, voffB); PG8_STAGE(PG8_SB(0, 1), b2 + hstep, voffB); PG8_STAGE(PG8_SA(0, 0), a2, vA[0]);
            PG8_WAIT_V(8); PG8_WAIT_L(0); PG8_BAR; PG8_MMA(1, 0, At, B0); PG8_MMA(1, 1, At, B1); PG8_BAR; PG8_SCHED;
            PG8_LDB(B0, 1, 0); PG8_LDB(B1, 1, 1); PG8_SCHED; PG8_LDA(At, 1, 0); PG8_STAGE(PG8_SA(0, 1), a2, vA[1]);
            PG8_WAIT_V(8); PG8_WAIT_L(0); PG8_BAR; PG8_MMA(0, 0, At, B0); PG8_MMA(0, 1, At, B1); PG8_BAR; PG8_SCHED;
            PG8_LDA(At, 1, 1); PG8_STAGE(PG8_SB(1, 0), b3, voffB); PG8_STAGE(PG8_SB(1, 1), b3 + hstep, voffB); PG8_STAGE(PG8_SA(1, 0), a3, vA[0]);
            PG8_WAIT_V(8); PG8_WAIT_L(0); PG8_BAR; PG8_MMA(1, 0, At, B0); PG8_MMA(1, 1, At, B1); PG8_BAR; PG8_SCHED;
        }
        if (wr == 0) PG8_BAR;
        if constexpr (NOEPI) {
#pragma unroll
            for (int a = 0; a < 2; ++a)
#pragma unroll
                for (int b = 0; b < 2; ++b)
#pragma unroll
                    for (int m = 0; m < 4; ++m)
#pragma unroll
                        for (int n = 0; n < 2; ++n) asm volatile("" :: "v"(acc[a][b][m][n]));
        } else
        { int le; asm volatile("v_mbcnt_lo_u32_b32 %0, -1, 0\n\tv_mbcnt_hi_u32_b32 %0, -1, %0" : "=v"(le)); E(acc, cur, wr, wc, le & 15, le >> 4); }
        if (!has_next) break;
#pragma unroll
        for (int a = 0; a < 2; ++a)
#pragma unroll
            for (int b = 0; b < 2; ++b)
#pragma unroll
                for (int m = 0; m < 4; ++m)
#pragma unroll
                    for (int n = 0; n < 2; ++n) acc[a][b][m][n] = (f32x4){0.f, 0.f, 0.f, 0.f};
        cur = nxt; cA = nA; cB = nB; ++ui;
        if (wr == 1) PG8_BAR;
    }
    PG8_WAIT_V(0);
    PG8_BAR;
#undef PG8_SA
#undef PG8_SB
#undef PG8_STAGE
#undef PG8_LDA
#undef PG8_LDB
#undef PG8_MMA
#undef PG8_WAIT_V
#undef PG8_WAIT_L
#undef PG8_BAR
#undef PG8_SCHED
}

struct DenseSched {
    const char* A; const char* Bt; int nM, nN, nwg, G, c;
    __device__ __forceinline__ void init(const void* A_, const void* Bt_, int M, int N, int G_, int c_) { A = (const char*)A_; Bt = (const char*)Bt_; nM = M / BM; nN = N / BM; nwg = nM * nN; G = G_; c = c_; }
    __device__ __forceinline__ bool next(int i, Unit& u) const {
        const long L = (long)i * G + c; if (L >= nwg) return false;
        int wgid = (int)L; { const int q = nwg / NXCD, r = nwg % NXCD, xcd = wgid % NXCD, off = wgid / NXCD; wgid = (xcd < r ? xcd * (q + 1) : r * (q + 1) + (xcd - r) * q) + off; }
        const int nig = WGM * nN, gid = wgid / nig, fm = gid * WGM, gsz = (nM - fm) < WGM ? (nM - fm) : WGM;
        u.pm = fm + ((wgid % nig) % gsz); u.pn = (wgid % nig) / gsz; u.e = 0; u.nvalid = 256; u.sbase = 0; return true;
    }
    __device__ __forceinline__ const char* a_ptr(const Unit& u) const { return A + (size_t)u.pm * (BM * K * 2); }
    __device__ __forceinline__ const char* b_ptr(const Unit& u) const { return Bt + (size_t)u.pn * (BM * K * 2); }
    __device__ __forceinline__ void a_off(const Unit&, int, int, unsigned (&)[2][2]) const {}
};
template <int NPN, bool GATHER_A, int KB> struct MoeSched {
    const char* A; const char* Bt; const int* slot; const LAS int* tab; int G, c; size_t bstride;
    __device__ __forceinline__ bool next(int i, Unit& u) const {
        const int ntile = __builtin_amdgcn_readfirstlane(tab[32]);
        int mtg;
        if ((G & 7) == 0) { const int x = c & 7, j = (c >> 3) + (G >> 3) * i; u.pn = j % NPN; mtg = (j / NPN) * 8 + x; if (mtg >= ntile) return false; }
        else { const int lin = i * G + c; if (lin >= ntile * NPN) return false; u.pn = lin % NPN; mtg = lin / NPN; }
        int e = 0;
        while (e < 31 && __builtin_amdgcn_readfirstlane(tab[e + 1]) <= mtg) ++e;
        const int mtl = mtg - __builtin_amdgcn_readfirstlane(tab[e]); int nv = __builtin_amdgcn_readfirstlane(tab[33 + e]) - 256 * mtl; nv = nv > 256 ? 256 : nv;
        u.pm = mtg; u.e = e; u.nvalid = nv; u.sbase = e * CAP + 256 * mtl; return true;
    }
    __device__ __forceinline__ const char* a_ptr(const Unit& u) const { return GATHER_A ? A : A + (size_t)u.pm * (BM * KB); }
    __device__ __forceinline__ const char* b_ptr(const Unit& u) const { return Bt + (size_t)u.e * bstride + (size_t)u.pn * (BM * KB); }
    __device__ __forceinline__ void a_off(const Unit& u, int R0, int C0, unsigned (&v)[2][2]) const {
#pragma unroll
        for (int h = 0; h < 2; ++h)
#pragma unroll
            for (int i = 0; i < 2; ++i) { const int rl = h * 128 + R0 + 64 * i; const int id = (rl < u.nvalid) ? slot[u.sbase + rl] : 0; v[h][i] = (unsigned)(id >> 2) * (unsigned)KB + (unsigned)C0 * 2u; }
    }
};
}

struct EpiInProj {
    static constexpr bool PERM = true;
    unsigned char* ws; const float* tab; const float* rope; int layer;
    template <int TYPE> __device__ __forceinline__ void run(const f32x4 (&acc)[2][2][4][2], const pg8::Unit& u, int wr, int wc, int fr, int fq) const {
        asm volatile("" : "+v"(fr), "+v"(fq));
        const int pn = u.pn, pm = u.pm; const bool ctx = pm >= 128;
        const int bb = ctx ? (pm - 128) : (pm >> 6);
#pragma unroll
        for (int ai = 0; ai < 2; ++ai)
#pragma unroll
            for (int m = 0; m < 4; ++m) {
                const int rl = 128 * ai + 64 * wr + 16 * m + fr; const int row = pm * 256 + rl;
                const int tt = ctx ? rl : (row & (T - 1));
                const int Lk = ctx ? tt : 256 + tt; const int ktile = Lk >> 6, krr = Lk & 63;
#pragma unroll
                for (int bj = 0; bj < 2; ++bj) {
                    const int np = 256 * pn + 128 * bj + 32 * wc + 8 * fq;
                    f32x4 v0 = acc[ai][bj][m][0], v1 = acc[ai][bj][m][1];
                    bf16_t* dst;
                    if (TYPE == 0) {
                        const int dir = np >= 384, col = np - 384 * dir;
                        const f32x4 l0 = *(const f32x4*)(tab + TB_LBT + layer * 384 + col), l1 = *(const f32x4*)(tab + TB_LBT + layer * 384 + col + 4);
#pragma unroll
                        for (int q = 0; q < 4; ++q) { v0[q] = (1.f - l0[q]) * sigmoidf_(-v0[q]); v1[q] = (1.f - l1[q]) * sigmoidf_(-v1[q]); }
                        dst = (bf16_t*)(ws + WS_SCAN + (size_t)(dir ? SC_KB : SC_KF) * SCAN_PITCH) + (size_t)row * 384 + col;
                    } else if (TYPE == 1 || TYPE == 2) {
                        f32x4 cs = (f32x4){1.f, 1.f, 1.f, 1.f}, sn = (f32x4){0.f, 0.f, 0.f, 0.f}; float sc;
                        if (TYPE == 1) {
                            const int m2 = np - 768; const int isk = m2 >= 384, col = m2 - 384 * isk; const int w0 = col & 63;
                            if (!ctx) { cs = *(const f32x4*)(rope + (size_t)tt * 32 + (w0 >> 1)); sn = *(const f32x4*)(rope + (size_t)T * 32 + (size_t)tt * 32 + (w0 >> 1)); }
                            sc = isk ? 0.125f : 1.f;
                            dst = (bf16_t*)(ws + WS_SCAN + (size_t)(isk ? SC_RK : SC_RQ) * SCAN_PITCH) + (size_t)row * 384 + col;
                        } else {
                            const int m3 = np - 1536; const int isk = m3 >= 256, col = m3 - 256 * isk; const int map = col >> 5, w0 = col & 31;
                            if (!ctx) { const float* tb = (w0 < 16) ? (tab + TB_AXR + (tt >> 6) * 8 + (w0 >> 1)) : (tab + TB_AXC + (tt & 63) * 8 + ((w0 - 16) >> 1));
                                        const int so = (w0 < 16) ? 2048 : 512; cs = *(const f32x4*)tb; sn = *(const f32x4*)(tb + so); }
                            sc = isk ? 1.f : 0.17677669529663687f * LOG2E * 4.f;
                            if (isk) dst = (bf16_t*)(ws + WS_KA) + ((size_t)((bb * 8 + map) * KT_TILES + ktile) * 4 + (w0 >> 3)) * 512 + krr * 8;
                            else if (ctx) dst = (bf16_t*)(ws + WS_QC) + ((size_t)(bb * 8 + map) * CL + tt) * 32 + w0;
                            else dst = (bf16_t*)(ws + WS_QA) + ((size_t)(bb * 8 + map) * T + tt) * 32 + w0;
                        }
                        f32x4 o0, o1;
                        o0[0] = (v0[0] * cs[0] - v0[1] * sn[0]) * sc; o0[1] = (v0[1] * cs[0] + v0[0] * sn[0]) * sc;
                        o0[2] = (v0[2] * cs[1] - v0[3] * sn[1]) * sc; o0[3] = (v0[3] * cs[1] + v0[2] * sn[1]) * sc;
                        o1[0] = (v1[0] * cs[2] - v1[1] * sn[2]) * sc; o1[1] = (v1[1] * cs[2] + v1[0] * sn[2]) * sc;
                        o1[2] = (v1[2] * cs[3] - v1[3] * sn[3]) * sc; o1[3] = (v1[3] * cs[3] + v1[2] * sn[3]) * sc;
                        v0 = o0; v1 = o1;
                    } else {
                        const int m4 = np - 2048; const int seg = m4 / 384, col = m4 - 384 * seg;
                        if (m4 >= 2176) continue;
                        if (seg < 5) dst = (bf16_t*)(ws + WS_SCAN + (size_t)(SC_HQ + seg) * SCAN_PITCH) + (size_t)row * 384 + col;
                        else { const int h4 = col >> 6, w0 = col & 63;
                               const int k5 = krr & 31; unsigned char* vb = ws + WS_VA + (size_t)((bb * 4 + h4) * KT_TILES + ktile) * 4096 + (krr >> 5) * 2048 + (w0 >> 5) * 1024 + ((k5 >> 2) & 1) * 512 + (w0 & 31) * 16 + (k5 & 3) + 4 * (k5 >> 3);
                               const unsigned wa = pk4_fp8(v0[0] * 16.f, v0[1] * 16.f, v0[2] * 16.f, v0[3] * 16.f), wb = pk4_fp8(v1[0] * 16.f, v1[1] * 16.f, v1[2] * 16.f, v1[3] * 16.f);
#pragma unroll
                               for (int i = 0; i < 4; ++i) { vb[16 * i] = (unsigned char)(wa >> (8 * i)); vb[64 + 16 * i] = (unsigned char)(wb >> (8 * i)); }
                               continue; }
                    }
                    u32x4 w; w.x = cvt_pk_bf16(v0[0], v0[1]); w.y = cvt_pk_bf16(v0[2], v0[3]); w.z = cvt_pk_bf16(v1[0], v1[1]); w.w = cvt_pk_bf16(v1[2], v1[3]);
                    *(u32x4*)dst = w;
                }
                if (m == 3) asm volatile("" ::: "memory");
            }
    }
    __device__ __forceinline__ void operator()(const f32x4 (&acc)[2][2][4][2], const pg8::Unit& u, int wr, int wc, int fr, int fq) const {
        if (u.pn < 3) run<0>(acc, u, wr, wc, fr, fq); else if (u.pn < 6) run<1>(acc, u, wr, wc, fr, fq); else if (u.pn < 8) run<2>(acc, u, wr, wc, fr, fq); else run<3>(acc, u, wr, wc, fr, fq);
    }
};
template <bool NOST = false> struct EpiBf16OutT {
    static constexpr bool PERM = true;
    bf16_t* C;
    __device__ __forceinline__ void operator()(const f32x4 (&acc)[2][2][4][2], const pg8::Unit& u, int wr, int wc, int fr, int fq) const {
        asm volatile("" : "+v"(fr), "+v"(fq));
        const int row0 = u.pm * 256 + wr * 64 + fr, col0 = u.pn * 256 + wc * 32 + 8 * fq;
#pragma unroll
        for (int ai = 0; ai < 2; ++ai)
#pragma unroll
            for (int m = 0; m < 4; ++m) { bf16_t* rowp = C + (size_t)(row0 + ai * 128 + m * 16) * D + col0;
#pragma unroll
                for (int bj = 0; bj < 2; ++bj) { const f32x4 v0 = acc[ai][bj][m][0], v1 = acc[ai][bj][m][1];
                    u32x4 w; w.x = cvt_pk_bf16(v0[0], v0[1]); w.y = cvt_pk_bf16(v0[2], v0[3]); w.z = cvt_pk_bf16(v1[0], v1[1]); w.w = cvt_pk_bf16(v1[2], v1[3]);
                    if (NOST) asm volatile("" :: "v"(w)); else *(u32x4*)(rowp + bj * 128) = w; } }
    }
};
typedef EpiBf16OutT<false> EpiBf16Out;
struct EpiSwiglu {
    static constexpr bool PERM = true;
    unsigned char* act; const float* b1;
    __device__ __forceinline__ void operator()(const f32x4 (&acc)[2][2][4][2], const pg8::Unit& u, int wr, int wc, int fr, int fq) const {
        asm volatile("" : "+v"(fr), "+v"(fq));
        const int j0 = 128 * u.pn + 32 * wc + 8 * fq;
        const float* bp = b1 + (size_t)u.e * 2048 + 2 * j0;
        f32x4 bq[4];
#pragma unroll
        for (int q = 0; q < 4; ++q) bq[q] = *(const f32x4*)(bp + 4 * q);
#pragma unroll
        for (int ai = 0; ai < 2; ++ai)
#pragma unroll
            for (int m = 0; m < 4; ++m) {
                const int rl = 128 * ai + 64 * wr + 16 * m + fr;
                float o[8];
#pragma unroll
                for (int n = 0; n < 2; ++n)
#pragma unroll
                    for (int q = 0; q < 4; ++q) { const int j = 4 * n + q;
                        float g = __builtin_fmaf(acc[ai][0][m][n][q], W8_INV, bq[j >> 1][(j & 1) * 2]), l = __builtin_fmaf(acc[ai][1][m][n][q], W8_INV, bq[j >> 1][(j & 1) * 2 + 1]);
                        g = fminf(g, 7.f); l = fminf(fmaxf(l, -7.f), 7.f);
                        o[j] = g * sigmoidf_(1.702f * g) * (l + 1.f); }
                u32x2 w; w.x = pk4_fp8(o[0], o[1], o[2], o[3]); w.y = pk4_fp8(o[4], o[5], o[6], o[7]);
                *(u32x2*)(act + (size_t)(u.pm * 256 + rl) * 1024 + j0) = w;
            }
    }
};
template <int NOST = 0> struct EpiMoeOutT {
    static constexpr int PERM = 2;
    unsigned char* ys; const float* b2; const float* sgate;
    __device__ __forceinline__ void operator()(const f32x4 (&acc)[2][2][4][2], const pg8::Unit& u, int wr, int wc, int fr, int fq) const {
        asm volatile("" : "+v"(fr), "+v"(fq));
        const int c0 = 256 * u.pn + 64 * wc + 16 * fq;
        const float* bp = b2 + (size_t)u.e * 1024 + c0;
        f32x4 bv[4];
#pragma unroll
        for (int q = 0; q < 4; ++q) bv[q] = *(const f32x4*)(bp + 4 * q);
#pragma unroll
        for (int ai = 0; ai < 2; ++ai)
#pragma unroll
            for (int m = 0; m < 4; ++m) {
                const int rl = 128 * ai + 64 * wr + 16 * m + fr;
                const float g = (rl < u.nvalid) ? sgate[u.sbase + rl] * 16.f : 0.f;
                unsigned char* rowp = ys + (size_t)(u.pm * 256 + rl) * 1024 + c0;
                if (NOST == 2) rowp = ys - (WS_YK - WS_OSCR) + (size_t)(blockIdx.x * 64 + (rl & 63)) * 1024 + c0;
                u32x4 w;
#pragma unroll
                for (int bj = 0; bj < 2; ++bj)
#pragma unroll
                    for (int n = 0; n < 2; ++n) { const f32x4 v = (acc[ai][bj][m][n] * W8_INV + bv[2 * bj + n]) * g; w[2 * bj + n] = pk4_fp8(v[0], v[1], v[2], v[3]); }
                if (NOST == 1) asm volatile("" :: "v"(w)); else *(u32x4*)rowp = w;
            }
    }
};
typedef EpiMoeOutT<0> EpiMoeOut;

__device__ __forceinline__ int map_in(int n) {
    if (n < 384) return 2048 + n;
    if (n < 768) return n - 384;
    if (n < 1152) return 384 + (n - 768);
    if (n < 1536) return 2048 + 384 + (n - 1152);
    if (n < 1920) return 2048 + 768 + (n - 1536);
    if (n < 2688) { const int isk = n >= 2304; const int c = n - 1920 - 384 * isk; const int h = c >> 6, w = c & 63; const int wp = (w < 32) ? 2 * w : 2 * (w - 32) + 1; return 768 + 384 * isk + h * 64 + wp; }
    if (n < 3072) return 2048 + 1152 + (n - 2688);
    if (n < 3456) return 2048 + 1536 + (n - 3072);
    if (n < 3968) { const int isk = n >= 3712; const int c = n - 3456 - 256 * isk; const int h = c >> 5, w = c & 31; const int half = w >> 4, uu = w & 15; const int up = (uu < 8) ? 2 * uu : 2 * (uu - 8) + 1; return 1536 + 256 * isk + h * 32 + half * 16 + up; }
    return 2048 + 1920 + (n - 3968);
}
__device__ __forceinline__ int map_w1(int n) { const int j = n >> 1, lin = n & 1; return (j >> 7) * 256 + lin * 128 + (j & 127); }
template <int MAP> __device__ __forceinline__ void p0_transpose_item(const float* W, int Kd, int N, bf16_t* WT, LAS float* scr, int item, int lane) {
    const int nblk = N / 32, kb = item / nblk, nb = item % nblk, k0 = 64 * kb, n0 = 32 * nb;
    { f32x4 rv[8];
#pragma unroll
      for (int i = 0; i < 8; ++i) rv[i] = *(const f32x4*)(W + (size_t)(k0 + (lane >> 3) + 8 * i) * N + n0 + 4 * (lane & 7));
#pragma unroll
      for (int i = 0; i < 8; ++i) { LAS float* sp_ = scr + ((lane >> 3) + 8 * i) * 33 + 4 * (lane & 7); sp_[0] = rv[i][0]; sp_[1] = rv[i][1]; sp_[2] = rv[i][2]; sp_[3] = rv[i][3]; } }
    LDS_WAIT(); asm volatile("" ::: "memory");
    const int c = lane & 7;
#pragma unroll
    for (int j = 0; j < 4; ++j) { const int n = (lane >> 3) + 8 * j; const LAS float* s = scr + (8 * c) * 33 + n;
        u32x4 o; o.x = pk2(s[0 * 33], s[1 * 33]); o.y = pk2(s[2 * 33], s[3 * 33]); o.z = pk2(s[4 * 33], s[5 * 33]); o.w = pk2(s[6 * 33], s[7 * 33]);
        const int nn = n0 + n; const int dr = MAP == 1 ? map_in(nn) : (MAP == 2 ? map_w1(nn) : nn);
        *(u32x4*)(WT + (size_t)dr * Kd + k0 + 8 * c) = o; }
    LDS_WAIT(); asm volatile("" ::: "memory");
}
template <int MAP> __device__ __forceinline__ void p0_transpose_item_fp8(const float* W, int Kd, int N, unsigned char* WT, LAS float* scr, int item, int lane) {
    const int nblk = N / 32, kb = item / nblk, nb = item % nblk, k0 = 64 * kb, n0 = 32 * nb;
    { f32x4 rv[8];
#pragma unroll
      for (int i = 0; i < 8; ++i) rv[i] = *(const f32x4*)(W + (size_t)(k0 + (lane >> 3) + 8 * i) * N + n0 + 4 * (lane & 7));
#pragma unroll
      for (int i = 0; i < 8; ++i) { LAS float* sp_ = scr + ((lane >> 3) + 8 * i) * 33 + 4 * (lane & 7); sp_[0] = rv[i][0]; sp_[1] = rv[i][1]; sp_[2] = rv[i][2]; sp_[3] = rv[i][3]; } }
    LDS_WAIT(); asm volatile("" ::: "memory");
    const int n = lane >> 1, hf = lane & 1; const LAS float* sp = scr + (32 * hf) * 33 + n;
    u32x4 o0, o1;
#pragma unroll
    for (int q = 0; q < 4; ++q) { o0[q] = pk4_fp8(sp[(4 * q) * 33] * W8_MUL, sp[(4 * q + 1) * 33] * W8_MUL, sp[(4 * q + 2) * 33] * W8_MUL, sp[(4 * q + 3) * 33] * W8_MUL);
                                  o1[q] = pk4_fp8(sp[(16 + 4 * q) * 33] * W8_MUL, sp[(16 + 4 * q + 1) * 33] * W8_MUL, sp[(16 + 4 * q + 2) * 33] * W8_MUL, sp[(16 + 4 * q + 3) * 33] * W8_MUL); }
    const int nn = n0 + n; const int dr = MAP == 2 ? map_w1(nn) : nn;
    unsigned char* dp = WT + (size_t)dr * Kd + k0 + 32 * hf;
    *(u32x4*)dp = o0; *(u32x4*)(dp + 16) = o1;
    LDS_WAIT(); asm volatile("" ::: "memory");
}
struct P0Item { const float* W; int N, kind, l, e, k0, n0; };
__device__ __forceinline__ P0Item p0_decode(const Frame& F, int it) {
    constexpr int I_IN = 16 * 132, I_OUT = 16 * 32, I_W1 = 16 * 64, I_W2 = 16 * 32, PER_L = I_IN + I_OUT + NE * (I_W1 + I_W2);
    P0Item d; d.l = it / PER_L; int r = it % PER_L; d.e = 0; int item;
    if (r < I_IN) { d.kind = 0; d.N = 4224; d.W = F.in[7] + (size_t)d.l * 1024 * 4224; item = r; }
    else if (r < I_IN + I_OUT) { d.kind = 1; d.N = 1024; d.W = F.in[14] + (size_t)d.l * 1024 * 1024; item = r - I_IN; }
    else { r -= I_IN + I_OUT; d.e = r / (I_W1 + I_W2); r -= d.e * (I_W1 + I_W2);
        if (r < I_W1) { d.kind = 2; d.N = 2048; d.W = F.in[17] + ((size_t)d.l * NE + d.e) * 1024 * 2048; item = r; }
        else { d.kind = 3; d.N = 1024; d.W = F.in[19] + ((size_t)d.l * NE + d.e) * 1024 * 1024; item = r - I_W1; } }
    const int nblk = d.N / 32; d.k0 = 64 * (item / nblk); d.n0 = 32 * (item % nblk); return d;
}
__device__ __forceinline__ void p0_issue(const P0Item& d, int lane, f32x4 (&rv)[8]) {
#pragma unroll
    for (int i = 0; i < 8; ++i) rv[i] = *(const f32x4*)(d.W + (size_t)(d.k0 + (lane >> 3) + 8 * i) * d.N + d.n0 + 4 * (lane & 7));
}
__device__ __forceinline__ void p0_finish(const Frame& F, const P0Item& d, LAS float* scr, int lane, const f32x4 (&rv)[8]) {
#pragma unroll
    for (int i = 0; i < 8; ++i) { LAS float* sp_ = scr + ((lane >> 3) + 8 * i) * 33 + 4 * (lane & 7); sp_[0] = rv[i][0]; sp_[1] = rv[i][1]; sp_[2] = rv[i][2]; sp_[3] = rv[i][3]; }
    LDS_WAIT(); asm volatile("" ::: "memory");
    if (d.kind < 2) {
        bf16_t* WT = d.kind == 0 ? (bf16_t*)(F.ws + WS_WIN) + (size_t)d.l * NIN * 1024 : (bf16_t*)(F.ws + WS_WOUT) + (size_t)d.l * 1024 * 1024;
        const int c = lane & 7;
#pragma unroll
        for (int j = 0; j < 4; ++j) { const int n = (lane >> 3) + 8 * j; const LAS float* s_ = scr + (8 * c) * 33 + n;
            u32x4 o; o.x = pk2(s_[0 * 33], s_[1 * 33]); o.y = pk2(s_[2 * 33], s_[3 * 33]); o.z = pk2(s_[4 * 33], s_[5 * 33]); o.w = pk2(s_[6 * 33], s_[7 * 33]);
            const int nn = d.n0 + n; const int dr = d.kind == 0 ? map_in(nn) : nn;
            *(u32x4*)(WT + (size_t)dr * 1024 + d.k0 + 8 * c) = o; }
    } else {
        unsigned char* WT = d.kind == 2 ? F.ws + WS_W1 + ((size_t)d.l * NE + d.e) * 2048 * 1024 : F.ws + WS_W2 + ((size_t)d.l * NE + d.e) * 1024 * 1024;
        const int n = lane >> 1, hf = lane & 1; const LAS float* sp = scr + (32 * hf) * 33 + n;
        u32x4 o0, o1;
#pragma unroll
        for (int q = 0; q < 4; ++q) { o0[q] = pk4_fp8(sp[(4 * q) * 33] * W8_MUL, sp[(4 * q + 1) * 33] * W8_MUL, sp[(4 * q + 2) * 33] * W8_MUL, sp[(4 * q + 3) * 33] * W8_MUL);
                                      o1[q] = pk4_fp8(sp[(16 + 4 * q) * 33] * W8_MUL, sp[(16 + 4 * q + 1) * 33] * W8_MUL, sp[(16 + 4 * q + 2) * 33] * W8_MUL, sp[(16 + 4 * q + 3) * 33] * W8_MUL); }
        const int nn = d.n0 + n; const int dr = d.kind == 2 ? map_w1(nn) : nn;
        unsigned char* dp = WT + (size_t)dr * 1024 + d.k0 + 32 * hf;
        *(u32x4*)dp = o0; *(u32x4*)(dp + 16) = o1;
    }
    LDS_WAIT(); asm volatile("" ::: "memory");
}
#ifndef P0_QA
#define P0_QA 8
#endif
#ifndef P0_QC
#define P0_QC 52
#endif
#ifndef P0_QI
#define P0_QI 7
#endif
#ifndef P0_QO
#define P0_QO 7
#endif
constexpr int P0_NFIX = 16 * 132 + 16 * 32, P0_NMOE = NE * (16 * 64 + 16 * 32), P0_PER_L = P0_NFIX + P0_NMOE;
struct P0Split { int thrA, idleA, NA, thrC, idleC, NC, thrI, shortI, NI, thrO, shortO, NO, NG, NX; };
#ifndef P0_QG
#define P0_QG 5
#endif
__device__ __forceinline__ int p0_min(int a, int b) { return a < b ? a : b; }
__device__ __forceinline__ P0Split p0_split(int G, int layer) {
    P0Split p; const int NGW = G * NWAVES, UA = NSEQ * NSC, RA = (UA + NGW - 1) / NGW, UC = 24 * NSC, RC = (UC + NGW - 1) / NGW;
    p.thrA = UA - (RA - 1) * NGW; p.idleA = NGW - p.thrA; p.thrC = UC - (RC - 1) * NGW; p.idleC = NGW - p.thrC;
    const int nI = (NROW / 256) * (NIN / 256), rI = (nI + G - 1) / G, nO = ((layer == 0 ? NROW : NLAT) / 256) * 4, rO = (nO + G - 1) / G;
    p.thrI = nI - (rI - 1) * G; p.shortI = G - p.thrI; p.thrO = nO - (rO - 1) * G; p.shortO = G - p.thrO;
    int left = P0_NMOE;
    p.NA = p0_min(p.idleA * P0_QA, left); left -= p.NA; p.NC = p0_min(p.idleC * P0_QC, left); left -= p.NC;
    p.NI = p0_min(p.shortI * NWAVES * P0_QI, left); left -= p.NI; p.NO = p0_min(p.shortO * NWAVES * P0_QO, left); left -= p.NO;
    p.NG = (layer == 1 && G == 256) ? p0_min(96 * NWAVES * P0_QG, left) : 0; left -= p.NG;
    p.NX = 0;
    if (layer == 1) { const int nO0 = (NROW / 256) * 4, rO0 = (nO0 + G - 1) / G, short0 = G - (nO0 - (rO0 - 1) * G);
        const int used0 = p0_min(short0 * NWAVES * P0_QO, P0_NMOE - p.NA - p.NC - p.NI);
        p.NX = p0_min(short0 * NWAVES * P0_QO - used0, left); }
    return p;
}
__device__ __forceinline__ void p0_run(const Frame& F, LAS float* scr, int lane, int base, int first, int step, int limit) {
    if (step <= 0) return;
    int v = first; if (v >= limit) return;
    P0Item cur = p0_decode(F, base + v), nxt = cur; f32x4 ra[8], rb[8];
    p0_issue(cur, lane, ra);
    for (; v < limit; v += step) {
        const bool hn = v + step < limit;
        if (hn) { nxt = p0_decode(F, base + v + step); p0_issue(nxt, lane, rb); }
        p0_finish(F, cur, scr, lane, ra);
        if (hn) { cur = nxt;
#pragma unroll
            for (int i = 0; i < 8; ++i) ra[i] = rb[i]; }
    }
}
__device__ __forceinline__ void phase_prologue_a(Frame& F) {
    PHASE_IDS();
    LAS float* scr = (LAS float*)(F.lds + wave * 16384);
    const int gw = blk_ * NWAVES + wave, NGW = F.G * NWAVES;
    unsigned char* ws = F.ws;
    for (int l = 0; l < 2; ++l) { const P0Split sp = p0_split(F.G, l); const int done = sp.NA + sp.NC + sp.NI + sp.NO + sp.NG + sp.NX, rem = P0_NMOE - done;
        p0_run(F, scr, lane, l * P0_PER_L, gw, NGW, P0_NFIX);
        p0_run(F, scr, lane, l * P0_PER_L + P0_NFIX + done, gw, NGW, rem); }
    for (int i = gw * 64 + lane; i < 2 * 128 * 1024 / 8; i += NGW * 64) { const int l = i / (128 * 128), rr = i % (128 * 128);
        *(u32x4*)((bf16_t*)(ws + WS_WIN) + ((size_t)l * NIN + 4224) * 1024 + (size_t)rr * 8) = (u32x4){0u, 0u, 0u, 0u}; }
    { LAS float* part = (LAS float*)(F.lds + 131072);
      for (int it = blk_; it < 2 * 96; it += F.G) {
        const int l = it / 96, n0 = (it % 96) * 64, n = n0 + lane;
        const float* mw = F.in[4] + (size_t)l * 1024 * 6144 + (size_t)(128 * wave) * 6144 + n;
        float a0 = 0.f, a1 = 0.f, a2 = 0.f;
#pragma unroll 1
        for (int kb = 0; kb < 2; ++kb) {
            const int kk = 128 * wave + 64 * kb + lane;
            float c0 = F.in[1][kk], c1 = F.in[1][1024 + kk], c2 = F.in[3][kk];
            c0 = c0 * sigmoidf_(c0); c1 = c1 * sigmoidf_(c1); c2 = c2 * sigmoidf_(c2);
#pragma unroll 1
            for (int j0 = 0; j0 < 64; j0 += 16) { float wv[16];
#pragma unroll
                for (int j = 0; j < 16; ++j) wv[j] = mw[(size_t)(64 * kb + j0 + j) * 6144];
#pragma unroll
                for (int j = 0; j < 16; ++j) { a0 += rdlane(c0, j0 + j) * wv[j]; a1 += rdlane(c1, j0 + j) * wv[j]; a2 += rdlane(c2, j0 + j) * wv[j]; } }
        }
        part[(wave * 3 + 0) * 64 + lane] = a0; part[(wave * 3 + 1) * 64 + lane] = a1; part[(wave * 3 + 2) * 64 + lane] = a2;
        __syncthreads();
        if (wave == 0) {
            float vals[3];
#pragma unroll
            for (int w = 0; w < 3; ++w) { float sacc = 0.f;
#pragma unroll
                for (int q = 0; q < 8; ++q) sacc += part[(q * 3 + w) * 64 + lane]; vals[w] = sacc + F.in[5][l * 6144 + n]; }
            const int ch = n >> 10, col = n & 1023;
            const float* ng = F.in[6] + (size_t)l * 4096;
#pragma unroll
            for (int w = 0; w < 3; ++w) { float v = vals[w];
                if (ch == 1) v = (1.f + v) * ng[col]; else if (ch == 2) v = v * ng[1024 + col]; else if (ch == 4) v = (1.f + v) * ng[2048 + col]; else if (ch == 5) v = v * ng[3072 + col];
                const int slot = (ch == 0) ? 1 : (ch == 1) ? 0 : (ch == 2) ? 2 : (ch == 3) ? 4 : (ch == 4) ? 3 : 5;
                ((float*)(ws + WS_MODV))[((size_t)(l * 3 + w) * 6 + slot) * 1024 + col] = v; }
        }
        __syncthreads();
      } }
    float* tab = (float*)(ws + WS_TAB);
    const int gt = blk_ * NTHR + tid, NGT = F.G * NTHR;
    for (int i = gt; i < 2 * 384; i += NGT) { const int l = i / 384, c = i % 384; const float a = F.in[8][c], b = F.in[8][384 + c];
        tab[TB_LBT + i] = (l == 0) ? 0.f : 1.f / (1.f + expf(a - b)); }
    if (gt < 2) { const int l = gt; const float* lm = F.in[12] + l * 128; float s0 = 0.f, s1 = 0.f;
        for (int i = 0; i < 32; ++i) { s0 += lm[i] * lm[32 + i]; s1 += lm[64 + i] * lm[96 + i]; }
        const float li = 0.8f - 0.6f * expf(-0.3f * (float)l);
        tab[TB_LAM + l] = expf(s0) - expf(s1) + li; tab[TB_LAM + 2 + l] = 1.f - li; }
    if (gt < 24) tab[TB_GAM + gt] = 1.f - exp2f(-F.in[10][gt]);
    for (int i = gt; i < 256 * 8 + 64 * 8; i += NGT) {
        const bool isr = i < 2048; const int ii = isr ? i : i - 2048; const int pos = ii >> 3, j = ii & 7;
        const float inv = exp2f(-(float)j * (13.287712379549449f / 8.f));
        const double rev = (double)pos * (double)inv * 0.15915494309189535; const float fr = (float)(rev - floor(rev));
        const float cs = __builtin_amdgcn_cosf(fr), sn = __builtin_amdgcn_sinf(fr);
        if (isr) { tab[TB_AXR + ii] = cs; tab[TB_AXR + 2048 + ii] = sn; } else { tab[TB_AXC + ii] = cs; tab[TB_AXC + 512 + ii] = sn; }
    }
    float* rope = (float*)(ws + WS_ROPE);
    for (int i = gt; i < T * 32; i += NGT) { const int pos = i >> 5, j = i & 31;
        const float inv = exp2f(-(float)j * (13.287712379549449f / 32.f));
        const double rev = (double)pos * (double)inv * 0.15915494309189535; const float fr = (float)(rev - floor(rev));
        rope[i] = __builtin_amdgcn_cosf(fr); rope[(size_t)T * 32 + i] = __builtin_amdgcn_sinf(fr); }
    bf16_t* rwh = (bf16_t*)(ws + WS_RWT); bf16_t* rwl = rwh + 2 * 32 * 1024;
    for (int i = gt; i < 2 * 32 * 1024; i += NGT) { const int l = i >> 15, e = (i >> 10) & 31, c = i & 1023; const float wv = F.in[15][((size_t)l * 1024 + c) * 32 + e];
        const unsigned hb = f2bf(wv); rwh[i] = (bf16_t)hb; rwl[i] = (bf16_t)f2bf(wv - __builtin_bit_cast(float, hb << 16)); }
}

__device__ __forceinline__ float row_sumsq(const f32x4 (&v)[4]) {
    float s = 0.f;
#pragma unroll
    for (int j = 0; j < 4; ++j) s += (v[j][0] * v[j][0] + v[j][1] * v[j][1]) + (v[j][2] * v[j][2] + v[j][3] * v[j][3]);
    return wave_sum(s);
}
__device__ __forceinline__ void row_load(const float* p, int lane, f32x4 (&v)[4]) {
#pragma unroll
    for (int j = 0; j < 4; ++j) v[j] = *(const f32x4*)(p + 4 * lane + 256 * j);
}
__device__ __forceinline__ void row_store(float* p, int lane, const f32x4 (&v)[4]) {
#pragma unroll
    for (int j = 0; j < 4; ++j) *(f32x4*)(p + 4 * lane + 256 * j) = v[j];
}
__device__ __forceinline__ void row_store_bf16(bf16_t* p, int lane, const f32x4 (&v)[4]) {
#pragma unroll
    for (int j = 0; j < 4; ++j) { u32x2 w; w.x = pk2(v[j][0], v[j][1]); w.y = pk2(v[j][2], v[j][3]); *(u32x2*)(p + 4 * lane + 256 * j) = w; }
}
__device__ __forceinline__ void row_load_bf16(const bf16_t* p, int lane, f32x4 (&v)[4]) {
#pragma unroll
    for (int j = 0; j < 4; ++j) { const u32x2 w = *(const u32x2*)(p + 4 * lane + 256 * j); v[j] = (f32x4){bflo(w.x), bfhi(w.x), bflo(w.y), bfhi(w.y)}; }
}
__device__ __forceinline__ int row_which(int r) { return r < NLAT ? (r >> 14) : 2; }
__device__ __forceinline__ void row_norm_mod(const f32x4 (&x)[4], const float* a, const float* b, int lane, f32x4 (&o)[4]) {
    const float r = __builtin_amdgcn_rsqf(row_sumsq(x) * (1.f / 1024.f) + EPS);
#pragma unroll
    for (int j = 0; j < 4; ++j) { const f32x4 av = *(const f32x4*)(a + 4 * lane + 256 * j), bv = *(const f32x4*)(b + 4 * lane + 256 * j); o[j] = x[j] * r * av + bv; }
}
__device__ __forceinline__ void phase_prologue_b(Frame& F) {
    PHASE_IDS();
    const int gw = blk_ * NWAVES + wave, NGW = F.G * NWAVES;
    const float* modv = (const float*)(F.ws + WS_MODV);
    f32x4 xc[4], xn[4];
    if (gw < NROW) row_load(gw < NLAT ? F.in[0] + (size_t)gw * D : F.in[2] + (size_t)(gw - NLAT) * D, lane, xc);
    for (int r = gw; r < NROW; r += NGW) {
        const int rn = r + NGW;
        if (rn < NROW) row_load(rn < NLAT ? F.in[0] + (size_t)rn * D : F.in[2] + (size_t)(rn - NLAT) * D, lane, xn);
        const int w = row_which(r);
        f32x4 o[4];
        row_norm_mod(xc, modv + (size_t)(0 * 3 + w) * 6 * 1024, modv + ((size_t)(0 * 3 + w) * 6 + 1) * 1024, lane, o);
        row_store_bf16((bf16_t*)(F.ws + WS_H) + (size_t)r * D, lane, o);
#pragma unroll
        for (int j = 0; j < 4; ++j) xc[j] = xn[j];
    }
}

__device__ __forceinline__ int scan_row(int sc, int p, int dir, int b) {
    if (sc == 0) return NLAT + b * CL + (dir ? (CL - 1 - p) : p);
    const int tt = (sc - 1) * 256 + p; return b * T + (dir ? (T - 1 - tt) : tt);
}
template <int TYPE, bool WITHQ>
__device__ __forceinline__ float scan_step(float (&S)[64], const LAS float* kq, float vv, float gam) {
    float o = 0.f;
#pragma unroll
    for (int kg = 0; kg < 8; ++kg) {
        f32x4 kv[2], qv[2];
#pragma unroll
        for (int j = 0; j < 2; ++j) { kv[j] = *(const LAS f32x4*)(kq + kg * 8 + 4 * j); if (WITHQ) qv[j] = *(const LAS f32x4*)(kq + 64 + kg * 8 + 4 * j); }
#pragma unroll
        for (int j = 0; j < 8; ++j) { const int k = kg * 8 + j; const float kk = kv[j >> 2][j & 3];
            if (TYPE == 0) S[k] = __builtin_fmaf(kk, vv - S[k], S[k]); else S[k] = __builtin_fmaf(kk, vv, gam * S[k]);
            if (WITHQ) o = __builtin_fmaf(qv[j >> 2][j & 3], S[k], o); }
        asm volatile("" ::: "memory"); __builtin_amdgcn_sched_barrier(0);
    }
    return o;
}
__device__ __forceinline__ void phase_scan_a(Frame& F, int layer) {
    PHASE_IDS();
    const int gw = blk_ * NWAVES + wave, NGW = F.G * NWAVES;
    const float* tab = (const float*)(F.ws + WS_TAB);
    LAS float* scr = (LAS float*)(F.lds + wave * 2048);
    for (int wu = gw; wu < NSEQ * NSC; wu += NGW) {
        const int s = wu / NSC, sc = wu % NSC; const int type = s / 24, rem = s % 24, b = rem / 12, h = (rem % 12) >> 1, dir = rem & 1;
        const bf16_t* Kb = (const bf16_t*)(F.ws + WS_SCAN + (size_t)(type ? SC_RK : (dir ? SC_KB : SC_KF)) * SCAN_PITCH);
        const bf16_t* Vb = (const bf16_t*)(F.ws + WS_SCAN + (size_t)(type ? SC_RV : SC_HV) * SCAN_PITCH);
        unsigned co = (unsigned)(h * 64 + lane); asm volatile("" : "+v"(co));
        const float gam = tab[TB_GAM + layer * 12 + dir * 6 + h];
        float S[64];
#pragma unroll
        for (int k = 0; k < 64; ++k) S[k] = 0.f;
        float dprod = 1.f;
        float kc[4], vc[4], kn[4], vn[4];
#pragma unroll
        for (int i = 0; i < 4; ++i) { const unsigned ro = (unsigned)scan_row(sc, i, dir, b) * 384u + co; kc[i] = bf2f(Kb[ro]); vc[i] = bf2f(Vb[ro]); kn[i] = 0.f; vn[i] = 0.f; }
        for (int p0 = 0; p0 < 256; p0 += 4) {
            if (p0 + 4 < 256) {
#pragma unroll
                for (int i = 0; i < 4; ++i) { const unsigned ro = (unsigned)scan_row(sc, p0 + 4 + i, dir, b) * 384u + co; kn[i] = bf2f(Kb[ro]); vn[i] = bf2f(Vb[ro]); }
            }
#pragma unroll
            for (int i = 0; i < 4; ++i) scr[i * 128 + lane] = kc[i];
#pragma unroll
            for (int i = 0; i < 4; ++i) {
                if (type == 0) { dprod *= (1.f - kc[i]); (void)scan_step<0, false>(S, scr + i * 128, vc[i], gam); }
                else { dprod *= gam; (void)scan_step<1, false>(S, scr + i * 128, vc[i], gam); }
            }
#pragma unroll
            for (int i = 0; i < 4; ++i) { kc[i] = kn[i]; vc[i] = vn[i]; }
        }
        float* sl = (float*)(F.ws + WS_SLOC) + (size_t)wu * 4096 + lane;
#pragma unroll
        for (int k = 0; k < 64; ++k) { *sl = S[k]; sl += 64; asm volatile("" : "+v"(sl)); }
        ((float*)(F.ws + WS_DEC))[(size_t)wu * 64 + lane] = dprod;
    }
}
__device__ __forceinline__ void phase_scan_b(Frame& F) {
    const float* sloc = (const float*)(F.ws + WS_SLOC); const float* dec = (const float*)(F.ws + WS_DEC); float* sin_ = (float*)(F.ws + WS_SIN);
    PHASE_IDS();
    if (tid < 384) for (int idx = blk_ * 384 + tid; idx < NSEQ * 2048; idx += F.G * 384) {
        const int s = idx >> 11, kv = (idx & 2047) * 2, k = kv >> 6; f32x2 st = {0.f, 0.f};
        const float* dp = dec + (size_t)s * NSC * 64 + k; const float* sp = sloc + (size_t)s * NSC * 4096 + kv; float* op = sin_ + ((size_t)s * NSC + 1) * 4096 + kv;
        float d[16], dn[16]; f32x2 v[16], vn[16];
#pragma unroll
        for (int i = 0; i < 16; ++i) { d[i] = dp[i * 64]; v[i] = *(const f32x2*)(sp + (size_t)i * 4096); }
#pragma unroll 1
        for (int c0 = 0; c0 < NSC - 1; c0 += 16) {
            if (c0 + 16 < NSC - 1) {
#pragma unroll
                for (int i = 0; i < 16; ++i) { dn[i] = dp[(c0 + 16 + i) * 64]; vn[i] = *(const f32x2*)(sp + (size_t)(c0 + 16 + i) * 4096); }
            }
#pragma unroll
            for (int i = 0; i < 16; ++i) { st = st * d[i] + v[i]; *(f32x2*)(op + (size_t)(c0 + i) * 4096) = st; }
#pragma unroll
            for (int i = 0; i < 16; ++i) { d[i] = dn[i]; v[i] = vn[i]; }
        }
    }
}
template <int TYPE, bool SECOND>
__device__ __forceinline__ void scan_dir(Frame& F, int lane_in, int wave, int layer, int b, int h, int dir, int sc, bool zero_state) {
    int lane = lane_in; asm volatile("" : "+v"(lane));
    const float* tab = (const float*)(F.ws + WS_TAB);
    const int s = TYPE * 24 + b * 12 + h * 2 + dir;
    const bf16_t* Kb = (const bf16_t*)(F.ws + WS_SCAN + (size_t)(TYPE ? SC_RK : (dir ? SC_KB : SC_KF)) * SCAN_PITCH);
    const bf16_t* Vb = (const bf16_t*)(F.ws + WS_SCAN + (size_t)(TYPE ? SC_RV : SC_HV) * SCAN_PITCH);
    const bf16_t* Qb = (const bf16_t*)(F.ws + WS_SCAN + (size_t)(TYPE ? SC_RQ : SC_HQ) * SCAN_PITCH);
    const bf16_t* Gb = (const bf16_t*)(F.ws + WS_SCAN + (size_t)(TYPE ? SC_RG : SC_HG) * SCAN_PITCH);
    float* oscr = (float*)(F.ws + WS_OSCR);
    bf16_t* mix = (bf16_t*)(F.ws + WS_MIX);
    unsigned co = (unsigned)(h * 64 + lane); asm volatile("" : "+v"(co));
    const unsigned co2 = co + TYPE * 384;
    const float gam = tab[TB_GAM + layer * 12 + dir * 6 + h];
    const float nw = F.in[TYPE ? 11 : 9][layer * 64 + lane];
    LAS float* scr = (LAS float*)(F.lds + wave * 2048);
    float S[64];
    if (zero_state) {
#pragma unroll
        for (int k = 0; k < 64; ++k) S[k] = 0.f;
    } else { const float* si = (const float*)(F.ws + WS_SIN) + ((size_t)s * NSC + sc) * 4096 + lane;
#pragma unroll
        for (int k = 0; k < 64; ++k) { S[k] = *si; si += 64; asm volatile("" : "+v"(si)); } }
    float kc[2], vc[2], qc[2], kn[2], vn[2], qn[2];
#pragma unroll
    for (int i = 0; i < 2; ++i) { const unsigned ro = (unsigned)scan_row(sc, i, dir, b) * 384u + co; kc[i] = bf2f(Kb[ro]); vc[i] = bf2f(Vb[ro]); qc[i] = bf2f(Qb[ro]); kn[i] = 0.f; vn[i] = 0.f; qn[i] = 0.f; }
    for (int p0 = 0; p0 < 256; p0 += 2) {
        if (p0 + 2 < 256) {
#pragma unroll
            for (int i = 0; i < 2; ++i) { const unsigned ro = (unsigned)scan_row(sc, p0 + 2 + i, dir, b) * 384u + co; kn[i] = bf2f(Kb[ro]); vn[i] = bf2f(Vb[ro]); qn[i] = bf2f(Qb[ro]); }
        }
#pragma unroll
        for (int i = 0; i < 2; ++i) { scr[i * 128 + lane] = kc[i]; scr[i * 128 + 64 + lane] = qc[i]; }
#pragma unroll
        for (int i = 0; i < 2; ++i) {
            float o = scan_step<TYPE, true>(S, scr + i * 128, vc[i], gam);
            const unsigned row = (unsigned)scan_row(sc, p0 + i, dir, b);
            if (!SECOND) oscr[row * 768u + co2] = o;
            else { o += oscr[row * 768u + co2];
                const float r = __builtin_amdgcn_rsqf(wave_sum_dpp(o * o) * (1.f / 64.f) + EPS);
                const float g = bf2f(Gb[row * 384u + co]);
                mix[row * 1024u + co2] = (bf16_t)f2bf(o * r * nw * g * sigmoidf_(g)); }
            asm volatile("" ::: "memory");
        }
#pragma unroll
        for (int i = 0; i < 2; ++i) { kc[i] = kn[i]; vc[i] = vn[i]; qc[i] = qn[i]; }
    }
}
__device__ __forceinline__ void phase_scan_c(Frame& F, int layer) {
    PHASE_IDS();
    const int gw = blk_ * NWAVES + wave, NGW = F.G * NWAVES;
    const bool need_ctx = layer == 0;
    for (int wu = gw; wu < 24 * NSC; wu += NGW) {
        const int sq = wu / NSC, blk = wu % NSC; const int type = sq / 12, b = (sq % 12) / 6, h = sq % 6;
        if (blk == 0 && !need_ctx) continue;
        const int scf = blk, scb = (blk == 0) ? 0 : 65 - blk;
        if (type == 0) { scan_dir<0, false>(F, lane, wave, layer, b, h, 0, scf, scf == 0); scan_dir<0, true>(F, lane, wave, layer, b, h, 1, scb, scb == 0); }
        else           { scan_dir<1, false>(F, lane, wave, layer, b, h, 0, scf, scf == 0); scan_dir<1, true>(F, lane, wave, layer, b, h, 1, scb, scb == 0); }
    }
}


namespace sc2 {
constexpr int WLDS = 8448;
__device__ __forceinline__ f32x4 mfma16(bf16x8 a, bf16x8 b, f32x4 c) { return __builtin_amdgcn_mfma_f32_16x16x32_bf16(a, b, c, 0, 0, 0); }
template <int TYPE, int MODE>
__device__ __forceinline__ void run(Frame& F, int lane_in, int wave, int layer, int b, int h, int dir, int sc, bool zero_state, int wu_out) {
    int lane = lane_in; asm volatile("" : "+v"(lane));
    const int g = lane >> 4, n = lane & 15;
    const float* tab = (const float*)(F.ws + WS_TAB);
    const int s = TYPE * 24 + b * 12 + h * 2 + dir;
    const bf16_t* Kb = (const bf16_t*)(F.ws + WS_SCAN + (size_t)(TYPE ? SC_RK : (dir ? SC_KB : SC_KF)) * SCAN_PITCH);
    const bf16_t* Vb = (const bf16_t*)(F.ws + WS_SCAN + (size_t)(TYPE ? SC_RV : SC_HV) * SCAN_PITCH);
    const bf16_t* Qb = (const bf16_t*)(F.ws + WS_SCAN + (size_t)(TYPE ? SC_RQ : SC_HQ) * SCAN_PITCH);
    const bf16_t* Gb = (const bf16_t*)(F.ws + WS_SCAN + (size_t)(TYPE ? SC_RG : SC_HG) * SCAN_PITCH);
    float* oscr = (float*)(F.ws + WS_OSCR);
    bf16_t* mix = (bf16_t*)(F.ws + WS_MIX);
    const unsigned co = (unsigned)(h * 64 + lane);
    const float lg2 = TYPE ? __builtin_amdgcn_logf(tab[TB_GAM + layer * 12 + dir * 6 + h]) : 0.f;
    LAS unsigned char* wl = F.lds + wave * WLDS;
    LAS bf16_t* QT = (LAS bf16_t*)wl; LAS bf16_t* KT = (LAS bf16_t*)(wl + 2048); LAS bf16_t* KPT = (LAS bf16_t*)(wl + 4096); LAS bf16_t* VT = (LAS bf16_t*)(wl + 6144); LAS float* DD = (LAS float*)(wl + 8192);
    f32x4 S[4][4];
    if (zero_state) {
#pragma unroll
        for (int kb = 0; kb < 4; ++kb)
#pragma unroll
            for (int vb = 0; vb < 4; ++vb) S[kb][vb] = (f32x4){0.f, 0.f, 0.f, 0.f};
    } else { const float* si = (const float*)(F.ws + WS_SIN) + ((size_t)s * NSC + sc) * 4096;
#pragma unroll
        for (int kb = 0; kb < 4; ++kb)
#pragma unroll
            for (int vb = 0; vb < 4; ++vb)
#pragma unroll
                for (int r = 0; r < 4; ++r) S[kb][vb][r] = si[(16 * kb + 4 * g + r) * 64 + 16 * vb + n]; }
    float dtot = 1.f;
    const float gam = TYPE ? tab[TB_GAM + layer * 12 + dir * 6 + h] : 0.f;
    unsigned short kr[16], vr[16], qr[16];
    const int rowbase = scan_row(sc, 0, dir, b), sgn = dir ? -1 : 1;
    const char* Kr = (const char*)Kb + (ptrdiff_t)rowbase * 768; const char* Vr = (const char*)Vb + (ptrdiff_t)rowbase * 768; const char* Qr = (const char*)Qb + (ptrdiff_t)rowbase * 768;
    const unsigned cob = co * 2u;
#define SC_LD(BASE, P) (*(const bf16_t*)((BASE) + (ptrdiff_t)(sgn * (P)) * 768 + cob))
#pragma unroll
    for (int t = 0; t < 16; ++t) { kr[t] = SC_LD(Kr, t); vr[t] = SC_LD(Vr, t); if (MODE != 0) qr[t] = SC_LD(Qr, t); else qr[t] = 0; }
    for (int blk = 0; blk < 16; ++blk) {
        const unsigned row = (unsigned)(rowbase + sgn * (16 * blk + n));
        const unsigned ob = row * 768u + (unsigned)(TYPE * 384 + h * 64 + 4 * g);
        f32x4 of[4]; u32x2 gg[4];
        if (MODE == 2) {
#pragma unroll
            for (int vb = 0; vb < 4; ++vb) { of[vb] = *(const f32x4*)(oscr + ob + 16 * vb); gg[vb] = *(const u32x2*)(Gb + row * 384u + (unsigned)(h * 64 + 16 * vb + 4 * g)); }
        }
        float ek[16]; float eq = 1.f;
#pragma unroll
        for (int t = 0; t < 16; ++t) { const float kk = bf2f(kr[t]);
            eq = fmaxf(eq * (TYPE == 0 ? 1.f - kk : gam), 7.9e-31f);
            ek[t] = __builtin_amdgcn_rcpf(eq);
            if (MODE != 0) { const unsigned w_ = cvt_pk_bf16(bf2f(qr[t]) * eq, kk * ek[t]); QT[t * 64 + lane] = (bf16_t)(w_ & 0xffffu); KT[t * 64 + lane] = (bf16_t)(w_ >> 16); } }
        dtot *= eq; DD[lane] = eq;
        { u32x4 w0, w1, x0, x1;
#pragma unroll
          for (int q = 0; q < 4; ++q) {
              w0[q] = cvt_pk_bf16(bf2f(kr[2 * q]) * (eq * ek[2 * q]), bf2f(kr[2 * q + 1]) * (eq * ek[2 * q + 1]));
              w1[q] = cvt_pk_bf16(bf2f(kr[8 + 2 * q]) * (eq * ek[8 + 2 * q]), bf2f(kr[8 + 2 * q + 1]) * (eq * ek[8 + 2 * q + 1]));
              x0[q] = (unsigned)vr[2 * q] | ((unsigned)vr[2 * q + 1] << 16); x1[q] = (unsigned)vr[8 + 2 * q] | ((unsigned)vr[8 + 2 * q + 1] << 16); }
          *(LAS u32x4*)(KPT + lane * 16) = w0; *(LAS u32x4*)(KPT + lane * 16 + 8) = w1; *(LAS u32x4*)(VT + lane * 16) = x0; *(LAS u32x4*)(VT + lane * 16 + 8) = x1; }
        if (blk + 1 < 16) {
#pragma unroll
            for (int t = 0; t < 16; ++t) { const int p_ = 16 * (blk + 1) + t; kr[t] = SC_LD(Kr, p_); vr[t] = SC_LD(Vr, p_); if (MODE != 0) qr[t] = SC_LD(Qr, p_); }
        }
        asm volatile("s_waitcnt lgkmcnt(0)" ::: "memory");
        if (MODE != 0) {
            f32x4 sct = (f32x4){0.f, 0.f, 0.f, 0.f};
#pragma unroll
            for (int ks = 0; ks < 2; ++ks) { const bf16x8 a = *(const LAS bf16x8*)(KT + n * 64 + 32 * ks + 8 * g), bq = *(const LAS bf16x8*)(QT + n * 64 + 32 * ks + 8 * g); sct = mfma16(a, bq, sct); }
#pragma unroll
            for (int r = 0; r < 4; ++r) sct[r] = (4 * g + r <= n) ? sct[r] : 0.f;
            u32x4 bs; bs.x = cvt_pk_bf16(sct[0], sct[1]); bs.y = cvt_pk_bf16(sct[2], sct[3]); bs.z = 0u; bs.w = 0u;
            f32x4 o[4];
#pragma unroll
            for (int vb = 0; vb < 4; ++vb) { const u32x2 lo = *(const LAS u32x2*)(VT + (16 * vb + n) * 16 + 4 * g); u32x4 av; av.x = lo.x; av.y = lo.y; av.z = 0u; av.w = 0u;
                o[vb] = mfma16(__builtin_bit_cast(bf16x8, av), __builtin_bit_cast(bf16x8, bs), (f32x4){0.f, 0.f, 0.f, 0.f}); }
#pragma unroll
            for (int ks = 0; ks < 2; ++ks) {
                const u32x2 q0 = *(const LAS u32x2*)(QT + n * 64 + 32 * ks + 4 * g), q1 = *(const LAS u32x2*)(QT + n * 64 + 32 * ks + 16 + 4 * g);
                u32x4 bq; bq.x = q0.x; bq.y = q0.y; bq.z = q1.x; bq.w = q1.y;
#pragma unroll
                for (int vb = 0; vb < 4; ++vb) { u32x4 av; av.x = cvt_pk_bf16(S[2 * ks][vb][0], S[2 * ks][vb][1]); av.y = cvt_pk_bf16(S[2 * ks][vb][2], S[2 * ks][vb][3]);
                    av.z = cvt_pk_bf16(S[2 * ks + 1][vb][0], S[2 * ks + 1][vb][1]); av.w = cvt_pk_bf16(S[2 * ks + 1][vb][2], S[2 * ks + 1][vb][3]);
                    o[vb] = mfma16(__builtin_bit_cast(bf16x8, av), __builtin_bit_cast(bf16x8, bq), o[vb]); }
            }
            if (MODE == 1) {
#pragma unroll
                for (int vb = 0; vb < 4; ++vb) *(f32x4*)(oscr + ob + 16 * vb) = o[vb];
            } else {
                float ss = 0.f;
#pragma unroll
                for (int vb = 0; vb < 4; ++vb) { o[vb] = o[vb] + of[vb]; ss += (o[vb][0] * o[vb][0] + o[vb][1] * o[vb][1]) + (o[vb][2] * o[vb][2] + o[vb][3] * o[vb][3]); }
                ss += xor_swz<16>(ss); ss += xor32(ss, lane);
                const float rn = __builtin_amdgcn_rsqf(ss * (1.f / 64.f) + EPS);
                const float* nw = F.in[TYPE ? 11 : 9] + layer * 64 + 4 * g;
#pragma unroll
                for (int vb = 0; vb < 4; ++vb) { const f32x4 w4 = *(const f32x4*)(nw + 16 * vb);
                    const float g0 = bflo(gg[vb].x), g1 = bfhi(gg[vb].x), g2 = bflo(gg[vb].y), g3 = bfhi(gg[vb].y);
                    u32x2 w; w.x = cvt_pk_bf16(o[vb][0] * rn * w4[0] * g0 * sigmoidf_(g0), o[vb][1] * rn * w4[1] * g1 * sigmoidf_(g1)); w.y = cvt_pk_bf16(o[vb][2] * rn * w4[2] * g2 * sigmoidf_(g2), o[vb][3] * rn * w4[3] * g3 * sigmoidf_(g3));
                    *(u32x2*)(mix + row * 1024u + (unsigned)(TYPE * 384 + h * 64 + 16 * vb + 4 * g)) = w; }
            }
        }
#pragma unroll
        for (int kb = 0; kb < 4; ++kb) { const f32x4 d4 = *(const LAS f32x4*)(DD + 16 * kb + 4 * g);
#pragma unroll
            for (int vb = 0; vb < 4; ++vb) S[kb][vb] = S[kb][vb] * d4; }
        { bf16x8 af[4], bfv[4];
#pragma unroll
          for (int q = 0; q < 4; ++q) { u32x4 a = *(const LAS u32x4*)(KPT + (16 * q + n) * 16 + 8 * (g & 1)), bq = *(const LAS u32x4*)(VT + (16 * q + n) * 16 + 8 * (g & 1));
              if (g >= 2) { a = (u32x4){0u, 0u, 0u, 0u}; bq = (u32x4){0u, 0u, 0u, 0u}; }
              af[q] = __builtin_bit_cast(bf16x8, a); bfv[q] = __builtin_bit_cast(bf16x8, bq); }
#pragma unroll
          for (int kb = 0; kb < 4; ++kb)
#pragma unroll
              for (int vb = 0; vb < 4; ++vb) S[kb][vb] = mfma16(af[kb], bfv[vb], S[kb][vb]); }
        asm volatile("s_waitcnt lgkmcnt(0)" ::: "memory");
    }
    if (MODE == 0) {
        float* sl = (float*)(F.ws + WS_SLOC) + (size_t)wu_out * 4096;
#pragma unroll
        for (int kb = 0; kb < 4; ++kb)
#pragma unroll
            for (int vb = 0; vb < 4; ++vb)
#pragma unroll
                for (int r = 0; r < 4; ++r) sl[(16 * kb + 4 * g + r) * 64 + 16 * vb + n] = S[kb][vb][r];
        ((float*)(F.ws + WS_DEC))[(size_t)wu_out * 64 + lane] = dtot;
    }
}
constexpr int WLDS0 = 10240;
template <int TYPE>
__device__ __forceinline__ void run0(Frame& F, int lane_in, int wave, int layer, int b, int h, int dir, int sc, int wu_out) {
    int lane = lane_in; asm volatile("" : "+v"(lane));
    const int g = lane >> 4, n = lane & 15;
    const float* tab = (const float*)(F.ws + WS_TAB);
    const bf16_t* Kb = (const bf16_t*)(F.ws + WS_SCAN + (size_t)(TYPE ? SC_RK : (dir ? SC_KB : SC_KF)) * SCAN_PITCH);
    const bf16_t* Vb = (const bf16_t*)(F.ws + WS_SCAN + (size_t)(TYPE ? SC_RV : SC_HV) * SCAN_PITCH);
    const unsigned co = (unsigned)(h * 64 + lane);
    const float gam = TYPE ? tab[TB_GAM + layer * 12 + dir * 6 + h] : 0.f;
    LAS unsigned char* wl = F.lds + wave * WLDS0;
    LAS unsigned char* KP = wl; LAS unsigned char* VT = wl + 5120;
    f32x4 S[4][4];
#pragma unroll
    for (int kb = 0; kb < 4; ++kb)
#pragma unroll
        for (int vb = 0; vb < 4; ++vb) S[kb][vb] = (f32x4){0.f, 0.f, 0.f, 0.f};
    float r = 1.f;
    unsigned short kr[32], vr[32];
    const int rowbase = scan_row(sc, 0, dir, b), sgn = dir ? -1 : 1;
    const char* Kr = (const char*)Kb + (ptrdiff_t)rowbase * 768; const char* Vr = (const char*)Vb + (ptrdiff_t)rowbase * 768;
    const unsigned cob = co * 2u;
#pragma unroll
    for (int i = 0; i < 32; ++i) { kr[i] = SC_LD(Kr, 255 - i); vr[i] = SC_LD(Vr, 255 - i); }
    for (int blk = 0; blk < 8; ++blk) {
        u32x4 kw[4], vw[4];
#pragma unroll
        for (int j = 0; j < 16; ++j) { const float k0 = bf2f(kr[2 * j]), k1 = bf2f(kr[2 * j + 1]);
            const float a0 = k0 * r; r *= (TYPE == 0 ? 1.f - k0 : gam); const float a1 = k1 * r; r *= (TYPE == 0 ? 1.f - k1 : gam);
            kw[j >> 2][j & 3] = cvt_pk_bf16(a0, a1); vw[j >> 2][j & 3] = (unsigned)vr[2 * j] | ((unsigned)vr[2 * j + 1] << 16); }
#pragma unroll
        for (int q = 0; q < 4; ++q) { *(LAS u32x4*)(KP + lane * 80 + 16 * q) = kw[q]; *(LAS u32x4*)(VT + lane * 80 + 16 * q) = vw[q]; }
        if (blk + 1 < 8) {
#pragma unroll
            for (int i = 0; i < 32; ++i) { const int p_ = 255 - 32 * (blk + 1) - i; kr[i] = SC_LD(Kr, p_); vr[i] = SC_LD(Vr, p_); }
        }
        asm volatile("s_waitcnt lgkmcnt(0)" ::: "memory");
        { bf16x8 af[4], bfv[4];
#pragma unroll
          for (int q = 0; q < 4; ++q) { af[q] = __builtin_bit_cast(bf16x8, *(const LAS u32x4*)(KP + (16 * q + n) * 80 + 16 * g)); bfv[q] = __builtin_bit_cast(bf16x8, *(const LAS u32x4*)(VT + (16 * q + n) * 80 + 16 * g)); }
#pragma unroll
          for (int kb = 0; kb < 4; ++kb)
#pragma unroll
              for (int vb = 0; vb < 4; ++vb) S[kb][vb] = mfma16(af[kb], bfv[vb], S[kb][vb]); }
        asm volatile("s_waitcnt lgkmcnt(0)" ::: "memory");
    }
    float* sl = (float*)(F.ws + WS_SLOC) + (size_t)wu_out * 4096;
#pragma unroll
    for (int kb = 0; kb < 4; ++kb)
#pragma unroll
        for (int vb = 0; vb < 4; ++vb)
#pragma unroll
            for (int rr = 0; rr < 4; ++rr) sl[(16 * kb + 4 * g + rr) * 64 + 16 * vb + n] = S[kb][vb][rr];
    ((float*)(F.ws + WS_DEC))[(size_t)wu_out * 64 + lane] = r;
}
#undef SC_LD
}
__device__ __forceinline__ void phase_scan2_a(Frame& F, int layer) {
    PHASE_IDS();
    const int gw = blk_ * NWAVES + wave, NGW = F.G * NWAVES;
    for (int wu = gw; wu < NSEQ * NSC; wu += NGW) {
        const int s = wu / NSC, sc = wu % NSC; const int type = s / 24, rem = s % 24, b = rem / 12, h = (rem % 12) >> 1, dir = rem & 1;
        if (type == 0) sc2::run0<0>(F, lane, wave, layer, b, h, dir, sc, wu); else sc2::run0<1>(F, lane, wave, layer, b, h, dir, sc, wu);
    }
    { const P0Split sp = p0_split(F.G, layer);
      if (gw >= sp.thrA) p0_run(F, (LAS float*)(F.lds + wave * sc2::WLDS0), lane, layer * P0_PER_L + P0_NFIX, gw - sp.thrA, sp.idleA, sp.NA); }
}
__device__ __forceinline__ void phase_scan2_c(Frame& F, int layer) {
    PHASE_IDS();
    const int gw = blk_ * NWAVES + wave, NGW = F.G * NWAVES;
    const bool need_ctx = layer == 0;
    for (int wu = gw; wu < 24 * NSC; wu += NGW) {
        const int sq = wu / NSC, blk = wu % NSC; const int type = sq / 12, b = (sq % 12) / 6, h = sq % 6;
        if (blk == 0 && !need_ctx) continue;
        const int scf = blk, scb = (blk == 0) ? 0 : 65 - blk;
        if (type == 0) { sc2::run<0, 1>(F, lane, wave, layer, b, h, 0, scf, scf == 0, 0); sc2::run<0, 2>(F, lane, wave, layer, b, h, 1, scb, scb == 0, 0); }
        else           { sc2::run<1, 1>(F, lane, wave, layer, b, h, 0, scf, scf == 0, 0); sc2::run<1, 2>(F, lane, wave, layer, b, h, 1, scb, scb == 0, 0); }
    }
    { const P0Split sp = p0_split(F.G, layer);
      if (gw >= sp.thrC) p0_run(F, (LAS float*)(F.lds + 67584 + wave * 8448), lane, layer * P0_PER_L + P0_NFIX + sp.NA, gw - sp.thrC, sp.idleC, sp.NC); }
}

namespace att {
constexpr int SLOT = 32768, NS = 3, WSF_OFF = NS * SLOT, OST_OFF = 0, OST_W = 32 * 68 * 4;
__device__ __forceinline__ int crow(int r, int hi) { return (r & 3) + 8 * (r >> 2) + 4 * hi; }
typedef short v4i16_t __attribute__((ext_vector_type(4)));
typedef LAS const char* lds_cptr;
__device__ __forceinline__ s16x4 vtr(lds_cptr p) { return __builtin_bit_cast(s16x4, __builtin_amdgcn_ds_read_tr16_b64_v4i16((LAS v4i16_t*)p)); }
__device__ __forceinline__ float max3f(float a, float b, float c) { return __builtin_fmaxf(__builtin_fmaxf(a, b), c); }
__device__ __forceinline__ float hmax32(const f32x16& p0, const f32x16& p1) {
    float a = max3f(p0[0], p0[1], p1[0]), b = max3f(p0[2], p0[3], p1[1]); a = max3f(a, p1[2], p1[3]);
#pragma unroll
    for (int r = 4; r < 16; r += 4) { a = max3f(a, p0[r], p0[r + 1]); b = max3f(b, p0[r + 2], p0[r + 3]); a = max3f(a, p1[r], p1[r + 1]); b = max3f(b, p1[r + 2], p1[r + 3]); }
    const float m = __builtin_fmaxf(a, b);
    auto rr = __builtin_amdgcn_permlane32_swap(__builtin_bit_cast(unsigned, m), __builtin_bit_cast(unsigned, m), false, false);
    return __builtin_fmaxf(__builtin_bit_cast(float, rr[0]), __builtin_bit_cast(float, rr[1]));
}
#define ATT_WAIT_BAR(N) asm volatile("s_waitcnt vmcnt(" #N ") lgkmcnt(0)\n\ts_barrier" ::: "memory")
template<int VAR>
__device__ __forceinline__ void attn_unit(Frame& F, int lane_in, int wid, int layer, int b, int h, bool isctx, int qb) {
    int lane = lane_in; asm volatile("" : "+v"(lane));
    const int r32 = lane & 31, hi = lane >> 5;
    LAS unsigned char* lds = F.lds; const unsigned lds0 = (unsigned)(uintptr_t)lds;
    const float* tab = (const float*)(F.ws + WS_TAB);
    const int qrow = qb * 256 + wid * 32 + r32;
    bf16x8 qr[2][2];
#pragma unroll
    for (int m = 0; m < 2; ++m) { const int mp = b * 8 + 2 * h + m;
        const bf16_t* qp = isctx ? (const bf16_t*)(F.ws + WS_QC) + ((size_t)mp * CL + qrow) * 32 : (const bf16_t*)(F.ws + WS_QA) + ((size_t)mp * T + qrow) * 32;
#pragma unroll
        for (int d0 = 0; d0 < 2; ++d0) qr[m][d0] = *(const bf16x8*)(qp + d0 * 16 + hi * 8); }
    const int NTL = isctx ? 2 : KT_TILES / 2;
    const bf16_t* ksrc = (const bf16_t*)(F.ws + WS_KA) + (size_t)((b * 8 + 2 * h + (wid >> 2)) * KT_TILES) * 2048 + (wid & 3) * 512;
    const unsigned char* vsrc = F.ws + WS_VA + (size_t)((b * 4 + h) * KT_TILES) * 4096 + (wid >> 2) * 4096 + (wid & 3) * 1024;
    const unsigned dma_off = (unsigned)lane * 16u;
#define ATT_DMA(t, slot) do { _Pragma("unroll") for (int sb_ = 0; sb_ < 2; ++sb_) \
                              ::glds16(ksrc + (size_t)(2 * (t) + sb_) * 2048, dma_off, (unsigned)__builtin_amdgcn_readfirstlane(lds0 + (slot) * SLOT + sb_ * 16384 + wid * 1024)); \
                              ::glds16(vsrc + (size_t)(t) * 8192, dma_off, (unsigned)__builtin_amdgcn_readfirstlane(lds0 + (slot) * SLOT + (wid >> 2) * 16384 + 8192 + (wid & 3) * 1024)); } while (0)
    LAS float* wsf = (LAS float*)(lds + WSF_OFF) + wid * 128;
    LAS float* ost = (LAS float*)(lds + OST_OFF + wid * OST_W);
    f32x16 o[2][2];
#pragma unroll
    for (int m = 0; m < 2; ++m)
#pragma unroll
        for (int d = 0; d < 2; ++d) o[m][d] = f32x16{};
    constexpr float POFS = 60.5f, PTHR = 32.f;
    float mhat = 0.f;
    f32x16 lacc[2]; lacc[0] = f32x16{}; lacc[1] = f32x16{};
    v8i ones8; { int o8 = 0x38383838; asm volatile("" : "+v"(o8)); ones8 = (v8i){o8, o8, o8, o8, o8, o8, o8, o8}; asm volatile("" : "+v"(ones8)); }
    f32x16 negm; { float z_ = POFS; asm volatile("" : "+v"(z_));
#pragma unroll
      for (int r = 0; r < 16; ++r) negm[r] = z_; }
    ATT_DMA(0, 0); ATT_DMA(1, 1);
    asm volatile("" : "+v"(qr[0][0]), "+v"(qr[0][1]), "+v"(qr[1][0]), "+v"(qr[1][1]));
    int slot = 0;
    for (int t = 0; t < NTL; ++t) {
        if (t + 1 < NTL) { ATT_WAIT_BAR(3); } else { ATT_WAIT_BAR(0); }
        if (t + 2 < NTL) { const int s2 = slot >= 1 ? slot - 1 : 2; ATT_DMA(t + 2, s2); }
#pragma unroll
        for (int sub = 0; sub < 2; ++sub) {
        const lds_cptr base = (lds_cptr)lds + slot * SLOT + sub * 16384;
        f32x16 p[2][2];
#pragma unroll
        for (int m = 0; m < 2; ++m) {
            const lds_cptr kb = base + m * 4096 + hi * 1024 + r32 * 16;
            const bf16x8 k00 = VAR == 4 ? qr[m][0] : *(const LAS bf16x8*)(kb), k01 = VAR == 4 ? qr[m][1] : *(const LAS bf16x8*)(kb + 512), k10 = VAR == 4 ? qr[1 - m][0] : *(const LAS bf16x8*)(kb + 2048), k11 = VAR == 4 ? qr[1 - m][1] : *(const LAS bf16x8*)(kb + 2048 + 512);
            p[m][0] = __builtin_amdgcn_mfma_f32_32x32x16_bf16(k00, qr[m][0], negm, 0, 0, 0);
            p[m][1] = __builtin_amdgcn_mfma_f32_32x32x16_bf16(k01, qr[m][0], negm, 0, 0, 0);
            p[m][0] = __builtin_amdgcn_mfma_f32_32x32x16_bf16(k10, qr[m][1], p[m][0], 0, 0, 0);
            p[m][1] = __builtin_amdgcn_mfma_f32_32x32x16_bf16(k11, qr[m][1], p[m][1], 0, 0, 0);
        }
        v8i vf[2];
        if (sub == 0 && (t & 1) == 0) {
          const float rm = __builtin_fmaxf(hmax32(p[0][0], p[0][1]), hmax32(p[1][0], p[1][1])) - POFS;
          const bool first = (t == 0);
          if (first || __any(rm > PTHR)) {
              const float dl = first ? rm : fmaxf(rm, 0.f);
              mhat += dl;
#pragma unroll
              for (int r = 0; r < 16; ++r) { p[0][0][r] -= dl; p[0][1][r] -= dl; p[1][0][r] -= dl; p[1][1][r] -= dl; negm[r] = POFS - mhat; }
              asm volatile("" : "+v"(negm));
              if (!first) {
                  const float f = __builtin_amdgcn_exp2f(-0.25f * dl);
                  if (hi == 0) wsf[r32] = f;
                  LDS_WAIT();
#pragma unroll
                  for (int r = 0; r < 16; ++r) { const float fr_ = wsf[crow(r, hi)]; o[0][0][r] *= fr_; o[0][1][r] *= fr_; o[1][0][r] *= fr_; o[1][1][r] *= fr_; lacc[0][r] *= fr_; lacc[1][r] *= fr_; }
                  LDS_WAIT();
              }
          } }
#pragma unroll
        for (int m = 0; m < 2; ++m) {
            f32x16& p0 = p[m][0]; f32x16& p1 = p[m][1];
            v8i pw;
#pragma unroll
            for (int q = 0; q < 4; ++q) {
                unsigned wa = __builtin_amdgcn_cvt_pk_u8_f32(p0[4 * q], 0, 0u), wb = __builtin_amdgcn_cvt_pk_u8_f32(p1[4 * q], 0, 0u);
#pragma unroll
                for (int j = 1; j < 4; ++j) { wa = __builtin_amdgcn_cvt_pk_u8_f32(p0[4 * q + j], j, wa); wb = __builtin_amdgcn_cvt_pk_u8_f32(p1[4 * q + j], j, wb); }
                pw[q] = (int)wa; pw[4 + q] = (int)wb; }
            if (m == 0) {
                const lds_cptr vp0 = base + 8192 + hi * 512 + r32 * 16;
#pragma unroll
                for (int d0 = 0; d0 < 2; ++d0) { const u32x4 lo = *(const LAS u32x4*)(vp0 + d0 * 1024), hh = *(const LAS u32x4*)(vp0 + d0 * 1024 + 2048);
                    vf[d0] = (v8i){(int)lo.x, (int)lo.y, (int)lo.z, (int)lo.w, (int)hh.x, (int)hh.y, (int)hh.z, (int)hh.w}; }
            }
#pragma unroll
            for (int d0 = 0; d0 < 2; ++d0) o[m][d0] = __builtin_amdgcn_mfma_scale_f32_32x32x64_f8f6f4(pw, vf[d0], o[m][d0], 1, 0, 0, 0x7F7F7F7F, 0, 0x7B7B7B7B);
            lacc[m] = __builtin_amdgcn_mfma_scale_f32_32x32x64_f8f6f4(pw, ones8, lacc[m], 1, 0, 0, 0x7F7F7F7F, 0, 0x7F7F7F7F);
        }
        }
        slot = slot == 2 ? 0 : slot + 1;
    }
    asm volatile("s_waitcnt lgkmcnt(0)\n\ts_barrier" ::: "memory");
    int lane_e = lane; asm volatile("" : "+v"(lane_e));
    const int r32e = lane_e & 31, hie = lane_e >> 5;
    const float lam = tab[TB_LAM + layer], oml = tab[TB_LAM + 2 + layer];
#pragma unroll
    for (int r = 0; r < 16; ++r) { const int qq = crow(r, hie); const float f0 = __builtin_amdgcn_rcpf(lacc[0][r]), f1 = -lam * __builtin_amdgcn_rcpf(lacc[1][r]);
#pragma unroll
        for (int d0 = 0; d0 < 2; ++d0) ost[qq * 68 + d0 * 32 + r32e] = o[0][d0][r] * f0 + o[1][d0][r] * f1; }
    LDS_WAIT();
    { const int rw = lane_e >> 1, hf = lane_e & 1; f32x4 xv[8]; float ss = 0.f;
#pragma unroll
      for (int j = 0; j < 8; ++j) { xv[j] = *(const LAS f32x4*)(ost + rw * 68 + hf * 32 + 4 * j); ss += (xv[j][0] * xv[j][0] + xv[j][1] * xv[j][1]) + (xv[j][2] * xv[j][2] + xv[j][3] * xv[j][3]); }
      ss += xor_swz<1>(ss);
      const float rs = __builtin_amdgcn_rsqf(ss * (1.f / 64.f) + EPS) * oml;
      const float* sw = F.in[13] + layer * 64 + hf * 32;
      const int qi = qb * 256 + wid * 32 + rw; const size_t orow = isctx ? (size_t)(NLAT + b * CL + qi) : (size_t)(b * T + qi);
      bf16_t* dst = (bf16_t*)(F.ws + WS_MIX) + orow * 1024 + 768 + h * 64 + hf * 32;
#pragma unroll
      for (int j = 0; j < 4; ++j) { const f32x4 a = xv[2 * j], c = xv[2 * j + 1]; const f32x4 wa = *(const f32x4*)(sw + 8 * j), wb = *(const f32x4*)(sw + 8 * j + 4);
          u32x4 w; w.x = pk2(a[0] * rs * wa[0], a[1] * rs * wa[1]); w.y = pk2(a[2] * rs * wa[2], a[3] * rs * wa[3]); w.z = pk2(c[0] * rs * wb[0], c[1] * rs * wb[1]); w.w = pk2(c[2] * rs * wb[2], c[3] * rs * wb[3]);
          *(u32x4*)(dst + 8 * j) = w; } }
    asm volatile("s_waitcnt lgkmcnt(0)\n\ts_barrier" ::: "memory");
#undef ATT_DMA
}

#define ATT_SBAR() __builtin_amdgcn_sched_barrier(0)
#define ATT_MFMA(a, b, c) __builtin_amdgcn_mfma_f32_32x32x16_bf16(a, b, c, 0, 0, 0)
#define ATT_PV(a, b, c, sb) __builtin_amdgcn_mfma_scale_f32_32x32x64_f8f6f4(a, b, c, 1, 0, 0, 0, 0, 0)
constexpr float POFS = 60.5f, PTHR = 32.f;
struct PState { f32x16 o[2][2]; f32x4 lacc[2]; f32x16 negm; bf16x8 qr[2][2]; float mhat; };
#define ATT_CVT8(p, e0, W, i0) do { unsigned a_ = __builtin_amdgcn_cvt_pk_u8_f32(p[e0], 0, 0u), b_ = __builtin_amdgcn_cvt_pk_u8_f32(p[(e0) + 4], 0, 0u); \
    _Pragma("unroll") for (int j_ = 1; j_ < 4; ++j_) { a_ = __builtin_amdgcn_cvt_pk_u8_f32(p[(e0) + j_], j_, a_); b_ = __builtin_amdgcn_cvt_pk_u8_f32(p[(e0) + 4 + j_], j_, b_); } \
    W[i0] = (int)a_; W[(i0) + 1] = (int)b_; } while (0)
template<int M, bool LOADV>
__device__ __forceinline__ void pstep(PState& S, f32x16& pa0, f32x16& pa1, f32x16& pb0, f32x16& pb1, bf16x8& kA, bf16x8& kB, v8i (&vf)[2], const v4i& sel4, lds_cptr vb, lds_cptr kc, lds_cptr kn, bool chk, LAS float* wsfw, int lane) {
    constexpr int MN = 1 - M;
    if (chk) {
        const float rm = hmax32(pa0, pa1) - POFS;
        if (__any(rm > PTHR)) {
            const int r32 = lane & 31, hi = lane >> 5;
            const float dl = fmaxf(rm, 0.f);
            S.mhat += dl;
#pragma unroll
            for (int r = 0; r < 16; ++r) { pa0[r] -= dl; pa1[r] -= dl; S.negm[r] = POFS - S.mhat; }
            const float f = __builtin_amdgcn_exp2f(-0.25f * dl);
            if (hi == 0) wsfw[r32] = f;
            LDS_WAIT();
#pragma unroll
            for (int r = 0; r < 16; ++r) { const float fr_ = wsfw[crow(r, hi)]; S.o[0][0][r] *= fr_; S.o[0][1][r] *= fr_; S.o[1][0][r] *= fr_; S.o[1][1][r] *= fr_; }
            { const float fl_ = wsfw[(lane & 15) + 16 * hi]; S.lacc[0] = S.lacc[0] * fl_; S.lacc[1] = S.lacc[1] * fl_; }
            LDS_WAIT();
        }
    }
    v8i pw;
    ATT_SBAR(); pb0 = ATT_MFMA(kA, S.qr[MN][0], S.negm); ATT_SBAR();
    kA = *(const LAS bf16x8*)(kc + 2048);
    if (LOADV) {
#pragma unroll
        for (int d0 = 0; d0 < 2; ++d0) { const u32x4 lo = *(const LAS u32x4*)(vb + d0 * 1024), hh = *(const LAS u32x4*)(vb + d0 * 1024 + 2048);
            vf[d0] = (v8i){(int)lo.x, (int)lo.y, (int)lo.z, (int)lo.w, (int)hh.x, (int)hh.y, (int)hh.z, (int)hh.w}; }
    }
    ATT_CVT8(pa0, 0, pw, 0);
    ATT_SBAR(); pb1 = ATT_MFMA(kB, S.qr[MN][0], S.negm); ATT_SBAR();
    kB = *(const LAS bf16x8*)(kc + 2048 + 512);
    ATT_CVT8(pa0, 8, pw, 2);
    ATT_SBAR(); pb0 = ATT_MFMA(kA, S.qr[MN][1], pb0); ATT_SBAR();
    kA = *(const LAS bf16x8*)(kn);
    ATT_CVT8(pa1, 0, pw, 4);
    ATT_SBAR(); pb1 = ATT_MFMA(kB, S.qr[MN][1], pb1); ATT_SBAR();
    kB = *(const LAS bf16x8*)(kn + 512);
    ATT_CVT8(pa1, 8, pw, 6);
    ATT_SBAR(); S.o[M][0] = ATT_PV(pw, vf[0], S.o[M][0], 0x7B7B7B7B);
    ATT_SBAR(); S.o[M][1] = ATT_PV(pw, vf[1], S.o[M][1], 0x7B7B7B7B);
    ATT_SBAR(); S.lacc[M] = __builtin_amdgcn_mfma_scale_f32_16x16x128_f8f6f4((v8i){sel4[0], sel4[1], sel4[2], sel4[3], 0, 0, 0, 0}, pw, S.lacc[M], 4, 1, 0, 0, 0, 0); ATT_SBAR();
}
__device__ __forceinline__ void attn_unit_p(Frame& F, int lane_in, int wid, int layer, int b, int h, bool isctx, int qb) {
    int lane = lane_in; asm volatile("" : "+v"(lane));
    const int r32 = lane & 31, hi = lane >> 5;
    LAS unsigned char* lds = F.lds; const unsigned lds0 = (unsigned)(uintptr_t)lds;
    const float* tab = (const float*)(F.ws + WS_TAB);
    const int qrow = qb * 256 + wid * 32 + r32;
    PState S;
#pragma unroll
    for (int m = 0; m < 2; ++m) { const int mp = b * 8 + 2 * h + m;
        const bf16_t* qp = isctx ? (const bf16_t*)(F.ws + WS_QC) + ((size_t)mp * CL + qrow) * 32 : (const bf16_t*)(F.ws + WS_QA) + ((size_t)mp * T + qrow) * 32;
#pragma unroll
        for (int d0 = 0; d0 < 2; ++d0) S.qr[m][d0] = *(const bf16x8*)(qp + d0 * 16 + hi * 8); }
    const int NTL = isctx ? 2 : KT_TILES / 2;
    const bf16_t* ksrc = (const bf16_t*)(F.ws + WS_KA) + (size_t)((b * 8 + 2 * h + (wid >> 2)) * KT_TILES) * 2048 + (wid & 3) * 512;
    const unsigned char* vsrc = F.ws + WS_VA + (size_t)((b * 4 + h) * KT_TILES) * 4096 + (wid >> 2) * 4096 + (wid & 3) * 1024;
    const unsigned dma_off = (unsigned)lane * 16u;
#define ATT_DMA(t, slot) do { _Pragma("unroll") for (int sb_ = 0; sb_ < 2; ++sb_) \
                              ::glds16(ksrc + (size_t)(2 * (t) + sb_) * 2048, dma_off, (unsigned)__builtin_amdgcn_readfirstlane(lds0 + (slot) * SLOT + sb_ * 16384 + wid * 1024)); \
                              ::glds16(vsrc + (size_t)(t) * 8192, dma_off, (unsigned)__builtin_amdgcn_readfirstlane(lds0 + (slot) * SLOT + (wid >> 2) * 16384 + 8192 + (wid & 3) * 1024)); } while (0)
    LAS float* wsf = (LAS float*)(lds + WSF_OFF) + wid * 128;
    LAS float* ost = (LAS float*)(lds + OST_OFF + wid * OST_W);
#pragma unroll
    for (int m = 0; m < 2; ++m) { S.o[m][0] = f32x16{}; S.o[m][1] = f32x16{}; S.lacc[m] = (f32x4){0.f, 0.f, 0.f, 0.f}; }
    S.mhat = 0.f;
    { float z_ = POFS; asm volatile("" : "+v"(z_));
#pragma unroll
      for (int r = 0; r < 16; ++r) S.negm[r] = z_; }
    v4i sel4; { int o4 = (((lane >> 4) ^ (lane >> 3)) & 1) ? 0 : 0x22222222; asm volatile("" : "+v"(o4)); sel4 = (v4i){o4, o4, o4, o4}; asm volatile("" : "+v"(sel4)); }
    ATT_DMA(0, 0); ATT_DMA(1, 1);
    asm volatile("" : "+v"(S.qr[0][0]), "+v"(S.qr[0][1]), "+v"(S.qr[1][0]), "+v"(S.qr[1][1]));
    const int koff = hi * 1024 + r32 * 16, voff = 8192 + hi * 512 + r32 * 16;
    ATT_WAIT_BAR(3);
    f32x16 pa0, pa1, pb0, pb1; bf16x8 kA, kB; v8i vf[2];
    {
        const lds_cptr kb = (lds_cptr)lds + koff;
        kA = *(const LAS bf16x8*)(kb); kB = *(const LAS bf16x8*)(kb + 512);
        pa0 = ATT_MFMA(kA, S.qr[0][0], S.negm); pa1 = ATT_MFMA(kB, S.qr[0][0], S.negm);
        ATT_SBAR();
        kA = *(const LAS bf16x8*)(kb + 2048); kB = *(const LAS bf16x8*)(kb + 2048 + 512);
        pa0 = ATT_MFMA(kA, S.qr[0][1], pa0); pa1 = ATT_MFMA(kB, S.qr[0][1], pa1);
        ATT_SBAR();
        kA = *(const LAS bf16x8*)(kb + 4096); kB = *(const LAS bf16x8*)(kb + 4096 + 512);
        const float rm = hmax32(pa0, pa1) - POFS; S.mhat = rm;
#pragma unroll
        for (int r = 0; r < 16; ++r) { pa0[r] -= rm; pa1[r] -= rm; S.negm[r] = POFS - rm; }
    }
    int slot = 0;
    for (int t = 0; t < NTL; ++t) {
        ATT_WAIT_BAR(0);
        if (t + 2 < NTL) { const int s2 = slot >= 1 ? slot - 1 : 2; ATT_DMA(t + 2, s2); }
        const int sn = slot == 2 ? 0 : slot + 1;
        const lds_cptr tb = (lds_cptr)lds + slot * SLOT, tn = (lds_cptr)lds + sn * SLOT;
        const bool chk = (t & 1) == 0;
        pstep<0, true >(S, pa0, pa1, pb0, pb1, kA, kB, vf, sel4, tb + voff,         tb + 4096 + koff,         tb + 16384 + koff,        chk && t > 0, wsf, lane);
        pstep<1, false>(S, pb0, pb1, pa0, pa1, kA, kB, vf, sel4, tb + voff,         tb + 16384 + koff,        tb + 16384 + 4096 + koff, chk,          wsf, lane);
        pstep<0, true >(S, pa0, pa1, pb0, pb1, kA, kB, vf, sel4, tb + 16384 + voff, tb + 16384 + 4096 + koff, tn + koff,                false,        wsf, lane);
        pstep<1, false>(S, pb0, pb1, pa0, pa1, kA, kB, vf, sel4, tb + 16384 + voff, tn + koff,                tn + 4096 + koff,         false,        wsf, lane);
        slot = sn;
    }
    asm volatile("s_waitcnt lgkmcnt(0)\n\ts_barrier" ::: "memory");
    int lane_e = lane; asm volatile("" : "+v"(lane_e));
    const int r32e = lane_e & 31, hie = lane_e >> 5;
    const float lam = tab[TB_LAM + layer], oml = tab[TB_LAM + 2 + layer];
    if ((lane_e & 16) == 0) { const int ql = (lane_e & 15) + 16 * hie; wsf[ql] = __builtin_amdgcn_rcpf(S.lacc[0][0]) * 0.0625f; wsf[32 + ql] = __builtin_amdgcn_rcpf(S.lacc[1][0]) * 0.0625f; }
    LDS_WAIT();
#pragma unroll
    for (int r = 0; r < 16; ++r) { const int qq = crow(r, hie); const float f0 = wsf[qq], f1 = -lam * wsf[32 + qq];
#pragma unroll
        for (int d0 = 0; d0 < 2; ++d0) ost[qq * 68 + d0 * 32 + r32e] = S.o[0][d0][r] * f0 + S.o[1][d0][r] * f1; }
    LDS_WAIT();
    { const int rw = lane_e >> 1, hf = lane_e & 1; f32x4 xv[8]; float ss = 0.f;
#pragma unroll
      for (int j = 0; j < 8; ++j) { xv[j] = *(const LAS f32x4*)(ost + rw * 68 + hf * 32 + 4 * j); ss += (xv[j][0] * xv[j][0] + xv[j][1] * xv[j][1]) + (xv[j][2] * xv[j][2] + xv[j][3] * xv[j][3]); }
      ss += xor_swz<1>(ss);
      const float rs = __builtin_amdgcn_rsqf(ss * (1.f / 64.f) + EPS) * oml;
      const float* sw = F.in[13] + layer * 64 + hf * 32;
      const int qi = qb * 256 + wid * 32 + rw; const size_t orow = isctx ? (size_t)(NLAT + b * CL + qi) : (size_t)(b * T + qi);
      bf16_t* dst = (bf16_t*)(F.ws + WS_MIX) + orow * 1024 + 768 + h * 64 + hf * 32;
#pragma unroll
      for (int j = 0; j < 4; ++j) { const f32x4 a = xv[2 * j], c = xv[2 * j + 1]; const f32x4 wa = *(const f32x4*)(sw + 8 * j), wb = *(const f32x4*)(sw + 8 * j + 4);
          u32x4 w; w.x = pk2(a[0] * rs * wa[0], a[1] * rs * wa[1]); w.y = pk2(a[2] * rs * wa[2], a[3] * rs * wa[3]); w.z = pk2(c[0] * rs * wb[0], c[1] * rs * wb[1]); w.w = pk2(c[2] * rs * wb[2], c[3] * rs * wb[3]);
          *(u32x4*)(dst + 8 * j) = w; } }
    asm volatile("s_waitcnt lgkmcnt(0)\n\ts_barrier" ::: "memory");
#undef ATT_DMA
}
}
template<int VAR>
__device__ __forceinline__ void phase_attn(Frame& F, int layer, int ulo, int uhi) {
    PHASE_IDS();
    __syncthreads();
    const int nunits = 512 + (layer == 0 ? 8 : 0);
    for (int u = blk_; u < nunits && u < uhi; u += F.G) {
        if (u < ulo) continue;
        if (u < 512) { const int bh = u & 7, qb = u >> 3; att::attn_unit_p(F, lane, wave, layer, bh >> 2, bh & 3, false, qb); }
        else { const int bh = u - 512; att::attn_unit_p(F, lane, wave, layer, bh >> 2, bh & 3, true, 0); }
    }
}

__device__ __forceinline__ void phase_route(Frame& F, int layer) {
    PHASE_IDS();
    const int wid = wave, G = F.G, blk = blk_;
    const int nrows = layer == 0 ? NROW : NLAT;
    constexpr int TP = 2064;
    LAS unsigned char* Th = F.lds; LAS unsigned char* Tl = F.lds + 16 * TP; LAS float* Pp = (LAS float*)(F.lds + 32 * TP);
    LAS int* hist = (LAS int*)(F.lds + LDS_TAB); LAS int* sbase = hist + 32; LAS unsigned* ent = (LAS unsigned*)(hist + 64); LAS float* entg = (LAS float*)(ent + 640);
    for (int i = tid; i < 64 + 640; i += NTHR) hist[i] = (i < 64) ? 0 : -1;
    LAS float* mv = (LAS float*)(F.lds + 32 * TP + 16384);
    { const float* mg = (const float*)(F.ws + WS_MODV) + (size_t)layer * 3 * 6 * 1024;
      for (int i = tid; i < 9 * 256; i += NTHR) { const int v = i >> 8, c4 = i & 255; *(LAS f32x4*)(mv + v * 1024 + 4 * c4) = *(const f32x4*)(mg + (size_t)((v / 3) * 6 + 2 + (v % 3)) * 1024 + 4 * c4); } }
    bf16x8 bh[4][2], bl[4][2];
    { const bf16_t* rwh = (const bf16_t*)(F.ws + WS_RWT) + (size_t)layer * 32768; const bf16_t* rwl = rwh + 2 * 32768;
#pragma unroll
      for (int ks = 0; ks < 4; ++ks)
#pragma unroll
        for (int nb = 0; nb < 2; ++nb) { const int o_ = (16 * nb + (lane & 15)) * 1024 + 128 * wid + 32 * ks + 8 * (lane >> 4); bh[ks][nb] = *(const bf16x8*)(rwh + o_); bl[ks][nb] = *(const bf16x8*)(rwl + o_); } }
    __syncthreads();
    const float* modv = (const float*)(F.ws + WS_MODV) + (size_t)layer * 3 * 6 * 1024;
    const bf16_t* yb = (const bf16_t*)(F.ws + WS_Y);
    bf16_t* x1b = (bf16_t*)(F.ws + WS_X1);
    const int nloc = (nrows - blk + G - 1) / G;
    const float rbias = F.in[16][layer * 32 + (lane & 31)];
    const int nbatch = (nloc + 15) >> 4;
    f32x4 xr[2][4]; u32x2 xh[2][4], yr[2][4];
#define ROUTE_ISSUE(IT) do { _Pragma("unroll") for (int q_ = 0; q_ < 2; ++q_) { const int il_ = 16 * (IT) + 2 * wid + q_; const int r_ = il_ < nloc ? blk + il_ * G : blk; \
        if (layer == 0) { const float* p_ = r_ < NLAT ? F.in[0] + (size_t)r_ * D : F.in[2] + (size_t)(r_ - NLAT) * D; _Pragma("unroll") for (int j = 0; j < 4; ++j) xr[q_][j] = *(const f32x4*)(p_ + 4 * lane + 256 * j); } \
        else { _Pragma("unroll") for (int j = 0; j < 4; ++j) xh[q_][j] = *(const u32x2*)(x1b + (size_t)r_ * D + 4 * lane + 256 * j); } \
        _Pragma("unroll") for (int j = 0; j < 4; ++j) yr[q_][j] = *(const u32x2*)(yb + (size_t)r_ * D + 4 * lane + 256 * j); } } while (0)
    if (nbatch > 0) ROUTE_ISSUE(0);
    for (int it = 0; it < nbatch; ++it) { const int i0 = 16 * it + 2 * wid;
        f32x4 tk[2][4]; bool val[2];
        f32x4 xx[2][4]; u32x2 yq[2][4];
#pragma unroll
        for (int q = 0; q < 2; ++q)
#pragma unroll
            for (int j = 0; j < 4; ++j) { if (layer == 0) xx[q][j] = xr[q][j]; else xx[q][j] = (f32x4){bflo(xh[q][j].x), bfhi(xh[q][j].x), bflo(xh[q][j].y), bfhi(xh[q][j].y)}; yq[q][j] = yr[q][j]; }
        asm volatile("" : "+v"(xx[0][0]), "+v"(xx[1][3]), "+v"(yq[0][0]), "+v"(yq[1][3]));
        if (it + 1 < nbatch) ROUTE_ISSUE(it + 1);
#pragma unroll
        for (int q = 0; q < 2; ++q) {
            const int il = i0 + q; val[q] = il < nloc; const int r = val[q] ? blk + il * G : blk;
            const int w = row_which(r);
            f32x4 x[4], y[4];
#pragma unroll
            for (int j = 0; j < 4; ++j) { x[j] = xx[q][j]; y[j] = (f32x4){bflo(yq[q][j].x), bfhi(yq[q][j].x), bflo(yq[q][j].y), bfhi(yq[q][j].y)}; }
            const float ry = __builtin_amdgcn_rsqf(row_sumsq(y) * (1.f / 1024.f) + EPS);
            const LAS float* c1 = mv + (w * 3 + 0) * 1024;
#pragma unroll
            for (int j = 0; j < 4; ++j) { const f32x4 cv = *(const LAS f32x4*)(c1 + 4 * lane + 256 * j); x[j] = x[j] + cv * (y[j] * ry); }
            if (val[q]) row_store_bf16(x1b + (size_t)r * D, lane, x);
            { const float rr_ = __builtin_amdgcn_rsqf(row_sumsq(x) * (1.f / 1024.f) + EPS); const LAS float* at_ = mv + (w * 3 + 1) * 1024; const LAS float* bt_ = mv + (w * 3 + 2) * 1024;
#pragma unroll
              for (int j = 0; j < 4; ++j) { const f32x4 av = *(const LAS f32x4*)(at_ + 4 * lane + 256 * j), bv = *(const LAS f32x4*)(bt_ + 4 * lane + 256 * j); tk[q][j] = x[j] * rr_ * av + bv; } }
            if (val[q]) {
                unsigned char* t8 = F.ws + WS_TOK8 + (size_t)r * D;
#pragma unroll
                for (int j = 0; j < 4; ++j) *(unsigned*)(t8 + 4 * lane + 256 * j) = pk4_fp8(tk[q][j][0], tk[q][j][1], tk[q][j][2], tk[q][j][3]); }
        }
#pragma unroll
        for (int q = 0; q < 2; ++q)
#pragma unroll
            for (int j = 0; j < 4; ++j) {
                const f32x4 t4 = tk[q][j];
                const unsigned h01 = cvt_pk_bf16(t4[0], t4[1]), h23 = cvt_pk_bf16(t4[2], t4[3]);
                const unsigned l01 = cvt_pk_bf16(t4[0] - bflo(h01), t4[1] - bfhi(h01)), l23 = cvt_pk_bf16(t4[2] - bflo(h23), t4[3] - bfhi(h23));
                const int off = (2 * wid + q) * TP + (4 * lane + 256 * j) * 2;
                *(LAS u32x2*)(Th + off) = (u32x2){h01, h23}; *(LAS u32x2*)(Tl + off) = (u32x2){l01, l23}; }
        __syncthreads();
        { f32x4 pacc[2]; pacc[0] = (f32x4){0.f, 0.f, 0.f, 0.f}; pacc[1] = pacc[0];
#pragma unroll
          for (int ks = 0; ks < 4; ++ks) { const int ao = (lane & 15) * TP + (128 * wid + 32 * ks + 8 * (lane >> 4)) * 2;
              const bf16x8 ah = *(const LAS bf16x8*)(Th + ao), al = *(const LAS bf16x8*)(Tl + ao);
#pragma unroll
              for (int nb = 0; nb < 2; ++nb) { pacc[nb] = __builtin_amdgcn_mfma_f32_16x16x32_bf16(ah, bh[ks][nb], pacc[nb], 0, 0, 0); pacc[nb] = __builtin_amdgcn_mfma_f32_16x16x32_bf16(al, bh[ks][nb], pacc[nb], 0, 0, 0);
                                               pacc[nb] = __builtin_amdgcn_mfma_f32_16x16x32_bf16(ah, bl[ks][nb], pacc[nb], 0, 0, 0); } }
#pragma unroll
          for (int nb = 0; nb < 2; ++nb)
#pragma unroll
              for (int r = 0; r < 4; ++r) Pp[(wid * 16 + 4 * (lane >> 4) + r) * 32 + 16 * nb + (lane & 15)] = pacc[nb][r]; }
        __syncthreads();
        float lg = 0.f;
#pragma unroll
        for (int w8 = 0; w8 < 8; ++w8) lg += Pp[(w8 * 16 + 2 * wid + (lane >> 5)) * 32 + (lane & 31)];
        lg += rbias;
#ifdef DBG_CHECK
        { const int q_ = lane >> 5; if (q_ == 0 ? val[0] : val[1]) ((float*)(F.ws + WS_END + 65536))[(size_t)(blk + (i0 + q_) * G) * 32 + (lane & 31)] = lg; }
#endif
        float tv[4]; int te[4];
#pragma unroll
        for (int k = 0; k < 4; ++k) {
            float m = lg;
            m = fmaxf(m, xor_swz<16>(m)); m = fmaxf(m, xor_swz<8>(m)); m = fmaxf(m, xor_swz<4>(m)); m = fmaxf(m, xor_swz<2>(m)); m = fmaxf(m, xor_swz<1>(m));
            const unsigned long long bal = __ballot(lg == m);
            const unsigned hb = (lane & 32) ? (unsigned)(bal >> 32) : (unsigned)bal;
            const int idx = __builtin_ctz(hb);
            tv[k] = m; te[k] = idx;
            if ((lane & 31) == idx) lg = -INFINITY;
        }
        float g[4]; { float s = 0.f;
#pragma unroll
            for (int k = 0; k < 4; ++k) { g[k] = __expf(tv[k] - tv[0]); s += g[k]; }
            const float inv = 1.f / s;
#pragma unroll
            for (int k = 0; k < 4; ++k) g[k] *= inv; }
        const int q = lane >> 5, k = lane & 31;
        if (k < 4 && (q == 0 ? val[0] : val[1])) {
            const int il = i0 + q; const int r = blk + il * G;
            const int ee = (k == 0) ? te[0] : (k == 1) ? te[1] : (k == 2) ? te[2] : te[3];
            const float gg = (k == 0) ? g[0] : (k == 1) ? g[1] : (k == 2) ? g[2] : g[3];
            entg[il * 4 + k] = gg;
            const int lp = __hip_atomic_fetch_add(hist + ee, 1, __ATOMIC_RELAXED, __HIP_MEMORY_SCOPE_WORKGROUP);
            ent[il * 4 + k] = (unsigned)ee | ((unsigned)lp << 8);
        }
    }
#undef ROUTE_ISSUE
    __syncthreads();
    if (tid < 32) sbase[tid] = (int)__hip_atomic_fetch_add((unsigned*)F.ctl + CW_CNT + layer * 32 + tid, (unsigned)hist[tid], __ATOMIC_RELAXED, __HIP_MEMORY_SCOPE_AGENT);
    __syncthreads();
    int* slot = (int*)(F.ws + WS_SLOT);
    for (int i = tid; i < nloc * 4; i += NTHR) { const unsigned en = ent[i]; if (en != 0xffffffffu) { const int e = en & 255, pos = sbase[e] + (int)(en >> 8); const int r = blk + (i >> 2) * G;
        slot[e * CAP + pos] = r * 4 + (i & 3); ((float*)(F.ws + WS_SGATE))[e * CAP + pos] = entg[i]; ((int*)(F.ws + WS_GATE))[r * 4 + (i & 3)] = e | (pos << 8); } }
    __syncthreads();
}
__device__ __forceinline__ void moe_tables(Frame& F, int layer) {
    PHASE_IDS();
    LAS int* tab = (LAS int*)(F.lds + LDS_TAB);
    if (tid == 0) { int acc = 0;
        for (int e = 0; e < 32; ++e) { const int c = (int)__hip_atomic_load((unsigned*)F.ctl + CW_CNT + layer * 32 + e, __ATOMIC_RELAXED, __HIP_MEMORY_SCOPE_AGENT); tab[e] = acc; tab[33 + e] = c; acc += (c + 255) >> 8; }
        tab[32] = acc; }
    __syncthreads();
}
__device__ __forceinline__ void phase_combine(Frame& F, int layer) {
    PHASE_IDS();
    const int gw = blk_ * NWAVES + wave, NGW = F.G * NWAVES;
    const int nrows = layer == 0 ? NROW : NLAT;
    const unsigned char* yk = F.ws + WS_YK; bf16_t* x1b = (bf16_t*)(F.ws + WS_X1);
    LAS float* mv = (LAS float*)F.lds;
    { const float* mg = (const float*)(F.ws + WS_MODV);
      for (int i = tid; i < 9 * 256; i += NTHR) { const int v = i >> 8, c4 = i & 255, w = v / 3, k = v % 3;
          const float* src = (k == 0) ? mg + (size_t)((layer * 3 + w) * 6 + 5) * 1024 : mg + (size_t)((1 * 3 + w) * 6 + (k - 1)) * 1024;
          *(LAS f32x4*)(mv + v * 1024 + 4 * c4) = *(const f32x4*)(src + 4 * c4); } }
    moe_tables(F, layer);
    const LAS int* ttab = (const LAS int*)(F.lds + LDS_TAB); const int* epos = (const int*)(F.ws + WS_GATE);
#define CMB_ISSUE(R, EP, YB, XB) do { _Pragma("unroll") for (int k = 0; k < 4; ++k) { const int ep = __builtin_amdgcn_readfirstlane(EP[k]); const unsigned char* yr = yk + (size_t)(256 * ttab[ep & 255] + (ep >> 8)) * D + 4 * lane; \
        _Pragma("unroll") for (int j = 0; j < 4; ++j) YB[k][j] = *(const unsigned*)(yr + 256 * j); } \
        _Pragma("unroll") for (int j = 0; j < 4; ++j) XB[j] = *(const u32x2*)(x1b + (size_t)(R) * D + 4 * lane + 256 * j); } while (0)
    int epn[4]; unsigned yb[4][4]; u32x2 xb[4];
#pragma unroll
    for (int k = 0; k < 4; ++k) epn[k] = (gw < nrows) ? epos[gw * 4 + k] : 0;
    if (gw < nrows) CMB_ISSUE(gw, epn, yb, xb);
    if (gw + NGW < nrows) {
#pragma unroll
        for (int k = 0; k < 4; ++k) epn[k] = epos[(gw + NGW) * 4 + k];
    }
    for (int r = gw; r < nrows; r += NGW) {
        const int w = row_which(r), rn = r + NGW;
        unsigned yn[4][4]; u32x2 xn[4];
        if (rn < nrows) {
            CMB_ISSUE(rn, epn, yn, xn);
            if (rn + NGW < nrows) {
#pragma unroll
                for (int k = 0; k < 4; ++k) epn[k] = epos[(rn + NGW) * 4 + k];
            }
        }
        f32x4 x[4], f[4];
#pragma unroll
        for (int j = 0; j < 4; ++j) { x[j] = (f32x4){bflo(xb[j].x), bfhi(xb[j].x), bflo(xb[j].y), bfhi(xb[j].y)}; f[j] = (f32x4){0.f, 0.f, 0.f, 0.f}; }
#pragma unroll
        for (int k = 0; k < 4; ++k)
#pragma unroll
            for (int j = 0; j < 4; ++j) { const unsigned u = yb[k][j];
                const f32x2 lo = __builtin_amdgcn_cvt_pk_f32_fp8((int)u, false), hi = __builtin_amdgcn_cvt_pk_f32_fp8((int)u, true); f[j][0] += lo[0]; f[j][1] += lo[1]; f[j][2] += hi[0]; f[j][3] += hi[1]; }
#pragma unroll
        for (int j = 0; j < 4; ++j) f[j] = f[j] * 0.0625f;
        const float rf = __builtin_amdgcn_rsqf(row_sumsq(f) * (1.f / 1024.f) + EPS);
        const LAS float* c2 = mv + (w * 3 + 0) * 1024;
#pragma unroll
        for (int j = 0; j < 4; ++j) { const f32x4 cv = *(const LAS f32x4*)(c2 + 4 * lane + 256 * j); x[j] = x[j] + cv * (f[j] * rf); }
        if (layer == 1) row_store(F.out + (size_t)r * D, lane, x);
        else { row_store_bf16(x1b + (size_t)r * D, lane, x);
            const float rr_ = __builtin_amdgcn_rsqf(row_sumsq(x) * (1.f / 1024.f) + EPS); const LAS float* ah_ = mv + (w * 3 + 1) * 1024; const LAS float* bh_ = mv + (w * 3 + 2) * 1024;
            f32x4 o[4];
#pragma unroll
            for (int j = 0; j < 4; ++j) { const f32x4 av = *(const LAS f32x4*)(ah_ + 4 * lane + 256 * j), bv = *(const LAS f32x4*)(bh_ + 4 * lane + 256 * j); o[j] = x[j] * rr_ * av + bv; }
            row_store_bf16((bf16_t*)(F.ws + WS_H) + (size_t)r * D, lane, o); }
#pragma unroll
        for (int k = 0; k < 4; ++k)
#pragma unroll
            for (int j = 0; j < 4; ++j) yb[k][j] = yn[k][j];
#pragma unroll
        for (int j = 0; j < 4; ++j) xb[j] = xn[j];
    }
#undef CMB_ISSUE
}

__device__ __forceinline__ void gemm_tail_copy(Frame& F, int layer, int which) {
    PHASE_IDS();
    const P0Split sp = p0_split(F.G, layer);
    const int thr = which ? sp.thrO : sp.thrI, nshort = which ? sp.shortO : sp.shortI, n = which ? sp.NO : sp.NI, off = sp.NA + sp.NC + (which ? sp.NI : 0);
    if (nshort > 0 && blk_ >= thr) { const int first = (blk_ - thr) * NWAVES + wave, step = nshort * NWAVES;
        p0_run(F, (LAS float*)(F.lds + wave * 16384), lane, layer * P0_PER_L + P0_NFIX + off, first, step, n);
        if (which == 1 && layer == 0) { const P0Split s1 = p0_split(F.G, 1);
            const int v0 = first >= n ? first : first + step * ((n - first + step - 1) / step);
            p0_run(F, (LAS float*)(F.lds + wave * 16384), lane, 1 * P0_PER_L + P0_NFIX + s1.NA + s1.NC + s1.NI + s1.NO + s1.NG, v0 - n, step, s1.NX); } }
}

struct Args { const float* in[21]; float* out; unsigned char* ws; int ph_lo, ph_hi; };
constexpr int PH_PER_LAYER = 10, NPHASE = 2 + 2 * PH_PER_LAYER;
template <int SUB> __global__ void __launch_bounds__(NTHR, 2) mk_fwd(Args args) {
    extern __shared__ __attribute__((aligned(16))) unsigned char lds_raw[];
    Frame F;
    F.lds = (LAS unsigned char*)lds_raw; F.ws = args.ws; F.out = args.out;
#pragma unroll
    for (int i = 0; i < 21; ++i) F.in[i] = args.in[i];
    F.ctl = (gu32*)(args.ws + WS_CTL);
    __builtin_amdgcn_s_setreg(1473, 1);
    F.tid = threadIdx.x; F.lane = F.tid & 63; F.wave = __builtin_amdgcn_readfirstlane(F.tid >> 6); F.G = gridDim.x; F.blk = blockIdx.x;
    volatile LAS unsigned* misc = (volatile LAS unsigned*)(F.lds + LDS_MISC);
    if (F.tid < 16) misc[F.tid] = 0u;
    __syncthreads();
    const int lo = args.ph_lo, hi = args.ph_hi;
    const bool use_bar = (hi - lo) > 1;
    XcdBarrier bar; bar.bar = (unsigned*)F.ctl + CW_BAR; bar.x = 0; bar.st = nullptr;
    if (use_bar) { bar = xcd_barrier_post((unsigned*)F.ctl + CW_BAR, misc + 8); if (F.tid == 0) xcd_barrier_census(bar); }
#define IN(k) (lo <= (k) && (k) < hi)
#define SEAM(k) do { if (IN(k) && IN((k) + 1)) xcd_barrier(bar); } while (0)
    if (PHON(0) && IN(0)) { for (int rep = 0; rep < NREP(0); ++rep) phase_prologue_a(F); } SEAM(0);
    if (PHON(1) && IN(1)) { for (int rep = 0; rep < NREP(1); ++rep) phase_prologue_b(F); } SEAM(1);
    for (int layer = 0; layer < 2; ++layer) {
        const int p0 = 2 + layer * PH_PER_LAYER;
        unsigned char* ws = F.ws;
        int blk_ = F.blk; asm volatile("" : "+s"(blk_));
        if (PHON(2) && IN(p0 + 0)) {
            pg8::DenseSched S; S.init(ws + WS_H, (bf16_t*)(ws + WS_WIN) + (size_t)layer * NIN * 1024, NROW, NIN, F.G, blk_);
            EpiInProj E{ws, (const float*)(ws + WS_TAB), (const float*)(ws + WS_ROPE), layer};
            if (STAG_EN_IN) stagger_dense((NROW / 256) * (NIN / 256), F.G, blk_);
            for (int rep = 0; rep < NREP(2); ++rep) pg8::gemm_phase<EpiInProj, pg8::DenseSched, false, false, (SUB & 4) != 0>(F.lds, F.wave, S, E);
            gemm_tail_copy(F, layer, 0);
        } SEAM(p0 + 0);
        if (PHON(3) && IN(p0 + 1)) { if constexpr (SUB & 1) phase_scan2_a(F, layer); if constexpr (SUB & 2) phase_attn<0>(F, layer, 0, F.G); } SEAM(p0 + 1);
        if (PHON(4) && IN(p0 + 2)) { for (int rep = 0; rep < NREP(4); ++rep) phase_scan_b(F); } SEAM(p0 + 2);
        if (PHON(5) && IN(p0 + 3)) { if constexpr (SUB & 1) phase_scan2_c(F, layer); if constexpr (SUB & 2) phase_attn<0>(F, layer, F.G, 1 << 30); } SEAM(p0 + 3);
          if (IN(p0 + 4) && IN(p0 + 5) && !IN(p0 + 3)) xcd_barrier(bar);
        if (PHON(7) && IN(p0 + 5)) {
            pg8::DenseSched S; S.init(ws + WS_MIX, (bf16_t*)(ws + WS_WOUT) + (size_t)layer * 1024 * 1024, layer == 0 ? NROW : NLAT, 1024, F.G, blk_);
            EpiBf16OutT<(SUB & 64) != 0> E{(bf16_t*)(ws + WS_Y)};
            { const int nwg = ((layer == 0 ? NROW : NLAT) / 256) * 4; if (STAG_EN_OUT && (nwg % F.G)) stagger_dense(nwg, F.G, blk_); }
            for (int rep = 0; rep < NREP(7); ++rep) pg8::gemm_phase<EpiBf16OutT<(SUB & 64) != 0>, pg8::DenseSched, false, false, (SUB & 4) != 0>(F.lds, F.wave, S, E);
            gemm_tail_copy(F, layer, 1);
        } SEAM(p0 + 5);
        if (PHON(8) && IN(p0 + 6)) { phase_route(F, layer); } SEAM(p0 + 6);
        if (PHON(9) && IN(p0 + 7)) {
            moe_tables(F, layer);
            pg8::MoeSched<8, true, 1024> S{(const char*)(ws + WS_TOK8), (const char*)(ws + WS_W1 + (size_t)layer * NE * 2048 * 1024), (const int*)(ws + WS_SLOT), (const LAS int*)(F.lds + LDS_TAB), F.G, blk_, (size_t)2048 * 1024};
            EpiSwiglu E{ws + WS_ACT, F.in[18] + (size_t)layer * NE * 2048};
            for (int rep = 0; rep < NREP(9); ++rep) pg8::gemm_phase<EpiSwiglu, pg8::MoeSched<8, true, 1024>, true, true, (SUB & 4) != 0>(F.lds, F.wave, S, E);
        } SEAM(p0 + 7);
        if (PHON(10) && IN(p0 + 8)) {
            moe_tables(F, layer);
            pg8::MoeSched<4, false, 1024> S{(const char*)(ws + WS_ACT), (const char*)(ws + WS_W2 + (size_t)layer * NE * 1024 * 1024), (const int*)(ws + WS_SLOT), (const LAS int*)(F.lds + LDS_TAB), F.G, blk_, (size_t)1024 * 1024};
            EpiMoeOutT<((SUB & 64) ? 1 : (SUB & 128) ? 2 : 0)> E{ws + WS_YK, F.in[20] + (size_t)layer * NE * 1024, (const float*)(ws + WS_SGATE)};
            if (STAG_EN_G2 && (F.G & 7) == 0) { const int ntile = __builtin_amdgcn_readfirstlane(((const LAS int*)(F.lds + LDS_TAB))[32]), per = F.G >> 2;
                const int rem = ntile - 8 * (blk_ >> 5) - (blk_ & 7), cnt = rem > 0 ? (rem + per - 1) / per : 0, nmax = (ntile + per - 1) / per;
                stagger_ns(blk_ * STAG_STEP + (cnt < nmax ? STAG_SHORT : 0)); }
            for (int rep = 0; rep < NREP(10); ++rep) pg8::gemm_phase<EpiMoeOutT<((SUB & 64) ? 1 : (SUB & 128) ? 2 : 0)>, pg8::MoeSched<4, false, 1024>, false, true, (SUB & 4) != 0>(F.lds, F.wave, S, E);
            if (layer == 0 && F.G == 256 && blk_ >= 160) { PHASE_IDS(); const P0Split sp = p0_split(F.G, 1);
                p0_run(F, (LAS float*)(F.lds + wave * 16384), lane, 1 * P0_PER_L + P0_NFIX + sp.NA + sp.NC + sp.NI + sp.NO, (blk_ - 160) * NWAVES + wave, 96 * NWAVES, sp.NG); }
        } SEAM(p0 + 8);
        if (PHON(11) && IN(p0 + 9)) { phase_combine(F, layer); } SEAM(p0 + 9);
    }
#ifdef OVFL_PROBE
    int lane_z; asm volatile("v_mbcnt_lo_u32_b32 %0, -1, 0\n\tv_mbcnt_hi_u32_b32 %0, -1, %0" : "=v"(lane_z));
    if (hi == NPHASE && F.blk == 0 && F.wave == 0 && lane_z == 0) { int w = 0; float big = 1e6f, huge = 3e38f; asm volatile("" : "+v"(big), "+v"(huge));
      w = __builtin_amdgcn_cvt_pk_bf8_f32(big, huge, w, false); int w2 = 0; w2 = __builtin_amdgcn_cvt_pk_fp8_f32(big, huge, w2, false);
      if (((w & 0xffff) != 0x7B7B) || ((w2 & 0xffff) != 0x7E7E)) { asm volatile("s_waitcnt vmcnt(0)" ::: "memory"); F.out[5] = __builtin_nanf(""); } }
#endif
#undef IN
#undef SEAM
}


#ifdef DBG_CHECK
namespace dbg {
__device__ float blk_sum(float v, float* red) { const int t = threadIdx.x; red[t] = v; __syncthreads(); for (int o = 128; o > 0; o >>= 1) { if (t < o) red[t] += red[t + o]; __syncthreads(); } const float r = red[0]; __syncthreads(); return r; }
struct Ctx { const float* const* in; unsigned char* ws; float* red; };
__device__ float bfb(const unsigned char* ws, size_t off, size_t idx) { return bf2f(((const bf16_t*)(ws + off))[idx]); }
__device__ float zdot(const Ctx& c, int row, int ocol) {
    float a = 0.f; for (int k = threadIdx.x; k < 1024; k += 256) a += bfb(c.ws, WS_H, (size_t)row * 1024 + k) * c.in[7][(size_t)k * 4224 + ocol];
    return blk_sum(a, c.red);
}
__device__ void upd(float* flag, float got, float want) { const float e = fabsf(got - want) / (fabsf(want) + 0.05f); if (threadIdx.x == 0 && (e > *flag || !(e == e))) *flag = (e == e) ? e : 1e9f; }
__device__ float sc_buf(const Ctx& c, int which, int row, int col) { return bfb(c.ws, WS_SCAN + (size_t)which * SCAN_PITCH, (size_t)row * 384 + col); }
__device__ void naive_scan(const Ctx& c, const float* tab, int type, int b, int h, int dir, int n, float* S, float* o64) {
    const int t = threadIdx.x;
    for (int i = t; i < 4096; i += 256) S[i] = 0.f; __syncthreads();
    const float gam = tab[TB_GAM + 0 * 12 + dir * 6 + h];
    int lastrow = 0;
    for (int p = 0; p < n; ++p) {
        const int sc = p < 256 ? 0 : 1 + (p - 256) / 256, pl = p < 256 ? p : (p - 256) % 256; const int row = scan_row(sc, pl, dir, 0) + (sc == 0 ? b * CL : b * T); lastrow = row;
        for (int i = t; i < 4096; i += 256) { const int k = i >> 6, v = i & 63;
            const float kk = sc_buf(c, type ? SC_RK : (dir ? SC_KB : SC_KF), row, h * 64 + k), vv = sc_buf(c, type ? SC_RV : SC_HV, row, h * 64 + v);
            const float f = type ? gam : 1.f - kk; S[i] = f * S[i] + kk * vv; }
        __syncthreads();
    }
    if (t < 64) { float o = 0.f; for (int k = 0; k < 64; ++k) o += sc_buf(c, type ? SC_RQ : SC_HQ, lastrow, h * 64 + k) * S[k * 64 + t]; o64[t] = o; }
    __syncthreads();
}
__global__ void __launch_bounds__(256) k_check(Args args, float* flags) {
    __shared__ float red[256]; __shared__ float S[4096]; __shared__ float o1[64], o2[64];
    Ctx c{args.in, args.ws, red}; const int id = blockIdx.x, t = threadIdx.x; float* fl = flags + id;
    const float* tab = (const float*)(args.ws + WS_TAB);
    if (t == 0) { *fl = 0.f; if (id == 12) { flags[13] = 0.f; flags[14] = 0.f; flags[15] = 0.f; } } __syncthreads();
#define rows(i) ((i) == 0 ? 5 : (i) == 1 ? 20000 : 33000)
    if (id == 0) { for (int ri = 0; ri < 3; ++ri) for (int cc = 3; cc < 384; cc += 197) { const float z = zdot(c, rows(ri), cc); upd(fl, sc_buf(c, SC_HQ, rows(ri), cc), z); } }
    if (id == 1) { for (int ri = 0; ri < 3; ++ri) for (int cc = 3; cc < 384; cc += 197) { upd(fl, sc_buf(c, SC_HV, rows(ri), cc), zdot(c, rows(ri), 1152 + cc)); upd(fl, sc_buf(c, SC_RG, rows(ri), cc), zdot(c, rows(ri), 3072 + cc)); upd(fl, sc_buf(c, SC_HG, rows(ri), cc), zdot(c, rows(ri), 1536 + cc)); upd(fl, sc_buf(c, SC_RV, rows(ri), cc), zdot(c, rows(ri), 2688 + cc)); } }
    if (id == 2) { for (int ri = 0; ri < 3; ++ri) for (int cc = 3; cc < 384; cc += 197) { const float z1 = zdot(c, rows(ri), 384 + cc), z2 = zdot(c, rows(ri), 768 + cc); upd(fl, sc_buf(c, SC_KF, rows(ri), cc), 1.f / (1.f + expf(z1))); upd(fl, sc_buf(c, SC_KB, rows(ri), cc), 1.f / (1.f + expf(z2))); } }
    if (id == 3) { for (int ri = 0; ri < 3; ++ri) for (int hh = 0; hh < 6; hh += 5) for (int i = 1; i < 32; i += 13) for (int isk = 0; isk < 2; ++isk) { const int r = rows(ri); const bool ctx = r >= NLAT; const int tt = r & (T - 1);
            const float x1 = zdot(c, r, 1920 + 384 * isk + hh * 64 + i), x2 = zdot(c, r, 1920 + 384 * isk + hh * 64 + i + 32);
            const float ang = ctx ? 0.f : (float)tt * powf(10000.f, -(float)i / 32.f); const float cs = cosf(ang), sn = sinf(ang), scl = isk ? 0.125f : 1.f;
            upd(fl, sc_buf(c, isk ? SC_RK : SC_RQ, r, hh * 64 + 2 * i), (x1 * cs - x2 * sn) * scl); upd(fl, sc_buf(c, isk ? SC_RK : SC_RQ, r, hh * 64 + 2 * i + 1), (x2 * cs + x1 * sn) * scl); } }
    if (id == 4) { for (int ri = 0; ri < 3; ++ri) for (int mp = 0; mp < 8; mp += 7) for (int half = 0; half < 2; ++half) for (int j = 1; j < 8; j += 5) { const int r = rows(ri); const bool ctx = r >= NLAT; const int tt = ctx ? (r - NLAT) & 255 : r & (T - 1); const int bb = ctx ? (r - NLAT) >> 8 : r >> 14;
            const int pos = half ? (tt & 63) : (tt >> 6); const float ang = ctx ? 0.f : (float)pos * powf(10000.f, -(float)j / 8.f); const float cs = cosf(ang), sn = sinf(ang);
            { const float x1 = zdot(c, r, 3456 + mp * 32 + half * 16 + j), x2 = zdot(c, r, 3456 + mp * 32 + half * 16 + j + 8); const float scl = 0.17677669529663687f * LOG2E;
              const size_t qi = ctx ? ((size_t)(bb * 8 + mp) * CL + tt) * 32 + half * 16 + 2 * j : ((size_t)(bb * 8 + mp) * T + tt) * 32 + half * 16 + 2 * j;
              upd(fl, bfb(c.ws, ctx ? WS_QC : WS_QA, qi), (x1 * cs - x2 * sn) * scl); upd(fl, bfb(c.ws, ctx ? WS_QC : WS_QA, qi + 1), (x2 * cs + x1 * sn) * scl); }
            { const float x1 = zdot(c, r, 3712 + mp * 32 + half * 16 + j), x2 = zdot(c, r, 3712 + mp * 32 + half * 16 + j + 8);
              const int Lk = ctx ? tt : 256 + tt, tile = Lk >> 6, rr = Lk & 63, pw = half * 16 + 2 * j;
              const size_t ki = ((size_t)((bb * 8 + mp) * KT_TILES + tile) * 4 + (pw >> 3)) * 512 + rr * 8 + (pw & 7);
              upd(fl, bfb(c.ws, WS_KA, ki), x1 * cs - x2 * sn); upd(fl, bfb(c.ws, WS_KA, ki + 1), x2 * cs + x1 * sn); }
            { const int h4 = mp >> 1, w = half * 32 + j * 3; const float z = zdot(c, r, 3968 + h4 * 64 + w); const int Lk = ctx ? tt : 256 + tt, tile = Lk >> 6, rr = Lk & 63;
              upd(fl, bfb(c.ws, WS_VA, ((size_t)((bb * 4 + h4) * KT_TILES + tile) * 2 + (w >> 5)) * 2048 + rr * 32 + (w & 31)), z); } } }
    if (id == 5 || id == 6) {
        const int type = id - 5, b = 1, h = 2;
#define ts(i) ((i) == 0 ? 0 : (i) == 1 ? 1 : 300)
        for (int q = 0; q < 3; ++q) { naive_scan(c, tab, type, b, h, 0, 256 + ts(q) + 1, S, o1);
            if (t < 64) { const float got = ((const float*)(args.ws + WS_OSCR))[(size_t)(b * T + ts(q)) * 768 + type * 384 + h * 64 + t]; const float e = fabsf(got - o1[t]) / (fabsf(o1[t]) + 0.05f); if (e > 0.05f || !(e == e)) atomicMax((int*)fl, __float_as_int((e == e) ? e : 1e9f)); } __syncthreads(); }
    }
    if (id == 7 || id == 8) {
        const int type = id - 7, b = 1, h = 4;
        for (int q = 0; q < 2; ++q) {
            int row;
            if (q == 0) { naive_scan(c, tab, type, b, h, 0, 101, S, o1); naive_scan(c, tab, type, b, h, 1, 256 - 100, S, o2); row = NLAT + b * CL + 100; }
            else { naive_scan(c, tab, type, b, h, 1, 257, S, o2); row = b * T + T - 1; if (t < 64) o1[t] = ((const float*)(args.ws + WS_OSCR))[(size_t)row * 768 + type * 384 + h * 64 + t]; __syncthreads(); }
            float o = t < 64 ? o1[t] + o2[t] : 0.f; const float ss = blk_sum(o * o, red); const float r = rsqrtf(ss / 64.f + EPS);
            if (t < 64) { const float g = sc_buf(c, type ? SC_RG : SC_HG, row, h * 64 + t); const float want = o * r * args.in[type ? 11 : 9][t] * g / (1.f + expf(-g));
                const float got = bfb(c.ws, WS_MIX, (size_t)row * 1024 + type * 384 + h * 64 + t); const float e = fabsf(got - want) / (fabsf(want) + 0.05f); if (e > 0.05f || !(e == e)) atomicMax((int*)fl, __float_as_int((e == e) ? e : 1e9f)); }
            __syncthreads(); }
    }
    if (id == 9) {
        for (int q = 0; q < 2; ++q) { const bool ctx = q == 1; const int b = ctx ? 0 : 1, h = ctx ? 3 : 2, tq = ctx ? 77 : 5000; const int nk = ctx ? 256 : 16640;
            __shared__ float po[2][64]; __shared__ float pl[2];
            for (int m = 0; m < 2; ++m) { const int mp = b * 8 + 2 * h + m;
                float mx = -1e30f;
                for (int kk = t; kk < nk; kk += 256) { float sdot = 0.f; for (int d = 0; d < 32; ++d) { const float qv = bfb(c.ws, ctx ? WS_QC : WS_QA, ((size_t)mp * (ctx ? CL : T) + tq) * 32 + d); const float kv = bfb(c.ws, WS_KA, ((size_t)(mp * KT_TILES + (kk >> 6)) * 4 + (d >> 3)) * 512 + (kk & 63) * 8 + (d & 7)); sdot += qv * kv; } mx = fmaxf(mx, sdot); }
                red[t] = mx; __syncthreads(); for (int o = 128; o > 0; o >>= 1) { if (t < o) red[t] = fmaxf(red[t], red[t + o]); __syncthreads(); } mx = red[0]; __syncthreads();
                float ls = 0.f; float av[64];
_Pragma("unroll") for (int d = 0; d < 64; ++d) av[d] = 0.f;
                for (int kk = t; kk < nk; kk += 256) { float sdot = 0.f; for (int d = 0; d < 32; ++d) { const float qv = bfb(c.ws, ctx ? WS_QC : WS_QA, ((size_t)mp * (ctx ? CL : T) + tq) * 32 + d); const float kv = bfb(c.ws, WS_KA, ((size_t)(mp * KT_TILES + (kk >> 6)) * 4 + (d >> 3)) * 512 + (kk & 63) * 8 + (d & 7)); sdot += qv * kv; }
                    const float p = exp2f(sdot - mx); ls += p;
_Pragma("unroll") for (int d = 0; d < 64; ++d) av[d] += p * bfb(c.ws, WS_VA, ((size_t)((b * 4 + h) * KT_TILES + (kk >> 6)) * 2 + (d >> 5)) * 2048 + (kk & 63) * 32 + (d & 31)); }
                ls = blk_sum(ls, red);
_Pragma("unroll") for (int d = 0; d < 64; ++d) { const float sv = blk_sum(av[d], red); if (t == 0) po[m][d] = sv; } if (t == 0) pl[m] = ls; __syncthreads();
            }
            const float lam = tab[TB_LAM + 0], oml = tab[TB_LAM + 2];
            float o = t < 64 ? po[0][t] / pl[0] - lam * po[1][t] / pl[1] : 0.f; const float ss = blk_sum(o * o, red); const float r = rsqrtf(ss / 64.f + EPS);
            if (t < 64) { const float want = o * r * args.in[13][t] * oml; const size_t row = ctx ? (size_t)(NLAT + b * CL + tq) : (size_t)(b * T + tq); const float got = bfb(c.ws, WS_MIX, row * 1024 + 768 + h * 64 + t);
                const float e = fabsf(got - want) / (fabsf(want) + 0.05f); if (e > 0.05f || !(e == e)) atomicMax((int*)fl, __float_as_int((e == e) ? e : 1e9f)); }
            __syncthreads(); }
    }
    if (id == 10) { for (int ri = 0; ri < 3; ++ri) for (int cc = 7; cc < 1024; cc += 401) { float a = 0.f; for (int k = t; k < 1024; k += 256) a += bfb(c.ws, WS_MIX, (size_t)rows(ri) * 1024 + k) * args.in[14][(size_t)k * 1024 + cc]; a = blk_sum(a, red); upd(fl, ((const float*)(args.ws + WS_Y))[(size_t)rows(ri) * 1024 + cc], a); } }
    if (id == 11) {
        const float* modv = (const float*)(args.ws + WS_MODV);
        for (int ri = 0; ri < 3; ++ri) { const int r = rows(ri), w = row_which(r); const float* xs = r < NLAT ? args.in[0] + (size_t)r * D : args.in[2] + (size_t)(r - NLAT) * D; const float* y = (const float*)(args.ws + WS_Y) + (size_t)r * D;
            float sy = 0.f; for (int k = t; k < 1024; k += 256) sy += y[k] * y[k]; sy = blk_sum(sy, red); const float ry = rsqrtf(sy / 1024.f + EPS);
            float x1[4]; float sx = 0.f;
_Pragma("unroll") for (int q = 0; q < 4; ++q) { const int k = t + 256 * q; x1[q] = xs[k] + modv[(size_t)(w * 6 + 2) * 1024 + k] * y[k] * ry; sx += x1[q] * x1[q]; } sx = blk_sum(sx, red); const float rx = rsqrtf(sx / 1024.f + EPS);
_Pragma("unroll")
            for (int q = 0; q < 4; ++q) { const int k = t + 256 * q; const float tk = x1[q] * rx * modv[(size_t)(w * 6 + 3) * 1024 + k] + modv[(size_t)(w * 6 + 4) * 1024 + k];
                const float got = bfb(c.ws, WS_H, (size_t)r * 1024 + k), got1 = ((const float*)(args.ws + WS_X1))[(size_t)r * 1024 + k];
                const float e = fmaxf(fabsf(got - tk) / (fabsf(tk) + 0.05f), fabsf(got1 - x1[q]) / (fabsf(x1[q]) + 0.05f)); if (e > 0.05f || !(e == e)) atomicMax((int*)fl, __float_as_int((e == e) ? e : 1e9f)); }
            __syncthreads(); } }

    if (id == 12) {
        __shared__ float tokf[1024], lg[32], abuf[2048], actb[1024], yb[1024]; __shared__ int te[4]; __shared__ float tg[4]; __shared__ int spos;
        const unsigned* cnt = (const unsigned*)(args.ws + WS_CTL) + CW_CNT; const int* slot = (const int*)(args.ws + WS_SLOT);
        for (int ri = 0; ri < 3; ++ri) { const int r = rows(ri);
            for (int k = t; k < 1024; k += 256) tokf[k] = bfb(c.ws, WS_H, (size_t)r * 1024 + k); __syncthreads();
            if (t < 32) { float a = args.in[16][t]; for (int k = 0; k < 1024; ++k) a += tokf[k] * args.in[15][(size_t)k * 32 + t]; lg[t] = a; } __syncthreads();
            if (t < 32) { const float got = ((const float*)(args.ws + WS_END + 65536))[(size_t)r * 32 + t]; const float e = fabsf(got - lg[t]); if (e > 0.02f || !(e == e)) atomicMax((int*)(flags + 15), __float_as_int((e == e) ? 1.f + e : 1e9f)); } __syncthreads();
            if (t == 0) { float tv[4]; for (int k = 0; k < 4; ++k) { int bi = 0; float bv = -1e30f; for (int e = 0; e < 32; ++e) if (lg[e] > bv) { bv = lg[e]; bi = e; } te[k] = bi; tv[k] = bv; lg[bi] = -1e30f; }
                float sm = 0.f; for (int k = 0; k < 4; ++k) { tg[k] = expf(tv[k] - tv[0]); sm += tg[k]; } for (int k = 0; k < 4; ++k) tg[k] /= sm; } __syncthreads();
            if (t < 4) { const float got = ((const float*)(args.ws + WS_GATE))[(size_t)r * 4 + t]; const float e = fabsf(got - tg[t]) / (tg[t] + 0.01f); if (e > 0.05f || !(e == e)) atomicMax((int*)(flags + 12), __float_as_int((e == e) ? e : 1e9f)); }
            for (int k4 = 0; k4 < 4; ++k4) { const int e = te[k4]; const float* w1 = args.in[17] + (size_t)e * 1024 * 2048; const float* w2 = args.in[19] + (size_t)e * 1024 * 1024;
                for (int n = t; n < 2048; n += 256) { float a = args.in[18][(size_t)e * 2048 + n]; for (int k = 0; k < 1024; ++k) a += tokf[k] * w1[(size_t)k * 2048 + n]; abuf[n] = a; } __syncthreads();
                for (int j = t; j < 1024; j += 256) { const float g = fminf(abuf[2 * j], 7.f), l = fminf(fmaxf(abuf[2 * j + 1], -7.f), 7.f); actb[j] = g / (1.f + expf(-1.702f * g)) * (l + 1.f); } __syncthreads();
                for (int cc = t; cc < 1024; cc += 256) { float a = args.in[20][(size_t)e * 1024 + cc]; for (int j = 0; j < 1024; ++j) a += actb[j] * w2[(size_t)j * 1024 + cc]; yb[cc] = a * tg[k4]; } __syncthreads();
                if (t == 0) spos = -1; __syncthreads();
                const int ce = (int)cnt[e]; for (int p = t; p < ce; p += 256) if (slot[e * CAP + p] == r * 4 + k4) spos = p; __syncthreads();
                int ts0 = 0; for (int q = 0; q < e; ++q) ts0 += ((int)cnt[q] + 255) >> 8;
                float sqa = 0.f, sqy = 0.f; for (int k = t; k < 1024; k += 256) { sqa += actb[k] * actb[k]; sqy += yb[k] * yb[k]; } sqa = blk_sum(sqa, red); sqy = blk_sum(sqy, red); const float ra = sqrtf(sqa / 1024.f), ry = sqrtf(sqy / 1024.f);
                if (spos < 0) { if (t == 0) flags[13] = 7e8f; }
                else for (int k = t; k < 1024; k += 256) { const float got = bfb(c.ws, WS_ACT, ((size_t)ts0 * 256 + spos) * 1024 + k); const float er = fabsf(got - actb[k]) / (fabsf(actb[k]) + 0.2f * ra + 1e-6f); if (er > 0.05f || !(er == er)) atomicMax((int*)(flags + 13), __float_as_int((er == er) ? er : 1e9f)); }
                for (int k = t; k < 1024; k += 256) { const float got = bfb(c.ws, WS_YK, ((size_t)r * 4 + k4) * 1024 + k); const float er = fabsf(got - yb[k]) / (fabsf(yb[k]) + 0.2f * ry + 1e-6f); if (er > 0.05f || !(er == er)) atomicMax((int*)(flags + 14), __float_as_int((er == er) ? er : 1e9f)); }
                __syncthreads(); }
        } }
}
__global__ void k_out(Args args, const float* flags, int nchk, unsigned mask) {
    int code = 0; for (int i = nchk - 1; i >= 0; --i) if (((mask >> i) & 1u) && flags[i] > 0.05f) code = i + 1;
    const float sc = 1.f + (float)code;
    for (size_t i = (size_t)blockIdx.x * blockDim.x + threadIdx.x; i < (size_t)NLAT * D; i += (size_t)gridDim.x * blockDim.x) args.out[i] = args.in[0][i] * sc;
}
}
#endif

extern "C" void kernel_launch(void* const* d_in, const int* in_sizes, int n_in, void* d_out, int out_size, void* d_ws, size_t ws_size, hipStream_t stream) {
    static int grid = 0;
    if (grid == 0) {
        if (n_in != 21 || out_size != NLAT * D || ws_size < WS_END) { fprintf(stderr, "kernel_launch: unexpected shapes (n_in %d out %d ws %zu)\n", n_in, out_size, ws_size); grid = -1; return; }
        int dev = 0, cus = 0, per_cu = 0;
        if (hipGetDevice(&dev) != hipSuccess || hipDeviceGetAttribute(&cus, hipDeviceAttributeMultiprocessorCount, dev) != hipSuccess) { grid = -1; return; }
        if (hipFuncSetAttribute((const void*)mk_fwd<MAIN_SUB>, hipFuncAttributeMaxDynamicSharedMemorySize, LDS_BYTES) != hipSuccess) { fprintf(stderr, "kernel_launch: hipFuncSetAttribute failed\n"); grid = -1; return; }
        if (hipOccupancyMaxActiveBlocksPerMultiprocessor(&per_cu, (const void*)mk_fwd<MAIN_SUB>, NTHR, LDS_BYTES) != hipSuccess || per_cu < 1) fprintf(stderr, "kernel_launch: occupancy query reports %d\n", per_cu);
        (void)hipGetLastError();
        grid = cus;
    }
    if (grid < 0) return;
    if (hipMemsetAsync((char*)d_ws + WS_CTL, 0, CTL_ZERO_BYTES, stream) != hipSuccess) return;
    Args a{};
    for (int i = 0; i < 21; ++i) a.in[i] = (const float*)d_in[i];
    a.out = (float*)d_out; a.ws = (unsigned char*)d_ws;
#if MK_ONE_LAUNCH
    a.ph_lo = 0; a.ph_hi = NPHASE;
    hipLaunchKernelGGL(mk_fwd<MAIN_SUB>, dim3(grid), dim3(NTHR), LDS_BYTES, stream, a);
#elif defined(DBG_CHECK)
    for (int p = 0; p < DBG_CHECK; ++p) { a.ph_lo = p; a.ph_hi = p + 1; hipLaunchKernelGGL(mk_fwd<MAIN_SUB>, dim3(grid), dim3(NTHR), LDS_BYTES, stream, a); }
    float* flags = (float*)((char*)d_ws + WS_END);
    hipLaunchKernelGGL(dbg::k_check, dim3(13), dim3(256), 0, stream, a, flags);
    hipLaunchKernelGGL(dbg::k_out, dim3(1024), dim3(256), 0, stream, a, (const float*)flags, 16, (unsigned)DBG_MASK);
#else
    if (hipFuncSetAttribute((const void*)mk_fwd<PROBE_SUB>, hipFuncAttributeMaxDynamicSharedMemorySize, LDS_BYTES) != hipSuccess) return;
    for (int p = 0; p < NPHASE; ++p) { a.ph_lo = p; a.ph_hi = p + 1; hipLaunchKernelGGL(mk_fwd<MAIN_SUB>, dim3(grid), dim3(NTHR), LDS_BYTES, stream, a);
        const int pid = p < 2 ? p : 2 + (p - 2) % PH_PER_LAYER;
        if (pid == PROBE_PH) for (int rep = 0; rep < PROBE_REP; ++rep) hipLaunchKernelGGL(mk_fwd<PROBE_SUB>, dim3(grid), dim3(NTHR), LDS_BYTES, stream, a); }
#endif
}
```
